# Optimizing an MI355X kernel written in HIP

```python
import math
import jax, jax.numpy as jnp
from jax import lax
import numpy as np

D_MODEL = 1024
BATCH = 4
SEQ = 4096
DEPTH = 4

HEAD_DIM = 64
ATTN_SCALE = HEAD_DIM ** -0.5
SWA_HEADS = 8
SWA_KV_HEADS = 2
SWA_WINDOW = 128
SWA_Q = SWA_HEADS * HEAD_DIM
SWA_KV = SWA_KV_HEADS * HEAD_DIM
SSM_WIDTH = 512
SSM_GROUP = 16
SSM_GROUPS = SSM_WIDTH // SSM_GROUP
SSM_STATE = 64
DT_MIN = 0.001
DT_MAX = 0.1
MOBA_HEADS = 8
MOBA_KV_HEADS = 2
MOBA_BLOCK = 256
MOBA_TOPK = 3
MOBA_Q_CHUNK = 64
MOBA_Q = MOBA_HEADS * HEAD_DIM
MOBA_KV = MOBA_KV_HEADS * HEAD_DIM
N_BRANCH = 3
D_FF = 4 * D_MODEL
NORM_EPS = 1e-6
ALIBI_MAX_BIAS = 8.0
IN_SIZES = (SWA_Q, SWA_KV, SWA_KV, SSM_WIDTH, MOBA_Q, MOBA_KV, MOBA_KV, N_BRANCH * D_MODEL)
D_IN = sum(IN_SIZES)

kernel_name = "hybrid_swa_s5_moba_gated"


def rms_norm(x, gain):
    xf = x.astype(jnp.float32)
    y = xf * lax.rsqrt(jnp.mean(xf * xf, axis=-1, keepdims=True) + NORM_EPS)
    return (y * gain.astype(jnp.float32)).astype(x.dtype)


def alibi_slopes():
    n = SWA_HEADS + MOBA_HEADS
    return jnp.asarray(2.0 ** (-ALIBI_MAX_BIAS * np.arange(1, n + 1) / n), jnp.float32)


def split_in(proj):
    outs, start = [], 0
    for size in IN_SIZES:
        outs.append(proj[..., start:start + size])
        start += size
    return outs


def swa_attention(q, k, v, sinks, slopes):
    B, S, Hq, d = q.shape
    Hkv = k.shape[2]
    G = Hq // Hkv
    W = SWA_WINDOW
    nb = S // W
    qb = q.reshape(B, nb, W, Hkv, G, d)
    kp = jnp.pad(k, ((0, 0), (W, 0), (0, 0), (0, 0))).reshape(B, nb + 1, W, Hkv, d)
    vp = jnp.pad(v, ((0, 0), (W, 0), (0, 0), (0, 0))).reshape(B, nb + 1, W, Hkv, d)
    kb = jnp.concatenate([kp[:, :-1], kp[:, 1:]], axis=2)
    vb = jnp.concatenate([vp[:, :-1], vp[:, 1:]], axis=2)
    s = jnp.einsum('bnqhgd,bnkhd->bnhgqk', qb, kb).astype(jnp.float32) * ATTN_SCALE
    t_rel = jnp.arange(W)[:, None]
    s_rel = jnp.arange(2 * W)[None, :] - W
    dist = t_rel - s_rel
    band = (dist >= 0) & (dist < W)
    mask = band[None] & ((jnp.arange(nb)[:, None, None] * W + s_rel[None]) >= 0)
    bias = -slopes.reshape(Hkv, G)[:, :, None, None] * dist.astype(jnp.float32)[None, None]
    s = jnp.where(mask[None, :, None, None], s + bias[None, None], -jnp.inf)
    sink = jnp.broadcast_to(sinks.astype(jnp.float32).reshape(Hkv, G)[None, None, :, :, None, None],
                            s.shape[:-1] + (1,))
    p = jax.nn.softmax(jnp.concatenate([s, sink], axis=-1), axis=-1)[..., :-1].astype(v.dtype)
    o = jnp.einsum('bnhgqk,bnkhd->bnqhgd', p, vb)
    return o.reshape(B, S, Hq * d)


def moba_attention(q, k, v, slopes):
    B, S, Hq, d = q.shape
    Hkv = k.shape[2]
    G = Hq // Hkv
    L = MOBA_BLOCK
    Qc = MOBA_Q_CHUNK
    Sp = -(-S // L) * L
    nblk = Sp // L
    topk = min(MOBA_TOPK, nblk)
    pad = ((0, 0), (0, Sp - S), (0, 0), (0, 0))
    q, k, v = jnp.pad(q, pad), jnp.pad(k, pad), jnp.pad(v, pad)
    k_blocks = jnp.repeat(k, G, axis=2).transpose(0, 2, 1, 3).reshape(B, Hq, nblk, L, d)
    v_blocks = jnp.repeat(v, G, axis=2).transpose(0, 2, 1, 3).reshape(B, Hq, nblk, L, d)
    k_mean = jnp.mean(k_blocks.astype(jnp.float32), axis=3)
    nq = Sp // Qc
    q_chunks = q.transpose(0, 2, 1, 3).reshape(B, Hq, nq, Qc, d).transpose(2, 0, 1, 3, 4)
    b_idx = jnp.arange(B)[:, None, None, None]
    h_idx = jnp.arange(Hq)[None, :, None, None]
    blk_ids = jnp.arange(nblk)
    rank_ids = jnp.arange(topk)
    offs = jnp.arange(L)

    def one_chunk(args):
        qi, ci = args
        t = ci * Qc + jnp.arange(Qc)
        j = (ci * Qc) // L
        gate = jnp.einsum('bhqd,bhnd->bhqn', qi.astype(jnp.float32), k_mean)
        gate = jnp.where(blk_ids < j, gate, -jnp.inf)
        _, sel = lax.top_k(gate, topk)
        valid = rank_ids < j
        k_sel = k_blocks[b_idx, h_idx, sel]
        v_sel = v_blocks[b_idx, h_idx, sel]
        s_sel = jnp.einsum('bhqd,bhqrkd->bhqrk', qi, k_sel).astype(jnp.float32) * ATTN_SCALE
        dist_sel = (t[None, None, :, None, None] - (sel[..., None] * L + offs)).astype(jnp.float32)
        s_sel = s_sel - slopes[None, :, None, None, None] * dist_sel
        s_sel = jnp.where(valid[None, None, None, :, None], s_sel, -jnp.inf)
        k_own = lax.dynamic_slice_in_dim(k_blocks, j, 1, axis=2)[:, :, 0]
        v_own = lax.dynamic_slice_in_dim(v_blocks, j, 1, axis=2)[:, :, 0]
        s_own = jnp.einsum('bhqd,bhkd->bhqk', qi, k_own).astype(jnp.float32) * ATTN_SCALE
        dist_own = t[:, None] - (j * L + offs)[None, :]
        s_own = s_own - slopes[None, :, None, None] * dist_own.astype(jnp.float32)[None, None]
        s_own = jnp.where((dist_own >= 0)[None, None], s_own, -jnp.inf)
        logits = jnp.concatenate([s_sel.reshape(B, Hq, Qc, topk * L), s_own], axis=-1)
        p = jax.nn.softmax(logits, axis=-1).astype(v_blocks.dtype)
        p_sel = p[..., :topk * L].reshape(B, Hq, Qc, topk, L)
        o = (jnp.einsum('bhqrk,bhqrkd->bhqd', p_sel, v_sel)
             + jnp.einsum('bhqk,bhkd->bhqd', p[..., topk * L:], v_own))
        return o

    o = lax.map(one_chunk, (q_chunks, jnp.arange(nq)))
    o = o.transpose(1, 0, 3, 2, 4).reshape(B, Sp, Hq * d)
    return o[:, :S]


def s5_ssm(u, lam_re, lam_im, log_step, b_re, b_im, c_re, c_im, d_skip):
    Bsz, S, _ = u.shape
    f32 = jnp.float32
    uf = u.astype(f32).reshape(Bsz, S, SSM_GROUPS, SSM_GROUP)
    lr, li = lam_re.astype(f32), lam_im.astype(f32)
    dt = jnp.exp(log_step.astype(f32))[:, None]
    mag = jnp.exp(lr * dt)
    ab_re, ab_im = mag * jnp.cos(li * dt), mag * jnp.sin(li * dt)
    den = lr * lr + li * li
    nr, ni = ab_re - 1.0, ab_im
    f_re, f_im = (nr * lr + ni * li) / den, (ni * lr - nr * li) / den
    br, bi = b_re.astype(f32), b_im.astype(f32)
    bb_re = f_re[..., None] * br - f_im[..., None] * bi
    bb_im = f_re[..., None] * bi + f_im[..., None] * br
    x_re = jnp.einsum('bsgh,gph->bsgp', uf, bb_re)
    x_im = jnp.einsum('bsgh,gph->bsgp', uf, bb_im)
    a_re = jnp.broadcast_to(ab_re, x_re.shape)
    a_im = jnp.broadcast_to(ab_im, x_im.shape)

    def combine(e1, e2):
        a1r, a1i, b1r, b1i = e1
        a2r, a2i, b2r, b2i = e2
        return (a2r * a1r - a2i * a1i, a2r * a1i + a2i * a1r,
                a2r * b1r - a2i * b1i + b2r, a2r * b1i + a2i * b1r + b2i)

    _, _, h_re, h_im = lax.associative_scan(combine, (a_re, a_im, x_re, x_im), axis=1)
    y = (jnp.einsum('bsgp,ghp->bsgh', h_re, c_re.astype(f32))
         - jnp.einsum('bsgp,ghp->bsgh', h_im, c_im.astype(f32))
         + d_skip.astype(f32).reshape(SSM_GROUPS, SSM_GROUP) * uf)
    return y.reshape(Bsz, S, SSM_WIDTH)


def setup_inputs(seed: int = 0) -> dict:
    key = jax.random.key(seed)
    ks = jax.random.split(key, 24)
    f32 = jnp.float32
    nrm = lambda k, shape, scale: jax.random.normal(k, shape, f32) * scale
    x = jax.random.normal(ks[0], (BATCH, SEQ, D_MODEL), f32)
    norm_mix = 1.0 + nrm(ks[1], (DEPTH, D_MODEL), 0.02)
    w_in = nrm(ks[2], (DEPTH, D_MODEL, D_IN), D_MODEL ** -0.5)
    sinks = nrm(ks[3], (DEPTH, SWA_HEADS), 0.5)
    lam_re = -0.5 + nrm(ks[4], (DEPTH, SSM_GROUPS, SSM_STATE), 0.01)
    lam_im = (math.pi * jnp.arange(SSM_STATE, dtype=f32))[None, None, :] + nrm(ks[5], (DEPTH, SSM_GROUPS, SSM_STATE), 0.01)
    log_step = math.log(DT_MIN) + jax.random.uniform(ks[6], (DEPTH, SSM_GROUPS), f32) * (math.log(DT_MAX) - math.log(DT_MIN))
    b_re = nrm(ks[7], (DEPTH, SSM_GROUPS, SSM_STATE, SSM_GROUP), (2 * SSM_GROUP) ** -0.5)
    b_im = nrm(ks[8], (DEPTH, SSM_GROUPS, SSM_STATE, SSM_GROUP), (2 * SSM_GROUP) ** -0.5)
    c_re = nrm(ks[9], (DEPTH, SSM_GROUPS, SSM_GROUP, SSM_STATE), (2 * SSM_STATE) ** -0.5)
    c_im = nrm(ks[10], (DEPTH, SSM_GROUPS, SSM_GROUP, SSM_STATE), (2 * SSM_STATE) ** -0.5)
    d_skip = nrm(ks[11], (DEPTH, SSM_WIDTH), 1.0)
    w_glu = nrm(ks[12], (DEPTH, SSM_WIDTH, 2 * SSM_WIDTH), SSM_WIDTH ** -0.5)
    w_o_swa = nrm(ks[13], (DEPTH, SWA_Q, D_MODEL), SWA_Q ** -0.5)
    w_o_ssm = nrm(ks[14], (DEPTH, SSM_WIDTH, D_MODEL), SSM_WIDTH ** -0.5)
    w_o_moba = nrm(ks[15], (DEPTH, MOBA_Q, D_MODEL), MOBA_Q ** -0.5)
    w_out = nrm(ks[16], (DEPTH, D_MODEL, D_MODEL), D_MODEL ** -0.5)
    norm_ffn = 1.0 + nrm(ks[17], (DEPTH, D_MODEL), 0.02)
    w_ff1 = nrm(ks[18], (DEPTH, D_MODEL, D_FF), D_MODEL ** -0.5)
    w_ff2 = nrm(ks[19], (DEPTH, D_FF, D_MODEL), D_FF ** -0.5)
    norm_final = 1.0 + nrm(ks[20], (D_MODEL,), 0.02)
    return {"x": x, "norm_mix": norm_mix, "w_in": w_in, "sinks": sinks,
            "lam_re": lam_re, "lam_im": lam_im, "log_step": log_step,
            "b_re": b_re, "b_im": b_im, "c_re": c_re, "c_im": c_im, "d_skip": d_skip,
            "w_glu": w_glu, "w_o_swa": w_o_swa, "w_o_ssm": w_o_ssm, "w_o_moba": w_o_moba,
            "w_out": w_out, "norm_ffn": norm_ffn, "w_ff1": w_ff1, "w_ff2": w_ff2,
            "norm_final": norm_final}


def reference(x, norm_mix, w_in, sinks, lam_re, lam_im, log_step, b_re, b_im, c_re, c_im,
              d_skip, w_glu, w_o_swa, w_o_ssm, w_o_moba, w_out, norm_ffn, w_ff1, w_ff2,
              norm_final):
    B, S, _ = x.shape
    slopes = alibi_slopes()
    slopes_swa, slopes_moba = slopes[:SWA_HEADS], slopes[SWA_HEADS:]
    for l in range(DEPTH):
        h = rms_norm(x, norm_mix[l])
        qa, ka, va, u, qm, km, vm, gates = split_in(h @ w_in[l])
        oa = swa_attention(qa.reshape(B, S, SWA_HEADS, HEAD_DIM),
                           ka.reshape(B, S, SWA_KV_HEADS, HEAD_DIM),
                           va.reshape(B, S, SWA_KV_HEADS, HEAD_DIM), sinks[l], slopes_swa)
        ya = oa @ w_o_swa[l]
        ys = s5_ssm(u, lam_re[l], lam_im[l], log_step[l], b_re[l], b_im[l], c_re[l], c_im[l], d_skip[l])
        z = jax.nn.gelu(ys).astype(x.dtype) @ w_glu[l]
        yb = (z[..., :SSM_WIDTH] * jax.nn.sigmoid(z[..., SSM_WIDTH:])) @ w_o_ssm[l]
        om = moba_attention(qm.reshape(B, S, MOBA_HEADS, HEAD_DIM),
                            km.reshape(B, S, MOBA_KV_HEADS, HEAD_DIM),
                            vm.reshape(B, S, MOBA_KV_HEADS, HEAD_DIM), slopes_moba)
        yc = om @ w_o_moba[l]
        g = jax.nn.sigmoid(gates)
        mixed = (g[..., :D_MODEL] * ya + g[..., D_MODEL:2 * D_MODEL] * yb
                 + g[..., 2 * D_MODEL:] * yc)
        x = x + mixed @ w_out[l]
        h = rms_norm(x, norm_ffn[l])
        x = x + jnp.square(jax.nn.relu(h @ w_ff1[l])) @ w_ff2[l]
    return rms_norm(x, norm_final)
```

```cpp
#include <hip/hip_runtime.h>
#include <cstdio>
#include <cstdint>

namespace nv {
constexpr int DM = 1024, NB = 4, S = 4096, DEPTH = 4, HD = 64;
constexpr int W = 128;
constexpr int SSM_W = 512, SSM_NG = 32, SSM_P = 64, SSM_H = 16;
constexpr int MB_L = 256, MB_NBLK = S / MB_L;
constexpr int DFF = 4096, DIN = 5120;
constexpr int C_QA = 0, C_KA = 512, C_VA = 640, C_U = 768, C_QM = 1280, C_KM = 1792, C_VM = 1920, C_G = 2048;
constexpr float ATTN_SCALE = 0.125f, EPS = 1e-6f;

__device__ __forceinline__ float wave_sum(float v) {
#pragma unroll
    for (int o = 1; o < 64; o <<= 1) v += __shfl_xor(v, o);
    return v;
}
__device__ __forceinline__ float wave_max(float v) {
#pragma unroll
    for (int o = 1; o < 64; o <<= 1) v = fmaxf(v, __shfl_xor(v, o));
    return v;
}
__device__ __forceinline__ float sigmoidf_(float x) { return 1.f / (1.f + expf(-x)); }
__device__ __forceinline__ float gelu_tanh(float x) { const float c = 0.7978845608028654f; return 0.5f * x * (1.f + tanhf(c * (x + 0.044715f * x * x * x))); }

__global__ void __launch_bounds__(256) rmsnorm_k(const float* x, const float* __restrict__ gain, float* out, int rows) {
    const int row = blockIdx.x * 4 + (threadIdx.x >> 6), lane = threadIdx.x & 63;
    if (row >= rows) return;
    const float4* xr = (const float4*)(x + (size_t)row * DM);
    float4 v[4]; float s = 0.f;
#pragma unroll
    for (int j = 0; j < 4; ++j) { v[j] = xr[lane + 64 * j]; s += v[j].x * v[j].x + v[j].y * v[j].y + v[j].z * v[j].z + v[j].w * v[j].w; }
    s = wave_sum(s);
    const float r = rsqrtf(s * (1.f / DM) + EPS);
    float4* o = (float4*)(out + (size_t)row * DM);
#pragma unroll
    for (int j = 0; j < 4; ++j) { const float4 g = ((const float4*)gain)[lane + 64 * j]; o[lane + 64 * j] = make_float4(v[j].x * r * g.x, v[j].y * r * g.y, v[j].z * r * g.z, v[j].w * r * g.w); }
}

template <int EPI>
__global__ void __launch_bounds__(256) gemm_k(const float* __restrict__ A, int lda, const float* __restrict__ Bm, int ldb, float* C, int ldc, int K) {
    __shared__ float As[16][64 + 4], Bs[16][64 + 4];
    const int tx = threadIdx.x & 15, ty = threadIdx.x >> 4, row0 = blockIdx.y * 64, col0 = blockIdx.x * 64;
    float acc[4][4] = {};
    for (int k0 = 0; k0 < K; k0 += 16) {
        { const int r = threadIdx.x >> 2, kk = (threadIdx.x & 3) * 4; const float4 a = *(const float4*)(A + (size_t)(row0 + r) * lda + k0 + kk);
          As[kk + 0][r] = a.x; As[kk + 1][r] = a.y; As[kk + 2][r] = a.z; As[kk + 3][r] = a.w; }
        { const int kk = threadIdx.x >> 4, c = (threadIdx.x & 15) * 4; const float4 b = *(const float4*)(Bm + (size_t)(k0 + kk) * ldb + col0 + c);
          *(float4*)&Bs[kk][c] = b; }
        __syncthreads();
#pragma unroll
        for (int kk = 0; kk < 16; ++kk) {
            const float4 a = *(const float4*)&As[kk][ty * 4], b = *(const float4*)&Bs[kk][tx * 4];
            const float av[4] = {a.x, a.y, a.z, a.w}, bv[4] = {b.x, b.y, b.z, b.w};
#pragma unroll
            for (int i = 0; i < 4; ++i)
#pragma unroll
                for (int j = 0; j < 4; ++j) acc[i][j] = fmaf(av[i], bv[j], acc[i][j]);
        }
        __syncthreads();
    }
#pragma unroll
    for (int i = 0; i < 4; ++i) {
        float* cp = C + (size_t)(row0 + ty * 4 + i) * ldc + col0 + tx * 4;
        float4 o;
        if (EPI == 1) { const float4 c = *(const float4*)cp; o = make_float4(c.x + acc[i][0], c.y + acc[i][1], c.z + acc[i][2], c.w + acc[i][3]); }
        else if (EPI == 2) { const float t0 = fmaxf(acc[i][0], 0.f), t1 = fmaxf(acc[i][1], 0.f), t2 = fmaxf(acc[i][2], 0.f), t3 = fmaxf(acc[i][3], 0.f); o = make_float4(t0 * t0, t1 * t1, t2 * t2, t3 * t3); }
        else o = make_float4(acc[i][0], acc[i][1], acc[i][2], acc[i][3]);
        *(float4*)cp = o;
    }
}

__global__ void __launch_bounds__(128) swa_k(const float* __restrict__ proj, const float* __restrict__ sinks  , float* __restrict__ oa  ) {
    const int t = blockIdx.x, h = blockIdx.y, kvh = h >> 2, i = threadIdx.x;
    __shared__ float q[64], p[128], red[4];
    if (i < 64) q[i] = proj[(size_t)t * DIN + C_QA + h * 64 + i];
    __syncthreads();
    const float slope = exp2f(-0.5f * (float)(h + 1));
    const int s = t - i;
    float sc = -INFINITY;
    if (s >= 0) { const float* kp = proj + (size_t)s * DIN + C_KA + kvh * 64; float d = 0.f; for (int c = 0; c < 64; ++c) d = fmaf(q[c], kp[c], d); sc = d * ATTN_SCALE - slope * (float)i; }
    const float sink = sinks[h];
    float m = wave_max(sc); if ((i & 63) == 0) red[i >> 6] = m; __syncthreads();
    m = fmaxf(fmaxf(red[0], red[1]), sink);
    const float e = (s >= 0) ? expf(sc - m) : 0.f; p[i] = e;
    float sum = wave_sum(e); if ((i & 63) == 0) red[2 + (i >> 6)] = sum; __syncthreads();
    const float denom = red[2] + red[3] + expf(sink - m);
    if (i < 64) { float o = 0.f; for (int k = 0; k < 128; ++k) { const int sk = t - k; if (sk >= 0) o = fmaf(p[k], proj[(size_t)sk * DIN + C_VA + kvh * 64 + i], o); } oa[(size_t)t * 512 + h * 64 + i] = o / denom; }
}

__global__ void __launch_bounds__(64) kmean_k(const float* __restrict__ proj, float* __restrict__ kmean  ) {
    const int n = blockIdx.x, kvh = blockIdx.y, d = threadIdx.x; float s = 0.f;
    for (int i = 0; i < MB_L; ++i) s += proj[(size_t)(n * MB_L + i) * DIN + C_KM + kvh * 64 + d];
    kmean[(kvh * MB_NBLK + n) * 64 + d] = s * (1.f / MB_L);
}
__global__ void __launch_bounds__(256) moba_k(const float* __restrict__ proj, const float* __restrict__ kmean, float* __restrict__ om  ) {
    const int t = blockIdx.x, h = blockIdx.y, kvh = h >> 2, i = threadIdx.x, j = t / MB_L;
    __shared__ float q[64], gate[16], p[4][256], red[8]; __shared__ int sel[4]; __shared__ int nsel_s;
    if (i < 64) q[i] = proj[(size_t)t * DIN + C_QM + h * 64 + i];
    __syncthreads();
    if (i < 16) { float g = -INFINITY; if (i < j) { g = 0.f; const float* km = kmean + (kvh * MB_NBLK + i) * 64; for (int c = 0; c < 64; ++c) g = fmaf(q[c], km[c], g); } gate[i] = g; }
    __syncthreads();
    if (i == 0) { int ns = j < 3 ? j : 3; unsigned used = 0u; for (int r = 0; r < ns; ++r) { int best = -1; float bv = -INFINITY; for (int n = 0; n < j; ++n) if (!((used >> n) & 1u) && (best < 0 || gate[n] > bv)) { best = n; bv = gate[n]; } used |= 1u << best; sel[r] = best; } sel[ns] = j; nsel_s = ns + 1; }
    __syncthreads();
    const int nsel = nsel_s; const float slope = exp2f(-0.5f * (float)(8 + h + 1));
    float sc[4]; float m = -INFINITY;
#pragma unroll
    for (int r = 0; r < 4; ++r) { sc[r] = -INFINITY; if (r >= nsel) continue; const int s = sel[r] * MB_L + i; float v = -INFINITY;
        if (s <= t) { const float* kp = proj + (size_t)s * DIN + C_KM + kvh * 64; float d = 0.f; for (int c = 0; c < 64; ++c) d = fmaf(q[c], kp[c], d); v = d * ATTN_SCALE - slope * (float)(t - s); }
        sc[r] = v; m = fmaxf(m, v); }
    m = wave_max(m); if ((i & 63) == 0) red[i >> 6] = m; __syncthreads();
    m = fmaxf(fmaxf(red[0], red[1]), fmaxf(red[2], red[3]));
    float sum = 0.f;
#pragma unroll
    for (int r = 0; r < 4; ++r) { if (r >= nsel) continue; const float e = (sc[r] == -INFINITY) ? 0.f : expf(sc[r] - m); p[r][i] = e; sum += e; }
    sum = wave_sum(sum); if ((i & 63) == 0) red[4 + (i >> 6)] = sum; __syncthreads();
    const float denom = red[4] + red[5] + red[6] + red[7];
    const int d = i & 63, qu = i >> 6; float o = 0.f;
    for (int r = 0; r < nsel; ++r) { const int s0 = sel[r] * MB_L + qu * 64; for (int k = 0; k < 64; ++k) { const float pv = p[r][qu * 64 + k]; if (pv != 0.f) o = fmaf(pv, proj[(size_t)(s0 + k) * DIN + C_VM + kvh * 64 + d], o); } }
    __syncthreads();
    p[qu][d] = o; __syncthreads();
    if (i < 64) om[(size_t)t * 512 + h * 64 + i] = (p[0][i] + p[1][i] + p[2][i] + p[3][i]) / denom;
}

__global__ void __launch_bounds__(64) ssm_k(const float* __restrict__ proj, const float* __restrict__ lam_re, const float* __restrict__ lam_im, const float* __restrict__ log_step,
                                            const float* __restrict__ b_re, const float* __restrict__ b_im, const float* __restrict__ c_re, const float* __restrict__ c_im,
                                            const float* __restrict__ d_skip, float* __restrict__ ys  ) {
    const int g = blockIdx.x, p = threadIdx.x;
    __shared__ float us[64][16], hr[64][65], hi[64][65], cr[16][64], ci[16][64];
    const float lr = lam_re[g * 64 + p], li = lam_im[g * 64 + p], dt = expf(log_step[g]);
    const float mag = expf(lr * dt), are = mag * cosf(li * dt), aim = mag * sinf(li * dt);
    const float den = lr * lr + li * li, nr = are - 1.f, ni = aim;
    const float fre = (nr * lr + ni * li) / den, fim = (ni * lr - nr * li) / den;
    float bbr[16], bbi[16];
#pragma unroll
    for (int h = 0; h < 16; ++h) { const float br = b_re[(g * 64 + p) * 16 + h], bi = b_im[(g * 64 + p) * 16 + h]; bbr[h] = fre * br - fim * bi; bbi[h] = fre * bi + fim * br; }
    for (int i = 0; i < 16; ++i) { cr[i][p] = c_re[(g * 16 + i) * 64 + p]; ci[i][p] = c_im[(g * 16 + i) * 64 + p]; }
    float sr = 0.f, si = 0.f;
    for (int t0 = 0; t0 < S; t0 += 64) {
        __syncthreads();
        for (int e = p; e < 64 * 16; e += 64) us[e >> 4][e & 15] = proj[(size_t)(t0 + (e >> 4)) * DIN + C_U + g * 16 + (e & 15)];
        __syncthreads();
        for (int tl = 0; tl < 64; ++tl) {
            float xr = 0.f, xi = 0.f;
#pragma unroll
            for (int h = 0; h < 16; ++h) { const float u = us[tl][h]; xr = fmaf(u, bbr[h], xr); xi = fmaf(u, bbi[h], xi); }
            const float nr2 = are * sr - aim * si + xr, ni2 = are * si + aim * sr + xi; sr = nr2; si = ni2;
            hr[tl][p] = sr; hi[tl][p] = si;
        }
        __syncthreads();
        { const int tl = p; float y[16];
#pragma unroll
          for (int i = 0; i < 16; ++i) y[i] = 0.f;
          for (int pp = 0; pp < 64; ++pp) { const float a = hr[tl][pp], b = hi[tl][pp];
#pragma unroll
              for (int i = 0; i < 16; ++i) y[i] += a * cr[i][pp] - b * ci[i][pp]; }
#pragma unroll
          for (int i = 0; i < 16; ++i) { const float v = y[i] + d_skip[g * 16 + i] * us[tl][i]; ys[(size_t)(t0 + tl) * 512 + g * 16 + i] = gelu_tanh(v); } }
    }
}
__global__ void glu_k(const float* __restrict__ z, float* __restrict__ out, int n) { const int idx = blockIdx.x * 256 + threadIdx.x; if (idx >= n) return; const int t = idx >> 9, c = idx & 511; out[idx] = z[(size_t)t * 1024 + c] * sigmoidf_(z[(size_t)t * 1024 + 512 + c]); }
__global__ void merge_k(const float* __restrict__ proj, const float* __restrict__ ya, const float* __restrict__ yb, const float* __restrict__ yc, float* __restrict__ mixed, int n) {
    const int idx = blockIdx.x * 256 + threadIdx.x; if (idx >= n) return; const int t = idx >> 10, c = idx & 1023; const float* g = proj + (size_t)t * DIN + C_G;
    mixed[idx] = sigmoidf_(g[c]) * ya[idx] + sigmoidf_(g[1024 + c]) * yb[idx] + sigmoidf_(g[2048 + c]) * yc[idx];
}
}

extern "C" void kernel_launch(void* const* d_in, const int* in_sizes, int n_in, void* d_out, int out_size, void* d_ws, size_t ws_size, hipStream_t stream) {
    using namespace nv;
    const float* x_in = (const float*)d_in[0]; const float* norm_mix = (const float*)d_in[1]; const float* w_in = (const float*)d_in[2]; const float* sinks = (const float*)d_in[3];
    const float* lam_re = (const float*)d_in[4]; const float* lam_im = (const float*)d_in[5]; const float* log_step = (const float*)d_in[6];
    const float* b_re = (const float*)d_in[7]; const float* b_im = (const float*)d_in[8]; const float* c_re = (const float*)d_in[9]; const float* c_im = (const float*)d_in[10];
    const float* d_skip = (const float*)d_in[11]; const float* w_glu = (const float*)d_in[12]; const float* w_o_swa = (const float*)d_in[13]; const float* w_o_ssm = (const float*)d_in[14];
    const float* w_o_moba = (const float*)d_in[15]; const float* w_out = (const float*)d_in[16]; const float* norm_ffn = (const float*)d_in[17]; const float* w_ff1 = (const float*)d_in[18];
    const float* w_ff2 = (const float*)d_in[19]; const float* norm_final = (const float*)d_in[20];
    float* x = (float*)d_out;
    float* ws = (float*)d_ws; size_t off = 0;
    auto carve = [&](size_t n) { float* p = ws + off; off += (n + 63) & ~(size_t)63; return p; };
    float* h = carve((size_t)S * DM); float* proj = carve((size_t)S * DIN); float* oa = carve((size_t)S * 512); float* ys = carve((size_t)S * 512); float* z = carve((size_t)S * 1024);
    float* glu = carve((size_t)S * 512); float* om = carve((size_t)S * 512); float* ya = carve((size_t)S * DM); float* yb = carve((size_t)S * DM); float* yc = carve((size_t)S * DM);
    float* mixed = carve((size_t)S * DM); float* kmean = carve(2 * 16 * 64); float* hid = carve((size_t)S * DFF);
    if (off * 4 > ws_size) { fprintf(stderr, "ws too small: need %zu have %zu\n", off * 4, ws_size); return; }
    hipMemcpyAsync(x, x_in, (size_t)NB * S * DM * 4, hipMemcpyDeviceToDevice, stream);
    for (int l = 0; l < DEPTH; ++l) {
        for (int b = 0; b < NB; ++b) {
            float* xb = x + (size_t)b * S * DM;
            rmsnorm_k<<<S / 4, 256, 0, stream>>>(xb, norm_mix + l * DM, h, S);
            gemm_k<0><<<dim3(DIN / 64, S / 64), 256, 0, stream>>>(h, DM, w_in + (size_t)l * DM * DIN, DIN, proj, DIN, DM);
            swa_k<<<dim3(S, 8), 128, 0, stream>>>(proj, sinks + l * 8, oa);
            ssm_k<<<SSM_NG, 64, 0, stream>>>(proj, lam_re + l * 2048, lam_im + l * 2048, log_step + l * 32, b_re + (size_t)l * 32768, b_im + (size_t)l * 32768, c_re + (size_t)l * 32768, c_im + (size_t)l * 32768, d_skip + l * 512, ys);
            gemm_k<0><<<dim3(1024 / 64, S / 64), 256, 0, stream>>>(ys, 512, w_glu + (size_t)l * 512 * 1024, 1024, z, 1024, 512);
            glu_k<<<S * 512 / 256, 256, 0, stream>>>(z, glu, S * 512);
            kmean_k<<<dim3(16, 2), 64, 0, stream>>>(proj, kmean);
            moba_k<<<dim3(S, 8), 256, 0, stream>>>(proj, kmean, om);
            gemm_k<0><<<dim3(DM / 64, S / 64), 256, 0, stream>>>(oa, 512, w_o_swa + (size_t)l * 512 * DM, DM, ya, DM, 512);
            gemm_k<0><<<dim3(DM / 64, S / 64), 256, 0, stream>>>(glu, 512, w_o_ssm + (size_t)l * 512 * DM, DM, yb, DM, 512);
            gemm_k<0><<<dim3(DM / 64, S / 64), 256, 0, stream>>>(om, 512, w_o_moba + (size_t)l * 512 * DM, DM, yc, DM, 512);
            merge_k<<<S * DM / 256, 256, 0, stream>>>(proj, ya, yb, yc, mixed, S * DM);
            gemm_k<1><<<dim3(DM / 64, S / 64), 256, 0, stream>>>(mixed, DM, w_out + (size_t)l * DM * DM, DM, xb, DM, DM);
            rmsnorm_k<<<S / 4, 256, 0, stream>>>(xb, norm_ffn + l * DM, h, S);
            gemm_k<2><<<dim3(DFF / 64, S / 64), 256, 0, stream>>>(h, DM, w_ff1 + (size_t)l * DM * DFF, DFF, hid, DFF, DM);
            gemm_k<1><<<dim3(DM / 64, S / 64), 256, 0, stream>>>(hid, DFF, w_ff2 + (size_t)l * DFF * DM, DM, xb, DM, DFF);
        }
    }
    rmsnorm_k<<<NB * S / 4, 256, 0, stream>>>(x, norm_final, x, NB * S);
}
```

```cpp
#define MK_GLU 1
#define MK_MERGE 1
#define MK_WOUT 1
#define MK_FFN 1
#define MK_SWA 1
#define MK_MOBA 1
#define MK_SSM 1
#include <hip/hip_runtime.h>
#include <cstdio>
#include <cstdint>

constexpr int NB = 4, S = 4096, T = NB * S, DM = 1024, DEPTH = 4, DIN = 5120, DFF = 4096;
constexpr float LOG2E = 1.4426950408889634f;
constexpr float C2 = 0.125f * LOG2E;
constexpr float NORM_EPS = 1e-6f;
constexpr int SSM_L = 16;
constexpr int SSM_KM = SSM_L * 16 + 128;
constexpr int SSM_KE = SSM_L * 16;
constexpr int NCH = T / SSM_L;

constexpr size_t MiB = 1u << 20;
constexpr size_t WS_CTL = 0, CTL_ZERO_BYTES = 1 * MiB;
constexpr size_t WS_WIN = 1 * MiB, WS_WGLU = 11 * MiB, WS_WMRG = 12 * MiB, WS_WOUT = 15 * MiB, WS_WFF1 = 17 * MiB, WS_WFF2 = 25 * MiB;
constexpr size_t WS_SMAIN = 33 * MiB, WS_SEND = 39 * MiB, WS_KMP = 43 * MiB;
constexpr size_t WS_XN = 44 * MiB;
constexpr size_t WS_QA = 76 * MiB, WS_KA = 92 * MiB, WS_VAT = 96 * MiB, WS_U = 100 * MiB, WS_QM = 116 * MiB, WS_KM = 132 * MiB, WS_VMT = 136 * MiB, WS_GATES = 140 * MiB;
constexpr size_t WS_H1 = 76 * MiB;
constexpr size_t WS_A1 = 236 * MiB, WS_MIXED = 252 * MiB, WS_HEND = 284 * MiB, WS_HINIT = 300 * MiB, WS_END = 308 * MiB;

typedef unsigned short bf16;
typedef short bf16x8 __attribute__((ext_vector_type(8)));
typedef short s16x4 __attribute__((ext_vector_type(4)));
typedef float f32x4 __attribute__((ext_vector_type(4)));
typedef float f32x16 __attribute__((ext_vector_type(16)));
typedef unsigned u32x4 __attribute__((ext_vector_type(4)));
typedef unsigned u32x2 __attribute__((ext_vector_type(2)));

__host__ __device__ __forceinline__ unsigned f2bf(float f) { unsigned u = __builtin_bit_cast(unsigned, f); return (u + 0x7fffu + ((u >> 16) & 1u)) >> 16; }
__host__ __device__ __forceinline__ float bf2f(unsigned b) { return __builtin_bit_cast(float, b << 16); }
typedef float f32x2_t __attribute__((ext_vector_type(2))); typedef __bf16 bf16x2_t __attribute__((ext_vector_type(2)));
__device__ __forceinline__ unsigned cvtpk_s(float lo, float hi) { f32x2_t v = {lo, hi}; bf16x2_t b = __builtin_convertvector(v, bf16x2_t); return __builtin_bit_cast(unsigned, b); }
__device__ __forceinline__ unsigned pk2(float lo, float hi) { return f2bf(lo) | (f2bf(hi) << 16); }
__device__ __forceinline__ float rbf(float f) { return bf2f(f2bf(f)); }
__device__ __forceinline__ float sigmoid_fast(float x) { return __builtin_amdgcn_rcpf(1.f + __builtin_amdgcn_exp2f(-x * LOG2E)); }
__device__ __forceinline__ float gelu_tanh(float x) {
    const float c2 = 2.f * 0.7978845608028654f; const float t = c2 * (x + 0.044715f * x * x * x); return x * sigmoid_fast(t); }
__device__ __forceinline__ float wave_sum(float v) {
#pragma unroll
    for (int o = 1; o < 64; o <<= 1) v += __shfl_xor(v, o);
    return v;
}
__device__ __forceinline__ float wave_max(float v) {
#pragma unroll
    for (int o = 1; o < 64; o <<= 1) v = fmaxf(v, __shfl_xor(v, o));
    return v;
}

struct Ptrs {
    const float *x_in, *norm_mix, *w_in, *sinks, *lam_re, *lam_im, *log_step, *b_re, *b_im, *c_re, *c_im, *d_skip, *w_glu, *w_o_swa, *w_o_ssm, *w_o_moba, *w_out, *norm_ffn, *w_ff1, *w_ff2, *norm_final;
    float* x;
    unsigned char* ws;
};
namespace n2 {
__global__ void __launch_bounds__(256) prep_k(const float* xin, float* x, bf16* XN, int copy) {
    const int row = blockIdx.x * 4 + (threadIdx.x >> 6), lane = threadIdx.x & 63;
    const float4* xr = (const float4*)((copy ? xin : x) + (size_t)row * DM);
    float4 v[4]; float s = 0.f;
#pragma unroll
    for (int j = 0; j < 4; ++j) { v[j] = xr[lane + 64 * j]; s += v[j].x * v[j].x + v[j].y * v[j].y + v[j].z * v[j].z + v[j].w * v[j].w; }
    s = wave_sum(s);
    const float r = rsqrtf(s * (1.f / DM) + NORM_EPS);
#pragma unroll
    for (int j = 0; j < 4; ++j) { if (copy) ((float4*)(x + (size_t)row * DM))[lane + 64 * j] = v[j];
        u32x2 o; o.x = pk2(v[j].x * r, v[j].y * r); o.y = pk2(v[j].z * r, v[j].w * r); *(u32x2*)(XN + (size_t)row * DM + (lane + 64 * j) * 4) = o; }
}
__global__ void __launch_bounds__(256) final_k(float* x, const float* __restrict__ gain) {
    const int row = blockIdx.x * 4 + (threadIdx.x >> 6), lane = threadIdx.x & 63;
    float4* xr = (float4*)(x + (size_t)row * DM);
    float4 v[4]; float s = 0.f;
#pragma unroll
    for (int j = 0; j < 4; ++j) { v[j] = xr[lane + 64 * j]; s += v[j].x * v[j].x + v[j].y * v[j].y + v[j].z * v[j].z + v[j].w * v[j].w; }
    s = wave_sum(s);
    const float r = rsqrtf(s * (1.f / DM) + NORM_EPS);
#pragma unroll
    for (int j = 0; j < 4; ++j) { const float4 g = ((const float4*)gain)[lane + 64 * j]; xr[lane + 64 * j] = make_float4(v[j].x * r * g.x, v[j].y * r * g.y, v[j].z * r * g.z, v[j].w * r * g.w); }
}

__device__ __forceinline__ void core(const bf16* __restrict__ A, int lda, int row0, const float* __restrict__ Bm, int ldb, int col0, const float* __restrict__ gain, int K, float (&acc)[4][4], float (*As)[68], float (*Bs)[68]) {
    const int tx = threadIdx.x & 15, ty = threadIdx.x >> 4;
    for (int k0 = 0; k0 < K; k0 += 16) {
        { const int r = threadIdx.x >> 2, kk = (threadIdx.x & 3) * 4; const u32x2 a = *(const u32x2*)(A + (size_t)(row0 + r) * lda + k0 + kk);
          As[kk + 0][r] = bf2f(a.x & 0xffffu); As[kk + 1][r] = bf2f(a.x >> 16); As[kk + 2][r] = bf2f(a.y & 0xffffu); As[kk + 3][r] = bf2f(a.y >> 16); }
        { const int kk = threadIdx.x >> 4, c = (threadIdx.x & 15) * 4; const float4 b = *(const float4*)(Bm + (size_t)(k0 + kk) * ldb + col0 + c); const float g = gain ? gain[k0 + kk] : 1.f;
          Bs[kk][c] = rbf(b.x * g); Bs[kk][c + 1] = rbf(b.y * g); Bs[kk][c + 2] = rbf(b.z * g); Bs[kk][c + 3] = rbf(b.w * g); }
        __syncthreads();
#pragma unroll
        for (int kk = 0; kk < 16; ++kk) {
            const float4 a = *(const float4*)&As[kk][ty * 4], b = *(const float4*)&Bs[kk][tx * 4];
            acc[0][0] = fmaf(a.x, b.x, acc[0][0]); acc[0][1] = fmaf(a.x, b.y, acc[0][1]); acc[0][2] = fmaf(a.x, b.z, acc[0][2]); acc[0][3] = fmaf(a.x, b.w, acc[0][3]);
            acc[1][0] = fmaf(a.y, b.x, acc[1][0]); acc[1][1] = fmaf(a.y, b.y, acc[1][1]); acc[1][2] = fmaf(a.y, b.z, acc[1][2]); acc[1][3] = fmaf(a.y, b.w, acc[1][3]);
            acc[2][0] = fmaf(a.z, b.x, acc[2][0]); acc[2][1] = fmaf(a.z, b.y, acc[2][1]); acc[2][2] = fmaf(a.z, b.z, acc[2][2]); acc[2][3] = fmaf(a.z, b.w, acc[2][3]);
            acc[3][0] = fmaf(a.w, b.x, acc[3][0]); acc[3][1] = fmaf(a.w, b.y, acc[3][1]); acc[3][2] = fmaf(a.w, b.z, acc[3][2]); acc[3][3] = fmaf(a.w, b.w, acc[3][3]);
        }
        __syncthreads();
    }
}
struct EpiInProj { bf16 *QA, *KA, *VAT, *U, *QM, *KM, *VMT, *GATES;
    __device__ __forceinline__ void operator()(int row, int col, float v) const {
        if (col < 512) QA[(size_t)row * 512 + col] = (bf16)f2bf(v * C2);
        else if (col < 640) KA[(size_t)row * 128 + col - 512] = (bf16)f2bf(v);
        else if (col < 768) { const int c = col - 640, b = row / S, s = row % S; VAT[((size_t)(b * 2 + (c >> 6)) * 64 + (c & 63)) * S + s] = (bf16)f2bf(v); }
        else if (col < 1280) U[(size_t)row * 512 + col - 768] = (bf16)f2bf(v);
        else if (col < 1792) QM[(size_t)row * 512 + col - 1280] = (bf16)f2bf(v * C2);
        else if (col < 1920) KM[(size_t)row * 128 + col - 1792] = (bf16)f2bf(v);
        else if (col < 2048) { const int c = col - 1920, b = row / S, s = row % S; VMT[((size_t)(b * 2 + (c >> 6)) * 64 + (c & 63)) * S + s] = (bf16)f2bf(v); }
        else GATES[(size_t)row * 3072 + col - 2048] = (bf16)f2bf(1.f / (1.f + expf(-v)));
    } };
struct EpiResid { float* x; __device__ __forceinline__ void operator()(int row, int col, float v) const { x[(size_t)row * DM + col] += v; } };
struct EpiFfn1 { bf16* H1; __device__ __forceinline__ void operator()(int row, int col, float v) const { const float t = fmaxf(v, 0.f); H1[(size_t)row * DFF + col] = (bf16)f2bf(t * t); } };
template <class Epi>
__global__ void __launch_bounds__(256) gemm_k(const bf16* __restrict__ A, int lda, const float* __restrict__ Bm, int ldb, const float* __restrict__ gain, int K, Epi E) {
    __shared__ float As[16][68], Bs[16][68];
    const int tx = threadIdx.x & 15, ty = threadIdx.x >> 4, row0 = blockIdx.y * 64, col0 = blockIdx.x * 64;
    float acc[4][4] = {};
    core(A, lda, row0, Bm, ldb, col0, gain, K, acc, As, Bs);
#pragma unroll
    for (int i = 0; i < 4; ++i)
#pragma unroll
        for (int j = 0; j < 4; ++j) E(row0 + ty * 4 + i, col0 + tx * 4 + j, acc[i][j]);
}
__global__ void __launch_bounds__(256) glu_k(const bf16* __restrict__ YS, const float* __restrict__ Wg, bf16* __restrict__ A1) {
    __shared__ float As[16][68], Bs[16][68];
    const int tx = threadIdx.x & 15, ty = threadIdx.x >> 4, row0 = blockIdx.y * 64, col0 = blockIdx.x * 64;
    float av[4][4] = {}, ag[4][4] = {};
    core(YS, 512, row0, Wg, 1024, col0, nullptr, 512, av, As, Bs);
    core(YS, 512, row0, Wg, 1024, 512 + col0, nullptr, 512, ag, As, Bs);
#pragma unroll
    for (int i = 0; i < 4; ++i)
#pragma unroll
        for (int j = 0; j < 4; ++j) A1[(size_t)(row0 + ty * 4 + i) * 512 + col0 + tx * 4 + j] = (bf16)f2bf(av[i][j] / (1.f + expf(-ag[i][j])));
}
__global__ void __launch_bounds__(256) merge_k(const bf16* __restrict__ OA, const bf16* __restrict__ A1, const bf16* __restrict__ OM, const float* __restrict__ Wa, const float* __restrict__ Ws, const float* __restrict__ Wm,
                                               const bf16* __restrict__ GATES, bf16* __restrict__ MIXED) {
    __shared__ float As[16][68], Bs[16][68];
    const int tx = threadIdx.x & 15, ty = threadIdx.x >> 4, row0 = blockIdx.y * 64, col0 = blockIdx.x * 64;
    float a0[4][4] = {}, a1[4][4] = {}, a2[4][4] = {};
    core(OA, 512, row0, Wa, DM, col0, nullptr, 512, a0, As, Bs);
    core(A1, 512, row0, Ws, DM, col0, nullptr, 512, a1, As, Bs);
    core(OM, 512, row0, Wm, DM, col0, nullptr, 512, a2, As, Bs);
#pragma unroll
    for (int i = 0; i < 4; ++i)
#pragma unroll
        for (int j = 0; j < 4; ++j) { const int row = row0 + ty * 4 + i, col = col0 + tx * 4 + j; const bf16* g = GATES + (size_t)row * 3072 + col;
            MIXED[(size_t)row * DM + col] = (bf16)f2bf(bf2f(g[0]) * a0[i][j] + bf2f(g[1024]) * a1[i][j] + bf2f(g[2048]) * a2[i][j]); }
}
__global__ void __launch_bounds__(128) kmean_k(const bf16* __restrict__ KM, float* __restrict__ KMP) {
    const int bn = blockIdx.x, c = threadIdx.x; float s = 0.f;
    for (int i = 0; i < 256; ++i) s += bf2f(KM[(size_t)(bn * 256 + i) * 128 + c]);
    KMP[bn * 128 + c] = s; KMP[64 * 128 + bn * 128 + c] = 0.f;
}
__global__ void __launch_bounds__(128) swa_k(bf16* QA, const bf16* __restrict__ KA, const bf16* __restrict__ VAT, const float* __restrict__ sinks) {
    const int row = blockIdx.x, h = blockIdx.y, kvh = h >> 2, i = threadIdx.x, b = row / S, t = row % S;
    __shared__ float q[64], p[128], red[4];
    if (i < 64) q[i] = bf2f(QA[(size_t)row * 512 + h * 64 + i]);
    __syncthreads();
    const float sl2 = exp2f(-0.5f * (float)(h + 1)) * LOG2E;
    const int s = t - i; float sc = -INFINITY;
    if (s >= 0) { const bf16* kp = KA + (size_t)(b * S + s) * 128 + kvh * 64; float d = 0.f; for (int c = 0; c < 64; ++c) d = fmaf(q[c], bf2f(kp[c]), d); sc = d - sl2 * (float)i; }
    const float sink = sinks[h] * LOG2E;
    float m = wave_max(sc); if ((i & 63) == 0) red[i >> 6] = m; __syncthreads();
    m = fmaxf(fmaxf(red[0], red[1]), sink);
    const float e = (s >= 0) ? exp2f(sc - m) : 0.f; p[i] = e;
    float sum = wave_sum(e); if ((i & 63) == 0) red[2 + (i >> 6)] = sum; __syncthreads();
    const float denom = red[2] + red[3] + exp2f(sink - m);
    if (i < 64) { float o = 0.f; const bf16* vp = VAT + ((size_t)(b * 2 + kvh) * 64 + i) * S; for (int k = 0; k < 128; ++k) { const int sk = t - k; if (sk >= 0) o = fmaf(rbf(p[k]), bf2f(vp[sk]), o); }
        QA[(size_t)row * 512 + h * 64 + i] = (bf16)f2bf(o / denom); }
}
__global__ void __launch_bounds__(256) moba_k(bf16* QM, const bf16* __restrict__ KM, const bf16* __restrict__ VMT, const float* __restrict__ KMP) {
    const int row = blockIdx.x, h = blockIdx.y, kvh = h >> 2, i = threadIdx.x, b = row / S, t = row % S, j = t / 256;
    __shared__ float q[64], gate[16], p[4][256], red[8]; __shared__ int sel[4]; __shared__ int nsel_s;
    if (i < 64) q[i] = bf2f(QM[(size_t)row * 512 + h * 64 + i]);
    __syncthreads();
    if (i < 16) { float g = -INFINITY; if (i < j) { g = 0.f; const float* k0 = KMP + (size_t)(b * 16 + i) * 128 + kvh * 64; const float* k1 = k0 + 64 * 128; for (int c = 0; c < 64; ++c) g = fmaf(q[c], k0[c] + k1[c], g); } gate[i] = g; }
    __syncthreads();
    if (i == 0) { int ns = j < 3 ? j : 3; unsigned used = 0u; for (int r = 0; r < ns; ++r) { int best = -1; float bv = -INFINITY; for (int n = 0; n < j; ++n) if (!((used >> n) & 1u) && (best < 0 || gate[n] > bv)) { best = n; bv = gate[n]; } used |= 1u << best; sel[r] = best; } sel[ns] = j; nsel_s = ns + 1; }
    __syncthreads();
    const int nsel = nsel_s; const float sl2 = exp2f(-0.5f * (float)(8 + h + 1)) * LOG2E;
    float sc[4]; float m = -INFINITY;
#pragma unroll
    for (int r = 0; r < 4; ++r) { sc[r] = -INFINITY; if (r >= nsel) continue; const int s = sel[r] * 256 + i; float v = -INFINITY;
        if (s <= t) { const bf16* kp = KM + (size_t)(b * S + s) * 128 + kvh * 64; float d = 0.f; for (int c = 0; c < 64; ++c) d = fmaf(q[c], bf2f(kp[c]), d); v = d - sl2 * (float)(t - s); }
        sc[r] = v; m = fmaxf(m, v); }
    m = wave_max(m); if ((i & 63) == 0) red[i >> 6] = m; __syncthreads();
    m = fmaxf(fmaxf(red[0], red[1]), fmaxf(red[2], red[3]));
    float sum = 0.f;
#pragma unroll
    for (int r = 0; r < 4; ++r) { if (r >= nsel) continue; const float e = (sc[r] == -INFINITY) ? 0.f : exp2f(sc[r] - m); p[r][i] = e; sum += e; }
    sum = wave_sum(sum); if ((i & 63) == 0) red[4 + (i >> 6)] = sum; __syncthreads();
    const float denom = red[4] + red[5] + red[6] + red[7];
    const int d = i & 63, qu = i >> 6; float o = 0.f; const bf16* vp = VMT + ((size_t)(b * 2 + kvh) * 64 + d) * S;
    for (int r = 0; r < nsel; ++r) { const int s0 = sel[r] * 256 + qu * 64; for (int k = 0; k < 64; ++k) { const float pv = p[r][qu * 64 + k]; if (pv != 0.f) o = fmaf(rbf(pv), bf2f(vp[s0 + k]), o); } }
    __syncthreads();
    p[qu][d] = o; __syncthreads();
    if (i < 64) QM[(size_t)row * 512 + h * 64 + i] = (bf16)f2bf((p[0][i] + p[1][i] + p[2][i] + p[3][i]) / denom);
}
__global__ void __launch_bounds__(64) ssm_k(bf16* U, const float* __restrict__ lam_re, const float* __restrict__ lam_im, const float* __restrict__ log_step,
                                            const float* __restrict__ b_re, const float* __restrict__ b_im, const float* __restrict__ c_re, const float* __restrict__ c_im, const float* __restrict__ d_skip) {
    const int g = blockIdx.x, b = blockIdx.y, p = threadIdx.x;
    __shared__ float us[64][16], hr[64][65], hi[64][65], cr[16][64], ci[16][64];
    const float lr = lam_re[g * 64 + p], li = lam_im[g * 64 + p], dt = expf(log_step[g]);
    const float mag = expf(lr * dt), are = mag * cosf(li * dt), aim = mag * sinf(li * dt);
    const float den = lr * lr + li * li, nr = are - 1.f, ni = aim;
    const float fre = (nr * lr + ni * li) / den, fim = (ni * lr - nr * li) / den;
    float bbr[16], bbi[16];
#pragma unroll
    for (int h = 0; h < 16; ++h) { const float br = b_re[(g * 64 + p) * 16 + h], bi = b_im[(g * 64 + p) * 16 + h]; bbr[h] = fre * br - fim * bi; bbi[h] = fre * bi + fim * br; }
    for (int i = 0; i < 16; ++i) { cr[i][p] = c_re[(g * 16 + i) * 64 + p]; ci[i][p] = c_im[(g * 16 + i) * 64 + p]; }
    float sr = 0.f, si = 0.f;
    for (int t0 = 0; t0 < S; t0 += 64) {
        __syncthreads();
        for (int e = p; e < 64 * 16; e += 64) us[e >> 4][e & 15] = bf2f(U[(size_t)(b * S + t0 + (e >> 4)) * 512 + g * 16 + (e & 15)]);
        __syncthreads();
        for (int tl = 0; tl < 64; ++tl) {
            float xr = 0.f, xi = 0.f;
#pragma unroll
            for (int h = 0; h < 16; ++h) { const float u = us[tl][h]; xr = fmaf(u, bbr[h], xr); xi = fmaf(u, bbi[h], xi); }
            const float nr2 = are * sr - aim * si + xr, ni2 = are * si + aim * sr + xi; sr = nr2; si = ni2;
            hr[tl][p] = sr; hi[tl][p] = si;
        }
        __syncthreads();
        { const int tl = p; float y[16];
#pragma unroll
          for (int i = 0; i < 16; ++i) y[i] = 0.f;
          for (int pp = 0; pp < 64; ++pp) { const float a = hr[tl][pp], bq = hi[tl][pp];
#pragma unroll
              for (int i = 0; i < 16; ++i) y[i] += a * cr[i][pp] - bq * ci[i][pp]; }
#pragma unroll
          for (int i = 0; i < 16; ++i) { const float v = y[i] + d_skip[g * 16 + i] * us[tl][i]; U[(size_t)(b * S + t0 + tl) * 512 + g * 16 + i] = (bf16)f2bf(gelu_tanh(v)); } }
    }
}
}
namespace pg8 {
#define PG8_LAS __attribute__((address_space(3)))
constexpr int BM = 256, BK = 64, HALF = 128, HTB = HALF * BK * 2  , STAGE_BYTES = 8 * HTB, NXCD = 8, WGM = 8;

__host__ __device__ __forceinline__ int lds_byte(int r, int c) { const int st = (r >> 4) * 2 + (c >> 5), rr = r & 15, cc = c & 31, ob = rr * 64 + cc * 2; return st * 1024 + (ob ^ (((ob >> 9) & 1) << 5)); }
__host__ __device__ __forceinline__ void stage_rc(int b, int& R, int& C) { const int st = b / 1024, sb = b % 1024, swz = sb ^ (((sb >> 9) & 1) << 5); R = (st >> 1) * 16 + swz / 64; C = (st & 1) * 32 + (swz % 64) / 2; }
__host__ __device__ __forceinline__ int perm32(int rho) { const int n = rho >> 4, i = rho & 15; return 8 * (i >> 2) + 4 * n + (i & 3); }

struct Unit { int pm, pn; };

struct StaticOrder {
    int nM, nN, nwg, G, c;
    __host__ __device__ void init(int M, int N, int G_, int c_) { nM = M / BM; nN = N / BM; nwg = nM * nN; G = G_; c = c_; }
    __host__ __device__ bool next(int i, Unit& u) const {
        const long L = (long)i * G + c; if (L >= nwg) return false;
        int wgid = (int)L; { const int q = nwg / NXCD, r = nwg % NXCD, xcd = wgid % NXCD, off = wgid / NXCD; wgid = (xcd < r ? xcd * (q + 1) : r * (q + 1) + (xcd - r) * q) + off; }
        const int nig = WGM * nN, gid = wgid / nig, fm = gid * WGM, gsz = (nM - fm) < WGM ? (nM - fm) : WGM;
        u.pm = fm + ((wgid % nig) % gsz); u.pn = (wgid % nig) / gsz; return true;
    }
};
struct SsmOrder {
    int G, c;
    __host__ __device__ bool next(int i, Unit& u) const { const int L = i * G + c; if (L >= 128) return false; u.pn = L >> 2; u.pm = L & 3; return true; }
};

struct SrcStd {
    static constexpr bool TWO_VAR = false;
    const char* A; const char* Bt; int K;
    __device__ __forceinline__ int nt() const { return K / BK; }
    __device__ __forceinline__ const char* a(const Unit& u, int kt, int h) const { return A + ((size_t)(u.pm * BM + h * HALF) * K + (size_t)kt * BK) * 2; }
    __device__ __forceinline__ const char* b(const Unit& u, int kt, int h) const { return Bt + ((size_t)(u.pn * BM + h * HALF) * K + (size_t)kt * BK) * 2; }
    __device__ __forceinline__ unsigned voffA(int R, int C, int) const { return (unsigned)(R * K + C) * 2u; }
    __device__ __forceinline__ unsigned voffB(int R, int C) const { return (unsigned)(R * K + C) * 2u; }
    __device__ __forceinline__ int avar(int) const { return 0; }
};
struct SrcMerge {
    static constexpr bool TWO_VAR = false;
    const char* A0; const char* A1; const char* A2; const char* Bt;
    __device__ __forceinline__ int nt() const { return 24; }
    __device__ __forceinline__ const char* a(const Unit& u, int kt, int h) const { const int sg = kt >> 3; const char* p = sg == 0 ? A0 : (sg == 1 ? A1 : A2); return p + ((size_t)(u.pm * BM + h * HALF) * 512 + (size_t)(kt & 7) * BK) * 2; }
    __device__ __forceinline__ const char* b(const Unit& u, int kt, int h) const { return Bt + ((size_t)(u.pn * BM + h * HALF) * 1536 + (size_t)kt * BK) * 2; }
    __device__ __forceinline__ unsigned voffA(int R, int C, int) const { return (unsigned)(R * 512 + C) * 2u; }
    __device__ __forceinline__ unsigned voffB(int R, int C) const { return (unsigned)(R * 1536 + C) * 2u; }
    __device__ __forceinline__ int avar(int) const { return 0; }
};
template <bool MAIN> struct SrcSsm {
    static constexpr bool TWO_VAR = MAIN; static constexpr int KTOT = MAIN ? SSM_KM : SSM_KE;
    const char* U; const char* HI; const char* Bt;
    __device__ __forceinline__ int nt() const { return KTOT / BK; }
    __device__ __forceinline__ const char* a(const Unit& u, int kt, int h) const {
        if (!MAIN || kt < 4) return U + ((size_t)((u.pm * BM + h * HALF) * 16 + 4 * kt) * 512 + (size_t)u.pn * 16) * 2;
        return HI + ((size_t)(u.pn * NCH + u.pm * BM + h * HALF) * 128 + (size_t)(kt - 4) * BK) * 2; }
    __device__ __forceinline__ const char* b(const Unit& u, int kt, int h) const { return Bt + ((size_t)(u.pn * 256 + h * HALF) * KTOT + (size_t)kt * BK) * 2; }
    __device__ __forceinline__ unsigned voffA(int R, int C, int var) const { return var ? (unsigned)(R * 128 + C) * 2u : (unsigned)((R * 16 + (C >> 4)) * 512 + (C & 15)) * 2u; }
    __device__ __forceinline__ unsigned voffB(int R, int C) const { return (unsigned)(R * KTOT + C) * 2u; }
    __device__ __forceinline__ int avar(int kt) const { return (MAIN && kt >= 4) ? 1 : 0; }
};

typedef f32x4 Acc[2][2][4][2];
__device__ __forceinline__ unsigned cvt_pk_bf16(float lo, float hi) { return cvtpk_s(lo, hi); }
__device__ __forceinline__ u32x4 pack8(f32x4 v0, f32x4 v1) { u32x4 w; w.x = cvt_pk_bf16(v0[0], v0[1]); w.y = cvt_pk_bf16(v0[2], v0[3]); w.z = cvt_pk_bf16(v1[0], v1[1]); w.w = cvt_pk_bf16(v1[2], v1[3]); return w; }
__device__ __forceinline__ f32x4 sig4(f32x4 v) { f32x4 o; o[0] = sigmoid_fast(v[0]); o[1] = sigmoid_fast(v[1]); o[2] = sigmoid_fast(v[2]); o[3] = sigmoid_fast(v[3]); return o; }
__device__ __forceinline__ f32x4 unpk_lo(u32x4 w) { f32x4 o; o[0] = bf2f(w.x & 0xffffu); o[1] = bf2f(w.x >> 16); o[2] = bf2f(w.y & 0xffffu); o[3] = bf2f(w.y >> 16); return o; }
__device__ __forceinline__ f32x4 unpk_hi(u32x4 w) { f32x4 o; o[0] = bf2f(w.z & 0xffffu); o[1] = bf2f(w.z >> 16); o[2] = bf2f(w.w & 0xffffu); o[3] = bf2f(w.w >> 16); return o; }
__device__ __forceinline__ f32x4 rcp4(f32x4 v) { f32x4 o; o[0] = __builtin_amdgcn_rcpf(v[0]); o[1] = __builtin_amdgcn_rcpf(v[1]); o[2] = __builtin_amdgcn_rcpf(v[2]); o[3] = __builtin_amdgcn_rcpf(v[3]); return o; }

template <int MODE> __device__ __forceinline__ void st_half_bf16(const Acc& acc, int bj, bf16* base, int ldc, float sc) {
#pragma unroll
    for (int ai = 0; ai < 2; ++ai)
#pragma unroll
        for (int m = 0; m < 4; ++m) { f32x4 v0 = acc[ai][bj][m][0], v1 = acc[ai][bj][m][1];
            if (MODE == 0) { v0 = v0 * sc; v1 = v1 * sc; }
            else if (MODE == 1) { v0 = sig4(v0); v1 = sig4(v1); }
            else if (MODE == 2) { v0 = __builtin_elementwise_max(v0, (f32x4){0.f, 0.f, 0.f, 0.f}); v1 = __builtin_elementwise_max(v1, (f32x4){0.f, 0.f, 0.f, 0.f}); v0 = v0 * v0; v1 = v1 * v1; }
            else { v0[0] = gelu_tanh(v0[0]); v0[1] = gelu_tanh(v0[1]); v0[2] = gelu_tanh(v0[2]); v0[3] = gelu_tanh(v0[3]); v1[0] = gelu_tanh(v1[0]); v1[1] = gelu_tanh(v1[1]); v1[2] = gelu_tanh(v1[2]); v1[3] = gelu_tanh(v1[3]); }
            *(u32x4*)(base + (size_t)(ai * HALF + m * 16) * ldc) = pack8(v0, v1); }
}
__device__ __forceinline__ void st_half_vt(const Acc& acc, int bj, bf16* VT, int b, int s0, int cc) {
    bf16* base = VT + ((size_t)(b * 2 + (cc >> 6)) * 64 + (cc & 63)) * S + s0;
#pragma unroll
    for (int ai = 0; ai < 2; ++ai)
#pragma unroll
        for (int m = 0; m < 4; ++m)
#pragma unroll
            for (int n = 0; n < 2; ++n)
#pragma unroll
                for (int e = 0; e < 4; ++e) base[(size_t)(4 * n + e) * S + ai * HALF + m * 16] = (bf16)f2bf(acc[ai][bj][m][n][e]);
}

struct EpiInProj {
    static constexpr bool PERM = true, AFTER_DRAIN = false, HAS_MID = false;
    bf16 *QA, *KA, *VAT, *U, *QM, *KM, *VMT, *GATES; float* KMP;
    __device__ __forceinline__ void operator()(const Acc& acc, const Unit& u, int wr, int wc, int fr, int fq) const {
        const int row = u.pm * BM + wr * 64 + fr, cc = wc * 32 + 8 * fq;
#pragma unroll
        for (int bj = 0; bj < 2; ++bj) {
            const int hc = u.pn * 2 + bj;
            if (hc < 4) st_half_bf16<0>(acc, bj, QA + (size_t)row * 512 + hc * 128 + cc, 512, C2);
            else if (hc == 4) st_half_bf16<0>(acc, bj, KA + (size_t)row * 128 + cc, 128, 1.f);
            else if (hc == 5) st_half_vt(acc, bj, VAT, row / S, row % S, cc);
            else if (hc < 10) st_half_bf16<0>(acc, bj, U + (size_t)row * 512 + (hc - 6) * 128 + cc, 512, 1.f);
            else if (hc < 14) st_half_bf16<0>(acc, bj, QM + (size_t)row * 512 + (hc - 10) * 128 + cc, 512, C2);
            else if (hc == 14) {
                st_half_bf16<0>(acc, bj, KM + (size_t)row * 128 + cc, 128, 1.f);
                f32x4 c0 = {0.f, 0.f, 0.f, 0.f}, c1 = {0.f, 0.f, 0.f, 0.f};
#pragma unroll
                for (int ai = 0; ai < 2; ++ai)
#pragma unroll
                    for (int m = 0; m < 4; ++m) { c0 += acc[ai][bj][m][0]; c1 += acc[ai][bj][m][1]; }
#pragma unroll
                for (int o = 1; o < 16; o <<= 1)
#pragma unroll
                    for (int e = 0; e < 4; ++e) { c0[e] += __shfl_xor(c0[e], o); c1[e] += __shfl_xor(c1[e], o); }
                if (fr == 0) { float* kp = KMP + (size_t)(wr * 64 + u.pm) * 128 + cc; *(f32x4*)kp = c0; *(f32x4*)(kp + 4) = c1; }
            }
            else if (hc == 15) st_half_vt(acc, bj, VMT, row / S, row % S, cc);
            else st_half_bf16<1>(acc, bj, GATES + (size_t)row * 3072 + (hc - 16) * 128 + cc, 3072, 1.f);
        }
    }
};
struct EpiFfn1 {
    static constexpr bool PERM = true, AFTER_DRAIN = false, HAS_MID = false;
    bf16* H1;
    __device__ __forceinline__ void operator()(const Acc& acc, const Unit& u, int wr, int wc, int fr, int fq) const {
        bf16* base = H1 + (size_t)(u.pm * BM + wr * 64 + fr) * DFF + u.pn * BM + wc * 32 + 8 * fq;
        st_half_bf16<2>(acc, 0, base, DFF, 1.f); st_half_bf16<2>(acc, 1, base + HALF, DFF, 1.f);
    }
};
struct EpiGlu {
    static constexpr bool PERM = true, AFTER_DRAIN = false, HAS_MID = false;
    bf16* A1;
    __device__ __forceinline__ void operator()(const Acc& acc, const Unit& u, int wr, int wc, int fr, int fq) const {
        bf16* base = A1 + (size_t)(u.pm * BM + wr * 64 + fr) * 512 + u.pn * 128 + wc * 32 + 8 * fq;
#pragma unroll
        for (int ai = 0; ai < 2; ++ai)
#pragma unroll
            for (int m = 0; m < 4; ++m) *(u32x4*)(base + (size_t)(ai * HALF + m * 16) * 512) = pack8(acc[ai][0][m][0] * sig4(acc[ai][1][m][0]), acc[ai][0][m][1] * sig4(acc[ai][1][m][1]));
    }
};
struct EpiMerge {
    static constexpr bool PERM = true, AFTER_DRAIN = false, HAS_MID = true;
    const bf16* GATES; bf16* MIXED;
    __device__ __forceinline__ void mid(Acc& acc, const Unit& u, int t, int wr, int wc, int fr, int fq) const {
        if (t != 8 && t != 16) return;
        const bf16* g = GATES + (size_t)(u.pm * BM + wr * 64 + fr) * 3072 + (t == 8 ? 0 : 1024) + u.pn * BM + wc * 32 + 8 * fq;
#pragma unroll
        for (int ai = 0; ai < 2; ++ai)
#pragma unroll
            for (int m = 0; m < 4; ++m)
#pragma unroll
                for (int bj = 0; bj < 2; ++bj) { const bf16* gp = g + (size_t)(ai * HALF + m * 16) * 3072 + bj * HALF; const u32x4 num = *(const u32x4*)gp, den = *(const u32x4*)(gp + 1024);
                    acc[ai][bj][m][0] = acc[ai][bj][m][0] * (unpk_lo(num) * rcp4(unpk_lo(den))); acc[ai][bj][m][1] = acc[ai][bj][m][1] * (unpk_hi(num) * rcp4(unpk_hi(den))); }
    }
    __device__ __forceinline__ void operator()(const Acc& acc, const Unit& u, int wr, int wc, int fr, int fq) const {
        const size_t ro = (size_t)(u.pm * BM + wr * 64 + fr); const int co = u.pn * BM + wc * 32 + 8 * fq;
#pragma unroll
        for (int ai = 0; ai < 2; ++ai)
#pragma unroll
            for (int m = 0; m < 4; ++m)
#pragma unroll
                for (int bj = 0; bj < 2; ++bj) { const size_t r = ro + ai * HALF + m * 16; const u32x4 g2 = *(const u32x4*)(GATES + r * 3072 + 2048 + co + bj * HALF);
                    *(u32x4*)(MIXED + r * DM + co + bj * HALF) = pack8(acc[ai][bj][m][0] * unpk_lo(g2), acc[ai][bj][m][1] * unpk_hi(g2)); }
    }
};
struct EpiResid {
    static constexpr bool PERM = false, AFTER_DRAIN = false, HAS_MID = false;
    float* X;
    __device__ __forceinline__ void operator()(const Acc& acc, const Unit& u, int wr, int wc, int fr, int fq) const {
        float* base = X + (size_t)(u.pm * BM + wr * 64 + fr) * DM + u.pn * BM + wc * 32 + 4 * fq;
#pragma unroll
        for (int ai = 0; ai < 2; ++ai)
#pragma unroll
            for (int m = 0; m < 4; ++m)
#pragma unroll
                for (int bj = 0; bj < 2; ++bj)
#pragma unroll
                    for (int n = 0; n < 2; ++n) { f32x4* p = (f32x4*)(base + (size_t)(ai * HALF + m * 16) * DM + bj * HALF + n * 16); *p = *p + acc[ai][bj][m][n]; }
    }
};
struct EpiSsmEnd {
    static constexpr bool PERM = false, AFTER_DRAIN = false, HAS_MID = false;
    float* HEND;
    __device__ __forceinline__ void operator()(const Acc& acc, const Unit& u, int wr, int wc, int fr, int fq) const {
        float* base = HEND + ((size_t)u.pn * NCH + u.pm * BM + wr * 64 + fr) * 128 + wc * 32 + 4 * fq;
#pragma unroll
        for (int ai = 0; ai < 2; ++ai)
#pragma unroll
            for (int m = 0; m < 4; ++m)
#pragma unroll
                for (int n = 0; n < 2; ++n) *(f32x4*)(base + (size_t)(ai * HALF + m * 16) * 128 + n * 16) = acc[ai][0][m][n];
    }
};
struct EpiSsmMain {
    static constexpr bool PERM = true, AFTER_DRAIN = false, HAS_MID = false;
    bf16* YS;
    __device__ __forceinline__ void operator()(const Acc& acc, const Unit& u, int wr, int wc, int fr, int fq) const {
        const int mrow = u.pm * BM + wr * 64 + fr;
#pragma unroll
        for (int bj = 0; bj < 2; ++bj) { const int s = 8 * bj + 2 * wc + (fq >> 1);
            bf16* base = YS + ((size_t)mrow * 16 + s) * 512 + u.pn * 16 + 8 * (fq & 1);
            st_half_bf16<3>(acc, bj, base, 16 * 512, 1.f); }
    }
};

template <class Epi, class Src, class Sched, bool ALIGN_EPI>
__device__ __forceinline__ void gemm_phase(PG8_LAS unsigned char* lds, const Src g, const Sched& S, const Epi& E) {
    int tid_ = threadIdx.x; asm volatile("" : "+v"(tid_));
    const int tid = tid_, wid = __builtin_amdgcn_readfirstlane(tid >> 6), lane = tid & 63, wr = wid >> 2, wc = wid & 3, fr = lane & 15, fq = lane >> 4;
    const int nt = g.nt();
    unsigned voffA[2], voffA2[2], voffB[2];
#pragma unroll
    for (int i = 0; i < 2; ++i) { int R, C; stage_rc(tid * 16 + i * 8192, R, C); const int Rb = Epi::PERM ? ((R & ~31) + perm32(R & 31)) : R;
        voffA[i] = g.voffA(R, C, 0); voffA2[i] = Src::TWO_VAR ? g.voffA(R, C, 1) : 0u; voffB[i] = g.voffB(Rb, C); }
    const unsigned ldsw = (unsigned)wid * 1024u;
    const int aoff = lds_byte(wr * 64 + fr, fq * 8), boff = lds_byte(wc * 32 + fr, fq * 8);
#define PG8_SA(b, h) (((b) * 2 + (h)) * HTB)
#define PG8_SB(b, h) ((4 + (b) * 2 + (h)) * HTB)
#define PG8_STAGE_B(bufoff, gbase) do { _Pragma("unroll") for (int _i = 0; _i < 2; ++_i) \
        __builtin_amdgcn_global_load_lds((const unsigned*)((const char*)(gbase) + voffB[_i]), (PG8_LAS unsigned*)(lds + (bufoff) + ldsw + _i * 8192), 16, 0, 0); } while (0)
#define PG8_STAGE_A(bufoff, gbase, kt) do { const bool _v = Src::TWO_VAR && g.avar(kt); _Pragma("unroll") for (int _i = 0; _i < 2; ++_i) { const unsigned _o = _v ? voffA2[_i] : voffA[_i]; \
        __builtin_amdgcn_global_load_lds((const unsigned*)((const char*)(gbase) + _o), (PG8_LAS unsigned*)(lds + (bufoff) + ldsw + _i * 8192), 16, 0, 0); } } while (0)
#define PG8_LDA(dst, b, h) do { _Pragma("unroll") for (int m = 0; m < 4; ++m) _Pragma("unroll") for (int k = 0; k < 2; ++k) dst[m][k] = *(const PG8_LAS bf16x8*)(lds + PG8_SA(b, h) + aoff + m * 2048 + k * 1024); } while (0)
#define PG8_LDB(dst, b, h) do { _Pragma("unroll") for (int n = 0; n < 2; ++n) _Pragma("unroll") for (int k = 0; k < 2; ++k) dst[n][k] = *(const PG8_LAS bf16x8*)(lds + PG8_SB(b, h) + boff + n * 2048 + k * 1024); } while (0)
#define PG8_MMA(ai, bj, At, Bt) do { __builtin_amdgcn_s_setprio(1); _Pragma("unroll") for (int m = 0; m < 4; ++m) _Pragma("unroll") for (int n = 0; n < 2; ++n) _Pragma("unroll") for (int k = 0; k < 2; ++k) \
        acc[ai][bj][m][n] = __builtin_amdgcn_mfma_f32_16x16x32_bf16(Bt[n][k], At[m][k], acc[ai][bj][m][n], 0, 0, 0); __builtin_amdgcn_s_setprio(0); } while (0)
#define PG8_WAIT_V(n) asm volatile("s_waitcnt vmcnt(" #n ")" ::: "memory")
#define PG8_WAIT_L(n) asm volatile("s_waitcnt lgkmcnt(" #n ")" ::: "memory")
#define PG8_BAR __builtin_amdgcn_s_barrier()
#define PG8_SCHED __builtin_amdgcn_sched_barrier(0)
    Unit cur, nxt; int ui = 0;
    if (!S.next(0, cur)) return;
    Acc acc;
#pragma unroll
    for (int a = 0; a < 2; ++a)
#pragma unroll
        for (int b = 0; b < 2; ++b)
#pragma unroll
            for (int m = 0; m < 4; ++m)
#pragma unroll
                for (int n = 0; n < 2; ++n) acc[a][b][m][n] = (f32x4){0.f, 0.f, 0.f, 0.f};
    bf16x8 At[4][2], B0[2][2], B1[2][2];
    PG8_STAGE_B(PG8_SB(0, 0), g.b(cur, 0, 0)); PG8_STAGE_B(PG8_SB(0, 1), g.b(cur, 0, 1)); PG8_STAGE_A(PG8_SA(0, 0), g.a(cur, 0, 0), 0); PG8_STAGE_A(PG8_SA(0, 1), g.a(cur, 0, 1), 0);
    if (wr == 1) PG8_BAR;
    PG8_WAIT_V(2); PG8_BAR;
    PG8_STAGE_B(PG8_SB(1, 0), g.b(cur, 1, 0)); PG8_STAGE_A(PG8_SA(1, 0), g.a(cur, 1, 0), 1); PG8_STAGE_B(PG8_SB(1, 1), g.b(cur, 1, 1));
    PG8_WAIT_V(6); PG8_BAR;
    for (;;) {
        const bool has_next = S.next(ui + 1, nxt);
        const Unit nu = has_next ? nxt : cur;
        for (int t = 0; t < nt; t += 2) {
            const bool last = (t == nt - 2);
            if constexpr (Epi::HAS_MID) E.mid(acc, cur, t, wr, wc, fr, fq);
            const Unit u2 = last ? nu : cur; const int k2 = last ? 0 : t + 2, k3 = k2 + 1;
            PG8_LDB(B0, 0, 0); PG8_LDB(B1, 0, 1); PG8_SCHED; PG8_LDA(At, 0, 0); PG8_STAGE_A(PG8_SA(1, 1), g.a(cur, t + 1, 1), t + 1);
            PG8_WAIT_V(8); PG8_WAIT_L(0); PG8_BAR; PG8_MMA(0, 0, At, B0); PG8_MMA(0, 1, At, B1); PG8_BAR; PG8_SCHED;
            PG8_LDA(At, 0, 1); PG8_STAGE_B(PG8_SB(0, 0), g.b(u2, k2, 0)); PG8_STAGE_B(PG8_SB(0, 1), g.b(u2, k2, 1)); PG8_STAGE_A(PG8_SA(0, 0), g.a(u2, k2, 0), k2);
            PG8_WAIT_V(8); PG8_WAIT_L(0); PG8_BAR; PG8_MMA(1, 0, At, B0); PG8_MMA(1, 1, At, B1); PG8_BAR; PG8_SCHED;
            PG8_LDB(B0, 1, 0); PG8_LDB(B1, 1, 1); PG8_SCHED; PG8_LDA(At, 1, 0); PG8_STAGE_A(PG8_SA(0, 1), g.a(u2, k2, 1), k2);
            PG8_WAIT_V(8); PG8_WAIT_L(0); PG8_BAR; PG8_MMA(0, 0, At, B0); PG8_MMA(0, 1, At, B1); PG8_BAR; PG8_SCHED;
            PG8_LDA(At, 1, 1); PG8_STAGE_B(PG8_SB(1, 0), g.b(u2, k3, 0)); PG8_STAGE_B(PG8_SB(1, 1), g.b(u2, k3, 1)); PG8_STAGE_A(PG8_SA(1, 0), g.a(u2, k3, 0), k3);
            PG8_WAIT_V(8); PG8_WAIT_L(0); PG8_BAR; PG8_MMA(1, 0, At, B0); PG8_MMA(1, 1, At, B1); PG8_BAR; PG8_SCHED;
        }
        if constexpr (ALIGN_EPI) { if (wr == 0) PG8_BAR; }
        E(acc, cur, wr, wc, fr, fq);
        if (!has_next) break;
#pragma unroll
        for (int a = 0; a < 2; ++a)
#pragma unroll
            for (int b = 0; b < 2; ++b)
#pragma unroll
                for (int m = 0; m < 4; ++m)
#pragma unroll
                    for (int n = 0; n < 2; ++n) acc[a][b][m][n] = (f32x4){0.f, 0.f, 0.f, 0.f};
        cur = nxt; ++ui;
        if constexpr (ALIGN_EPI) { if (wr == 1) PG8_BAR; }
    }
    PG8_WAIT_V(0);
    if constexpr (!ALIGN_EPI) { if (wr == 0) PG8_BAR; }
    PG8_BAR;
#undef PG8_SA
#undef PG8_SB
#undef PG8_STAGE_A
#undef PG8_STAGE_B
#undef PG8_LDA
#undef PG8_LDB
#undef PG8_MMA
#undef PG8_WAIT_V
#undef PG8_WAIT_L
#undef PG8_BAR
#undef PG8_SCHED
}
}
constexpr int NWAVES = 8;
constexpr int RING_OFF = 0, RING_BYTES = 131072;
constexpr int LDSCTL_OFF = RING_BYTES, MISC_OFF = LDSCTL_OFF + 320;
constexpr int LDS_BYTES = 147456;
constexpr int CW_TMO = 0, CW_CODE = 1, CW_BAR = 4096;

#define GAS __attribute__((address_space(1)))
#define LAS __attribute__((address_space(3)))
typedef GAS unsigned gu32;
#define RLX_AGENT __ATOMIC_RELAXED, __HIP_MEMORY_SCOPE_AGENT
#define LDS_WAIT() asm volatile("s_waitcnt lgkmcnt(0)" ::: "memory")
#define VM_WAIT() asm volatile("s_waitcnt vmcnt(0)" ::: "memory")

#define XB_TMO      128
#define XB_XCNT(j)  (256  + 64 * (j))
#define XB_XSUB(j)  (1280 + 64 * (j))
#define XB_XGEN(j)  (2304 + 64 * (j))
#define XB_TOP      3328
#define XB_TOPGEN   3392
#define XCD_BAR_WORDS 3456
#define XB_SPIN_CAP (1u << 20)
__device__ __forceinline__ unsigned xb_ld(unsigned* p)              { return __hip_atomic_load(p, __ATOMIC_RELAXED, __HIP_MEMORY_SCOPE_AGENT); }
__device__ __forceinline__ unsigned xb_add(unsigned* p, unsigned v) { return __hip_atomic_fetch_add(p, v, __ATOMIC_RELAXED, __HIP_MEMORY_SCOPE_AGENT); }
__device__ __forceinline__ unsigned xb_xcc_id() { return (unsigned)__builtin_amdgcn_s_getreg((3 << 11) | 20) & 0xFu; }
#define XB_SPIN(cond, bar) do { unsigned _sp = 0; while (cond) { __builtin_amdgcn_s_sleep(1); \
    if ((++_sp & 255u) == 0u) { if (xb_ld(&(bar)[XB_TMO])) break; if (_sp > XB_SPIN_CAP) { atomicAdd(&(bar)[XB_TMO], 1u); break; } } } } while (0)
struct XcdBarrier { unsigned* bar; unsigned x; volatile LAS unsigned* st; };
__device__ __forceinline__ XcdBarrier xcd_barrier_post(unsigned* bar, volatile LAS unsigned* st) {
    XcdBarrier b; b.bar = bar; b.x = xb_xcc_id(); b.st = st;
    if (threadIdx.x == 0) (void)xb_add(&bar[XB_XCNT(b.x)], 1u);
    return b;
}
__device__ __forceinline__ void xcd_barrier_complete(unsigned* bar, unsigned x, unsigned& nloc, unsigned& nx) {
    const unsigned G = gridDim.x * gridDim.y * gridDim.z;
    unsigned sum, cnt, mine, sp = 0u;
    for (;;) {
        sum = 0u; cnt = 0u; mine = 0u;
#pragma unroll
        for (unsigned j = 0; j < 16; ++j) { const unsigned c = xb_ld(&bar[XB_XCNT(j)]); sum += c; cnt += (c > 0u) ? 1u : 0u; mine = (j == x) ? c : mine; }
        if (sum == G) break;
        __builtin_amdgcn_s_sleep(1);
        if ((++sp & 255u) == 0u) { if (xb_ld(&bar[XB_TMO])) break; if (sp > XB_SPIN_CAP) { atomicAdd(&bar[XB_TMO], 1u); break; } }
    }
    nloc = mine > 0u ? mine : 1u; nx = cnt > 0u ? cnt : 1u;
}
__device__ __forceinline__ void xcd_barrier(const XcdBarrier& b) {
    asm volatile("s_waitcnt vmcnt(0)" ::: "memory");
    __syncthreads();
    if (threadIdx.x == 0) {
        unsigned* bar = b.bar;
        __builtin_amdgcn_s_waitcnt(0);
        unsigned nloc = b.st[0], nx = b.st[1];
        if (nloc == 0u) { xcd_barrier_complete(bar, b.x, nloc, nx); b.st[0] = nloc; b.st[1] = nx; }
        const unsigned old = xb_add(&bar[XB_XSUB(b.x)], 1u);
        const unsigned gen = old / nloc;
        if (old + 1u == (gen + 1u) * nloc) {
            __builtin_amdgcn_fence(__ATOMIC_RELEASE, "agent");
            asm volatile("s_waitcnt vmcnt(0)" ::: "memory");
            const unsigned og = xb_add(&bar[XB_TOP], 1u);
            const unsigned tg = og / nx;
            if (og + 1u == (tg + 1u) * nx) xb_add(&bar[XB_TOPGEN], 1u);
            else XB_SPIN(xb_ld(&bar[XB_TOPGEN]) == tg, bar);
            __builtin_amdgcn_fence(__ATOMIC_ACQUIRE, "agent");
            xb_add(&bar[XB_XGEN(b.x)], 1u);
            asm volatile("s_waitcnt vmcnt(0)" ::: "memory");
        } else {
            XB_SPIN(xb_ld(&bar[XB_XGEN(b.x)]) == gen, bar);
            __builtin_amdgcn_fence(__ATOMIC_ACQUIRE, "agent");
            asm volatile("s_waitcnt vmcnt(0)" ::: "memory");
        }
    }
    __syncthreads();
}

struct Frame {
    LAS unsigned char* lds;
    int tid, lane, wave, vcu, G;
};

__device__ __forceinline__ void conv_item(const float* __restrict__ W, int N, const float* __restrict__ gain, bf16* WT, int Kdst, int k_off, int k0, int n0, int drow0, LAS float* scr, int lane) {
#pragma unroll 8
    for (int i = 0; i < 32; ++i) { const int kk = 2 * i + (lane >> 5); float v = W[(size_t)(k0 + kk) * N + n0 + (lane & 31)]; if (gain) v *= gain[k0 + kk]; scr[kk * 33 + (lane & 31)] = v; }
    LDS_WAIT(); asm volatile("" ::: "memory");
    const int c = lane & 7;
#pragma unroll
    for (int j = 0; j < 4; ++j) { const int n = (lane >> 3) + 8 * j; const LAS float* s = scr + (8 * c) * 33 + n;
        u32x4 o; o.x = pk2(s[0 * 33], s[1 * 33]); o.y = pk2(s[2 * 33], s[3 * 33]); o.z = pk2(s[4 * 33], s[5 * 33]); o.w = pk2(s[6 * 33], s[7 * 33]);
        *(GAS u32x4*)(WT + (size_t)(drow0 + n) * Kdst + k_off + k0 + 8 * c) = o; }
    LDS_WAIT(); asm volatile("" ::: "memory");
}
__device__ __forceinline__ void conv_layer(const Frame& F, const Ptrs& P, int l) {
    LAS float* scr = (LAS float*)(F.lds + RING_OFF + F.wave * 16384);
    const int gw = F.vcu * NWAVES + F.wave, NGW = F.G * NWAVES;
    unsigned char* ws = P.ws;
    constexpr int I_IN = 16 * 160, I_GLU = 8 * 32, I_MRG = 3 * 8 * 32, I_OUT = 16 * 32, I_F1 = 16 * 128, I_F2 = 64 * 32;
    constexpr int NITEMS = I_IN + I_GLU + I_MRG + I_OUT + I_F1 + I_F2;
    for (int it = gw; it < NITEMS; it += NGW) {
        int r = it;
        if (r < I_IN) { const int kb = r / 160, nb = r % 160; conv_item(P.w_in + (size_t)l * DM * DIN, DIN, P.norm_mix + l * DM, (bf16*)(ws + WS_WIN), DM, 0, 64 * kb, 32 * nb, 32 * nb, scr, F.lane); continue; } r -= I_IN;
        if (r < I_GLU) { const int kb = r / 32, nb = r % 32; const int n0 = 32 * nb, v = n0 & 511, drow0 = (v >> 7) * 256 + (n0 >= 512 ? 128 : 0) + (v & 127);
            conv_item(P.w_glu + (size_t)l * 512 * 1024, 1024, nullptr, (bf16*)(ws + WS_WGLU), 512, 0, 64 * kb, n0, drow0, scr, F.lane); continue; } r -= I_GLU;
        if (r < I_MRG) { const int sg = r / 256, q = r % 256, kb = q / 32, nb = q % 32; const float* W = (sg == 0 ? P.w_o_swa : (sg == 1 ? P.w_o_ssm : P.w_o_moba)) + (size_t)l * 512 * DM;
            conv_item(W, DM, nullptr, (bf16*)(ws + WS_WMRG), 1536, 512 * sg, 64 * kb, 32 * nb, 32 * nb, scr, F.lane); continue; } r -= I_MRG;
        if (r < I_OUT) { const int kb = r / 32, nb = r % 32; conv_item(P.w_out + (size_t)l * DM * DM, DM, nullptr, (bf16*)(ws + WS_WOUT), DM, 0, 64 * kb, 32 * nb, 32 * nb, scr, F.lane); continue; } r -= I_OUT;
        if (r < I_F1) { const int kb = r / 128, nb = r % 128; conv_item(P.w_ff1 + (size_t)l * DM * DFF, DFF, P.norm_ffn + l * DM, (bf16*)(ws + WS_WFF1), DM, 0, 64 * kb, 32 * nb, 32 * nb, scr, F.lane); continue; } r -= I_F1;
        { const int kb = r / 32, nb = r % 32; conv_item(P.w_ff2 + (size_t)l * DFF * DM, DM, nullptr, (bf16*)(ws + WS_WFF2), DFF, 0, 64 * kb, 32 * nb, 32 * nb, scr, F.lane); }
    }
}
__device__ __forceinline__ void ssm_mats(const Frame& F, const Ptrs& P, int l) {
    __syncthreads();
    LAS float* L = (LAS float*)(F.lds + RING_OFF);
    LAS float* apr = L;
    LAS float* api = L + 17 * 64;
    LAS float* bbr = L + 34 * 64;
    LAS float* bbi = bbr + 1024;
    LAS float* ccr = bbi + 1024;
    LAS float* cci = ccr + 1024;
    LAS float* ktab = cci + 1024;
    for (int g = F.vcu; g < 32; g += F.G) {
        const int tid = F.tid;
        if (tid < 64) { const int p = tid; const float lr = P.lam_re[l * 2048 + g * 64 + p], li = P.lam_im[l * 2048 + g * 64 + p], dt = expf(P.log_step[l * 32 + g]);
            const float mag = expf(lr * dt), are = mag * cosf(li * dt), aim = mag * sinf(li * dt);
            const float den = lr * lr + li * li, nr = are - 1.f, ni = aim, fre = (nr * lr + ni * li) / den, fim = (ni * lr - nr * li) / den;
            float pr = 1.f, pi = 0.f;
            for (int k = 0; k <= 16; ++k) { apr[k * 64 + p] = pr; api[k * 64 + p] = pi; const float t = pr * are - pi * aim; pi = pr * aim + pi * are; pr = t; }
            for (int h = 0; h < 16; ++h) { const float br = P.b_re[(size_t)l * 32768 + (g * 64 + p) * 16 + h], bi = P.b_im[(size_t)l * 32768 + (g * 64 + p) * 16 + h]; bbr[p * 16 + h] = fre * br - fim * bi; bbi[p * 16 + h] = fre * bi + fim * br; } }
        for (int e = tid; e < 1024; e += 512) { ccr[e] = P.c_re[(size_t)l * 32768 + g * 1024 + e]; cci[e] = P.c_im[(size_t)l * 32768 + g * 1024 + e]; }
        __syncthreads();
        for (int e = tid; e < 4096; e += 512) { const int tau = e >> 8, i = (e >> 4) & 15, j = e & 15; float acc = 0.f;
            for (int p = 0; p < 64; ++p) { const float cr = ccr[i * 64 + p], ci = cci[i * 64 + p], ar = apr[tau * 64 + p], ai = api[tau * 64 + p]; const float er = cr * ar - ci * ai, ei = cr * ai + ci * ar; acc += er * bbr[p * 16 + j] - ei * bbi[p * 16 + j]; }
            if (tau == 0 && i == j) acc += P.d_skip[l * 512 + g * 16 + i];
            ktab[e] = acc; }
        __syncthreads();
        bf16* BM_ = (bf16*)(P.ws + WS_SMAIN) + (size_t)g * 256 * SSM_KM;
        for (int e = tid; e < 256 * SSM_KM / 2; e += 512) {
            const int n = e / (SSM_KM / 2), k = (e % (SSM_KM / 2)) * 2, s = n >> 4, i = n & 15; float v[2];
#pragma unroll
            for (int q = 0; q < 2; ++q) { const int kk = k + q;
                if (kk < 256) { const int sp = kk >> 4, j = kk & 15; v[q] = (sp <= s) ? ktab[(s - sp) * 256 + i * 16 + j] : 0.f; }
                else { const int p = (kk - 256) & 63; const float cr = ccr[i * 64 + p], ci = cci[i * 64 + p], ar = apr[(s + 1) * 64 + p], ai = api[(s + 1) * 64 + p]; v[q] = (kk < 320) ? (cr * ar - ci * ai) : -(cr * ai + ci * ar); } }
            *(GAS unsigned*)(BM_ + (size_t)n * SSM_KM + k) = pk2(v[0], v[1]); }
        bf16* BE_ = (bf16*)(P.ws + WS_SEND) + (size_t)g * 256 * SSM_KE;
        for (int e = tid; e < 256 * SSM_KE / 2; e += 512) {
            const int n = e / (SSM_KE / 2), k = (e % (SSM_KE / 2)) * 2; float v[2];
#pragma unroll
            for (int q = 0; q < 2; ++q) { const int kk = k + q, sp = kk >> 4, j = kk & 15, p = n & 63; const float ar = apr[(15 - sp) * 64 + p], ai = api[(15 - sp) * 64 + p], br = bbr[p * 16 + j], bi = bbi[p * 16 + j];
                v[q] = (n < 64) ? (ar * br - ai * bi) : ((n < 128) ? (ar * bi + ai * br) : 0.f); }
            *(GAS unsigned*)(BE_ + (size_t)n * SSM_KE + k) = pk2(v[0], v[1]); }
        __syncthreads();
    }
}
__device__ __forceinline__ void xn_pass(const Frame& F, const Ptrs& P, bool first) {
    const int gw = F.vcu * NWAVES + F.wave, NGW = F.G * NWAVES;
    bf16* XN = (bf16*)(P.ws + WS_XN);
    for (int m = gw; m < T; m += NGW) {
        const GAS f32x4* xr = (const GAS f32x4*)((first ? P.x_in : P.x) + (size_t)m * DM) + F.lane;
        f32x4 v[4]; float s = 0.f;
#pragma unroll
        for (int j = 0; j < 4; ++j) { v[j] = xr[64 * j]; s += (v[j].x * v[j].x + v[j].y * v[j].y) + (v[j].z * v[j].z + v[j].w * v[j].w); }
        const float r = rsqrtf(wave_sum(s) * (1.f / DM) + NORM_EPS);
        if (first) { GAS f32x4* xo = (GAS f32x4*)(P.x + (size_t)m * DM) + F.lane;
#pragma unroll
            for (int j = 0; j < 4; ++j) xo[64 * j] = v[j]; }
        GAS unsigned long long* o8 = (GAS unsigned long long*)(XN + (size_t)m * DM) + F.lane;
#pragma unroll
        for (int j = 0; j < 4; ++j) o8[64 * j] = (unsigned long long)pk2(v[j].x * r, v[j].y * r) | ((unsigned long long)pk2(v[j].z * r, v[j].w * r) << 32);
    }
}
__device__ __forceinline__ void final_pass(const Frame& F, const Ptrs& P) {
    const int gw = F.vcu * NWAVES + F.wave, NGW = F.G * NWAVES;
    for (int m = gw; m < T; m += NGW) {
        GAS f32x4* xr = (GAS f32x4*)(P.x + (size_t)m * DM) + F.lane;
        f32x4 v[4]; float s = 0.f;
#pragma unroll
        for (int j = 0; j < 4; ++j) { v[j] = xr[64 * j]; s += (v[j].x * v[j].x + v[j].y * v[j].y) + (v[j].z * v[j].z + v[j].w * v[j].w); }
        const float r = rsqrtf(wave_sum(s) * (1.f / DM) + NORM_EPS);
#pragma unroll
        for (int j = 0; j < 4; ++j) { const f32x4 g = ((const GAS f32x4*)P.norm_final)[F.lane + 64 * j]; xr[64 * j] = v[j] * r * g; }
    }
}
__device__ __forceinline__ void ssm_carry(const Frame& F, const Ptrs& P, int l) {
    const int gt = F.vcu * 512 + F.tid;
    if (gt >= 32 * NB * 64) return;
    const int p = gt & 63, b = (gt >> 6) & 3, g = gt >> 8;
    const float lr = P.lam_re[l * 2048 + g * 64 + p], li = P.lam_im[l * 2048 + g * 64 + p], dt = expf(P.log_step[l * 32 + g]);
    const float mag = expf(lr * dt), are = mag * cosf(li * dt), aim = mag * sinf(li * dt);
    float pr = 1.f, pi = 0.f;
    for (int k = 0; k < 16; ++k) { const float t = pr * are - pi * aim; pi = pr * aim + pi * are; pr = t; }
    const float* he = (const float*)(P.ws + WS_HEND) + ((size_t)g * NCH + b * 256) * 128 + p;
    bf16* hi = (bf16*)(P.ws + WS_HINIT) + ((size_t)g * NCH + b * 256) * 128 + p;
    float sr = 0.f, si = 0.f;
    float er[8], ei[8];
#pragma unroll
    for (int q = 0; q < 8; ++q) { er[q] = he[(size_t)q * 128]; ei[q] = he[(size_t)q * 128 + 64]; }
    for (int c0 = 0; c0 < 256; c0 += 8) {
        float nr_[8], ni_[8];
        const int cn = (c0 + 8 < 256) ? c0 + 8 : c0;
#pragma unroll
        for (int q = 0; q < 8; ++q) { nr_[q] = he[(size_t)(cn + q) * 128]; ni_[q] = he[(size_t)(cn + q) * 128 + 64]; }
#pragma unroll
        for (int q = 0; q < 8; ++q) { hi[(size_t)(c0 + q) * 128] = (bf16)f2bf(sr); hi[(size_t)(c0 + q) * 128 + 64] = (bf16)f2bf(si);
            const float tr = pr * sr - pi * si + er[q], ti = pr * si + pi * sr + ei[q]; sr = tr; si = ti; }
#pragma unroll
        for (int q = 0; q < 8; ++q) { er[q] = nr_[q]; ei[q] = ni_[q]; }
    }
}
namespace att {
__device__ __forceinline__ int crow(int r, int hi) { return (r & 3) + 8 * (r >> 2) + 4 * hi; }
struct St { f32x16 o0, o1; float m, l; };
__device__ __forceinline__ unsigned cvtpk(float lo, float hi) { return cvtpk_s(lo, hi); }

__device__ __forceinline__ void loadk(bf16x8 (&kf)[8], const bf16* kp) {
#pragma unroll
    for (int d0 = 0; d0 < 4; ++d0) { kf[2 * d0] = *(const bf16x8*)(kp + d0 * 16); kf[2 * d0 + 1] = *(const bf16x8*)(kp + 32 * 128 + d0 * 16); }
}
template <int MODE>
__device__ __forceinline__ void tile(St& st, const bf16x8 (&qr)[4], const bf16x8 (&kf)[8], const bf16* vtp  , int kq  , float sl2, bool rowok, int klo  , int hi) {
    f32x16 p0 = {}, p1 = {};
#pragma unroll
    for (int d0 = 0; d0 < 4; ++d0) { p0 = __builtin_amdgcn_mfma_f32_32x32x16_bf16(kf[2 * d0], qr[d0], p0, 0, 0, 0); p1 = __builtin_amdgcn_mfma_f32_32x32x16_bf16(kf[2 * d0 + 1], qr[d0], p1, 0, 0, 0); }
    s16x4 vl[2][4], vh[2][4];
#pragma unroll
    for (int dh = 0; dh < 2; ++dh)
#pragma unroll
        for (int s = 0; s < 4; ++s) { vl[dh][s] = *(const s16x4*)(vtp + (size_t)dh * 32 * S + 16 * s); vh[dh][s] = *(const s16x4*)(vtp + (size_t)dh * 32 * S + 16 * s + 8); }
    const float base = sl2 * (float)(kq + 4 * hi);
    float mx = -INFINITY;
#pragma unroll
    for (int r = 0; r < 16; ++r) { const int c = (r & 3) + 8 * (r >> 2); const int k0 = kq + 4 * hi + c, k1 = k0 + 32;
        float a = p0[r] + (base + sl2 * (float)c), b = p1[r] + (base + sl2 * (float)(c + 32));
        if (MODE == 1) { a = (k0 <= 0 && k0 >= klo) ? a : -INFINITY; b = (k1 <= 0 && k1 >= klo) ? b : -INFINITY; }
        else if (MODE == 2) { a = (k0 <= 0) ? a : -INFINITY; b = (k1 <= 0) ? b : -INFINITY; }
        else if (MODE == 3) { a = (rowok && k0 <= 0) ? a : -INFINITY; b = (rowok && k1 <= 0) ? b : -INFINITY; }
        p0[r] = a; p1[r] = b; mx = fmaxf(mx, fmaxf(a, b)); }
    mx = fmaxf(mx, __shfl_xor(mx, 32));
    const float mn = fmaxf(st.m, mx), alpha = __builtin_amdgcn_exp2f(st.m - mn);
    float sum = 0.f;
#pragma unroll
    for (int r = 0; r < 16; ++r) { p0[r] = __builtin_amdgcn_exp2f(p0[r] - mn); p1[r] = __builtin_amdgcn_exp2f(p1[r] - mn); sum += p0[r] + p1[r]; }
    st.m = mn; st.l = st.l * alpha + sum;
#pragma unroll
    for (int r = 0; r < 16; ++r) { st.o0[r] *= alpha; st.o1[r] *= alpha; }
    bf16x8 pf[4];
#pragma unroll
    for (int s = 0; s < 2; ++s) { u32x4 w0, w1;
        w0.x = cvtpk(p0[8 * s + 0], p0[8 * s + 1]); w0.y = cvtpk(p0[8 * s + 2], p0[8 * s + 3]); w0.z = cvtpk(p0[8 * s + 4], p0[8 * s + 5]); w0.w = cvtpk(p0[8 * s + 6], p0[8 * s + 7]);
        w1.x = cvtpk(p1[8 * s + 0], p1[8 * s + 1]); w1.y = cvtpk(p1[8 * s + 2], p1[8 * s + 3]); w1.z = cvtpk(p1[8 * s + 4], p1[8 * s + 5]); w1.w = cvtpk(p1[8 * s + 6], p1[8 * s + 7]);
        pf[s] = __builtin_bit_cast(bf16x8, w0); pf[2 + s] = __builtin_bit_cast(bf16x8, w1); }
#pragma unroll
    for (int s = 0; s < 4; ++s) {
        const bf16x8 v0 = (bf16x8){vl[0][s][0], vl[0][s][1], vl[0][s][2], vl[0][s][3], vh[0][s][0], vh[0][s][1], vh[0][s][2], vh[0][s][3]};
        const bf16x8 v1 = (bf16x8){vl[1][s][0], vl[1][s][1], vl[1][s][2], vl[1][s][3], vh[1][s][0], vh[1][s][1], vh[1][s][2], vh[1][s][3]};
        st.o0 = __builtin_amdgcn_mfma_f32_32x32x16_bf16(v0, pf[s], st.o0, 0, 0, 0);
        st.o1 = __builtin_amdgcn_mfma_f32_32x32x16_bf16(v1, pf[s], st.o1, 0, 0, 0); }
}
__device__ __forceinline__ void finish(const St& st, bf16* op, int hi) {
    const float lt = st.l + __shfl_xor(st.l, 32), rl = __builtin_amdgcn_rcpf(lt);
#pragma unroll
    for (int g = 0; g < 4; ++g) { u32x2 a, b;
        a.x = cvtpk(st.o0[4 * g] * rl, st.o0[4 * g + 1] * rl); a.y = cvtpk(st.o0[4 * g + 2] * rl, st.o0[4 * g + 3] * rl);
        b.x = cvtpk(st.o1[4 * g] * rl, st.o1[4 * g + 1] * rl); b.y = cvtpk(st.o1[4 * g + 2] * rl, st.o1[4 * g + 3] * rl);
        *(u32x2*)(op + 8 * g + 4 * hi) = a; *(u32x2*)(op + 32 + 8 * g + 4 * hi) = b; }
}
__device__ __forceinline__ void loadq(bf16x8 (&qr)[4], const bf16* qp) {
#pragma unroll
    for (int d0 = 0; d0 < 4; ++d0) qr[d0] = *(const bf16x8*)(qp + d0 * 16);
}

__device__ __forceinline__ void swa_phase(const Frame& F, const Ptrs& P, int l) {
    bf16* QA = (bf16*)(P.ws + WS_QA); const bf16* KA = (const bf16*)(P.ws + WS_KA); const bf16* VAT = (const bf16*)(P.ws + WS_VAT);
    const int lane = F.lane, r32 = lane & 31, hi = lane >> 5, w = F.wave;
    for (int un = F.vcu; un < 256; un += F.G) {
        const int bk = un >> 5, nb = un & 31, b = bk >> 1, kvh = bk & 1, h = kvh * 4 + (w >> 1);
        const float sl2 = exp2f(-0.5f * (float)(h + 1)) * LOG2E, sink2 = P.sinks[l * 8 + h] * LOG2E;
        for (int qt = 0; qt < 2; ++qt) {
            const int t0 = nb * 128 + (w & 1) * 64 + qt * 32;
            bf16* qrow = QA + (size_t)(b * S + t0 + r32) * 512 + h * 64;
            bf16x8 qr[4]; loadq(qr, qrow + 8 * hi);
            St st; st.o0 = f32x16{}; st.o1 = f32x16{}; st.m = sink2; st.l = hi ? 0.f : 1.f;
            for (int kt = 0; kt < 3; ++kt) {
                const int key0 = t0 - 128 + 64 * kt;
                if (key0 + 63 < 0) continue;
                bf16x8 kf[8]; loadk(kf, KA + ((long)(b * S + key0 + r32)) * 128 + kvh * 64 + 8 * hi);
                tile<1>(st, qr, kf, VAT + ((long)((b * 2 + kvh) * 64 + r32)) * S + key0 + 4 * hi, key0 - (t0 + r32), sl2, true, ((t0 + r32) < 127 ? -(t0 + r32) : -127), hi);
            }
            finish(st, qrow, hi);
        }
    }
}
__device__ __forceinline__ void moba_phase(const Frame& F, const Ptrs& P) {
    bf16* QM = (bf16*)(P.ws + WS_QM); const bf16* KM = (const bf16*)(P.ws + WS_KM); const bf16* VMT = (const bf16*)(P.ws + WS_VMT); const float* KMP = (const float*)(P.ws + WS_KMP);
    const int lane = F.lane, r32 = lane & 31, hi = lane >> 5, w = F.wave;
    for (int L = F.vcu; L < 512; L += F.G) {
        const int bk = (L & 255) >> 5, pi = L & 31, qc = (L < 256) ? pi : 63 - pi, b = bk >> 1, kvh = bk & 1, h = kvh * 4 + (w >> 1);
        const float sl2 = exp2f(-0.5f * (float)(8 + h + 1)) * LOG2E;
        const int t0 = qc * 64 + (w & 1) * 32, j = t0 >> 8;
        bf16* qrow = QM + (size_t)(b * S + t0 + r32) * 512 + h * 64;
        bf16x8 qr[4]; loadq(qr, qrow + 8 * hi);
        unsigned selmask = (j >= 3) ? 0u : ((1u << j) - 1u);
        if (j > 3) {
            float qf[32];
#pragma unroll
            for (int d0 = 0; d0 < 4; ++d0)
#pragma unroll
                for (int e = 0; e < 8; ++e) qf[d0 * 8 + e] = bf2f((unsigned)(unsigned short)qr[d0][e]);
            float v0 = -INFINITY, v1 = -INFINITY, v2 = -INFINITY; int i0 = 0, i1 = 0, i2 = 0;
#pragma unroll 1
            for (int n = 0; n < j; ++n) { const float* k0 = KMP + (size_t)(b * 16 + n) * 128 + kvh * 64 + 8 * hi; float a = 0.f;
#pragma unroll
                for (int d0 = 0; d0 < 4; ++d0) { const f32x4 x0 = *(const f32x4*)(k0 + d0 * 16) + *(const f32x4*)(k0 + 64 * 128 + d0 * 16), x1 = *(const f32x4*)(k0 + d0 * 16 + 4) + *(const f32x4*)(k0 + 64 * 128 + d0 * 16 + 4);
                    a += qf[d0 * 8 + 0] * x0[0] + qf[d0 * 8 + 1] * x0[1] + qf[d0 * 8 + 2] * x0[2] + qf[d0 * 8 + 3] * x0[3] + qf[d0 * 8 + 4] * x1[0] + qf[d0 * 8 + 5] * x1[1] + qf[d0 * 8 + 6] * x1[2] + qf[d0 * 8 + 7] * x1[3]; }
                const float g = a + __shfl_xor(a, 32);
                if (g > v0) { v2 = v1; i2 = i1; v1 = v0; i1 = i0; v0 = g; i0 = n; } else if (g > v1) { v2 = v1; i2 = i1; v1 = g; i1 = n; } else if (g > v2) { v2 = g; i2 = n; } }
            selmask = (1u << i0) | (1u << i1) | (1u << i2);
        } else if (j == 3) selmask = 7u;
        St st; st.o0 = f32x16{}; st.o1 = f32x16{}; st.m = -INFINITY; st.l = 0.f;
        const bf16* kbase = KM + ((long)(b * S + r32)) * 128 + kvh * 64 + 8 * hi;
        const bf16* vbase = VMT + ((long)((b * 2 + kvh) * 64 + r32)) * S + 4 * hi;
        const int q = t0 + r32;
        const int nti = ((t0 - j * 256) >> 6) + 1;
#pragma unroll 1
        for (int it = 0; it < nti + 4 * j; ++it) {
            int key0; bool ok = true;
            if (it < nti) key0 = j * 256 + 64 * it;
            else { const int n = (it - nti) >> 2; ok = (selmask >> n) & 1u; if (!__any(ok)) continue; key0 = n * 256 + 64 * ((it - nti) & 3); }
            bf16x8 kf[8]; loadk(kf, kbase + (long)key0 * 128);
            tile<3>(st, qr, kf, vbase + key0, key0 - q, sl2, ok, 0, hi);
        }
        finish(st, qrow, hi);
    }
}
}
#ifndef PH_MASK
#define PH_MASK 0xFFF
#endif
#define PH_ON(k) (((PH_MASK) >> (k)) & 1)
constexpr int NPH = 11, PH_FINAL = DEPTH * NPH, PH_TOTAL = PH_FINAL + 1;
struct Args { Ptrs P; int ph_lo, ph_hi, use_bar, sub; };
__global__ void __launch_bounds__(NWAVES * 64, 2) mk_fwd(Args args) {
    extern __shared__ __attribute__((aligned(16))) unsigned char lds[];
    Frame F;
    F.lds = (LAS unsigned char*)lds;
    F.tid = threadIdx.x; F.lane = F.tid & 63; F.wave = __builtin_amdgcn_readfirstlane(F.tid >> 6);
    F.G = gridDim.x; { const int bx = blockIdx.x; F.vcu = (F.G % 8 == 0) ? (bx % 8) * (F.G / 8) + bx / 8 : bx; }
    const Ptrs& P = args.P;
    unsigned char* ws0 = P.ws;
    volatile LAS unsigned* MISC = (volatile LAS unsigned*)(F.lds + MISC_OFF);
    for (int u = F.tid; u < (LDS_BYTES - LDSCTL_OFF) / 4; u += NWAVES * 64) ((LAS unsigned*)(F.lds + LDSCTL_OFF))[u] = 0u;
    __syncthreads();
    XcdBarrier bar; bar.bar = (unsigned*)(ws0 + WS_CTL) + CW_BAR; bar.x = 0; bar.st = nullptr;
    if (args.use_bar) bar = xcd_barrier_post((unsigned*)(ws0 + WS_CTL) + CW_BAR, MISC + 8);
    LAS unsigned char* ring = F.lds + RING_OFF;
    const int bx = (int)blockIdx.x;
    for (int ph = args.ph_lo; ph < args.ph_hi; ++ph) {
        const int l = ph / NPH, k = ph % NPH;
        unsigned char* ws = ws0; asm volatile("" : "+s"(ws));
        F.tid = threadIdx.x; asm volatile("" : "+v"(F.tid)); F.lane = F.tid & 63;
        if (ph == PH_FINAL) { if (PH_ON(11)) final_pass(F, P); }
        else if (k == 0 && PH_ON(0)) { conv_layer(F, P, l); ssm_mats(F, P, l); xn_pass(F, P, l == 0); __syncthreads(); }
        else if (k == 1 && PH_ON(1)) {
            pg8::SrcStd g{(const char*)(ws + WS_XN), (const char*)(ws + WS_WIN), DM}; pg8::StaticOrder So; So.init(T, DIN, F.G, bx);
            pg8::EpiInProj E{(bf16*)(ws + WS_QA), (bf16*)(ws + WS_KA), (bf16*)(ws + WS_VAT), (bf16*)(ws + WS_U), (bf16*)(ws + WS_QM), (bf16*)(ws + WS_KM), (bf16*)(ws + WS_VMT), (bf16*)(ws + WS_GATES), (float*)(ws + WS_KMP)};
            pg8::gemm_phase<pg8::EpiInProj, pg8::SrcStd, pg8::StaticOrder, true>(ring, g, So, E);
        }
        else if (k == 2 && PH_ON(2)) {
            if (args.sub & 1) { pg8::SrcSsm<false> g{(const char*)(ws + WS_U), nullptr, (const char*)(ws + WS_SEND)}; pg8::SsmOrder So{F.G, bx}; pg8::EpiSsmEnd E{(float*)(ws + WS_HEND)};
                pg8::gemm_phase<pg8::EpiSsmEnd, pg8::SrcSsm<false>, pg8::SsmOrder, true>(ring, g, So, E); }
            if (args.sub & 2) att::swa_phase(F, P, l);
        }
        else if (k == 3 && PH_ON(3)) {
#ifndef NO_CARRY
            if (args.sub & 1) ssm_carry(F, P, l);
#endif
#ifndef NO_MOBA
            if (args.sub & 2) att::moba_phase(F, P);
#endif
        }
        else if (k == 4 && PH_ON(4)) {
            pg8::SrcSsm<true> g{(const char*)(ws + WS_U), (const char*)(ws + WS_HINIT), (const char*)(ws + WS_SMAIN)}; pg8::SsmOrder So{F.G, bx}; pg8::EpiSsmMain E{(bf16*)(ws + WS_U)};
            pg8::gemm_phase<pg8::EpiSsmMain, pg8::SrcSsm<true>, pg8::SsmOrder, true>(ring, g, So, E);
        }
        else if (k == 5 && PH_ON(5)) {
            pg8::SrcStd g{(const char*)(ws + WS_U), (const char*)(ws + WS_WGLU), 512}; pg8::StaticOrder So; So.init(T, 1024, F.G, bx); pg8::EpiGlu E{(bf16*)(ws + WS_A1)};
            pg8::gemm_phase<pg8::EpiGlu, pg8::SrcStd, pg8::StaticOrder, true>(ring, g, So, E);
        }
        else if (k == 6 && PH_ON(6)) {
            pg8::SrcMerge g{(const char*)(ws + WS_QA), (const char*)(ws + WS_A1), (const char*)(ws + WS_QM), (const char*)(ws + WS_WMRG)}; pg8::StaticOrder So; So.init(T, DM, F.G, bx);
            pg8::EpiMerge E{(const bf16*)(ws + WS_GATES), (bf16*)(ws + WS_MIXED)};
            pg8::gemm_phase<pg8::EpiMerge, pg8::SrcMerge, pg8::StaticOrder, true>(ring, g, So, E);
        }
        else if ((k == 7 || k == 10) && PH_ON(7)) {
            const bool f2 = (k == 10);
            pg8::SrcStd g{(const char*)(ws + (f2 ? WS_H1 : WS_MIXED)), (const char*)(ws + (f2 ? WS_WFF2 : WS_WOUT)), f2 ? DFF : DM}; pg8::StaticOrder So; So.init(T, DM, F.G, bx); pg8::EpiResid E{P.x};
            pg8::gemm_phase<pg8::EpiResid, pg8::SrcStd, pg8::StaticOrder, true>(ring, g, So, E);
        }
        else if (k == 8 && PH_ON(8)) { xn_pass(F, P, false); }
        else if (k == 9 && PH_ON(9)) {
            pg8::SrcStd g{(const char*)(ws + WS_XN), (const char*)(ws + WS_WFF1), DM}; pg8::StaticOrder So; So.init(T, DFF, F.G, bx); pg8::EpiFfn1 E{(bf16*)(ws + WS_H1)};
            pg8::gemm_phase<pg8::EpiFfn1, pg8::SrcStd, pg8::StaticOrder, true>(ring, g, So, E);
        }
        if (ph + 1 < args.ph_hi) { if (args.use_bar) xcd_barrier(bar); else __syncthreads(); }
    }
}
namespace dbg {
struct EpiCheck { const bf16 *QA, *KA, *VAT, *U, *QM, *KM, *VMT, *GATES; unsigned* mask;
    __device__ __forceinline__ void cmp(float e, bf16 s, int region) const { const float sv = bf2f(s), ev = bf2f(f2bf(e)); if (!(fabsf(sv - ev) <= 0.02f + 0.02f * fabsf(ev))) atomicOr(mask, 1u << region); }
    __device__ __forceinline__ void operator()(int row, int col, float v) const {
        if (col < 512) cmp(v * C2, QA[(size_t)row * 512 + col], 0);
        else if (col < 640) cmp(v, KA[(size_t)row * 128 + col - 512], 1);
        else if (col < 768) { const int c = col - 640, b = row / S, s = row % S; cmp(v, VAT[((size_t)(b * 2 + (c >> 6)) * 64 + (c & 63)) * S + s], 2); }
        else if (col < 1280) cmp(v, U[(size_t)row * 512 + col - 768], 3);
        else if (col < 1792) cmp(v * C2, QM[(size_t)row * 512 + col - 1280], 4);
        else if (col < 1920) cmp(v, KM[(size_t)row * 128 + col - 1792], 5);
        else if (col < 2048) { const int c = col - 1920, b = row / S, s = row % S; cmp(v, VMT[((size_t)(b * 2 + (c >> 6)) * 64 + (c & 63)) * S + s], 6); }
        else { const int gg = (col - 2048) >> 10; const float e = 1.f / (1.f + expf(-v)); const float sv = bf2f(GATES[(size_t)row * 3072 + col - 2048]);
            if (!(fabsf(sv - e) <= 0.02f)) atomicOr(mask, 1u << (1 + gg)); if (!(fabsf(sv - e) <= 0.2f)) atomicOr(mask, 1u << (4 + gg)); }
    } };
__global__ void __launch_bounds__(128) kmean_check_k(const bf16* __restrict__ KM, const float* __restrict__ KMP, unsigned* mask) {
    const int bn = blockIdx.x, c = threadIdx.x; float s = 0.f;
    for (int i = 0; i < 256; ++i) s += bf2f(KM[(size_t)(bn * 256 + i) * 128 + c]);
    const float g = KMP[bn * 128 + c] + KMP[64 * 128 + bn * 128 + c];
    if (!(fabsf(g - s) <= 0.3f + 0.02f * fabsf(s))) atomicOr(mask, 1u);
}
__global__ void __launch_bounds__(256) cmp_k(const bf16* __restrict__ a, const bf16* __restrict__ b, size_t n, unsigned* mask, int region, float atol, float rtol) {
    for (size_t i = (size_t)blockIdx.x * 256 + threadIdx.x; i < n; i += (size_t)gridDim.x * 256) { const float x = bf2f(a[i]), y = bf2f(b[i]); if (!(fabsf(x - y) <= atol + rtol * fabsf(y))) atomicOr(mask, 1u << region); }
}
__global__ void __launch_bounds__(256) cmpf_k(const float* __restrict__ a, const float* __restrict__ b, size_t n, unsigned* mask, int region, float atol, float rtol) {
    for (size_t i = (size_t)blockIdx.x * 256 + threadIdx.x; i < n; i += (size_t)gridDim.x * 256) { const float x = a[i], y = b[i]; if (!(fabsf(x - y) <= atol + rtol * fabsf(y))) atomicOr(mask, 1u << region); }
}
__global__ void __launch_bounds__(256) encode_k(float* x, size_t n, const unsigned* mask) {
    const unsigned m = *mask; if (m == 0u) return; const unsigned mh = m >> 4; const int k = mh ? __ffs(mh) - 1 : -1; const float sc = 1.f + 0.05f * (float)(k + 1);
    if (k >= 0) for (size_t i = (size_t)blockIdx.x * 256 + threadIdx.x; i < n; i += (size_t)gridDim.x * 256) x[i] *= sc;
    if (blockIdx.x == 0 && threadIdx.x == 0 && (m & 15u)) x[12345] += 2.f * (float)(1 + (m & 15u));
}
}
#ifndef MK_INPROJ
#define MK_INPROJ 1
#endif
#ifndef DBG_INPROJ
#define DBG_INPROJ 0
#endif
#ifndef DBG_STAGE
#define DBG_STAGE 0
#endif
#ifndef MK_SWA
#define MK_SWA 0
#endif
#ifndef MK_SSM
#define MK_SSM 0
#endif
#ifndef MK_MOBA
#define MK_MOBA 0
#endif
#ifndef MK_GLU
#define MK_GLU 0
#endif
#ifndef MK_MERGE
#define MK_MERGE 0
#endif
#ifndef MK_WOUT
#define MK_WOUT 0
#endif
#ifndef MK_FFN
#define MK_FFN 0
#endif
extern "C" void kernel_launch(void* const* d_in, const int* in_sizes, int n_in, void* d_out, int out_size, void* d_ws, size_t ws_size, hipStream_t stream) {
    static int grid = 0;
    if (grid == 0) {
        if (n_in != 21 || out_size != T * DM || ws_size < WS_END) { fprintf(stderr, "kernel_launch: unexpected shapes (n_in %d out %d ws %zu)\n", n_in, out_size, ws_size); grid = -1; return; }
        int dev = 0, cus = 0;
        if (hipGetDevice(&dev) != hipSuccess || hipDeviceGetAttribute(&cus, hipDeviceAttributeMultiprocessorCount, dev) != hipSuccess) { grid = -1; return; }
        if (hipFuncSetAttribute((const void*)mk_fwd, hipFuncAttributeMaxDynamicSharedMemorySize, LDS_BYTES) != hipSuccess) { fprintf(stderr, "kernel_launch: hipFuncSetAttribute failed\n"); grid = -1; return; }
        grid = cus;
    }
    if (grid < 0) return;
    (void)hipMemsetAsync((char*)d_ws + WS_CTL, 0, CTL_ZERO_BYTES, stream);
    Args a{};
    const float** pp = (const float**)&a.P; for (int i = 0; i < 21; ++i) pp[i] = (const float*)d_in[i];
    a.P.x = (float*)d_out; a.P.ws = (unsigned char*)d_ws;
    const Ptrs& P = a.P; unsigned char* ws = P.ws;
    bf16 *XN = (bf16*)(ws + WS_XN), *QA = (bf16*)(ws + WS_QA), *KA = (bf16*)(ws + WS_KA), *VAT = (bf16*)(ws + WS_VAT), *U = (bf16*)(ws + WS_U), *QM = (bf16*)(ws + WS_QM), *KM = (bf16*)(ws + WS_KM), *VMT = (bf16*)(ws + WS_VMT),
         *GATES = (bf16*)(ws + WS_GATES), *H1 = (bf16*)(ws + WS_H1), *A1 = (bf16*)(ws + WS_A1), *MIXED = (bf16*)(ws + WS_MIXED);
    float* KMP = (float*)(ws + WS_KMP);
    auto phase = [&](int ph, int sub) { a.ph_lo = ph; a.ph_hi = ph + 1; a.use_bar = 0; a.sub = sub; hipLaunchKernelGGL(mk_fwd, dim3(grid), dim3(NWAVES * 64), LDS_BYTES, stream, a); };
    for (int l = 0; l < DEPTH; ++l) {
        const int p0 = l * NPH;
        phase(p0 + 0, 3);
#if MK_INPROJ
        phase(p0 + 1, 3);
#if DBG_INPROJ
        if (l == 0) {
            unsigned* mask = (unsigned*)(ws + WS_CTL) + 8;
            n2::gemm_k<dbg::EpiCheck><<<dim3(DIN / 64, T / 64), 256, 0, stream>>>(XN, DM, P.w_in + (size_t)l * DM * DIN, DIN, P.norm_mix + l * DM, DM, dbg::EpiCheck{QA, KA, VAT, U, QM, KM, VMT, GATES, mask});
            dbg::kmean_check_k<<<64, 128, 0, stream>>>(KM, KMP, mask);
        }
        n2::gemm_k<n2::EpiInProj><<<dim3(DIN / 64, T / 64), 256, 0, stream>>>(XN, DM, P.w_in + (size_t)l * DM * DIN, DIN, P.norm_mix + l * DM, DM, n2::EpiInProj{QA, KA, VAT, U, QM, KM, VMT, GATES});
        n2::kmean_k<<<64, 128, 0, stream>>>(KM, KMP);
#endif
#else
        n2::gemm_k<n2::EpiInProj><<<dim3(DIN / 64, T / 64), 256, 0, stream>>>(XN, DM, P.w_in + (size_t)l * DM * DIN, DIN, P.norm_mix + l * DM, DM, n2::EpiInProj{QA, KA, VAT, U, QM, KM, VMT, GATES});
        n2::kmean_k<<<64, 128, 0, stream>>>(KM, KMP);
#endif
#if MK_SWA
        phase(p0 + 2, 2);
#else
        n2::swa_k<<<dim3(T, 8), 128, 0, stream>>>(QA, KA, VAT, P.sinks + l * 8);
#endif
#if MK_MOBA
        phase(p0 + 3, 2);
#else
        n2::moba_k<<<dim3(T, 8), 256, 0, stream>>>(QM, KM, VMT, KMP);
#endif
#if MK_SSM
        phase(p0 + 2, 1); phase(p0 + 3, 1); phase(p0 + 4, 3);
#else
        n2::ssm_k<<<dim3(32, NB), 64, 0, stream>>>(U, P.lam_re + l * 2048, P.lam_im + l * 2048, P.log_step + l * 32, P.b_re + (size_t)l * 32768, P.b_im + (size_t)l * 32768, P.c_re + (size_t)l * 32768, P.c_im + (size_t)l * 32768, P.d_skip + l * 512);
#endif
#if MK_GLU
        phase(p0 + 5, 3);
#else
        n2::glu_k<<<dim3(512 / 64, T / 64), 256, 0, stream>>>(U, P.w_glu + (size_t)l * 512 * 1024, A1);
#endif
#if MK_MERGE
        phase(p0 + 6, 3);
#else
        n2::merge_k<<<dim3(DM / 64, T / 64), 256, 0, stream>>>(QA, A1, QM, P.w_o_swa + (size_t)l * 512 * DM, P.w_o_ssm + (size_t)l * 512 * DM, P.w_o_moba + (size_t)l * 512 * DM, GATES, MIXED);
#endif
#if MK_WOUT
        phase(p0 + 7, 3);
#else
        n2::gemm_k<n2::EpiResid><<<dim3(DM / 64, T / 64), 256, 0, stream>>>(MIXED, DM, P.w_out + (size_t)l * DM * DM, DM, nullptr, DM, n2::EpiResid{P.x});
#endif
#if MK_FFN
        phase(p0 + 8, 3); phase(p0 + 9, 3); phase(p0 + 10, 3);
#else
        n2::prep_k<<<T / 4, 256, 0, stream>>>(P.x_in, P.x, XN, 0);
        n2::gemm_k<n2::EpiFfn1><<<dim3(DFF / 64, T / 64), 256, 0, stream>>>(XN, DM, P.w_ff1 + (size_t)l * DM * DFF, DFF, P.norm_ffn + l * DM, DM, n2::EpiFfn1{H1});
        n2::gemm_k<n2::EpiResid><<<dim3(DM / 64, T / 64), 256, 0, stream>>>(H1, DFF, P.w_ff2 + (size_t)l * DFF * DM, DM, nullptr, DFF, n2::EpiResid{P.x});
#endif
    }
    phase(PH_FINAL, 3);
#if DBG_INPROJ || DBG_STAGE
    dbg::encode_k<<<1024, 256, 0, stream>>>(P.x, (size_t)T * DM, (unsigned*)(ws + WS_CTL) + 8);
#endif
}
```

```cpp
#include <hip/hip_runtime.h>
#include <cstdio>
#include <cstdint>

constexpr int NB = 4, S = 4096, T = NB * S, DM = 1024, DEPTH = 4, DIN = 5120, DFF = 4096;
constexpr float LOG2E = 1.4426950408889634f;
constexpr float C2 = 0.125f * LOG2E;
constexpr float NORM_EPS = 1e-6f;
constexpr int SSM_L = 16;
constexpr int SSM_KM = SSM_L * 16 + 128;
constexpr int SSM_KE = SSM_L * 16;
constexpr int NCH = T / SSM_L;

constexpr size_t MiB = 1u << 20;
constexpr size_t WS_CTL = 0, CTL_ZERO_BYTES = 1 * MiB;
constexpr size_t WS_WIN = 1 * MiB, WS_WGLU = 11 * MiB, WS_WMRG = 12 * MiB, WS_WOUT = 15 * MiB, WS_WFF1 = 17 * MiB, WS_WFF2 = 25 * MiB;
constexpr size_t WS_SMAIN = 33 * MiB, WS_SEND = 39 * MiB, WS_KMP = 43 * MiB;
constexpr size_t WS_XN = 44 * MiB;
constexpr size_t WS_QA = 76 * MiB, WS_KA = 92 * MiB, WS_VAT = 96 * MiB, WS_U = 100 * MiB, WS_QM = 116 * MiB, WS_KM = 132 * MiB, WS_VMT = 136 * MiB, WS_GATES = 140 * MiB;
constexpr size_t WS_H1 = 76 * MiB;
constexpr size_t WS_A1 = 236 * MiB, WS_MIXED = 252 * MiB, WS_HEND = 284 * MiB, WS_HINIT = 300 * MiB, WS_END = 308 * MiB;

typedef unsigned short bf16;
typedef short bf16x8 __attribute__((ext_vector_type(8)));
typedef short s16x4 __attribute__((ext_vector_type(4)));
typedef float f32x4 __attribute__((ext_vector_type(4)));
typedef float f32x16 __attribute__((ext_vector_type(16)));
typedef unsigned u32x4 __attribute__((ext_vector_type(4)));
typedef unsigned u32x2 __attribute__((ext_vector_type(2)));

__host__ __device__ __forceinline__ unsigned f2bf(float f) { unsigned u = __builtin_bit_cast(unsigned, f); return (u + 0x7fffu + ((u >> 16) & 1u)) >> 16; }
__host__ __device__ __forceinline__ float bf2f(unsigned b) { return __builtin_bit_cast(float, b << 16); }
typedef float f32x2_t __attribute__((ext_vector_type(2))); typedef __bf16 bf16x2_t __attribute__((ext_vector_type(2)));
__device__ __forceinline__ unsigned cvtpk_s(float lo, float hi) { f32x2_t v = {lo, hi}; bf16x2_t b = __builtin_convertvector(v, bf16x2_t); return __builtin_bit_cast(unsigned, b); }
__device__ __forceinline__ unsigned pk2(float lo, float hi) { return f2bf(lo) | (f2bf(hi) << 16); }
__device__ __forceinline__ float rbf(float f) { return bf2f(f2bf(f)); }
__device__ __forceinline__ float sigmoid_fast(float x) { return __builtin_amdgcn_rcpf(1.f + __builtin_amdgcn_exp2f(-x * LOG2E)); }
__device__ __forceinline__ float gelu_tanh(float x) {
    const float c2 = 2.f * 0.7978845608028654f; const float t = c2 * (x + 0.044715f * x * x * x); return x * sigmoid_fast(t); }
__device__ __forceinline__ float wave_sum(float v) {
#pragma unroll
    for (int o = 1; o < 64; o <<= 1) v += __shfl_xor(v, o);
    return v;
}
__device__ __forceinline__ float wave_max(float v) {
#pragma unroll
    for (int o = 1; o < 64; o <<= 1) v = fmaxf(v, __shfl_xor(v, o));
    return v;
}

struct Ptrs {
    const float *x_in, *norm_mix, *w_in, *sinks, *lam_re, *lam_im, *log_step, *b_re, *b_im, *c_re, *c_im, *d_skip, *w_glu, *w_o_swa, *w_o_ssm, *w_o_moba, *w_out, *norm_ffn, *w_ff1, *w_ff2, *norm_final;
    float* x;
    unsigned char* ws;
};
namespace pg8 {
#define PG8_LAS __attribute__((address_space(3)))
constexpr int BM = 256, BK = 64, HALF = 128, HTB = HALF * BK * 2  , STAGE_BYTES = 8 * HTB, NXCD = 8, WGM = 8;

__host__ __device__ __forceinline__ int lds_byte(int r, int c) { const int st = (r >> 4) * 2 + (c >> 5), rr = r & 15, cc = c & 31, ob = rr * 64 + cc * 2; return st * 1024 + (ob ^ (((ob >> 9) & 1) << 5)); }
__host__ __device__ __forceinline__ void stage_rc(int b, int& R, int& C) { const int st = b / 1024, sb = b % 1024, swz = sb ^ (((sb >> 9) & 1) << 5); R = (st >> 1) * 16 + swz / 64; C = (st & 1) * 32 + (swz % 64) / 2; }
__host__ __device__ __forceinline__ int perm32(int rho) { const int n = rho >> 4, i = rho & 15; return 8 * (i >> 2) + 4 * n + (i & 3); }

struct Unit { int pm, pn; };

struct StaticOrder {
    int nM, nN, nwg, G, c;
    __host__ __device__ void init(int M, int N, int G_, int c_) { nM = M / BM; nN = N / BM; nwg = nM * nN; G = G_; c = c_; }
    __host__ __device__ bool next(int i, Unit& u) const {
        const long L = (long)i * G + c; if (L >= nwg) return false;
        int wgid = (int)L; { const int q = nwg / NXCD, r = nwg % NXCD, xcd = wgid % NXCD, off = wgid / NXCD; wgid = (xcd < r ? xcd * (q + 1) : r * (q + 1) + (xcd - r) * q) + off; }
        const int nig = WGM * nN, gid = wgid / nig, fm = gid * WGM, gsz = (nM - fm) < WGM ? (nM - fm) : WGM;
        u.pm = fm + ((wgid % nig) % gsz); u.pn = (wgid % nig) / gsz; return true;
    }
};
struct SsmOrder {
    int G, c;
    __host__ __device__ bool next(int i, Unit& u) const { const int L = i * G + c; if (L >= 128) return false; u.pn = L >> 2; u.pm = L & 3; return true; }
};

struct SrcStd {
    static constexpr bool TWO_VAR = false;
    const char* A; const char* Bt; int K;
    __device__ __forceinline__ int nt() const { return K / BK; }
    __device__ __forceinline__ const char* a(const Unit& u, int kt, int h) const { return A + ((size_t)(u.pm * BM + h * HALF) * K + (size_t)kt * BK) * 2; }
    __device__ __forceinline__ const char* b(const Unit& u, int kt, int h) const { return Bt + ((size_t)(u.pn * BM + h * HALF) * K + (size_t)kt * BK) * 2; }
    __device__ __forceinline__ unsigned voffA(int R, int C, int) const { return (unsigned)(R * K + C) * 2u; }
    __device__ __forceinline__ unsigned voffB(int R, int C) const { return (unsigned)(R * K + C) * 2u; }
    __device__ __forceinline__ int avar(int) const { return 0; }
};
struct SrcMerge {
    static constexpr bool TWO_VAR = false;
    const char* A0; const char* A1; const char* A2; const char* Bt;
    __device__ __forceinline__ int nt() const { return 24; }
    __device__ __forceinline__ const char* a(const Unit& u, int kt, int h) const { const int sg = kt >> 3; const char* p = sg == 0 ? A0 : (sg == 1 ? A1 : A2); return p + ((size_t)(u.pm * BM + h * HALF) * 512 + (size_t)(kt & 7) * BK) * 2; }
    __device__ __forceinline__ const char* b(const Unit& u, int kt, int h) const { return Bt + ((size_t)(u.pn * BM + h * HALF) * 1536 + (size_t)kt * BK) * 2; }
    __device__ __forceinline__ unsigned voffA(int R, int C, int) const { return (unsigned)(R * 512 + C) * 2u; }
    __device__ __forceinline__ unsigned voffB(int R, int C) const { return (unsigned)(R * 1536 + C) * 2u; }
    __device__ __forceinline__ int avar(int) const { return 0; }
};
template <bool MAIN> struct SrcSsm {
    static constexpr bool TWO_VAR = MAIN; static constexpr int KTOT = MAIN ? SSM_KM : SSM_KE;
    const char* U; const char* HI; const char* Bt;
    __device__ __forceinline__ int nt() const { return KTOT / BK; }
    __device__ __forceinline__ const char* a(const Unit& u, int kt, int h) const {
        if (!MAIN || kt < 4) return U + ((size_t)((u.pm * BM + h * HALF) * 16 + 4 * kt) * 512 + (size_t)u.pn * 16) * 2;
        return HI + ((size_t)(u.pn * NCH + u.pm * BM + h * HALF) * 128 + (size_t)(kt - 4) * BK) * 2; }
    __device__ __forceinline__ const char* b(const Unit& u, int kt, int h) const { return Bt + ((size_t)(u.pn * 256 + h * HALF) * KTOT + (size_t)kt * BK) * 2; }
    __device__ __forceinline__ unsigned voffA(int R, int C, int var) const { return var ? (unsigned)(R * 128 + C) * 2u : (unsigned)((R * 16 + (C >> 4)) * 512 + (C & 15)) * 2u; }
    __device__ __forceinline__ unsigned voffB(int R, int C) const { return (unsigned)(R * KTOT + C) * 2u; }
    __device__ __forceinline__ int avar(int kt) const { return (MAIN && kt >= 4) ? 1 : 0; }
};

typedef f32x4 Acc[2][2][4][2];
__device__ __forceinline__ unsigned cvt_pk_bf16(float lo, float hi) { return cvtpk_s(lo, hi); }
__device__ __forceinline__ u32x4 pack8(f32x4 v0, f32x4 v1) { u32x4 w; w.x = cvt_pk_bf16(v0[0], v0[1]); w.y = cvt_pk_bf16(v0[2], v0[3]); w.z = cvt_pk_bf16(v1[0], v1[1]); w.w = cvt_pk_bf16(v1[2], v1[3]); return w; }
__device__ __forceinline__ f32x4 sig4(f32x4 v) { f32x4 o; o[0] = sigmoid_fast(v[0]); o[1] = sigmoid_fast(v[1]); o[2] = sigmoid_fast(v[2]); o[3] = sigmoid_fast(v[3]); return o; }
__device__ __forceinline__ f32x4 unpk_lo(u32x4 w) { f32x4 o; o[0] = bf2f(w.x & 0xffffu); o[1] = bf2f(w.x >> 16); o[2] = bf2f(w.y & 0xffffu); o[3] = bf2f(w.y >> 16); return o; }
__device__ __forceinline__ f32x4 unpk_hi(u32x4 w) { f32x4 o; o[0] = bf2f(w.z & 0xffffu); o[1] = bf2f(w.z >> 16); o[2] = bf2f(w.w & 0xffffu); o[3] = bf2f(w.w >> 16); return o; }
__device__ __forceinline__ f32x4 rcp4(f32x4 v) { f32x4 o; o[0] = __builtin_amdgcn_rcpf(v[0]); o[1] = __builtin_amdgcn_rcpf(v[1]); o[2] = __builtin_amdgcn_rcpf(v[2]); o[3] = __builtin_amdgcn_rcpf(v[3]); return o; }

template <int MODE> __device__ __forceinline__ void st_half_bf16(const Acc& acc, int bj, bf16* base, int ldc, float sc) {
#pragma unroll
    for (int ai = 0; ai < 2; ++ai)
#pragma unroll
        for (int m = 0; m < 4; ++m) { f32x4 v0 = acc[ai][bj][m][0], v1 = acc[ai][bj][m][1];
            if (MODE == 0) { v0 = v0 * sc; v1 = v1 * sc; }
            else if (MODE == 1) { v0 = sig4(v0); v1 = sig4(v1); }
            else if (MODE == 2) { v0 = __builtin_elementwise_max(v0, (f32x4){0.f, 0.f, 0.f, 0.f}); v1 = __builtin_elementwise_max(v1, (f32x4){0.f, 0.f, 0.f, 0.f}); v0 = v0 * v0; v1 = v1 * v1; }
            else { v0[0] = gelu_tanh(v0[0]); v0[1] = gelu_tanh(v0[1]); v0[2] = gelu_tanh(v0[2]); v0[3] = gelu_tanh(v0[3]); v1[0] = gelu_tanh(v1[0]); v1[1] = gelu_tanh(v1[1]); v1[2] = gelu_tanh(v1[2]); v1[3] = gelu_tanh(v1[3]); }
            *(u32x4*)(base + (size_t)(ai * HALF + m * 16) * ldc) = pack8(v0, v1); }
}
__device__ __forceinline__ void st_half_vt(const Acc& acc, int bj, bf16* VT, int b, int s0, int cc) {
    bf16* base = VT + ((size_t)(b * 2 + (cc >> 6)) * 64 + (cc & 63)) * S + s0;
#pragma unroll
    for (int ai = 0; ai < 2; ++ai)
#pragma unroll
        for (int m = 0; m < 4; ++m)
#pragma unroll
            for (int n = 0; n < 2; ++n)
#pragma unroll
                for (int e = 0; e < 4; ++e) base[(size_t)(4 * n + e) * S + ai * HALF + m * 16] = (bf16)f2bf(acc[ai][bj][m][n][e]);
}

struct EpiInProj {
    static constexpr bool PERM = true, AFTER_DRAIN = false, HAS_MID = false;
    bf16 *QA, *KA, *VAT, *U, *QM, *KM, *VMT, *GATES; float* KMP;
    __device__ __forceinline__ void operator()(const Acc& acc, const Unit& u, int wr, int wc, int fr, int fq) const {
        const int row = u.pm * BM + wr * 64 + fr, cc = wc * 32 + 8 * fq;
#pragma unroll
        for (int bj = 0; bj < 2; ++bj) {
            const int hc = u.pn * 2 + bj;
            if (hc < 4) st_half_bf16<0>(acc, bj, QA + (size_t)row * 512 + hc * 128 + cc, 512, C2);
            else if (hc == 4) st_half_bf16<0>(acc, bj, KA + (size_t)row * 128 + cc, 128, 1.f);
            else if (hc == 5) st_half_vt(acc, bj, VAT, row / S, row % S, cc);
            else if (hc < 10) st_half_bf16<0>(acc, bj, U + (size_t)row * 512 + (hc - 6) * 128 + cc, 512, 1.f);
            else if (hc < 14) st_half_bf16<0>(acc, bj, QM + (size_t)row * 512 + (hc - 10) * 128 + cc, 512, C2);
            else if (hc == 14) {
                st_half_bf16<0>(acc, bj, KM + (size_t)row * 128 + cc, 128, 1.f);
                f32x4 c0 = {0.f, 0.f, 0.f, 0.f}, c1 = {0.f, 0.f, 0.f, 0.f};
#pragma unroll
                for (int ai = 0; ai < 2; ++ai)
#pragma unroll
                    for (int m = 0; m < 4; ++m) { c0 += acc[ai][bj][m][0]; c1 += acc[ai][bj][m][1]; }
#pragma unroll
                for (int o = 1; o < 16; o <<= 1)
#pragma unroll
                    for (int e = 0; e < 4; ++e) { c0[e] += __shfl_xor(c0[e], o); c1[e] += __shfl_xor(c1[e], o); }
                if (fr == 0) { float* kp = KMP + (size_t)(wr * 64 + u.pm) * 128 + cc; *(f32x4*)kp = c0; *(f32x4*)(kp + 4) = c1; }
            }
            else if (hc == 15) st_half_vt(acc, bj, VMT, row / S, row % S, cc);
            else st_half_bf16<1>(acc, bj, GATES + (size_t)row * 3072 + (hc - 16) * 128 + cc, 3072, 1.f);
        }
    }
};
struct EpiFfn1 {
    static constexpr bool PERM = true, AFTER_DRAIN = false, HAS_MID = false;
    bf16* H1;
    __device__ __forceinline__ void operator()(const Acc& acc, const Unit& u, int wr, int wc, int fr, int fq) const {
        bf16* base = H1 + (size_t)(u.pm * BM + wr * 64 + fr) * DFF + u.pn * BM + wc * 32 + 8 * fq;
        st_half_bf16<2>(acc, 0, base, DFF, 1.f); st_half_bf16<2>(acc, 1, base + HALF, DFF, 1.f);
    }
};
struct EpiGlu {
    static constexpr bool PERM = true, AFTER_DRAIN = false, HAS_MID = false;
    bf16* A1;
    __device__ __forceinline__ void operator()(const Acc& acc, const Unit& u, int wr, int wc, int fr, int fq) const {
        bf16* base = A1 + (size_t)(u.pm * BM + wr * 64 + fr) * 512 + u.pn * 128 + wc * 32 + 8 * fq;
#pragma unroll
        for (int ai = 0; ai < 2; ++ai)
#pragma unroll
            for (int m = 0; m < 4; ++m) *(u32x4*)(base + (size_t)(ai * HALF + m * 16) * 512) = pack8(acc[ai][0][m][0] * sig4(acc[ai][1][m][0]), acc[ai][0][m][1] * sig4(acc[ai][1][m][1]));
    }
};
struct EpiMerge {
    static constexpr bool PERM = true, AFTER_DRAIN = false, HAS_MID = true;
    const bf16* GATES; bf16* MIXED;
    __device__ __forceinline__ void mid(Acc& acc, const Unit& u, int t, int wr, int wc, int fr, int fq) const {
        if (t != 8 && t != 16) return;
        const bf16* g = GATES + (size_t)(u.pm * BM + wr * 64 + fr) * 3072 + (t == 8 ? 0 : 1024) + u.pn * BM + wc * 32 + 8 * fq;
#pragma unroll
        for (int ai = 0; ai < 2; ++ai)
#pragma unroll
            for (int m = 0; m < 4; ++m)
#pragma unroll
                for (int bj = 0; bj < 2; ++bj) { const bf16* gp = g + (size_t)(ai * HALF + m * 16) * 3072 + bj * HALF; const u32x4 num = *(const u32x4*)gp, den = *(const u32x4*)(gp + 1024);
                    acc[ai][bj][m][0] = acc[ai][bj][m][0] * (unpk_lo(num) * rcp4(unpk_lo(den))); acc[ai][bj][m][1] = acc[ai][bj][m][1] * (unpk_hi(num) * rcp4(unpk_hi(den))); }
    }
    __device__ __forceinline__ void operator()(const Acc& acc, const Unit& u, int wr, int wc, int fr, int fq) const {
        const size_t ro = (size_t)(u.pm * BM + wr * 64 + fr); const int co = u.pn * BM + wc * 32 + 8 * fq;
#pragma unroll
        for (int ai = 0; ai < 2; ++ai)
#pragma unroll
            for (int m = 0; m < 4; ++m)
#pragma unroll
                for (int bj = 0; bj < 2; ++bj) { const size_t r = ro + ai * HALF + m * 16; const u32x4 g2 = *(const u32x4*)(GATES + r * 3072 + 2048 + co + bj * HALF);
                    *(u32x4*)(MIXED + r * DM + co + bj * HALF) = pack8(acc[ai][bj][m][0] * unpk_lo(g2), acc[ai][bj][m][1] * unpk_hi(g2)); }
    }
};
struct EpiResid {
    static constexpr bool PERM = false, AFTER_DRAIN = false, HAS_MID = false;
    float* X;
    __device__ __forceinline__ void operator()(const Acc& acc, const Unit& u, int wr, int wc, int fr, int fq) const {
        float* base = X + (size_t)(u.pm * BM + wr * 64 + fr) * DM + u.pn * BM + wc * 32 + 4 * fq;
#pragma unroll
        for (int ai = 0; ai < 2; ++ai)
#pragma unroll
            for (int m = 0; m < 4; ++m)
#pragma unroll
                for (int bj = 0; bj < 2; ++bj)
#pragma unroll
                    for (int n = 0; n < 2; ++n) { f32x4* p = (f32x4*)(base + (size_t)(ai * HALF + m * 16) * DM + bj * HALF + n * 16); *p = *p + acc[ai][bj][m][n]; }
    }
};
struct EpiSsmEnd {
    static constexpr bool PERM = false, AFTER_DRAIN = false, HAS_MID = false;
    float* HEND;
    __device__ __forceinline__ void operator()(const Acc& acc, const Unit& u, int wr, int wc, int fr, int fq) const {
        float* base = HEND + ((size_t)u.pn * NCH + u.pm * BM + wr * 64 + fr) * 128 + wc * 32 + 4 * fq;
#pragma unroll
        for (int ai = 0; ai < 2; ++ai)
#pragma unroll
            for (int m = 0; m < 4; ++m)
#pragma unroll
                for (int n = 0; n < 2; ++n) *(f32x4*)(base + (size_t)(ai * HALF + m * 16) * 128 + n * 16) = acc[ai][0][m][n];
    }
};
struct EpiSsmMain {
    static constexpr bool PERM = true, AFTER_DRAIN = false, HAS_MID = false;
    bf16* YS;
    __device__ __forceinline__ void operator()(const Acc& acc, const Unit& u, int wr, int wc, int fr, int fq) const {
        const int mrow = u.pm * BM + wr * 64 + fr;
#pragma unroll
        for (int bj = 0; bj < 2; ++bj) { const int s = 8 * bj + 2 * wc + (fq >> 1);
            bf16* base = YS + ((size_t)mrow * 16 + s) * 512 + u.pn * 16 + 8 * (fq & 1);
            st_half_bf16<3>(acc, bj, base, 16 * 512, 1.f); }
    }
};

template <class Epi, class Src, class Sched, bool ALIGN_EPI>
__device__ __forceinline__ void gemm_phase(PG8_LAS unsigned char* lds, const Src g, const Sched& S, const Epi& E) {
    int tid_ = threadIdx.x; asm volatile("" : "+v"(tid_));
    const int tid = tid_, wid = __builtin_amdgcn_readfirstlane(tid >> 6), lane = tid & 63, wr = wid >> 2, wc = wid & 3, fr = lane & 15, fq = lane >> 4;
    const int nt = g.nt();
    unsigned voffA[2], voffA2[2], voffB[2];
#pragma unroll
    for (int i = 0; i < 2; ++i) { int R, C; stage_rc(tid * 16 + i * 8192, R, C); const int Rb = Epi::PERM ? ((R & ~31) + perm32(R & 31)) : R;
        voffA[i] = g.voffA(R, C, 0); voffA2[i] = Src::TWO_VAR ? g.voffA(R, C, 1) : 0u; voffB[i] = g.voffB(Rb, C); }
    const unsigned ldsw = (unsigned)wid * 1024u;
    const int aoff = lds_byte(wr * 64 + fr, fq * 8), boff = lds_byte(wc * 32 + fr, fq * 8);
#define PG8_SA(b, h) (((b) * 2 + (h)) * HTB)
#define PG8_SB(b, h) ((4 + (b) * 2 + (h)) * HTB)
#define PG8_STAGE_B(bufoff, gbase) do { _Pragma("unroll") for (int _i = 0; _i < 2; ++_i) \
        __builtin_amdgcn_global_load_lds((const unsigned*)((const char*)(gbase) + voffB[_i]), (PG8_LAS unsigned*)(lds + (bufoff) + ldsw + _i * 8192), 16, 0, 0); } while (0)
#define PG8_STAGE_A(bufoff, gbase, kt) do { const bool _v = Src::TWO_VAR && g.avar(kt); _Pragma("unroll") for (int _i = 0; _i < 2; ++_i) { const unsigned _o = _v ? voffA2[_i] : voffA[_i]; \
        __builtin_amdgcn_global_load_lds((const unsigned*)((const char*)(gbase) + _o), (PG8_LAS unsigned*)(lds + (bufoff) + ldsw + _i * 8192), 16, 0, 0); } } while (0)
#define PG8_LDA(dst, b, h) do { _Pragma("unroll") for (int m = 0; m < 4; ++m) _Pragma("unroll") for (int k = 0; k < 2; ++k) dst[m][k] = *(const PG8_LAS bf16x8*)(lds + PG8_SA(b, h) + aoff + m * 2048 + k * 1024); } while (0)
#define PG8_LDB(dst, b, h) do { _Pragma("unroll") for (int n = 0; n < 2; ++n) _Pragma("unroll") for (int k = 0; k < 2; ++k) dst[n][k] = *(const PG8_LAS bf16x8*)(lds + PG8_SB(b, h) + boff + n * 2048 + k * 1024); } while (0)
#define PG8_MMA(ai, bj, At, Bt) do { __builtin_amdgcn_s_setprio(1); _Pragma("unroll") for (int m = 0; m < 4; ++m) _Pragma("unroll") for (int n = 0; n < 2; ++n) _Pragma("unroll") for (int k = 0; k < 2; ++k) \
        acc[ai][bj][m][n] = __builtin_amdgcn_mfma_f32_16x16x32_bf16(Bt[n][k], At[m][k], acc[ai][bj][m][n], 0, 0, 0); __builtin_amdgcn_s_setprio(0); } while (0)
#define PG8_WAIT_V(n) asm volatile("s_waitcnt vmcnt(" #n ")" ::: "memory")
#define PG8_WAIT_L(n) asm volatile("s_waitcnt lgkmcnt(" #n ")" ::: "memory")
#define PG8_BAR __builtin_amdgcn_s_barrier()
#define PG8_SCHED __builtin_amdgcn_sched_barrier(0)
    Unit cur, nxt; int ui = 0;
    if (!S.next(0, cur)) return;
    Acc acc;
#pragma unroll
    for (int a = 0; a < 2; ++a)
#pragma unroll
        for (int b = 0; b < 2; ++b)
#pragma unroll
            for (int m = 0; m < 4; ++m)
#pragma unroll
                for (int n = 0; n < 2; ++n) acc[a][b][m][n] = (f32x4){0.f, 0.f, 0.f, 0.f};
    bf16x8 At[4][2], B0[2][2], B1[2][2];
    PG8_STAGE_B(PG8_SB(0, 0), g.b(cur, 0, 0)); PG8_STAGE_B(PG8_SB(0, 1), g.b(cur, 0, 1)); PG8_STAGE_A(PG8_SA(0, 0), g.a(cur, 0, 0), 0); PG8_STAGE_A(PG8_SA(0, 1), g.a(cur, 0, 1), 0);
    if (wr == 1) PG8_BAR;
    PG8_WAIT_V(2); PG8_BAR;
    PG8_STAGE_B(PG8_SB(1, 0), g.b(cur, 1, 0)); PG8_STAGE_A(PG8_SA(1, 0), g.a(cur, 1, 0), 1); PG8_STAGE_B(PG8_SB(1, 1), g.b(cur, 1, 1));
    PG8_WAIT_V(6); PG8_BAR;
    for (;;) {
        const bool has_next = S.next(ui + 1, nxt);
        const Unit nu = has_next ? nxt : cur;
        for (int t = 0; t < nt; t += 2) {
            const bool last = (t == nt - 2);
            if constexpr (Epi::HAS_MID) E.mid(acc, cur, t, wr, wc, fr, fq);
            const Unit u2 = last ? nu : cur; const int k2 = last ? 0 : t + 2, k3 = k2 + 1;
            PG8_LDB(B0, 0, 0); PG8_LDB(B1, 0, 1); PG8_SCHED; PG8_LDA(At, 0, 0); PG8_STAGE_A(PG8_SA(1, 1), g.a(cur, t + 1, 1), t + 1);
            PG8_WAIT_V(8); PG8_WAIT_L(0); PG8_BAR; PG8_MMA(0, 0, At, B0); PG8_MMA(0, 1, At, B1); PG8_BAR; PG8_SCHED;
            PG8_LDA(At, 0, 1); PG8_STAGE_B(PG8_SB(0, 0), g.b(u2, k2, 0)); PG8_STAGE_B(PG8_SB(0, 1), g.b(u2, k2, 1)); PG8_STAGE_A(PG8_SA(0, 0), g.a(u2, k2, 0), k2);
            PG8_WAIT_V(8); PG8_WAIT_L(0); PG8_BAR; PG8_MMA(1, 0, At, B0); PG8_MMA(1, 1, At, B1); PG8_BAR; PG8_SCHED;
            PG8_LDB(B0, 1, 0); PG8_LDB(B1, 1, 1); PG8_SCHED; PG8_LDA(At, 1, 0); PG8_STAGE_A(PG8_SA(0, 1), g.a(u2, k2, 1), k2);
            PG8_WAIT_V(8); PG8_WAIT_L(0); PG8_BAR; PG8_MMA(0, 0, At, B0); PG8_MMA(0, 1, At, B1); PG8_BAR; PG8_SCHED;
            PG8_LDA(At, 1, 1); PG8_STAGE_B(PG8_SB(1, 0), g.b(u2, k3, 0)); PG8_STAGE_B(PG8_SB(1, 1), g.b(u2, k3, 1)); PG8_STAGE_A(PG8_SA(1, 0), g.a(u2, k3, 0), k3);
            PG8_WAIT_V(8); PG8_WAIT_L(0); PG8_BAR; PG8_MMA(1, 0, At, B0); PG8_MMA(1, 1, At, B1); PG8_BAR; PG8_SCHED;
        }
        if constexpr (ALIGN_EPI) { if (wr == 0) PG8_BAR; }
        E(acc, cur, wr, wc, fr, fq);
        if (!has_next) break;
#pragma unroll
        for (int a = 0; a < 2; ++a)
#pragma unroll
            for (int b = 0; b < 2; ++b)
#pragma unroll
                for (int m = 0; m < 4; ++m)
#pragma unroll
                    for (int n = 0; n < 2; ++n) acc[a][b][m][n] = (f32x4){0.f, 0.f, 0.f, 0.f};
        cur = nxt; ++ui;
        if constexpr (ALIGN_EPI) { if (wr == 1) PG8_BAR; }
    }
    PG8_WAIT_V(0);
    if constexpr (!ALIGN_EPI) { if (wr == 0) PG8_BAR; }
    PG8_BAR;
#undef PG8_SA
#undef PG8_SB
#undef PG8_STAGE_A
#undef PG8_STAGE_B
#undef PG8_LDA
#undef PG8_LDB
#undef PG8_MMA
#undef PG8_WAIT_V
#undef PG8_WAIT_L
#undef PG8_BAR
#undef PG8_SCHED
}
}
constexpr int NWAVES = 8;
constexpr int RING_OFF = 0, RING_BYTES = 131072;
constexpr int LDSCTL_OFF = RING_BYTES, MISC_OFF = LDSCTL_OFF + 320;
constexpr int LDS_BYTES = 147456;
constexpr int CW_TMO = 0, CW_CODE = 1, CW_BAR = 4096;

#define GAS __attribute__((address_space(1)))
#define LAS __attribute__((address_space(3)))
typedef GAS unsigned gu32;
#define RLX_AGENT __ATOMIC_RELAXED, __HIP_MEMORY_SCOPE_AGENT
#define LDS_WAIT() asm volatile("s_waitcnt lgkmcnt(0)" ::: "memory")
#define VM_WAIT() asm volatile("s_waitcnt vmcnt(0)" ::: "memory")

#define XB_TMO      128
#define XB_XCNT(j)  (256  + 64 * (j))
#define XB_XSUB(j)  (1280 + 64 * (j))
#define XB_XGEN(j)  (2304 + 64 * (j))
#define XB_TOP      3328
#define XB_TOPGEN   3392
#define XCD_BAR_WORDS 3456
#define XB_SPIN_CAP (1u << 20)
__device__ __forceinline__ unsigned xb_ld(unsigned* p)              { return __hip_atomic_load(p, __ATOMIC_RELAXED, __HIP_MEMORY_SCOPE_AGENT); }
__device__ __forceinline__ unsigned xb_add(unsigned* p, unsigned v) { return __hip_atomic_fetch_add(p, v, __ATOMIC_RELAXED, __HIP_MEMORY_SCOPE_AGENT); }
__device__ __forceinline__ unsigned xb_xcc_id() { return (unsigned)__builtin_amdgcn_s_getreg((3 << 11) | 20) & 0xFu; }
#define XB_SPIN(cond, bar) do { unsigned _sp = 0; while (cond) { __builtin_amdgcn_s_sleep(1); \
    if ((++_sp & 255u) == 0u) { if (xb_ld(&(bar)[XB_TMO])) break; if (_sp > XB_SPIN_CAP) { atomicAdd(&(bar)[XB_TMO], 1u); break; } } } } while (0)
struct XcdBarrier { unsigned* bar; unsigned x; volatile LAS unsigned* st; };
__device__ __forceinline__ XcdBarrier xcd_barrier_post(unsigned* bar, volatile LAS unsigned* st) {
    XcdBarrier b; b.bar = bar; b.x = xb_xcc_id(); b.st = st;
    if (threadIdx.x == 0) (void)xb_add(&bar[XB_XCNT(b.x)], 1u);
    return b;
}
__device__ __forceinline__ void xcd_barrier_complete(unsigned* bar, unsigned x, unsigned& nloc, unsigned& nx) {
    const unsigned G = gridDim.x * gridDim.y * gridDim.z;
    unsigned sum, cnt, mine, sp = 0u;
    for (;;) {
        sum = 0u; cnt = 0u; mine = 0u;
#pragma unroll
        for (unsigned j = 0; j < 16; ++j) { const unsigned c = xb_ld(&bar[XB_XCNT(j)]); sum += c; cnt += (c > 0u) ? 1u : 0u; mine = (j == x) ? c : mine; }
        if (sum == G) break;
        __builtin_amdgcn_s_sleep(1);
        if ((++sp & 255u) == 0u) { if (xb_ld(&bar[XB_TMO])) break; if (sp > XB_SPIN_CAP) { atomicAdd(&bar[XB_TMO], 1u); break; } }
    }
    nloc = mine > 0u ? mine : 1u; nx = cnt > 0u ? cnt : 1u;
}
__device__ __forceinline__ void xcd_barrier(const XcdBarrier& b) {
    asm volatile("s_waitcnt vmcnt(0)" ::: "memory");
    __syncthreads();
    if (threadIdx.x == 0) {
        unsigned* bar = b.bar;
        __builtin_amdgcn_s_waitcnt(0);
        unsigned nloc = b.st[0], nx = b.st[1];
        if (nloc == 0u) { xcd_barrier_complete(bar, b.x, nloc, nx); b.st[0] = nloc; b.st[1] = nx; }
        const unsigned old = xb_add(&bar[XB_XSUB(b.x)], 1u);
        const unsigned gen = old / nloc;
        if (old + 1u == (gen + 1u) * nloc) {
            __builtin_amdgcn_fence(__ATOMIC_RELEASE, "agent");
            asm volatile("s_waitcnt vmcnt(0)" ::: "memory");
            const unsigned og = xb_add(&bar[XB_TOP], 1u);
            const unsigned tg = og / nx;
            if (og + 1u == (tg + 1u) * nx) xb_add(&bar[XB_TOPGEN], 1u);
            else XB_SPIN(xb_ld(&bar[XB_TOPGEN]) == tg, bar);
            __builtin_amdgcn_fence(__ATOMIC_ACQUIRE, "agent");
            xb_add(&bar[XB_XGEN(b.x)], 1u);
            asm volatile("s_waitcnt vmcnt(0)" ::: "memory");
        } else {
            XB_SPIN(xb_ld(&bar[XB_XGEN(b.x)]) == gen, bar);
            __builtin_amdgcn_fence(__ATOMIC_ACQUIRE, "agent");
            asm volatile("s_waitcnt vmcnt(0)" ::: "memory");
        }
    }
    __syncthreads();
}

struct Frame {
    LAS unsigned char* lds;
    int tid, lane, wave, vcu, G;
};

__device__ __forceinline__ void conv_item(const float* __restrict__ W, int N, const float* __restrict__ gain, bf16* WT, int Kdst, int k_off, int k0, int n0, int drow0, LAS float* scr, int lane) {
#pragma unroll 8
    for (int i = 0; i < 32; ++i) { const int kk = 2 * i + (lane >> 5); float v = W[(size_t)(k0 + kk) * N + n0 + (lane & 31)]; if (gain) v *= gain[k0 + kk]; scr[kk * 33 + (lane & 31)] = v; }
    LDS_WAIT(); asm volatile("" ::: "memory");
    const int c = lane & 7;
#pragma unroll
    for (int j = 0; j < 4; ++j) { const int n = (lane >> 3) + 8 * j; const LAS float* s = scr + (8 * c) * 33 + n;
        u32x4 o; o.x = pk2(s[0 * 33], s[1 * 33]); o.y = pk2(s[2 * 33], s[3 * 33]); o.z = pk2(s[4 * 33], s[5 * 33]); o.w = pk2(s[6 * 33], s[7 * 33]);
        *(GAS u32x4*)(WT + (size_t)(drow0 + n) * Kdst + k_off + k0 + 8 * c) = o; }
    LDS_WAIT(); asm volatile("" ::: "memory");
}
__device__ __forceinline__ void conv_layer(const Frame& F, const Ptrs& P, int l) {
    LAS float* scr = (LAS float*)(F.lds + RING_OFF + F.wave * 16384);
    const int gw = F.vcu * NWAVES + F.wave, NGW = F.G * NWAVES;
    unsigned char* ws = P.ws;
    constexpr int I_IN = 16 * 160, I_GLU = 8 * 32, I_MRG = 3 * 8 * 32, I_OUT = 16 * 32, I_F1 = 16 * 128, I_F2 = 64 * 32;
    constexpr int NITEMS = I_IN + I_GLU + I_MRG + I_OUT + I_F1 + I_F2;
    for (int it = gw; it < NITEMS; it += NGW) {
        int r = it;
        if (r < I_IN) { const int kb = r / 160, nb = r % 160; conv_item(P.w_in + (size_t)l * DM * DIN, DIN, P.norm_mix + l * DM, (bf16*)(ws + WS_WIN), DM, 0, 64 * kb, 32 * nb, 32 * nb, scr, F.lane); continue; } r -= I_IN;
        if (r < I_GLU) { const int kb = r / 32, nb = r % 32; const int n0 = 32 * nb, v = n0 & 511, drow0 = (v >> 7) * 256 + (n0 >= 512 ? 128 : 0) + (v & 127);
            conv_item(P.w_glu + (size_t)l * 512 * 1024, 1024, nullptr, (bf16*)(ws + WS_WGLU), 512, 0, 64 * kb, n0, drow0, scr, F.lane); continue; } r -= I_GLU;
        if (r < I_MRG) { const int sg = r / 256, q = r % 256, kb = q / 32, nb = q % 32; const float* W = (sg == 0 ? P.w_o_swa : (sg == 1 ? P.w_o_ssm : P.w_o_moba)) + (size_t)l * 512 * DM;
            conv_item(W, DM, nullptr, (bf16*)(ws + WS_WMRG), 1536, 512 * sg, 64 * kb, 32 * nb, 32 * nb, scr, F.lane); continue; } r -= I_MRG;
        if (r < I_OUT) { const int kb = r / 32, nb = r % 32; conv_item(P.w_out + (size_t)l * DM * DM, DM, nullptr, (bf16*)(ws + WS_WOUT), DM, 0, 64 * kb, 32 * nb, 32 * nb, scr, F.lane); continue; } r -= I_OUT;
        if (r < I_F1) { const int kb = r / 128, nb = r % 128; conv_item(P.w_ff1 + (size_t)l * DM * DFF, DFF, P.norm_ffn + l * DM, (bf16*)(ws + WS_WFF1), DM, 0, 64 * kb, 32 * nb, 32 * nb, scr, F.lane); continue; } r -= I_F1;
        { const int kb = r / 32, nb = r % 32; conv_item(P.w_ff2 + (size_t)l * DFF * DM, DM, nullptr, (bf16*)(ws + WS_WFF2), DFF, 0, 64 * kb, 32 * nb, 32 * nb, scr, F.lane); }
    }
}
__device__ __forceinline__ void ssm_mats(const Frame& F, const Ptrs& P, int l) {
    __syncthreads();
    LAS float* L = (LAS float*)(F.lds + RING_OFF);
    LAS float* apr = L;
    LAS float* api = L + 17 * 64;
    LAS float* bbr = L + 34 * 64;
    LAS float* bbi = bbr + 1024;
    LAS float* ccr = bbi + 1024;
    LAS float* cci = ccr + 1024;
    LAS float* ktab = cci + 1024;
    for (int g = F.vcu; g < 32; g += F.G) {
        const int tid = F.tid;
        if (tid < 64) { const int p = tid; const float lr = P.lam_re[l * 2048 + g * 64 + p], li = P.lam_im[l * 2048 + g * 64 + p], dt = expf(P.log_step[l * 32 + g]);
            const float mag = expf(lr * dt), are = mag * cosf(li * dt), aim = mag * sinf(li * dt);
            const float den = lr * lr + li * li, nr = are - 1.f, ni = aim, fre = (nr * lr + ni * li) / den, fim = (ni * lr - nr * li) / den;
            float pr = 1.f, pi = 0.f;
            for (int k = 0; k <= 16; ++k) { apr[k * 64 + p] = pr; api[k * 64 + p] = pi; const float t = pr * are - pi * aim; pi = pr * aim + pi * are; pr = t; }
            for (int h = 0; h < 16; ++h) { const float br = P.b_re[(size_t)l * 32768 + (g * 64 + p) * 16 + h], bi = P.b_im[(size_t)l * 32768 + (g * 64 + p) * 16 + h]; bbr[p * 16 + h] = fre * br - fim * bi; bbi[p * 16 + h] = fre * bi + fim * br; } }
        for (int e = tid; e < 1024; e += 512) { ccr[e] = P.c_re[(size_t)l * 32768 + g * 1024 + e]; cci[e] = P.c_im[(size_t)l * 32768 + g * 1024 + e]; }
        __syncthreads();
        for (int e = tid; e < 4096; e += 512) { const int tau = e >> 8, i = (e >> 4) & 15, j = e & 15; float acc = 0.f;
            for (int p = 0; p < 64; ++p) { const float cr = ccr[i * 64 + p], ci = cci[i * 64 + p], ar = apr[tau * 64 + p], ai = api[tau * 64 + p]; const float er = cr * ar - ci * ai, ei = cr * ai + ci * ar; acc += er * bbr[p * 16 + j] - ei * bbi[p * 16 + j]; }
            if (tau == 0 && i == j) acc += P.d_skip[l * 512 + g * 16 + i];
            ktab[e] = acc; }
        __syncthreads();
        bf16* BM_ = (bf16*)(P.ws + WS_SMAIN) + (size_t)g * 256 * SSM_KM;
        for (int e = tid; e < 256 * SSM_KM / 2; e += 512) {
            const int n = e / (SSM_KM / 2), k = (e % (SSM_KM / 2)) * 2, s = n >> 4, i = n & 15; float v[2];
#pragma unroll
            for (int q = 0; q < 2; ++q) { const int kk = k + q;
                if (kk < 256) { const int sp = kk >> 4, j = kk & 15; v[q] = (sp <= s) ? ktab[(s - sp) * 256 + i * 16 + j] : 0.f; }
                else { const int p = (kk - 256) & 63; const float cr = ccr[i * 64 + p], ci = cci[i * 64 + p], ar = apr[(s + 1) * 64 + p], ai = api[(s + 1) * 64 + p]; v[q] = (kk < 320) ? (cr * ar - ci * ai) : -(cr * ai + ci * ar); } }
            *(GAS unsigned*)(BM_ + (size_t)n * SSM_KM + k) = pk2(v[0], v[1]); }
        bf16* BE_ = (bf16*)(P.ws + WS_SEND) + (size_t)g * 256 * SSM_KE;
        for (int e = tid; e < 256 * SSM_KE / 2; e += 512) {
            const int n = e / (SSM_KE / 2), k = (e % (SSM_KE / 2)) * 2; float v[2];
#pragma unroll
            for (int q = 0; q < 2; ++q) { const int kk = k + q, sp = kk >> 4, j = kk & 15, p = n & 63; const float ar = apr[(15 - sp) * 64 + p], ai = api[(15 - sp) * 64 + p], br = bbr[p * 16 + j], bi = bbi[p * 16 + j];
                v[q] = (n < 64) ? (ar * br - ai * bi) : ((n < 128) ? (ar * bi + ai * br) : 0.f); }
            *(GAS unsigned*)(BE_ + (size_t)n * SSM_KE + k) = pk2(v[0], v[1]); }
        __syncthreads();
    }
}
__device__ __forceinline__ void xn_pass(const Frame& F, const Ptrs& P, bool first) {
    const int gw = F.vcu * NWAVES + F.wave, NGW = F.G * NWAVES;
    bf16* XN = (bf16*)(P.ws + WS_XN);
    for (int m = gw; m < T; m += NGW) {
        const GAS f32x4* xr = (const GAS f32x4*)((first ? P.x_in : P.x) + (size_t)m * DM) + F.lane;
        f32x4 v[4]; float s = 0.f;
#pragma unroll
        for (int j = 0; j < 4; ++j) { v[j] = xr[64 * j]; s += (v[j].x * v[j].x + v[j].y * v[j].y) + (v[j].z * v[j].z + v[j].w * v[j].w); }
        const float r = rsqrtf(wave_sum(s) * (1.f / DM) + NORM_EPS);
        if (first) { GAS f32x4* xo = (GAS f32x4*)(P.x + (size_t)m * DM) + F.lane;
#pragma unroll
            for (int j = 0; j < 4; ++j) xo[64 * j] = v[j]; }
        GAS unsigned long long* o8 = (GAS unsigned long long*)(XN + (size_t)m * DM) + F.lane;
#pragma unroll
        for (int j = 0; j < 4; ++j) o8[64 * j] = (unsigned long long)pk2(v[j].x * r, v[j].y * r) | ((unsigned long long)pk2(v[j].z * r, v[j].w * r) << 32);
    }
}
__device__ __forceinline__ void final_pass(const Frame& F, const Ptrs& P) {
    const int gw = F.vcu * NWAVES + F.wave, NGW = F.G * NWAVES;
    for (int m = gw; m < T; m += NGW) {
        GAS f32x4* xr = (GAS f32x4*)(P.x + (size_t)m * DM) + F.lane;
        f32x4 v[4]; float s = 0.f;
#pragma unroll
        for (int j = 0; j < 4; ++j) { v[j] = xr[64 * j]; s += (v[j].x * v[j].x + v[j].y * v[j].y) + (v[j].z * v[j].z + v[j].w * v[j].w); }
        const float r = rsqrtf(wave_sum(s) * (1.f / DM) + NORM_EPS);
#pragma unroll
        for (int j = 0; j < 4; ++j) { const f32x4 g = ((const GAS f32x4*)P.norm_final)[F.lane + 64 * j]; xr[64 * j] = v[j] * r * g; }
    }
}
__device__ __forceinline__ void ssm_carry(const Frame& F, const Ptrs& P, int l) {
    const int gt = F.vcu * 512 + F.tid;
    if (gt >= 32 * NB * 64) return;
    const int p = gt & 63, b = (gt >> 6) & 3, g = gt >> 8;
    const float lr = P.lam_re[l * 2048 + g * 64 + p], li = P.lam_im[l * 2048 + g * 64 + p], dt = expf(P.log_step[l * 32 + g]);
    const float mag = expf(lr * dt), are = mag * cosf(li * dt), aim = mag * sinf(li * dt);
    float pr = 1.f, pi = 0.f;
    for (int k = 0; k < 16; ++k) { const float t = pr * are - pi * aim; pi = pr * aim + pi * are; pr = t; }
    const float* he = (const float*)(P.ws + WS_HEND) + ((size_t)g * NCH + b * 256) * 128 + p;
    bf16* hi = (bf16*)(P.ws + WS_HINIT) + ((size_t)g * NCH + b * 256) * 128 + p;
    float sr = 0.f, si = 0.f;
    float er[8], ei[8];
#pragma unroll
    for (int q = 0; q < 8; ++q) { er[q] = he[(size_t)q * 128]; ei[q] = he[(size_t)q * 128 + 64]; }
    for (int c0 = 0; c0 < 256; c0 += 8) {
        float nr_[8], ni_[8];
        const int cn = (c0 + 8 < 256) ? c0 + 8 : c0;
#pragma unroll
        for (int q = 0; q < 8; ++q) { nr_[q] = he[(size_t)(cn + q) * 128]; ni_[q] = he[(size_t)(cn + q) * 128 + 64]; }
#pragma unroll
        for (int q = 0; q < 8; ++q) { hi[(size_t)(c0 + q) * 128] = (bf16)f2bf(sr); hi[(size_t)(c0 + q) * 128 + 64] = (bf16)f2bf(si);
            const float tr = pr * sr - pi * si + er[q], ti = pr * si + pi * sr + ei[q]; sr = tr; si = ti; }
#pragma unroll
        for (int q = 0; q < 8; ++q) { er[q] = nr_[q]; ei[q] = ni_[q]; }
    }
}
namespace att {
__device__ __forceinline__ int crow(int r, int hi) { return (r & 3) + 8 * (r >> 2) + 4 * hi; }
struct St { f32x16 o0, o1; float m, l; };
__device__ __forceinline__ unsigned cvtpk(float lo, float hi) { return cvtpk_s(lo, hi); }

__device__ __forceinline__ void loadk(bf16x8 (&kf)[8], const bf16* kp) {
#pragma unroll
    for (int d0 = 0; d0 < 4; ++d0) { kf[2 * d0] = *(const bf16x8*)(kp + d0 * 16); kf[2 * d0 + 1] = *(const bf16x8*)(kp + 32 * 128 + d0 * 16); }
}
template <int MODE>
__device__ __forceinline__ void tile(St& st, const bf16x8 (&qr)[4], const bf16x8 (&kf)[8], const bf16* vtp  , int kq  , float sl2, bool rowok, int klo  , int hi) {
    f32x16 p0 = {}, p1 = {};
#pragma unroll
    for (int d0 = 0; d0 < 4; ++d0) { p0 = __builtin_amdgcn_mfma_f32_32x32x16_bf16(kf[2 * d0], qr[d0], p0, 0, 0, 0); p1 = __builtin_amdgcn_mfma_f32_32x32x16_bf16(kf[2 * d0 + 1], qr[d0], p1, 0, 0, 0); }
    s16x4 vl[2][4], vh[2][4];
#pragma unroll
    for (int dh = 0; dh < 2; ++dh)
#pragma unroll
        for (int s = 0; s < 4; ++s) { vl[dh][s] = *(const s16x4*)(vtp + (size_t)dh * 32 * S + 16 * s); vh[dh][s] = *(const s16x4*)(vtp + (size_t)dh * 32 * S + 16 * s + 8); }
    const float base = sl2 * (float)(kq + 4 * hi);
    float mx = -INFINITY;
#pragma unroll
    for (int r = 0; r < 16; ++r) { const int c = (r & 3) + 8 * (r >> 2); const int k0 = kq + 4 * hi + c, k1 = k0 + 32;
        float a = p0[r] + (base + sl2 * (float)c), b = p1[r] + (base + sl2 * (float)(c + 32));
        if (MODE == 1) { a = (k0 <= 0 && k0 >= klo) ? a : -INFINITY; b = (k1 <= 0 && k1 >= klo) ? b : -INFINITY; }
        else if (MODE == 2) { a = (k0 <= 0) ? a : -INFINITY; b = (k1 <= 0) ? b : -INFINITY; }
        else if (MODE == 3) { a = (rowok && k0 <= 0) ? a : -INFINITY; b = (rowok && k1 <= 0) ? b : -INFINITY; }
        p0[r] = a; p1[r] = b; mx = fmaxf(mx, fmaxf(a, b)); }
    mx = fmaxf(mx, __shfl_xor(mx, 32));
    const float mn = fmaxf(st.m, mx), alpha = __builtin_amdgcn_exp2f(st.m - mn);
    float sum = 0.f;
#pragma unroll
    for (int r = 0; r < 16; ++r) { p0[r] = __builtin_amdgcn_exp2f(p0[r] - mn); p1[r] = __builtin_amdgcn_exp2f(p1[r] - mn); sum += p0[r] + p1[r]; }
    st.m = mn; st.l = st.l * alpha + sum;
#pragma unroll
    for (int r = 0; r < 16; ++r) { st.o0[r] *= alpha; st.o1[r] *= alpha; }
    bf16x8 pf[4];
#pragma unroll
    for (int s = 0; s < 2; ++s) { u32x4 w0, w1;
        w0.x = cvtpk(p0[8 * s + 0], p0[8 * s + 1]); w0.y = cvtpk(p0[8 * s + 2], p0[8 * s + 3]); w0.z = cvtpk(p0[8 * s + 4], p0[8 * s + 5]); w0.w = cvtpk(p0[8 * s + 6], p0[8 * s + 7]);
        w1.x = cvtpk(p1[8 * s + 0], p1[8 * s + 1]); w1.y = cvtpk(p1[8 * s + 2], p1[8 * s + 3]); w1.z = cvtpk(p1[8 * s + 4], p1[8 * s + 5]); w1.w = cvtpk(p1[8 * s + 6], p1[8 * s + 7]);
        pf[s] = __builtin_bit_cast(bf16x8, w0); pf[2 + s] = __builtin_bit_cast(bf16x8, w1); }
#pragma unroll
    for (int s = 0; s < 4; ++s) {
        const bf16x8 v0 = (bf16x8){vl[0][s][0], vl[0][s][1], vl[0][s][2], vl[0][s][3], vh[0][s][0], vh[0][s][1], vh[0][s][2], vh[0][s][3]};
        const bf16x8 v1 = (bf16x8){vl[1][s][0], vl[1][s][1], vl[1][s][2], vl[1][s][3], vh[1][s][0], vh[1][s][1], vh[1][s][2], vh[1][s][3]};
        st.o0 = __builtin_amdgcn_mfma_f32_32x32x16_bf16(v0, pf[s], st.o0, 0, 0, 0);
        st.o1 = __builtin_amdgcn_mfma_f32_32x32x16_bf16(v1, pf[s], st.o1, 0, 0, 0); }
}
__device__ __forceinline__ void finish(const St& st, bf16* op, int hi) {
    const float lt = st.l + __shfl_xor(st.l, 32), rl = __builtin_amdgcn_rcpf(lt);
#pragma unroll
    for (int g = 0; g < 4; ++g) { u32x2 a, b;
        a.x = cvtpk(st.o0[4 * g] * rl, st.o0[4 * g + 1] * rl); a.y = cvtpk(st.o0[4 * g + 2] * rl, st.o0[4 * g + 3] * rl);
        b.x = cvtpk(st.o1[4 * g] * rl, st.o1[4 * g + 1] * rl); b.y = cvtpk(st.o1[4 * g + 2] * rl, st.o1[4 * g + 3] * rl);
        *(u32x2*)(op + 8 * g + 4 * hi) = a; *(u32x2*)(op + 32 + 8 * g + 4 * hi) = b; }
}
__device__ __forceinline__ void loadq(bf16x8 (&qr)[4], const bf16* qp) {
#pragma unroll
    for (int d0 = 0; d0 < 4; ++d0) qr[d0] = *(const bf16x8*)(qp + d0 * 16);
}

__device__ __forceinline__ void swa_phase(const Frame& F, const Ptrs& P, int l) {
    bf16* QA = (bf16*)(P.ws + WS_QA); const bf16* KA = (const bf16*)(P.ws + WS_KA); const bf16* VAT = (const bf16*)(P.ws + WS_VAT);
    const int lane = F.lane, r32 = lane & 31, hi = lane >> 5, w = F.wave;
    for (int un = F.vcu; un < 256; un += F.G) {
        const int bk = un >> 5, nb = un & 31, b = bk >> 1, kvh = bk & 1, h = kvh * 4 + (w >> 1);
        const float sl2 = exp2f(-0.5f * (float)(h + 1)) * LOG2E, sink2 = P.sinks[l * 8 + h] * LOG2E;
        for (int qt = 0; qt < 2; ++qt) {
            const int t0 = nb * 128 + (w & 1) * 64 + qt * 32;
            bf16* qrow = QA + (size_t)(b * S + t0 + r32) * 512 + h * 64;
            bf16x8 qr[4]; loadq(qr, qrow + 8 * hi);
            St st; st.o0 = f32x16{}; st.o1 = f32x16{}; st.m = sink2; st.l = hi ? 0.f : 1.f;
            for (int kt = 0; kt < 3; ++kt) {
                const int key0 = t0 - 128 + 64 * kt;
                if (key0 + 63 < 0) continue;
                bf16x8 kf[8]; loadk(kf, KA + ((long)(b * S + key0 + r32)) * 128 + kvh * 64 + 8 * hi);
                tile<1>(st, qr, kf, VAT + ((long)((b * 2 + kvh) * 64 + r32)) * S + key0 + 4 * hi, key0 - (t0 + r32), sl2, true, ((t0 + r32) < 127 ? -(t0 + r32) : -127), hi);
            }
            finish(st, qrow, hi);
        }
    }
}
__device__ __forceinline__ void moba_phase(const Frame& F, const Ptrs& P) {
    bf16* QM = (bf16*)(P.ws + WS_QM); const bf16* KM = (const bf16*)(P.ws + WS_KM); const bf16* VMT = (const bf16*)(P.ws + WS_VMT); const float* KMP = (const float*)(P.ws + WS_KMP);
    const int lane = F.lane, r32 = lane & 31, hi = lane >> 5, w = F.wave;
    for (int L = F.vcu; L < 512; L += F.G) {
        const int bk = (L & 255) >> 5, pi = L & 31, qc = (L < 256) ? pi : 63 - pi, b = bk >> 1, kvh = bk & 1, h = kvh * 4 + (w >> 1);
        const float sl2 = exp2f(-0.5f * (float)(8 + h + 1)) * LOG2E;
        const int t0 = qc * 64 + (w & 1) * 32, j = t0 >> 8;
        bf16* qrow = QM + (size_t)(b * S + t0 + r32) * 512 + h * 64;
        bf16x8 qr[4]; loadq(qr, qrow + 8 * hi);
        unsigned selmask = (j >= 3) ? 0u : ((1u << j) - 1u);
        if (j > 3) {
            float qf[32];
#pragma unroll
            for (int d0 = 0; d0 < 4; ++d0)
#pragma unroll
                for (int e = 0; e < 8; ++e) qf[d0 * 8 + e] = bf2f((unsigned)(unsigned short)qr[d0][e]);
            float v0 = -INFINITY, v1 = -INFINITY, v2 = -INFINITY; int i0 = 0, i1 = 0, i2 = 0;
#pragma unroll 1
            for (int n = 0; n < j; ++n) { const float* k0 = KMP + (size_t)(b * 16 + n) * 128 + kvh * 64 + 8 * hi; float a = 0.f;
#pragma unroll
                for (int d0 = 0; d0 < 4; ++d0) { const f32x4 x0 = *(const f32x4*)(k0 + d0 * 16) + *(const f32x4*)(k0 + 64 * 128 + d0 * 16), x1 = *(const f32x4*)(k0 + d0 * 16 + 4) + *(const f32x4*)(k0 + 64 * 128 + d0 * 16 + 4);
                    a += qf[d0 * 8 + 0] * x0[0] + qf[d0 * 8 + 1] * x0[1] + qf[d0 * 8 + 2] * x0[2] + qf[d0 * 8 + 3] * x0[3] + qf[d0 * 8 + 4] * x1[0] + qf[d0 * 8 + 5] * x1[1] + qf[d0 * 8 + 6] * x1[2] + qf[d0 * 8 + 7] * x1[3]; }
                const float g = a + __shfl_xor(a, 32);
                if (g > v0) { v2 = v1; i2 = i1; v1 = v0; i1 = i0; v0 = g; i0 = n; } else if (g > v1) { v2 = v1; i2 = i1; v1 = g; i1 = n; } else if (g > v2) { v2 = g; i2 = n; } }
            selmask = (1u << i0) | (1u << i1) | (1u << i2);
        } else if (j == 3) selmask = 7u;
        St st; st.o0 = f32x16{}; st.o1 = f32x16{}; st.m = -INFINITY; st.l = 0.f;
        const bf16* kbase = KM + ((long)(b * S + r32)) * 128 + kvh * 64 + 8 * hi;
        const bf16* vbase = VMT + ((long)((b * 2 + kvh) * 64 + r32)) * S + 4 * hi;
        const int q = t0 + r32;
        const int nti = ((t0 - j * 256) >> 6) + 1;
#pragma unroll 1
        for (int it = 0; it < nti + 4 * j; ++it) {
            int key0; bool ok = true;
            if (it < nti) key0 = j * 256 + 64 * it;
            else { const int n = (it - nti) >> 2; ok = (selmask >> n) & 1u; if (!__any(ok)) continue; key0 = n * 256 + 64 * ((it - nti) & 3); }
            bf16x8 kf[8]; loadk(kf, kbase + (long)key0 * 128);
            tile<3>(st, qr, kf, vbase + key0, key0 - q, sl2, ok, 0, hi);
        }
        finish(st, qrow, hi);
    }
}
}
#ifndef PH_MASK
#define PH_MASK 0xFFF
#endif
#define PH_ON(k) (((PH_MASK) >> (k)) & 1)
constexpr int NPH = 11, PH_FINAL = DEPTH * NPH, PH_TOTAL = PH_FINAL + 1;
struct Args { Ptrs P; int ph_lo, ph_hi, use_bar, sub; };
__global__ void __launch_bounds__(NWAVES * 64, 2) mk_fwd(Args args) {
    extern __shared__ __attribute__((aligned(16))) unsigned char lds[];
    Frame F;
    F.lds = (LAS unsigned char*)lds;
    F.tid = threadIdx.x; F.lane = F.tid & 63; F.wave = __builtin_amdgcn_readfirstlane(F.tid >> 6);
    F.G = gridDim.x; { const int bx = blockIdx.x; F.vcu = (F.G % 8 == 0) ? (bx % 8) * (F.G / 8) + bx / 8 : bx; }
    const Ptrs& P = args.P;
    unsigned char* ws0 = P.ws;
    volatile LAS unsigned* MISC = (volatile LAS unsigned*)(F.lds + MISC_OFF);
    for (int u = F.tid; u < (LDS_BYTES - LDSCTL_OFF) / 4; u += NWAVES * 64) ((LAS unsigned*)(F.lds + LDSCTL_OFF))[u] = 0u;
    __syncthreads();
    XcdBarrier bar; bar.bar = (unsigned*)(ws0 + WS_CTL) + CW_BAR; bar.x = 0; bar.st = nullptr;
    if (args.use_bar) bar = xcd_barrier_post((unsigned*)(ws0 + WS_CTL) + CW_BAR, MISC + 8);
    LAS unsigned char* ring = F.lds + RING_OFF;
    const int bx = (int)blockIdx.x;
    for (int ph = args.ph_lo; ph < args.ph_hi; ++ph) {
        const int l = ph / NPH, k = ph % NPH;
        unsigned char* ws = ws0; asm volatile("" : "+s"(ws));
        F.tid = threadIdx.x; asm volatile("" : "+v"(F.tid)); F.lane = F.tid & 63;
        if (ph == PH_FINAL) { if (PH_ON(11)) final_pass(F, P); }
        else if (k == 0 && PH_ON(0)) { conv_layer(F, P, l); ssm_mats(F, P, l); xn_pass(F, P, l == 0); __syncthreads(); }
        else if (k == 1 && PH_ON(1)) {
            pg8::SrcStd g{(const char*)(ws + WS_XN), (const char*)(ws + WS_WIN), DM}; pg8::StaticOrder So; So.init(T, DIN, F.G, bx);
            pg8::EpiInProj E{(bf16*)(ws + WS_QA), (bf16*)(ws + WS_KA), (bf16*)(ws + WS_VAT), (bf16*)(ws + WS_U), (bf16*)(ws + WS_QM), (bf16*)(ws + WS_KM), (bf16*)(ws + WS_VMT), (bf16*)(ws + WS_GATES), (float*)(ws + WS_KMP)};
            pg8::gemm_phase<pg8::EpiInProj, pg8::SrcStd, pg8::StaticOrder, true>(ring, g, So, E);
        }
        else if (k == 2 && PH_ON(2)) {
            if (args.sub & 1) { pg8::SrcSsm<false> g{(const char*)(ws + WS_U), nullptr, (const char*)(ws + WS_SEND)}; pg8::SsmOrder So{F.G, bx}; pg8::EpiSsmEnd E{(float*)(ws + WS_HEND)};
                pg8::gemm_phase<pg8::EpiSsmEnd, pg8::SrcSsm<false>, pg8::SsmOrder, true>(ring, g, So, E); }
            if (args.sub & 2) att::swa_phase(F, P, l);
        }
        else if (k == 3 && PH_ON(3)) {
#ifndef NO_CARRY
            if (args.sub & 1) ssm_carry(F, P, l);
#endif
#ifndef NO_MOBA
            if (args.sub & 2) att::moba_phase(F, P);
#endif
        }
        else if (k == 4 && PH_ON(4)) {
            pg8::SrcSsm<true> g{(const char*)(ws + WS_U), (const char*)(ws + WS_HINIT), (const char*)(ws + WS_SMAIN)}; pg8::SsmOrder So{F.G, bx}; pg8::EpiSsmMain E{(bf16*)(ws + WS_U)};
            pg8::gemm_phase<pg8::EpiSsmMain, pg8::SrcSsm<true>, pg8::SsmOrder, true>(ring, g, So, E);
        }
        else if (k == 5 && PH_ON(5)) {
            pg8::SrcStd g{(const char*)(ws + WS_U), (const char*)(ws + WS_WGLU), 512}; pg8::StaticOrder So; So.init(T, 1024, F.G, bx); pg8::EpiGlu E{(bf16*)(ws + WS_A1)};
            pg8::gemm_phase<pg8::EpiGlu, pg8::SrcStd, pg8::StaticOrder, true>(ring, g, So, E);
        }
        else if (k == 6 && PH_ON(6)) {
            pg8::SrcMerge g{(const char*)(ws + WS_QA), (const char*)(ws + WS_A1), (const char*)(ws + WS_QM), (const char*)(ws + WS_WMRG)}; pg8::StaticOrder So; So.init(T, DM, F.G, bx);
            pg8::EpiMerge E{(const bf16*)(ws + WS_GATES), (bf16*)(ws + WS_MIXED)};
            pg8::gemm_phase<pg8::EpiMerge, pg8::SrcMerge, pg8::StaticOrder, true>(ring, g, So, E);
        }
        else if ((k == 7 || k == 10) && PH_ON(7)) {
            const bool f2 = (k == 10);
            pg8::SrcStd g{(const char*)(ws + (f2 ? WS_H1 : WS_MIXED)), (const char*)(ws + (f2 ? WS_WFF2 : WS_WOUT)), f2 ? DFF : DM}; pg8::StaticOrder So; So.init(T, DM, F.G, bx); pg8::EpiResid E{P.x};
            pg8::gemm_phase<pg8::EpiResid, pg8::SrcStd, pg8::StaticOrder, true>(ring, g, So, E);
        }
        else if (k == 8 && PH_ON(8)) { xn_pass(F, P, false); }
        else if (k == 9 && PH_ON(9)) {
            pg8::SrcStd g{(const char*)(ws + WS_XN), (const char*)(ws + WS_WFF1), DM}; pg8::StaticOrder So; So.init(T, DFF, F.G, bx); pg8::EpiFfn1 E{(bf16*)(ws + WS_H1)};
            pg8::gemm_phase<pg8::EpiFfn1, pg8::SrcStd, pg8::StaticOrder, true>(ring, g, So, E);
        }
        if (ph + 1 < args.ph_hi) { if (args.use_bar) xcd_barrier(bar); else __syncthreads(); }
    }
}
extern "C" void kernel_launch(void* const* d_in, const int* in_sizes, int n_in, void* d_out, int out_size, void* d_ws, size_t ws_size, hipStream_t stream) {
    static int grid = 0;
    if (grid == 0) {
        if (n_in != 21 || out_size != T * DM || ws_size < WS_END) { fprintf(stderr, "kernel_launch: unexpected shapes (n_in %d out %d ws %zu)\n", n_in, out_size, ws_size); grid = -1; return; }
        int dev = 0, cus = 0;
        if (hipGetDevice(&dev) != hipSuccess || hipDeviceGetAttribute(&cus, hipDeviceAttributeMultiprocessorCount, dev) != hipSuccess) { grid = -1; return; }
        if (hipFuncSetAttribute((const void*)mk_fwd, hipFuncAttributeMaxDynamicSharedMemorySize, LDS_BYTES) != hipSuccess) { fprintf(stderr, "kernel_launch: hipFuncSetAttribute failed\n"); grid = -1; return; }
        int per_cu = 0;
        if (hipOccupancyMaxActiveBlocksPerMultiprocessor(&per_cu, (const void*)mk_fwd, NWAVES * 64, LDS_BYTES) != hipSuccess || per_cu < 1) { fprintf(stderr, "kernel_launch: occupancy query reports %d workgroups per CU\n", per_cu); (void)hipGetLastError(); }
        grid = cus;
    }
    if (grid < 0) return;
    (void)hipMemsetAsync((char*)d_ws + WS_CTL, 0, CTL_ZERO_BYTES, stream);
    Args a{};
    const float** pp = (const float**)&a.P; for (int i = 0; i < 21; ++i) pp[i] = (const float*)d_in[i];
    a.P.x = (float*)d_out; a.P.ws = (unsigned char*)d_ws;
    a.ph_lo = 0; a.ph_hi = PH_TOTAL; a.use_bar = 1; a.sub = 3;
    hipLaunchKernelGGL(mk_fwd, dim3(grid), dim3(NWAVES * 64), LDS_BYTES, stream, a);
}
```

```cpp
#include <hip/hip_runtime.h>
#include <cstdio>
#include <cstdint>

constexpr int NB = 4, S = 4096, T = NB * S, DM = 1024, DEPTH = 4, DIN = 5120, DFF = 4096;
constexpr float LOG2E = 1.4426950408889634f;
constexpr float C2 = 0.125f * LOG2E;
constexpr float NORM_EPS = 1e-6f;
constexpr int SSM_L = 16;
constexpr int SSM_KM = SSM_L * 16 + 128;
constexpr int SSM_KE = SSM_L * 16;
constexpr int NCH = T / SSM_L;

constexpr size_t MiB = 1u << 20;
constexpr size_t WS_CTL = 0, CTL_ZERO_BYTES = 1 * MiB;
constexpr size_t WS_WIN = 1 * MiB, WS_WGLU = 11 * MiB, WS_WMRG = 12 * MiB, WS_WOUT = 15 * MiB, WS_WFF1 = 17 * MiB, WS_WFF2 = 25 * MiB;
constexpr size_t WS_SMAIN = 33 * MiB, WS_SEND = 39 * MiB, WS_KMP = 43 * MiB;
constexpr size_t WS_XN = 44 * MiB;
constexpr size_t WS_QA = 76 * MiB, WS_KA = 92 * MiB, WS_VAT = 96 * MiB, WS_U = 100 * MiB, WS_QM = 116 * MiB, WS_KM = 132 * MiB, WS_VMT = 136 * MiB, WS_GATES = 140 * MiB;
constexpr size_t WS_H1 = 76 * MiB;
constexpr size_t WS_LIST = WS_XN, WS_LSE = WS_XN + 8 * MiB;
constexpr size_t WS_PART = 236 * MiB;
constexpr size_t WS_A1 = 236 * MiB, WS_MIXED = 252 * MiB, WS_HEND = 284 * MiB, WS_HINIT = 300 * MiB, WS_END = 308 * MiB;

typedef unsigned short bf16;
typedef short bf16x8 __attribute__((ext_vector_type(8)));
typedef short s16x4 __attribute__((ext_vector_type(4)));
typedef float f32x4 __attribute__((ext_vector_type(4)));
typedef float f32x16 __attribute__((ext_vector_type(16)));
typedef unsigned u32x4 __attribute__((ext_vector_type(4)));
typedef unsigned u32x2 __attribute__((ext_vector_type(2)));

__host__ __device__ __forceinline__ unsigned f2bf(float f) { unsigned u = __builtin_bit_cast(unsigned, f); return (u + 0x7fffu + ((u >> 16) & 1u)) >> 16; }
__host__ __device__ __forceinline__ float bf2f(unsigned b) { return __builtin_bit_cast(float, b << 16); }
typedef float f32x2_t __attribute__((ext_vector_type(2))); typedef __bf16 bf16x2_t __attribute__((ext_vector_type(2)));
__device__ __forceinline__ unsigned cvtpk_s(float lo, float hi) { f32x2_t v = {lo, hi}; bf16x2_t b = __builtin_convertvector(v, bf16x2_t); return __builtin_bit_cast(unsigned, b); }
__device__ __forceinline__ unsigned pk2(float lo, float hi) { return f2bf(lo) | (f2bf(hi) << 16); }
__device__ __forceinline__ float rbf(float f) { return bf2f(f2bf(f)); }
__device__ __forceinline__ float sigmoid_fast(float x) { return __builtin_amdgcn_rcpf(1.f + __builtin_amdgcn_exp2f(-x * LOG2E)); }
__device__ __forceinline__ float gelu_tanh(float x) {
    const float c2 = 2.f * 0.7978845608028654f; const float t = c2 * (x + 0.044715f * x * x * x); return x * sigmoid_fast(t); }
__device__ __forceinline__ float wave_sum(float v) {
#pragma unroll
    for (int o = 1; o < 64; o <<= 1) v += __shfl_xor(v, o);
    return v;
}
__device__ __forceinline__ float wave_max(float v) {
#pragma unroll
    for (int o = 1; o < 64; o <<= 1) v = fmaxf(v, __shfl_xor(v, o));
    return v;
}

struct Ptrs {
    const float *x_in, *norm_mix, *w_in, *sinks, *lam_re, *lam_im, *log_step, *b_re, *b_im, *c_re, *c_im, *d_skip, *w_glu, *w_o_swa, *w_o_ssm, *w_o_moba, *w_out, *norm_ffn, *w_ff1, *w_ff2, *norm_final;
    float* x;
    unsigned char* ws;
};
namespace pg8 {
#define PG8_LAS __attribute__((address_space(3)))
constexpr int BM = 256, BK = 64, HALF = 128, HTB = HALF * BK * 2  , STAGE_BYTES = 8 * HTB, NXCD = 8, WGM = 8;

__host__ __device__ __forceinline__ int lds_byte(int r, int c) { const int st = (r >> 4) * 2 + (c >> 5), rr = r & 15, cc = c & 31, ob = rr * 64 + cc * 2; return st * 1024 + (ob ^ (((ob >> 9) & 1) << 5)); }
__host__ __device__ __forceinline__ void stage_rc(int b, int& R, int& C) { const int st = b / 1024, sb = b % 1024, swz = sb ^ (((sb >> 9) & 1) << 5); R = (st >> 1) * 16 + swz / 64; C = (st & 1) * 32 + (swz % 64) / 2; }
__host__ __device__ __forceinline__ int perm32(int rho) { const int n = rho >> 4, i = rho & 15; return 8 * (i >> 2) + 4 * n + (i & 3); }

struct Unit { int pm, pn; };

struct StaticOrder {
    int nM, nN, nwg, G, c;
    __host__ __device__ void init(int M, int N, int G_, int c_) { nM = M / BM; nN = N / BM; nwg = nM * nN; G = G_; c = c_; }
    __host__ __device__ bool next(int i, Unit& u) const {
        const long L = (long)i * G + c; if (L >= nwg) return false;
        int wgid = (int)L; { const int q = nwg / NXCD, r = nwg % NXCD, xcd = wgid % NXCD, off = wgid / NXCD; wgid = (xcd < r ? xcd * (q + 1) : r * (q + 1) + (xcd - r) * q) + off; }
        const int nig = WGM * nN, gid = wgid / nig, fm = gid * WGM, gsz = (nM - fm) < WGM ? (nM - fm) : WGM;
        u.pm = fm + ((wgid % nig) % gsz); u.pn = (wgid % nig) / gsz; return true;
    }
};
struct SsmOrder {
    int G, c;
    __host__ __device__ bool next(int i, Unit& u) const { const int L = i * G + c; if (L >= 128) return false; u.pn = L >> 2; u.pm = L & 3; return true; }
};

struct SrcStd {
    static constexpr bool TWO_VAR = false;
    const char* A; const char* Bt; int K;
    __device__ __forceinline__ int nt() const { return K / BK; }
    __device__ __forceinline__ const char* a(const Unit& u, int kt, int h) const { return A + ((size_t)(u.pm * BM + h * HALF) * K + (size_t)kt * BK) * 2; }
    __device__ __forceinline__ const char* b(const Unit& u, int kt, int h) const { return Bt + ((size_t)(u.pn * BM + h * HALF) * K + (size_t)kt * BK) * 2; }
    __device__ __forceinline__ unsigned voffA(int R, int C, int) const { return (unsigned)(R * K + C) * 2u; }
    __device__ __forceinline__ unsigned voffB(int R, int C) const { return (unsigned)(R * K + C) * 2u; }
    __device__ __forceinline__ int avar(int) const { return 0; }
};
struct SrcMerge {
    static constexpr bool TWO_VAR = false;
    const char* A0; const char* A1; const char* A2; const char* Bt;
    __device__ __forceinline__ int nt() const { return 24; }
    __device__ __forceinline__ const char* a(const Unit& u, int kt, int h) const { const int sg = kt >> 3; const char* p = sg == 0 ? A0 : (sg == 1 ? A1 : A2); return p + ((size_t)(u.pm * BM + h * HALF) * 512 + (size_t)(kt & 7) * BK) * 2; }
    __device__ __forceinline__ const char* b(const Unit& u, int kt, int h) const { return Bt + ((size_t)(u.pn * BM + h * HALF) * 1536 + (size_t)kt * BK) * 2; }
    __device__ __forceinline__ unsigned voffA(int R, int C, int) const { return (unsigned)(R * 512 + C) * 2u; }
    __device__ __forceinline__ unsigned voffB(int R, int C) const { return (unsigned)(R * 1536 + C) * 2u; }
    __device__ __forceinline__ int avar(int) const { return 0; }
};
template <bool MAIN> struct SrcSsm {
    static constexpr bool TWO_VAR = MAIN; static constexpr int KTOT = MAIN ? SSM_KM : SSM_KE;
    const char* U; const char* HI; const char* Bt;
    __device__ __forceinline__ int nt() const { return KTOT / BK; }
    __device__ __forceinline__ const char* a(const Unit& u, int kt, int h) const {
        if (!MAIN || kt < 4) return U + ((size_t)((u.pm * BM + h * HALF) * 16 + 4 * kt) * 512 + (size_t)u.pn * 16) * 2;
        return HI + ((size_t)(u.pn * NCH + u.pm * BM + h * HALF) * 128 + (size_t)(kt - 4) * BK) * 2; }
    __device__ __forceinline__ const char* b(const Unit& u, int kt, int h) const { return Bt + ((size_t)(u.pn * 256 + h * HALF) * KTOT + (size_t)kt * BK) * 2; }
    __device__ __forceinline__ unsigned voffA(int R, int C, int var) const { return var ? (unsigned)(R * 128 + C) * 2u : (unsigned)((R * 16 + (C >> 4)) * 512 + (C & 15)) * 2u; }
    __device__ __forceinline__ unsigned voffB(int R, int C) const { return (unsigned)(R * KTOT + C) * 2u; }
    __device__ __forceinline__ int avar(int kt) const { return (MAIN && kt >= 4) ? 1 : 0; }
};

typedef f32x4 Acc[2][2][4][2];
__device__ __forceinline__ unsigned cvt_pk_bf16(float lo, float hi) { return cvtpk_s(lo, hi); }
__device__ __forceinline__ u32x4 pack8(f32x4 v0, f32x4 v1) { u32x4 w; w.x = cvt_pk_bf16(v0[0], v0[1]); w.y = cvt_pk_bf16(v0[2], v0[3]); w.z = cvt_pk_bf16(v1[0], v1[1]); w.w = cvt_pk_bf16(v1[2], v1[3]); return w; }
__device__ __forceinline__ f32x4 sig4(f32x4 v) { f32x4 o; o[0] = sigmoid_fast(v[0]); o[1] = sigmoid_fast(v[1]); o[2] = sigmoid_fast(v[2]); o[3] = sigmoid_fast(v[3]); return o; }
__device__ __forceinline__ f32x4 unpk_lo(u32x4 w) { f32x4 o; o[0] = bf2f(w.x & 0xffffu); o[1] = bf2f(w.x >> 16); o[2] = bf2f(w.y & 0xffffu); o[3] = bf2f(w.y >> 16); return o; }
__device__ __forceinline__ f32x4 unpk_hi(u32x4 w) { f32x4 o; o[0] = bf2f(w.z & 0xffffu); o[1] = bf2f(w.z >> 16); o[2] = bf2f(w.w & 0xffffu); o[3] = bf2f(w.w >> 16); return o; }
__device__ __forceinline__ f32x4 rcp4(f32x4 v) { f32x4 o; o[0] = __builtin_amdgcn_rcpf(v[0]); o[1] = __builtin_amdgcn_rcpf(v[1]); o[2] = __builtin_amdgcn_rcpf(v[2]); o[3] = __builtin_amdgcn_rcpf(v[3]); return o; }

template <int MODE> __device__ __forceinline__ void st_half_bf16(const Acc& acc, int bj, bf16* base, int ldc, float sc) {
#pragma unroll
    for (int ai = 0; ai < 2; ++ai)
#pragma unroll
        for (int m = 0; m < 4; ++m) { f32x4 v0 = acc[ai][bj][m][0], v1 = acc[ai][bj][m][1];
            if (MODE == 0) { v0 = v0 * sc; v1 = v1 * sc; }
            else if (MODE == 1) { v0 = sig4(v0); v1 = sig4(v1); }
            else if (MODE == 2) { v0 = __builtin_elementwise_max(v0, (f32x4){0.f, 0.f, 0.f, 0.f}); v1 = __builtin_elementwise_max(v1, (f32x4){0.f, 0.f, 0.f, 0.f}); v0 = v0 * v0; v1 = v1 * v1; }
            else { v0[0] = gelu_tanh(v0[0]); v0[1] = gelu_tanh(v0[1]); v0[2] = gelu_tanh(v0[2]); v0[3] = gelu_tanh(v0[3]); v1[0] = gelu_tanh(v1[0]); v1[1] = gelu_tanh(v1[1]); v1[2] = gelu_tanh(v1[2]); v1[3] = gelu_tanh(v1[3]); }
            *(u32x4*)(base + (size_t)(ai * HALF + m * 16) * ldc) = pack8(v0, v1); }
}
__device__ __forceinline__ void st_half_vt(const Acc& acc, int bj, bf16* VT, int b, int s0, int cc) {
    bf16* base = VT + ((size_t)(b * 2 + (cc >> 6)) * 64 + (cc & 63)) * S + s0;
#pragma unroll
    for (int ai = 0; ai < 2; ++ai)
#pragma unroll
        for (int m = 0; m < 4; ++m)
#pragma unroll
            for (int n = 0; n < 2; ++n)
#pragma unroll
                for (int e = 0; e < 4; ++e) base[(size_t)(4 * n + e) * S + ai * HALF + m * 16] = (bf16)f2bf(acc[ai][bj][m][n][e]);
}

struct EpiInProj {
    static constexpr bool PERM = true, AFTER_DRAIN = false, HAS_MID = false;
    bf16 *QA, *KA, *VAT, *U, *QM, *KM, *VMT, *GATES; float* KMP;
    __device__ __forceinline__ void operator()(const Acc& acc, const Unit& u, int wr, int wc, int fr, int fq) const {
        const int row = u.pm * BM + wr * 64 + fr, cc = wc * 32 + 8 * fq;
#pragma unroll
        for (int bj = 0; bj < 2; ++bj) {
            const int hc = u.pn * 2 + bj;
            if (hc < 4) st_half_bf16<0>(acc, bj, QA + (size_t)row * 512 + hc * 128 + cc, 512, C2);
            else if (hc == 4) st_half_bf16<0>(acc, bj, KA + (size_t)row * 128 + cc, 128, 1.f);
            else if (hc == 5) st_half_vt(acc, bj, VAT, row / S, row % S, cc);
            else if (hc < 10) st_half_bf16<0>(acc, bj, U + (size_t)row * 512 + (hc - 6) * 128 + cc, 512, 1.f);
            else if (hc < 14) st_half_bf16<0>(acc, bj, QM + (size_t)row * 512 + (hc - 10) * 128 + cc, 512, C2);
            else if (hc == 14) {
                st_half_bf16<0>(acc, bj, KM + (size_t)row * 128 + cc, 128, 1.f);
                f32x4 c0 = {0.f, 0.f, 0.f, 0.f}, c1 = {0.f, 0.f, 0.f, 0.f};
#pragma unroll
                for (int ai = 0; ai < 2; ++ai)
#pragma unroll
                    for (int m = 0; m < 4; ++m) { c0 += acc[ai][bj][m][0]; c1 += acc[ai][bj][m][1]; }
#pragma unroll
                for (int o = 1; o < 16; o <<= 1)
#pragma unroll
                    for (int e = 0; e < 4; ++e) { c0[e] += __shfl_xor(c0[e], o); c1[e] += __shfl_xor(c1[e], o); }
                if (fr == 0) { float* kp = KMP + (size_t)(wr * 64 + u.pm) * 128 + cc; *(f32x4*)kp = c0; *(f32x4*)(kp + 4) = c1; }
            }
            else if (hc == 15) st_half_vt(acc, bj, VMT, row / S, row % S, cc);
            else st_half_bf16<1>(acc, bj, GATES + (size_t)row * 3072 + (hc - 16) * 128 + cc, 3072, 1.f);
        }
    }
};
struct EpiFfn1 {
    static constexpr bool PERM = true, AFTER_DRAIN = false, HAS_MID = false;
    bf16* H1;
    __device__ __forceinline__ void operator()(const Acc& acc, const Unit& u, int wr, int wc, int fr, int fq) const {
        bf16* base = H1 + (size_t)(u.pm * BM + wr * 64 + fr) * DFF + u.pn * BM + wc * 32 + 8 * fq;
        st_half_bf16<2>(acc, 0, base, DFF, 1.f); st_half_bf16<2>(acc, 1, base + HALF, DFF, 1.f);
    }
};
struct EpiGlu {
    static constexpr bool PERM = true, AFTER_DRAIN = false, HAS_MID = false;
    bf16* A1;
    __device__ __forceinline__ void operator()(const Acc& acc, const Unit& u, int wr, int wc, int fr, int fq) const {
        bf16* base = A1 + (size_t)(u.pm * BM + wr * 64 + fr) * 512 + u.pn * 128 + wc * 32 + 8 * fq;
#pragma unroll
        for (int ai = 0; ai < 2; ++ai)
#pragma unroll
            for (int m = 0; m < 4; ++m) *(u32x4*)(base + (size_t)(ai * HALF + m * 16) * 512) = pack8(acc[ai][0][m][0] * sig4(acc[ai][1][m][0]), acc[ai][0][m][1] * sig4(acc[ai][1][m][1]));
    }
};
struct EpiMerge {
    static constexpr bool PERM = true, AFTER_DRAIN = false, HAS_MID = true;
    const bf16* GATES; bf16* MIXED;
    __device__ __forceinline__ void mid(Acc& acc, const Unit& u, int t, int wr, int wc, int fr, int fq) const {
        if (t != 8 && t != 16) return;
        const bf16* g = GATES + (size_t)(u.pm * BM + wr * 64 + fr) * 3072 + (t == 8 ? 0 : 1024) + u.pn * BM + wc * 32 + 8 * fq;
#pragma unroll
        for (int ai = 0; ai < 2; ++ai)
#pragma unroll
            for (int m = 0; m < 4; ++m)
#pragma unroll
                for (int bj = 0; bj < 2; ++bj) { const bf16* gp = g + (size_t)(ai * HALF + m * 16) * 3072 + bj * HALF; const u32x4 num = *(const u32x4*)gp, den = *(const u32x4*)(gp + 1024);
                    acc[ai][bj][m][0] = acc[ai][bj][m][0] * (unpk_lo(num) * rcp4(unpk_lo(den))); acc[ai][bj][m][1] = acc[ai][bj][m][1] * (unpk_hi(num) * rcp4(unpk_hi(den))); }
    }
    __device__ __forceinline__ void operator()(const Acc& acc, const Unit& u, int wr, int wc, int fr, int fq) const {
        const size_t ro = (size_t)(u.pm * BM + wr * 64 + fr); const int co = u.pn * BM + wc * 32 + 8 * fq;
#pragma unroll
        for (int ai = 0; ai < 2; ++ai)
#pragma unroll
            for (int m = 0; m < 4; ++m)
#pragma unroll
                for (int bj = 0; bj < 2; ++bj) { const size_t r = ro + ai * HALF + m * 16; const u32x4 g2 = *(const u32x4*)(GATES + r * 3072 + 2048 + co + bj * HALF);
                    *(u32x4*)(MIXED + r * DM + co + bj * HALF) = pack8(acc[ai][bj][m][0] * unpk_lo(g2), acc[ai][bj][m][1] * unpk_hi(g2)); }
    }
};
struct EpiResid {
    static constexpr bool PERM = false, AFTER_DRAIN = false, HAS_MID = false;
    float* X;
    __device__ __forceinline__ void operator()(const Acc& acc, const Unit& u, int wr, int wc, int fr, int fq) const {
        float* base = X + (size_t)(u.pm * BM + wr * 64 + fr) * DM + u.pn * BM + wc * 32 + 4 * fq;
#pragma unroll
        for (int ai = 0; ai < 2; ++ai)
#pragma unroll
            for (int m = 0; m < 4; ++m)
#pragma unroll
                for (int bj = 0; bj < 2; ++bj)
#pragma unroll
                    for (int n = 0; n < 2; ++n) { f32x4* p = (f32x4*)(base + (size_t)(ai * HALF + m * 16) * DM + bj * HALF + n * 16); *p = *p + acc[ai][bj][m][n]; }
    }
};
struct EpiSsmEnd {
    static constexpr bool PERM = false, AFTER_DRAIN = false, HAS_MID = false;
    float* HEND;
    __device__ __forceinline__ void operator()(const Acc& acc, const Unit& u, int wr, int wc, int fr, int fq) const {
        float* base = HEND + ((size_t)u.pn * NCH + u.pm * BM + wr * 64 + fr) * 128 + wc * 32 + 4 * fq;
#pragma unroll
        for (int ai = 0; ai < 2; ++ai)
#pragma unroll
            for (int m = 0; m < 4; ++m)
#pragma unroll
                for (int n = 0; n < 2; ++n) *(f32x4*)(base + (size_t)(ai * HALF + m * 16) * 128 + n * 16) = acc[ai][0][m][n];
    }
};
struct EpiSsmMain {
    static constexpr bool PERM = true, AFTER_DRAIN = false, HAS_MID = false;
    bf16* YS;
    __device__ __forceinline__ void operator()(const Acc& acc, const Unit& u, int wr, int wc, int fr, int fq) const {
        const int mrow = u.pm * BM + wr * 64 + fr;
#pragma unroll
        for (int bj = 0; bj < 2; ++bj) { const int s = 8 * bj + 2 * wc + (fq >> 1);
            bf16* base = YS + ((size_t)mrow * 16 + s) * 512 + u.pn * 16 + 8 * (fq & 1);
            st_half_bf16<3>(acc, bj, base, 16 * 512, 1.f); }
    }
};

template <class Epi, class Src, class Sched, bool ALIGN_EPI>
__device__ __forceinline__ void gemm_phase(PG8_LAS unsigned char* lds, const Src g, const Sched& S, const Epi& E) {
    int tid_ = threadIdx.x; asm volatile("" : "+v"(tid_));
    const int tid = tid_, wid = __builtin_amdgcn_readfirstlane(tid >> 6), lane = tid & 63, wr = wid >> 2, wc = wid & 3, fr = lane & 15, fq = lane >> 4;
    const int nt = g.nt();
    unsigned voffA[2], voffA2[2], voffB[2];
#pragma unroll
    for (int i = 0; i < 2; ++i) { int R, C; stage_rc(tid * 16 + i * 8192, R, C); const int Rb = Epi::PERM ? ((R & ~31) + perm32(R & 31)) : R;
        voffA[i] = g.voffA(R, C, 0); voffA2[i] = Src::TWO_VAR ? g.voffA(R, C, 1) : 0u; voffB[i] = g.voffB(Rb, C); }
    const unsigned ldsw = (unsigned)wid * 1024u;
    const int aoff = lds_byte(wr * 64 + fr, fq * 8), boff = lds_byte(wc * 32 + fr, fq * 8);
#define PG8_SA(b, h) (((b) * 2 + (h)) * HTB)
#define PG8_SB(b, h) ((4 + (b) * 2 + (h)) * HTB)
#define PG8_STAGE_B(bufoff, gbase) do { _Pragma("unroll") for (int _i = 0; _i < 2; ++_i) \
        __builtin_amdgcn_global_load_lds((const unsigned*)((const char*)(gbase) + voffB[_i]), (PG8_LAS unsigned*)(lds + (bufoff) + ldsw + _i * 8192), 16, 0, 0); } while (0)
#define PG8_STAGE_A(bufoff, gbase, kt) do { const bool _v = Src::TWO_VAR && g.avar(kt); _Pragma("unroll") for (int _i = 0; _i < 2; ++_i) { const unsigned _o = _v ? voffA2[_i] : voffA[_i]; \
        __builtin_amdgcn_global_load_lds((const unsigned*)((const char*)(gbase) + _o), (PG8_LAS unsigned*)(lds + (bufoff) + ldsw + _i * 8192), 16, 0, 0); } } while (0)
#define PG8_LDA(dst, b, h) do { _Pragma("unroll") for (int m = 0; m < 4; ++m) _Pragma("unroll") for (int k = 0; k < 2; ++k) dst[m][k] = *(const PG8_LAS bf16x8*)(lds + PG8_SA(b, h) + aoff + m * 2048 + k * 1024); } while (0)
#define PG8_LDB(dst, b, h) do { _Pragma("unroll") for (int n = 0; n < 2; ++n) _Pragma("unroll") for (int k = 0; k < 2; ++k) dst[n][k] = *(const PG8_LAS bf16x8*)(lds + PG8_SB(b, h) + boff + n * 2048 + k * 1024); } while (0)
#define PG8_MMA(ai, bj, At, Bt) do { __builtin_amdgcn_s_setprio(1); _Pragma("unroll") for (int m = 0; m < 4; ++m) _Pragma("unroll") for (int n = 0; n < 2; ++n) _Pragma("unroll") for (int k = 0; k < 2; ++k) \
        acc[ai][bj][m][n] = __builtin_amdgcn_mfma_f32_16x16x32_bf16(Bt[n][k], At[m][k], acc[ai][bj][m][n], 0, 0, 0); __builtin_amdgcn_s_setprio(0); } while (0)
#define PG8_WAIT_V(n) asm volatile("s_waitcnt vmcnt(" #n ")" ::: "memory")
#define PG8_WAIT_L(n) asm volatile("s_waitcnt lgkmcnt(" #n ")" ::: "memory")
#define PG8_BAR __builtin_amdgcn_s_barrier()
#define PG8_SCHED __builtin_amdgcn_sched_barrier(0)
    Unit cur, nxt; int ui = 0;
    if (!S.next(0, cur)) return;
    Acc acc;
#pragma unroll
    for (int a = 0; a < 2; ++a)
#pragma unroll
        for (int b = 0; b < 2; ++b)
#pragma unroll
            for (int m = 0; m < 4; ++m)
#pragma unroll
                for (int n = 0; n < 2; ++n) acc[a][b][m][n] = (f32x4){0.f, 0.f, 0.f, 0.f};
    bf16x8 At[4][2], B0[2][2], B1[2][2];
    PG8_STAGE_B(PG8_SB(0, 0), g.b(cur, 0, 0)); PG8_STAGE_B(PG8_SB(0, 1), g.b(cur, 0, 1)); PG8_STAGE_A(PG8_SA(0, 0), g.a(cur, 0, 0), 0); PG8_STAGE_A(PG8_SA(0, 1), g.a(cur, 0, 1), 0);
    if (wr == 1) PG8_BAR;
    PG8_WAIT_V(2); PG8_BAR;
    PG8_STAGE_B(PG8_SB(1, 0), g.b(cur, 1, 0)); PG8_STAGE_A(PG8_SA(1, 0), g.a(cur, 1, 0), 1); PG8_STAGE_B(PG8_SB(1, 1), g.b(cur, 1, 1));
    PG8_WAIT_V(6); PG8_BAR;
    for (;;) {
        const bool has_next = S.next(ui + 1, nxt);
        const Unit nu = has_next ? nxt : cur;
        for (int t = 0; t < nt; t += 2) {
            const bool last = (t == nt - 2);
            if constexpr (Epi::HAS_MID) E.mid(acc, cur, t, wr, wc, fr, fq);
            const Unit u2 = last ? nu : cur; const int k2 = last ? 0 : t + 2, k3 = k2 + 1;
            PG8_LDB(B0, 0, 0); PG8_LDB(B1, 0, 1); PG8_SCHED; PG8_LDA(At, 0, 0); PG8_STAGE_A(PG8_SA(1, 1), g.a(cur, t + 1, 1), t + 1);
            PG8_WAIT_V(8); PG8_WAIT_L(0); PG8_BAR; PG8_MMA(0, 0, At, B0); PG8_MMA(0, 1, At, B1); PG8_BAR; PG8_SCHED;
            PG8_LDA(At, 0, 1); PG8_STAGE_B(PG8_SB(0, 0), g.b(u2, k2, 0)); PG8_STAGE_B(PG8_SB(0, 1), g.b(u2, k2, 1)); PG8_STAGE_A(PG8_SA(0, 0), g.a(u2, k2, 0), k2);
            PG8_WAIT_V(8); PG8_WAIT_L(0); PG8_BAR; PG8_MMA(1, 0, At, B0); PG8_MMA(1, 1, At, B1); PG8_BAR; PG8_SCHED;
            PG8_LDB(B0, 1, 0); PG8_LDB(B1, 1, 1); PG8_SCHED; PG8_LDA(At, 1, 0); PG8_STAGE_A(PG8_SA(0, 1), g.a(u2, k2, 1), k2);
            PG8_WAIT_V(8); PG8_WAIT_L(0); PG8_BAR; PG8_MMA(0, 0, At, B0); PG8_MMA(0, 1, At, B1); PG8_BAR; PG8_SCHED;
            PG8_LDA(At, 1, 1); PG8_STAGE_B(PG8_SB(1, 0), g.b(u2, k3, 0)); PG8_STAGE_B(PG8_SB(1, 1), g.b(u2, k3, 1)); PG8_STAGE_A(PG8_SA(1, 0), g.a(u2, k3, 0), k3);
            PG8_WAIT_V(8); PG8_WAIT_L(0); PG8_BAR; PG8_MMA(1, 0, At, B0); PG8_MMA(1, 1, At, B1); PG8_BAR; PG8_SCHED;
        }
        if constexpr (ALIGN_EPI) { if (wr == 0) PG8_BAR; }
        E(acc, cur, wr, wc, fr, fq);
        if (!has_next) break;
#pragma unroll
        for (int a = 0; a < 2; ++a)
#pragma unroll
            for (int b = 0; b < 2; ++b)
#pragma unroll
                for (int m = 0; m < 4; ++m)
#pragma unroll
                    for (int n = 0; n < 2; ++n) acc[a][b][m][n] = (f32x4){0.f, 0.f, 0.f, 0.f};
        cur = nxt; ++ui;
        if constexpr (ALIGN_EPI) { if (wr == 1) PG8_BAR; }
    }
    PG8_WAIT_V(0);
    if constexpr (!ALIGN_EPI) { if (wr == 0) PG8_BAR; }
    PG8_BAR;
#undef PG8_SA
#undef PG8_SB
#undef PG8_STAGE_A
#undef PG8_STAGE_B
#undef PG8_LDA
#undef PG8_LDB
#undef PG8_MMA
#undef PG8_WAIT_V
#undef PG8_WAIT_L
#undef PG8_BAR
#undef PG8_SCHED
}
}
constexpr int NWAVES = 8;
constexpr int RING_OFF = 0, RING_BYTES = 131072;
constexpr int LDSCTL_OFF = RING_BYTES, MISC_OFF = LDSCTL_OFF + 320;
constexpr int LDS_BYTES = 147456;
constexpr int CW_TMO = 0, CW_CODE = 1, CW_BAR = 4096, CW_CNT = 16384;

#define GAS __attribute__((address_space(1)))
#define LAS __attribute__((address_space(3)))
typedef GAS unsigned gu32;
#define RLX_AGENT __ATOMIC_RELAXED, __HIP_MEMORY_SCOPE_AGENT
#define LDS_WAIT() asm volatile("s_waitcnt lgkmcnt(0)" ::: "memory")
#define VM_WAIT() asm volatile("s_waitcnt vmcnt(0)" ::: "memory")

#define XB_TMO      128
#define XB_XCNT(j)  (256  + 64 * (j))
#define XB_XSUB(j)  (1280 + 64 * (j))
#define XB_XGEN(j)  (2304 + 64 * (j))
#define XB_TOP      3328
#define XB_TOPGEN   3392
#define XCD_BAR_WORDS 3456
#define XB_SPIN_CAP (1u << 20)
__device__ __forceinline__ unsigned xb_ld(unsigned* p)              { return __hip_atomic_load(p, __ATOMIC_RELAXED, __HIP_MEMORY_SCOPE_AGENT); }
__device__ __forceinline__ unsigned xb_add(unsigned* p, unsigned v) { return __hip_atomic_fetch_add(p, v, __ATOMIC_RELAXED, __HIP_MEMORY_SCOPE_AGENT); }
__device__ __forceinline__ unsigned xb_xcc_id() { return (unsigned)__builtin_amdgcn_s_getreg((3 << 11) | 20) & 0xFu; }
#define XB_SPIN(cond, bar) do { unsigned _sp = 0; while (cond) { __builtin_amdgcn_s_sleep(1); \
    if ((++_sp & 255u) == 0u) { if (xb_ld(&(bar)[XB_TMO])) break; if (_sp > XB_SPIN_CAP) { atomicAdd(&(bar)[XB_TMO], 1u); break; } } } } while (0)
struct XcdBarrier { unsigned* bar; unsigned x; volatile LAS unsigned* st; };
__device__ __forceinline__ XcdBarrier xcd_barrier_post(unsigned* bar, volatile LAS unsigned* st) {
    XcdBarrier b; b.bar = bar; b.x = xb_xcc_id(); b.st = st;
    if (threadIdx.x == 0) (void)xb_add(&bar[XB_XCNT(b.x)], 1u);
    return b;
}
__device__ __forceinline__ void xcd_barrier_complete(unsigned* bar, unsigned x, unsigned& nloc, unsigned& nx) {
    const unsigned G = gridDim.x * gridDim.y * gridDim.z;
    unsigned sum, cnt, mine, sp = 0u;
    for (;;) {
        sum = 0u; cnt = 0u; mine = 0u;
#pragma unroll
        for (unsigned j = 0; j < 16; ++j) { const unsigned c = xb_ld(&bar[XB_XCNT(j)]); sum += c; cnt += (c > 0u) ? 1u : 0u; mine = (j == x) ? c : mine; }
        if (sum == G) break;
        __builtin_amdgcn_s_sleep(1);
        if ((++sp & 255u) == 0u) { if (xb_ld(&bar[XB_TMO])) break; if (sp > XB_SPIN_CAP) { atomicAdd(&bar[XB_TMO], 1u); break; } }
    }
    nloc = mine > 0u ? mine : 1u; nx = cnt > 0u ? cnt : 1u;
}
__device__ __forceinline__ void xcd_barrier(const XcdBarrier& b) {
    asm volatile("s_waitcnt vmcnt(0)" ::: "memory");
    __syncthreads();
    if (threadIdx.x == 0) {
        unsigned* bar = b.bar;
        __builtin_amdgcn_s_waitcnt(0);
        unsigned nloc = b.st[0], nx = b.st[1];
        if (nloc == 0u) { xcd_barrier_complete(bar, b.x, nloc, nx); b.st[0] = nloc; b.st[1] = nx; }
        const unsigned old = xb_add(&bar[XB_XSUB(b.x)], 1u);
        const unsigned gen = old / nloc;
        if (old + 1u == (gen + 1u) * nloc) {
            __builtin_amdgcn_fence(__ATOMIC_RELEASE, "agent");
            asm volatile("s_waitcnt vmcnt(0)" ::: "memory");
            const unsigned og = xb_add(&bar[XB_TOP], 1u);
            const unsigned tg = og / nx;
            if (og + 1u == (tg + 1u) * nx) xb_add(&bar[XB_TOPGEN], 1u);
            else XB_SPIN(xb_ld(&bar[XB_TOPGEN]) == tg, bar);
            __builtin_amdgcn_fence(__ATOMIC_ACQUIRE, "agent");
            xb_add(&bar[XB_XGEN(b.x)], 1u);
            asm volatile("s_waitcnt vmcnt(0)" ::: "memory");
        } else {
            XB_SPIN(xb_ld(&bar[XB_XGEN(b.x)]) == gen, bar);
            __builtin_amdgcn_fence(__ATOMIC_ACQUIRE, "agent");
            asm volatile("s_waitcnt vmcnt(0)" ::: "memory");
        }
    }
    __syncthreads();
}

struct Frame {
    LAS unsigned char* lds;
    int tid, lane, wave, vcu, G;
};

__device__ __forceinline__ void conv_item(const float* __restrict__ W, int N, const float* __restrict__ gain, bf16* WT, int Kdst, int k_off, int k0, int n0, int drow0, LAS float* scr, int lane) {
#pragma unroll 8
    for (int i = 0; i < 32; ++i) { const int kk = 2 * i + (lane >> 5); float v = W[(size_t)(k0 + kk) * N + n0 + (lane & 31)]; if (gain) v *= gain[k0 + kk]; scr[kk * 33 + (lane & 31)] = v; }
    LDS_WAIT(); asm volatile("" ::: "memory");
    const int c = lane & 7;
#pragma unroll
    for (int j = 0; j < 4; ++j) { const int n = (lane >> 3) + 8 * j; const LAS float* s = scr + (8 * c) * 33 + n;
        u32x4 o; o.x = pk2(s[0 * 33], s[1 * 33]); o.y = pk2(s[2 * 33], s[3 * 33]); o.z = pk2(s[4 * 33], s[5 * 33]); o.w = pk2(s[6 * 33], s[7 * 33]);
        *(GAS u32x4*)(WT + (size_t)(drow0 + n) * Kdst + k_off + k0 + 8 * c) = o; }
    LDS_WAIT(); asm volatile("" ::: "memory");
}
__device__ __forceinline__ void conv_layer(const Frame& F, const Ptrs& P, int l) {
    LAS float* scr = (LAS float*)(F.lds + RING_OFF + F.wave * 16384);
    const int gw = F.vcu * NWAVES + F.wave, NGW = F.G * NWAVES;
    unsigned char* ws = P.ws;
    constexpr int I_IN = 16 * 160, I_GLU = 8 * 32, I_MRG = 3 * 8 * 32, I_OUT = 16 * 32, I_F1 = 16 * 128, I_F2 = 64 * 32;
    constexpr int NITEMS = I_IN + I_GLU + I_MRG + I_OUT + I_F1 + I_F2;
    for (int it = gw; it < NITEMS; it += NGW) {
        int r = it;
        if (r < I_IN) { const int kb = r / 160, nb = r % 160; conv_item(P.w_in + (size_t)l * DM * DIN, DIN, P.norm_mix + l * DM, (bf16*)(ws + WS_WIN), DM, 0, 64 * kb, 32 * nb, 32 * nb, scr, F.lane); continue; } r -= I_IN;
        if (r < I_GLU) { const int kb = r / 32, nb = r % 32; const int n0 = 32 * nb, v = n0 & 511, drow0 = (v >> 7) * 256 + (n0 >= 512 ? 128 : 0) + (v & 127);
            conv_item(P.w_glu + (size_t)l * 512 * 1024, 1024, nullptr, (bf16*)(ws + WS_WGLU), 512, 0, 64 * kb, n0, drow0, scr, F.lane); continue; } r -= I_GLU;
        if (r < I_MRG) { const int sg = r / 256, q = r % 256, kb = q / 32, nb = q % 32; const float* W = (sg == 0 ? P.w_o_swa : (sg == 1 ? P.w_o_ssm : P.w_o_moba)) + (size_t)l * 512 * DM;
            conv_item(W, DM, nullptr, (bf16*)(ws + WS_WMRG), 1536, 512 * sg, 64 * kb, 32 * nb, 32 * nb, scr, F.lane); continue; } r -= I_MRG;
        if (r < I_OUT) { const int kb = r / 32, nb = r % 32; conv_item(P.w_out + (size_t)l * DM * DM, DM, nullptr, (bf16*)(ws + WS_WOUT), DM, 0, 64 * kb, 32 * nb, 32 * nb, scr, F.lane); continue; } r -= I_OUT;
        if (r < I_F1) { const int kb = r / 128, nb = r % 128; conv_item(P.w_ff1 + (size_t)l * DM * DFF, DFF, P.norm_ffn + l * DM, (bf16*)(ws + WS_WFF1), DM, 0, 64 * kb, 32 * nb, 32 * nb, scr, F.lane); continue; } r -= I_F1;
        { const int kb = r / 32, nb = r % 32; conv_item(P.w_ff2 + (size_t)l * DFF * DM, DM, nullptr, (bf16*)(ws + WS_WFF2), DFF, 0, 64 * kb, 32 * nb, 32 * nb, scr, F.lane); }
    }
}
__device__ __forceinline__ void ssm_mats(const Frame& F, const Ptrs& P, int l) {
    __syncthreads();
    LAS float* L = (LAS float*)(F.lds + RING_OFF);
    LAS float* apr = L;
    LAS float* api = L + 17 * 64;
    LAS float* bbr = L + 34 * 64;
    LAS float* bbi = bbr + 1024;
    LAS float* ccr = bbi + 1024;
    LAS float* cci = ccr + 1024;
    LAS float* ktab = cci + 1024;
    for (int g = F.vcu; g < 32; g += F.G) {
        const int tid = F.tid;
        if (tid < 64) { const int p = tid; const float lr = P.lam_re[l * 2048 + g * 64 + p], li = P.lam_im[l * 2048 + g * 64 + p], dt = expf(P.log_step[l * 32 + g]);
            const float mag = expf(lr * dt), are = mag * cosf(li * dt), aim = mag * sinf(li * dt);
            const float den = lr * lr + li * li, nr = are - 1.f, ni = aim, fre = (nr * lr + ni * li) / den, fim = (ni * lr - nr * li) / den;
            float pr = 1.f, pi = 0.f;
            for (int k = 0; k <= 16; ++k) { apr[k * 64 + p] = pr; api[k * 64 + p] = pi; const float t = pr * are - pi * aim; pi = pr * aim + pi * are; pr = t; }
            for (int h = 0; h < 16; ++h) { const float br = P.b_re[(size_t)l * 32768 + (g * 64 + p) * 16 + h], bi = P.b_im[(size_t)l * 32768 + (g * 64 + p) * 16 + h]; bbr[p * 16 + h] = fre * br - fim * bi; bbi[p * 16 + h] = fre * bi + fim * br; } }
        for (int e = tid; e < 1024; e += 512) { ccr[e] = P.c_re[(size_t)l * 32768 + g * 1024 + e]; cci[e] = P.c_im[(size_t)l * 32768 + g * 1024 + e]; }
        __syncthreads();
        for (int e = tid; e < 4096; e += 512) { const int tau = e >> 8, i = (e >> 4) & 15, j = e & 15; float acc = 0.f;
            for (int p = 0; p < 64; ++p) { const float cr = ccr[i * 64 + p], ci = cci[i * 64 + p], ar = apr[tau * 64 + p], ai = api[tau * 64 + p]; const float er = cr * ar - ci * ai, ei = cr * ai + ci * ar; acc += er * bbr[p * 16 + j] - ei * bbi[p * 16 + j]; }
            if (tau == 0 && i == j) acc += P.d_skip[l * 512 + g * 16 + i];
            ktab[e] = acc; }
        __syncthreads();
        bf16* BM_ = (bf16*)(P.ws + WS_SMAIN) + (size_t)g * 256 * SSM_KM;
        for (int e = tid; e < 256 * SSM_KM / 2; e += 512) {
            const int n = e / (SSM_KM / 2), k = (e % (SSM_KM / 2)) * 2, s = n >> 4, i = n & 15; float v[2];
#pragma unroll
            for (int q = 0; q < 2; ++q) { const int kk = k + q;
                if (kk < 256) { const int sp = kk >> 4, j = kk & 15; v[q] = (sp <= s) ? ktab[(s - sp) * 256 + i * 16 + j] : 0.f; }
                else { const int p = (kk - 256) & 63; const float cr = ccr[i * 64 + p], ci = cci[i * 64 + p], ar = apr[(s + 1) * 64 + p], ai = api[(s + 1) * 64 + p]; v[q] = (kk < 320) ? (cr * ar - ci * ai) : -(cr * ai + ci * ar); } }
            *(GAS unsigned*)(BM_ + (size_t)n * SSM_KM + k) = pk2(v[0], v[1]); }
        bf16* BE_ = (bf16*)(P.ws + WS_SEND) + (size_t)g * 256 * SSM_KE;
        for (int e = tid; e < 256 * SSM_KE / 2; e += 512) {
            const int n = e / (SSM_KE / 2), k = (e % (SSM_KE / 2)) * 2; float v[2];
#pragma unroll
            for (int q = 0; q < 2; ++q) { const int kk = k + q, sp = kk >> 4, j = kk & 15, p = n & 63; const float ar = apr[(15 - sp) * 64 + p], ai = api[(15 - sp) * 64 + p], br = bbr[p * 16 + j], bi = bbi[p * 16 + j];
                v[q] = (n < 64) ? (ar * br - ai * bi) : ((n < 128) ? (ar * bi + ai * br) : 0.f); }
            *(GAS unsigned*)(BE_ + (size_t)n * SSM_KE + k) = pk2(v[0], v[1]); }
        __syncthreads();
    }
}
__device__ __forceinline__ void xn_pass(const Frame& F, const Ptrs& P, bool first) {
    const int gw = F.vcu * NWAVES + F.wave, NGW = F.G * NWAVES;
    bf16* XN = (bf16*)(P.ws + WS_XN);
    for (int m = gw; m < T; m += NGW) {
        const GAS f32x4* xr = (const GAS f32x4*)((first ? P.x_in : P.x) + (size_t)m * DM) + F.lane;
        f32x4 v[4]; float s = 0.f;
#pragma unroll
        for (int j = 0; j < 4; ++j) { v[j] = xr[64 * j]; s += (v[j].x * v[j].x + v[j].y * v[j].y) + (v[j].z * v[j].z + v[j].w * v[j].w); }
        const float r = rsqrtf(wave_sum(s) * (1.f / DM) + NORM_EPS);
        if (first) { GAS f32x4* xo = (GAS f32x4*)(P.x + (size_t)m * DM) + F.lane;
#pragma unroll
            for (int j = 0; j < 4; ++j) xo[64 * j] = v[j]; }
        GAS unsigned long long* o8 = (GAS unsigned long long*)(XN + (size_t)m * DM) + F.lane;
#pragma unroll
        for (int j = 0; j < 4; ++j) o8[64 * j] = (unsigned long long)pk2(v[j].x * r, v[j].y * r) | ((unsigned long long)pk2(v[j].z * r, v[j].w * r) << 32);
    }
}
__device__ __forceinline__ void final_pass(const Frame& F, const Ptrs& P) {
    const int gw = F.vcu * NWAVES + F.wave, NGW = F.G * NWAVES;
    for (int m = gw; m < T; m += NGW) {
        GAS f32x4* xr = (GAS f32x4*)(P.x + (size_t)m * DM) + F.lane;
        f32x4 v[4]; float s = 0.f;
#pragma unroll
        for (int j = 0; j < 4; ++j) { v[j] = xr[64 * j]; s += (v[j].x * v[j].x + v[j].y * v[j].y) + (v[j].z * v[j].z + v[j].w * v[j].w); }
        const float r = rsqrtf(wave_sum(s) * (1.f / DM) + NORM_EPS);
#pragma unroll
        for (int j = 0; j < 4; ++j) { const f32x4 g = ((const GAS f32x4*)P.norm_final)[F.lane + 64 * j]; xr[64 * j] = v[j] * r * g; }
    }
}
__device__ __forceinline__ void ssm_carry(const Frame& F, const Ptrs& P, int l) {
    if (F.vcu & 15) return;
    const int gt = (F.vcu >> 4) * 512 + F.tid;
    if (gt >= 32 * NB * 64) return;
    const int p = gt & 63, b = (gt >> 6) & 3, g = gt >> 8;
    const float lr = P.lam_re[l * 2048 + g * 64 + p], li = P.lam_im[l * 2048 + g * 64 + p], dt = expf(P.log_step[l * 32 + g]);
    const float mag = expf(lr * dt), are = mag * cosf(li * dt), aim = mag * sinf(li * dt);
    float pr = 1.f, pi = 0.f;
    for (int k = 0; k < 16; ++k) { const float t = pr * are - pi * aim; pi = pr * aim + pi * are; pr = t; }
    const float* he = (const float*)(P.ws + WS_HEND) + ((size_t)g * NCH + b * 256) * 128 + p;
    bf16* hi = (bf16*)(P.ws + WS_HINIT) + ((size_t)g * NCH + b * 256) * 128 + p;
    float sr = 0.f, si = 0.f;
    float er[8], ei[8];
#pragma unroll
    for (int q = 0; q < 8; ++q) { er[q] = he[(size_t)q * 128]; ei[q] = he[(size_t)q * 128 + 64]; }
    for (int c0 = 0; c0 < 256; c0 += 8) {
        float nr_[8], ni_[8];
        const int cn = (c0 + 8 < 256) ? c0 + 8 : c0;
#pragma unroll
        for (int q = 0; q < 8; ++q) { nr_[q] = he[(size_t)(cn + q) * 128]; ni_[q] = he[(size_t)(cn + q) * 128 + 64]; }
#pragma unroll
        for (int q = 0; q < 8; ++q) { hi[(size_t)(c0 + q) * 128] = (bf16)f2bf(sr); hi[(size_t)(c0 + q) * 128 + 64] = (bf16)f2bf(si);
            const float tr = pr * sr - pi * si + er[q], ti = pr * si + pi * sr + ei[q]; sr = tr; si = ti; }
#pragma unroll
        for (int q = 0; q < 8; ++q) { er[q] = nr_[q]; ei[q] = ni_[q]; }
    }
}
namespace att {
__device__ __forceinline__ int crow(int r, int hi) { return (r & 3) + 8 * (r >> 2) + 4 * hi; }
struct St { f32x16 o0, o1; float m, l; };
__device__ __forceinline__ unsigned cvtpk(float lo, float hi) { return cvtpk_s(lo, hi); }

__device__ __forceinline__ void loadk(bf16x8 (&kf)[8], const bf16* kp) {
#pragma unroll
    for (int d0 = 0; d0 < 4; ++d0) { kf[2 * d0] = *(const bf16x8*)(kp + d0 * 16); kf[2 * d0 + 1] = *(const bf16x8*)(kp + 32 * 128 + d0 * 16); }
}
template <int MODE>
__device__ __forceinline__ void tile(St& st, const bf16x8 (&qr)[4], const bf16x8 (&kf)[8], const bf16* vtp  , int kq  , float sl2, bool rowok, int klo  , int hi) {
    f32x16 p0 = {}, p1 = {};
#pragma unroll
    for (int d0 = 0; d0 < 4; ++d0) { p0 = __builtin_amdgcn_mfma_f32_32x32x16_bf16(kf[2 * d0], qr[d0], p0, 0, 0, 0); p1 = __builtin_amdgcn_mfma_f32_32x32x16_bf16(kf[2 * d0 + 1], qr[d0], p1, 0, 0, 0); }
    s16x4 vl[2][4], vh[2][4];
#pragma unroll
    for (int dh = 0; dh < 2; ++dh)
#pragma unroll
        for (int s = 0; s < 4; ++s) { vl[dh][s] = *(const s16x4*)(vtp + (size_t)dh * 32 * S + 16 * s); vh[dh][s] = *(const s16x4*)(vtp + (size_t)dh * 32 * S + 16 * s + 8); }
    const float base = sl2 * (float)(kq + 4 * hi);
    float mx = -INFINITY;
#pragma unroll
    for (int r = 0; r < 16; ++r) { const int c = (r & 3) + 8 * (r >> 2); const int k0 = kq + 4 * hi + c, k1 = k0 + 32;
        float a = fmaf(sl2, (float)c, p0[r]), b = fmaf(sl2, (float)(c + 32), p1[r]);
        if (MODE == 1) { a = (k0 <= 0 && k0 >= klo) ? a : -INFINITY; b = (k1 <= 0 && k1 >= klo) ? b : -INFINITY; }
        else if (MODE == 2) { a = (k0 <= 0) ? a : -INFINITY; b = (k1 <= 0) ? b : -INFINITY; }
        else if (MODE == 3) { a = (rowok && k0 <= 0) ? a : -INFINITY; b = (rowok && k1 <= 0) ? b : -INFINITY; }
        p0[r] = a; p1[r] = b; mx = fmaxf(mx, fmaxf(a, b)); }
    mx += base;
    mx = fmaxf(mx, __shfl_xor(mx, 32));
    const float mn = fmaxf(st.m, mx), alpha = __builtin_amdgcn_exp2f(st.m - mn), off = base - mn;
    float sum = 0.f;
#pragma unroll
    for (int r = 0; r < 16; ++r) { p0[r] = __builtin_amdgcn_exp2f(p0[r] + off); p1[r] = __builtin_amdgcn_exp2f(p1[r] + off); sum += p0[r] + p1[r]; }
    st.m = mn; st.l = st.l * alpha + sum;
#pragma unroll
    for (int r = 0; r < 16; ++r) { st.o0[r] *= alpha; st.o1[r] *= alpha; }
    bf16x8 pf[4];
#pragma unroll
    for (int s = 0; s < 2; ++s) { u32x4 w0, w1;
        w0.x = cvtpk(p0[8 * s + 0], p0[8 * s + 1]); w0.y = cvtpk(p0[8 * s + 2], p0[8 * s + 3]); w0.z = cvtpk(p0[8 * s + 4], p0[8 * s + 5]); w0.w = cvtpk(p0[8 * s + 6], p0[8 * s + 7]);
        w1.x = cvtpk(p1[8 * s + 0], p1[8 * s + 1]); w1.y = cvtpk(p1[8 * s + 2], p1[8 * s + 3]); w1.z = cvtpk(p1[8 * s + 4], p1[8 * s + 5]); w1.w = cvtpk(p1[8 * s + 6], p1[8 * s + 7]);
        pf[s] = __builtin_bit_cast(bf16x8, w0); pf[2 + s] = __builtin_bit_cast(bf16x8, w1); }
#pragma unroll
    for (int s = 0; s < 4; ++s) {
        const bf16x8 v0 = (bf16x8){vl[0][s][0], vl[0][s][1], vl[0][s][2], vl[0][s][3], vh[0][s][0], vh[0][s][1], vh[0][s][2], vh[0][s][3]};
        const bf16x8 v1 = (bf16x8){vl[1][s][0], vl[1][s][1], vl[1][s][2], vl[1][s][3], vh[1][s][0], vh[1][s][1], vh[1][s][2], vh[1][s][3]};
        st.o0 = __builtin_amdgcn_mfma_f32_32x32x16_bf16(v0, pf[s], st.o0, 0, 0, 0);
        st.o1 = __builtin_amdgcn_mfma_f32_32x32x16_bf16(v1, pf[s], st.o1, 0, 0, 0); }
}
__device__ __forceinline__ void finish(const St& st, bf16* op, int hi) {
    const float lt = st.l + __shfl_xor(st.l, 32), rl = __builtin_amdgcn_rcpf(lt);
#pragma unroll
    for (int g = 0; g < 4; ++g) { u32x2 a, b;
        a.x = cvtpk(st.o0[4 * g] * rl, st.o0[4 * g + 1] * rl); a.y = cvtpk(st.o0[4 * g + 2] * rl, st.o0[4 * g + 3] * rl);
        b.x = cvtpk(st.o1[4 * g] * rl, st.o1[4 * g + 1] * rl); b.y = cvtpk(st.o1[4 * g + 2] * rl, st.o1[4 * g + 3] * rl);
        *(u32x2*)(op + 8 * g + 4 * hi) = a; *(u32x2*)(op + 32 + 8 * g + 4 * hi) = b; }
}
__device__ __forceinline__ void loadq(bf16x8 (&qr)[4], const bf16* qp) {
#pragma unroll
    for (int d0 = 0; d0 < 4; ++d0) qr[d0] = *(const bf16x8*)(qp + d0 * 16);
}

__device__ __forceinline__ void swa_phase(const Frame& F, const Ptrs& P, int l) {
    bf16* QA = (bf16*)(P.ws + WS_QA); const bf16* KA = (const bf16*)(P.ws + WS_KA); const bf16* VAT = (const bf16*)(P.ws + WS_VAT);
    const int lane = F.lane, r32 = lane & 31, hi = lane >> 5, w = F.wave;
    for (int un = F.vcu; un < 256; un += F.G) {
        const int bk = un >> 5, nb = un & 31, b = bk >> 1, kvh = bk & 1, h = kvh * 4 + (w >> 1);
        const float sl2 = exp2f(-0.5f * (float)(h + 1)) * LOG2E, sink2 = P.sinks[l * 8 + h] * LOG2E;
        for (int qt = 0; qt < 2; ++qt) {
            const int t0 = nb * 128 + (w & 1) * 64 + qt * 32;
            bf16* qrow = QA + (size_t)(b * S + t0 + r32) * 512 + h * 64;
            bf16x8 qr[4]; loadq(qr, qrow + 8 * hi);
            St st; st.o0 = f32x16{}; st.o1 = f32x16{}; st.m = sink2; st.l = hi ? 0.f : 1.f;
            for (int kt = 0; kt < 3; ++kt) {
                const int key0 = t0 - 128 + 64 * kt;
                if (key0 + 63 < 0) continue;
                bf16x8 kf[8]; loadk(kf, KA + ((long)(b * S + key0 + r32)) * 128 + kvh * 64 + 8 * hi);
                tile<1>(st, qr, kf, VAT + ((long)((b * 2 + kvh) * 64 + r32)) * S + key0 + 4 * hi, key0 - (t0 + r32), sl2, true, ((t0 + r32) < 127 ? -(t0 + r32) : -127), hi);
            }
            finish(st, qrow, hi);
        }
    }
}
__device__ __forceinline__ float moba_sl2(int h) { return exp2f(-0.5f * (float)(8 + h + 1)) * LOG2E; }
__device__ __forceinline__ void moba_select(const Frame& F, const Ptrs& P, int l) {
    const bf16* QM = (const bf16*)(P.ws + WS_QM); const float* KMP = (const float*)(P.ws + WS_KMP);
    unsigned* LIST = (unsigned*)(P.ws + WS_LIST); unsigned* CNT = (unsigned*)(P.ws + WS_CTL) + CW_CNT + l * 128;
    LAS float* km = (LAS float*)(F.lds + RING_OFF);
    const int tid = F.tid, lane = F.lane;
    for (int un = F.vcu; un < 256; un += F.G) {
        const int bk = un >> 5, ch = un & 31, b = bk >> 1, kvh = bk & 1, j = ch >> 1;
        __syncthreads();
        for (int e = tid; e < 1024; e += 512) { const int n = e >> 6, d = e & 63; const float* k0 = KMP + (size_t)(b * 16 + n) * 128 + kvh * 64 + d; km[e] = k0[0] + k0[64 * 128]; }
        __syncthreads();
        if (j == 0) continue;
        const int hg = tid >> 7, t = ch * 128 + (tid & 127);
        const bf16* qp = QM + (size_t)(b * S + t) * 512 + (kvh * 4 + hg) * 64;
        u32x4 qv[8];
#pragma unroll
        for (int i = 0; i < 8; ++i) qv[i] = *(const u32x4*)(qp + 8 * i);
        int i0 = 0, i1 = 1, i2 = 2;
        if (j > 3) {
            float v0 = -INFINITY, v1 = -INFINITY, v2 = -INFINITY; i0 = 0; i1 = 0; i2 = 0;
#pragma unroll 1
            for (int n = 0; n < j; ++n) { float a = 0.f;
#pragma unroll
                for (int i = 0; i < 8; ++i) { const f32x4 x0 = *(const LAS f32x4*)(km + n * 64 + 8 * i), x1 = *(const LAS f32x4*)(km + n * 64 + 8 * i + 4);
                    a += bf2f(qv[i].x & 0xffffu) * x0[0] + bf2f(qv[i].x >> 16) * x0[1] + bf2f(qv[i].y & 0xffffu) * x0[2] + bf2f(qv[i].y >> 16) * x0[3]
                       + bf2f(qv[i].z & 0xffffu) * x1[0] + bf2f(qv[i].z >> 16) * x1[1] + bf2f(qv[i].w & 0xffffu) * x1[2] + bf2f(qv[i].w >> 16) * x1[3]; }
                if (a > v0) { v2 = v1; i2 = i1; v1 = v0; i1 = i0; v0 = a; i0 = n; } else if (a > v1) { v2 = v1; i2 = i1; v1 = a; i1 = n; } else if (a > v2) { v2 = a; i2 = n; } }
        }
        const int nsel = j < 3 ? j : 3;
#pragma unroll 1
        for (int n = 0; n < j; ++n) {
            const int r = (n == i0) ? 0 : ((n == i1) ? 1 : ((n == i2) ? 2 : 3));
            const bool sel = r < nsel;
            const unsigned long long mask = __ballot(sel);
            if (mask == 0ull) continue;
            unsigned base = 0u;
            if (lane == 0) base = __hip_atomic_fetch_add(CNT + bk * 16 + n, (unsigned)__popcll(mask), __ATOMIC_RELAXED, __HIP_MEMORY_SCOPE_AGENT);
            base = __builtin_amdgcn_readfirstlane(base);
            const unsigned pos = base + (unsigned)__popcll(mask & ((1ull << lane) - 1ull));
            if (sel) LIST[(size_t)(bk * 16 + n) * 16384 + pos] = ((unsigned)t << 4) | ((unsigned)hg << 2) | (unsigned)r;
        }
    }
    __syncthreads();
}
__device__ __forceinline__ void store_o(const St& st, bf16* op, float rl, int hi) {
#pragma unroll
    for (int g = 0; g < 4; ++g) { u32x2 a, b;
        a.x = cvtpk(st.o0[4 * g] * rl, st.o0[4 * g + 1] * rl); a.y = cvtpk(st.o0[4 * g + 2] * rl, st.o0[4 * g + 3] * rl);
        b.x = cvtpk(st.o1[4 * g] * rl, st.o1[4 * g + 1] * rl); b.y = cvtpk(st.o1[4 * g + 2] * rl, st.o1[4 * g + 3] * rl);
        *(u32x2*)(op + 8 * g + 4 * hi) = a; *(u32x2*)(op + 32 + 8 * g + 4 * hi) = b; }
}
__device__ __forceinline__ void moba_gather(const Frame& F, const Ptrs& P, int l) {
    const bf16* QM = (const bf16*)(P.ws + WS_QM); const bf16* KM = (const bf16*)(P.ws + WS_KM); const bf16* VMT = (const bf16*)(P.ws + WS_VMT);
    const unsigned* LIST = (const unsigned*)(P.ws + WS_LIST); unsigned* CNT = (unsigned*)(P.ws + WS_CTL) + CW_CNT + l * 128;
    bf16* PART = (bf16*)(P.ws + WS_PART); float* LSE = (float*)(P.ws + WS_LSE);
    const int lane = F.lane, r32 = lane & 31, hi = lane >> 5;
    const int per = F.G >> 3;
    const int bk = F.vcu / per, wv = (F.vcu % per) * NWAVES + F.wave, nwv = per * NWAVES;
    if (bk >= 8) return;
    const int b = bk >> 1, kvh = bk & 1;
    unsigned cnt = 0u;
    if (lane < 16) cnt = __hip_atomic_load(CNT + bk * 16 + lane, __ATOMIC_RELAXED, __HIP_MEMORY_SCOPE_AGENT);
    const int nt_l = (int)((cnt + 31u) >> 5);
    int pre = nt_l;
#pragma unroll
    for (int o = 1; o < 16; o <<= 1) { const int v = __shfl_up(pre, o); if (lane >= o) pre += v; }
    const int total = __shfl(pre, 15);
#pragma unroll 1
    for (int item = wv; item < total; item += nwv) {
        const unsigned long long le = __ballot(lane < 16 && pre <= item);
        const int n = (int)__popcll(le);
        const int start = (n == 0) ? 0 : __shfl(pre, n - 1), ti = item - start;
        const int cn = (int)__shfl((int)cnt, n);
        const int idx = ti * 32 + r32; const bool valid = idx < cn;
        const unsigned e = LIST[(size_t)(bk * 16 + n) * 16384 + (valid ? idx : ti * 32)];
        const int t = (int)(e >> 4), hg = (int)((e >> 2) & 3u), r = (int)(e & 3u), h = kvh * 4 + hg;
        const size_t row = (size_t)(b * S + t);
        bf16x8 qr[4]; loadq(qr, QM + row * 512 + h * 64 + 8 * hi);
        const float sl2 = moba_sl2(h);
        St st; st.o0 = f32x16{}; st.o1 = f32x16{}; st.m = -INFINITY; st.l = 0.f;
        const bf16* kb = KM + ((long)(b * S + n * 256 + r32)) * 128 + kvh * 64 + 8 * hi;
        const bf16* vb = VMT + ((long)((b * 2 + kvh) * 64 + r32)) * S + n * 256 + 4 * hi;
        const int kq = n * 256 - t;
        bf16x8 kf0[8], kf1[8];
        loadk(kf0, kb); loadk(kf1, kb + 64 * 128);
        tile<0>(st, qr, kf0, vb, kq, sl2, true, 0, hi);
        loadk(kf0, kb + 128 * 128);
        tile<0>(st, qr, kf1, vb + 64, kq + 64, sl2, true, 0, hi);
        loadk(kf1, kb + 192 * 128);
        tile<0>(st, qr, kf0, vb + 128, kq + 128, sl2, true, 0, hi);
        tile<0>(st, qr, kf1, vb + 192, kq + 192, sl2, true, 0, hi);
        const float lt = st.l + __shfl_xor(st.l, 32);
        if (valid) { const size_t slot = (row * 8 + h) * 3 + r; store_o(st, PART + slot * 64, __builtin_amdgcn_rcpf(lt), hi); if (hi == 0) LSE[slot] = st.m + __builtin_amdgcn_logf(lt); }
    }
}
__device__ __forceinline__ void moba_own(const Frame& F, const Ptrs& P) {
    bf16* QM = (bf16*)(P.ws + WS_QM); const bf16* KM = (const bf16*)(P.ws + WS_KM); const bf16* VMT = (const bf16*)(P.ws + WS_VMT);
    const bf16* PART = (const bf16*)(P.ws + WS_PART); const float* LSE = (const float*)(P.ws + WS_LSE);
    const int lane = F.lane, r32 = lane & 31, hi = lane >> 5, w = F.wave;
    for (int L = F.vcu; L < 512; L += F.G) {
        const int bk = (L & 255) >> 5, pi = L & 31, qc = (L < 256) ? pi : 63 - pi, b = bk >> 1, kvh = bk & 1, h = kvh * 4 + (w >> 1);
        const float sl2 = moba_sl2(h);
        const int t0 = qc * 64 + (w & 1) * 32, j = t0 >> 8, q = t0 + r32;
        const size_t row = (size_t)(b * S + q);
        bf16* qrow = QM + row * 512 + h * 64;
        bf16x8 qr[4]; loadq(qr, qrow + 8 * hi);
        St st; st.o0 = f32x16{}; st.o1 = f32x16{}; st.m = -INFINITY; st.l = 0.f;
        const bf16* kbase = KM + ((long)(b * S + r32)) * 128 + kvh * 64 + 8 * hi;
        const bf16* vbase = VMT + ((long)((b * 2 + kvh) * 64 + r32)) * S + 4 * hi;
        const int nti = ((t0 - j * 256) >> 6) + 1;
#pragma unroll 1
        for (int it = 0; it < nti; ++it) { const int key0 = j * 256 + 64 * it; bf16x8 kf[8]; loadk(kf, kbase + (long)key0 * 128); tile<2>(st, qr, kf, vbase + key0, key0 - q, sl2, true, 0, hi); }
        const float lt = st.l + __shfl_xor(st.l, 32);
        const float lse_own = st.m + __builtin_amdgcn_logf(lt);
        const int nsel = j < 3 ? j : 3;
        const size_t slot0 = (row * 8 + h) * 3;
        float ls[3]; float M = lse_own;
#pragma unroll
        for (int r = 0; r < 3; ++r) { ls[r] = (r < nsel) ? LSE[slot0 + r] : -INFINITY; M = fmaxf(M, ls[r]); }
        const float w_own = __builtin_amdgcn_exp2f(lse_own - M); float W = w_own; const float s_own = w_own * __builtin_amdgcn_rcpf(lt);
#pragma unroll
        for (int rr = 0; rr < 16; ++rr) { st.o0[rr] *= s_own; st.o1[rr] *= s_own; }
#pragma unroll
        for (int r = 0; r < 3; ++r) { if (r < nsel) { const float wr_ = __builtin_amdgcn_exp2f(ls[r] - M); W += wr_; const bf16* pp = PART + (slot0 + r) * 64 + 4 * hi;
#pragma unroll
            for (int g = 0; g < 4; ++g) { const u32x2 a = *(const u32x2*)(pp + 8 * g), c = *(const u32x2*)(pp + 32 + 8 * g);
                st.o0[4 * g] += wr_ * bf2f(a.x & 0xffffu); st.o0[4 * g + 1] += wr_ * bf2f(a.x >> 16); st.o0[4 * g + 2] += wr_ * bf2f(a.y & 0xffffu); st.o0[4 * g + 3] += wr_ * bf2f(a.y >> 16);
                st.o1[4 * g] += wr_ * bf2f(c.x & 0xffffu); st.o1[4 * g + 1] += wr_ * bf2f(c.x >> 16); st.o1[4 * g + 2] += wr_ * bf2f(c.y & 0xffffu); st.o1[4 * g + 3] += wr_ * bf2f(c.y >> 16); } } }
        store_o(st, qrow, __builtin_amdgcn_rcpf(W), hi);
    }
}
}
#ifndef PH_MASK
#define PH_MASK 0xFFF
#endif
#define PH_ON(k) (((PH_MASK) >> (k)) & 1)
constexpr int NPH = 11, PH_FINAL = DEPTH * NPH, PH_TOTAL = PH_FINAL + 1;
struct Args { Ptrs P; int ph_lo, ph_hi, use_bar, sub; };
__global__ void __launch_bounds__(NWAVES * 64, 2) mk_fwd(Args args) {
    extern __shared__ __attribute__((aligned(16))) unsigned char lds[];
    Frame F;
    F.lds = (LAS unsigned char*)lds;
    F.tid = threadIdx.x; F.lane = F.tid & 63; F.wave = __builtin_amdgcn_readfirstlane(F.tid >> 6);
    F.G = gridDim.x; { const int bx = blockIdx.x; F.vcu = (F.G % 8 == 0) ? (bx % 8) * (F.G / 8) + bx / 8 : bx; }
    const Ptrs& P = args.P;
    unsigned char* ws0 = P.ws;
    volatile LAS unsigned* MISC = (volatile LAS unsigned*)(F.lds + MISC_OFF);
    for (int u = F.tid; u < (LDS_BYTES - LDSCTL_OFF) / 4; u += NWAVES * 64) ((LAS unsigned*)(F.lds + LDSCTL_OFF))[u] = 0u;
    __syncthreads();
    XcdBarrier bar; bar.bar = (unsigned*)(ws0 + WS_CTL) + CW_BAR; bar.x = 0; bar.st = nullptr;
    if (args.use_bar) bar = xcd_barrier_post((unsigned*)(ws0 + WS_CTL) + CW_BAR, MISC + 8);
    LAS unsigned char* ring = F.lds + RING_OFF;
    const int bx = (int)blockIdx.x;
    for (int ph = args.ph_lo; ph < args.ph_hi; ++ph) {
#if defined(BENCH_SET)
        const bool bench = ph >= PH_TOTAL; const int l = bench ? DEPTH - 1 : ph / NPH, k = bench ? (ph - PH_TOTAL) % NPH : ph % NPH;
        if (bench && !(((BENCH_SET) >> k) & 1)) continue;
#else
        const bool bench = false; const int l = ph / NPH, k = ph % NPH;
#endif
        unsigned char* ws = ws0; asm volatile("" : "+s"(ws));
        F.tid = threadIdx.x; asm volatile("" : "+v"(F.tid)); F.lane = F.tid & 63;
        if (ph == PH_FINAL && !bench) { if (PH_ON(11)) final_pass(F, P);
        }
        else if (k == 0 && PH_ON(0)) { conv_layer(F, P, l); ssm_mats(F, P, l); xn_pass(F, P, l == 0); __syncthreads(); }
        else if (k == 1 && PH_ON(1)) {
            pg8::SrcStd g{(const char*)(ws + WS_XN), (const char*)(ws + WS_WIN), DM}; pg8::StaticOrder So; So.init(T, DIN, F.G, bx);
            pg8::EpiInProj E{(bf16*)(ws + WS_QA), (bf16*)(ws + WS_KA), (bf16*)(ws + WS_VAT), (bf16*)(ws + WS_U), (bf16*)(ws + WS_QM), (bf16*)(ws + WS_KM), (bf16*)(ws + WS_VMT), (bf16*)(ws + WS_GATES), (float*)(ws + WS_KMP)};
            pg8::gemm_phase<pg8::EpiInProj, pg8::SrcStd, pg8::StaticOrder, true>(ring, g, So, E);
        }
        else if (k == 2 && PH_ON(2)) {
            if (args.sub & 1) { pg8::SrcSsm<false> g{(const char*)(ws + WS_U), nullptr, (const char*)(ws + WS_SEND)}; pg8::SsmOrder So{F.G, bx}; pg8::EpiSsmEnd E{(float*)(ws + WS_HEND)};
                pg8::gemm_phase<pg8::EpiSsmEnd, pg8::SrcSsm<false>, pg8::SsmOrder, true>(ring, g, So, E); }
            if (args.sub & 2) { att::swa_phase(F, P, l); att::moba_select(F, P, l); }
        }
        else if (k == 3 && PH_ON(3)) {
#ifndef NO_CARRY
            if (args.sub & 1) ssm_carry(F, P, l);
#endif
#ifndef NO_MOBA
            if (args.sub & 2) att::moba_gather(F, P, l);
#endif
        }
        else if (k == 4 && PH_ON(4)) {
            pg8::SrcSsm<true> g{(const char*)(ws + WS_U), (const char*)(ws + WS_HINIT), (const char*)(ws + WS_SMAIN)}; pg8::SsmOrder So{F.G, bx}; pg8::EpiSsmMain E{(bf16*)(ws + WS_U)};
            pg8::gemm_phase<pg8::EpiSsmMain, pg8::SrcSsm<true>, pg8::SsmOrder, true>(ring, g, So, E);
            att::moba_own(F, P);
        }
        else if (k == 5 && PH_ON(5)) {
            pg8::SrcStd g{(const char*)(ws + WS_U), (const char*)(ws + WS_WGLU), 512}; pg8::StaticOrder So; So.init(T, 1024, F.G, bx); pg8::EpiGlu E{(bf16*)(ws + WS_A1)};
            pg8::gemm_phase<pg8::EpiGlu, pg8::SrcStd, pg8::StaticOrder, true>(ring, g, So, E);
        }
        else if (k == 6 && PH_ON(6)) {
            pg8::SrcMerge g{(const char*)(ws + WS_QA), (const char*)(ws + WS_A1), (const char*)(ws + WS_QM), (const char*)(ws + WS_WMRG)}; pg8::StaticOrder So; So.init(T, DM, F.G, bx);
            pg8::EpiMerge E{(const bf16*)(ws + WS_GATES), (bf16*)(ws + WS_MIXED)};
            pg8::gemm_phase<pg8::EpiMerge, pg8::SrcMerge, pg8::StaticOrder, true>(ring, g, So, E);
        }
        else if ((k == 7 || k == 10) && PH_ON(7)) {
            const bool f2 = (k == 10);
            pg8::SrcStd g{(const char*)(ws + (f2 ? WS_H1 : WS_MIXED)), (const char*)(ws + (f2 ? WS_WFF2 : WS_WOUT)), f2 ? DFF : DM}; pg8::StaticOrder So; So.init(T, DM, F.G, bx); pg8::EpiResid E{bench ? (float*)(ws + WS_QA) : P.x};
            pg8::gemm_phase<pg8::EpiResid, pg8::SrcStd, pg8::StaticOrder, true>(ring, g, So, E);
        }
        else if (k == 8 && PH_ON(8)) { xn_pass(F, P, false); }
        else if (k == 9 && PH_ON(9)) {
            pg8::SrcStd g{(const char*)(ws + WS_XN), (const char*)(ws + WS_WFF1), DM}; pg8::StaticOrder So; So.init(T, DFF, F.G, bx); pg8::EpiFfn1 E{(bf16*)(ws + WS_H1)};
            pg8::gemm_phase<pg8::EpiFfn1, pg8::SrcStd, pg8::StaticOrder, true>(ring, g, So, E);
        }
        if (ph + 1 < args.ph_hi) { if (args.use_bar) xcd_barrier(bar); else __syncthreads(); }
    }
}
extern "C" void kernel_launch(void* const* d_in, const int* in_sizes, int n_in, void* d_out, int out_size, void* d_ws, size_t ws_size, hipStream_t stream) {
    static int grid = 0;
    if (grid == 0) {
        if (n_in != 21 || out_size != T * DM || ws_size < WS_END) { fprintf(stderr, "kernel_launch: unexpected shapes (n_in %d out %d ws %zu)\n", n_in, out_size, ws_size); grid = -1; return; }
        int dev = 0, cus = 0;
        if (hipGetDevice(&dev) != hipSuccess || hipDeviceGetAttribute(&cus, hipDeviceAttributeMultiprocessorCount, dev) != hipSuccess) { grid = -1; return; }
        if (hipFuncSetAttribute((const void*)mk_fwd, hipFuncAttributeMaxDynamicSharedMemorySize, LDS_BYTES) != hipSuccess) { fprintf(stderr, "kernel_launch: hipFuncSetAttribute failed\n"); grid = -1; return; }
        int per_cu = 0;
        if (hipOccupancyMaxActiveBlocksPerMultiprocessor(&per_cu, (const void*)mk_fwd, NWAVES * 64, LDS_BYTES) != hipSuccess || per_cu < 1) { fprintf(stderr, "kernel_launch: occupancy query reports %d workgroups per CU\n", per_cu); (void)hipGetLastError(); }
        grid = cus;
    }
    if (grid < 0) return;
    (void)hipMemsetAsync((char*)d_ws + WS_CTL, 0, CTL_ZERO_BYTES, stream);
    Args a{};
    const float** pp = (const float**)&a.P; for (int i = 0; i < 21; ++i) pp[i] = (const float*)d_in[i];
    a.P.x = (float*)d_out; a.P.ws = (unsigned char*)d_ws;
    #if defined(BENCH_SET)
    a.ph_lo = 0; a.ph_hi = PH_TOTAL + NPH * (BENCH_REPS);
#else
    a.ph_lo = 0; a.ph_hi = PH_TOTAL;
#endif
    a.use_bar = 1; a.sub = 3;
    hipLaunchKernelGGL(mk_fwd, dim3(grid), dim3(NWAVES * 64), LDS_BYTES, stream, a);
}
```

```cpp
#include <hip/hip_runtime.h>
#include <cstdio>
#include <cstdint>

constexpr int NB = 4, S = 4096, T = NB * S, DM = 1024, DEPTH = 4, DIN = 5120, DFF = 4096;
constexpr float LOG2E = 1.4426950408889634f;
constexpr float C2 = 0.125f * LOG2E;
constexpr float NORM_EPS = 1e-6f;
constexpr int SSM_L = 16;
constexpr int SSM_KM = SSM_L * 16 + 128;
constexpr int SSM_KE = SSM_L * 16;
constexpr int NCH = T / SSM_L;

constexpr size_t MiB = 1u << 20;
constexpr size_t WS_CTL = 0, CTL_ZERO_BYTES = 1 * MiB;
constexpr size_t WS_WIN = 1 * MiB, WS_WGLU = 11 * MiB, WS_WMRG = 12 * MiB, WS_WOUT = 15 * MiB, WS_WFF1 = 17 * MiB, WS_WFF2 = 25 * MiB;
constexpr size_t WS_SMAIN = 33 * MiB, WS_SEND = 39 * MiB, WS_KMP = 43 * MiB;
constexpr size_t WS_XN = 44 * MiB;
constexpr size_t WS_QA = 76 * MiB, WS_KA = 92 * MiB, WS_VAT = 96 * MiB, WS_U = 100 * MiB, WS_QM = 116 * MiB, WS_KM = 132 * MiB, WS_VMT = 136 * MiB, WS_GATES = 140 * MiB;
constexpr size_t WS_H1 = 76 * MiB;
constexpr size_t WS_LIST = WS_XN, WS_LSE = WS_XN + 8 * MiB;
constexpr size_t WS_PART = 236 * MiB;
constexpr size_t WS_A1 = 236 * MiB, WS_MIXED = 252 * MiB, WS_HEND = 284 * MiB, WS_HINIT = 300 * MiB, WS_SSQ = 308 * MiB, WS_END = 309 * MiB;

typedef unsigned short bf16;
typedef short bf16x8 __attribute__((ext_vector_type(8)));
typedef short s16x4 __attribute__((ext_vector_type(4)));
typedef float f32x4 __attribute__((ext_vector_type(4)));
typedef float f32x16 __attribute__((ext_vector_type(16)));
typedef unsigned u32x4 __attribute__((ext_vector_type(4)));
typedef unsigned u32x2 __attribute__((ext_vector_type(2)));

__host__ __device__ __forceinline__ unsigned f2bf(float f) { unsigned u = __builtin_bit_cast(unsigned, f); return (u + 0x7fffu + ((u >> 16) & 1u)) >> 16; }
__host__ __device__ __forceinline__ float bf2f(unsigned b) { return __builtin_bit_cast(float, b << 16); }
typedef float f32x2_t __attribute__((ext_vector_type(2))); typedef __bf16 bf16x2_t __attribute__((ext_vector_type(2)));
__device__ __forceinline__ unsigned cvtpk_s(float lo, float hi) { f32x2_t v = {lo, hi}; bf16x2_t b = __builtin_convertvector(v, bf16x2_t); return __builtin_bit_cast(unsigned, b); }
__device__ __forceinline__ unsigned pk2(float lo, float hi) { return f2bf(lo) | (f2bf(hi) << 16); }
__device__ __forceinline__ float rbf(float f) { return bf2f(f2bf(f)); }
__device__ __forceinline__ float sigmoid_fast(float x) { return __builtin_amdgcn_rcpf(1.f + __builtin_amdgcn_exp2f(-x * LOG2E)); }
__device__ __forceinline__ float gelu_tanh(float x) {
    const float c2 = 2.f * 0.7978845608028654f; const float t = c2 * (x + 0.044715f * x * x * x); return x * sigmoid_fast(t); }
__device__ __forceinline__ float wave_sum(float v) {
#pragma unroll
    for (int o = 1; o < 64; o <<= 1) v += __shfl_xor(v, o);
    return v;
}
__device__ __forceinline__ float wave_max(float v) {
#pragma unroll
    for (int o = 1; o < 64; o <<= 1) v = fmaxf(v, __shfl_xor(v, o));
    return v;
}

struct Ptrs {
    const float *x_in, *norm_mix, *w_in, *sinks, *lam_re, *lam_im, *log_step, *b_re, *b_im, *c_re, *c_im, *d_skip, *w_glu, *w_o_swa, *w_o_ssm, *w_o_moba, *w_out, *norm_ffn, *w_ff1, *w_ff2, *norm_final;
    float* x;
    unsigned char* ws;
};
namespace pg8 {
#define PG8_LAS __attribute__((address_space(3)))
constexpr int BM = 256, BK = 64, HALF = 128, HTB = HALF * BK * 2  , STAGE_BYTES = 8 * HTB, NXCD = 8, WGM = 8;

__host__ __device__ __forceinline__ int lds_byte(int r, int c) { const int st = (r >> 4) * 2 + (c >> 5), rr = r & 15, cc = c & 31, ob = rr * 64 + cc * 2; return st * 1024 + (ob ^ (((ob >> 9) & 1) << 5)); }
__host__ __device__ __forceinline__ void stage_rc(int b, int& R, int& C) { const int st = b / 1024, sb = b % 1024, swz = sb ^ (((sb >> 9) & 1) << 5); R = (st >> 1) * 16 + swz / 64; C = (st & 1) * 32 + (swz % 64) / 2; }
__host__ __device__ __forceinline__ int perm32(int rho) { const int n = rho >> 4, i = rho & 15; return 8 * (i >> 2) + 4 * n + (i & 3); }

struct Unit { int pm, pn; };

struct StaticOrder {
    int nM, nN, nwg, G, c;
    __host__ __device__ void init(int M, int N, int G_, int c_) { nM = M / BM; nN = N / BM; nwg = nM * nN; G = G_; c = c_; }
    __host__ __device__ bool next(int i, Unit& u) const {
        const long L = (long)i * G + c; if (L >= nwg) return false;
        int wgid = (int)L; { const int q = nwg / NXCD, r = nwg % NXCD, xcd = wgid % NXCD, off = wgid / NXCD; wgid = (xcd < r ? xcd * (q + 1) : r * (q + 1) + (xcd - r) * q) + off; }
        const int nig = WGM * nN, gid = wgid / nig, fm = gid * WGM, gsz = (nM - fm) < WGM ? (nM - fm) : WGM;
        u.pm = fm + ((wgid % nig) % gsz); u.pn = (wgid % nig) / gsz; return true;
    }
};
struct SsmOrder {
    int G, c;
    __host__ __device__ bool next(int i, Unit& u) const { const int L = i * G + c; if (L >= 128) return false; u.pn = L >> 2; u.pm = L & 3; return true; }
};

struct SrcStd {
    static constexpr bool TWO_VAR = false;
    const char* A; const char* Bt; int K;
    __device__ __forceinline__ int nt() const { return K / BK; }
    __device__ __forceinline__ const char* a(const Unit& u, int kt, int h) const { return A + ((size_t)(u.pm * BM + h * HALF) * K + (size_t)kt * BK) * 2; }
    __device__ __forceinline__ const char* b(const Unit& u, int kt, int h) const { return Bt + ((size_t)(u.pn * BM + h * HALF) * K + (size_t)kt * BK) * 2; }
    __device__ __forceinline__ unsigned voffA(int R, int C, int) const { return (unsigned)(R * K + C) * 2u; }
    __device__ __forceinline__ unsigned voffB(int R, int C) const { return (unsigned)(R * K + C) * 2u; }
    __device__ __forceinline__ int avar(int) const { return 0; }
};
struct SrcMerge {
    static constexpr bool TWO_VAR = false;
    const char* A0; const char* A1; const char* A2; const char* Bt;
    __device__ __forceinline__ int nt() const { return 24; }
    __device__ __forceinline__ const char* a(const Unit& u, int kt, int h) const { const int sg = kt >> 3; const char* p = sg == 0 ? A0 : (sg == 1 ? A1 : A2); return p + ((size_t)(u.pm * BM + h * HALF) * 512 + (size_t)(kt & 7) * BK) * 2; }
    __device__ __forceinline__ const char* b(const Unit& u, int kt, int h) const { return Bt + ((size_t)(u.pn * BM + h * HALF) * 1536 + (size_t)kt * BK) * 2; }
    __device__ __forceinline__ unsigned voffA(int R, int C, int) const { return (unsigned)(R * 512 + C) * 2u; }
    __device__ __forceinline__ unsigned voffB(int R, int C) const { return (unsigned)(R * 1536 + C) * 2u; }
    __device__ __forceinline__ int avar(int) const { return 0; }
};
template <bool MAIN> struct SrcSsm {
    static constexpr bool TWO_VAR = MAIN; static constexpr int KTOT = MAIN ? SSM_KM : SSM_KE;
    const char* U; const char* HI; const char* Bt;
    __device__ __forceinline__ int nt() const { return KTOT / BK; }
    __device__ __forceinline__ const char* a(const Unit& u, int kt, int h) const {
        if (!MAIN || kt < 4) return U + ((size_t)((u.pm * BM + h * HALF) * 16 + 4 * kt) * 512 + (size_t)u.pn * 16) * 2;
        return HI + ((size_t)(u.pn * NCH + u.pm * BM + h * HALF) * 128 + (size_t)(kt - 4) * BK) * 2; }
    __device__ __forceinline__ const char* b(const Unit& u, int kt, int h) const { return Bt + ((size_t)(u.pn * 256 + h * HALF) * KTOT + (size_t)kt * BK) * 2; }
    __device__ __forceinline__ unsigned voffA(int R, int C, int var) const { return var ? (unsigned)(R * 128 + C) * 2u : (unsigned)((R * 16 + (C >> 4)) * 512 + (C & 15)) * 2u; }
    __device__ __forceinline__ unsigned voffB(int R, int C) const { return (unsigned)(R * KTOT + C) * 2u; }
    __device__ __forceinline__ int avar(int kt) const { return (MAIN && kt >= 4) ? 1 : 0; }
};

typedef f32x4 Acc[2][2][4][2];
__device__ __forceinline__ unsigned cvt_pk_bf16(float lo, float hi) { return cvtpk_s(lo, hi); }
__device__ __forceinline__ u32x4 pack8(f32x4 v0, f32x4 v1) { u32x4 w; w.x = cvt_pk_bf16(v0[0], v0[1]); w.y = cvt_pk_bf16(v0[2], v0[3]); w.z = cvt_pk_bf16(v1[0], v1[1]); w.w = cvt_pk_bf16(v1[2], v1[3]); return w; }
__device__ __forceinline__ f32x4 sig4(f32x4 v) { f32x4 o; o[0] = sigmoid_fast(v[0]); o[1] = sigmoid_fast(v[1]); o[2] = sigmoid_fast(v[2]); o[3] = sigmoid_fast(v[3]); return o; }
__device__ __forceinline__ f32x4 unpk_lo(u32x4 w) { f32x4 o; o[0] = bf2f(w.x & 0xffffu); o[1] = bf2f(w.x >> 16); o[2] = bf2f(w.y & 0xffffu); o[3] = bf2f(w.y >> 16); return o; }
__device__ __forceinline__ f32x4 unpk_hi(u32x4 w) { f32x4 o; o[0] = bf2f(w.z & 0xffffu); o[1] = bf2f(w.z >> 16); o[2] = bf2f(w.w & 0xffffu); o[3] = bf2f(w.w >> 16); return o; }
__device__ __forceinline__ f32x4 rcp4(f32x4 v) { f32x4 o; o[0] = __builtin_amdgcn_rcpf(v[0]); o[1] = __builtin_amdgcn_rcpf(v[1]); o[2] = __builtin_amdgcn_rcpf(v[2]); o[3] = __builtin_amdgcn_rcpf(v[3]); return o; }

typedef float RowScale[2][4];
__device__ __forceinline__ void row_rinv(RowScale& ri, const float* SSQ, int row0) {
#pragma unroll
    for (int ai = 0; ai < 2; ++ai)
#pragma unroll
        for (int m = 0; m < 4; ++m) { const f32x4* sp = (const f32x4*)(SSQ + (size_t)(row0 + ai * HALF + m * 16) * 16); const f32x4 s = (sp[0] + sp[1]) + (sp[2] + sp[3]); ri[ai][m] = rsqrtf(((s[0] + s[1]) + (s[2] + s[3])) * (1.f / DM) + NORM_EPS); }
}
template <int MODE> __device__ __forceinline__ void st_half_bf16(const Acc& acc, int bj, bf16* base, int ldc, float sc, const RowScale* ri = nullptr) {
#pragma unroll
    for (int ai = 0; ai < 2; ++ai)
#pragma unroll
        for (int m = 0; m < 4; ++m) { f32x4 v0 = acc[ai][bj][m][0], v1 = acc[ai][bj][m][1];
            if (ri) { v0 = v0 * (*ri)[ai][m]; v1 = v1 * (*ri)[ai][m]; }
            if (MODE == 0) { v0 = v0 * sc; v1 = v1 * sc; }
            else if (MODE == 1) { v0 = sig4(v0); v1 = sig4(v1); }
            else if (MODE == 2) { v0 = __builtin_elementwise_max(v0, (f32x4){0.f, 0.f, 0.f, 0.f}); v1 = __builtin_elementwise_max(v1, (f32x4){0.f, 0.f, 0.f, 0.f}); v0 = v0 * v0; v1 = v1 * v1; }
            else { v0[0] = gelu_tanh(v0[0]); v0[1] = gelu_tanh(v0[1]); v0[2] = gelu_tanh(v0[2]); v0[3] = gelu_tanh(v0[3]); v1[0] = gelu_tanh(v1[0]); v1[1] = gelu_tanh(v1[1]); v1[2] = gelu_tanh(v1[2]); v1[3] = gelu_tanh(v1[3]); }
            *(u32x4*)(base + (size_t)(ai * HALF + m * 16) * ldc) = pack8(v0, v1); }
}
__device__ __forceinline__ void st_half_vt(const Acc& acc, int bj, bf16* VT, int b, int s0, int cc, const RowScale& ri) {
    bf16* base = VT + ((size_t)(b * 2 + (cc >> 6)) * 64 + (cc & 63)) * S + s0;
#pragma unroll
    for (int ai = 0; ai < 2; ++ai)
#pragma unroll
        for (int m = 0; m < 4; ++m)
#pragma unroll
            for (int n = 0; n < 2; ++n)
#pragma unroll
                for (int e = 0; e < 4; ++e) base[(size_t)(4 * n + e) * S + ai * HALF + m * 16] = (bf16)f2bf(acc[ai][bj][m][n][e] * ri[ai][m]);
}

struct EpiInProj {
    static constexpr bool PERM = true, AFTER_DRAIN = false, HAS_MID = false;
    bf16 *QA, *KA, *VAT, *U, *QM, *KM, *VMT, *GATES; float* KMP; const float* SSQ;
    __device__ __forceinline__ void operator()(const Acc& acc, const Unit& u, int wr, int wc, int fr, int fq) const {
        const int row = u.pm * BM + wr * 64 + fr, cc = wc * 32 + 8 * fq;
        RowScale ri; row_rinv(ri, SSQ, row);
#pragma unroll
        for (int bj = 0; bj < 2; ++bj) {
            const int hc = u.pn * 2 + bj;
            if (hc < 4) st_half_bf16<0>(acc, bj, QA + (size_t)row * 512 + hc * 128 + cc, 512, C2, &ri);
            else if (hc == 4) st_half_bf16<0>(acc, bj, KA + (size_t)row * 128 + cc, 128, 1.f, &ri);
            else if (hc == 5) st_half_vt(acc, bj, VAT, row / S, row % S, cc, ri);
            else if (hc < 10) st_half_bf16<0>(acc, bj, U + (size_t)row * 512 + (hc - 6) * 128 + cc, 512, 1.f, &ri);
            else if (hc < 14) st_half_bf16<0>(acc, bj, QM + (size_t)row * 512 + (hc - 10) * 128 + cc, 512, C2, &ri);
            else if (hc == 14) {
                st_half_bf16<0>(acc, bj, KM + (size_t)row * 128 + cc, 128, 1.f, &ri);
                f32x4 c0 = {0.f, 0.f, 0.f, 0.f}, c1 = {0.f, 0.f, 0.f, 0.f};
#pragma unroll
                for (int ai = 0; ai < 2; ++ai)
#pragma unroll
                    for (int m = 0; m < 4; ++m) { c0 += acc[ai][bj][m][0] * ri[ai][m]; c1 += acc[ai][bj][m][1] * ri[ai][m]; }
#pragma unroll
                for (int o = 1; o < 16; o <<= 1)
#pragma unroll
                    for (int e = 0; e < 4; ++e) { c0[e] += __shfl_xor(c0[e], o); c1[e] += __shfl_xor(c1[e], o); }
                if (fr == 0) { float* kp = KMP + (size_t)(wr * 64 + u.pm) * 128 + cc; *(f32x4*)kp = c0; *(f32x4*)(kp + 4) = c1; }
            }
            else if (hc == 15) st_half_vt(acc, bj, VMT, row / S, row % S, cc, ri);
            else st_half_bf16<1>(acc, bj, GATES + (size_t)row * 3072 + (hc - 16) * 128 + cc, 3072, 1.f, &ri);
        }
    }
};
struct EpiFfn1 {
    static constexpr bool PERM = true, AFTER_DRAIN = false, HAS_MID = false;
    bf16* H1; const float* SSQ;
    __device__ __forceinline__ void operator()(const Acc& acc, const Unit& u, int wr, int wc, int fr, int fq) const {
        bf16* base = H1 + (size_t)(u.pm * BM + wr * 64 + fr) * DFF + u.pn * BM + wc * 32 + 8 * fq;
        RowScale ri; row_rinv(ri, SSQ, u.pm * BM + wr * 64 + fr);
        st_half_bf16<2>(acc, 0, base, DFF, 1.f, &ri); st_half_bf16<2>(acc, 1, base + HALF, DFF, 1.f, &ri);
    }
};
struct EpiGlu {
    static constexpr bool PERM = true, AFTER_DRAIN = false, HAS_MID = false;
    bf16* A1;
    __device__ __forceinline__ void operator()(const Acc& acc, const Unit& u, int wr, int wc, int fr, int fq) const {
        bf16* base = A1 + (size_t)(u.pm * BM + wr * 64 + fr) * 512 + u.pn * 128 + wc * 32 + 8 * fq;
#pragma unroll
        for (int ai = 0; ai < 2; ++ai)
#pragma unroll
            for (int m = 0; m < 4; ++m) *(u32x4*)(base + (size_t)(ai * HALF + m * 16) * 512) = pack8(acc[ai][0][m][0] * sig4(acc[ai][1][m][0]), acc[ai][0][m][1] * sig4(acc[ai][1][m][1]));
    }
};
struct EpiMerge {
    static constexpr bool PERM = true, AFTER_DRAIN = false, HAS_MID = true;
    const bf16* GATES; bf16* MIXED;
    __device__ __forceinline__ void mid(Acc& acc, const Unit& u, int t, int wr, int wc, int fr, int fq) const {
        if (t != 8 && t != 16) return;
        const bf16* g = GATES + (size_t)(u.pm * BM + wr * 64 + fr) * 3072 + (t == 8 ? 0 : 1024) + u.pn * BM + wc * 32 + 8 * fq;
#pragma unroll
        for (int ai = 0; ai < 2; ++ai)
#pragma unroll
            for (int m = 0; m < 4; ++m)
#pragma unroll
                for (int bj = 0; bj < 2; ++bj) { const bf16* gp = g + (size_t)(ai * HALF + m * 16) * 3072 + bj * HALF; const u32x4 num = *(const u32x4*)gp, den = *(const u32x4*)(gp + 1024);
                    acc[ai][bj][m][0] = acc[ai][bj][m][0] * (unpk_lo(num) * rcp4(unpk_lo(den))); acc[ai][bj][m][1] = acc[ai][bj][m][1] * (unpk_hi(num) * rcp4(unpk_hi(den))); }
    }
    __device__ __forceinline__ void operator()(const Acc& acc, const Unit& u, int wr, int wc, int fr, int fq) const {
        const size_t ro = (size_t)(u.pm * BM + wr * 64 + fr); const int co = u.pn * BM + wc * 32 + 8 * fq;
#pragma unroll
        for (int ai = 0; ai < 2; ++ai)
#pragma unroll
            for (int m = 0; m < 4; ++m)
#pragma unroll
                for (int bj = 0; bj < 2; ++bj) { const size_t r = ro + ai * HALF + m * 16; const u32x4 g2 = *(const u32x4*)(GATES + r * 3072 + 2048 + co + bj * HALF);
                    *(u32x4*)(MIXED + r * DM + co + bj * HALF) = pack8(acc[ai][bj][m][0] * unpk_lo(g2), acc[ai][bj][m][1] * unpk_hi(g2)); }
    }
};
struct EpiResid {
    static constexpr bool PERM = false, AFTER_DRAIN = false, HAS_MID = false;
    float* X; bf16* XB; float* SSQ;
    __device__ __forceinline__ void operator()(const Acc& acc, const Unit& u, int wr, int wc, int fr, int fq) const {
        const size_t row0 = (size_t)(u.pm * BM + wr * 64 + fr); const int col0 = u.pn * BM + wc * 32 + 4 * fq;
#pragma unroll
        for (int ai = 0; ai < 2; ++ai)
#pragma unroll
            for (int m = 0; m < 4; ++m) { const size_t r = row0 + ai * HALF + m * 16; float ss = 0.f;
#pragma unroll
                for (int bj = 0; bj < 2; ++bj)
#pragma unroll
                    for (int n = 0; n < 2; ++n) { f32x4* p = (f32x4*)(X + r * DM + col0 + bj * HALF + n * 16); const f32x4 v = *p + acc[ai][bj][m][n]; *p = v;
                        ss += (v[0] * v[0] + v[1] * v[1]) + (v[2] * v[2] + v[3] * v[3]);
                        u32x2 w; w.x = cvt_pk_bf16(v[0], v[1]); w.y = cvt_pk_bf16(v[2], v[3]); *(u32x2*)(XB + r * DM + col0 + bj * HALF + n * 16) = w; }
                ss += __shfl_xor(ss, 16); ss += __shfl_xor(ss, 32);
                if (fq == 0) SSQ[r * 16 + u.pn * 4 + wc] = ss; }
    }
};
struct EpiSsmEnd {
    static constexpr bool PERM = false, AFTER_DRAIN = false, HAS_MID = false;
    float* HEND;
    __device__ __forceinline__ void operator()(const Acc& acc, const Unit& u, int wr, int wc, int fr, int fq) const {
        float* base = HEND + ((size_t)u.pn * NCH + u.pm * BM + wr * 64 + fr) * 128 + wc * 32 + 4 * fq;
#pragma unroll
        for (int ai = 0; ai < 2; ++ai)
#pragma unroll
            for (int m = 0; m < 4; ++m)
#pragma unroll
                for (int n = 0; n < 2; ++n) *(f32x4*)(base + (size_t)(ai * HALF + m * 16) * 128 + n * 16) = acc[ai][0][m][n];
    }
};
struct EpiSsmMain {
    static constexpr bool PERM = true, AFTER_DRAIN = false, HAS_MID = false;
    bf16* YS;
    __device__ __forceinline__ void operator()(const Acc& acc, const Unit& u, int wr, int wc, int fr, int fq) const {
        const int mrow = u.pm * BM + wr * 64 + fr;
#pragma unroll
        for (int bj = 0; bj < 2; ++bj) { const int s = 8 * bj + 2 * wc + (fq >> 1);
            bf16* base = YS + ((size_t)mrow * 16 + s) * 512 + u.pn * 16 + 8 * (fq & 1);
            st_half_bf16<3>(acc, bj, base, 16 * 512, 1.f); }
    }
};

template <class Epi, class Src, class Sched, bool ALIGN_EPI>
__device__ __forceinline__ void gemm_phase(PG8_LAS unsigned char* lds, const Src g, const Sched& S, const Epi& E) {
    int tid_ = threadIdx.x; asm volatile("" : "+v"(tid_));
    const int tid = tid_, wid = __builtin_amdgcn_readfirstlane(tid >> 6), lane = tid & 63, wr = wid >> 2, wc = wid & 3, fr = lane & 15, fq = lane >> 4;
    const int nt = g.nt();
    unsigned voffA[2], voffA2[2], voffB[2];
#pragma unroll
    for (int i = 0; i < 2; ++i) { int R, C; stage_rc(tid * 16 + i * 8192, R, C); const int Rb = Epi::PERM ? ((R & ~31) + perm32(R & 31)) : R;
        voffA[i] = g.voffA(R, C, 0); voffA2[i] = Src::TWO_VAR ? g.voffA(R, C, 1) : 0u; voffB[i] = g.voffB(Rb, C); }
    const unsigned ldsw = (unsigned)wid * 1024u;
    const int aoff = lds_byte(wr * 64 + fr, fq * 8), boff = lds_byte(wc * 32 + fr, fq * 8);
#define PG8_SA(b, h) (((b) * 2 + (h)) * HTB)
#define PG8_SB(b, h) ((4 + (b) * 2 + (h)) * HTB)
#define PG8_STAGE_B(bufoff, gbase) do { _Pragma("unroll") for (int _i = 0; _i < 2; ++_i) \
        __builtin_amdgcn_global_load_lds((const unsigned*)((const char*)(gbase) + voffB[_i]), (PG8_LAS unsigned*)(lds + (bufoff) + ldsw + _i * 8192), 16, 0, 0); } while (0)
#define PG8_STAGE_A(bufoff, gbase, kt) do { const bool _v = Src::TWO_VAR && g.avar(kt); _Pragma("unroll") for (int _i = 0; _i < 2; ++_i) { const unsigned _o = _v ? voffA2[_i] : voffA[_i]; \
        __builtin_amdgcn_global_load_lds((const unsigned*)((const char*)(gbase) + _o), (PG8_LAS unsigned*)(lds + (bufoff) + ldsw + _i * 8192), 16, 0, 0); } } while (0)
#define PG8_LDA(dst, b, h) do { _Pragma("unroll") for (int m = 0; m < 4; ++m) _Pragma("unroll") for (int k = 0; k < 2; ++k) dst[m][k] = *(const PG8_LAS bf16x8*)(lds + PG8_SA(b, h) + aoff + m * 2048 + k * 1024); } while (0)
#define PG8_LDB(dst, b, h) do { _Pragma("unroll") for (int n = 0; n < 2; ++n) _Pragma("unroll") for (int k = 0; k < 2; ++k) dst[n][k] = *(const PG8_LAS bf16x8*)(lds + PG8_SB(b, h) + boff + n * 2048 + k * 1024); } while (0)
#define PG8_MMA(ai, bj, At, Bt) do { __builtin_amdgcn_s_setprio(1); _Pragma("unroll") for (int m = 0; m < 4; ++m) _Pragma("unroll") for (int n = 0; n < 2; ++n) _Pragma("unroll") for (int k = 0; k < 2; ++k) \
        acc[ai][bj][m][n] = __builtin_amdgcn_mfma_f32_16x16x32_bf16(Bt[n][k], At[m][k], acc[ai][bj][m][n], 0, 0, 0); __builtin_amdgcn_s_setprio(0); } while (0)
#define PG8_WAIT_V(n) asm volatile("s_waitcnt vmcnt(" #n ")" ::: "memory")
#define PG8_WAIT_L(n) asm volatile("s_waitcnt lgkmcnt(" #n ")" ::: "memory")
#define PG8_BAR __builtin_amdgcn_s_barrier()
#define PG8_SCHED __builtin_amdgcn_sched_barrier(0)
    Unit cur, nxt; int ui = 0;
    if (!S.next(0, cur)) return;
    Acc acc;
#pragma unroll
    for (int a = 0; a < 2; ++a)
#pragma unroll
        for (int b = 0; b < 2; ++b)
#pragma unroll
            for (int m = 0; m < 4; ++m)
#pragma unroll
                for (int n = 0; n < 2; ++n) acc[a][b][m][n] = (f32x4){0.f, 0.f, 0.f, 0.f};
    bf16x8 At[4][2], B0[2][2], B1[2][2];
    PG8_STAGE_B(PG8_SB(0, 0), g.b(cur, 0, 0)); PG8_STAGE_B(PG8_SB(0, 1), g.b(cur, 0, 1)); PG8_STAGE_A(PG8_SA(0, 0), g.a(cur, 0, 0), 0); PG8_STAGE_A(PG8_SA(0, 1), g.a(cur, 0, 1), 0);
    if (wr == 1) PG8_BAR;
    PG8_WAIT_V(2); PG8_BAR;
    PG8_STAGE_B(PG8_SB(1, 0), g.b(cur, 1, 0)); PG8_STAGE_A(PG8_SA(1, 0), g.a(cur, 1, 0), 1); PG8_STAGE_B(PG8_SB(1, 1), g.b(cur, 1, 1));
    PG8_WAIT_V(6); PG8_BAR;
    for (;;) {
        const bool has_next = S.next(ui + 1, nxt);
        const Unit nu = has_next ? nxt : cur;
        for (int t = 0; t < nt; t += 2) {
            const bool last = (t == nt - 2);
            if constexpr (Epi::HAS_MID) E.mid(acc, cur, t, wr, wc, fr, fq);
            const Unit u2 = last ? nu : cur; const int k2 = last ? 0 : t + 2, k3 = k2 + 1;
            PG8_LDB(B0, 0, 0); PG8_LDB(B1, 0, 1); PG8_SCHED; PG8_LDA(At, 0, 0); PG8_STAGE_A(PG8_SA(1, 1), g.a(cur, t + 1, 1), t + 1);
            PG8_WAIT_V(8); PG8_WAIT_L(0); PG8_BAR; PG8_MMA(0, 0, At, B0); PG8_MMA(0, 1, At, B1); PG8_BAR; PG8_SCHED;
            PG8_LDA(At, 0, 1); PG8_STAGE_B(PG8_SB(0, 0), g.b(u2, k2, 0)); PG8_STAGE_B(PG8_SB(0, 1), g.b(u2, k2, 1)); PG8_STAGE_A(PG8_SA(0, 0), g.a(u2, k2, 0), k2);
            PG8_WAIT_V(8); PG8_WAIT_L(0); PG8_BAR; PG8_MMA(1, 0, At, B0); PG8_MMA(1, 1, At, B1); PG8_BAR; PG8_SCHED;
            PG8_LDB(B0, 1, 0); PG8_LDB(B1, 1, 1); PG8_SCHED; PG8_LDA(At, 1, 0); PG8_STAGE_A(PG8_SA(0, 1), g.a(u2, k2, 1), k2);
            PG8_WAIT_V(8); PG8_WAIT_L(0); PG8_BAR; PG8_MMA(0, 0, At, B0); PG8_MMA(0, 1, At, B1); PG8_BAR; PG8_SCHED;
            PG8_LDA(At, 1, 1); PG8_STAGE_B(PG8_SB(1, 0), g.b(u2, k3, 0)); PG8_STAGE_B(PG8_SB(1, 1), g.b(u2, k3, 1)); PG8_STAGE_A(PG8_SA(1, 0), g.a(u2, k3, 0), k3);
            PG8_WAIT_V(8); PG8_WAIT_L(0); PG8_BAR; PG8_MMA(1, 0, At, B0); PG8_MMA(1, 1, At, B1); PG8_BAR; PG8_SCHED;
        }
        if constexpr (ALIGN_EPI) { if (wr == 0) PG8_BAR; }
        E(acc, cur, wr, wc, fr, fq);
        if (!has_next) break;
#pragma unroll
        for (int a = 0; a < 2; ++a)
#pragma unroll
            for (int b = 0; b < 2; ++b)
#pragma unroll
                for (int m = 0; m < 4; ++m)
#pragma unroll
                    for (int n = 0; n < 2; ++n) acc[a][b][m][n] = (f32x4){0.f, 0.f, 0.f, 0.f};
        cur = nxt; ++ui;
        if constexpr (ALIGN_EPI) { if (wr == 1) PG8_BAR; }
    }
    PG8_WAIT_V(0);
    if constexpr (!ALIGN_EPI) { if (wr == 0) PG8_BAR; }
    PG8_BAR;
#undef PG8_SA
#undef PG8_SB
#undef PG8_STAGE_A
#undef PG8_STAGE_B
#undef PG8_LDA
#undef PG8_LDB
#undef PG8_MMA
#undef PG8_WAIT_V
#undef PG8_WAIT_L
#undef PG8_BAR
#undef PG8_SCHED
}
}
constexpr int NWAVES = 8;
constexpr int RING_OFF = 0, RING_BYTES = 131072;
constexpr int LDSCTL_OFF = RING_BYTES, MISC_OFF = LDSCTL_OFF + 320;
constexpr int LDS_BYTES = 147456;
constexpr int CW_TMO = 0, CW_CODE = 1, CW_BAR = 4096, CW_CNT = 16384;

#define GAS __attribute__((address_space(1)))
#define LAS __attribute__((address_space(3)))
typedef GAS unsigned gu32;
#define RLX_AGENT __ATOMIC_RELAXED, __HIP_MEMORY_SCOPE_AGENT
#define LDS_WAIT() asm volatile("s_waitcnt lgkmcnt(0)" ::: "memory")
#define VM_WAIT() asm volatile("s_waitcnt vmcnt(0)" ::: "memory")

#define XB_TMO      128
#define XB_XCNT(j)  (256  + 64 * (j))
#define XB_XSUB(j)  (1280 + 64 * (j))
#define XB_XGEN(j)  (2304 + 64 * (j))
#define XB_TOP      3328
#define XB_TOPGEN   3392
#define XCD_BAR_WORDS 3456
#define XB_SPIN_CAP (1u << 20)
__device__ __forceinline__ unsigned xb_ld(unsigned* p)              { return __hip_atomic_load(p, __ATOMIC_RELAXED, __HIP_MEMORY_SCOPE_AGENT); }
__device__ __forceinline__ unsigned xb_add(unsigned* p, unsigned v) { return __hip_atomic_fetch_add(p, v, __ATOMIC_RELAXED, __HIP_MEMORY_SCOPE_AGENT); }
__device__ __forceinline__ unsigned xb_xcc_id() { return (unsigned)__builtin_amdgcn_s_getreg((3 << 11) | 20) & 0xFu; }
#define XB_SPIN(cond, bar) do { unsigned _sp = 0; while (cond) { __builtin_amdgcn_s_sleep(1); \
    if ((++_sp & 255u) == 0u) { if (xb_ld(&(bar)[XB_TMO])) break; if (_sp > XB_SPIN_CAP) { atomicAdd(&(bar)[XB_TMO], 1u); break; } } } } while (0)
struct XcdBarrier { unsigned* bar; unsigned x; volatile LAS unsigned* st; };
__device__ __forceinline__ XcdBarrier xcd_barrier_post(unsigned* bar, volatile LAS unsigned* st) {
    XcdBarrier b; b.bar = bar; b.x = xb_xcc_id(); b.st = st;
    if (threadIdx.x == 0) (void)xb_add(&bar[XB_XCNT(b.x)], 1u);
    return b;
}
__device__ __forceinline__ void xcd_barrier_complete(unsigned* bar, unsigned x, unsigned& nloc, unsigned& nx) {
    const unsigned G = gridDim.x * gridDim.y * gridDim.z;
    unsigned sum, cnt, mine, sp = 0u;
    for (;;) {
        sum = 0u; cnt = 0u; mine = 0u;
#pragma unroll
        for (unsigned j = 0; j < 16; ++j) { const unsigned c = xb_ld(&bar[XB_XCNT(j)]); sum += c; cnt += (c > 0u) ? 1u : 0u; mine = (j == x) ? c : mine; }
        if (sum == G) break;
        __builtin_amdgcn_s_sleep(1);
        if ((++sp & 255u) == 0u) { if (xb_ld(&bar[XB_TMO])) break; if (sp > XB_SPIN_CAP) { atomicAdd(&bar[XB_TMO], 1u); break; } }
    }
    nloc = mine > 0u ? mine : 1u; nx = cnt > 0u ? cnt : 1u;
}
__device__ __forceinline__ void xcd_barrier(const XcdBarrier& b) {
    asm volatile("s_waitcnt vmcnt(0)" ::: "memory");
    __syncthreads();
    if (threadIdx.x == 0) {
        unsigned* bar = b.bar;
        __builtin_amdgcn_s_waitcnt(0);
        unsigned nloc = b.st[0], nx = b.st[1];
        if (nloc == 0u) { xcd_barrier_complete(bar, b.x, nloc, nx); b.st[0] = nloc; b.st[1] = nx; }
        const unsigned old = xb_add(&bar[XB_XSUB(b.x)], 1u);
        const unsigned gen = old / nloc;
        if (old + 1u == (gen + 1u) * nloc) {
            __builtin_amdgcn_fence(__ATOMIC_RELEASE, "agent");
            asm volatile("s_waitcnt vmcnt(0)" ::: "memory");
            const unsigned og = xb_add(&bar[XB_TOP], 1u);
            const unsigned tg = og / nx;
            if (og + 1u == (tg + 1u) * nx) xb_add(&bar[XB_TOPGEN], 1u);
            else XB_SPIN(xb_ld(&bar[XB_TOPGEN]) == tg, bar);
            __builtin_amdgcn_fence(__ATOMIC_ACQUIRE, "agent");
            xb_add(&bar[XB_XGEN(b.x)], 1u);
            asm volatile("s_waitcnt vmcnt(0)" ::: "memory");
        } else {
            XB_SPIN(xb_ld(&bar[XB_XGEN(b.x)]) == gen, bar);
            __builtin_amdgcn_fence(__ATOMIC_ACQUIRE, "agent");
            asm volatile("s_waitcnt vmcnt(0)" ::: "memory");
        }
    }
    __syncthreads();
}

struct Frame {
    LAS unsigned char* lds;
    int tid, lane, wave, vcu, G;
};

__device__ __forceinline__ void conv_item(const float* __restrict__ W, int N, const float* __restrict__ gain, bf16* WT, int Kdst, int k_off, int k0, int n0, int drow0, LAS float* scr, int lane) {
    f32x4 wv[8];
#pragma unroll
    for (int i = 0; i < 8; ++i) wv[i] = *(const f32x4*)(W + (size_t)(k0 + 8 * i + (lane >> 3)) * N + n0 + 4 * (lane & 7));
#pragma unroll
    for (int i = 0; i < 8; ++i) { const int kk = 8 * i + (lane >> 3); const float g = gain ? gain[k0 + kk] : 1.f; LAS float* sp = scr + kk * 33 + 4 * (lane & 7);
        sp[0] = wv[i][0] * g; sp[1] = wv[i][1] * g; sp[2] = wv[i][2] * g; sp[3] = wv[i][3] * g; }
    LDS_WAIT(); asm volatile("" ::: "memory");
    const int c = lane & 7;
#pragma unroll
    for (int j = 0; j < 4; ++j) { const int n = (lane >> 3) + 8 * j; const LAS float* s = scr + (8 * c) * 33 + n;
        u32x4 o; o.x = pk2(s[0 * 33], s[1 * 33]); o.y = pk2(s[2 * 33], s[3 * 33]); o.z = pk2(s[4 * 33], s[5 * 33]); o.w = pk2(s[6 * 33], s[7 * 33]);
        *(GAS u32x4*)(WT + (size_t)(drow0 + n) * Kdst + k_off + k0 + 8 * c) = o; }
    LDS_WAIT(); asm volatile("" ::: "memory");
}
__device__ __forceinline__ void conv_layer(const Frame& F, const Ptrs& P, int l) {
    LAS float* scr = (LAS float*)(F.lds + RING_OFF + F.wave * 16384);
    const int gw = F.vcu * NWAVES + F.wave, NGW = F.G * NWAVES;
    unsigned char* ws = P.ws;
    constexpr int I_IN = 16 * 160, I_GLU = 8 * 32, I_MRG = 3 * 8 * 32, I_OUT = 16 * 32, I_F1 = 16 * 128, I_F2 = 64 * 32;
    constexpr int NITEMS = I_IN + I_GLU + I_MRG + I_OUT + I_F1 + I_F2;
    for (int it = gw; it < NITEMS; it += NGW) {
        int r = it;
        if (r < I_IN) { const int kb = r / 160, nb = r % 160; conv_item(P.w_in + (size_t)l * DM * DIN, DIN, P.norm_mix + l * DM, (bf16*)(ws + WS_WIN), DM, 0, 64 * kb, 32 * nb, 32 * nb, scr, F.lane); continue; } r -= I_IN;
        if (r < I_GLU) { const int kb = r / 32, nb = r % 32; const int n0 = 32 * nb, v = n0 & 511, drow0 = (v >> 7) * 256 + (n0 >= 512 ? 128 : 0) + (v & 127);
            conv_item(P.w_glu + (size_t)l * 512 * 1024, 1024, nullptr, (bf16*)(ws + WS_WGLU), 512, 0, 64 * kb, n0, drow0, scr, F.lane); continue; } r -= I_GLU;
        if (r < I_MRG) { const int sg = r / 256, q = r % 256, kb = q / 32, nb = q % 32; const float* W = (sg == 0 ? P.w_o_swa : (sg == 1 ? P.w_o_ssm : P.w_o_moba)) + (size_t)l * 512 * DM;
            conv_item(W, DM, nullptr, (bf16*)(ws + WS_WMRG), 1536, 512 * sg, 64 * kb, 32 * nb, 32 * nb, scr, F.lane); continue; } r -= I_MRG;
        if (r < I_OUT) { const int kb = r / 32, nb = r % 32; conv_item(P.w_out + (size_t)l * DM * DM, DM, nullptr, (bf16*)(ws + WS_WOUT), DM, 0, 64 * kb, 32 * nb, 32 * nb, scr, F.lane); continue; } r -= I_OUT;
        if (r < I_F1) { const int kb = r / 128, nb = r % 128; conv_item(P.w_ff1 + (size_t)l * DM * DFF, DFF, P.norm_ffn + l * DM, (bf16*)(ws + WS_WFF1), DM, 0, 64 * kb, 32 * nb, 32 * nb, scr, F.lane); continue; } r -= I_F1;
        { const int kb = r / 32, nb = r % 32; conv_item(P.w_ff2 + (size_t)l * DFF * DM, DM, nullptr, (bf16*)(ws + WS_WFF2), DFF, 0, 64 * kb, 32 * nb, 32 * nb, scr, F.lane); }
    }
}
__device__ __forceinline__ void ssm_mats(const Frame& F, const Ptrs& P, int l) {
    __syncthreads();
    LAS float* L = (LAS float*)(F.lds + RING_OFF);
    LAS float* apr = L;
    LAS float* api = L + 17 * 64;
    LAS float* bbr = L + 34 * 64;
    LAS float* bbi = bbr + 1024;
    LAS float* ccr = bbi + 1024;
    LAS float* cci = ccr + 1024;
    LAS float* ktab = cci + 1024;
    for (int g = F.vcu; g < 32; g += F.G) {
        const int tid = F.tid;
        if (tid < 64) { const int p = tid; const float lr = P.lam_re[l * 2048 + g * 64 + p], li = P.lam_im[l * 2048 + g * 64 + p], dt = expf(P.log_step[l * 32 + g]);
            const float mag = expf(lr * dt), are = mag * cosf(li * dt), aim = mag * sinf(li * dt);
            const float den = lr * lr + li * li, nr = are - 1.f, ni = aim, fre = (nr * lr + ni * li) / den, fim = (ni * lr - nr * li) / den;
            float pr = 1.f, pi = 0.f;
            for (int k = 0; k <= 16; ++k) { apr[k * 64 + p] = pr; api[k * 64 + p] = pi; const float t = pr * are - pi * aim; pi = pr * aim + pi * are; pr = t; }
            for (int h = 0; h < 16; ++h) { const float br = P.b_re[(size_t)l * 32768 + (g * 64 + p) * 16 + h], bi = P.b_im[(size_t)l * 32768 + (g * 64 + p) * 16 + h]; bbr[p * 16 + h] = fre * br - fim * bi; bbi[p * 16 + h] = fre * bi + fim * br; } }
        for (int e = tid; e < 1024; e += 512) { ccr[e] = P.c_re[(size_t)l * 32768 + g * 1024 + e]; cci[e] = P.c_im[(size_t)l * 32768 + g * 1024 + e]; }
        __syncthreads();
        for (int e = tid; e < 4096; e += 512) { const int tau = e >> 8, i = (e >> 4) & 15, j = e & 15; float acc = 0.f;
            for (int p = 0; p < 64; ++p) { const float cr = ccr[i * 64 + p], ci = cci[i * 64 + p], ar = apr[tau * 64 + p], ai = api[tau * 64 + p]; const float er = cr * ar - ci * ai, ei = cr * ai + ci * ar; acc += er * bbr[p * 16 + j] - ei * bbi[p * 16 + j]; }
            if (tau == 0 && i == j) acc += P.d_skip[l * 512 + g * 16 + i];
            ktab[e] = acc; }
        __syncthreads();
        bf16* BM_ = (bf16*)(P.ws + WS_SMAIN) + (size_t)g * 256 * SSM_KM;
        for (int e = tid; e < 256 * SSM_KM / 2; e += 512) {
            const int n = e / (SSM_KM / 2), k = (e % (SSM_KM / 2)) * 2, s = n >> 4, i = n & 15; float v[2];
#pragma unroll
            for (int q = 0; q < 2; ++q) { const int kk = k + q;
                if (kk < 256) { const int sp = kk >> 4, j = kk & 15; v[q] = (sp <= s) ? ktab[(s - sp) * 256 + i * 16 + j] : 0.f; }
                else { const int p = (kk - 256) & 63; const float cr = ccr[i * 64 + p], ci = cci[i * 64 + p], ar = apr[(s + 1) * 64 + p], ai = api[(s + 1) * 64 + p]; v[q] = (kk < 320) ? (cr * ar - ci * ai) : -(cr * ai + ci * ar); } }
            *(GAS unsigned*)(BM_ + (size_t)n * SSM_KM + k) = pk2(v[0], v[1]); }
        bf16* BE_ = (bf16*)(P.ws + WS_SEND) + (size_t)g * 256 * SSM_KE;
        for (int e = tid; e < 256 * SSM_KE / 2; e += 512) {
            const int n = e / (SSM_KE / 2), k = (e % (SSM_KE / 2)) * 2; float v[2];
#pragma unroll
            for (int q = 0; q < 2; ++q) { const int kk = k + q, sp = kk >> 4, j = kk & 15, p = n & 63; const float ar = apr[(15 - sp) * 64 + p], ai = api[(15 - sp) * 64 + p], br = bbr[p * 16 + j], bi = bbi[p * 16 + j];
                v[q] = (n < 64) ? (ar * br - ai * bi) : ((n < 128) ? (ar * bi + ai * br) : 0.f); }
            *(GAS unsigned*)(BE_ + (size_t)n * SSM_KE + k) = pk2(v[0], v[1]); }
        __syncthreads();
    }
}
__device__ __forceinline__ void xb_pass(const Frame& F, const Ptrs& P) {
    const int gw = F.vcu * NWAVES + F.wave, NGW = F.G * NWAVES;
    bf16* XB = (bf16*)(P.ws + WS_XN); float* SSQ = (float*)(P.ws + WS_SSQ);
    for (int m = gw; m < T; m += NGW) {
        const GAS f32x4* xr = (const GAS f32x4*)(P.x_in + (size_t)m * DM) + F.lane;
        f32x4 v[4]; float s = 0.f;
#pragma unroll
        for (int j = 0; j < 4; ++j) { v[j] = xr[64 * j]; s += (v[j].x * v[j].x + v[j].y * v[j].y) + (v[j].z * v[j].z + v[j].w * v[j].w); }
        s = wave_sum(s);
        GAS f32x4* xo = (GAS f32x4*)(P.x + (size_t)m * DM) + F.lane;
#pragma unroll
        for (int j = 0; j < 4; ++j) xo[64 * j] = v[j];
        GAS unsigned long long* o8 = (GAS unsigned long long*)(XB + (size_t)m * DM) + F.lane;
#pragma unroll
        for (int j = 0; j < 4; ++j) o8[64 * j] = (unsigned long long)pk2(v[j].x, v[j].y) | ((unsigned long long)pk2(v[j].z, v[j].w) << 32);
        if (F.lane < 16) SSQ[(size_t)m * 16 + F.lane] = (F.lane == 0) ? s : 0.f;
    }
}
__device__ __forceinline__ void final_pass(const Frame& F, const Ptrs& P) {
    const int gw = F.vcu * NWAVES + F.wave, NGW = F.G * NWAVES;
    for (int m = gw; m < T; m += NGW) {
        GAS f32x4* xr = (GAS f32x4*)(P.x + (size_t)m * DM) + F.lane;
        f32x4 v[4]; float s = 0.f;
#pragma unroll
        for (int j = 0; j < 4; ++j) { v[j] = xr[64 * j]; s += (v[j].x * v[j].x + v[j].y * v[j].y) + (v[j].z * v[j].z + v[j].w * v[j].w); }
        const float r = rsqrtf(wave_sum(s) * (1.f / DM) + NORM_EPS);
#pragma unroll
        for (int j = 0; j < 4; ++j) { const f32x4 g = ((const GAS f32x4*)P.norm_final)[F.lane + 64 * j]; xr[64 * j] = v[j] * r * g; }
    }
}
__device__ __forceinline__ void ssm_carry(const Frame& F, const Ptrs& P, int l) {
    if (F.vcu & 15) return;
    const int gt = (F.vcu >> 4) * 512 + F.tid;
    if (gt >= 32 * NB * 64) return;
    const int p = gt & 63, b = (gt >> 6) & 3, g = gt >> 8;
    const float lr = P.lam_re[l * 2048 + g * 64 + p], li = P.lam_im[l * 2048 + g * 64 + p], dt = expf(P.log_step[l * 32 + g]);
    const float mag = expf(lr * dt), are = mag * cosf(li * dt), aim = mag * sinf(li * dt);
    float pr = 1.f, pi = 0.f;
    for (int k = 0; k < 16; ++k) { const float t = pr * are - pi * aim; pi = pr * aim + pi * are; pr = t; }
    const float* he = (const float*)(P.ws + WS_HEND) + ((size_t)g * NCH + b * 256) * 128 + p;
    bf16* hi = (bf16*)(P.ws + WS_HINIT) + ((size_t)g * NCH + b * 256) * 128 + p;
    float sr = 0.f, si = 0.f;
    float er[8], ei[8];
#pragma unroll
    for (int q = 0; q < 8; ++q) { er[q] = he[(size_t)q * 128]; ei[q] = he[(size_t)q * 128 + 64]; }
    for (int c0 = 0; c0 < 256; c0 += 8) {
        float nr_[8], ni_[8];
        const int cn = (c0 + 8 < 256) ? c0 + 8 : c0;
#pragma unroll
        for (int q = 0; q < 8; ++q) { nr_[q] = he[(size_t)(cn + q) * 128]; ni_[q] = he[(size_t)(cn + q) * 128 + 64]; }
#pragma unroll
        for (int q = 0; q < 8; ++q) { hi[(size_t)(c0 + q) * 128] = (bf16)f2bf(sr); hi[(size_t)(c0 + q) * 128 + 64] = (bf16)f2bf(si);
            const float tr = pr * sr - pi * si + er[q], ti = pr * si + pi * sr + ei[q]; sr = tr; si = ti; }
#pragma unroll
        for (int q = 0; q < 8; ++q) { er[q] = nr_[q]; ei[q] = ni_[q]; }
    }
}
namespace att {
__device__ __forceinline__ int crow(int r, int hi) { return (r & 3) + 8 * (r >> 2) + 4 * hi; }
struct St { f32x16 o0, o1; float m, l; };
__device__ __forceinline__ unsigned cvtpk(float lo, float hi) { return cvtpk_s(lo, hi); }

__device__ __forceinline__ void loadk(bf16x8 (&kf)[8], const bf16* kp) {
#pragma unroll
    for (int d0 = 0; d0 < 4; ++d0) { kf[2 * d0] = *(const bf16x8*)(kp + d0 * 16); kf[2 * d0 + 1] = *(const bf16x8*)(kp + 32 * 128 + d0 * 16); }
}
template <int MODE>
__device__ __forceinline__ void tile(St& st, const bf16x8 (&qr)[4], const bf16x8 (&kf)[8], const bf16* vtp  , int kq  , float sl2, bool rowok, int klo  , int hi) {
    f32x16 p0 = {}, p1 = {};
#pragma unroll
    for (int d0 = 0; d0 < 4; ++d0) { p0 = __builtin_amdgcn_mfma_f32_32x32x16_bf16(kf[2 * d0], qr[d0], p0, 0, 0, 0); p1 = __builtin_amdgcn_mfma_f32_32x32x16_bf16(kf[2 * d0 + 1], qr[d0], p1, 0, 0, 0); }
    s16x4 vl[2][4], vh[2][4];
#pragma unroll
    for (int dh = 0; dh < 2; ++dh)
#pragma unroll
        for (int s = 0; s < 4; ++s) { vl[dh][s] = *(const s16x4*)(vtp + (size_t)dh * 32 * S + 16 * s); vh[dh][s] = *(const s16x4*)(vtp + (size_t)dh * 32 * S + 16 * s + 8); }
    const float base = sl2 * (float)(kq + 4 * hi);
    float mx = -INFINITY;
#pragma unroll
    for (int r = 0; r < 16; ++r) { const int c = (r & 3) + 8 * (r >> 2); const int k0 = kq + 4 * hi + c, k1 = k0 + 32;
        float a = fmaf(sl2, (float)c, p0[r]), b = fmaf(sl2, (float)(c + 32), p1[r]);
        if (MODE == 1) { a = (k0 <= 0 && k0 >= klo) ? a : -INFINITY; b = (k1 <= 0 && k1 >= klo) ? b : -INFINITY; }
        else if (MODE == 2) { a = (k0 <= 0) ? a : -INFINITY; b = (k1 <= 0) ? b : -INFINITY; }
        else if (MODE == 3) { a = (rowok && k0 <= 0) ? a : -INFINITY; b = (rowok && k1 <= 0) ? b : -INFINITY; }
        p0[r] = a; p1[r] = b; mx = fmaxf(mx, fmaxf(a, b)); }
    mx += base;
    mx = fmaxf(mx, __shfl_xor(mx, 32));
    const float mn = fmaxf(st.m, mx), alpha = __builtin_amdgcn_exp2f(st.m - mn), off = base - mn;
    float sum = 0.f;
#pragma unroll
    for (int r = 0; r < 16; ++r) { p0[r] = __builtin_amdgcn_exp2f(p0[r] + off); p1[r] = __builtin_amdgcn_exp2f(p1[r] + off); sum += p0[r] + p1[r]; }
    st.m = mn; st.l = st.l * alpha + sum;
#pragma unroll
    for (int r = 0; r < 16; ++r) { st.o0[r] *= alpha; st.o1[r] *= alpha; }
    bf16x8 pf[4];
#pragma unroll
    for (int s = 0; s < 2; ++s) { u32x4 w0, w1;
        w0.x = cvtpk(p0[8 * s + 0], p0[8 * s + 1]); w0.y = cvtpk(p0[8 * s + 2], p0[8 * s + 3]); w0.z = cvtpk(p0[8 * s + 4], p0[8 * s + 5]); w0.w = cvtpk(p0[8 * s + 6], p0[8 * s + 7]);
        w1.x = cvtpk(p1[8 * s + 0], p1[8 * s + 1]); w1.y = cvtpk(p1[8 * s + 2], p1[8 * s + 3]); w1.z = cvtpk(p1[8 * s + 4], p1[8 * s + 5]); w1.w = cvtpk(p1[8 * s + 6], p1[8 * s + 7]);
        pf[s] = __builtin_bit_cast(bf16x8, w0); pf[2 + s] = __builtin_bit_cast(bf16x8, w1); }
#pragma unroll
    for (int s = 0; s < 4; ++s) {
        const bf16x8 v0 = (bf16x8){vl[0][s][0], vl[0][s][1], vl[0][s][2], vl[0][s][3], vh[0][s][0], vh[0][s][1], vh[0][s][2], vh[0][s][3]};
        const bf16x8 v1 = (bf16x8){vl[1][s][0], vl[1][s][1], vl[1][s][2], vl[1][s][3], vh[1][s][0], vh[1][s][1], vh[1][s][2], vh[1][s][3]};
        st.o0 = __builtin_amdgcn_mfma_f32_32x32x16_bf16(v0, pf[s], st.o0, 0, 0, 0);
        st.o1 = __builtin_amdgcn_mfma_f32_32x32x16_bf16(v1, pf[s], st.o1, 0, 0, 0); }
}
__device__ __forceinline__ void finish(const St& st, bf16* op, int hi) {
    const float lt = st.l + __shfl_xor(st.l, 32), rl = __builtin_amdgcn_rcpf(lt);
#pragma unroll
    for (int g = 0; g < 4; ++g) { u32x2 a, b;
        a.x = cvtpk(st.o0[4 * g] * rl, st.o0[4 * g + 1] * rl); a.y = cvtpk(st.o0[4 * g + 2] * rl, st.o0[4 * g + 3] * rl);
        b.x = cvtpk(st.o1[4 * g] * rl, st.o1[4 * g + 1] * rl); b.y = cvtpk(st.o1[4 * g + 2] * rl, st.o1[4 * g + 3] * rl);
        *(u32x2*)(op + 8 * g + 4 * hi) = a; *(u32x2*)(op + 32 + 8 * g + 4 * hi) = b; }
}
__device__ __forceinline__ void loadq(bf16x8 (&qr)[4], const bf16* qp) {
#pragma unroll
    for (int d0 = 0; d0 < 4; ++d0) qr[d0] = *(const bf16x8*)(qp + d0 * 16);
}

constexpr int IMG_K = 0, IMG_V = 32768, IMG_BYTES = 65536;
__device__ __forceinline__ void img_load(const Frame& F, LAS unsigned char* img, const bf16* K, long krow0, int kvh, const bf16* vt0, int key0) {
    const int lane = F.lane, w = F.wave;
#pragma unroll
    for (int i = 0; i < 4; ++i) { const int piece = w * 4 + i, key = piece * 8 + (lane >> 3), c = (lane & 7) ^ ((key >> 1) & 7); long row = krow0 + key; row = row < 0 ? 0 : row;
        __builtin_amdgcn_global_load_lds((const unsigned*)(K + row * 128 + kvh * 64 + c * 8), (LAS unsigned*)(img + IMG_K + piece * 1024), 16, 0, 0); }
#pragma unroll
    for (int i = 0; i < 4; ++i) { const int piece = w * 4 + i, d = piece * 2 + (lane >> 5), c = (lane & 31) ^ (d & 15); int kk = key0 + c * 8; kk = kk < 0 ? 0 : kk;
        __builtin_amdgcn_global_load_lds((const unsigned*)(vt0 + (long)d * S + kk), (LAS unsigned*)(img + IMG_V + piece * 1024), 16, 0, 0); }
}
template <int MODE, bool HALF>
__device__ __forceinline__ void tile_lds(St& st, const bf16x8 (&qr)[4], const LAS unsigned char* img, int ko, int kq  , float sl2, bool rowok, int klo, int hi, int r32) {
    const LAS unsigned char* kp = img + IMG_K + (ko + r32) * 128; const int s7 = (r32 >> 1) & 7;
    f32x16 p0 = {}, p1 = {};
#pragma unroll
    for (int d0 = 0; d0 < 4; ++d0) { const int off = ((2 * d0 + hi) ^ s7) << 4;
        p0 = __builtin_amdgcn_mfma_f32_32x32x16_bf16(*(const LAS bf16x8*)(kp + off), qr[d0], p0, 0, 0, 0);
        if (!HALF) p1 = __builtin_amdgcn_mfma_f32_32x32x16_bf16(*(const LAS bf16x8*)(kp + 32 * 128 + off), qr[d0], p1, 0, 0, 0); }
    const float base = sl2 * (float)(kq + 4 * hi);
    float mx = -INFINITY;
#pragma unroll
    for (int r = 0; r < 16; ++r) { const int c = (r & 3) + 8 * (r >> 2); const int k0 = kq + 4 * hi + c, k1 = k0 + 32;
        float a = fmaf(sl2, (float)c, p0[r]), b = HALF ? -INFINITY : fmaf(sl2, (float)(c + 32), p1[r]);
        if (MODE == 1) { a = (k0 <= 0 && k0 >= klo) ? a : -INFINITY; if (!HALF) b = (k1 <= 0 && k1 >= klo) ? b : -INFINITY; }
        else if (MODE == 2) { a = (k0 <= 0) ? a : -INFINITY; if (!HALF) b = (k1 <= 0) ? b : -INFINITY; }
        else if (MODE == 3) { a = (rowok && k0 <= 0) ? a : -INFINITY; if (!HALF) b = (rowok && k1 <= 0) ? b : -INFINITY; }
        p0[r] = a; if (!HALF) p1[r] = b; mx = fmaxf(mx, HALF ? a : fmaxf(a, b)); }
    mx += base;
    mx = fmaxf(mx, __shfl_xor(mx, 32));
    const float mn = fmaxf(st.m, mx), alpha = __builtin_amdgcn_exp2f(st.m - mn), off = base - mn;
    float sum = 0.f;
#pragma unroll
    for (int r = 0; r < 16; ++r) { p0[r] = __builtin_amdgcn_exp2f(p0[r] + off); sum += p0[r]; if (!HALF) { p1[r] = __builtin_amdgcn_exp2f(p1[r] + off); sum += p1[r]; } }
    st.m = mn; st.l = st.l * alpha + sum;
#pragma unroll
    for (int r = 0; r < 16; ++r) { st.o0[r] *= alpha; st.o1[r] *= alpha; }
    const LAS unsigned char* vp = img + IMG_V + r32 * 512 + hi * 8; const int x = r32 & 15, kc = ko >> 3;
#pragma unroll
    for (int s = 0; s < (HALF ? 2 : 4); ++s) {
        u32x4 w;
        if (s < 2) { w.x = cvtpk(p0[8 * s + 0], p0[8 * s + 1]); w.y = cvtpk(p0[8 * s + 2], p0[8 * s + 3]); w.z = cvtpk(p0[8 * s + 4], p0[8 * s + 5]); w.w = cvtpk(p0[8 * s + 6], p0[8 * s + 7]); }
        else { w.x = cvtpk(p1[8 * s - 16], p1[8 * s - 15]); w.y = cvtpk(p1[8 * s - 14], p1[8 * s - 13]); w.z = cvtpk(p1[8 * s - 12], p1[8 * s - 11]); w.w = cvtpk(p1[8 * s - 10], p1[8 * s - 9]); }
        const bf16x8 pf = __builtin_bit_cast(bf16x8, w);
        const int o0 = ((kc + 2 * s) ^ x) << 4, o1 = ((kc + 2 * s + 1) ^ x) << 4;
        const s16x4 a0 = *(const LAS s16x4*)(vp + o0), a1 = *(const LAS s16x4*)(vp + o1), b0 = *(const LAS s16x4*)(vp + 32 * 512 + o0), b1 = *(const LAS s16x4*)(vp + 32 * 512 + o1);
        st.o0 = __builtin_amdgcn_mfma_f32_32x32x16_bf16((bf16x8){a0[0], a0[1], a0[2], a0[3], a1[0], a1[1], a1[2], a1[3]}, pf, st.o0, 0, 0, 0);
        st.o1 = __builtin_amdgcn_mfma_f32_32x32x16_bf16((bf16x8){b0[0], b0[1], b0[2], b0[3], b1[0], b1[1], b1[2], b1[3]}, pf, st.o1, 0, 0, 0); }
}
__device__ __forceinline__ void swa_phase(const Frame& F, const Ptrs& P, int l) {
    bf16* QA = (bf16*)(P.ws + WS_QA); const bf16* KA = (const bf16*)(P.ws + WS_KA); const bf16* VAT = (const bf16*)(P.ws + WS_VAT);
    const int lane = F.lane, r32 = lane & 31, hi = lane >> 5, w = F.wave;
    LAS unsigned char* img = F.lds + RING_OFF;
    for (int un = F.vcu; un < 256; un += F.G) {
        const int bk = un >> 5, nb = un & 31, b = bk >> 1, kvh = bk & 1, h = kvh * 4 + (w >> 1);
        __syncthreads();
        img_load(F, img, KA, (long)b * S + nb * 128 - 128, kvh, VAT + (long)((b * 2 + kvh) * 64) * S, nb * 128 - 128);
        const float sl2 = exp2f(-0.5f * (float)(h + 1)) * LOG2E, sink2 = P.sinks[l * 8 + h] * LOG2E;
        asm volatile("s_waitcnt vmcnt(0)" ::: "memory"); __syncthreads();
        for (int qt = 0; qt < 2; ++qt) {
            const int qo = (w & 1) * 64 + qt * 32, t0 = nb * 128 + qo, q = t0 + r32;
            bf16* qrow = QA + (size_t)(b * S + q) * 512 + h * 64;
            bf16x8 qr[4]; loadq(qr, qrow + 8 * hi);
            St st; st.o0 = f32x16{}; st.o1 = f32x16{}; st.m = sink2; st.l = hi ? 0.f : 1.f;
            const int klo = q < 127 ? -q : -127;
            if (t0 - 128 + 63 >= 0) tile_lds<1, false>(st, qr, img, qo, t0 - 128 - q, sl2, true, klo, hi, r32);
            if (t0 - 64 + 63 >= 0) tile_lds<1, false>(st, qr, img, qo + 64, t0 - 64 - q, sl2, true, klo, hi, r32);
            tile_lds<1, true>(st, qr, img, qo + 128, t0 - q, sl2, true, klo, hi, r32);
            finish(st, qrow, hi);
        }
    }
    __syncthreads();
}
__device__ __forceinline__ float moba_sl2(int h) { return exp2f(-0.5f * (float)(8 + h + 1)) * LOG2E; }
__device__ __forceinline__ void moba_select(const Frame& F, const Ptrs& P, int l) {
    const bf16* QM = (const bf16*)(P.ws + WS_QM); const float* KMP = (const float*)(P.ws + WS_KMP);
    unsigned* LIST = (unsigned*)(P.ws + WS_LIST); unsigned* CNT = (unsigned*)(P.ws + WS_CTL) + CW_CNT + l * 128;
    LAS float* km = (LAS float*)(F.lds + RING_OFF);
    const int tid = F.tid, lane = F.lane;
    for (int un = F.vcu; un < 256; un += F.G) {
        const int bk = un >> 5, ch = un & 31, b = bk >> 1, kvh = bk & 1, j = ch >> 1;
        __syncthreads();
        for (int e = tid; e < 1024; e += 512) { const int n = e >> 6, d = e & 63; const float* k0 = KMP + (size_t)(b * 16 + n) * 128 + kvh * 64 + d; km[e] = k0[0] + k0[64 * 128]; }
        __syncthreads();
        if (j == 0) continue;
        const int hg = tid >> 7, t = ch * 128 + (tid & 127);
        const bf16* qp = QM + (size_t)(b * S + t) * 512 + (kvh * 4 + hg) * 64;
        u32x4 qv[8];
#pragma unroll
        for (int i = 0; i < 8; ++i) qv[i] = *(const u32x4*)(qp + 8 * i);
        int i0 = 0, i1 = 1, i2 = 2;
        if (j > 3) {
            float v0 = -INFINITY, v1 = -INFINITY, v2 = -INFINITY; i0 = 0; i1 = 0; i2 = 0;
#pragma unroll 1
            for (int n = 0; n < j; ++n) { float a = 0.f;
#pragma unroll
                for (int i = 0; i < 8; ++i) { const f32x4 x0 = *(const LAS f32x4*)(km + n * 64 + 8 * i), x1 = *(const LAS f32x4*)(km + n * 64 + 8 * i + 4);
                    a += bf2f(qv[i].x & 0xffffu) * x0[0] + bf2f(qv[i].x >> 16) * x0[1] + bf2f(qv[i].y & 0xffffu) * x0[2] + bf2f(qv[i].y >> 16) * x0[3]
                       + bf2f(qv[i].z & 0xffffu) * x1[0] + bf2f(qv[i].z >> 16) * x1[1] + bf2f(qv[i].w & 0xffffu) * x1[2] + bf2f(qv[i].w >> 16) * x1[3]; }
                if (a > v0) { v2 = v1; i2 = i1; v1 = v0; i1 = i0; v0 = a; i0 = n; } else if (a > v1) { v2 = v1; i2 = i1; v1 = a; i1 = n; } else if (a > v2) { v2 = a; i2 = n; } }
        }
        const int nsel = j < 3 ? j : 3;
#pragma unroll 1
        for (int n = 0; n < j; ++n) {
            const int r = (n == i0) ? 0 : ((n == i1) ? 1 : ((n == i2) ? 2 : 3));
            const bool sel = r < nsel;
            const unsigned long long mask = __ballot(sel);
            if (mask == 0ull) continue;
            unsigned base = 0u;
            if (lane == 0) base = __hip_atomic_fetch_add(CNT + bk * 16 + n, (unsigned)__popcll(mask), __ATOMIC_RELAXED, __HIP_MEMORY_SCOPE_AGENT);
            base = __builtin_amdgcn_readfirstlane(base);
            const unsigned pos = base + (unsigned)__popcll(mask & ((1ull << lane) - 1ull));
            if (sel) LIST[(size_t)(bk * 16 + n) * 16384 + pos] = ((unsigned)t << 4) | ((unsigned)hg << 2) | (unsigned)r;
        }
    }
    __syncthreads();
}
__device__ __forceinline__ void store_o(const St& st, bf16* op, float rl, int hi) {
#pragma unroll
    for (int g = 0; g < 4; ++g) { u32x2 a, b;
        a.x = cvtpk(st.o0[4 * g] * rl, st.o0[4 * g + 1] * rl); a.y = cvtpk(st.o0[4 * g + 2] * rl, st.o0[4 * g + 3] * rl);
        b.x = cvtpk(st.o1[4 * g] * rl, st.o1[4 * g + 1] * rl); b.y = cvtpk(st.o1[4 * g + 2] * rl, st.o1[4 * g + 3] * rl);
        *(u32x2*)(op + 8 * g + 4 * hi) = a; *(u32x2*)(op + 32 + 8 * g + 4 * hi) = b; }
}
__device__ __forceinline__ void moba_gather(const Frame& F, const Ptrs& P, int l) {
    const bf16* QM = (const bf16*)(P.ws + WS_QM); const bf16* KM = (const bf16*)(P.ws + WS_KM); const bf16* VMT = (const bf16*)(P.ws + WS_VMT);
    const unsigned* LIST = (const unsigned*)(P.ws + WS_LIST); unsigned* CNT = (unsigned*)(P.ws + WS_CTL) + CW_CNT + l * 128;
    bf16* PART = (bf16*)(P.ws + WS_PART); float* LSE = (float*)(P.ws + WS_LSE);
    const int lane = F.lane, r32 = lane & 31, hi = lane >> 5, w = F.wave;
    const int per = F.G >> 3;
    const int bk = F.vcu / per, loc = F.vcu % per;
    if (bk >= 8 || (F.vcu & 15) == 0) return;
    const int wg = loc - 1 - (loc > 16 ? 1 : 0), nwg = per - 2;
    const int b = bk >> 1, kvh = bk & 1;
    unsigned cnt = 0u;
    if (lane < 16) cnt = __hip_atomic_load(CNT + bk * 16 + lane, __ATOMIC_RELAXED, __HIP_MEMORY_SCOPE_AGENT);
    const int ns_l = (int)((cnt + 255u) >> 8);
    int pre = ns_l;
#pragma unroll
    for (int o = 1; o < 16; o <<= 1) { const int v = __shfl_up(pre, o); if (lane >= o) pre += v; }
    const int total = __shfl(pre, 15);
    const bf16* vt0 = VMT + (long)((b * 2 + kvh) * 64) * S;
    LAS unsigned char* ring = F.lds + RING_OFF;
    __syncthreads();
    int item = wg, n = 0, sub = 0;
    if (item < total) { const unsigned long long le = __ballot(lane < 16 && pre <= item); n = (int)__popcll(le); sub = item - ((n == 0) ? 0 : __shfl(pre, n - 1));
        img_load(F, ring, KM, (long)b * S + n * 256, kvh, vt0, n * 256); }
    int buf = 0;
#pragma unroll 1
    for (; item < total; item += nwg) {
        const int cn = (int)__shfl((int)cnt, n);
        const int ti = sub * 8 + w, idx = ti * 32 + r32; const bool tile_ok = ti * 32 < cn, valid = idx < cn;
        unsigned e = 0u; if (tile_ok) e = LIST[(size_t)(bk * 16 + n) * 16384 + (valid ? idx : ti * 32)];
        const int t = (int)(e >> 4), hg = (int)((e >> 2) & 3u), r = (int)(e & 3u), h = kvh * 4 + hg;
        const size_t row = (size_t)(b * S + t);
        bf16x8 qr[4]; loadq(qr, QM + row * 512 + h * 64 + 8 * hi);
        asm volatile("s_waitcnt vmcnt(0)" ::: "memory"); __syncthreads();
        const int cur_n = n; const LAS unsigned char* img = ring + buf * IMG_BYTES;
        const int nitem = item + nwg;
        if (nitem < total) { const unsigned long long le = __ballot(lane < 16 && pre <= nitem); n = (int)__popcll(le); sub = nitem - ((n == 0) ? 0 : __shfl(pre, n - 1));
            img_load(F, ring + (buf ^ 1) * IMG_BYTES, KM, (long)b * S + n * 256, kvh, vt0, n * 256); }
        buf ^= 1;
        if (tile_ok) {
            const float sl2 = moba_sl2(h);
            St st; st.o0 = f32x16{}; st.o1 = f32x16{}; st.m = -INFINITY; st.l = 0.f;
            const int kq = cur_n * 256 - t;
#pragma unroll 1
            for (int i = 0; i < 4; ++i) tile_lds<0, false>(st, qr, img, 64 * i, kq + 64 * i, sl2, true, 0, hi, r32);
            const float lt = st.l + __shfl_xor(st.l, 32);
            if (valid) { const size_t slot = (row * 8 + h) * 3 + r; store_o(st, PART + slot * 64, __builtin_amdgcn_rcpf(lt), hi); if (hi == 0) LSE[slot] = st.m + __builtin_amdgcn_logf(lt); }
        }
    }
    asm volatile("s_waitcnt vmcnt(0)" ::: "memory"); __syncthreads();
}
__device__ __forceinline__ void moba_own(const Frame& F, const Ptrs& P) {
    bf16* QM = (bf16*)(P.ws + WS_QM); const bf16* KM = (const bf16*)(P.ws + WS_KM); const bf16* VMT = (const bf16*)(P.ws + WS_VMT);
    const bf16* PART = (const bf16*)(P.ws + WS_PART); const float* LSE = (const float*)(P.ws + WS_LSE);
    const int lane = F.lane, r32 = lane & 31, hi = lane >> 5, w = F.wave;
    for (int L = F.vcu; L < 512; L += F.G) {
        const int bk = (L & 255) >> 5, pi = L & 31, qc = (L < 256) ? pi : 63 - pi, b = bk >> 1, kvh = bk & 1, h = kvh * 4 + (w >> 1);
        const float sl2 = moba_sl2(h);
        const int t0 = qc * 64 + (w & 1) * 32, j = t0 >> 8, q = t0 + r32;
        const size_t row = (size_t)(b * S + q);
        bf16* qrow = QM + row * 512 + h * 64;
        bf16x8 qr[4]; loadq(qr, qrow + 8 * hi);
        St st; st.o0 = f32x16{}; st.o1 = f32x16{}; st.m = -INFINITY; st.l = 0.f;
        const bf16* kbase = KM + ((long)(b * S + r32)) * 128 + kvh * 64 + 8 * hi;
        const bf16* vbase = VMT + ((long)((b * 2 + kvh) * 64 + r32)) * S + 4 * hi;
        const int nti = ((t0 - j * 256) >> 6) + 1;
#pragma unroll 1
        for (int it = 0; it < nti; ++it) { const int key0 = j * 256 + 64 * it; bf16x8 kf[8]; loadk(kf, kbase + (long)key0 * 128); tile<2>(st, qr, kf, vbase + key0, key0 - q, sl2, true, 0, hi); }
        const float lt = st.l + __shfl_xor(st.l, 32);
        const float lse_own = st.m + __builtin_amdgcn_logf(lt);
        const int nsel = j < 3 ? j : 3;
        const size_t slot0 = (row * 8 + h) * 3;
        float ls[3]; float M = lse_own;
#pragma unroll
        for (int r = 0; r < 3; ++r) { ls[r] = (r < nsel) ? LSE[slot0 + r] : -INFINITY; M = fmaxf(M, ls[r]); }
        const float w_own = __builtin_amdgcn_exp2f(lse_own - M); float W = w_own; const float s_own = w_own * __builtin_amdgcn_rcpf(lt);
#pragma unroll
        for (int rr = 0; rr < 16; ++rr) { st.o0[rr] *= s_own; st.o1[rr] *= s_own; }
#pragma unroll
        for (int r = 0; r < 3; ++r) { if (r < nsel) { const float wr_ = __builtin_amdgcn_exp2f(ls[r] - M); W += wr_; const bf16* pp = PART + (slot0 + r) * 64 + 4 * hi;
#pragma unroll
            for (int g = 0; g < 4; ++g) { const u32x2 a = *(const u32x2*)(pp + 8 * g), c = *(const u32x2*)(pp + 32 + 8 * g);
                st.o0[4 * g] += wr_ * bf2f(a.x & 0xffffu); st.o0[4 * g + 1] += wr_ * bf2f(a.x >> 16); st.o0[4 * g + 2] += wr_ * bf2f(a.y & 0xffffu); st.o0[4 * g + 3] += wr_ * bf2f(a.y >> 16);
                st.o1[4 * g] += wr_ * bf2f(c.x & 0xffffu); st.o1[4 * g + 1] += wr_ * bf2f(c.x >> 16); st.o1[4 * g + 2] += wr_ * bf2f(c.y & 0xffffu); st.o1[4 * g + 3] += wr_ * bf2f(c.y >> 16); } } }
        store_o(st, qrow, __builtin_amdgcn_rcpf(W), hi);
    }
}
}
#ifndef PH_MASK
#define PH_MASK 0xFFF
#endif
#define PH_ON(k) (((PH_MASK) >> (k)) & 1)
constexpr int NPH = 10, PH_FINAL = DEPTH * NPH, PH_TOTAL = PH_FINAL + 1;
struct Args { Ptrs P; int ph_lo, ph_hi, use_bar, sub; };
__global__ void __launch_bounds__(NWAVES * 64, 2) mk_fwd(Args args) {
    extern __shared__ __attribute__((aligned(16))) unsigned char lds[];
    Frame F;
    F.lds = (LAS unsigned char*)lds;
    F.tid = threadIdx.x; F.lane = F.tid & 63; F.wave = __builtin_amdgcn_readfirstlane(F.tid >> 6);
    F.G = gridDim.x; { const int bx = blockIdx.x; F.vcu = (F.G % 8 == 0) ? (bx % 8) * (F.G / 8) + bx / 8 : bx; }
    const Ptrs& P = args.P;
    unsigned char* ws0 = P.ws;
    volatile LAS unsigned* MISC = (volatile LAS unsigned*)(F.lds + MISC_OFF);
    for (int u = F.tid; u < (LDS_BYTES - LDSCTL_OFF) / 4; u += NWAVES * 64) ((LAS unsigned*)(F.lds + LDSCTL_OFF))[u] = 0u;
    __syncthreads();
    XcdBarrier bar; bar.bar = (unsigned*)(ws0 + WS_CTL) + CW_BAR; bar.x = 0; bar.st = nullptr;
    if (args.use_bar) bar = xcd_barrier_post((unsigned*)(ws0 + WS_CTL) + CW_BAR, MISC + 8);
    LAS unsigned char* ring = F.lds + RING_OFF;
    const int bx = (int)blockIdx.x;
    for (int ph = args.ph_lo; ph < args.ph_hi; ++ph) {
#if defined(BENCH_SET)
        const bool bench = ph >= PH_TOTAL; const int l = bench ? DEPTH - 1 : ph / NPH, k = bench ? (ph - PH_TOTAL) % NPH : ph % NPH;
        if (bench && !(((BENCH_SET) >> k) & 1)) continue;
        const int lc = bench ? DEPTH + (ph - PH_TOTAL) / NPH : l;
#else
        const bool bench = false; const int l = ph / NPH, k = ph % NPH; const int lc = l;
#endif
        unsigned char* ws = ws0; asm volatile("" : "+s"(ws));
        F.tid = threadIdx.x; asm volatile("" : "+v"(F.tid)); F.lane = F.tid & 63;
        if (ph == PH_FINAL && !bench) { if (PH_ON(10)) final_pass(F, P);
        }
        else if (k == 0 && PH_ON(0)) { conv_layer(F, P, l); ssm_mats(F, P, l); if (l == 0) xb_pass(F, P); __syncthreads(); }
        else if (k == 1 && PH_ON(1)) {
            pg8::SrcStd g{(const char*)(ws + WS_XN), (const char*)(ws + WS_WIN), DM}; pg8::StaticOrder So; So.init(T, DIN, F.G, bx);
            pg8::EpiInProj E{(bf16*)(ws + WS_QA), (bf16*)(ws + WS_KA), (bf16*)(ws + WS_VAT), (bf16*)(ws + WS_U), (bf16*)(ws + WS_QM), (bf16*)(ws + WS_KM), (bf16*)(ws + WS_VMT), (bf16*)(ws + WS_GATES), (float*)(ws + WS_KMP), (const float*)(ws + WS_SSQ)};
            pg8::gemm_phase<pg8::EpiInProj, pg8::SrcStd, pg8::StaticOrder, true>(ring, g, So, E);
        }
        else if (k == 2 && PH_ON(2)) {
            if (args.sub & 1) { pg8::SrcSsm<false> g{(const char*)(ws + WS_U), nullptr, (const char*)(ws + WS_SEND)}; pg8::SsmOrder So{F.G, bx}; pg8::EpiSsmEnd E{(float*)(ws + WS_HEND)};
                pg8::gemm_phase<pg8::EpiSsmEnd, pg8::SrcSsm<false>, pg8::SsmOrder, true>(ring, g, So, E); }
            if (args.sub & 2) { att::swa_phase(F, P, l); att::moba_select(F, P, lc); }
        }
        else if (k == 3 && PH_ON(3)) {
#ifndef NO_CARRY
            if (args.sub & 1) ssm_carry(F, P, l);
#endif
#ifndef NO_MOBA
            if (args.sub & 2) att::moba_gather(F, P, lc);
#endif
        }
        else if (k == 4 && PH_ON(4)) {
            pg8::SrcSsm<true> g{(const char*)(ws + WS_U), (const char*)(ws + WS_HINIT), (const char*)(ws + WS_SMAIN)}; pg8::SsmOrder So{F.G, bx}; pg8::EpiSsmMain E{(bf16*)(ws + WS_U)};
            pg8::gemm_phase<pg8::EpiSsmMain, pg8::SrcSsm<true>, pg8::SsmOrder, true>(ring, g, So, E);
            att::moba_own(F, P);
        }
        else if (k == 5 && PH_ON(5)) {
            pg8::SrcStd g{(const char*)(ws + WS_U), (const char*)(ws + WS_WGLU), 512}; pg8::StaticOrder So; So.init(T, 1024, F.G, bx); pg8::EpiGlu E{(bf16*)(ws + WS_A1)};
            pg8::gemm_phase<pg8::EpiGlu, pg8::SrcStd, pg8::StaticOrder, true>(ring, g, So, E);
        }
        else if (k == 6 && PH_ON(6)) {
            pg8::SrcMerge g{(const char*)(ws + WS_QA), (const char*)(ws + WS_A1), (const char*)(ws + WS_QM), (const char*)(ws + WS_WMRG)}; pg8::StaticOrder So; So.init(T, DM, F.G, bx);
            pg8::EpiMerge E{(const bf16*)(ws + WS_GATES), (bf16*)(ws + WS_MIXED)};
            pg8::gemm_phase<pg8::EpiMerge, pg8::SrcMerge, pg8::StaticOrder, true>(ring, g, So, E);
        }
        else if ((k == 7 || k == 9) && PH_ON(7)) {
            const bool f2 = (k == 9);
            pg8::SrcStd g{(const char*)(ws + (f2 ? WS_H1 : WS_MIXED)), (const char*)(ws + (f2 ? WS_WFF2 : WS_WOUT)), f2 ? DFF : DM}; pg8::StaticOrder So; So.init(T, DM, F.G, bx); pg8::EpiResid E{bench ? (float*)(ws + WS_QA) : P.x, (bf16*)(ws + (bench ? WS_KM : WS_XN)), (float*)(ws + WS_SSQ)};
            pg8::gemm_phase<pg8::EpiResid, pg8::SrcStd, pg8::StaticOrder, true>(ring, g, So, E);
        }
        else if (k == 8 && PH_ON(8)) {
            pg8::SrcStd g{(const char*)(ws + WS_XN), (const char*)(ws + WS_WFF1), DM}; pg8::StaticOrder So; So.init(T, DFF, F.G, bx); pg8::EpiFfn1 E{(bf16*)(ws + WS_H1), (const float*)(ws + WS_SSQ)};
            pg8::gemm_phase<pg8::EpiFfn1, pg8::SrcStd, pg8::StaticOrder, true>(ring, g, So, E);
        }
        if (ph + 1 < args.ph_hi) { if (args.use_bar) xcd_barrier(bar); else __syncthreads(); }
    }
}
extern "C" void kernel_launch(void* const* d_in, const int* in_sizes, int n_in, void* d_out, int out_size, void* d_ws, size_t ws_size, hipStream_t stream) {
    static int grid = 0;
    if (grid == 0) {
        if (n_in != 21 || out_size != T * DM || ws_size < WS_END) { fprintf(stderr, "kernel_launch: unexpected shapes (n_in %d out %d ws %zu)\n", n_in, out_size, ws_size); grid = -1; return; }
        int dev = 0, cus = 0;
        if (hipGetDevice(&dev) != hipSuccess || hipDeviceGetAttribute(&cus, hipDeviceAttributeMultiprocessorCount, dev) != hipSuccess) { grid = -1; return; }
        if (hipFuncSetAttribute((const void*)mk_fwd, hipFuncAttributeMaxDynamicSharedMemorySize, LDS_BYTES) != hipSuccess) { fprintf(stderr, "kernel_launch: hipFuncSetAttribute failed\n"); grid = -1; return; }
        int per_cu = 0;
        if (hipOccupancyMaxActiveBlocksPerMultiprocessor(&per_cu, (const void*)mk_fwd, NWAVES * 64, LDS_BYTES) != hipSuccess || per_cu < 1) { fprintf(stderr, "kernel_launch: occupancy query reports %d workgroups per CU\n", per_cu); (void)hipGetLastError(); }
        grid = cus;
    }
    if (grid < 0) return;
    (void)hipMemsetAsync((char*)d_ws + WS_CTL, 0, CTL_ZERO_BYTES, stream);
    Args a{};
    const float** pp = (const float**)&a.P; for (int i = 0; i < 21; ++i) pp[i] = (const float*)d_in[i];
    a.P.x = (float*)d_out; a.P.ws = (unsigned char*)d_ws;
    #if defined(BENCH_SET)
    a.ph_lo = 0; a.ph_hi = PH_TOTAL + NPH * (BENCH_REPS);
#else
    a.ph_lo = 0; a.ph_hi = PH_TOTAL;
#endif
    a.use_bar = 1; a.sub = 3;
    hipLaunchKernelGGL(mk_fwd, dim3(grid), dim3(NWAVES * 64), LDS_BYTES, stream, a);
}
```

```cpp
#include <hip/hip_runtime.h>
#include <cstdio>
#include <cstdint>

constexpr int NB = 4, S = 4096, T = NB * S, DM = 1024, DEPTH = 4, DIN = 5120, DFF = 4096;
constexpr float LOG2E = 1.4426950408889634f;
constexpr float C2 = 0.125f * LOG2E;
constexpr float NORM_EPS = 1e-6f;
constexpr int SSM_L = 16;
constexpr int SSM_KM = SSM_L * 16 + 128;
constexpr int SSM_KE = SSM_L * 16;
constexpr int NCH = T / SSM_L;

constexpr size_t MiB = 1u << 20;
constexpr size_t WS_CTL = 0, CTL_ZERO_BYTES = 1 * MiB;
constexpr size_t WS_WIN = 1 * MiB, WS_WGLU = 11 * MiB, WS_WMRG = 12 * MiB, WS_WOUT = 15 * MiB, WS_WFF1 = 17 * MiB, WS_WFF2 = 25 * MiB;
constexpr size_t WS_SMAIN = 33 * MiB, WS_SEND = 39 * MiB, WS_KMP = 43 * MiB;
constexpr size_t WS_XN = 44 * MiB;
constexpr size_t WS_QA = 76 * MiB, WS_KA = 92 * MiB, WS_VAT = 96 * MiB, WS_U = 100 * MiB, WS_QM = 116 * MiB, WS_KM = 132 * MiB, WS_VMT = 136 * MiB, WS_GATES = 140 * MiB;
constexpr size_t WS_H1 = 76 * MiB;
constexpr size_t WS_LIST = WS_XN, WS_LSE = WS_XN + 8 * MiB;
constexpr size_t WS_YS = 284 * MiB;
constexpr size_t WS_PART = 236 * MiB;
constexpr size_t WS_A1 = 236 * MiB, WS_MIXED = 252 * MiB, WS_HEND = 284 * MiB, WS_HINIT = 300 * MiB, WS_SSQ = 308 * MiB, WS_END = 309 * MiB;

typedef unsigned short bf16;
typedef short bf16x8 __attribute__((ext_vector_type(8)));
typedef short s16x4 __attribute__((ext_vector_type(4)));
typedef float f32x4 __attribute__((ext_vector_type(4)));
typedef float f32x16 __attribute__((ext_vector_type(16)));
typedef unsigned u32x4 __attribute__((ext_vector_type(4)));
typedef unsigned u32x2 __attribute__((ext_vector_type(2)));

__host__ __device__ __forceinline__ unsigned f2bf(float f) { unsigned u = __builtin_bit_cast(unsigned, f); return (u + 0x7fffu + ((u >> 16) & 1u)) >> 16; }
__host__ __device__ __forceinline__ float bf2f(unsigned b) { return __builtin_bit_cast(float, b << 16); }
typedef float f32x2_t __attribute__((ext_vector_type(2))); typedef __bf16 bf16x2_t __attribute__((ext_vector_type(2)));
__device__ __forceinline__ unsigned cvtpk_s(float lo, float hi) { f32x2_t v = {lo, hi}; bf16x2_t b = __builtin_convertvector(v, bf16x2_t); return __builtin_bit_cast(unsigned, b); }
__device__ __forceinline__ unsigned pk2(float lo, float hi) { return f2bf(lo) | (f2bf(hi) << 16); }
__device__ __forceinline__ float rbf(float f) { return bf2f(f2bf(f)); }
__device__ __forceinline__ float sigmoid_fast(float x) { return __builtin_amdgcn_rcpf(1.f + __builtin_amdgcn_exp2f(-x * LOG2E)); }
__device__ __forceinline__ float gelu_tanh(float x) {
    const float c2 = 2.f * 0.7978845608028654f; const float t = c2 * (x + 0.044715f * x * x * x); return x * sigmoid_fast(t); }
__device__ __forceinline__ float wave_sum(float v) {
#pragma unroll
    for (int o = 1; o < 64; o <<= 1) v += __shfl_xor(v, o);
    return v;
}
__device__ __forceinline__ float wave_max(float v) {
#pragma unroll
    for (int o = 1; o < 64; o <<= 1) v = fmaxf(v, __shfl_xor(v, o));
    return v;
}

struct Ptrs {
    const float *x_in, *norm_mix, *w_in, *sinks, *lam_re, *lam_im, *log_step, *b_re, *b_im, *c_re, *c_im, *d_skip, *w_glu, *w_o_swa, *w_o_ssm, *w_o_moba, *w_out, *norm_ffn, *w_ff1, *w_ff2, *norm_final;
    float* x;
    unsigned char* ws;
};
namespace pg8 {
#define PG8_LAS __attribute__((address_space(3)))
constexpr int BM = 256, BK = 64, HALF = 128, HTB = HALF * BK * 2  , STAGE_BYTES = 8 * HTB, NXCD = 8, WGM = 8;

__host__ __device__ __forceinline__ int lds_byte(int r, int c) { const int st = (r >> 4) * 2 + (c >> 5), rr = r & 15, cc = c & 31, ob = rr * 64 + cc * 2; return st * 1024 + (ob ^ (((ob >> 9) & 1) << 5)); }
__host__ __device__ __forceinline__ void stage_rc(int b, int& R, int& C) { const int st = b / 1024, sb = b % 1024, swz = sb ^ (((sb >> 9) & 1) << 5); R = (st >> 1) * 16 + swz / 64; C = (st & 1) * 32 + (swz % 64) / 2; }
__host__ __device__ __forceinline__ int perm32(int rho) { const int n = rho >> 4, i = rho & 15; return 8 * (i >> 2) + 4 * n + (i & 3); }

struct Unit { int pm, pn; };

struct StaticOrder {
    int nM, nN, nwg, G, c;
    __host__ __device__ void init(int M, int N, int G_, int c_) { nM = M / BM; nN = N / BM; nwg = nM * nN; G = G_; c = c_; }
    __host__ __device__ bool next(int i, Unit& u) const {
        const long L = (long)i * G + c; if (L >= nwg) return false;
        int wgid = (int)L; { const int q = nwg / NXCD, r = nwg % NXCD, xcd = wgid % NXCD, off = wgid / NXCD; wgid = (xcd < r ? xcd * (q + 1) : r * (q + 1) + (xcd - r) * q) + off; }
        const int nig = WGM * nN, gid = wgid / nig, fm = gid * WGM, gsz = (nM - fm) < WGM ? (nM - fm) : WGM;
        u.pm = fm + ((wgid % nig) % gsz); u.pn = (wgid % nig) / gsz; return true;
    }
};
struct SsmOrder {
    int G, c;
    __host__ __device__ bool next(int i, Unit& u) const { const int L = i * G + c; if (L >= 128) return false; u.pn = L >> 2; u.pm = L & 3; return true; }
};

struct SrcStd {
    static constexpr bool TWO_VAR = false;
    const char* A; const char* Bt; int K;
    __device__ __forceinline__ int nt() const { return K / BK; }
    __device__ __forceinline__ const char* a(const Unit& u, int kt, int h) const { return A + ((size_t)(u.pm * BM + h * HALF) * K + (size_t)kt * BK) * 2; }
    __device__ __forceinline__ const char* b(const Unit& u, int kt, int h) const { return Bt + ((size_t)(u.pn * BM + h * HALF) * K + (size_t)kt * BK) * 2; }
    __device__ __forceinline__ unsigned voffA(int R, int C, int) const { return (unsigned)(R * K + C) * 2u; }
    __device__ __forceinline__ unsigned voffB(int R, int C) const { return (unsigned)(R * K + C) * 2u; }
    __device__ __forceinline__ int avar(int) const { return 0; }
};
struct SrcMerge {
    static constexpr bool TWO_VAR = false;
    const char* A0; const char* A1; const char* A2; const char* Bt;
    __device__ __forceinline__ int nt() const { return 24; }
    __device__ __forceinline__ const char* a(const Unit& u, int kt, int h) const { const int sg = kt >> 3; const char* p = sg == 0 ? A0 : (sg == 1 ? A1 : A2); return p + ((size_t)(u.pm * BM + h * HALF) * 512 + (size_t)(kt & 7) * BK) * 2; }
    __device__ __forceinline__ const char* b(const Unit& u, int kt, int h) const { return Bt + ((size_t)(u.pn * BM + h * HALF) * 1536 + (size_t)kt * BK) * 2; }
    __device__ __forceinline__ unsigned voffA(int R, int C, int) const { return (unsigned)(R * 512 + C) * 2u; }
    __device__ __forceinline__ unsigned voffB(int R, int C) const { return (unsigned)(R * 1536 + C) * 2u; }
    __device__ __forceinline__ int avar(int) const { return 0; }
};
template <bool MAIN> struct SrcSsm {
    static constexpr bool TWO_VAR = MAIN; static constexpr int KTOT = MAIN ? SSM_KM : SSM_KE;
    const char* U; const char* HI; const char* Bt;
    __device__ __forceinline__ int nt() const { return KTOT / BK; }
    __device__ __forceinline__ const char* a(const Unit& u, int kt, int h) const {
        if (!MAIN || kt < 4) return U + ((size_t)(u.pn * NCH + u.pm * BM + h * HALF) * 256 + (size_t)kt * BK) * 2;
        return HI + ((size_t)(u.pn * NCH + u.pm * BM + h * HALF) * 128 + (size_t)(kt - 4) * BK) * 2; }
    __device__ __forceinline__ const char* b(const Unit& u, int kt, int h) const { return Bt + ((size_t)(u.pn * 256 + h * HALF) * KTOT + (size_t)kt * BK) * 2; }
    __device__ __forceinline__ unsigned voffA(int R, int C, int var) const { return var ? (unsigned)(R * 128 + C) * 2u : (unsigned)(R * 256 + C) * 2u; }
    __device__ __forceinline__ unsigned voffB(int R, int C) const { return (unsigned)(R * KTOT + C) * 2u; }
    __device__ __forceinline__ int avar(int kt) const { return (MAIN && kt >= 4) ? 1 : 0; }
};

typedef f32x4 Acc[2][2][4][2];
__device__ __forceinline__ unsigned cvt_pk_bf16(float lo, float hi) { return cvtpk_s(lo, hi); }
__device__ __forceinline__ u32x4 pack8(f32x4 v0, f32x4 v1) { u32x4 w; w.x = cvt_pk_bf16(v0[0], v0[1]); w.y = cvt_pk_bf16(v0[2], v0[3]); w.z = cvt_pk_bf16(v1[0], v1[1]); w.w = cvt_pk_bf16(v1[2], v1[3]); return w; }
__device__ __forceinline__ f32x4 sig4(f32x4 v) { f32x4 o; o[0] = sigmoid_fast(v[0]); o[1] = sigmoid_fast(v[1]); o[2] = sigmoid_fast(v[2]); o[3] = sigmoid_fast(v[3]); return o; }
__device__ __forceinline__ f32x4 unpk_lo(u32x4 w) { f32x4 o; o[0] = bf2f(w.x & 0xffffu); o[1] = bf2f(w.x >> 16); o[2] = bf2f(w.y & 0xffffu); o[3] = bf2f(w.y >> 16); return o; }
__device__ __forceinline__ f32x4 unpk_hi(u32x4 w) { f32x4 o; o[0] = bf2f(w.z & 0xffffu); o[1] = bf2f(w.z >> 16); o[2] = bf2f(w.w & 0xffffu); o[3] = bf2f(w.w >> 16); return o; }
__device__ __forceinline__ f32x4 rcp4(f32x4 v) { f32x4 o; o[0] = __builtin_amdgcn_rcpf(v[0]); o[1] = __builtin_amdgcn_rcpf(v[1]); o[2] = __builtin_amdgcn_rcpf(v[2]); o[3] = __builtin_amdgcn_rcpf(v[3]); return o; }

typedef float RowScale[2][4];
struct RinvTab { const PG8_LAS float* tab; };
__device__ __forceinline__ void rinv_build(PG8_LAS float* tab, const float* SSQ, int pm0) {
    if (threadIdx.x < 256) { const f32x4* sp = (const f32x4*)(SSQ + (size_t)(pm0 * BM + threadIdx.x) * 16); const f32x4 s = (sp[0] + sp[1]) + (sp[2] + sp[3]); tab[threadIdx.x] = rsqrtf(((s[0] + s[1]) + (s[2] + s[3])) * (1.f / DM) + NORM_EPS); }
    __syncthreads();
}
__device__ __forceinline__ void row_rinv(RowScale& ri, const RinvTab& rt, int pm, int r0  ) {
#pragma unroll
    for (int ai = 0; ai < 2; ++ai)
#pragma unroll
        for (int m = 0; m < 4; ++m) ri[ai][m] = rt.tab[r0 + ai * HALF + m * 16];
}
template <int MODE> __device__ __forceinline__ void st_half_bf16(const Acc& acc, int bj, bf16* base, int ldc, float sc, const RowScale* ri = nullptr) {
#pragma unroll
    for (int ai = 0; ai < 2; ++ai)
#pragma unroll
        for (int m = 0; m < 4; ++m) { f32x4 v0 = acc[ai][bj][m][0], v1 = acc[ai][bj][m][1];
            if (ri) { v0 = v0 * (*ri)[ai][m]; v1 = v1 * (*ri)[ai][m]; }
            if (MODE == 0) { v0 = v0 * sc; v1 = v1 * sc; }
            else if (MODE == 1) { v0 = sig4(v0); v1 = sig4(v1); }
            else if (MODE == 2) { v0 = __builtin_elementwise_max(v0, (f32x4){0.f, 0.f, 0.f, 0.f}); v1 = __builtin_elementwise_max(v1, (f32x4){0.f, 0.f, 0.f, 0.f}); v0 = v0 * v0; v1 = v1 * v1; }
            else { v0[0] = gelu_tanh(v0[0]); v0[1] = gelu_tanh(v0[1]); v0[2] = gelu_tanh(v0[2]); v0[3] = gelu_tanh(v0[3]); v1[0] = gelu_tanh(v1[0]); v1[1] = gelu_tanh(v1[1]); v1[2] = gelu_tanh(v1[2]); v1[3] = gelu_tanh(v1[3]); }
            *(u32x4*)(base + (size_t)(ai * HALF + m * 16) * ldc) = pack8(v0, v1); }
}
__device__ __forceinline__ void st_half_vt(const Acc& acc, int bj, bf16* VT, int b, int s0, int cc, const RowScale& ri) {
    bf16* base = VT + ((size_t)(b * 2 + (cc >> 6)) * 64 + (cc & 63)) * S + s0;
#pragma unroll
    for (int ai = 0; ai < 2; ++ai)
#pragma unroll
        for (int m = 0; m < 4; ++m)
#pragma unroll
            for (int n = 0; n < 2; ++n)
#pragma unroll
                for (int e = 0; e < 4; ++e) base[(size_t)(4 * n + e) * S + ai * HALF + m * 16] = (bf16)f2bf(acc[ai][bj][m][n][e] * ri[ai][m]);
}

struct EpiInProj {
    static constexpr bool PERM = true, AFTER_DRAIN = false, HAS_MID = false;
    unsigned char* ws; RinvTab RT;
    __device__ __forceinline__ void operator()(const Acc& acc, const Unit& u, int wr, int wc, int fr, int fq) const {
        bf16 *QA = (bf16*)(ws + WS_QA), *KA = (bf16*)(ws + WS_KA), *VAT = (bf16*)(ws + WS_VAT), *U = (bf16*)(ws + WS_U), *QM = (bf16*)(ws + WS_QM), *KM = (bf16*)(ws + WS_KM), *VMT = (bf16*)(ws + WS_VMT), *GATES = (bf16*)(ws + WS_GATES); float* KMP = (float*)(ws + WS_KMP);
        const int row = u.pm * BM + wr * 64 + fr, cc = wc * 32 + 8 * fq;
        RowScale ri; row_rinv(ri, RT, u.pm, wr * 64 + fr);
#pragma unroll
        for (int bj = 0; bj < 2; ++bj) {
            const int hc = u.pn * 2 + bj;
            if (hc < 4) st_half_bf16<0>(acc, bj, QA + (size_t)row * 512 + hc * 128 + cc, 512, C2, &ri);
            else if (hc == 4) st_half_bf16<0>(acc, bj, KA + (size_t)row * 128 + cc, 128, 1.f, &ri);
            else if (hc == 5) st_half_vt(acc, bj, VAT, row / S, row % S, cc, ri);
            else if (hc < 10) { const int ucol = (hc - 6) * 128 + cc;
                st_half_bf16<0>(acc, bj, U + ((size_t)(ucol >> 4) * NCH + ((u.pm * BM + wr * 64) >> 4)) * 256 + fr * 16 + (ucol & 15), 16, 1.f, &ri); }
            else if (hc < 14) st_half_bf16<0>(acc, bj, QM + (size_t)row * 512 + (hc - 10) * 128 + cc, 512, C2, &ri);
            else if (hc == 14) {
                st_half_bf16<0>(acc, bj, KM + (size_t)row * 128 + cc, 128, 1.f, &ri);
                f32x4 c0 = {0.f, 0.f, 0.f, 0.f}, c1 = {0.f, 0.f, 0.f, 0.f};
#pragma unroll
                for (int ai = 0; ai < 2; ++ai)
#pragma unroll
                    for (int m = 0; m < 4; ++m) { c0 += acc[ai][bj][m][0] * ri[ai][m]; c1 += acc[ai][bj][m][1] * ri[ai][m]; }
#pragma unroll
                for (int o = 1; o < 16; o <<= 1)
#pragma unroll
                    for (int e = 0; e < 4; ++e) { c0[e] += __shfl_xor(c0[e], o); c1[e] += __shfl_xor(c1[e], o); }
                if (fr == 0) { float* kp = KMP + (size_t)(wr * 64 + u.pm) * 128 + cc; *(f32x4*)kp = c0; *(f32x4*)(kp + 4) = c1; }
            }
            else if (hc == 15) st_half_vt(acc, bj, VMT, row / S, row % S, cc, ri);
            else st_half_bf16<1>(acc, bj, GATES + (size_t)row * 3072 + (hc - 16) * 128 + cc, 3072, 1.f, &ri);
        }
    }
};
struct EpiFfn1 {
    static constexpr bool PERM = true, AFTER_DRAIN = false, HAS_MID = false;
    bf16* H1; RinvTab RT;
    __device__ __forceinline__ void operator()(const Acc& acc, const Unit& u, int wr, int wc, int fr, int fq) const {
        bf16* base = H1 + (size_t)(u.pm * BM + wr * 64 + fr) * DFF + u.pn * BM + wc * 32 + 8 * fq;
        RowScale ri; row_rinv(ri, RT, u.pm, wr * 64 + fr);
        st_half_bf16<2>(acc, 0, base, DFF, 1.f, &ri); st_half_bf16<2>(acc, 1, base + HALF, DFF, 1.f, &ri);
    }
};
struct EpiGlu {
    static constexpr bool PERM = true, AFTER_DRAIN = false, HAS_MID = false;
    bf16* A1;
    __device__ __forceinline__ void operator()(const Acc& acc, const Unit& u, int wr, int wc, int fr, int fq) const {
        bf16* base = A1 + (size_t)(u.pm * BM + wr * 64 + fr) * 512 + u.pn * 128 + wc * 32 + 8 * fq;
#pragma unroll
        for (int ai = 0; ai < 2; ++ai)
#pragma unroll
            for (int m = 0; m < 4; ++m) *(u32x4*)(base + (size_t)(ai * HALF + m * 16) * 512) = pack8(acc[ai][0][m][0] * sig4(acc[ai][1][m][0]), acc[ai][0][m][1] * sig4(acc[ai][1][m][1]));
    }
};
struct EpiMerge {
    static constexpr bool PERM = true, AFTER_DRAIN = false, HAS_MID = true;
    const bf16* GATES; bf16* MIXED;
    __device__ __forceinline__ void mid(Acc& acc, const Unit& u, int t, int wr, int wc, int fr, int fq) const {
        if (t != 8 && t != 16) return;
        const bf16* g = GATES + (size_t)(u.pm * BM + wr * 64 + fr) * 3072 + (t == 8 ? 0 : 1024) + u.pn * BM + wc * 32 + 8 * fq;
#pragma unroll
        for (int ai = 0; ai < 2; ++ai)
#pragma unroll
            for (int m = 0; m < 4; ++m)
#pragma unroll
                for (int bj = 0; bj < 2; ++bj) { const bf16* gp = g + (size_t)(ai * HALF + m * 16) * 3072 + bj * HALF; const u32x4 num = *(const u32x4*)gp, den = *(const u32x4*)(gp + 1024);
                    acc[ai][bj][m][0] = acc[ai][bj][m][0] * (unpk_lo(num) * rcp4(unpk_lo(den))); acc[ai][bj][m][1] = acc[ai][bj][m][1] * (unpk_hi(num) * rcp4(unpk_hi(den))); }
    }
    __device__ __forceinline__ void operator()(const Acc& acc, const Unit& u, int wr, int wc, int fr, int fq) const {
        const size_t ro = (size_t)(u.pm * BM + wr * 64 + fr); const int co = u.pn * BM + wc * 32 + 8 * fq;
#pragma unroll
        for (int ai = 0; ai < 2; ++ai)
#pragma unroll
            for (int m = 0; m < 4; ++m)
#pragma unroll
                for (int bj = 0; bj < 2; ++bj) { const size_t r = ro + ai * HALF + m * 16; const u32x4 g2 = *(const u32x4*)(GATES + r * 3072 + 2048 + co + bj * HALF);
                    *(u32x4*)(MIXED + r * DM + co + bj * HALF) = pack8(acc[ai][bj][m][0] * unpk_lo(g2), acc[ai][bj][m][1] * unpk_hi(g2)); }
    }
};
struct EpiResid {
    static constexpr bool PERM = false, AFTER_DRAIN = false, HAS_MID = false;
    float* X; bf16* XB; float* SSQ;
    __device__ __forceinline__ void operator()(const Acc& acc, const Unit& u, int wr, int wc, int fr, int fq) const {
        const size_t row0 = (size_t)(u.pm * BM + wr * 64 + fr); const int col0 = u.pn * BM + wc * 32 + 4 * fq;
#pragma unroll
        for (int ai = 0; ai < 2; ++ai)
#pragma unroll
            for (int m = 0; m < 4; ++m) { const size_t r = row0 + ai * HALF + m * 16; float ss = 0.f;
#pragma unroll
                for (int bj = 0; bj < 2; ++bj)
#pragma unroll
                    for (int n = 0; n < 2; ++n) { f32x4* p = (f32x4*)(X + r * DM + col0 + bj * HALF + n * 16); const f32x4 v = *p + acc[ai][bj][m][n]; *p = v;
                        ss += (v[0] * v[0] + v[1] * v[1]) + (v[2] * v[2] + v[3] * v[3]);
                        u32x2 w; w.x = cvt_pk_bf16(v[0], v[1]); w.y = cvt_pk_bf16(v[2], v[3]); *(u32x2*)(XB + r * DM + col0 + bj * HALF + n * 16) = w; }
                ss += __shfl_xor(ss, 16); ss += __shfl_xor(ss, 32);
                if (fq == 0) SSQ[r * 16 + u.pn * 4 + wc] = ss; }
    }
};
struct EpiSsmEnd {
    static constexpr bool PERM = false, AFTER_DRAIN = false, HAS_MID = false;
    float* HEND;
    __device__ __forceinline__ void operator()(const Acc& acc, const Unit& u, int wr, int wc, int fr, int fq) const {
        float* base = HEND + ((size_t)u.pn * NCH + u.pm * BM + wr * 64 + fr) * 128 + wc * 32 + 4 * fq;
#pragma unroll
        for (int ai = 0; ai < 2; ++ai)
#pragma unroll
            for (int m = 0; m < 4; ++m)
#pragma unroll
                for (int n = 0; n < 2; ++n) *(f32x4*)(base + (size_t)(ai * HALF + m * 16) * 128 + n * 16) = acc[ai][0][m][n];
    }
};
struct EpiSsmMain {
    static constexpr bool PERM = true, AFTER_DRAIN = false, HAS_MID = false;
    bf16* YS;
    __device__ __forceinline__ void operator()(const Acc& acc, const Unit& u, int wr, int wc, int fr, int fq) const {
        const int mrow = u.pm * BM + wr * 64 + fr;
#pragma unroll
        for (int bj = 0; bj < 2; ++bj) { const int s = 8 * bj + 2 * wc + (fq >> 1);
            bf16* base = YS + ((size_t)mrow * 16 + s) * 512 + u.pn * 16 + 8 * (fq & 1);
            st_half_bf16<3>(acc, bj, base, 16 * 512, 1.f); }
    }
};

template <class Epi, class Src, class Sched, bool ALIGN_EPI>
__device__ __forceinline__ void gemm_phase(PG8_LAS unsigned char* lds, const Src g, const Sched& S, const Epi& E) {
    int tid_ = threadIdx.x; asm volatile("" : "+v"(tid_));
    const int tid = tid_, wid = __builtin_amdgcn_readfirstlane(tid >> 6), lane = tid & 63, wr = wid >> 2, wc = wid & 3, fr = lane & 15, fq = lane >> 4;
    const int nt = g.nt();
    unsigned voffA[2], voffA2[2], voffB[2];
#pragma unroll
    for (int i = 0; i < 2; ++i) { int R, C; stage_rc(tid * 16 + i * 8192, R, C); const int Rb = Epi::PERM ? ((R & ~31) + perm32(R & 31)) : R;
        voffA[i] = g.voffA(R, C, 0); voffA2[i] = Src::TWO_VAR ? g.voffA(R, C, 1) : 0u; voffB[i] = g.voffB(Rb, C); }
    const unsigned ldsw = (unsigned)wid * 1024u;
    const int aoff = lds_byte(wr * 64 + fr, fq * 8), boff = lds_byte(wc * 32 + fr, fq * 8);
#define PG8_SA(b, h) (((b) * 2 + (h)) * HTB)
#define PG8_SB(b, h) ((4 + (b) * 2 + (h)) * HTB)
#define PG8_STAGE_B(bufoff, gbase) do { _Pragma("unroll") for (int _i = 0; _i < 2; ++_i) \
        __builtin_amdgcn_global_load_lds((const unsigned*)((const char*)(gbase) + voffB[_i]), (PG8_LAS unsigned*)(lds + (bufoff) + ldsw + _i * 8192), 16, 0, 0); } while (0)
#define PG8_STAGE_A(bufoff, gbase, kt) do { const bool _v = Src::TWO_VAR && g.avar(kt); _Pragma("unroll") for (int _i = 0; _i < 2; ++_i) { const unsigned _o = _v ? voffA2[_i] : voffA[_i]; \
        __builtin_amdgcn_global_load_lds((const unsigned*)((const char*)(gbase) + _o), (PG8_LAS unsigned*)(lds + (bufoff) + ldsw + _i * 8192), 16, 0, 0); } } while (0)
#define PG8_LDA(dst, b, h) do { _Pragma("unroll") for (int m = 0; m < 4; ++m) _Pragma("unroll") for (int k = 0; k < 2; ++k) dst[m][k] = *(const PG8_LAS bf16x8*)(lds + PG8_SA(b, h) + aoff + m * 2048 + k * 1024); } while (0)
#define PG8_LDB(dst, b, h) do { _Pragma("unroll") for (int n = 0; n < 2; ++n) _Pragma("unroll") for (int k = 0; k < 2; ++k) dst[n][k] = *(const PG8_LAS bf16x8*)(lds + PG8_SB(b, h) + boff + n * 2048 + k * 1024); } while (0)
#define PG8_MMA(ai, bj, At, Bt) do { __builtin_amdgcn_s_setprio(1); _Pragma("unroll") for (int m = 0; m < 4; ++m) _Pragma("unroll") for (int n = 0; n < 2; ++n) _Pragma("unroll") for (int k = 0; k < 2; ++k) \
        acc[ai][bj][m][n] = __builtin_amdgcn_mfma_f32_16x16x32_bf16(Bt[n][k], At[m][k], acc[ai][bj][m][n], 0, 0, 0); __builtin_amdgcn_s_setprio(0); } while (0)
#define PG8_WAIT_V(n) asm volatile("s_waitcnt vmcnt(" #n ")" ::: "memory")
#define PG8_WAIT_L(n) asm volatile("s_waitcnt lgkmcnt(" #n ")" ::: "memory")
#define PG8_BAR __builtin_amdgcn_s_barrier()
#define PG8_SCHED __builtin_amdgcn_sched_barrier(0)
    Unit cur, nxt; int ui = 0;
    if (!S.next(0, cur)) return;
    Acc acc;
#pragma unroll
    for (int a = 0; a < 2; ++a)
#pragma unroll
        for (int b = 0; b < 2; ++b)
#pragma unroll
            for (int m = 0; m < 4; ++m)
#pragma unroll
                for (int n = 0; n < 2; ++n) acc[a][b][m][n] = (f32x4){0.f, 0.f, 0.f, 0.f};
    bf16x8 At[4][2], B0[2][2], B1[2][2];
    PG8_STAGE_B(PG8_SB(0, 0), g.b(cur, 0, 0)); PG8_STAGE_B(PG8_SB(0, 1), g.b(cur, 0, 1)); PG8_STAGE_A(PG8_SA(0, 0), g.a(cur, 0, 0), 0); PG8_STAGE_A(PG8_SA(0, 1), g.a(cur, 0, 1), 0);
    if (wr == 1) PG8_BAR;
    PG8_WAIT_V(2); PG8_BAR;
    PG8_STAGE_B(PG8_SB(1, 0), g.b(cur, 1, 0)); PG8_STAGE_A(PG8_SA(1, 0), g.a(cur, 1, 0), 1); PG8_STAGE_B(PG8_SB(1, 1), g.b(cur, 1, 1));
    PG8_WAIT_V(6); PG8_BAR;
    for (;;) {
        const bool has_next = S.next(ui + 1, nxt);
        const Unit nu = has_next ? nxt : cur;
        for (int t = 0; t < nt; t += 2) {
            const bool last = (t == nt - 2);
            if constexpr (Epi::HAS_MID) E.mid(acc, cur, t, wr, wc, fr, fq);
            const Unit u2 = last ? nu : cur; const int k2 = last ? 0 : t + 2, k3 = k2 + 1;
            PG8_LDB(B0, 0, 0); PG8_LDB(B1, 0, 1); PG8_SCHED; PG8_LDA(At, 0, 0); PG8_STAGE_A(PG8_SA(1, 1), g.a(cur, t + 1, 1), t + 1);
            PG8_WAIT_V(8); PG8_WAIT_L(0); PG8_BAR; PG8_MMA(0, 0, At, B0); PG8_MMA(0, 1, At, B1); PG8_BAR; PG8_SCHED;
            PG8_LDA(At, 0, 1); PG8_STAGE_B(PG8_SB(0, 0), g.b(u2, k2, 0)); PG8_STAGE_B(PG8_SB(0, 1), g.b(u2, k2, 1)); PG8_STAGE_A(PG8_SA(0, 0), g.a(u2, k2, 0), k2);
            PG8_WAIT_V(8); PG8_WAIT_L(0); PG8_BAR; PG8_MMA(1, 0, At, B0); PG8_MMA(1, 1, At, B1); PG8_BAR; PG8_SCHED;
            PG8_LDB(B0, 1, 0); PG8_LDB(B1, 1, 1); PG8_SCHED; PG8_LDA(At, 1, 0); PG8_STAGE_A(PG8_SA(0, 1), g.a(u2, k2, 1), k2);
            PG8_WAIT_V(8); PG8_WAIT_L(0); PG8_BAR; PG8_MMA(0, 0, At, B0); PG8_MMA(0, 1, At, B1); PG8_BAR; PG8_SCHED;
            PG8_LDA(At, 1, 1); PG8_STAGE_B(PG8_SB(1, 0), g.b(u2, k3, 0)); PG8_STAGE_B(PG8_SB(1, 1), g.b(u2, k3, 1)); PG8_STAGE_A(PG8_SA(1, 0), g.a(u2, k3, 0), k3);
            PG8_WAIT_V(8); PG8_WAIT_L(0); PG8_BAR; PG8_MMA(1, 0, At, B0); PG8_MMA(1, 1, At, B1); PG8_BAR; PG8_SCHED;
        }
        if constexpr (ALIGN_EPI) { if (wr == 0) PG8_BAR; }
        E(acc, cur, wr, wc, fr, fq);
        if (!has_next) break;
#pragma unroll
        for (int a = 0; a < 2; ++a)
#pragma unroll
            for (int b = 0; b < 2; ++b)
#pragma unroll
                for (int m = 0; m < 4; ++m)
#pragma unroll
                    for (int n = 0; n < 2; ++n) acc[a][b][m][n] = (f32x4){0.f, 0.f, 0.f, 0.f};
        cur = nxt; ++ui;
        if constexpr (ALIGN_EPI) { if (wr == 1) PG8_BAR; }
    }
    PG8_WAIT_V(0);
    if constexpr (!ALIGN_EPI) { if (wr == 0) PG8_BAR; }
    PG8_BAR;
#undef PG8_SA
#undef PG8_SB
#undef PG8_STAGE_A
#undef PG8_STAGE_B
#undef PG8_LDA
#undef PG8_LDB
#undef PG8_MMA
#undef PG8_WAIT_V
#undef PG8_WAIT_L
#undef PG8_BAR
#undef PG8_SCHED
}
}
constexpr int NWAVES = 8;
constexpr int RING_OFF = 0, RING_BYTES = 131072;
constexpr int LDSCTL_OFF = RING_BYTES, MISC_OFF = LDSCTL_OFF + 320, RINV_OFF = LDSCTL_OFF + 1024;
constexpr int LDS_BYTES = 147456;
constexpr int CW_TMO = 0, CW_CODE = 1, CW_BAR = 4096, CW_CNT = 16384;

#define GAS __attribute__((address_space(1)))
#define LAS __attribute__((address_space(3)))
typedef GAS unsigned gu32;
#define RLX_AGENT __ATOMIC_RELAXED, __HIP_MEMORY_SCOPE_AGENT
#define LDS_WAIT() asm volatile("s_waitcnt lgkmcnt(0)" ::: "memory")
#define VM_WAIT() asm volatile("s_waitcnt vmcnt(0)" ::: "memory")

#define XB_TMO      128
#define XB_XCNT(j)  (256  + 64 * (j))
#define XB_XSUB(j)  (1280 + 64 * (j))
#define XB_XGEN(j)  (2304 + 64 * (j))
#define XB_TOP      3328
#define XB_TOPGEN   3392
#define XCD_BAR_WORDS 3456
#define XB_SPIN_CAP (1u << 20)
__device__ __forceinline__ unsigned xb_ld(unsigned* p)              { return __hip_atomic_load(p, __ATOMIC_RELAXED, __HIP_MEMORY_SCOPE_AGENT); }
__device__ __forceinline__ unsigned xb_add(unsigned* p, unsigned v) { return __hip_atomic_fetch_add(p, v, __ATOMIC_RELAXED, __HIP_MEMORY_SCOPE_AGENT); }
__device__ __forceinline__ unsigned xb_xcc_id() { return (unsigned)__builtin_amdgcn_s_getreg((3 << 11) | 20) & 0xFu; }
#define XB_SPIN(cond, bar) do { unsigned _sp = 0; while (cond) { __builtin_amdgcn_s_sleep(1); \
    if ((++_sp & 255u) == 0u) { if (xb_ld(&(bar)[XB_TMO])) break; if (_sp > XB_SPIN_CAP) { atomicAdd(&(bar)[XB_TMO], 1u); break; } } } } while (0)
struct XcdBarrier { unsigned* bar; unsigned x; volatile LAS unsigned* st; };
__device__ __forceinline__ XcdBarrier xcd_barrier_post(unsigned* bar, volatile LAS unsigned* st) {
    XcdBarrier b; b.bar = bar; b.x = xb_xcc_id(); b.st = st;
    if (threadIdx.x == 0) (void)xb_add(&bar[XB_XCNT(b.x)], 1u);
    return b;
}
__device__ __forceinline__ void xcd_barrier_complete(unsigned* bar, unsigned x, unsigned& nloc, unsigned& nx) {
    const unsigned G = gridDim.x * gridDim.y * gridDim.z;
    unsigned sum, cnt, mine, sp = 0u;
    for (;;) {
        sum = 0u; cnt = 0u; mine = 0u;
#pragma unroll
        for (unsigned j = 0; j < 16; ++j) { const unsigned c = xb_ld(&bar[XB_XCNT(j)]); sum += c; cnt += (c > 0u) ? 1u : 0u; mine = (j == x) ? c : mine; }
        if (sum == G) break;
        __builtin_amdgcn_s_sleep(1);
        if ((++sp & 255u) == 0u) { if (xb_ld(&bar[XB_TMO])) break; if (sp > XB_SPIN_CAP) { atomicAdd(&bar[XB_TMO], 1u); break; } }
    }
    nloc = mine > 0u ? mine : 1u; nx = cnt > 0u ? cnt : 1u;
}
__device__ __forceinline__ void xcd_barrier(const XcdBarrier& b) {
    asm volatile("s_waitcnt vmcnt(0)" ::: "memory");
    __syncthreads();
    if (threadIdx.x == 0) {
        unsigned* bar = b.bar;
        __builtin_amdgcn_s_waitcnt(0);
        unsigned nloc = b.st[0], nx = b.st[1];
        if (nloc == 0u) { xcd_barrier_complete(bar, b.x, nloc, nx); b.st[0] = nloc; b.st[1] = nx; }
        const unsigned old = xb_add(&bar[XB_XSUB(b.x)], 1u);
        const unsigned gen = old / nloc;
        if (old + 1u == (gen + 1u) * nloc) {
            __builtin_amdgcn_fence(__ATOMIC_RELEASE, "agent");
            asm volatile("s_waitcnt vmcnt(0)" ::: "memory");
            const unsigned og = xb_add(&bar[XB_TOP], 1u);
            const unsigned tg = og / nx;
            if (og + 1u == (tg + 1u) * nx) xb_add(&bar[XB_TOPGEN], 1u);
            else XB_SPIN(xb_ld(&bar[XB_TOPGEN]) == tg, bar);
            __builtin_amdgcn_fence(__ATOMIC_ACQUIRE, "agent");
            xb_add(&bar[XB_XGEN(b.x)], 1u);
            asm volatile("s_waitcnt vmcnt(0)" ::: "memory");
        } else {
            XB_SPIN(xb_ld(&bar[XB_XGEN(b.x)]) == gen, bar);
            __builtin_amdgcn_fence(__ATOMIC_ACQUIRE, "agent");
            asm volatile("s_waitcnt vmcnt(0)" ::: "memory");
        }
    }
    __syncthreads();
}

struct Frame {
    LAS unsigned char* lds;
    int tid, lane, wave, vcu, G;
};

__device__ __forceinline__ void conv_item(const float* __restrict__ W, int N, const float* __restrict__ gain, bf16* WT, int Kdst, int k_off, int k0, int n0, int drow0, LAS float* scr, int lane) {
    f32x4 wv[8];
#pragma unroll
    for (int i = 0; i < 8; ++i) wv[i] = *(const f32x4*)(W + (size_t)(k0 + 8 * i + (lane >> 3)) * N + n0 + 4 * (lane & 7));
#pragma unroll
    for (int i = 0; i < 8; ++i) { const int kk = 8 * i + (lane >> 3); const float g = gain ? gain[k0 + kk] : 1.f; LAS float* sp = scr + kk * 33 + 4 * (lane & 7);
        sp[0] = wv[i][0] * g; sp[1] = wv[i][1] * g; sp[2] = wv[i][2] * g; sp[3] = wv[i][3] * g; }
    LDS_WAIT(); asm volatile("" ::: "memory");
    const int c = lane & 7;
#pragma unroll
    for (int j = 0; j < 4; ++j) { const int n = (lane >> 3) + 8 * j; const LAS float* s = scr + (8 * c) * 33 + n;
        u32x4 o; o.x = pk2(s[0 * 33], s[1 * 33]); o.y = pk2(s[2 * 33], s[3 * 33]); o.z = pk2(s[4 * 33], s[5 * 33]); o.w = pk2(s[6 * 33], s[7 * 33]);
        *(GAS u32x4*)(WT + (size_t)(drow0 + n) * Kdst + k_off + k0 + 8 * c) = o; }
    LDS_WAIT(); asm volatile("" ::: "memory");
}
__device__ __forceinline__ void conv_layer(const Frame& F, const Ptrs& P, int l) {
    LAS float* scr = (LAS float*)(F.lds + RING_OFF + F.wave * 16384);
    const int gw = F.vcu * NWAVES + F.wave, NGW = F.G * NWAVES;
    unsigned char* ws = P.ws;
    constexpr int I_IN = 16 * 160, I_GLU = 8 * 32, I_MRG = 3 * 8 * 32, I_OUT = 16 * 32, I_F1 = 16 * 128, I_F2 = 64 * 32;
    constexpr int NITEMS = I_IN + I_GLU + I_MRG + I_OUT + I_F1 + I_F2;
    for (int it = gw; it < NITEMS; it += NGW) {
        int r = it;
        if (r < I_IN) { const int kb = r / 160, nb = r % 160; conv_item(P.w_in + (size_t)l * DM * DIN, DIN, P.norm_mix + l * DM, (bf16*)(ws + WS_WIN), DM, 0, 64 * kb, 32 * nb, 32 * nb, scr, F.lane); continue; } r -= I_IN;
        if (r < I_GLU) { const int kb = r / 32, nb = r % 32; const int n0 = 32 * nb, v = n0 & 511, drow0 = (v >> 7) * 256 + (n0 >= 512 ? 128 : 0) + (v & 127);
            conv_item(P.w_glu + (size_t)l * 512 * 1024, 1024, nullptr, (bf16*)(ws + WS_WGLU), 512, 0, 64 * kb, n0, drow0, scr, F.lane); continue; } r -= I_GLU;
        if (r < I_MRG) { const int sg = r / 256, q = r % 256, kb = q / 32, nb = q % 32; const float* W = (sg == 0 ? P.w_o_swa : (sg == 1 ? P.w_o_ssm : P.w_o_moba)) + (size_t)l * 512 * DM;
            conv_item(W, DM, nullptr, (bf16*)(ws + WS_WMRG), 1536, 512 * sg, 64 * kb, 32 * nb, 32 * nb, scr, F.lane); continue; } r -= I_MRG;
        if (r < I_OUT) { const int kb = r / 32, nb = r % 32; conv_item(P.w_out + (size_t)l * DM * DM, DM, nullptr, (bf16*)(ws + WS_WOUT), DM, 0, 64 * kb, 32 * nb, 32 * nb, scr, F.lane); continue; } r -= I_OUT;
        if (r < I_F1) { const int kb = r / 128, nb = r % 128; conv_item(P.w_ff1 + (size_t)l * DM * DFF, DFF, P.norm_ffn + l * DM, (bf16*)(ws + WS_WFF1), DM, 0, 64 * kb, 32 * nb, 32 * nb, scr, F.lane); continue; } r -= I_F1;
        { const int kb = r / 32, nb = r % 32; conv_item(P.w_ff2 + (size_t)l * DFF * DM, DM, nullptr, (bf16*)(ws + WS_WFF2), DFF, 0, 64 * kb, 32 * nb, 32 * nb, scr, F.lane); }
    }
}
__device__ __forceinline__ void ssm_mats(const Frame& F, const Ptrs& P, int l) {
    __syncthreads();
    LAS float* L = (LAS float*)(F.lds + RING_OFF);
    LAS float* apr = L;
    LAS float* api = L + 17 * 64;
    LAS float* bbr = L + 34 * 64;
    LAS float* bbi = bbr + 1024;
    LAS float* ccr = bbi + 1024;
    LAS float* cci = ccr + 1024;
    LAS float* ktab = cci + 1024;
    for (int wi = F.vcu; wi < 256; wi += F.G) {
        const int g = wi >> 3, part = wi & 7; const int tid = F.tid;
        if (tid < 64) { const int p = tid; const float lr = P.lam_re[l * 2048 + g * 64 + p], li = P.lam_im[l * 2048 + g * 64 + p], dt = expf(P.log_step[l * 32 + g]);
            const float mag = expf(lr * dt), are = mag * cosf(li * dt), aim = mag * sinf(li * dt);
            const float den = lr * lr + li * li, nr = are - 1.f, ni = aim, fre = (nr * lr + ni * li) / den, fim = (ni * lr - nr * li) / den;
            float pr = 1.f, pi = 0.f;
            for (int k = 0; k <= 16; ++k) { apr[k * 64 + p] = pr; api[k * 64 + p] = pi; const float t = pr * are - pi * aim; pi = pr * aim + pi * are; pr = t; }
            for (int h = 0; h < 16; ++h) { const float br = P.b_re[(size_t)l * 32768 + (g * 64 + p) * 16 + h], bi = P.b_im[(size_t)l * 32768 + (g * 64 + p) * 16 + h]; bbr[p * 16 + h] = fre * br - fim * bi; bbi[p * 16 + h] = fre * bi + fim * br; } }
        for (int e = tid; e < 1024; e += 512) { ccr[e] = P.c_re[(size_t)l * 32768 + g * 1024 + e]; cci[e] = P.c_im[(size_t)l * 32768 + g * 1024 + e]; }
        __syncthreads();
        for (int e = tid; e < 4096; e += 512) { const int tau = e >> 8, i = (e >> 4) & 15, j = e & 15; float acc = 0.f;
            for (int p = 0; p < 64; ++p) { const float cr = ccr[i * 64 + p], ci = cci[i * 64 + p], ar = apr[tau * 64 + p], ai = api[tau * 64 + p]; const float er = cr * ar - ci * ai, ei = cr * ai + ci * ar; acc += er * bbr[p * 16 + j] - ei * bbi[p * 16 + j]; }
            if (tau == 0 && i == j) acc += P.d_skip[l * 512 + g * 16 + i];
            ktab[e] = acc; }
        __syncthreads();
        bf16* BM_ = (bf16*)(P.ws + WS_SMAIN) + (size_t)g * 256 * SSM_KM;
        for (int e = tid; e < 32 * SSM_KM / 2; e += 512) {
            const int n = part * 32 + e / (SSM_KM / 2), k = (e % (SSM_KM / 2)) * 2, s = n >> 4, i = n & 15; float v[2];
#pragma unroll
            for (int q = 0; q < 2; ++q) { const int kk = k + q;
                if (kk < 256) { const int sp = kk >> 4, j = kk & 15; v[q] = (sp <= s) ? ktab[(s - sp) * 256 + i * 16 + j] : 0.f; }
                else { const int p = (kk - 256) & 63; const float cr = ccr[i * 64 + p], ci = cci[i * 64 + p], ar = apr[(s + 1) * 64 + p], ai = api[(s + 1) * 64 + p]; v[q] = (kk < 320) ? (cr * ar - ci * ai) : -(cr * ai + ci * ar); } }
            *(GAS unsigned*)(BM_ + (size_t)n * SSM_KM + k) = pk2(v[0], v[1]); }
        bf16* BE_ = (bf16*)(P.ws + WS_SEND) + (size_t)g * 256 * SSM_KE;
        for (int e = tid; e < 32 * SSM_KE / 2; e += 512) {
            const int n = part * 32 + e / (SSM_KE / 2), k = (e % (SSM_KE / 2)) * 2; float v[2];
#pragma unroll
            for (int q = 0; q < 2; ++q) { const int kk = k + q, sp = kk >> 4, j = kk & 15, p = n & 63; const float ar = apr[(15 - sp) * 64 + p], ai = api[(15 - sp) * 64 + p], br = bbr[p * 16 + j], bi = bbi[p * 16 + j];
                v[q] = (n < 64) ? (ar * br - ai * bi) : ((n < 128) ? (ar * bi + ai * br) : 0.f); }
            *(GAS unsigned*)(BE_ + (size_t)n * SSM_KE + k) = pk2(v[0], v[1]); }
        __syncthreads();
    }
}
__device__ __forceinline__ void xb_pass(const Frame& F, const Ptrs& P) {
    const int gw = F.vcu * NWAVES + F.wave, NGW = F.G * NWAVES;
    bf16* XB = (bf16*)(P.ws + WS_XN); float* SSQ = (float*)(P.ws + WS_SSQ);
    for (int m = gw; m < T; m += NGW) {
        const GAS f32x4* xr = (const GAS f32x4*)(P.x_in + (size_t)m * DM) + F.lane;
        f32x4 v[4]; float s = 0.f;
#pragma unroll
        for (int j = 0; j < 4; ++j) { v[j] = xr[64 * j]; s += (v[j].x * v[j].x + v[j].y * v[j].y) + (v[j].z * v[j].z + v[j].w * v[j].w); }
        s = wave_sum(s);
        GAS f32x4* xo = (GAS f32x4*)(P.x + (size_t)m * DM) + F.lane;
#pragma unroll
        for (int j = 0; j < 4; ++j) xo[64 * j] = v[j];
        GAS unsigned long long* o8 = (GAS unsigned long long*)(XB + (size_t)m * DM) + F.lane;
#pragma unroll
        for (int j = 0; j < 4; ++j) o8[64 * j] = (unsigned long long)pk2(v[j].x, v[j].y) | ((unsigned long long)pk2(v[j].z, v[j].w) << 32);
        if (F.lane < 16) SSQ[(size_t)m * 16 + F.lane] = (F.lane == 0) ? s : 0.f;
    }
}
__device__ __forceinline__ void final_pass(const Frame& F, const Ptrs& P) {
    const int gw = F.vcu * NWAVES + F.wave, NGW = F.G * NWAVES;
    for (int m = gw; m < T; m += NGW) {
        GAS f32x4* xr = (GAS f32x4*)(P.x + (size_t)m * DM) + F.lane;
        f32x4 v[4]; float s = 0.f;
#pragma unroll
        for (int j = 0; j < 4; ++j) { v[j] = xr[64 * j]; s += (v[j].x * v[j].x + v[j].y * v[j].y) + (v[j].z * v[j].z + v[j].w * v[j].w); }
        const float r = rsqrtf(wave_sum(s) * (1.f / DM) + NORM_EPS);
#pragma unroll
        for (int j = 0; j < 4; ++j) { const f32x4 g = ((const GAS f32x4*)P.norm_final)[F.lane + 64 * j]; xr[64 * j] = v[j] * r * g; }
    }
}
__device__ __forceinline__ void ssm_carry(const Frame& F, const Ptrs& P, int l) {
    if (F.vcu & 15) return;
    const int gt = (F.vcu >> 4) * 512 + F.tid;
    if (gt >= 32 * NB * 64) return;
    const int p = gt & 63, b = (gt >> 6) & 3, g = gt >> 8;
    const float lr = P.lam_re[l * 2048 + g * 64 + p], li = P.lam_im[l * 2048 + g * 64 + p], dt = expf(P.log_step[l * 32 + g]);
    const float mag = expf(lr * dt), are = mag * cosf(li * dt), aim = mag * sinf(li * dt);
    float pr = 1.f, pi = 0.f;
    for (int k = 0; k < 16; ++k) { const float t = pr * are - pi * aim; pi = pr * aim + pi * are; pr = t; }
    const float* he = (const float*)(P.ws + WS_HEND) + ((size_t)g * NCH + b * 256) * 128 + p;
    bf16* hi = (bf16*)(P.ws + WS_HINIT) + ((size_t)g * NCH + b * 256) * 128 + p;
    float sr = 0.f, si = 0.f;
    float er[8], ei[8];
#pragma unroll
    for (int q = 0; q < 8; ++q) { er[q] = he[(size_t)q * 128]; ei[q] = he[(size_t)q * 128 + 64]; }
    for (int c0 = 0; c0 < 256; c0 += 8) {
        float nr_[8], ni_[8];
        const int cn = (c0 + 8 < 256) ? c0 + 8 : c0;
#pragma unroll
        for (int q = 0; q < 8; ++q) { nr_[q] = he[(size_t)(cn + q) * 128]; ni_[q] = he[(size_t)(cn + q) * 128 + 64]; }
#pragma unroll
        for (int q = 0; q < 8; ++q) { hi[(size_t)(c0 + q) * 128] = (bf16)f2bf(sr); hi[(size_t)(c0 + q) * 128 + 64] = (bf16)f2bf(si);
            const float tr = pr * sr - pi * si + er[q], ti = pr * si + pi * sr + ei[q]; sr = tr; si = ti; }
#pragma unroll
        for (int q = 0; q < 8; ++q) { er[q] = nr_[q]; ei[q] = ni_[q]; }
    }
}
namespace att {
__device__ __forceinline__ int crow(int r, int hi) { return (r & 3) + 8 * (r >> 2) + 4 * hi; }
struct St { f32x16 o0, o1; float m, l; };
__device__ __forceinline__ unsigned cvtpk(float lo, float hi) { return cvtpk_s(lo, hi); }

__device__ __forceinline__ void loadk(bf16x8 (&kf)[8], const bf16* kp) {
#pragma unroll
    for (int d0 = 0; d0 < 4; ++d0) { kf[2 * d0] = *(const bf16x8*)(kp + d0 * 16); kf[2 * d0 + 1] = *(const bf16x8*)(kp + 32 * 128 + d0 * 16); }
}
template <int MODE>
__device__ __forceinline__ void tile(St& st, const bf16x8 (&qr)[4], const bf16x8 (&kf)[8], const bf16* vtp  , int kq  , float sl2, bool rowok, int klo  , int hi) {
    f32x16 p0 = {}, p1 = {};
#pragma unroll
    for (int d0 = 0; d0 < 4; ++d0) { p0 = __builtin_amdgcn_mfma_f32_32x32x16_bf16(kf[2 * d0], qr[d0], p0, 0, 0, 0); p1 = __builtin_amdgcn_mfma_f32_32x32x16_bf16(kf[2 * d0 + 1], qr[d0], p1, 0, 0, 0); }
    s16x4 vl[2][4], vh[2][4];
#pragma unroll
    for (int dh = 0; dh < 2; ++dh)
#pragma unroll
        for (int s = 0; s < 4; ++s) { vl[dh][s] = *(const s16x4*)(vtp + (size_t)dh * 32 * S + 16 * s); vh[dh][s] = *(const s16x4*)(vtp + (size_t)dh * 32 * S + 16 * s + 8); }
    const float base = sl2 * (float)(kq + 4 * hi);
    float mx = -INFINITY;
#pragma unroll
    for (int r = 0; r < 16; ++r) { const int c = (r & 3) + 8 * (r >> 2); const int k0 = kq + 4 * hi + c, k1 = k0 + 32;
        float a = fmaf(sl2, (float)c, p0[r]), b = fmaf(sl2, (float)(c + 32), p1[r]);
        if (MODE == 1) { a = (k0 <= 0 && k0 >= klo) ? a : -INFINITY; b = (k1 <= 0 && k1 >= klo) ? b : -INFINITY; }
        else if (MODE == 2) { a = (k0 <= 0) ? a : -INFINITY; b = (k1 <= 0) ? b : -INFINITY; }
        else if (MODE == 3) { a = (rowok && k0 <= 0) ? a : -INFINITY; b = (rowok && k1 <= 0) ? b : -INFINITY; }
        p0[r] = a; p1[r] = b; mx = fmaxf(mx, fmaxf(a, b)); }
    mx += base;
    mx = fmaxf(mx, __shfl_xor(mx, 32));
    const float mn = fmaxf(st.m, mx), alpha = __builtin_amdgcn_exp2f(st.m - mn), off = base - mn;
    float sum = 0.f;
#pragma unroll
    for (int r = 0; r < 16; ++r) { p0[r] = __builtin_amdgcn_exp2f(p0[r] + off); p1[r] = __builtin_amdgcn_exp2f(p1[r] + off); sum += p0[r] + p1[r]; }
    st.m = mn; st.l = st.l * alpha + sum;
#pragma unroll
    for (int r = 0; r < 16; ++r) { st.o0[r] *= alpha; st.o1[r] *= alpha; }
    bf16x8 pf[4];
#pragma unroll
    for (int s = 0; s < 2; ++s) { u32x4 w0, w1;
        w0.x = cvtpk(p0[8 * s + 0], p0[8 * s + 1]); w0.y = cvtpk(p0[8 * s + 2], p0[8 * s + 3]); w0.z = cvtpk(p0[8 * s + 4], p0[8 * s + 5]); w0.w = cvtpk(p0[8 * s + 6], p0[8 * s + 7]);
        w1.x = cvtpk(p1[8 * s + 0], p1[8 * s + 1]); w1.y = cvtpk(p1[8 * s + 2], p1[8 * s + 3]); w1.z = cvtpk(p1[8 * s + 4], p1[8 * s + 5]); w1.w = cvtpk(p1[8 * s + 6], p1[8 * s + 7]);
        pf[s] = __builtin_bit_cast(bf16x8, w0); pf[2 + s] = __builtin_bit_cast(bf16x8, w1); }
#pragma unroll
    for (int s = 0; s < 4; ++s) {
        const bf16x8 v0 = (bf16x8){vl[0][s][0], vl[0][s][1], vl[0][s][2], vl[0][s][3], vh[0][s][0], vh[0][s][1], vh[0][s][2], vh[0][s][3]};
        const bf16x8 v1 = (bf16x8){vl[1][s][0], vl[1][s][1], vl[1][s][2], vl[1][s][3], vh[1][s][0], vh[1][s][1], vh[1][s][2], vh[1][s][3]};
        st.o0 = __builtin_amdgcn_mfma_f32_32x32x16_bf16(v0, pf[s], st.o0, 0, 0, 0);
        st.o1 = __builtin_amdgcn_mfma_f32_32x32x16_bf16(v1, pf[s], st.o1, 0, 0, 0); }
}
__device__ __forceinline__ void finish(const St& st, bf16* op, int hi) {
    const float lt = st.l + __shfl_xor(st.l, 32), rl = __builtin_amdgcn_rcpf(lt);
#pragma unroll
    for (int g = 0; g < 4; ++g) { u32x2 a, b;
        a.x = cvtpk(st.o0[4 * g] * rl, st.o0[4 * g + 1] * rl); a.y = cvtpk(st.o0[4 * g + 2] * rl, st.o0[4 * g + 3] * rl);
        b.x = cvtpk(st.o1[4 * g] * rl, st.o1[4 * g + 1] * rl); b.y = cvtpk(st.o1[4 * g + 2] * rl, st.o1[4 * g + 3] * rl);
        *(u32x2*)(op + 8 * g + 4 * hi) = a; *(u32x2*)(op + 32 + 8 * g + 4 * hi) = b; }
}
__device__ __forceinline__ void loadq(bf16x8 (&qr)[4], const bf16* qp) {
#pragma unroll
    for (int d0 = 0; d0 < 4; ++d0) qr[d0] = *(const bf16x8*)(qp + d0 * 16);
}

constexpr int IMG_K = 0, IMG_V = 32768, IMG_BYTES = 65536;
__device__ __forceinline__ void img_load(const Frame& F, LAS unsigned char* img, const bf16* K, long krow0, int kvh, const bf16* vt0, int key0) {
    const int lane = F.lane, w = F.wave;
#pragma unroll
    for (int i = 0; i < 4; ++i) { const int piece = w * 4 + i, key = piece * 8 + (lane >> 3), c = (lane & 7) ^ ((key >> 1) & 7); long row = krow0 + key; row = row < 0 ? 0 : row;
        __builtin_amdgcn_global_load_lds((const unsigned*)(K + row * 128 + kvh * 64 + c * 8), (LAS unsigned*)(img + IMG_K + piece * 1024), 16, 0, 0); }
#pragma unroll
    for (int i = 0; i < 4; ++i) { const int piece = w * 4 + i, d = piece * 2 + (lane >> 5), c = (lane & 31) ^ (d & 15); int kk = key0 + c * 8; kk = kk < 0 ? 0 : kk;
        __builtin_amdgcn_global_load_lds((const unsigned*)(vt0 + (long)d * S + kk), (LAS unsigned*)(img + IMG_V + piece * 1024), 16, 0, 0); }
}
struct LaneOff { int k[4]; int v[8]; };
__device__ __forceinline__ void lane_off(LaneOff& lo, int r32, int hi) { const int s7 = (r32 >> 1) & 7, x = r32 & 15;
#pragma unroll
    for (int d0 = 0; d0 < 4; ++d0) lo.k[d0] = ((2 * d0 + hi) ^ s7) << 4;
#pragma unroll
    for (int j = 0; j < 8; ++j) lo.v[j] = (j ^ (x & 7)) << 4; }
template <int MODE, bool HALF, bool AL64>
__device__ __forceinline__ void tile_lds(St& st, const bf16x8 (&qr)[4], const LAS unsigned char* img, const LaneOff& lo, int ko, int kq  , float sl2, bool rowok, int klo, int hi, int r32) {
    const LAS unsigned char* kp = img + IMG_K + (ko + r32) * 128;
    const bool fresh = st.m == -INFINITY; const float ref = fresh ? 0.f : st.m;
    const float cin = sl2 * (float)(kq + 4 * hi) - ref;
    f32x16 p0, p1;
#pragma unroll
    for (int r = 0; r < 16; ++r) { p0[r] = cin; p1[r] = cin; }
#pragma unroll
    for (int d0 = 0; d0 < 4; ++d0) {
        p0 = __builtin_amdgcn_mfma_f32_32x32x16_bf16(*(const LAS bf16x8*)(kp + lo.k[d0]), qr[d0], p0, 0, 0, 0);
        if (!HALF) p1 = __builtin_amdgcn_mfma_f32_32x32x16_bf16(*(const LAS bf16x8*)(kp + 32 * 128 + lo.k[d0]), qr[d0], p1, 0, 0, 0); }
    float mx = -INFINITY;
#pragma unroll
    for (int r = 0; r < 16; ++r) { const int c = (r & 3) + 8 * (r >> 2); const int k0 = kq + 4 * hi + c, k1 = k0 + 32;
        float a = fmaf(sl2, (float)c, p0[r]), b = HALF ? -INFINITY : fmaf(sl2, (float)(c + 32), p1[r]);
        if (MODE == 1) { a = (k0 <= 0 && k0 >= klo) ? a : -INFINITY; if (!HALF) b = (k1 <= 0 && k1 >= klo) ? b : -INFINITY; }
        else if (MODE == 2) { a = (k0 <= 0) ? a : -INFINITY; if (!HALF) b = (k1 <= 0) ? b : -INFINITY; }
        else if (MODE == 3) { a = (rowok && k0 <= 0) ? a : -INFINITY; if (!HALF) b = (rowok && k1 <= 0) ? b : -INFINITY; }
        p0[r] = a; if (!HALF) p1[r] = b; mx = fmaxf(mx, HALF ? a : fmaxf(a, b)); }
    mx = fmaxf(mx, __shfl_xor(mx, 32));
    const float delta = fresh ? ((mx == -INFINITY) ? 0.f : mx) : ((mx > 8.f) ? mx : 0.f);
    if (__any(delta != 0.f)) {
        const float alpha = fresh ? 1.f : __builtin_amdgcn_exp2f(-delta);
#pragma unroll
        for (int r = 0; r < 16; ++r) { p0[r] -= delta; if (!HALF) p1[r] -= delta; st.o0[r] *= alpha; st.o1[r] *= alpha; }
        st.l *= alpha;
        st.m = (fresh && mx == -INFINITY) ? -INFINITY : ref + delta;
    }
    float sum = 0.f;
#pragma unroll
    for (int r = 0; r < 16; ++r) { p0[r] = __builtin_amdgcn_exp2f(p0[r]); sum += p0[r]; if (!HALF) { p1[r] = __builtin_amdgcn_exp2f(p1[r]); sum += p1[r]; } }
    st.l += sum;
    const int x = r32 & 15, kc = ko >> 3;
    const LAS unsigned char* vp = img + IMG_V + r32 * 512 + hi * 8 + (AL64 ? ((kc ^ (x & 8)) << 4) : 0);
#pragma unroll
    for (int s = 0; s < (HALF ? 2 : 4); ++s) {
        u32x4 w;
        if (s < 2) { w.x = cvtpk(p0[8 * s + 0], p0[8 * s + 1]); w.y = cvtpk(p0[8 * s + 2], p0[8 * s + 3]); w.z = cvtpk(p0[8 * s + 4], p0[8 * s + 5]); w.w = cvtpk(p0[8 * s + 6], p0[8 * s + 7]); }
        else { w.x = cvtpk(p1[8 * s - 16], p1[8 * s - 15]); w.y = cvtpk(p1[8 * s - 14], p1[8 * s - 13]); w.z = cvtpk(p1[8 * s - 12], p1[8 * s - 11]); w.w = cvtpk(p1[8 * s - 10], p1[8 * s - 9]); }
        const bf16x8 pf = __builtin_bit_cast(bf16x8, w);
        const int o0 = AL64 ? lo.v[2 * s] : (((kc + 2 * s) ^ x) << 4), o1 = AL64 ? lo.v[2 * s + 1] : (((kc + 2 * s + 1) ^ x) << 4);
        const s16x4 a0 = *(const LAS s16x4*)(vp + o0), a1 = *(const LAS s16x4*)(vp + o1), b0 = *(const LAS s16x4*)(vp + 32 * 512 + o0), b1 = *(const LAS s16x4*)(vp + 32 * 512 + o1);
        st.o0 = __builtin_amdgcn_mfma_f32_32x32x16_bf16((bf16x8){a0[0], a0[1], a0[2], a0[3], a1[0], a1[1], a1[2], a1[3]}, pf, st.o0, 0, 0, 0);
        st.o1 = __builtin_amdgcn_mfma_f32_32x32x16_bf16((bf16x8){b0[0], b0[1], b0[2], b0[3], b1[0], b1[1], b1[2], b1[3]}, pf, st.o1, 0, 0, 0); }
}
__device__ __forceinline__ void swa_phase(const Frame& F, const Ptrs& P, int l) {
    bf16* QA = (bf16*)(P.ws + WS_QA); const bf16* KA = (const bf16*)(P.ws + WS_KA); const bf16* VAT = (const bf16*)(P.ws + WS_VAT);
    const int lane = F.lane, r32 = lane & 31, hi = lane >> 5, w = F.wave;
    LAS unsigned char* img = F.lds + RING_OFF;
    LaneOff lo; lane_off(lo, r32, hi);
    for (int un = F.vcu; un < 256; un += F.G) {
        const int bk = un >> 5, nb = un & 31, b = bk >> 1, kvh = bk & 1, h = kvh * 4 + (w >> 1);
        __syncthreads();
        img_load(F, img, KA, (long)b * S + nb * 128 - 128, kvh, VAT + (long)((b * 2 + kvh) * 64) * S, nb * 128 - 128);
        const float sl2 = exp2f(-0.5f * (float)(h + 1)) * LOG2E, sink2 = P.sinks[l * 8 + h] * LOG2E;
        asm volatile("s_waitcnt vmcnt(0)" ::: "memory"); __syncthreads();
        for (int qt = 0; qt < 2; ++qt) {
            const int qo = (w & 1) * 64 + qt * 32, t0 = nb * 128 + qo, q = t0 + r32;
            bf16* qrow = QA + (size_t)(b * S + q) * 512 + h * 64;
            bf16x8 qr[4]; loadq(qr, qrow + 8 * hi);
            St st; st.o0 = f32x16{}; st.o1 = f32x16{}; st.m = sink2; st.l = hi ? 0.f : 1.f;
            const int klo = q < 127 ? -q : -127;
#pragma unroll 1
            for (int kt = 0; kt < 2; ++kt) { if (t0 - 128 + 64 * kt + 63 >= 0) tile_lds<1, false, false>(st, qr, img, lo, qo + 64 * kt, t0 - 128 + 64 * kt - q, sl2, true, klo, hi, r32); }
            tile_lds<1, true, false>(st, qr, img, lo, qo + 128, t0 - q, sl2, true, klo, hi, r32);
            finish(st, qrow, hi);
        }
    }
    __syncthreads();
}
__device__ __forceinline__ float moba_sl2(int h) { return exp2f(-0.5f * (float)(8 + h + 1)) * LOG2E; }
__device__ __forceinline__ void moba_select(const Frame& F, const Ptrs& P, int l) {
    const bf16* QM = (const bf16*)(P.ws + WS_QM); const float* KMP = (const float*)(P.ws + WS_KMP);
    unsigned* LIST = (unsigned*)(P.ws + WS_LIST); unsigned* CNT = (unsigned*)(P.ws + WS_CTL) + CW_CNT + l * 128;
    LAS float* km = (LAS float*)(F.lds + RING_OFF);
    const int tid = F.tid, lane = F.lane;
    const int halfg = F.G >> 1; const int wi_ = (int)blockIdx.x - halfg;
    if (wi_ < 0) return;
    for (int un = wi_; un < 256; un += halfg) {
        const int bk = un >> 5, ch = un & 31, b = bk >> 1, kvh = bk & 1, j = ch >> 1;
        __syncthreads();
        for (int e = tid; e < 1024; e += 512) { const int n = e >> 6, d = e & 63; const float* k0 = KMP + (size_t)(b * 16 + n) * 128 + kvh * 64 + d; km[e] = k0[0] + k0[64 * 128]; }
        __syncthreads();
        if (j == 0) continue;
        const int hg = tid >> 7, t = ch * 128 + (tid & 127);
        const bf16* qp = QM + (size_t)(b * S + t) * 512 + (kvh * 4 + hg) * 64;
        u32x4 qv[8];
#pragma unroll
        for (int i = 0; i < 8; ++i) qv[i] = *(const u32x4*)(qp + 8 * i);
        int i0 = 0, i1 = 1, i2 = 2;
        if (j > 3) {
            float v0 = -INFINITY, v1 = -INFINITY, v2 = -INFINITY; i0 = 0; i1 = 0; i2 = 0;
#pragma unroll 1
            for (int n = 0; n < j; ++n) { float a = 0.f;
#pragma unroll
                for (int i = 0; i < 8; ++i) { const f32x4 x0 = *(const LAS f32x4*)(km + n * 64 + 8 * i), x1 = *(const LAS f32x4*)(km + n * 64 + 8 * i + 4);
                    a += bf2f(qv[i].x & 0xffffu) * x0[0] + bf2f(qv[i].x >> 16) * x0[1] + bf2f(qv[i].y & 0xffffu) * x0[2] + bf2f(qv[i].y >> 16) * x0[3]
                       + bf2f(qv[i].z & 0xffffu) * x1[0] + bf2f(qv[i].z >> 16) * x1[1] + bf2f(qv[i].w & 0xffffu) * x1[2] + bf2f(qv[i].w >> 16) * x1[3]; }
                if (a > v0) { v2 = v1; i2 = i1; v1 = v0; i1 = i0; v0 = a; i0 = n; } else if (a > v1) { v2 = v1; i2 = i1; v1 = a; i1 = n; } else if (a > v2) { v2 = a; i2 = n; } }
        }
        const int nsel = j < 3 ? j : 3;
        unsigned mycnt = 0u;
#pragma unroll 1
        for (int n = 0; n < j; ++n) { const bool sel = (n == i0 && nsel > 0) || (n == i1 && nsel > 1) || (n == i2 && nsel > 2); const unsigned long long mask = __ballot(sel); if (lane == n) mycnt = (unsigned)__popcll(mask); }
        unsigned mybase = 0u;
        if (lane < j && mycnt) mybase = __hip_atomic_fetch_add(CNT + bk * 16 + lane, mycnt, __ATOMIC_RELAXED, __HIP_MEMORY_SCOPE_AGENT);
#pragma unroll 1
        for (int n = 0; n < j; ++n) {
            const int r = (n == i0) ? 0 : ((n == i1) ? 1 : ((n == i2) ? 2 : 3));
            const bool sel = r < nsel;
            const unsigned long long mask = __ballot(sel);
            if (mask == 0ull) continue;
            const unsigned base = (unsigned)__shfl((int)mybase, n);
            const unsigned pos = base + (unsigned)__popcll(mask & ((1ull << lane) - 1ull));
            if (sel) LIST[(size_t)(bk * 16 + n) * 16384 + pos] = ((unsigned)t << 4) | ((unsigned)hg << 2) | (unsigned)r;
        }
    }
    __syncthreads();
}
__device__ __forceinline__ void store_o(const St& st, bf16* op, float rl, int hi) {
#pragma unroll
    for (int g = 0; g < 4; ++g) { u32x2 a, b;
        a.x = cvtpk(st.o0[4 * g] * rl, st.o0[4 * g + 1] * rl); a.y = cvtpk(st.o0[4 * g + 2] * rl, st.o0[4 * g + 3] * rl);
        b.x = cvtpk(st.o1[4 * g] * rl, st.o1[4 * g + 1] * rl); b.y = cvtpk(st.o1[4 * g + 2] * rl, st.o1[4 * g + 3] * rl);
        *(u32x2*)(op + 8 * g + 4 * hi) = a; *(u32x2*)(op + 32 + 8 * g + 4 * hi) = b; }
}
__device__ __forceinline__ void moba_gather(const Frame& F, const Ptrs& P, int l) {
    const bf16* QM = (const bf16*)(P.ws + WS_QM); const bf16* KM = (const bf16*)(P.ws + WS_KM); const bf16* VMT = (const bf16*)(P.ws + WS_VMT);
    const unsigned* LIST = (const unsigned*)(P.ws + WS_LIST); unsigned* CNT = (unsigned*)(P.ws + WS_CTL) + CW_CNT + l * 128;
    bf16* PART = (bf16*)(P.ws + WS_PART); float* LSE = (float*)(P.ws + WS_LSE);
    const int lane = F.lane, r32 = lane & 31, hi = lane >> 5, w = F.wave;
    const int per = F.G >> 3;
    const int bk = F.vcu / per, loc = F.vcu % per;
    if (bk >= 8 || (F.vcu & 15) == 0) return;
    const int wg = loc - 1 - (loc > 16 ? 1 : 0), nwg = per - 2;
    const int b = bk >> 1, kvh = bk & 1;
    unsigned cnt = 0u;
    if (lane < 16) cnt = __hip_atomic_load(CNT + bk * 16 + lane, __ATOMIC_RELAXED, __HIP_MEMORY_SCOPE_AGENT);
    const int ns_l = (int)((cnt + 255u) >> 8);
    int pre = ns_l;
#pragma unroll
    for (int o = 1; o < 16; o <<= 1) { const int v = __shfl_up(pre, o); if (lane >= o) pre += v; }
    const int total = __shfl(pre, 15);
    const bf16* vt0 = VMT + (long)((b * 2 + kvh) * 64) * S;
    LAS unsigned char* ring = F.lds + RING_OFF;
    LaneOff lo; lane_off(lo, r32, hi);
    __syncthreads();
    int item = wg, n = 0, sub = 0;
    if (item < total) { const unsigned long long le = __ballot(lane < 16 && pre <= item); n = (int)__popcll(le); sub = item - ((n == 0) ? 0 : __shfl(pre, n - 1));
        img_load(F, ring, KM, (long)b * S + n * 256, kvh, vt0, n * 256); }
    int buf = 0;
#pragma unroll 1
    for (; item < total; item += nwg) {
        const int cn = (int)__shfl((int)cnt, n);
        const int ti = sub * 8 + w, idx = ti * 32 + r32; const bool tile_ok = ti * 32 < cn, valid = idx < cn;
        unsigned e = 0u; if (tile_ok) e = LIST[(size_t)(bk * 16 + n) * 16384 + (valid ? idx : ti * 32)];
        const int t = (int)(e >> 4), hg = (int)((e >> 2) & 3u), r = (int)(e & 3u), h = kvh * 4 + hg;
        const size_t row = (size_t)(b * S + t);
        bf16x8 qr[4]; loadq(qr, QM + row * 512 + h * 64 + 8 * hi);
        asm volatile("s_waitcnt vmcnt(0)" ::: "memory"); __syncthreads();
        const int cur_n = n; const LAS unsigned char* img = ring + buf * IMG_BYTES;
        const int nitem = item + nwg;
        if (nitem < total) { const unsigned long long le = __ballot(lane < 16 && pre <= nitem); n = (int)__popcll(le); sub = nitem - ((n == 0) ? 0 : __shfl(pre, n - 1));
            img_load(F, ring + (buf ^ 1) * IMG_BYTES, KM, (long)b * S + n * 256, kvh, vt0, n * 256); }
        buf ^= 1;
        if (tile_ok) {
            const float sl2 = moba_sl2(h);
            St st; st.o0 = f32x16{}; st.o1 = f32x16{}; st.m = -INFINITY; st.l = 0.f;
            const int kq = cur_n * 256 - t;
#pragma unroll 1
            for (int i = 0; i < 4; ++i) tile_lds<0, false, true>(st, qr, img, lo, 64 * i, kq + 64 * i, sl2, true, 0, hi, r32);
            const float lt = st.l + __shfl_xor(st.l, 32);
            if (valid) { const size_t slot = (row * 8 + h) * 3 + r; store_o(st, PART + slot * 64, __builtin_amdgcn_rcpf(lt), hi); if (hi == 0) LSE[slot] = st.m + __builtin_amdgcn_logf(lt); }
        }
    }
    asm volatile("s_waitcnt vmcnt(0)" ::: "memory"); __syncthreads();
}
__device__ __forceinline__ void moba_own(const Frame& F, const Ptrs& P) {
    bf16* QM = (bf16*)(P.ws + WS_QM); const bf16* KM = (const bf16*)(P.ws + WS_KM); const bf16* VMT = (const bf16*)(P.ws + WS_VMT);
    const bf16* PART = (const bf16*)(P.ws + WS_PART); const float* LSE = (const float*)(P.ws + WS_LSE);
    const int lane = F.lane, r32 = lane & 31, hi = lane >> 5, w = F.wave;
    LAS unsigned char* img = F.lds + RING_OFF;
    LaneOff lo; lane_off(lo, r32, hi);
    const int half = F.G >> 1, wi = ((int)blockIdx.x + half) % F.G;
    for (int job = wi; job < 128; job += F.G) {
        const int bk = job >> 4, j = job & 15, b = bk >> 1, kvh = bk & 1;
        __syncthreads();
        img_load(F, img, KM, (long)b * S + j * 256, kvh, VMT + (long)((b * 2 + kvh) * 64) * S, j * 256);
        asm volatile("s_waitcnt vmcnt(0)" ::: "memory"); __syncthreads();
        const int nsel = j < 3 ? j : 3;
#pragma unroll 1
        for (int k = 0; k < 4; ++k) {
            const int hg = k, qs = (k & 1) ? 7 - w : w, qo = qs * 32, h = kvh * 4 + hg;
            const float sl2 = moba_sl2(h);
            const int t0 = j * 256 + qo, q = t0 + r32;
            const size_t row = (size_t)(b * S + q);
            bf16* qrow = QM + row * 512 + h * 64;
            bf16x8 qr[4]; loadq(qr, qrow + 8 * hi);
            St st; st.o0 = f32x16{}; st.o1 = f32x16{}; st.m = -INFINITY; st.l = 0.f;
            const int nfull = qo >> 6;
#pragma unroll 1
            for (int i = 0; i < nfull; ++i) tile_lds<0, false, true>(st, qr, img, lo, 64 * i, 64 * i - qo - r32, sl2, true, 0, hi, r32);
            if (qo & 32) tile_lds<2, false, true>(st, qr, img, lo, qo - 32, -32 - r32, sl2, true, 0, hi, r32);
            else tile_lds<2, true, true>(st, qr, img, lo, qo, -r32, sl2, true, 0, hi, r32);
            const float lt = st.l + __shfl_xor(st.l, 32);
            const float lse_own = st.m + __builtin_amdgcn_logf(lt);
            const size_t slot0 = (row * 8 + h) * 3;
            float ls[3]; float M = lse_own;
#pragma unroll
            for (int r = 0; r < 3; ++r) { ls[r] = (r < nsel) ? LSE[slot0 + r] : -INFINITY; M = fmaxf(M, ls[r]); }
            const float w_own = __builtin_amdgcn_exp2f(lse_own - M); float W = w_own; const float s_own = w_own * __builtin_amdgcn_rcpf(lt);
#pragma unroll
            for (int rr = 0; rr < 16; ++rr) { st.o0[rr] *= s_own; st.o1[rr] *= s_own; }
#pragma unroll
            for (int r = 0; r < 3; ++r) { if (r < nsel) { const float wr_ = __builtin_amdgcn_exp2f(ls[r] - M); W += wr_; const bf16* pp = PART + (slot0 + r) * 64 + 4 * hi;
#pragma unroll
                for (int g = 0; g < 4; ++g) { const u32x2 a = *(const u32x2*)(pp + 8 * g), c = *(const u32x2*)(pp + 32 + 8 * g);
                    st.o0[4 * g] += wr_ * bf2f(a.x & 0xffffu); st.o0[4 * g + 1] += wr_ * bf2f(a.x >> 16); st.o0[4 * g + 2] += wr_ * bf2f(a.y & 0xffffu); st.o0[4 * g + 3] += wr_ * bf2f(a.y >> 16);
                    st.o1[4 * g] += wr_ * bf2f(c.x & 0xffffu); st.o1[4 * g + 1] += wr_ * bf2f(c.x >> 16); st.o1[4 * g + 2] += wr_ * bf2f(c.y & 0xffffu); st.o1[4 * g + 3] += wr_ * bf2f(c.y >> 16); } } }
            store_o(st, qrow, __builtin_amdgcn_rcpf(W), hi);
        }
    }
    __syncthreads();
}
}
#ifndef BENCH_AGLU
#define BENCH_AGLU 0
#endif
#ifndef BENCH_KGLU
#define BENCH_KGLU 0
#endif
#ifndef PH_MASK
#define PH_MASK 0xFFF
#endif
#define PH_ON(k) (((PH_MASK) >> (k)) & 1)
constexpr int NPH = 10, PH_FINAL = DEPTH * NPH, PH_TOTAL = PH_FINAL + 1;
struct Args { Ptrs P; int ph_lo, ph_hi, use_bar, sub; };
__global__ void __launch_bounds__(NWAVES * 64, 2) mk_fwd(Args args) {
    extern __shared__ __attribute__((aligned(16))) unsigned char lds[];
    Frame F;
    F.lds = (LAS unsigned char*)lds;
    F.tid = threadIdx.x; F.lane = F.tid & 63; F.wave = __builtin_amdgcn_readfirstlane(F.tid >> 6);
    F.G = gridDim.x; { const int bx = blockIdx.x; F.vcu = (F.G % 8 == 0) ? (bx % 8) * (F.G / 8) + bx / 8 : bx; }
    const Ptrs& P = args.P;
    unsigned char* ws0 = P.ws;
    volatile LAS unsigned* MISC = (volatile LAS unsigned*)(F.lds + MISC_OFF);
    for (int u = F.tid; u < (LDS_BYTES - LDSCTL_OFF) / 4; u += NWAVES * 64) ((LAS unsigned*)(F.lds + LDSCTL_OFF))[u] = 0u;
    __syncthreads();
    XcdBarrier bar; bar.bar = (unsigned*)(ws0 + WS_CTL) + CW_BAR; bar.x = 0; bar.st = nullptr;
    if (args.use_bar) bar = xcd_barrier_post((unsigned*)(ws0 + WS_CTL) + CW_BAR, MISC + 8);
    LAS unsigned char* ring = F.lds + RING_OFF;
    for (int ph = args.ph_lo; ph < args.ph_hi; ++ph) {
#if defined(BENCH_SET)
        const bool bench = ph >= PH_TOTAL; const int l = bench ? DEPTH - 1 : ph / NPH, k = bench ? (ph - PH_TOTAL) % NPH : ph % NPH;
        if (bench && !(((BENCH_SET) >> k) & 1)) continue;
#if defined(BENCH_EMPTY)
        if (bench) { if (ph + 1 < args.ph_hi) xcd_barrier(bar); continue; }
#endif
        const int lc = bench ? DEPTH + (ph - PH_TOTAL) / NPH : l;
#else
        const bool bench = false; const int l = ph / NPH, k = ph % NPH; const int lc = l;
#endif
        unsigned char* ws = ws0; asm volatile("" : "+s"(ws));
        F.tid = threadIdx.x; asm volatile("" : "+v"(F.tid)); F.lane = F.tid & 63;
        int bx = (int)blockIdx.x; asm volatile("" : "+s"(bx));
        if (ph == PH_FINAL && !bench) { if (PH_ON(10)) final_pass(F, P);
        }
        else if (k == 0 && PH_ON(0)) { conv_layer(F, P, l); ssm_mats(F, P, l); if (l == 0) xb_pass(F, P); __syncthreads(); }
        else if (k == 1 && PH_ON(1)) {
            pg8::SrcStd g{(const char*)(ws + WS_XN), (const char*)(ws + WS_WIN), DM}; pg8::StaticOrder So; So.init(T, DIN, F.G, bx);
            pg8::Unit u0; So.next(0, u0); pg8::rinv_build((LAS float*)(F.lds + RINV_OFF), (const float*)(ws + WS_SSQ), u0.pm);
            pg8::EpiInProj E{ws, pg8::RinvTab{(const LAS float*)(F.lds + RINV_OFF)}};
            pg8::gemm_phase<pg8::EpiInProj, pg8::SrcStd, pg8::StaticOrder, true>(ring, g, So, E);
        }
        else if (k == 2 && PH_ON(2)) {
            if (args.sub & 1) { pg8::SrcSsm<false> g{(const char*)(ws + WS_U), nullptr, (const char*)(ws + WS_SEND)}; pg8::SsmOrder So{F.G, bx}; pg8::EpiSsmEnd E{(float*)(ws + WS_HEND)};
                pg8::gemm_phase<pg8::EpiSsmEnd, pg8::SrcSsm<false>, pg8::SsmOrder, true>(ring, g, So, E); }
            if (args.sub & 2) { att::swa_phase(F, P, l); att::moba_select(F, P, lc); }
        }
        else if (k == 3 && PH_ON(3)) {
#ifndef NO_CARRY
            if (args.sub & 1) ssm_carry(F, P, l);
#endif
#ifndef NO_MOBA
            if (args.sub & 2) att::moba_gather(F, P, lc);
#endif
        }
        else if (k == 4 && PH_ON(4)) {
            pg8::SrcSsm<true> g{(const char*)(ws + WS_U), (const char*)(ws + WS_HINIT), (const char*)(ws + WS_SMAIN)}; pg8::SsmOrder So{F.G, bx}; pg8::EpiSsmMain E{(bf16*)(ws + WS_YS)};
            pg8::gemm_phase<pg8::EpiSsmMain, pg8::SrcSsm<true>, pg8::SsmOrder, true>(ring, g, So, E);
            att::moba_own(F, P);
        }
        else if (k == 5 && PH_ON(5)) {
            pg8::SrcStd g{(const char*)(ws + ((bench && BENCH_AGLU) ? WS_MIXED : WS_YS)), (const char*)(ws + WS_WGLU), (bench && BENCH_KGLU) ? BENCH_KGLU : 512}; pg8::StaticOrder So; So.init(T, 1024, F.G, bx); pg8::EpiGlu E{(bf16*)(ws + WS_A1)};
            pg8::gemm_phase<pg8::EpiGlu, pg8::SrcStd, pg8::StaticOrder, true>(ring, g, So, E);
        }
        else if (k == 6 && PH_ON(6)) {
            pg8::SrcMerge g{(const char*)(ws + WS_QA), (const char*)(ws + WS_A1), (const char*)(ws + WS_QM), (const char*)(ws + WS_WMRG)}; pg8::StaticOrder So; So.init(T, DM, F.G, bx);
            pg8::EpiMerge E{(const bf16*)(ws + WS_GATES), (bf16*)(ws + WS_MIXED)};
            pg8::gemm_phase<pg8::EpiMerge, pg8::SrcMerge, pg8::StaticOrder, true>(ring, g, So, E);
        }
        else if ((k == 7 || k == 9) && PH_ON(7)) {
            const bool f2 = (k == 9);
            pg8::SrcStd g{(const char*)(ws + (f2 ? WS_H1 : WS_MIXED)), (const char*)(ws + (f2 ? WS_WFF2 : WS_WOUT)), f2 ? DFF : DM}; pg8::StaticOrder So; So.init(T, DM, F.G, bx); pg8::EpiResid E{bench ? (float*)(ws + WS_QA) : P.x, (bf16*)(ws + (bench ? WS_KM : WS_XN)), (float*)(ws + WS_SSQ)};
            pg8::gemm_phase<pg8::EpiResid, pg8::SrcStd, pg8::StaticOrder, true>(ring, g, So, E);
        }
        else if (k == 8 && PH_ON(8)) {
            pg8::SrcStd g{(const char*)(ws + WS_XN), (const char*)(ws + WS_WFF1), DM}; pg8::StaticOrder So; So.init(T, DFF, F.G, bx);
            pg8::Unit u0; So.next(0, u0); pg8::rinv_build((LAS float*)(F.lds + RINV_OFF), (const float*)(ws + WS_SSQ), u0.pm);
            pg8::EpiFfn1 E{(bf16*)(ws + WS_H1), pg8::RinvTab{(const LAS float*)(F.lds + RINV_OFF)}};
            pg8::gemm_phase<pg8::EpiFfn1, pg8::SrcStd, pg8::StaticOrder, true>(ring, g, So, E);
        }
        if (ph + 1 < args.ph_hi) { if (args.use_bar) xcd_barrier(bar); else __syncthreads(); }
    }
}
extern "C" void kernel_launch(void* const* d_in, const int* in_sizes, int n_in, void* d_out, int out_size, void* d_ws, size_t ws_size, hipStream_t stream) {
    static int grid = 0;
    if (grid == 0) {
        if (n_in != 21 || out_size != T * DM || ws_size < WS_END) { fprintf(stderr, "kernel_launch: unexpected shapes (n_in %d out %d ws %zu)\n", n_in, out_size, ws_size); grid = -1; return; }
        int dev = 0, cus = 0;
        if (hipGetDevice(&dev) != hipSuccess || hipDeviceGetAttribute(&cus, hipDeviceAttributeMultiprocessorCount, dev) != hipSuccess) { grid = -1; return; }
        if (hipFuncSetAttribute((const void*)mk_fwd, hipFuncAttributeMaxDynamicSharedMemorySize, LDS_BYTES) != hipSuccess) { fprintf(stderr, "kernel_launch: hipFuncSetAttribute failed\n"); grid = -1; return; }
        int per_cu = 0;
        if (hipOccupancyMaxActiveBlocksPerMultiprocessor(&per_cu, (const void*)mk_fwd, NWAVES * 64, LDS_BYTES) != hipSuccess || per_cu < 1) { fprintf(stderr, "kernel_launch: occupancy query reports %d workgroups per CU\n", per_cu); (void)hipGetLastError(); }
        grid = cus;
        if (grid != 256) { fprintf(stderr, "kernel_launch: built for a 256-CU device (unit dealing assumes 256 workgroups); found %d CUs; nothing launched\n", cus); grid = -1; return; }
    }
    if (grid < 0) return;
    (void)hipMemsetAsync((char*)d_ws + WS_CTL, 0, CTL_ZERO_BYTES, stream);
    Args a{};
    const float** pp = (const float**)&a.P; for (int i = 0; i < 21; ++i) pp[i] = (const float*)d_in[i];
    a.P.x = (float*)d_out; a.P.ws = (unsigned char*)d_ws;
    #if defined(BENCH_SET)
    a.ph_lo = 0; a.ph_hi = PH_TOTAL + NPH * (BENCH_REPS);
#else
    a.ph_lo = 0; a.ph_hi = PH_TOTAL;
#endif
    a.use_bar = 1; a.sub = 3;
    hipLaunchKernelGGL(mk_fwd, dim3(grid), dim3(NWAVES * 64), LDS_BYTES, stream, a);
}
```

```cpp
#include <hip/hip_runtime.h>
#include <cstdio>
#include <cstdint>

constexpr int NB = 4, S = 4096, T = NB * S, DM = 1024, DEPTH = 4, DIN = 5120, DFF = 4096;
constexpr float LOG2E = 1.4426950408889634f;
constexpr float C2 = 0.125f * LOG2E;
constexpr float NORM_EPS = 1e-6f;
constexpr int SSM_L = 16;
constexpr int SSM_KM = SSM_L * 16 + 128;
constexpr int SSM_KE = SSM_L * 16;
constexpr int NCH = T / SSM_L;

constexpr size_t MiB = 1u << 20;
constexpr size_t WS_CTL = 0, CTL_ZERO_BYTES = 1 * MiB;
constexpr size_t WS_WIN = 1 * MiB, WS_WGLU = 11 * MiB, WS_WMRG = 12 * MiB, WS_WOUT = 15 * MiB, WS_WFF1 = 17 * MiB, WS_WFF2 = 25 * MiB;
constexpr size_t WS_SMAIN = 33 * MiB, WS_SEND = 39 * MiB, WS_KMP = 43 * MiB;
constexpr size_t WS_XN = 44 * MiB;
constexpr size_t WS_QA = 76 * MiB, WS_KA = 92 * MiB, WS_VAT = 96 * MiB, WS_U = 100 * MiB, WS_QM = 116 * MiB, WS_KM = 132 * MiB, WS_VMT = 136 * MiB, WS_GATES = 140 * MiB;
constexpr size_t WS_H1 = 76 * MiB;
constexpr size_t WS_LIST = WS_XN, WS_LSE = WS_XN + 8 * MiB;
constexpr size_t WS_YS = 284 * MiB;
constexpr size_t WS_PART = 236 * MiB;
constexpr size_t WS_A1 = 236 * MiB, WS_MIXED = 252 * MiB, WS_HEND = 284 * MiB, WS_HINIT = 300 * MiB, WS_SSQ = 308 * MiB, WS_END = 309 * MiB;

typedef unsigned short bf16;
typedef short bf16x8 __attribute__((ext_vector_type(8)));
typedef short s16x4 __attribute__((ext_vector_type(4)));
typedef float f32x4 __attribute__((ext_vector_type(4)));
typedef float f32x16 __attribute__((ext_vector_type(16)));
typedef unsigned u32x4 __attribute__((ext_vector_type(4)));
typedef unsigned u32x2 __attribute__((ext_vector_type(2)));

__host__ __device__ __forceinline__ unsigned f2bf(float f) { unsigned u = __builtin_bit_cast(unsigned, f); return (u + 0x7fffu + ((u >> 16) & 1u)) >> 16; }
__host__ __device__ __forceinline__ float bf2f(unsigned b) { return __builtin_bit_cast(float, b << 16); }
typedef float f32x2_t __attribute__((ext_vector_type(2))); typedef __bf16 bf16x2_t __attribute__((ext_vector_type(2)));
__device__ __forceinline__ unsigned cvtpk_s(float lo, float hi) { f32x2_t v = {lo, hi}; bf16x2_t b = __builtin_convertvector(v, bf16x2_t); return __builtin_bit_cast(unsigned, b); }
__device__ __forceinline__ unsigned pk2(float lo, float hi) { return f2bf(lo) | (f2bf(hi) << 16); }
__device__ __forceinline__ float rbf(float f) { return bf2f(f2bf(f)); }
__device__ __forceinline__ float sigmoid_fast(float x) { return __builtin_amdgcn_rcpf(1.f + __builtin_amdgcn_exp2f(-x * LOG2E)); }
__device__ __forceinline__ float gelu_tanh(float x) {
    const float c2 = 2.f * 0.7978845608028654f; const float t = c2 * (x + 0.044715f * x * x * x); return x * sigmoid_fast(t); }
__device__ __forceinline__ float wave_sum(float v) {
#pragma unroll
    for (int o = 1; o < 64; o <<= 1) v += __shfl_xor(v, o);
    return v;
}
__device__ __forceinline__ float wave_max(float v) {
#pragma unroll
    for (int o = 1; o < 64; o <<= 1) v = fmaxf(v, __shfl_xor(v, o));
    return v;
}

struct Ptrs {
    const float *x_in, *norm_mix, *w_in, *sinks, *lam_re, *lam_im, *log_step, *b_re, *b_im, *c_re, *c_im, *d_skip, *w_glu, *w_o_swa, *w_o_ssm, *w_o_moba, *w_out, *norm_ffn, *w_ff1, *w_ff2, *norm_final;
    float* x;
    unsigned char* ws;
};
namespace pg8 {
#define PG8_LAS __attribute__((address_space(3)))
constexpr int BM = 256, BK = 64, HALF = 128, HTB = HALF * BK * 2  , STAGE_BYTES = 8 * HTB, NXCD = 8, WGM = 8;

__host__ __device__ __forceinline__ int lds_byte(int r, int c) { const int st = (r >> 4) * 2 + (c >> 5), rr = r & 15, cc = c & 31, ob = rr * 64 + cc * 2; return st * 1024 + (ob ^ (((ob >> 9) & 1) << 5)); }
__host__ __device__ __forceinline__ void stage_rc(int b, int& R, int& C) { const int st = b / 1024, sb = b % 1024, swz = sb ^ (((sb >> 9) & 1) << 5); R = (st >> 1) * 16 + swz / 64; C = (st & 1) * 32 + (swz % 64) / 2; }
__host__ __device__ __forceinline__ int perm32(int rho) { const int n = rho >> 4, i = rho & 15; return 8 * (i >> 2) + 4 * n + (i & 3); }

struct Unit { int pm, pn; };

struct StaticOrder {
    int nM, nN, nwg, G, c;
    __host__ __device__ void init(int M, int N, int G_, int c_) { nM = M / BM; nN = N / BM; nwg = nM * nN; G = G_; c = c_; }
    __host__ __device__ bool next(int i, Unit& u) const {
        const long L = (long)i * G + c; if (L >= nwg) return false;
        int wgid = (int)L; { const int q = nwg / NXCD, r = nwg % NXCD, xcd = wgid % NXCD, off = wgid / NXCD; wgid = (xcd < r ? xcd * (q + 1) : r * (q + 1) + (xcd - r) * q) + off; }
        const int nig = WGM * nN, gid = wgid / nig, fm = gid * WGM, gsz = (nM - fm) < WGM ? (nM - fm) : WGM;
        u.pm = fm + ((wgid % nig) % gsz); u.pn = (wgid % nig) / gsz; return true;
    }
};
struct SsmOrder {
    int G, c;
    __host__ __device__ bool next(int i, Unit& u) const { const int L = i * G + c; if (L >= 128) return false; u.pn = L >> 2; u.pm = L & 3; return true; }
};

struct SrcStd {
    static constexpr bool TWO_VAR = false;
    const char* A; const char* Bt; int K; int hot;
    __device__ __forceinline__ int nt() const { return K / BK; }
    __device__ __forceinline__ const char* a(const Unit& u, int kt, int h) const { return A + ((size_t)((hot ? 0 : u.pm) * BM + h * HALF) * K + (size_t)kt * BK) * 2; }
    __device__ __forceinline__ const char* b(const Unit& u, int kt, int h) const { return Bt + ((size_t)((hot ? 0 : u.pn) * BM + h * HALF) * K + (size_t)kt * BK) * 2; }
    __device__ __forceinline__ unsigned voffA(int R, int C, int) const { return (unsigned)(R * K + C) * 2u; }
    __device__ __forceinline__ unsigned voffB(int R, int C) const { return (unsigned)(R * K + C) * 2u; }
    __device__ __forceinline__ int avar(int) const { return 0; }
};
struct SrcMerge {
    static constexpr bool TWO_VAR = false;
    const char* A0; const char* A1; const char* A2; const char* Bt;
    __device__ __forceinline__ int nt() const { return 24; }
    __device__ __forceinline__ const char* a(const Unit& u, int kt, int h) const { const int sg = kt >> 3; const char* p = sg == 0 ? A0 : (sg == 1 ? A1 : A2); return p + ((size_t)(u.pm * BM + h * HALF) * 512 + (size_t)(kt & 7) * BK) * 2; }
    __device__ __forceinline__ const char* b(const Unit& u, int kt, int h) const { return Bt + ((size_t)(u.pn * BM + h * HALF) * 1536 + (size_t)kt * BK) * 2; }
    __device__ __forceinline__ unsigned voffA(int R, int C, int) const { return (unsigned)(R * 512 + C) * 2u; }
    __device__ __forceinline__ unsigned voffB(int R, int C) const { return (unsigned)(R * 1536 + C) * 2u; }
    __device__ __forceinline__ int avar(int) const { return 0; }
};
template <bool MAIN> struct SrcSsm {
    static constexpr bool TWO_VAR = MAIN; static constexpr int KTOT = MAIN ? SSM_KM : SSM_KE;
    const char* U; const char* HI; const char* Bt;
    __device__ __forceinline__ int nt() const { return KTOT / BK; }
    __device__ __forceinline__ const char* a(const Unit& u, int kt, int h) const {
        if (!MAIN || kt < 4) return U + ((size_t)(u.pn * NCH + u.pm * BM + h * HALF) * 256 + (size_t)kt * BK) * 2;
        return HI + ((size_t)(u.pn * NCH + u.pm * BM + h * HALF) * 128 + (size_t)(kt - 4) * BK) * 2; }
    __device__ __forceinline__ const char* b(const Unit& u, int kt, int h) const { return Bt + ((size_t)(u.pn * 256 + h * HALF) * KTOT + (size_t)kt * BK) * 2; }
    __device__ __forceinline__ unsigned voffA(int R, int C, int var) const { return var ? (unsigned)(R * 128 + C) * 2u : (unsigned)(R * 256 + C) * 2u; }
    __device__ __forceinline__ unsigned voffB(int R, int C) const { return (unsigned)(R * KTOT + C) * 2u; }
    __device__ __forceinline__ int avar(int kt) const { return (MAIN && kt >= 4) ? 1 : 0; }
};

typedef f32x4 Acc[2][2][4][2];
__device__ __forceinline__ unsigned cvt_pk_bf16(float lo, float hi) { return cvtpk_s(lo, hi); }
__device__ __forceinline__ u32x4 pack8(f32x4 v0, f32x4 v1) { u32x4 w; w.x = cvt_pk_bf16(v0[0], v0[1]); w.y = cvt_pk_bf16(v0[2], v0[3]); w.z = cvt_pk_bf16(v1[0], v1[1]); w.w = cvt_pk_bf16(v1[2], v1[3]); return w; }
__device__ __forceinline__ f32x4 sig4(f32x4 v) { f32x4 o; o[0] = sigmoid_fast(v[0]); o[1] = sigmoid_fast(v[1]); o[2] = sigmoid_fast(v[2]); o[3] = sigmoid_fast(v[3]); return o; }
__device__ __forceinline__ f32x4 unpk_lo(u32x4 w) { f32x4 o; o[0] = bf2f(w.x & 0xffffu); o[1] = bf2f(w.x >> 16); o[2] = bf2f(w.y & 0xffffu); o[3] = bf2f(w.y >> 16); return o; }
__device__ __forceinline__ f32x4 unpk_hi(u32x4 w) { f32x4 o; o[0] = bf2f(w.z & 0xffffu); o[1] = bf2f(w.z >> 16); o[2] = bf2f(w.w & 0xffffu); o[3] = bf2f(w.w >> 16); return o; }
__device__ __forceinline__ f32x4 rcp4(f32x4 v) { f32x4 o; o[0] = __builtin_amdgcn_rcpf(v[0]); o[1] = __builtin_amdgcn_rcpf(v[1]); o[2] = __builtin_amdgcn_rcpf(v[2]); o[3] = __builtin_amdgcn_rcpf(v[3]); return o; }

struct RinvTab { const PG8_LAS float* tab; };
__device__ __forceinline__ void rinv_build(PG8_LAS float* tab, const float* SSQ, int pm0) {
    if (threadIdx.x < 256) { const f32x4* sp = (const f32x4*)(SSQ + (size_t)(pm0 * BM + threadIdx.x) * 16); const f32x4 s = (sp[0] + sp[1]) + (sp[2] + sp[3]); tab[threadIdx.x] = rsqrtf(((s[0] + s[1]) + (s[2] + s[3])) * (1.f / DM) + NORM_EPS); }
    __syncthreads();
}
template <int MODE> __device__ __forceinline__ void st_half_bf16(const Acc& acc, int bj, bf16* base, int ldc, float sc, const PG8_LAS float* ri = nullptr  ) {
    bf16* p = base;
#pragma unroll
    for (int ai = 0; ai < 2; ++ai) {
#pragma unroll
        for (int m = 0; m < 4; ++m) { f32x4 v0 = acc[ai][bj][m][0], v1 = acc[ai][bj][m][1];
            if (ri) { const float rs = ri[ai * HALF + m * 16]; v0 = v0 * rs; v1 = v1 * rs; }
            if (MODE == 0) { v0 = v0 * sc; v1 = v1 * sc; }
            else if (MODE == 1) { v0 = sig4(v0); v1 = sig4(v1); }
            else if (MODE == 2) { v0 = __builtin_elementwise_max(v0, (f32x4){0.f, 0.f, 0.f, 0.f}); v1 = __builtin_elementwise_max(v1, (f32x4){0.f, 0.f, 0.f, 0.f}); v0 = v0 * v0; v1 = v1 * v1; }
            else { v0[0] = gelu_tanh(v0[0]); v0[1] = gelu_tanh(v0[1]); v0[2] = gelu_tanh(v0[2]); v0[3] = gelu_tanh(v0[3]); v1[0] = gelu_tanh(v1[0]); v1[1] = gelu_tanh(v1[1]); v1[2] = gelu_tanh(v1[2]); v1[3] = gelu_tanh(v1[3]); }
            *(u32x4*)p = pack8(v0, v1); asm volatile("" : "+v"(p)); p += (size_t)16 * ldc; }
        p += (size_t)(HALF - 64) * ldc; }
}
__device__ __forceinline__ void st_half_vt(const Acc& acc, int bj, bf16* VT, int b, int s0, int cc, const PG8_LAS float* ri) {
    bf16* p = VT + ((size_t)(b * 2 + (cc >> 6)) * 64 + (cc & 63)) * S + s0;
    float rs[2][4];
#pragma unroll
    for (int ai = 0; ai < 2; ++ai)
#pragma unroll
        for (int m = 0; m < 4; ++m) rs[ai][m] = ri[ai * HALF + m * 16];
#pragma unroll
    for (int n = 0; n < 2; ++n)
#pragma unroll
        for (int e = 0; e < 4; ++e) {
#pragma unroll
            for (int ai = 0; ai < 2; ++ai)
#pragma unroll
                for (int m = 0; m < 4; ++m) p[ai * HALF + m * 16] = (bf16)f2bf(acc[ai][bj][m][n][e] * rs[ai][m]);
            asm volatile("" : "+v"(p)); p += S; }
}

struct EpiInProj {
    static constexpr bool PERM = true, AFTER_DRAIN = false, HAS_MID = false;
    unsigned char* ws; RinvTab RT; int skip;
    __device__ __forceinline__ void operator()(const Acc& acc, const Unit& u, int wr, int wc, int fr, int fq) const {
        if (skip) return;
        bf16 *QA = (bf16*)(ws + WS_QA), *KA = (bf16*)(ws + WS_KA), *VAT = (bf16*)(ws + WS_VAT), *U = (bf16*)(ws + WS_U), *QM = (bf16*)(ws + WS_QM), *KM = (bf16*)(ws + WS_KM), *VMT = (bf16*)(ws + WS_VMT), *GATES = (bf16*)(ws + WS_GATES); float* KMP = (float*)(ws + WS_KMP);
        const int row = u.pm * BM + wr * 64 + fr, cc = wc * 32 + 8 * fq;
        const PG8_LAS float* ri = RT.tab + wr * 64 + fr;
#pragma unroll
        for (int bj = 0; bj < 2; ++bj) {
            const int hc = u.pn * 2 + bj;
            if (hc < 4) st_half_bf16<0>(acc, bj, QA + (size_t)row * 512 + hc * 128 + cc, 512, C2, ri);
            else if (hc == 4) st_half_bf16<0>(acc, bj, KA + (size_t)row * 128 + cc, 128, 1.f, ri);
            else if (hc == 5) st_half_vt(acc, bj, VAT, row / S, row % S, cc, ri);
            else if (hc < 10) { const int ucol = (hc - 6) * 128 + cc;
                st_half_bf16<0>(acc, bj, U + ((size_t)(ucol >> 4) * NCH + ((u.pm * BM + wr * 64) >> 4)) * 256 + fr * 16 + (ucol & 15), 16, 1.f, ri); }
            else if (hc < 14) st_half_bf16<0>(acc, bj, QM + (size_t)row * 512 + (hc - 10) * 128 + cc, 512, C2, ri);
            else if (hc == 14) {
                st_half_bf16<0>(acc, bj, KM + (size_t)row * 128 + cc, 128, 1.f, ri);
                f32x4 c0 = {0.f, 0.f, 0.f, 0.f}, c1 = {0.f, 0.f, 0.f, 0.f};
#pragma unroll
                for (int ai = 0; ai < 2; ++ai)
#pragma unroll
                    for (int m = 0; m < 4; ++m) { const float rs = ri[ai * HALF + m * 16]; c0 += acc[ai][bj][m][0] * rs; c1 += acc[ai][bj][m][1] * rs; }
#pragma unroll
                for (int o = 1; o < 16; o <<= 1)
#pragma unroll
                    for (int e = 0; e < 4; ++e) { c0[e] += __shfl_xor(c0[e], o); c1[e] += __shfl_xor(c1[e], o); }
                if (fr == 0) { float* kp = KMP + (size_t)(wr * 64 + u.pm) * 128 + cc; *(f32x4*)kp = c0; *(f32x4*)(kp + 4) = c1; }
            }
            else if (hc == 15) st_half_vt(acc, bj, VMT, row / S, row % S, cc, ri);
            else st_half_bf16<1>(acc, bj, GATES + (size_t)row * 3072 + (hc - 16) * 128 + cc, 3072, 1.f, ri);
        }
    }
};
struct EpiFfn1 {
    static constexpr bool PERM = true, AFTER_DRAIN = false, HAS_MID = false;
    bf16* H1; RinvTab RT; int skip;
    __device__ __forceinline__ void operator()(const Acc& acc, const Unit& u, int wr, int wc, int fr, int fq) const {
        if (skip) return;
        bf16* base = H1 + (size_t)(u.pm * BM + wr * 64 + fr) * DFF + u.pn * BM + wc * 32 + 8 * fq;
        const PG8_LAS float* ri = RT.tab + wr * 64 + fr;
        st_half_bf16<2>(acc, 0, base, DFF, 1.f, ri); st_half_bf16<2>(acc, 1, base + HALF, DFF, 1.f, ri);
    }
};
struct EpiGlu {
    static constexpr bool PERM = true, AFTER_DRAIN = false, HAS_MID = false;
    bf16* A1;
    __device__ __forceinline__ void operator()(const Acc& acc, const Unit& u, int wr, int wc, int fr, int fq) const {
        bf16* base = A1 + (size_t)(u.pm * BM + wr * 64 + fr) * 512 + u.pn * 128 + wc * 32 + 8 * fq;
#pragma unroll
        for (int ai = 0; ai < 2; ++ai)
#pragma unroll
            for (int m = 0; m < 4; ++m) *(u32x4*)(base + (size_t)(ai * HALF + m * 16) * 512) = pack8(acc[ai][0][m][0] * sig4(acc[ai][1][m][0]), acc[ai][0][m][1] * sig4(acc[ai][1][m][1]));
    }
};
struct EpiMerge {
    static constexpr bool PERM = true, AFTER_DRAIN = false, HAS_MID = true;
    const bf16* GATES; bf16* MIXED;
    __device__ __forceinline__ void mid(Acc& acc, const Unit& u, int t, int wr, int wc, int fr, int fq) const {
        if (t != 8 && t != 16) return;
        const bf16* g = GATES + (size_t)(u.pm * BM + wr * 64 + fr) * 3072 + (t == 8 ? 0 : 1024) + u.pn * BM + wc * 32 + 8 * fq;
#pragma unroll
        for (int ai = 0; ai < 2; ++ai)
#pragma unroll
            for (int m = 0; m < 4; ++m)
#pragma unroll
                for (int bj = 0; bj < 2; ++bj) { const bf16* gp = g + (size_t)(ai * HALF + m * 16) * 3072 + bj * HALF; const u32x4 num = *(const u32x4*)gp, den = *(const u32x4*)(gp + 1024);
                    acc[ai][bj][m][0] = acc[ai][bj][m][0] * (unpk_lo(num) * rcp4(unpk_lo(den))); acc[ai][bj][m][1] = acc[ai][bj][m][1] * (unpk_hi(num) * rcp4(unpk_hi(den))); }
    }
    __device__ __forceinline__ void operator()(const Acc& acc, const Unit& u, int wr, int wc, int fr, int fq) const {
        const size_t ro = (size_t)(u.pm * BM + wr * 64 + fr); const int co = u.pn * BM + wc * 32 + 8 * fq;
#pragma unroll
        for (int ai = 0; ai < 2; ++ai)
#pragma unroll
            for (int m = 0; m < 4; ++m)
#pragma unroll
                for (int bj = 0; bj < 2; ++bj) { const size_t r = ro + ai * HALF + m * 16; const u32x4 g2 = *(const u32x4*)(GATES + r * 3072 + 2048 + co + bj * HALF);
                    *(u32x4*)(MIXED + r * DM + co + bj * HALF) = pack8(acc[ai][bj][m][0] * unpk_lo(g2), acc[ai][bj][m][1] * unpk_hi(g2)); }
    }
};
struct EpiResid {
    static constexpr bool PERM = false, AFTER_DRAIN = false, HAS_MID = false;
    float* X; bf16* XB; float* SSQ;
    __device__ __forceinline__ void operator()(const Acc& acc, const Unit& u, int wr, int wc, int fr, int fq) const {
        const size_t row0 = (size_t)(u.pm * BM + wr * 64 + fr); const int col0 = u.pn * BM + wc * 32 + 4 * fq;
#pragma unroll
        for (int ai = 0; ai < 2; ++ai)
#pragma unroll
            for (int m = 0; m < 4; ++m) { const size_t r = row0 + ai * HALF + m * 16; float ss = 0.f;
#pragma unroll
                for (int bj = 0; bj < 2; ++bj)
#pragma unroll
                    for (int n = 0; n < 2; ++n) { f32x4* p = (f32x4*)(X + r * DM + col0 + bj * HALF + n * 16); const f32x4 v = *p + acc[ai][bj][m][n]; *p = v;
                        ss += (v[0] * v[0] + v[1] * v[1]) + (v[2] * v[2] + v[3] * v[3]);
                        u32x2 w; w.x = cvt_pk_bf16(v[0], v[1]); w.y = cvt_pk_bf16(v[2], v[3]); *(u32x2*)(XB + r * DM + col0 + bj * HALF + n * 16) = w; }
                ss += __shfl_xor(ss, 16); ss += __shfl_xor(ss, 32);
                if (fq == 0) SSQ[r * 16 + u.pn * 4 + wc] = ss; }
    }
};
struct EpiSsmEnd {
    static constexpr bool PERM = false, AFTER_DRAIN = false, HAS_MID = false;
    float* HEND;
    __device__ __forceinline__ void operator()(const Acc& acc, const Unit& u, int wr, int wc, int fr, int fq) const {
        float* base = HEND + ((size_t)u.pn * NCH + u.pm * BM + wr * 64 + fr) * 128 + wc * 32 + 4 * fq;
#pragma unroll
        for (int ai = 0; ai < 2; ++ai)
#pragma unroll
            for (int m = 0; m < 4; ++m)
#pragma unroll
                for (int n = 0; n < 2; ++n) *(f32x4*)(base + (size_t)(ai * HALF + m * 16) * 128 + n * 16) = acc[ai][0][m][n];
    }
};
struct EpiSsmMain {
    static constexpr bool PERM = true, AFTER_DRAIN = false, HAS_MID = false;
    bf16* YS;
    __device__ __forceinline__ void operator()(const Acc& acc, const Unit& u, int wr, int wc, int fr, int fq) const {
        const int mrow = u.pm * BM + wr * 64 + fr;
#pragma unroll
        for (int bj = 0; bj < 2; ++bj) { const int s = 8 * bj + 2 * wc + (fq >> 1);
            bf16* base = YS + ((size_t)mrow * 16 + s) * 512 + u.pn * 16 + 8 * (fq & 1);
            st_half_bf16<3>(acc, bj, base, 16 * 512, 1.f); }
    }
};

template <class Epi, class Src, class Sched, bool ALIGN_EPI>
__device__ __forceinline__ void gemm_phase(PG8_LAS unsigned char* lds, const Src g, const Sched& S, const Epi& E) {
    int tid_ = threadIdx.x; asm volatile("" : "+v"(tid_));
    const int tid = tid_, wid = __builtin_amdgcn_readfirstlane(tid >> 6), lane = tid & 63, wr = wid >> 2, wc = wid & 3, fr = lane & 15, fq = lane >> 4;
    const int nt = g.nt();
    unsigned voffA[2], voffA2[2], voffB[2];
#pragma unroll
    for (int i = 0; i < 2; ++i) { int R, C; stage_rc(tid * 16 + i * 8192, R, C); const int Rb = Epi::PERM ? ((R & ~31) + perm32(R & 31)) : R;
        voffA[i] = g.voffA(R, C, 0); voffA2[i] = Src::TWO_VAR ? g.voffA(R, C, 1) : 0u; voffB[i] = g.voffB(Rb, C); }
    const unsigned ldsw = (unsigned)wid * 1024u;
    const int aoff = lds_byte(wr * 64 + fr, fq * 8), boff = lds_byte(wc * 32 + fr, fq * 8);
#define PG8_SA(b, h) (((b) * 2 + (h)) * HTB)
#define PG8_SB(b, h) ((4 + (b) * 2 + (h)) * HTB)
#define PG8_STAGE_B(bufoff, gbase) do { _Pragma("unroll") for (int _i = 0; _i < 2; ++_i) \
        __builtin_amdgcn_global_load_lds((const unsigned*)((const char*)(gbase) + voffB[_i]), (PG8_LAS unsigned*)(lds + (bufoff) + ldsw + _i * 8192), 16, 0, 0); } while (0)
#define PG8_STAGE_A(bufoff, gbase, kt) do { const bool _v = Src::TWO_VAR && g.avar(kt); _Pragma("unroll") for (int _i = 0; _i < 2; ++_i) { const unsigned _o = _v ? voffA2[_i] : voffA[_i]; \
        __builtin_amdgcn_global_load_lds((const unsigned*)((const char*)(gbase) + _o), (PG8_LAS unsigned*)(lds + (bufoff) + ldsw + _i * 8192), 16, 0, 0); } } while (0)
#define PG8_LDA(dst, b, h) do { _Pragma("unroll") for (int m = 0; m < 4; ++m) _Pragma("unroll") for (int k = 0; k < 2; ++k) dst[m][k] = *(const PG8_LAS bf16x8*)(lds + PG8_SA(b, h) + aoff + m * 2048 + k * 1024); } while (0)
#define PG8_LDB(dst, b, h) do { _Pragma("unroll") for (int n = 0; n < 2; ++n) _Pragma("unroll") for (int k = 0; k < 2; ++k) dst[n][k] = *(const PG8_LAS bf16x8*)(lds + PG8_SB(b, h) + boff + n * 2048 + k * 1024); } while (0)
#define PG8_MMA(ai, bj, At, Bt) do { __builtin_amdgcn_s_setprio(1); _Pragma("unroll") for (int m = 0; m < 4; ++m) _Pragma("unroll") for (int n = 0; n < 2; ++n) _Pragma("unroll") for (int k = 0; k < 2; ++k) \
        acc[ai][bj][m][n] = __builtin_amdgcn_mfma_f32_16x16x32_bf16(Bt[n][k], At[m][k], acc[ai][bj][m][n], 0, 0, 0); __builtin_amdgcn_s_setprio(0); } while (0)
#define PG8_WAIT_V(n) asm volatile("s_waitcnt vmcnt(" #n ")" ::: "memory")
#define PG8_WAIT_L(n) asm volatile("s_waitcnt lgkmcnt(" #n ")" ::: "memory")
#define PG8_BAR __builtin_amdgcn_s_barrier()
#define PG8_SCHED __builtin_amdgcn_sched_barrier(0)
    Unit cur, nxt; int ui = 0;
    if (!S.next(0, cur)) return;
    Acc acc;
#pragma unroll
    for (int a = 0; a < 2; ++a)
#pragma unroll
        for (int b = 0; b < 2; ++b)
#pragma unroll
            for (int m = 0; m < 4; ++m)
#pragma unroll
                for (int n = 0; n < 2; ++n) acc[a][b][m][n] = (f32x4){0.f, 0.f, 0.f, 0.f};
    bf16x8 At[4][2], B0[2][2], B1[2][2];
    PG8_STAGE_B(PG8_SB(0, 0), g.b(cur, 0, 0)); PG8_STAGE_B(PG8_SB(0, 1), g.b(cur, 0, 1)); PG8_STAGE_A(PG8_SA(0, 0), g.a(cur, 0, 0), 0); PG8_STAGE_A(PG8_SA(0, 1), g.a(cur, 0, 1), 0);
    if (wr == 1) PG8_BAR;
    PG8_WAIT_V(2); PG8_BAR;
    PG8_STAGE_B(PG8_SB(1, 0), g.b(cur, 1, 0)); PG8_STAGE_A(PG8_SA(1, 0), g.a(cur, 1, 0), 1); PG8_STAGE_B(PG8_SB(1, 1), g.b(cur, 1, 1));
    PG8_WAIT_V(6); PG8_BAR;
    for (;;) {
        const bool has_next = S.next(ui + 1, nxt);
        const Unit nu = has_next ? nxt : cur;
        for (int t = 0; t < nt; t += 2) {
            const bool last = (t == nt - 2);
            if constexpr (Epi::HAS_MID) E.mid(acc, cur, t, wr, wc, fr, fq);
            const Unit u2 = last ? nu : cur; const int k2 = last ? 0 : t + 2, k3 = k2 + 1;
            PG8_LDB(B0, 0, 0); PG8_LDB(B1, 0, 1); PG8_SCHED; PG8_LDA(At, 0, 0); PG8_STAGE_A(PG8_SA(1, 1), g.a(cur, t + 1, 1), t + 1);
            PG8_WAIT_V(8); PG8_WAIT_L(0); PG8_BAR; PG8_MMA(0, 0, At, B0); PG8_MMA(0, 1, At, B1); PG8_BAR; PG8_SCHED;
            PG8_LDA(At, 0, 1); PG8_STAGE_B(PG8_SB(0, 0), g.b(u2, k2, 0)); PG8_STAGE_B(PG8_SB(0, 1), g.b(u2, k2, 1)); PG8_STAGE_A(PG8_SA(0, 0), g.a(u2, k2, 0), k2);
            PG8_WAIT_V(8); PG8_WAIT_L(0); PG8_BAR; PG8_MMA(1, 0, At, B0); PG8_MMA(1, 1, At, B1); PG8_BAR; PG8_SCHED;
            PG8_LDB(B0, 1, 0); PG8_LDB(B1, 1, 1); PG8_SCHED; PG8_LDA(At, 1, 0); PG8_STAGE_A(PG8_SA(0, 1), g.a(u2, k2, 1), k2);
            PG8_WAIT_V(8); PG8_WAIT_L(0); PG8_BAR; PG8_MMA(0, 0, At, B0); PG8_MMA(0, 1, At, B1); PG8_BAR; PG8_SCHED;
            PG8_LDA(At, 1, 1); PG8_STAGE_B(PG8_SB(1, 0), g.b(u2, k3, 0)); PG8_STAGE_B(PG8_SB(1, 1), g.b(u2, k3, 1)); PG8_STAGE_A(PG8_SA(1, 0), g.a(u2, k3, 0), k3);
            PG8_WAIT_V(8); PG8_WAIT_L(0); PG8_BAR; PG8_MMA(1, 0, At, B0); PG8_MMA(1, 1, At, B1); PG8_BAR; PG8_SCHED;
        }
        if constexpr (ALIGN_EPI) { if (wr == 0) PG8_BAR; }
        { int fr_ = fr, fq_ = fq; asm volatile("" : "+v"(fr_), "+v"(fq_));
          E(acc, cur, wr, wc, fr_, fq_); }
        if (!has_next) break;
#pragma unroll
        for (int a = 0; a < 2; ++a)
#pragma unroll
            for (int b = 0; b < 2; ++b)
#pragma unroll
                for (int m = 0; m < 4; ++m)
#pragma unroll
                    for (int n = 0; n < 2; ++n) acc[a][b][m][n] = (f32x4){0.f, 0.f, 0.f, 0.f};
        cur = nxt; ++ui;
        if constexpr (ALIGN_EPI) { if (wr == 1) PG8_BAR; }
    }
    PG8_WAIT_V(0);
    if constexpr (!ALIGN_EPI) { if (wr == 0) PG8_BAR; }
    PG8_BAR;
#undef PG8_SA
#undef PG8_SB
#undef PG8_STAGE_A
#undef PG8_STAGE_B
#undef PG8_LDA
#undef PG8_LDB
#undef PG8_MMA
#undef PG8_WAIT_V
#undef PG8_WAIT_L
#undef PG8_BAR
#undef PG8_SCHED
}
}
constexpr int NWAVES = 8;
constexpr int RING_OFF = 0, RING_BYTES = 131072;
constexpr int LDSCTL_OFF = RING_BYTES, MISC_OFF = LDSCTL_OFF + 320, RINV_OFF = LDSCTL_OFF + 1024;
constexpr int LDS_BYTES = 147456;
constexpr int CW_TMO = 0, CW_CODE = 1, CW_BAR = 4096, CW_CNT = 16384, CW_OWNQ = 20480;

#define GAS __attribute__((address_space(1)))
#define LAS __attribute__((address_space(3)))
typedef GAS unsigned gu32;
#define RLX_AGENT __ATOMIC_RELAXED, __HIP_MEMORY_SCOPE_AGENT
#define LDS_WAIT() asm volatile("s_waitcnt lgkmcnt(0)" ::: "memory")
#define VM_WAIT() asm volatile("s_waitcnt vmcnt(0)" ::: "memory")

#define XB_TMO      128
#define XB_XCNT(j)  (256  + 64 * (j))
#define XB_XSUB(j)  (1280 + 64 * (j))
#define XB_XGEN(j)  (2304 + 64 * (j))
#define XB_TOP      3328
#define XB_TOPGEN   3392
#define XCD_BAR_WORDS 3456
#define XB_SPIN_CAP (1u << 20)
__device__ __forceinline__ unsigned xb_ld(unsigned* p)              { return __hip_atomic_load(p, __ATOMIC_RELAXED, __HIP_MEMORY_SCOPE_AGENT); }
__device__ __forceinline__ unsigned xb_add(unsigned* p, unsigned v) { return __hip_atomic_fetch_add(p, v, __ATOMIC_RELAXED, __HIP_MEMORY_SCOPE_AGENT); }
__device__ __forceinline__ unsigned xb_xcc_id() { return (unsigned)__builtin_amdgcn_s_getreg((3 << 11) | 20) & 0xFu; }
#define XB_SPIN(cond, bar) do { unsigned _sp = 0; while (cond) { __builtin_amdgcn_s_sleep(1); \
    if ((++_sp & 255u) == 0u) { if (xb_ld(&(bar)[XB_TMO])) break; if (_sp > XB_SPIN_CAP) { atomicAdd(&(bar)[XB_TMO], 1u); break; } } } } while (0)
struct XcdBarrier { unsigned* bar; unsigned x; volatile LAS unsigned* st; };
__device__ __forceinline__ XcdBarrier xcd_barrier_post(unsigned* bar, volatile LAS unsigned* st) {
    XcdBarrier b; b.bar = bar; b.x = xb_xcc_id(); b.st = st;
    if (threadIdx.x == 0) (void)xb_add(&bar[XB_XCNT(b.x)], 1u);
    return b;
}
__device__ __forceinline__ void xcd_barrier_complete(unsigned* bar, unsigned x, unsigned& nloc, unsigned& nx) {
    const unsigned G = gridDim.x * gridDim.y * gridDim.z;
    unsigned sum, cnt, mine, sp = 0u;
    for (;;) {
        sum = 0u; cnt = 0u; mine = 0u;
#pragma unroll
        for (unsigned j = 0; j < 16; ++j) { const unsigned c = xb_ld(&bar[XB_XCNT(j)]); sum += c; cnt += (c > 0u) ? 1u : 0u; mine = (j == x) ? c : mine; }
        if (sum == G) break;
        __builtin_amdgcn_s_sleep(1);
        if ((++sp & 255u) == 0u) { if (xb_ld(&bar[XB_TMO])) break; if (sp > XB_SPIN_CAP) { atomicAdd(&bar[XB_TMO], 1u); break; } }
    }
    nloc = mine > 0u ? mine : 1u; nx = cnt > 0u ? cnt : 1u;
}
__device__ __forceinline__ void xcd_barrier(const XcdBarrier& b) {
    asm volatile("s_waitcnt vmcnt(0)" ::: "memory");
    __syncthreads();
    if (threadIdx.x == 0) {
        unsigned* bar = b.bar;
        __builtin_amdgcn_s_waitcnt(0);
        unsigned nloc = b.st[0], nx = b.st[1];
        if (nloc == 0u) { xcd_barrier_complete(bar, b.x, nloc, nx); b.st[0] = nloc; b.st[1] = nx; }
        const unsigned old = xb_add(&bar[XB_XSUB(b.x)], 1u);
        const unsigned gen = old / nloc;
        if (old + 1u == (gen + 1u) * nloc) {
            __builtin_amdgcn_fence(__ATOMIC_RELEASE, "agent");
            asm volatile("s_waitcnt vmcnt(0)" ::: "memory");
            const unsigned og = xb_add(&bar[XB_TOP], 1u);
            const unsigned tg = og / nx;
            if (og + 1u == (tg + 1u) * nx) xb_add(&bar[XB_TOPGEN], 1u);
            else XB_SPIN(xb_ld(&bar[XB_TOPGEN]) == tg, bar);
            __builtin_amdgcn_fence(__ATOMIC_ACQUIRE, "agent");
            xb_add(&bar[XB_XGEN(b.x)], 1u);
            asm volatile("s_waitcnt vmcnt(0)" ::: "memory");
        } else {
            XB_SPIN(xb_ld(&bar[XB_XGEN(b.x)]) == gen, bar);
            __builtin_amdgcn_fence(__ATOMIC_ACQUIRE, "agent");
            asm volatile("s_waitcnt vmcnt(0)" ::: "memory");
        }
    }
    __syncthreads();
}

struct Frame {
    LAS unsigned char* lds;
    int tid, lane, wave, vcu, G;
};

struct ConvItem { const float* W; const float* gain; bf16* WT; int N, Kdst, k_off, k0, n0, drow0; };
__device__ __forceinline__ bool conv_decode(ConvItem& c, const Ptrs& P, int l, int it) {
    constexpr int I_IN = 16 * 160, I_GLU = 8 * 32, I_MRG = 3 * 8 * 32, I_OUT = 16 * 32, I_F1 = 16 * 128, I_F2 = 64 * 32;
    constexpr int NITEMS = I_IN + I_GLU + I_MRG + I_OUT + I_F1 + I_F2;
    if (it >= NITEMS) return false;
    unsigned char* ws = P.ws; int r = it; c.gain = nullptr; c.k_off = 0;
    if (r < I_IN) { const int kb = r / 160, nb = r % 160; c.W = P.w_in + (size_t)l * DM * DIN; c.N = DIN; c.gain = P.norm_mix + l * DM; c.WT = (bf16*)(ws + WS_WIN); c.Kdst = DM; c.k0 = 64 * kb; c.n0 = 32 * nb; c.drow0 = 32 * nb; return true; } r -= I_IN;
    if (r < I_GLU) { const int kb = r / 32, nb = r % 32; const int n0 = 32 * nb, v = n0 & 511;
        c.W = P.w_glu + (size_t)l * 512 * 1024; c.N = 1024; c.WT = (bf16*)(ws + WS_WGLU); c.Kdst = 512; c.k0 = 64 * kb; c.n0 = n0; c.drow0 = (v >> 7) * 256 + (n0 >= 512 ? 128 : 0) + (v & 127); return true; } r -= I_GLU;
    if (r < I_MRG) { const int sg = r / 256, q = r % 256, kb = q / 32, nb = q % 32; c.W = (sg == 0 ? P.w_o_swa : (sg == 1 ? P.w_o_ssm : P.w_o_moba)) + (size_t)l * 512 * DM;
        c.N = DM; c.WT = (bf16*)(ws + WS_WMRG); c.Kdst = 1536; c.k_off = 512 * sg; c.k0 = 64 * kb; c.n0 = 32 * nb; c.drow0 = 32 * nb; return true; } r -= I_MRG;
    if (r < I_OUT) { const int kb = r / 32, nb = r % 32; c.W = P.w_out + (size_t)l * DM * DM; c.N = DM; c.WT = (bf16*)(ws + WS_WOUT); c.Kdst = DM; c.k0 = 64 * kb; c.n0 = 32 * nb; c.drow0 = 32 * nb; return true; } r -= I_OUT;
    if (r < I_F1) { const int kb = r / 128, nb = r % 128; c.W = P.w_ff1 + (size_t)l * DM * DFF; c.N = DFF; c.gain = P.norm_ffn + l * DM; c.WT = (bf16*)(ws + WS_WFF1); c.Kdst = DM; c.k0 = 64 * kb; c.n0 = 32 * nb; c.drow0 = 32 * nb; return true; } r -= I_F1;
    { const int kb = r / 32, nb = r % 32; c.W = P.w_ff2 + (size_t)l * DFF * DM; c.N = DM; c.WT = (bf16*)(ws + WS_WFF2); c.Kdst = DFF; c.k0 = 64 * kb; c.n0 = 32 * nb; c.drow0 = 32 * nb; return true; }
}
__device__ __forceinline__ void conv_loads(f32x4 (&wv)[8], const ConvItem& c, int lane) {
#pragma unroll
    for (int i = 0; i < 8; ++i) wv[i] = *(const f32x4*)(c.W + (size_t)(c.k0 + 8 * i + (lane >> 3)) * c.N + c.n0 + 4 * (lane & 7));
}
__device__ __forceinline__ void conv_store(const f32x4 (&wv)[8], const ConvItem& c, LAS float* scr, int lane) {
#pragma unroll
    for (int i = 0; i < 8; ++i) { const int kk = 8 * i + (lane >> 3); const float g = c.gain ? c.gain[c.k0 + kk] : 1.f; LAS float* sp = scr + kk * 33 + 4 * (lane & 7);
        sp[0] = wv[i][0] * g; sp[1] = wv[i][1] * g; sp[2] = wv[i][2] * g; sp[3] = wv[i][3] * g; }
    LDS_WAIT(); asm volatile("" ::: "memory");
    const int cc = lane & 7;
#pragma unroll
    for (int j = 0; j < 4; ++j) { const int n = (lane >> 3) + 8 * j; const LAS float* s = scr + (8 * cc) * 33 + n;
        u32x4 o; o.x = pk2(s[0 * 33], s[1 * 33]); o.y = pk2(s[2 * 33], s[3 * 33]); o.z = pk2(s[4 * 33], s[5 * 33]); o.w = pk2(s[6 * 33], s[7 * 33]);
        *(GAS u32x4*)(c.WT + (size_t)(c.drow0 + n) * c.Kdst + c.k_off + c.k0 + 8 * cc) = o; }
    LDS_WAIT(); asm volatile("" ::: "memory");
}
__device__ __forceinline__ void conv_layer(const Frame& F, const Ptrs& P, int l) {
    LAS float* scr = (LAS float*)(F.lds + RING_OFF + F.wave * 16384);
    const int gw = F.vcu * NWAVES + F.wave, NGW = F.G * NWAVES;
    f32x4 wa[8], wb[8];
    int it = gw; bool have;
    { ConvItem c; have = conv_decode(c, P, l, it); if (have) conv_loads(wa, c, F.lane); }
#pragma unroll 1
    while (have) {
        bool hn; { ConvItem n; hn = conv_decode(n, P, l, it + NGW); if (hn) conv_loads(wb, n, F.lane); }
        { ConvItem c; conv_decode(c, P, l, it); asm volatile("" ::: "memory"); conv_store(wa, c, scr, F.lane); }
        have = hn; it += NGW;
#pragma unroll
        for (int i = 0; i < 8; ++i) wa[i] = wb[i];
    }
}
__device__ __forceinline__ void ssm_mats(const Frame& F, const Ptrs& P, int l) {
    __syncthreads();
    LAS float* L = (LAS float*)(F.lds + RING_OFF);
    LAS float* apr = L;
    LAS float* api = L + 17 * 64;
    LAS float* bbr = L + 34 * 64;
    LAS float* bbi = bbr + 1024;
    LAS float* ccr = bbi + 1024;
    LAS float* cci = ccr + 1024;
    LAS float* ktab = cci + 1024;
    for (int wi = F.vcu; wi < 256; wi += F.G) {
        const int g = wi >> 3, part = wi & 7; const int tid = F.tid;
        if (tid < 64) { const int p = tid; const float lr = P.lam_re[l * 2048 + g * 64 + p], li = P.lam_im[l * 2048 + g * 64 + p], dt = expf(P.log_step[l * 32 + g]);
            const float mag = expf(lr * dt), are = mag * cosf(li * dt), aim = mag * sinf(li * dt);
            const float den = lr * lr + li * li, nr = are - 1.f, ni = aim, fre = (nr * lr + ni * li) / den, fim = (ni * lr - nr * li) / den;
            float pr = 1.f, pi = 0.f;
            for (int k = 0; k <= 16; ++k) { apr[k * 64 + p] = pr; api[k * 64 + p] = pi; const float t = pr * are - pi * aim; pi = pr * aim + pi * are; pr = t; }
            for (int h = 0; h < 16; ++h) { const float br = P.b_re[(size_t)l * 32768 + (g * 64 + p) * 16 + h], bi = P.b_im[(size_t)l * 32768 + (g * 64 + p) * 16 + h]; bbr[p * 16 + h] = fre * br - fim * bi; bbi[p * 16 + h] = fre * bi + fim * br; } }
        for (int e = tid; e < 1024; e += 512) { ccr[e] = P.c_re[(size_t)l * 32768 + g * 1024 + e]; cci[e] = P.c_im[(size_t)l * 32768 + g * 1024 + e]; }
        __syncthreads();
        for (int e = tid; e < 512; e += 512) { const int tau = e >> 5, i = 2 * part + ((e >> 4) & 1), j = e & 15; float acc = 0.f;
            for (int p = 0; p < 64; ++p) { const float cr = ccr[i * 64 + p], ci = cci[i * 64 + p], ar = apr[tau * 64 + p], ai = api[tau * 64 + p]; const float er = cr * ar - ci * ai, ei = cr * ai + ci * ar; acc += er * bbr[p * 16 + j] - ei * bbi[p * 16 + j]; }
            if (tau == 0 && i == j) acc += P.d_skip[l * 512 + g * 16 + i];
            ktab[tau * 256 + i * 16 + j] = acc; }
        __syncthreads();
        bf16* BM_ = (bf16*)(P.ws + WS_SMAIN) + (size_t)g * 256 * SSM_KM;
        for (int e = tid; e < 32 * SSM_KM / 2; e += 512) {
            const int rr = e / (SSM_KM / 2), k = (e % (SSM_KM / 2)) * 2, s = rr >> 1, i = 2 * part + (rr & 1), n = s * 16 + i; float v[2];
#pragma unroll
            for (int q = 0; q < 2; ++q) { const int kk = k + q;
                if (kk < 256) { const int sp = kk >> 4, j = kk & 15; v[q] = (sp <= s) ? ktab[(s - sp) * 256 + i * 16 + j] : 0.f; }
                else { const int p = (kk - 256) & 63; const float cr = ccr[i * 64 + p], ci = cci[i * 64 + p], ar = apr[(s + 1) * 64 + p], ai = api[(s + 1) * 64 + p]; v[q] = (kk < 320) ? (cr * ar - ci * ai) : -(cr * ai + ci * ar); } }
            *(GAS unsigned*)(BM_ + (size_t)n * SSM_KM + k) = pk2(v[0], v[1]); }
        bf16* BE_ = (bf16*)(P.ws + WS_SEND) + (size_t)g * 256 * SSM_KE;
        for (int e = tid; e < 32 * SSM_KE / 2; e += 512) {
            const int n = part * 32 + e / (SSM_KE / 2), k = (e % (SSM_KE / 2)) * 2; float v[2];
#pragma unroll
            for (int q = 0; q < 2; ++q) { const int kk = k + q, sp = kk >> 4, j = kk & 15, p = n & 63; const float ar = apr[(15 - sp) * 64 + p], ai = api[(15 - sp) * 64 + p], br = bbr[p * 16 + j], bi = bbi[p * 16 + j];
                v[q] = (n < 64) ? (ar * br - ai * bi) : ((n < 128) ? (ar * bi + ai * br) : 0.f); }
            *(GAS unsigned*)(BE_ + (size_t)n * SSM_KE + k) = pk2(v[0], v[1]); }
        __syncthreads();
    }
}
__device__ __forceinline__ void xb_pass(const Frame& F, const Ptrs& P) {
    const int gw = F.vcu * NWAVES + F.wave, NGW = F.G * NWAVES;
    bf16* XB = (bf16*)(P.ws + WS_XN); float* SSQ = (float*)(P.ws + WS_SSQ);
    for (int m = gw; m < T; m += NGW) {
        const GAS f32x4* xr = (const GAS f32x4*)(P.x_in + (size_t)m * DM) + F.lane;
        f32x4 v[4]; float s = 0.f;
#pragma unroll
        for (int j = 0; j < 4; ++j) { v[j] = xr[64 * j]; s += (v[j].x * v[j].x + v[j].y * v[j].y) + (v[j].z * v[j].z + v[j].w * v[j].w); }
        s = wave_sum(s);
        GAS f32x4* xo = (GAS f32x4*)(P.x + (size_t)m * DM) + F.lane;
#pragma unroll
        for (int j = 0; j < 4; ++j) xo[64 * j] = v[j];
        GAS unsigned long long* o8 = (GAS unsigned long long*)(XB + (size_t)m * DM) + F.lane;
#pragma unroll
        for (int j = 0; j < 4; ++j) o8[64 * j] = (unsigned long long)pk2(v[j].x, v[j].y) | ((unsigned long long)pk2(v[j].z, v[j].w) << 32);
        if (F.lane < 16) SSQ[(size_t)m * 16 + F.lane] = (F.lane == 0) ? s : 0.f;
    }
}
__device__ __forceinline__ void final_pass(const Frame& F, const Ptrs& P) {
    const int gw = F.vcu * NWAVES + F.wave, NGW = F.G * NWAVES;
    for (int m = gw; m < T; m += NGW) {
        GAS f32x4* xr = (GAS f32x4*)(P.x + (size_t)m * DM) + F.lane;
        f32x4 v[4]; float s = 0.f;
#pragma unroll
        for (int j = 0; j < 4; ++j) { v[j] = xr[64 * j]; s += (v[j].x * v[j].x + v[j].y * v[j].y) + (v[j].z * v[j].z + v[j].w * v[j].w); }
        const float r = rsqrtf(wave_sum(s) * (1.f / DM) + NORM_EPS);
#pragma unroll
        for (int j = 0; j < 4; ++j) { const f32x4 g = ((const GAS f32x4*)P.norm_final)[F.lane + 64 * j]; xr[64 * j] = v[j] * r * g; }
    }
}
__device__ __forceinline__ void ssm_carry(const Frame& F, const Ptrs& P, int l) {
    if (F.vcu & 15) return;
    const int gt = (F.vcu >> 4) * 512 + F.tid;
    if (gt >= 32 * NB * 64) return;
    const int p = gt & 63, b = (gt >> 6) & 3, g = gt >> 8;
    const float lr = P.lam_re[l * 2048 + g * 64 + p], li = P.lam_im[l * 2048 + g * 64 + p], dt = expf(P.log_step[l * 32 + g]);
    const float mag = expf(lr * dt), are = mag * cosf(li * dt), aim = mag * sinf(li * dt);
    float pr = 1.f, pi = 0.f;
    for (int k = 0; k < 16; ++k) { const float t = pr * are - pi * aim; pi = pr * aim + pi * are; pr = t; }
    const float* he = (const float*)(P.ws + WS_HEND) + ((size_t)g * NCH + b * 256) * 128 + p;
    bf16* hi = (bf16*)(P.ws + WS_HINIT) + ((size_t)g * NCH + b * 256) * 128 + p;
    float sr = 0.f, si = 0.f;
    float er[8], ei[8];
#pragma unroll
    for (int q = 0; q < 8; ++q) { er[q] = he[(size_t)q * 128]; ei[q] = he[(size_t)q * 128 + 64]; }
    for (int c0 = 0; c0 < 256; c0 += 8) {
        float nr_[8], ni_[8];
        const int cn = (c0 + 8 < 256) ? c0 + 8 : c0;
#pragma unroll
        for (int q = 0; q < 8; ++q) { nr_[q] = he[(size_t)(cn + q) * 128]; ni_[q] = he[(size_t)(cn + q) * 128 + 64]; }
#pragma unroll
        for (int q = 0; q < 8; ++q) { hi[(size_t)(c0 + q) * 128] = (bf16)f2bf(sr); hi[(size_t)(c0 + q) * 128 + 64] = (bf16)f2bf(si);
            const float tr = pr * sr - pi * si + er[q], ti = pr * si + pi * sr + ei[q]; sr = tr; si = ti; }
#pragma unroll
        for (int q = 0; q < 8; ++q) { er[q] = nr_[q]; ei[q] = ni_[q]; }
    }
}
namespace att {
__device__ __forceinline__ int crow(int r, int hi) { return (r & 3) + 8 * (r >> 2) + 4 * hi; }
struct St { f32x16 o0, o1; float m, l; };
__device__ __forceinline__ unsigned cvtpk(float lo, float hi) { return cvtpk_s(lo, hi); }

__device__ __forceinline__ void loadk(bf16x8 (&kf)[8], const bf16* kp) {
#pragma unroll
    for (int d0 = 0; d0 < 4; ++d0) { kf[2 * d0] = *(const bf16x8*)(kp + d0 * 16); kf[2 * d0 + 1] = *(const bf16x8*)(kp + 32 * 128 + d0 * 16); }
}
template <int MODE>
__device__ __forceinline__ void tile(St& st, const bf16x8 (&qr)[4], const bf16x8 (&kf)[8], const bf16* vtp  , int kq  , float sl2, bool rowok, int klo  , int hi) {
    f32x16 p0 = {}, p1 = {};
#pragma unroll
    for (int d0 = 0; d0 < 4; ++d0) { p0 = __builtin_amdgcn_mfma_f32_32x32x16_bf16(kf[2 * d0], qr[d0], p0, 0, 0, 0); p1 = __builtin_amdgcn_mfma_f32_32x32x16_bf16(kf[2 * d0 + 1], qr[d0], p1, 0, 0, 0); }
    s16x4 vl[2][4], vh[2][4];
#pragma unroll
    for (int dh = 0; dh < 2; ++dh)
#pragma unroll
        for (int s = 0; s < 4; ++s) { vl[dh][s] = *(const s16x4*)(vtp + (size_t)dh * 32 * S + 16 * s); vh[dh][s] = *(const s16x4*)(vtp + (size_t)dh * 32 * S + 16 * s + 8); }
    const float base = sl2 * (float)(kq + 4 * hi);
    float mx = -INFINITY;
#pragma unroll
    for (int r = 0; r < 16; ++r) { const int c = (r & 3) + 8 * (r >> 2); const int k0 = kq + 4 * hi + c, k1 = k0 + 32;
        float a = fmaf(sl2, (float)c, p0[r]), b = fmaf(sl2, (float)(c + 32), p1[r]);
        if (MODE == 1) { a = (k0 <= 0 && k0 >= klo) ? a : -INFINITY; b = (k1 <= 0 && k1 >= klo) ? b : -INFINITY; }
        else if (MODE == 2) { a = (k0 <= 0) ? a : -INFINITY; b = (k1 <= 0) ? b : -INFINITY; }
        else if (MODE == 3) { a = (rowok && k0 <= 0) ? a : -INFINITY; b = (rowok && k1 <= 0) ? b : -INFINITY; }
        p0[r] = a; p1[r] = b; mx = fmaxf(mx, fmaxf(a, b)); }
    mx += base;
    mx = fmaxf(mx, __shfl_xor(mx, 32));
    const float mn = fmaxf(st.m, mx), alpha = __builtin_amdgcn_exp2f(st.m - mn), off = base - mn;
    float sum = 0.f;
#pragma unroll
    for (int r = 0; r < 16; ++r) { p0[r] = __builtin_amdgcn_exp2f(p0[r] + off); p1[r] = __builtin_amdgcn_exp2f(p1[r] + off); sum += p0[r] + p1[r]; }
    st.m = mn; st.l = st.l * alpha + sum;
#pragma unroll
    for (int r = 0; r < 16; ++r) { st.o0[r] *= alpha; st.o1[r] *= alpha; }
    bf16x8 pf[4];
#pragma unroll
    for (int s = 0; s < 2; ++s) { u32x4 w0, w1;
        w0.x = cvtpk(p0[8 * s + 0], p0[8 * s + 1]); w0.y = cvtpk(p0[8 * s + 2], p0[8 * s + 3]); w0.z = cvtpk(p0[8 * s + 4], p0[8 * s + 5]); w0.w = cvtpk(p0[8 * s + 6], p0[8 * s + 7]);
        w1.x = cvtpk(p1[8 * s + 0], p1[8 * s + 1]); w1.y = cvtpk(p1[8 * s + 2], p1[8 * s + 3]); w1.z = cvtpk(p1[8 * s + 4], p1[8 * s + 5]); w1.w = cvtpk(p1[8 * s + 6], p1[8 * s + 7]);
        pf[s] = __builtin_bit_cast(bf16x8, w0); pf[2 + s] = __builtin_bit_cast(bf16x8, w1); }
#pragma unroll
    for (int s = 0; s < 4; ++s) {
        const bf16x8 v0 = (bf16x8){vl[0][s][0], vl[0][s][1], vl[0][s][2], vl[0][s][3], vh[0][s][0], vh[0][s][1], vh[0][s][2], vh[0][s][3]};
        const bf16x8 v1 = (bf16x8){vl[1][s][0], vl[1][s][1], vl[1][s][2], vl[1][s][3], vh[1][s][0], vh[1][s][1], vh[1][s][2], vh[1][s][3]};
        st.o0 = __builtin_amdgcn_mfma_f32_32x32x16_bf16(v0, pf[s], st.o0, 0, 0, 0);
        st.o1 = __builtin_amdgcn_mfma_f32_32x32x16_bf16(v1, pf[s], st.o1, 0, 0, 0); }
}
__device__ __forceinline__ void finish(const St& st, bf16* op, int hi) {
    const float lt = st.l + __shfl_xor(st.l, 32), rl = __builtin_amdgcn_rcpf(lt);
#pragma unroll
    for (int g = 0; g < 4; ++g) { u32x2 a, b;
        a.x = cvtpk(st.o0[4 * g] * rl, st.o0[4 * g + 1] * rl); a.y = cvtpk(st.o0[4 * g + 2] * rl, st.o0[4 * g + 3] * rl);
        b.x = cvtpk(st.o1[4 * g] * rl, st.o1[4 * g + 1] * rl); b.y = cvtpk(st.o1[4 * g + 2] * rl, st.o1[4 * g + 3] * rl);
        *(u32x2*)(op + 8 * g + 4 * hi) = a; *(u32x2*)(op + 32 + 8 * g + 4 * hi) = b; }
}
__device__ __forceinline__ void loadq(bf16x8 (&qr)[4], const bf16* qp) {
#pragma unroll
    for (int d0 = 0; d0 < 4; ++d0) qr[d0] = *(const bf16x8*)(qp + d0 * 16);
}

constexpr int IMG_K = 0, IMG_V = 32768, IMG_BYTES = 65536;
__device__ __forceinline__ void img_load(const Frame& F, LAS unsigned char* img, const bf16* K, long krow0, int kvh, const bf16* vt0, int key0) {
    const int lane = F.lane, w = F.wave;
#pragma unroll
    for (int i = 0; i < 4; ++i) { const int piece = w * 4 + i, key = piece * 8 + (lane >> 3), c = (lane & 7) ^ ((key >> 1) & 7); long row = krow0 + key; row = row < 0 ? 0 : row;
        __builtin_amdgcn_global_load_lds((const unsigned*)(K + row * 128 + kvh * 64 + c * 8), (LAS unsigned*)(img + IMG_K + piece * 1024), 16, 0, 0); }
#pragma unroll
    for (int i = 0; i < 4; ++i) { const int piece = w * 4 + i, d = piece * 2 + (lane >> 5), c = (lane & 31) ^ (d & 15); int kk = key0 + c * 8; kk = kk < 0 ? 0 : kk;
        __builtin_amdgcn_global_load_lds((const unsigned*)(vt0 + (long)d * S + kk), (LAS unsigned*)(img + IMG_V + piece * 1024), 16, 0, 0); }
}
struct LaneOff { int k[4]; int v[8]; };
__device__ __forceinline__ void lane_off(LaneOff& lo, int r32, int hi) { const int s7 = (r32 >> 1) & 7, x = r32 & 15;
#pragma unroll
    for (int d0 = 0; d0 < 4; ++d0) lo.k[d0] = ((2 * d0 + hi) ^ s7) << 4;
#pragma unroll
    for (int j = 0; j < 8; ++j) lo.v[j] = (j ^ (x & 7)) << 4; }
template <int MODE, bool HALF, bool AL64>
__device__ __forceinline__ void tile_lds(St& st, const bf16x8 (&qr)[4], const LAS unsigned char* img, const LaneOff& lo, int ko, int kq  , float sl2, bool rowok, int klo, int hi, int r32) {
    const LAS unsigned char* kp = img + IMG_K + (ko + r32) * 128;
    const bool fresh = st.m == -INFINITY; const float ref = fresh ? 0.f : st.m;
    const float cin = sl2 * (float)(kq + 4 * hi) - ref;
    f32x16 p0, p1;
#pragma unroll
    for (int r = 0; r < 16; ++r) { p0[r] = cin; p1[r] = cin; }
#pragma unroll
    for (int d0 = 0; d0 < 4; ++d0) {
        p0 = __builtin_amdgcn_mfma_f32_32x32x16_bf16(*(const LAS bf16x8*)(kp + lo.k[d0]), qr[d0], p0, 0, 0, 0);
        if (!HALF) p1 = __builtin_amdgcn_mfma_f32_32x32x16_bf16(*(const LAS bf16x8*)(kp + 32 * 128 + lo.k[d0]), qr[d0], p1, 0, 0, 0); }
    float mx = -INFINITY;
#pragma unroll
    for (int r = 0; r < 16; ++r) { const int c = (r & 3) + 8 * (r >> 2); const int k0 = kq + 4 * hi + c, k1 = k0 + 32;
        float a = fmaf(sl2, (float)c, p0[r]), b = HALF ? -INFINITY : fmaf(sl2, (float)(c + 32), p1[r]);
        if (MODE == 1) { a = (k0 <= 0 && k0 >= klo) ? a : -INFINITY; if (!HALF) b = (k1 <= 0 && k1 >= klo) ? b : -INFINITY; }
        else if (MODE == 2) { a = (k0 <= 0) ? a : -INFINITY; if (!HALF) b = (k1 <= 0) ? b : -INFINITY; }
        else if (MODE == 3) { a = (rowok && k0 <= 0) ? a : -INFINITY; if (!HALF) b = (rowok && k1 <= 0) ? b : -INFINITY; }
        p0[r] = a; if (!HALF) p1[r] = b; mx = fmaxf(mx, HALF ? a : fmaxf(a, b)); }
    mx = fmaxf(mx, __shfl_xor(mx, 32));
    const float delta = fresh ? ((mx == -INFINITY) ? 0.f : mx) : ((mx > 8.f) ? mx : 0.f);
    if (__any(delta != 0.f)) {
        const float alpha = fresh ? 1.f : __builtin_amdgcn_exp2f(-delta);
#pragma unroll
        for (int r = 0; r < 16; ++r) { p0[r] -= delta; if (!HALF) p1[r] -= delta; st.o0[r] *= alpha; st.o1[r] *= alpha; }
        st.l *= alpha;
        st.m = (fresh && mx == -INFINITY) ? -INFINITY : ref + delta;
    }
    float sum = 0.f;
#pragma unroll
    for (int r = 0; r < 16; ++r) { p0[r] = __builtin_amdgcn_exp2f(p0[r]); sum += p0[r]; if (!HALF) { p1[r] = __builtin_amdgcn_exp2f(p1[r]); sum += p1[r]; } }
    st.l += sum;
    const int x = r32 & 15, kc = ko >> 3;
    const LAS unsigned char* vp = img + IMG_V + r32 * 512 + hi * 8 + (AL64 ? ((kc ^ (x & 8)) << 4) : 0);
#pragma unroll
    for (int s = 0; s < (HALF ? 2 : 4); ++s) {
        u32x4 w;
        if (s < 2) { w.x = cvtpk(p0[8 * s + 0], p0[8 * s + 1]); w.y = cvtpk(p0[8 * s + 2], p0[8 * s + 3]); w.z = cvtpk(p0[8 * s + 4], p0[8 * s + 5]); w.w = cvtpk(p0[8 * s + 6], p0[8 * s + 7]); }
        else { w.x = cvtpk(p1[8 * s - 16], p1[8 * s - 15]); w.y = cvtpk(p1[8 * s - 14], p1[8 * s - 13]); w.z = cvtpk(p1[8 * s - 12], p1[8 * s - 11]); w.w = cvtpk(p1[8 * s - 10], p1[8 * s - 9]); }
        const bf16x8 pf = __builtin_bit_cast(bf16x8, w);
        const int o0 = AL64 ? lo.v[2 * s] : (((kc + 2 * s) ^ x) << 4), o1 = AL64 ? lo.v[2 * s + 1] : (((kc + 2 * s + 1) ^ x) << 4);
        const s16x4 a0 = *(const LAS s16x4*)(vp + o0), a1 = *(const LAS s16x4*)(vp + o1), b0 = *(const LAS s16x4*)(vp + 32 * 512 + o0), b1 = *(const LAS s16x4*)(vp + 32 * 512 + o1);
        st.o0 = __builtin_amdgcn_mfma_f32_32x32x16_bf16((bf16x8){a0[0], a0[1], a0[2], a0[3], a1[0], a1[1], a1[2], a1[3]}, pf, st.o0, 0, 0, 0);
        st.o1 = __builtin_amdgcn_mfma_f32_32x32x16_bf16((bf16x8){b0[0], b0[1], b0[2], b0[3], b1[0], b1[1], b1[2], b1[3]}, pf, st.o1, 0, 0, 0); }
}
__device__ __forceinline__ void swa_phase(const Frame& F, const Ptrs& P, int l) {
    bf16* QA = (bf16*)(P.ws + WS_QA); const bf16* KA = (const bf16*)(P.ws + WS_KA); const bf16* VAT = (const bf16*)(P.ws + WS_VAT);
    const int lane = F.lane, r32 = lane & 31, hi = lane >> 5, w = F.wave;
    LAS unsigned char* img = F.lds + RING_OFF;
    LaneOff lo; lane_off(lo, r32, hi);
    for (int un = F.vcu; un < 256; un += F.G) {
        const int bk = un >> 5, nb = un & 31, b = bk >> 1, kvh = bk & 1, h = kvh * 4 + (w >> 1);
        __syncthreads();
        img_load(F, img, KA, (long)b * S + nb * 128 - 128, kvh, VAT + (long)((b * 2 + kvh) * 64) * S, nb * 128 - 128);
        const float sl2 = exp2f(-0.5f * (float)(h + 1)) * LOG2E, sink2 = P.sinks[l * 8 + h] * LOG2E;
        asm volatile("s_waitcnt vmcnt(0)" ::: "memory"); __syncthreads();
        for (int qt = 0; qt < 2; ++qt) {
            const int qo = (w & 1) * 64 + qt * 32, t0 = nb * 128 + qo, q = t0 + r32;
            bf16* qrow = QA + (size_t)(b * S + q) * 512 + h * 64;
            bf16x8 qr[4]; loadq(qr, qrow + 8 * hi);
            St st; st.o0 = f32x16{}; st.o1 = f32x16{}; st.m = sink2; st.l = hi ? 0.f : 1.f;
            const int klo = q < 127 ? -q : -127;
#pragma unroll 1
            for (int kt = 0; kt < 2; ++kt) { if (t0 - 128 + 64 * kt + 63 >= 0) tile_lds<1, false, false>(st, qr, img, lo, qo + 64 * kt, t0 - 128 + 64 * kt - q, sl2, true, klo, hi, r32); }
            tile_lds<1, true, false>(st, qr, img, lo, qo + 128, t0 - q, sl2, true, klo, hi, r32);
            finish(st, qrow, hi);
        }
    }
    __syncthreads();
}
__device__ __forceinline__ float moba_sl2(int h) { return exp2f(-0.5f * (float)(8 + h + 1)) * LOG2E; }
__device__ __forceinline__ void moba_select(const Frame& F, const Ptrs& P, int l) {
    const bf16* QM = (const bf16*)(P.ws + WS_QM); const float* KMP = (const float*)(P.ws + WS_KMP);
    unsigned* LIST = (unsigned*)(P.ws + WS_LIST); unsigned* CNT = (unsigned*)(P.ws + WS_CTL) + CW_CNT + l * 128;
    LAS float* km = (LAS float*)(F.lds + RING_OFF);
    const int tid = F.tid, lane = F.lane;
    const int halfg = F.G >> 1; const int wi_ = (int)blockIdx.x - halfg;
    if (wi_ < 0) return;
    for (int un = wi_; un < 256; un += halfg) {
        const int bk = un >> 5, ch = un & 31, b = bk >> 1, kvh = bk & 1, j = ch >> 1;
        __syncthreads();
        for (int e = tid; e < 1024; e += 512) { const int n = e >> 6, d = e & 63; const float* k0 = KMP + (size_t)(b * 16 + n) * 128 + kvh * 64 + d; km[e] = k0[0] + k0[64 * 128]; }
        __syncthreads();
        if (j == 0) continue;
        const int hg = tid >> 7, t = ch * 128 + (tid & 127);
        const bf16* qp = QM + (size_t)(b * S + t) * 512 + (kvh * 4 + hg) * 64;
        u32x4 qv[8];
#pragma unroll
        for (int i = 0; i < 8; ++i) qv[i] = *(const u32x4*)(qp + 8 * i);
        int i0 = 0, i1 = 1, i2 = 2;
        if (j > 3) {
            float v0 = -INFINITY, v1 = -INFINITY, v2 = -INFINITY; i0 = 0; i1 = 0; i2 = 0;
#pragma unroll 1
            for (int n = 0; n < j; ++n) { float a = 0.f;
#pragma unroll
                for (int i = 0; i < 8; ++i) { const f32x4 x0 = *(const LAS f32x4*)(km + n * 64 + 8 * i), x1 = *(const LAS f32x4*)(km + n * 64 + 8 * i + 4);
                    a += bf2f(qv[i].x & 0xffffu) * x0[0] + bf2f(qv[i].x >> 16) * x0[1] + bf2f(qv[i].y & 0xffffu) * x0[2] + bf2f(qv[i].y >> 16) * x0[3]
                       + bf2f(qv[i].z & 0xffffu) * x1[0] + bf2f(qv[i].z >> 16) * x1[1] + bf2f(qv[i].w & 0xffffu) * x1[2] + bf2f(qv[i].w >> 16) * x1[3]; }
                if (a > v0) { v2 = v1; i2 = i1; v1 = v0; i1 = i0; v0 = a; i0 = n; } else if (a > v1) { v2 = v1; i2 = i1; v1 = a; i1 = n; } else if (a > v2) { v2 = a; i2 = n; } }
        }
        const int nsel = j < 3 ? j : 3;
        unsigned mycnt = 0u;
#pragma unroll 1
        for (int n = 0; n < j; ++n) { const bool sel = (n == i0 && nsel > 0) || (n == i1 && nsel > 1) || (n == i2 && nsel > 2); const unsigned long long mask = __ballot(sel); if (lane == n) mycnt = (unsigned)__popcll(mask); }
        unsigned mybase = 0u;
        if (lane < j && mycnt) mybase = __hip_atomic_fetch_add(CNT + bk * 16 + lane, mycnt, __ATOMIC_RELAXED, __HIP_MEMORY_SCOPE_AGENT);
#pragma unroll 1
        for (int n = 0; n < j; ++n) {
            const int r = (n == i0) ? 0 : ((n == i1) ? 1 : ((n == i2) ? 2 : 3));
            const bool sel = r < nsel;
            const unsigned long long mask = __ballot(sel);
            if (mask == 0ull) continue;
            const unsigned base = (unsigned)__shfl((int)mybase, n);
            const unsigned pos = base + (unsigned)__popcll(mask & ((1ull << lane) - 1ull));
            if (sel) LIST[(size_t)(bk * 16 + n) * 16384 + pos] = ((unsigned)t << 4) | ((unsigned)hg << 2) | (unsigned)r;
        }
    }
    __syncthreads();
}
__device__ __forceinline__ void store_o(const St& st, bf16* op, float rl, int hi) {
#pragma unroll
    for (int g = 0; g < 4; ++g) { u32x2 a, b;
        a.x = cvtpk(st.o0[4 * g] * rl, st.o0[4 * g + 1] * rl); a.y = cvtpk(st.o0[4 * g + 2] * rl, st.o0[4 * g + 3] * rl);
        b.x = cvtpk(st.o1[4 * g] * rl, st.o1[4 * g + 1] * rl); b.y = cvtpk(st.o1[4 * g + 2] * rl, st.o1[4 * g + 3] * rl);
        *(u32x2*)(op + 8 * g + 4 * hi) = a; *(u32x2*)(op + 32 + 8 * g + 4 * hi) = b; }
}
__device__ __forceinline__ void moba_gather(const Frame& F, const Ptrs& P, int l) {
    const bf16* QM = (const bf16*)(P.ws + WS_QM); const bf16* KM = (const bf16*)(P.ws + WS_KM); const bf16* VMT = (const bf16*)(P.ws + WS_VMT);
    const unsigned* LIST = (const unsigned*)(P.ws + WS_LIST); unsigned* CNT = (unsigned*)(P.ws + WS_CTL) + CW_CNT + l * 128;
    bf16* PART = (bf16*)(P.ws + WS_PART); float* LSE = (float*)(P.ws + WS_LSE);
    const int lane = F.lane, r32 = lane & 31, hi = lane >> 5, w = F.wave;
    const int per = F.G >> 3;
    const int bk = F.vcu / per, loc = F.vcu % per;
    if (bk >= 8 || (F.vcu & 15) == 0) return;
    const int wg = loc - 1 - (loc > 16 ? 1 : 0), nwg = per - 2;
    const int b = bk >> 1, kvh = bk & 1;
    unsigned cnt = 0u;
    if (lane < 16) cnt = __hip_atomic_load(CNT + bk * 16 + lane, __ATOMIC_RELAXED, __HIP_MEMORY_SCOPE_AGENT);
    const int ns_l = (int)((cnt + 255u) >> 8);
    int pre = ns_l;
#pragma unroll
    for (int o = 1; o < 16; o <<= 1) { const int v = __shfl_up(pre, o); if (lane >= o) pre += v; }
    const int total = __shfl(pre, 15);
    const bf16* vt0 = VMT + (long)((b * 2 + kvh) * 64) * S;
    LAS unsigned char* ring = F.lds + RING_OFF;
    LaneOff lo; lane_off(lo, r32, hi);
    __syncthreads();
    int item = wg, n = 0, sub = 0;
    if (item < total) { const unsigned long long le = __ballot(lane < 16 && pre <= item); n = (int)__popcll(le); sub = item - ((n == 0) ? 0 : __shfl(pre, n - 1));
        img_load(F, ring, KM, (long)b * S + n * 256, kvh, vt0, n * 256); }
    int buf = 0;
#pragma unroll 1
    for (; item < total; item += nwg) {
        const int cn = (int)__shfl((int)cnt, n);
        const int ti = sub * 8 + w, idx = ti * 32 + r32; const bool tile_ok = ti * 32 < cn, valid = idx < cn;
        unsigned e = 0u; if (tile_ok) e = LIST[(size_t)(bk * 16 + n) * 16384 + (valid ? idx : ti * 32)];
        const int t = (int)(e >> 4), hg = (int)((e >> 2) & 3u), r = (int)(e & 3u), h = kvh * 4 + hg;
        const size_t row = (size_t)(b * S + t);
        bf16x8 qr[4]; loadq(qr, QM + row * 512 + h * 64 + 8 * hi);
        asm volatile("s_waitcnt vmcnt(0)" ::: "memory"); __syncthreads();
        const int cur_n = n; const LAS unsigned char* img = ring + buf * IMG_BYTES;
        const int nitem = item + nwg;
        if (nitem < total) { const unsigned long long le = __ballot(lane < 16 && pre <= nitem); n = (int)__popcll(le); sub = nitem - ((n == 0) ? 0 : __shfl(pre, n - 1));
            img_load(F, ring + (buf ^ 1) * IMG_BYTES, KM, (long)b * S + n * 256, kvh, vt0, n * 256); }
        buf ^= 1;
        if (tile_ok) {
            const float sl2 = moba_sl2(h);
            St st; st.o0 = f32x16{}; st.o1 = f32x16{}; st.m = -INFINITY; st.l = 0.f;
            const int kq = cur_n * 256 - t;
#pragma unroll 1
            for (int i = 0; i < 4; ++i) tile_lds<0, false, true>(st, qr, img, lo, 64 * i, kq + 64 * i, sl2, true, 0, hi, r32);
            const float lt = st.l + __shfl_xor(st.l, 32);
            if (valid) { const size_t slot = ((size_t)((b * 8 + h) * 3 + r)) * S + t;
                store_o(st, PART + slot * 64, __builtin_amdgcn_rcpf(lt), hi); if (hi == 0) LSE[slot] = st.m + __builtin_amdgcn_logf(lt); }
        }
    }
    asm volatile("s_waitcnt vmcnt(0)" ::: "memory"); __syncthreads();
}
__device__ __forceinline__ void moba_own(const Frame& F, const Ptrs& P, int lq, bool nofull = false, bool nocomb = false) {
    bf16* QM = (bf16*)(P.ws + WS_QM); const bf16* KM = (const bf16*)(P.ws + WS_KM); const bf16* VMT = (const bf16*)(P.ws + WS_VMT);
    const bf16* PART = (const bf16*)(P.ws + WS_PART); const float* LSE = (const float*)(P.ws + WS_LSE);
    unsigned* qctr = (unsigned*)(P.ws + WS_CTL) + CW_OWNQ + lq;
    const int lane = F.lane, r32 = lane & 31, hi = lane >> 5, w = F.wave;
    LAS unsigned char* img = F.lds + RING_OFF;
    volatile LAS unsigned* jobw = (volatile LAS unsigned*)(F.lds + MISC_OFF + 64);
    LaneOff lo; lane_off(lo, r32, hi);
    for (;;) {
        __syncthreads();
        if (F.tid == 0) *jobw = __hip_atomic_fetch_add(qctr, 1u, __ATOMIC_RELAXED, __HIP_MEMORY_SCOPE_AGENT);
        __syncthreads();
        const int sjob = (int)*jobw;
        if (sjob >= 256) break;
        const int bk = sjob >> 5, j = 15 - ((sjob & 31) >> 1), hp = sjob & 1, b = bk >> 1, kvh = bk & 1;
        img_load(F, img, KM, (long)b * S + j * 256, kvh, VMT + (long)((b * 2 + kvh) * 64) * S, j * 256);
        asm volatile("s_waitcnt vmcnt(0)" ::: "memory"); __syncthreads();
        const int nsel = j < 3 ? j : 3;
        bf16x8 qn[4];
        { const int qs0 = w; loadq(qn, QM + (size_t)(b * S + j * 256 + qs0 * 32 + r32) * 512 + (kvh * 4 + 2 * hp) * 64 + 8 * hi); }
#pragma unroll 1
        for (int k = 0; k < 2; ++k) {
            const int hg = 2 * hp + k, qs = (k & 1) ? 7 - w : w, qo = qs * 32, h = kvh * 4 + hg;
            const float sl2 = moba_sl2(h);
            const int t0 = j * 256 + qo, q = t0 + r32;
            const size_t row = (size_t)(b * S + q);
            bf16* qrow = QM + row * 512 + h * 64;
            bf16x8 qr[4];
#pragma unroll
            for (int i = 0; i < 4; ++i) qr[i] = qn[i];
            if (k < 1) { const int qs1 = 7 - w; loadq(qn, QM + (size_t)(b * S + j * 256 + qs1 * 32 + r32) * 512 + (kvh * 4 + 2 * hp + 1) * 64 + 8 * hi); }
            St st; st.o0 = f32x16{}; st.o1 = f32x16{}; st.m = -INFINITY; st.l = 0.f;
            const int nfull = nofull ? 0 : (qo >> 6);
#pragma unroll 1
            for (int i = 0; i < nfull; ++i) tile_lds<0, false, true>(st, qr, img, lo, 64 * i, 64 * i - qo - r32, sl2, true, 0, hi, r32);
            if (qo & 32) tile_lds<2, false, true>(st, qr, img, lo, qo - 32, -32 - r32, sl2, true, 0, hi, r32);
            else tile_lds<2, true, true>(st, qr, img, lo, qo, -r32, sl2, true, 0, hi, r32);
            const float lt = st.l + __shfl_xor(st.l, 32);
            const float lse_own = st.m + __builtin_amdgcn_logf(lt), rl = __builtin_amdgcn_rcpf(lt);
            LAS unsigned char* stg = F.lds + RING_OFF + IMG_BYTES + w * 4736;
#pragma unroll
            for (int g = 0; g < 4; ++g) { u32x2 a2, c2;
                a2.x = cvtpk(st.o0[4 * g] * rl, st.o0[4 * g + 1] * rl); a2.y = cvtpk(st.o0[4 * g + 2] * rl, st.o0[4 * g + 3] * rl);
                c2.x = cvtpk(st.o1[4 * g] * rl, st.o1[4 * g + 1] * rl); c2.y = cvtpk(st.o1[4 * g + 2] * rl, st.o1[4 * g + 3] * rl);
                *(LAS u32x2*)(stg + r32 * 144 + (8 * g + 4 * hi) * 2) = a2; *(LAS u32x2*)(stg + r32 * 144 + (32 + 8 * g + 4 * hi) * 2) = c2; }
            if (hi == 0) *(LAS float*)(stg + 4608 + r32 * 4) = lse_own;
            LDS_WAIT(); asm volatile("" ::: "memory");
            if (nocomb) continue;
#pragma unroll
            for (int i = 0; i < 4; ++i) {
                const int rw = i * 8 + (lane >> 3), ch = lane & 7;
                const size_t grow = (size_t)(b * S + t0 + rw), sl0 = ((size_t)((b * 8 + h) * 3)) * S + t0 + rw;
                const u32x4 own = *(const LAS u32x4*)(stg + rw * 144 + ch * 16); const float lo_ = *(const LAS float*)(stg + 4608 + rw * 4);
                float ls[3]; u32x4 pr[3];
#pragma unroll
                for (int r = 0; r < 3; ++r) { ls[r] = -INFINITY; pr[r] = (u32x4){0u, 0u, 0u, 0u}; if (r < nsel) { ls[r] = LSE[sl0 + (size_t)r * S]; pr[r] = *(const u32x4*)(PART + (sl0 + (size_t)r * S) * 64 + ch * 8); } }
                float M = lo_;
#pragma unroll
                for (int r = 0; r < 3; ++r) M = fmaxf(M, ls[r]);
                const float w0 = __builtin_amdgcn_exp2f(lo_ - M); float W = w0;
                float acc8[8];
                acc8[0] = w0 * bf2f(own.x & 0xffffu); acc8[1] = w0 * bf2f(own.x >> 16); acc8[2] = w0 * bf2f(own.y & 0xffffu); acc8[3] = w0 * bf2f(own.y >> 16);
                acc8[4] = w0 * bf2f(own.z & 0xffffu); acc8[5] = w0 * bf2f(own.z >> 16); acc8[6] = w0 * bf2f(own.w & 0xffffu); acc8[7] = w0 * bf2f(own.w >> 16);
#pragma unroll
                for (int r = 0; r < 3; ++r) { const float wr_ = __builtin_amdgcn_exp2f(ls[r] - M); W += wr_;
                    acc8[0] += wr_ * bf2f(pr[r].x & 0xffffu); acc8[1] += wr_ * bf2f(pr[r].x >> 16); acc8[2] += wr_ * bf2f(pr[r].y & 0xffffu); acc8[3] += wr_ * bf2f(pr[r].y >> 16);
                    acc8[4] += wr_ * bf2f(pr[r].z & 0xffffu); acc8[5] += wr_ * bf2f(pr[r].z >> 16); acc8[6] += wr_ * bf2f(pr[r].w & 0xffffu); acc8[7] += wr_ * bf2f(pr[r].w >> 16); }
                const float rW = __builtin_amdgcn_rcpf(W);
                u32x4 o; o.x = cvtpk(acc8[0] * rW, acc8[1] * rW); o.y = cvtpk(acc8[2] * rW, acc8[3] * rW); o.z = cvtpk(acc8[4] * rW, acc8[5] * rW); o.w = cvtpk(acc8[6] * rW, acc8[7] * rW);
                *(u32x4*)(QM + grow * 512 + h * 64 + ch * 8) = o;
            }
            LDS_WAIT(); asm volatile("" ::: "memory");
        }
    }
}
}
#ifndef BENCH_HOT
#define BENCH_HOT 0
#endif
#ifndef ALIGN_BIG
#define ALIGN_BIG true
#endif
#ifndef BENCH_NOEPI
#define BENCH_NOEPI 0
#endif
#ifndef BENCH_AGLU
#define BENCH_AGLU 0
#endif
#ifndef BENCH_KGLU
#define BENCH_KGLU 0
#endif
#ifndef PH_MASK
#define PH_MASK 0xFFF
#endif
#define PH_ON(k) (((PH_MASK) >> (k)) & 1)
constexpr int NPH = 10, PH_FINAL = DEPTH * NPH, PH_TOTAL = PH_FINAL + 1;
struct Args { Ptrs P; int ph_lo, ph_hi, use_bar, sub; };
__global__ void __launch_bounds__(NWAVES * 64, 2) mk_fwd(Args args) {
    extern __shared__ __attribute__((aligned(16))) unsigned char lds[];
    Frame F;
    F.lds = (LAS unsigned char*)lds;
    F.tid = threadIdx.x; F.lane = F.tid & 63; F.wave = __builtin_amdgcn_readfirstlane(F.tid >> 6);
    F.G = gridDim.x; { const int bx = blockIdx.x; F.vcu = (F.G % 8 == 0) ? (bx % 8) * (F.G / 8) + bx / 8 : bx; }
    const Ptrs& P = args.P;
    unsigned char* ws0 = P.ws;
    volatile LAS unsigned* MISC = (volatile LAS unsigned*)(F.lds + MISC_OFF);
    for (int u = F.tid; u < (LDS_BYTES - LDSCTL_OFF) / 4; u += NWAVES * 64) ((LAS unsigned*)(F.lds + LDSCTL_OFF))[u] = 0u;
    __syncthreads();
    XcdBarrier bar; bar.bar = (unsigned*)(ws0 + WS_CTL) + CW_BAR; bar.x = 0; bar.st = nullptr;
    if (args.use_bar) bar = xcd_barrier_post((unsigned*)(ws0 + WS_CTL) + CW_BAR, MISC + 8);
    LAS unsigned char* ring = F.lds + RING_OFF;
    for (int ph = args.ph_lo; ph < args.ph_hi; ++ph) {
#if defined(BENCH_SET)
        const bool bench = ph >= PH_TOTAL; const int l = bench ? DEPTH - 1 : ph / NPH, k = bench ? (ph - PH_TOTAL) % NPH : ph % NPH;
        if (bench && !(((BENCH_SET) >> k) & 1)) continue;
#if defined(BENCH_EMPTY)
        if (bench) { if (ph + 1 < args.ph_hi) xcd_barrier(bar); continue; }
#endif
        const int lc = bench ? DEPTH + (ph - PH_TOTAL) / NPH : l;
#else
        const bool bench = false; const int l = ph / NPH, k = ph % NPH; const int lc = l;
#endif
        unsigned char* ws = ws0; asm volatile("" : "+s"(ws));
        F.tid = threadIdx.x; asm volatile("" : "+v"(F.tid)); F.lane = F.tid & 63;
        int bx = (int)blockIdx.x; asm volatile("" : "+s"(bx));
        if (ph == PH_FINAL && !bench) { if (PH_ON(10)) final_pass(F, P);
        }
        else if (k == 0 && PH_ON(0)) { conv_layer(F, P, l); ssm_mats(F, P, l); if (l == 0) xb_pass(F, P); __syncthreads(); }
        else if (k == 1 && PH_ON(1)) {
            pg8::SrcStd g{(const char*)(ws + WS_XN), (const char*)(ws + WS_WIN), DM, 0}; pg8::StaticOrder So; So.init(T, DIN, F.G, bx);
            pg8::Unit u0; So.next(0, u0); pg8::rinv_build((LAS float*)(F.lds + RINV_OFF), (const float*)(ws + WS_SSQ), u0.pm);
            pg8::EpiInProj E{ws, pg8::RinvTab{(const LAS float*)(F.lds + RINV_OFF)}, (bench && BENCH_NOEPI) ? 1 : 0};
            pg8::gemm_phase<pg8::EpiInProj, pg8::SrcStd, pg8::StaticOrder, ALIGN_BIG>(ring, g, So, E);
        }
        else if (k == 2 && PH_ON(2)) {
            if (args.sub & 1) { pg8::SrcSsm<false> g{(const char*)(ws + WS_U), nullptr, (const char*)(ws + WS_SEND)}; pg8::SsmOrder So{F.G, bx}; pg8::EpiSsmEnd E{(float*)(ws + WS_HEND)};
                pg8::gemm_phase<pg8::EpiSsmEnd, pg8::SrcSsm<false>, pg8::SsmOrder, true>(ring, g, So, E); }
            if (args.sub & 2) { att::swa_phase(F, P, l); att::moba_select(F, P, lc); }
        }
        else if (k == 3 && PH_ON(3)) {
#ifndef NO_CARRY
            if (args.sub & 1) ssm_carry(F, P, l);
#endif
#ifndef NO_MOBA
            if (args.sub & 2) att::moba_gather(F, P, lc);
#endif
        }
        else if (k == 4 && PH_ON(4)) {
            pg8::SrcSsm<true> g{(const char*)(ws + WS_U), (const char*)(ws + WS_HINIT), (const char*)(ws + WS_SMAIN)}; pg8::SsmOrder So{F.G, bx}; pg8::EpiSsmMain E{(bf16*)(ws + WS_YS)};
#ifdef BENCH_NO_SSMMAIN
            if (!bench)
#endif
            pg8::gemm_phase<pg8::EpiSsmMain, pg8::SrcSsm<true>, pg8::SsmOrder, true>(ring, g, So, E);
#ifdef BENCH_NO_OWN
            if (!bench)
#endif
#if defined(BENCH_OWN_NOFULL)
            att::moba_own(F, P, lc, bench && (BENCH_OWN_NOFULL & 1), bench && (BENCH_OWN_NOFULL & 2));
#else
            att::moba_own(F, P, lc);
#endif
        }
        else if (k == 5 && PH_ON(5)) {
            pg8::SrcStd g{(const char*)(ws + ((bench && BENCH_AGLU) ? WS_MIXED : WS_YS)), (const char*)(ws + WS_WGLU), (bench && BENCH_KGLU) ? BENCH_KGLU : 512, 0}; pg8::StaticOrder So; So.init(T, 1024, F.G, bx); pg8::EpiGlu E{(bf16*)(ws + WS_A1)};
            pg8::gemm_phase<pg8::EpiGlu, pg8::SrcStd, pg8::StaticOrder, true>(ring, g, So, E);
        }
        else if (k == 6 && PH_ON(6)) {
            pg8::SrcMerge g{(const char*)(ws + WS_QA), (const char*)(ws + WS_A1), (const char*)(ws + WS_QM), (const char*)(ws + WS_WMRG)}; pg8::StaticOrder So; So.init(T, DM, F.G, bx);
            pg8::EpiMerge E{(const bf16*)(ws + WS_GATES), (bf16*)(ws + WS_MIXED)};
            pg8::gemm_phase<pg8::EpiMerge, pg8::SrcMerge, pg8::StaticOrder, true>(ring, g, So, E);
        }
        else if ((k == 7 || k == 9) && PH_ON(7)) {
            const bool f2 = (k == 9);
            pg8::SrcStd g{(const char*)(ws + (f2 ? WS_H1 : WS_MIXED)), (const char*)(ws + (f2 ? WS_WFF2 : WS_WOUT)), f2 ? DFF : DM, 0}; pg8::StaticOrder So; So.init(T, DM, F.G, bx); pg8::EpiResid E{bench ? (float*)(ws + WS_QA) : P.x, (bf16*)(ws + (bench ? WS_KM : WS_XN)), (float*)(ws + WS_SSQ)};
            pg8::gemm_phase<pg8::EpiResid, pg8::SrcStd, pg8::StaticOrder, true>(ring, g, So, E);
        }
        else if (k == 8 && PH_ON(8)) {
            pg8::SrcStd g{(const char*)(ws + WS_XN), (const char*)(ws + WS_WFF1), DM, (bench && BENCH_HOT) ? 1 : 0}; pg8::StaticOrder So; So.init(T, DFF, F.G, bx);
            pg8::Unit u0; So.next(0, u0); pg8::rinv_build((LAS float*)(F.lds + RINV_OFF), (const float*)(ws + WS_SSQ), u0.pm);
            pg8::EpiFfn1 E{(bf16*)(ws + WS_H1), pg8::RinvTab{(const LAS float*)(F.lds + RINV_OFF)}, (bench && BENCH_NOEPI) ? 1 : 0};
            pg8::gemm_phase<pg8::EpiFfn1, pg8::SrcStd, pg8::StaticOrder, ALIGN_BIG>(ring, g, So, E);
        }
        if (ph + 1 < args.ph_hi) { if (args.use_bar) xcd_barrier(bar); else __syncthreads(); }
    }
}
extern "C" void kernel_launch(void* const* d_in, const int* in_sizes, int n_in, void* d_out, int out_size, void* d_ws, size_t ws_size, hipStream_t stream) {
    static int grid = 0;
    if (grid == 0) {
        if (n_in != 21 || out_size != T * DM || ws_size < WS_END) { fprintf(stderr, "kernel_launch: unexpected shapes (n_in %d out %d ws %zu)\n", n_in, out_size, ws_size); grid = -1; return; }
        int dev = 0, cus = 0;
        if (hipGetDevice(&dev) != hipSuccess || hipDeviceGetAttribute(&cus, hipDeviceAttributeMultiprocessorCount, dev) != hipSuccess) { grid = -1; return; }
        if (hipFuncSetAttribute((const void*)mk_fwd, hipFuncAttributeMaxDynamicSharedMemorySize, LDS_BYTES) != hipSuccess) { fprintf(stderr, "kernel_launch: hipFuncSetAttribute failed\n"); grid = -1; return; }
        int per_cu = 0;
        if (hipOccupancyMaxActiveBlocksPerMultiprocessor(&per_cu, (const void*)mk_fwd, NWAVES * 64, LDS_BYTES) != hipSuccess || per_cu < 1) { fprintf(stderr, "kernel_launch: occupancy query reports %d workgroups per CU\n", per_cu); (void)hipGetLastError(); }
        grid = cus;
        if (grid != 256) { fprintf(stderr, "kernel_launch: built for a 256-CU device (unit dealing assumes 256 workgroups); found %d CUs; nothing launched\n", cus); grid = -1; return; }
    }
    if (grid < 0) return;
    (void)hipMemsetAsync((char*)d_ws + WS_CTL, 0, CTL_ZERO_BYTES, stream);
    Args a{};
    const float** pp = (const float**)&a.P; for (int i = 0; i < 21; ++i) pp[i] = (const float*)d_in[i];
    a.P.x = (float*)d_out; a.P.ws = (unsigned char*)d_ws;
    #if defined(BENCH_SET)
    a.ph_lo = 0; a.ph_hi = PH_TOTAL + NPH * (BENCH_REPS);
#else
    a.ph_lo = 0; a.ph_hi = PH_TOTAL;
#endif
    a.use_bar = 1; a.sub = 3;
    hipLaunchKernelGGL(mk_fwd, dim3(grid), dim3(NWAVES * 64), LDS_BYTES, stream, a);
}
```

```cpp
#include <hip/hip_runtime.h>
#include <cstdio>
#include <cstdint>

constexpr int NB = 4, S = 4096, T = NB * S, DM = 1024, DEPTH = 4, DIN = 5120, DFF = 4096;
constexpr float LOG2E = 1.4426950408889634f;
constexpr float C2 = 0.125f * LOG2E;
constexpr float NORM_EPS = 1e-6f;
constexpr int SSM_L = 16;
constexpr int SSM_KM = SSM_L * 16 + 128;
constexpr int SSM_KE = SSM_L * 16;
constexpr int NCH = T / SSM_L;

constexpr size_t MiB = 1u << 20;
constexpr size_t WS_CTL = 0, CTL_ZERO_BYTES = 1 * MiB;
constexpr size_t WS_WIN = 1 * MiB, WS_WGLU = 11 * MiB, WS_WMRG = 12 * MiB, WS_WOUT = 15 * MiB, WS_WFF1 = 17 * MiB, WS_WFF2 = 25 * MiB;
constexpr size_t WS_SMAIN = 33 * MiB, WS_SEND = 39 * MiB, WS_KMP = 43 * MiB;
constexpr size_t WS_XN = 44 * MiB;
constexpr size_t WS_QA = 76 * MiB, WS_KA = 92 * MiB, WS_VAT = 96 * MiB, WS_U = 100 * MiB, WS_QM = 116 * MiB, WS_KM = 132 * MiB, WS_VMT = 136 * MiB, WS_GATES = 140 * MiB;
constexpr size_t WS_H1 = 76 * MiB;
constexpr size_t WS_LIST = WS_XN, WS_LSE = WS_XN + 8 * MiB;
constexpr size_t WS_YS = 284 * MiB;
constexpr size_t WS_PART = 236 * MiB;
constexpr size_t WS_A1 = 236 * MiB, WS_MIXED = 252 * MiB, WS_HEND = 284 * MiB, WS_HINIT = 300 * MiB, WS_SSQ = 308 * MiB, WS_END = 309 * MiB;

typedef unsigned short bf16;
typedef short bf16x8 __attribute__((ext_vector_type(8)));
typedef short s16x4 __attribute__((ext_vector_type(4)));
typedef float f32x4 __attribute__((ext_vector_type(4)));
typedef float f32x16 __attribute__((ext_vector_type(16)));
typedef unsigned u32x4 __attribute__((ext_vector_type(4)));
typedef unsigned u32x2 __attribute__((ext_vector_type(2)));

__host__ __device__ __forceinline__ unsigned f2bf(float f) { unsigned u = __builtin_bit_cast(unsigned, f); return (u + 0x7fffu + ((u >> 16) & 1u)) >> 16; }
__host__ __device__ __forceinline__ float bf2f(unsigned b) { return __builtin_bit_cast(float, b << 16); }
typedef float f32x2_t __attribute__((ext_vector_type(2))); typedef __bf16 bf16x2_t __attribute__((ext_vector_type(2)));
__device__ __forceinline__ unsigned cvtpk_s(float lo, float hi) { f32x2_t v = {lo, hi}; bf16x2_t b = __builtin_convertvector(v, bf16x2_t); return __builtin_bit_cast(unsigned, b); }
__device__ __forceinline__ unsigned pk2(float lo, float hi) { return f2bf(lo) | (f2bf(hi) << 16); }
__device__ __forceinline__ float rbf(float f) { return bf2f(f2bf(f)); }
__device__ __forceinline__ float sigmoid_fast(float x) { return __builtin_amdgcn_rcpf(1.f + __builtin_amdgcn_exp2f(-x * LOG2E)); }
__device__ __forceinline__ float gelu_tanh(float x) {
    const float c2 = 2.f * 0.7978845608028654f; const float t = c2 * (x + 0.044715f * x * x * x); return x * sigmoid_fast(t); }
__device__ __forceinline__ float wave_sum(float v) {
#pragma unroll
    for (int o = 1; o < 64; o <<= 1) v += __shfl_xor(v, o);
    return v;
}
__device__ __forceinline__ float wave_max(float v) {
#pragma unroll
    for (int o = 1; o < 64; o <<= 1) v = fmaxf(v, __shfl_xor(v, o));
    return v;
}

struct Ptrs {
    const float *x_in, *norm_mix, *w_in, *sinks, *lam_re, *lam_im, *log_step, *b_re, *b_im, *c_re, *c_im, *d_skip, *w_glu, *w_o_swa, *w_o_ssm, *w_o_moba, *w_out, *norm_ffn, *w_ff1, *w_ff2, *norm_final;
    float* x;
    unsigned char* ws;
};
namespace pg8 {
#define PG8_LAS __attribute__((address_space(3)))
constexpr int BM = 256, BK = 64, HALF = 128, HTB = HALF * BK * 2  , STAGE_BYTES = 8 * HTB, NXCD = 8, WGM = 8;

__host__ __device__ __forceinline__ int lds_byte(int r, int c) { const int st = (r >> 4) * 2 + (c >> 5), rr = r & 15, cc = c & 31, ob = rr * 64 + cc * 2; return st * 1024 + (ob ^ (((ob >> 9) & 1) << 5)); }
__host__ __device__ __forceinline__ void stage_rc(int b, int& R, int& C) { const int st = b / 1024, sb = b % 1024, swz = sb ^ (((sb >> 9) & 1) << 5); R = (st >> 1) * 16 + swz / 64; C = (st & 1) * 32 + (swz % 64) / 2; }
__host__ __device__ __forceinline__ int perm32(int rho) { const int n = rho >> 4, i = rho & 15; return 8 * (i >> 2) + 4 * n + (i & 3); }

struct Unit { int pm, pn; };

struct StaticOrder {
    int nM, nN, nwg, G, c;
    __host__ __device__ void init(int M, int N, int G_, int c_) { nM = M / BM; nN = N / BM; nwg = nM * nN; G = G_; c = c_; }
    __host__ __device__ bool next(int i, Unit& u) const {
        const long L = (long)i * G + c; if (L >= nwg) return false;
        int wgid = (int)L; { const int q = nwg / NXCD, r = nwg % NXCD, xcd = wgid % NXCD, off = wgid / NXCD; wgid = (xcd < r ? xcd * (q + 1) : r * (q + 1) + (xcd - r) * q) + off; }
        const int nig = WGM * nN, gid = wgid / nig, fm = gid * WGM, gsz = (nM - fm) < WGM ? (nM - fm) : WGM;
        u.pm = fm + ((wgid % nig) % gsz); u.pn = (wgid % nig) / gsz; return true;
    }
};
struct SsmOrder {
    int G, c;
    __host__ __device__ bool next(int i, Unit& u) const { const int L = i * G + c; if (L >= 128) return false; u.pn = L >> 2; u.pm = L & 3; return true; }
};

struct SrcStd {
    static constexpr bool TWO_VAR = false;
    const char* A; const char* Bt; int K; int hot;
    __device__ __forceinline__ int nt() const { return K / BK; }
    __device__ __forceinline__ const char* a(const Unit& u, int kt, int h) const { return A + ((size_t)((hot ? 0 : u.pm) * BM + h * HALF) * K + (size_t)kt * BK) * 2; }
    __device__ __forceinline__ const char* b(const Unit& u, int kt, int h) const { return Bt + ((size_t)((hot ? 0 : u.pn) * BM + h * HALF) * K + (size_t)kt * BK) * 2; }
    __device__ __forceinline__ unsigned voffA(int R, int C, int) const { return (unsigned)(R * K + C) * 2u; }
    __device__ __forceinline__ unsigned voffB(int R, int C) const { return (unsigned)(R * K + C) * 2u; }
    __device__ __forceinline__ int avar(int) const { return 0; }
};
struct SrcMerge {
    static constexpr bool TWO_VAR = false;
    const char* A0; const char* A1; const char* A2; const char* Bt;
    __device__ __forceinline__ int nt() const { return 24; }
    __device__ __forceinline__ const char* a(const Unit& u, int kt, int h) const { const int sg = kt >> 3; const char* p = sg == 0 ? A0 : (sg == 1 ? A1 : A2); return p + ((size_t)(u.pm * BM + h * HALF) * 512 + (size_t)(kt & 7) * BK) * 2; }
    __device__ __forceinline__ const char* b(const Unit& u, int kt, int h) const { return Bt + ((size_t)(u.pn * BM + h * HALF) * 1536 + (size_t)kt * BK) * 2; }
    __device__ __forceinline__ unsigned voffA(int R, int C, int) const { return (unsigned)(R * 512 + C) * 2u; }
    __device__ __forceinline__ unsigned voffB(int R, int C) const { return (unsigned)(R * 1536 + C) * 2u; }
    __device__ __forceinline__ int avar(int) const { return 0; }
};
template <bool MAIN> struct SrcSsm {
    static constexpr bool TWO_VAR = MAIN; static constexpr int KTOT = MAIN ? SSM_KM : SSM_KE;
    const char* U; const char* HI; const char* Bt;
    __device__ __forceinline__ int nt() const { return KTOT / BK; }
    __device__ __forceinline__ const char* a(const Unit& u, int kt, int h) const {
        if (!MAIN || kt < 4) return U + ((size_t)(u.pn * NCH + u.pm * BM + h * HALF) * 256 + (size_t)kt * BK) * 2;
        return HI + ((size_t)(u.pn * NCH + u.pm * BM + h * HALF) * 128 + (size_t)(kt - 4) * BK) * 2; }
    __device__ __forceinline__ const char* b(const Unit& u, int kt, int h) const { return Bt + ((size_t)(u.pn * 256 + h * HALF) * KTOT + (size_t)kt * BK) * 2; }
    __device__ __forceinline__ unsigned voffA(int R, int C, int var) const { return var ? (unsigned)(R * 128 + C) * 2u : (unsigned)(R * 256 + C) * 2u; }
    __device__ __forceinline__ unsigned voffB(int R, int C) const { return (unsigned)(R * KTOT + C) * 2u; }
    __device__ __forceinline__ int avar(int kt) const { return (MAIN && kt >= 4) ? 1 : 0; }
};

typedef f32x4 Acc[2][2][4][2];
__device__ __forceinline__ unsigned cvt_pk_bf16(float lo, float hi) { return cvtpk_s(lo, hi); }
__device__ __forceinline__ u32x4 pack8(f32x4 v0, f32x4 v1) { u32x4 w; w.x = cvt_pk_bf16(v0[0], v0[1]); w.y = cvt_pk_bf16(v0[2], v0[3]); w.z = cvt_pk_bf16(v1[0], v1[1]); w.w = cvt_pk_bf16(v1[2], v1[3]); return w; }
__device__ __forceinline__ f32x4 sig4(f32x4 v) { f32x4 o; o[0] = sigmoid_fast(v[0]); o[1] = sigmoid_fast(v[1]); o[2] = sigmoid_fast(v[2]); o[3] = sigmoid_fast(v[3]); return o; }
__device__ __forceinline__ f32x4 unpk_lo(u32x4 w) { f32x4 o; o[0] = bf2f(w.x & 0xffffu); o[1] = bf2f(w.x >> 16); o[2] = bf2f(w.y & 0xffffu); o[3] = bf2f(w.y >> 16); return o; }
__device__ __forceinline__ f32x4 unpk_hi(u32x4 w) { f32x4 o; o[0] = bf2f(w.z & 0xffffu); o[1] = bf2f(w.z >> 16); o[2] = bf2f(w.w & 0xffffu); o[3] = bf2f(w.w >> 16); return o; }
__device__ __forceinline__ f32x4 rcp4(f32x4 v) { f32x4 o; o[0] = __builtin_amdgcn_rcpf(v[0]); o[1] = __builtin_amdgcn_rcpf(v[1]); o[2] = __builtin_amdgcn_rcpf(v[2]); o[3] = __builtin_amdgcn_rcpf(v[3]); return o; }

struct RinvTab { const PG8_LAS float* tab; };
__device__ __forceinline__ void rinv_build(PG8_LAS float* tab, const float* SSQ, int pm0) {
    if (threadIdx.x < 256) { const f32x4* sp = (const f32x4*)(SSQ + (size_t)(pm0 * BM + threadIdx.x) * 16); const f32x4 s = (sp[0] + sp[1]) + (sp[2] + sp[3]); tab[threadIdx.x] = rsqrtf(((s[0] + s[1]) + (s[2] + s[3])) * (1.f / DM) + NORM_EPS); }
    __syncthreads();
}
template <int MODE> __device__ __forceinline__ void st_half_bf16(const Acc& acc, int bj, bf16* base, int ldc, float sc, const PG8_LAS float* ri = nullptr  ) {
    bf16* p = base;
#pragma unroll
    for (int ai = 0; ai < 2; ++ai) {
#pragma unroll
        for (int m = 0; m < 4; ++m) { f32x4 v0 = acc[ai][bj][m][0], v1 = acc[ai][bj][m][1];
            if (ri) { const float rs = ri[ai * HALF + m * 16]; v0 = v0 * rs; v1 = v1 * rs; }
            if (MODE == 0) { v0 = v0 * sc; v1 = v1 * sc; }
            else if (MODE == 1) { v0 = sig4(v0); v1 = sig4(v1); }
            else if (MODE == 2) { v0 = __builtin_elementwise_max(v0, (f32x4){0.f, 0.f, 0.f, 0.f}); v1 = __builtin_elementwise_max(v1, (f32x4){0.f, 0.f, 0.f, 0.f}); v0 = v0 * v0; v1 = v1 * v1; }
            else { v0[0] = gelu_tanh(v0[0]); v0[1] = gelu_tanh(v0[1]); v0[2] = gelu_tanh(v0[2]); v0[3] = gelu_tanh(v0[3]); v1[0] = gelu_tanh(v1[0]); v1[1] = gelu_tanh(v1[1]); v1[2] = gelu_tanh(v1[2]); v1[3] = gelu_tanh(v1[3]); }
            *(u32x4*)p = pack8(v0, v1); asm volatile("" : "+v"(p)); p += (size_t)16 * ldc; }
        p += (size_t)(HALF - 64) * ldc; }
}
__device__ __forceinline__ void st_half_vt(const Acc& acc, int bj, bf16* VT, int b, int s0, int cc, const PG8_LAS float* ri) {
    bf16* p = VT + ((size_t)(b * 2 + (cc >> 6)) * 64 + (cc & 63)) * S + s0;
    float rs[2][4];
#pragma unroll
    for (int ai = 0; ai < 2; ++ai)
#pragma unroll
        for (int m = 0; m < 4; ++m) rs[ai][m] = ri[ai * HALF + m * 16];
#pragma unroll
    for (int n = 0; n < 2; ++n)
#pragma unroll
        for (int e = 0; e < 4; ++e) {
#pragma unroll
            for (int ai = 0; ai < 2; ++ai)
#pragma unroll
                for (int m = 0; m < 4; ++m) p[ai * HALF + m * 16] = (bf16)f2bf(acc[ai][bj][m][n][e] * rs[ai][m]);
            asm volatile("" : "+v"(p)); p += S; }
}

struct EpiInProj {
    static constexpr bool PERM = true, AFTER_DRAIN = false, HAS_MID = false;
    unsigned char* ws; RinvTab RT; int skip;
    __device__ __forceinline__ void operator()(const Acc& acc, const Unit& u, int wr, int wc, int fr, int fq) const {
        if (skip) return;
        bf16 *QA = (bf16*)(ws + WS_QA), *KA = (bf16*)(ws + WS_KA), *VAT = (bf16*)(ws + WS_VAT), *U = (bf16*)(ws + WS_U), *QM = (bf16*)(ws + WS_QM), *KM = (bf16*)(ws + WS_KM), *VMT = (bf16*)(ws + WS_VMT), *GATES = (bf16*)(ws + WS_GATES); float* KMP = (float*)(ws + WS_KMP);
        const int row = u.pm * BM + wr * 64 + fr, cc = wc * 32 + 8 * fq;
        const PG8_LAS float* ri = RT.tab + wr * 64 + fr;
#pragma unroll
        for (int bj = 0; bj < 2; ++bj) {
            const int hc = u.pn * 2 + bj;
            if (hc < 4) st_half_bf16<0>(acc, bj, QA + (size_t)row * 512 + hc * 128 + cc, 512, C2, ri);
            else if (hc == 4) st_half_bf16<0>(acc, bj, KA + (size_t)row * 128 + cc, 128, 1.f, ri);
            else if (hc == 5) st_half_vt(acc, bj, VAT, row / S, row % S, cc, ri);
            else if (hc < 10) { const int ucol = (hc - 6) * 128 + cc;
                st_half_bf16<0>(acc, bj, U + ((size_t)(ucol >> 4) * NCH + ((u.pm * BM + wr * 64) >> 4)) * 256 + fr * 16 + (ucol & 15), 16, 1.f, ri); }
            else if (hc < 14) st_half_bf16<0>(acc, bj, QM + (size_t)row * 512 + (hc - 10) * 128 + cc, 512, C2, ri);
            else if (hc == 14) {
                st_half_bf16<0>(acc, bj, KM + (size_t)row * 128 + cc, 128, 1.f, ri);
                f32x4 c0 = {0.f, 0.f, 0.f, 0.f}, c1 = {0.f, 0.f, 0.f, 0.f};
#pragma unroll
                for (int ai = 0; ai < 2; ++ai)
#pragma unroll
                    for (int m = 0; m < 4; ++m) { const float rs = ri[ai * HALF + m * 16]; c0 += acc[ai][bj][m][0] * rs; c1 += acc[ai][bj][m][1] * rs; }
#pragma unroll
                for (int o = 1; o < 16; o <<= 1)
#pragma unroll
                    for (int e = 0; e < 4; ++e) { c0[e] += __shfl_xor(c0[e], o); c1[e] += __shfl_xor(c1[e], o); }
                if (fr == 0) { float* kp = KMP + (size_t)(wr * 64 + u.pm) * 128 + cc; *(f32x4*)kp = c0; *(f32x4*)(kp + 4) = c1; }
            }
            else if (hc == 15) st_half_vt(acc, bj, VMT, row / S, row % S, cc, ri);
            else st_half_bf16<1>(acc, bj, GATES + (size_t)row * 3072 + (hc - 16) * 128 + cc, 3072, 1.f, ri);
        }
    }
};
struct EpiFfn1 {
    static constexpr bool PERM = true, AFTER_DRAIN = false, HAS_MID = false;
    bf16* H1; RinvTab RT; int skip;
    __device__ __forceinline__ void operator()(const Acc& acc, const Unit& u, int wr, int wc, int fr, int fq) const {
        if (skip) return;
        bf16* base = H1 + (size_t)(u.pm * BM + wr * 64 + fr) * DFF + u.pn * BM + wc * 32 + 8 * fq;
        const PG8_LAS float* ri = RT.tab + wr * 64 + fr;
        st_half_bf16<2>(acc, 0, base, DFF, 1.f, ri); st_half_bf16<2>(acc, 1, base + HALF, DFF, 1.f, ri);
    }
};
struct EpiGlu {
    static constexpr bool PERM = true, AFTER_DRAIN = false, HAS_MID = false;
    bf16* A1;
    __device__ __forceinline__ void operator()(const Acc& acc, const Unit& u, int wr, int wc, int fr, int fq) const {
        bf16* base = A1 + (size_t)(u.pm * BM + wr * 64 + fr) * 512 + u.pn * 128 + wc * 32 + 8 * fq;
#pragma unroll
        for (int ai = 0; ai < 2; ++ai)
#pragma unroll
            for (int m = 0; m < 4; ++m) *(u32x4*)(base + (size_t)(ai * HALF + m * 16) * 512) = pack8(acc[ai][0][m][0] * sig4(acc[ai][1][m][0]), acc[ai][0][m][1] * sig4(acc[ai][1][m][1]));
    }
};
struct EpiMerge {
    static constexpr bool PERM = true, AFTER_DRAIN = false, HAS_MID = true;
    const bf16* GATES; bf16* MIXED;
    __device__ __forceinline__ void mid(Acc& acc, const Unit& u, int t, int wr, int wc, int fr, int fq) const {
        if (t != 8 && t != 16) return;
        const bf16* g = GATES + (size_t)(u.pm * BM + wr * 64 + fr) * 3072 + (t == 8 ? 0 : 1024) + u.pn * BM + wc * 32 + 8 * fq;
#pragma unroll
        for (int ai = 0; ai < 2; ++ai)
#pragma unroll
            for (int m = 0; m < 4; ++m)
#pragma unroll
                for (int bj = 0; bj < 2; ++bj) { const bf16* gp = g + (size_t)(ai * HALF + m * 16) * 3072 + bj * HALF; const u32x4 num = *(const u32x4*)gp, den = *(const u32x4*)(gp + 1024);
                    acc[ai][bj][m][0] = acc[ai][bj][m][0] * (unpk_lo(num) * rcp4(unpk_lo(den))); acc[ai][bj][m][1] = acc[ai][bj][m][1] * (unpk_hi(num) * rcp4(unpk_hi(den))); }
    }
    __device__ __forceinline__ void operator()(const Acc& acc, const Unit& u, int wr, int wc, int fr, int fq) const {
        const size_t ro = (size_t)(u.pm * BM + wr * 64 + fr); const int co = u.pn * BM + wc * 32 + 8 * fq;
#pragma unroll
        for (int ai = 0; ai < 2; ++ai)
#pragma unroll
            for (int m = 0; m < 4; ++m)
#pragma unroll
                for (int bj = 0; bj < 2; ++bj) { const size_t r = ro + ai * HALF + m * 16; const u32x4 g2 = *(const u32x4*)(GATES + r * 3072 + 2048 + co + bj * HALF);
                    *(u32x4*)(MIXED + r * DM + co + bj * HALF) = pack8(acc[ai][bj][m][0] * unpk_lo(g2), acc[ai][bj][m][1] * unpk_hi(g2)); }
    }
};
struct EpiResid {
    static constexpr bool PERM = false, AFTER_DRAIN = false, HAS_MID = false;
    const float* XS; float* X; bf16* XB; float* SSQ;
    __device__ __forceinline__ void operator()(const Acc& acc, const Unit& u, int wr, int wc, int fr, int fq) const {
        const size_t row0 = (size_t)(u.pm * BM + wr * 64 + fr); const int col0 = u.pn * BM + wc * 32 + 4 * fq;
#pragma unroll
        for (int ai = 0; ai < 2; ++ai)
#pragma unroll
            for (int m = 0; m < 4; ++m) { const size_t r = row0 + ai * HALF + m * 16; float ss = 0.f;
#pragma unroll
                for (int bj = 0; bj < 2; ++bj)
#pragma unroll
                    for (int n = 0; n < 2; ++n) { const size_t o_ = r * DM + col0 + bj * HALF + n * 16; const f32x4 v = *(const f32x4*)(XS + o_) + acc[ai][bj][m][n]; *(f32x4*)(X + o_) = v;
                        ss += (v[0] * v[0] + v[1] * v[1]) + (v[2] * v[2] + v[3] * v[3]);
                        u32x2 w; w.x = cvt_pk_bf16(v[0], v[1]); w.y = cvt_pk_bf16(v[2], v[3]); *(u32x2*)(XB + r * DM + col0 + bj * HALF + n * 16) = w; }
                ss += __shfl_xor(ss, 16); ss += __shfl_xor(ss, 32);
                if (fq == 0) SSQ[r * 16 + u.pn * 4 + wc] = ss; }
    }
};
struct EpiSsmEnd {
    static constexpr bool PERM = false, AFTER_DRAIN = false, HAS_MID = false;
    float* HEND;
    __device__ __forceinline__ void operator()(const Acc& acc, const Unit& u, int wr, int wc, int fr, int fq) const {
        float* base = HEND + ((size_t)u.pn * NCH + u.pm * BM + wr * 64 + fr) * 128 + wc * 32 + 4 * fq;
#pragma unroll
        for (int ai = 0; ai < 2; ++ai)
#pragma unroll
            for (int m = 0; m < 4; ++m)
#pragma unroll
                for (int n = 0; n < 2; ++n) *(f32x4*)(base + (size_t)(ai * HALF + m * 16) * 128 + n * 16) = acc[ai][0][m][n];
    }
};
struct EpiSsmMain {
    static constexpr bool PERM = true, AFTER_DRAIN = false, HAS_MID = false;
    bf16* YS;
    __device__ __forceinline__ void operator()(const Acc& acc, const Unit& u, int wr, int wc, int fr, int fq) const {
        const int mrow = u.pm * BM + wr * 64 + fr;
#pragma unroll
        for (int bj = 0; bj < 2; ++bj) { const int s = 8 * bj + 2 * wc + (fq >> 1);
            bf16* base = YS + ((size_t)mrow * 16 + s) * 512 + u.pn * 16 + 8 * (fq & 1);
            st_half_bf16<3>(acc, bj, base, 16 * 512, 1.f); }
    }
};

template <class Epi, class Src, class Sched, bool ALIGN_EPI>
__device__ __forceinline__ void gemm_phase(PG8_LAS unsigned char* lds, const Src g, const Sched& S, const Epi& E) {
    int tid_ = threadIdx.x; asm volatile("" : "+v"(tid_));
    const int tid = tid_, wid = __builtin_amdgcn_readfirstlane(tid >> 6), lane = tid & 63, wr = wid >> 2, wc = wid & 3, fr = lane & 15, fq = lane >> 4;
    const int nt = g.nt();
    unsigned voffA[2], voffA2[2], voffB[2];
#pragma unroll
    for (int i = 0; i < 2; ++i) { int R, C; stage_rc(tid * 16 + i * 8192, R, C); const int Rb = Epi::PERM ? ((R & ~31) + perm32(R & 31)) : R;
        voffA[i] = g.voffA(R, C, 0); voffA2[i] = Src::TWO_VAR ? g.voffA(R, C, 1) : 0u; voffB[i] = g.voffB(Rb, C); }
    const unsigned ldsw = (unsigned)wid * 1024u;
    const int aoff = lds_byte(wr * 64 + fr, fq * 8), boff = lds_byte(wc * 32 + fr, fq * 8);
#define PG8_SA(b, h) (((b) * 2 + (h)) * HTB)
#define PG8_SB(b, h) ((4 + (b) * 2 + (h)) * HTB)
#define PG8_STAGE_B(bufoff, gbase) do { _Pragma("unroll") for (int _i = 0; _i < 2; ++_i) \
        __builtin_amdgcn_global_load_lds((const unsigned*)((const char*)(gbase) + voffB[_i]), (PG8_LAS unsigned*)(lds + (bufoff) + ldsw + _i * 8192), 16, 0, 0); } while (0)
#define PG8_STAGE_A(bufoff, gbase, kt) do { const bool _v = Src::TWO_VAR && g.avar(kt); _Pragma("unroll") for (int _i = 0; _i < 2; ++_i) { const unsigned _o = _v ? voffA2[_i] : voffA[_i]; \
        __builtin_amdgcn_global_load_lds((const unsigned*)((const char*)(gbase) + _o), (PG8_LAS unsigned*)(lds + (bufoff) + ldsw + _i * 8192), 16, 0, 0); } } while (0)
#define PG8_LDA(dst, b, h) do { _Pragma("unroll") for (int m = 0; m < 4; ++m) _Pragma("unroll") for (int k = 0; k < 2; ++k) dst[m][k] = *(const PG8_LAS bf16x8*)(lds + PG8_SA(b, h) + aoff + m * 2048 + k * 1024); } while (0)
#define PG8_LDB(dst, b, h) do { _Pragma("unroll") for (int n = 0; n < 2; ++n) _Pragma("unroll") for (int k = 0; k < 2; ++k) dst[n][k] = *(const PG8_LAS bf16x8*)(lds + PG8_SB(b, h) + boff + n * 2048 + k * 1024); } while (0)
#define PG8_MMA(ai, bj, At, Bt) do { __builtin_amdgcn_s_setprio(1); _Pragma("unroll") for (int m = 0; m < 4; ++m) _Pragma("unroll") for (int n = 0; n < 2; ++n) _Pragma("unroll") for (int k = 0; k < 2; ++k) \
        acc[ai][bj][m][n] = __builtin_amdgcn_mfma_f32_16x16x32_bf16(Bt[n][k], At[m][k], acc[ai][bj][m][n], 0, 0, 0); __builtin_amdgcn_s_setprio(0); } while (0)
#define PG8_WAIT_V(n) asm volatile("s_waitcnt vmcnt(" #n ")" ::: "memory")
#define PG8_WAIT_L(n) asm volatile("s_waitcnt lgkmcnt(" #n ")" ::: "memory")
#define PG8_BAR __builtin_amdgcn_s_barrier()
#define PG8_SCHED __builtin_amdgcn_sched_barrier(0)
    Unit cur, nxt; int ui = 0;
    if (!S.next(0, cur)) return;
    Acc acc;
#pragma unroll
    for (int a = 0; a < 2; ++a)
#pragma unroll
        for (int b = 0; b < 2; ++b)
#pragma unroll
            for (int m = 0; m < 4; ++m)
#pragma unroll
                for (int n = 0; n < 2; ++n) acc[a][b][m][n] = (f32x4){0.f, 0.f, 0.f, 0.f};
    bf16x8 At[4][2], B0[2][2], B1[2][2];
    PG8_STAGE_B(PG8_SB(0, 0), g.b(cur, 0, 0)); PG8_STAGE_B(PG8_SB(0, 1), g.b(cur, 0, 1)); PG8_STAGE_A(PG8_SA(0, 0), g.a(cur, 0, 0), 0); PG8_STAGE_A(PG8_SA(0, 1), g.a(cur, 0, 1), 0);
    if (wr == 1) PG8_BAR;
    PG8_WAIT_V(2); PG8_BAR;
    PG8_STAGE_B(PG8_SB(1, 0), g.b(cur, 1, 0)); PG8_STAGE_A(PG8_SA(1, 0), g.a(cur, 1, 0), 1); PG8_STAGE_B(PG8_SB(1, 1), g.b(cur, 1, 1));
    PG8_WAIT_V(6); PG8_BAR;
    for (;;) {
        const bool has_next = S.next(ui + 1, nxt);
        const Unit nu = has_next ? nxt : cur;
        for (int t = 0; t < nt; t += 2) {
            const bool last = (t == nt - 2);
            if constexpr (Epi::HAS_MID) E.mid(acc, cur, t, wr, wc, fr, fq);
            const Unit u2 = last ? nu : cur; const int k2 = last ? 0 : t + 2, k3 = k2 + 1;
            PG8_LDB(B0, 0, 0); PG8_LDB(B1, 0, 1); PG8_SCHED; PG8_LDA(At, 0, 0); PG8_STAGE_A(PG8_SA(1, 1), g.a(cur, t + 1, 1), t + 1);
            PG8_WAIT_V(8); PG8_WAIT_L(0); PG8_BAR; PG8_MMA(0, 0, At, B0); PG8_MMA(0, 1, At, B1); PG8_BAR; PG8_SCHED;
            PG8_LDA(At, 0, 1); PG8_STAGE_B(PG8_SB(0, 0), g.b(u2, k2, 0)); PG8_STAGE_B(PG8_SB(0, 1), g.b(u2, k2, 1)); PG8_STAGE_A(PG8_SA(0, 0), g.a(u2, k2, 0), k2);
            PG8_WAIT_V(8); PG8_WAIT_L(0); PG8_BAR; PG8_MMA(1, 0, At, B0); PG8_MMA(1, 1, At, B1); PG8_BAR; PG8_SCHED;
            PG8_LDB(B0, 1, 0); PG8_LDB(B1, 1, 1); PG8_SCHED; PG8_LDA(At, 1, 0); PG8_STAGE_A(PG8_SA(0, 1), g.a(u2, k2, 1), k2);
            PG8_WAIT_V(8); PG8_WAIT_L(0); PG8_BAR; PG8_MMA(0, 0, At, B0); PG8_MMA(0, 1, At, B1); PG8_BAR; PG8_SCHED;
            PG8_LDA(At, 1, 1); PG8_STAGE_B(PG8_SB(1, 0), g.b(u2, k3, 0)); PG8_STAGE_B(PG8_SB(1, 1), g.b(u2, k3, 1)); PG8_STAGE_A(PG8_SA(1, 0), g.a(u2, k3, 0), k3);
            PG8_WAIT_V(8); PG8_WAIT_L(0); PG8_BAR; PG8_MMA(1, 0, At, B0); PG8_MMA(1, 1, At, B1); PG8_BAR; PG8_SCHED;
        }
        if constexpr (ALIGN_EPI) { if (wr == 0) PG8_BAR; }
        { int fr_ = fr, fq_ = fq; asm volatile("" : "+v"(fr_), "+v"(fq_));
          E(acc, cur, wr, wc, fr_, fq_); }
        if (!has_next) break;
#pragma unroll
        for (int a = 0; a < 2; ++a)
#pragma unroll
            for (int b = 0; b < 2; ++b)
#pragma unroll
                for (int m = 0; m < 4; ++m)
#pragma unroll
                    for (int n = 0; n < 2; ++n) acc[a][b][m][n] = (f32x4){0.f, 0.f, 0.f, 0.f};
        cur = nxt; ++ui;
        if constexpr (ALIGN_EPI) { if (wr == 1) PG8_BAR; }
    }
    PG8_WAIT_V(0);
    if constexpr (!ALIGN_EPI) { if (wr == 0) PG8_BAR; }
    PG8_BAR;
#undef PG8_SA
#undef PG8_SB
#undef PG8_STAGE_A
#undef PG8_STAGE_B
#undef PG8_LDA
#undef PG8_LDB
#undef PG8_MMA
#undef PG8_WAIT_V
#undef PG8_WAIT_L
#undef PG8_BAR
#undef PG8_SCHED
}
}
constexpr int NWAVES = 8;
constexpr int RING_OFF = 0, RING_BYTES = 131072;
constexpr int LDSCTL_OFF = RING_BYTES, MISC_OFF = LDSCTL_OFF + 320, RINV_OFF = LDSCTL_OFF + 1024;
constexpr int LDS_BYTES = 147456;
constexpr int CW_TMO = 0, CW_CODE = 1, CW_BAR = 4096, CW_CNT = 16384, CW_OWNQ = 20480, CW_SWAQ = 20544;

#define GAS __attribute__((address_space(1)))
#define LAS __attribute__((address_space(3)))
typedef GAS unsigned gu32;
#define RLX_AGENT __ATOMIC_RELAXED, __HIP_MEMORY_SCOPE_AGENT
#define LDS_WAIT() asm volatile("s_waitcnt lgkmcnt(0)" ::: "memory")
#define VM_WAIT() asm volatile("s_waitcnt vmcnt(0)" ::: "memory")

#define XB_TMO      128
#define XB_XCNT(j)  (256  + 64 * (j))
#define XB_XSUB(j)  (1280 + 64 * (j))
#define XB_XGEN(j)  (2304 + 64 * (j))
#define XB_TOP      3328
#define XB_TOPGEN   3392
#define XCD_BAR_WORDS 3456
#define XB_SPIN_CAP (1u << 20)
__device__ __forceinline__ unsigned xb_ld(unsigned* p)              { return __hip_atomic_load(p, __ATOMIC_RELAXED, __HIP_MEMORY_SCOPE_AGENT); }
__device__ __forceinline__ unsigned xb_add(unsigned* p, unsigned v) { return __hip_atomic_fetch_add(p, v, __ATOMIC_RELAXED, __HIP_MEMORY_SCOPE_AGENT); }
__device__ __forceinline__ unsigned xb_xcc_id() { return (unsigned)__builtin_amdgcn_s_getreg((3 << 11) | 20) & 0xFu; }
#define XB_SPIN(cond, bar) do { unsigned _sp = 0; while (cond) { __builtin_amdgcn_s_sleep(1); \
    if ((++_sp & 255u) == 0u) { if (xb_ld(&(bar)[XB_TMO])) break; if (_sp > XB_SPIN_CAP) { atomicAdd(&(bar)[XB_TMO], 1u); break; } } } } while (0)
struct XcdBarrier { unsigned* bar; unsigned x; volatile LAS unsigned* st; };
__device__ __forceinline__ XcdBarrier xcd_barrier_post(unsigned* bar, volatile LAS unsigned* st) {
    XcdBarrier b; b.bar = bar; b.x = xb_xcc_id(); b.st = st;
    if (threadIdx.x == 0) (void)xb_add(&bar[XB_XCNT(b.x)], 1u);
    return b;
}
__device__ __forceinline__ void xcd_barrier_complete(unsigned* bar, unsigned x, unsigned& nloc, unsigned& nx) {
    const unsigned G = gridDim.x * gridDim.y * gridDim.z;
    unsigned sum, cnt, mine, sp = 0u;
    for (;;) {
        sum = 0u; cnt = 0u; mine = 0u;
#pragma unroll
        for (unsigned j = 0; j < 16; ++j) { const unsigned c = xb_ld(&bar[XB_XCNT(j)]); sum += c; cnt += (c > 0u) ? 1u : 0u; mine = (j == x) ? c : mine; }
        if (sum == G) break;
        __builtin_amdgcn_s_sleep(1);
        if ((++sp & 255u) == 0u) { if (xb_ld(&bar[XB_TMO])) break; if (sp > XB_SPIN_CAP) { atomicAdd(&bar[XB_TMO], 1u); break; } }
    }
    nloc = mine > 0u ? mine : 1u; nx = cnt > 0u ? cnt : 1u;
}
__device__ __forceinline__ void xcd_barrier(const XcdBarrier& b) {
    asm volatile("s_waitcnt vmcnt(0)" ::: "memory");
    __syncthreads();
    if (threadIdx.x == 0) {
        unsigned* bar = b.bar;
        __builtin_amdgcn_s_waitcnt(0);
        unsigned nloc = b.st[0], nx = b.st[1];
        if (nloc == 0u) { xcd_barrier_complete(bar, b.x, nloc, nx); b.st[0] = nloc; b.st[1] = nx; }
        const unsigned old = xb_add(&bar[XB_XSUB(b.x)], 1u);
        const unsigned gen = old / nloc;
        if (old + 1u == (gen + 1u) * nloc) {
            __builtin_amdgcn_fence(__ATOMIC_RELEASE, "agent");
            asm volatile("s_waitcnt vmcnt(0)" ::: "memory");
            const unsigned og = xb_add(&bar[XB_TOP], 1u);
            const unsigned tg = og / nx;
            if (og + 1u == (tg + 1u) * nx) xb_add(&bar[XB_TOPGEN], 1u);
            else XB_SPIN(xb_ld(&bar[XB_TOPGEN]) == tg, bar);
            __builtin_amdgcn_fence(__ATOMIC_ACQUIRE, "agent");
            xb_add(&bar[XB_XGEN(b.x)], 1u);
            asm volatile("s_waitcnt vmcnt(0)" ::: "memory");
        } else {
            XB_SPIN(xb_ld(&bar[XB_XGEN(b.x)]) == gen, bar);
            __builtin_amdgcn_fence(__ATOMIC_ACQUIRE, "agent");
            asm volatile("s_waitcnt vmcnt(0)" ::: "memory");
        }
    }
    __syncthreads();
}

struct Frame {
    LAS unsigned char* lds;
    int tid, lane, wave, vcu, G;
};

struct ConvItem { const float* W; const float* gain; bf16* WT; int N, Kdst, k_off, k0, n0, drow0; };
__device__ __forceinline__ bool conv_decode(ConvItem& c, const Ptrs& P, int l, int it) {
    constexpr int I_IN = 16 * 160, I_GLU = 8 * 32, I_MRG = 3 * 8 * 32, I_OUT = 16 * 32, I_F1 = 16 * 128, I_F2 = 64 * 32;
    constexpr int NITEMS = I_IN + I_GLU + I_MRG + I_OUT + I_F1 + I_F2;
    if (it >= NITEMS) return false;
    unsigned char* ws = P.ws; int r = it; c.gain = nullptr; c.k_off = 0;
    if (r < I_IN) { const int kb = r / 160, nb = r % 160; c.W = P.w_in + (size_t)l * DM * DIN; c.N = DIN; c.gain = P.norm_mix + l * DM; c.WT = (bf16*)(ws + WS_WIN); c.Kdst = DM; c.k0 = 64 * kb; c.n0 = 32 * nb; c.drow0 = 32 * nb; return true; } r -= I_IN;
    if (r < I_GLU) { const int kb = r / 32, nb = r % 32; const int n0 = 32 * nb, v = n0 & 511;
        c.W = P.w_glu + (size_t)l * 512 * 1024; c.N = 1024; c.WT = (bf16*)(ws + WS_WGLU); c.Kdst = 512; c.k0 = 64 * kb; c.n0 = n0; c.drow0 = (v >> 7) * 256 + (n0 >= 512 ? 128 : 0) + (v & 127); return true; } r -= I_GLU;
    if (r < I_MRG) { const int sg = r / 256, q = r % 256, kb = q / 32, nb = q % 32; c.W = (sg == 0 ? P.w_o_swa : (sg == 1 ? P.w_o_ssm : P.w_o_moba)) + (size_t)l * 512 * DM;
        c.N = DM; c.WT = (bf16*)(ws + WS_WMRG); c.Kdst = 1536; c.k_off = 512 * sg; c.k0 = 64 * kb; c.n0 = 32 * nb; c.drow0 = 32 * nb; return true; } r -= I_MRG;
    if (r < I_OUT) { const int kb = r / 32, nb = r % 32; c.W = P.w_out + (size_t)l * DM * DM; c.N = DM; c.WT = (bf16*)(ws + WS_WOUT); c.Kdst = DM; c.k0 = 64 * kb; c.n0 = 32 * nb; c.drow0 = 32 * nb; return true; } r -= I_OUT;
    if (r < I_F1) { const int kb = r / 128, nb = r % 128; c.W = P.w_ff1 + (size_t)l * DM * DFF; c.N = DFF; c.gain = P.norm_ffn + l * DM; c.WT = (bf16*)(ws + WS_WFF1); c.Kdst = DM; c.k0 = 64 * kb; c.n0 = 32 * nb; c.drow0 = 32 * nb; return true; } r -= I_F1;
    { const int kb = r / 32, nb = r % 32; c.W = P.w_ff2 + (size_t)l * DFF * DM; c.N = DM; c.WT = (bf16*)(ws + WS_WFF2); c.Kdst = DFF; c.k0 = 64 * kb; c.n0 = 32 * nb; c.drow0 = 32 * nb; return true; }
}
__device__ __forceinline__ void conv_loads(f32x4 (&wv)[8], const ConvItem& c, int lane) {
#pragma unroll
    for (int i = 0; i < 8; ++i) wv[i] = *(const f32x4*)(c.W + (size_t)(c.k0 + 8 * i + (lane >> 3)) * c.N + c.n0 + 4 * (lane & 7));
}
__device__ __forceinline__ void conv_store(const f32x4 (&wv)[8], const ConvItem& c, LAS float* scr, int lane) {
#pragma unroll
    for (int i = 0; i < 8; ++i) { const int kk = 8 * i + (lane >> 3); const float g = c.gain ? c.gain[c.k0 + kk] : 1.f; LAS float* sp = scr + kk * 33 + 4 * (lane & 7);
        sp[0] = wv[i][0] * g; sp[1] = wv[i][1] * g; sp[2] = wv[i][2] * g; sp[3] = wv[i][3] * g; }
    LDS_WAIT(); asm volatile("" ::: "memory");
    const int cc = lane & 7;
#pragma unroll
    for (int j = 0; j < 4; ++j) { const int n = (lane >> 3) + 8 * j; const LAS float* s = scr + (8 * cc) * 33 + n;
        u32x4 o; o.x = pk2(s[0 * 33], s[1 * 33]); o.y = pk2(s[2 * 33], s[3 * 33]); o.z = pk2(s[4 * 33], s[5 * 33]); o.w = pk2(s[6 * 33], s[7 * 33]);
        *(GAS u32x4*)(c.WT + (size_t)(c.drow0 + n) * c.Kdst + c.k_off + c.k0 + 8 * cc) = o; }
    LDS_WAIT(); asm volatile("" ::: "memory");
}
__device__ __forceinline__ void conv_layer(const Frame& F, const Ptrs& P, int l) {
    LAS float* scr = (LAS float*)(F.lds + RING_OFF + F.wave * 16384);
    const int gw = F.vcu * NWAVES + F.wave, NGW = F.G * NWAVES;
    f32x4 wa[8], wb[8];
    int it = gw; bool have;
    { ConvItem c; have = conv_decode(c, P, l, it); if (have) conv_loads(wa, c, F.lane); }
#pragma unroll 1
    while (have) {
        bool hn; { ConvItem n; hn = conv_decode(n, P, l, it + NGW); if (hn) conv_loads(wb, n, F.lane); }
        { ConvItem c; conv_decode(c, P, l, it); asm volatile("" ::: "memory"); conv_store(wa, c, scr, F.lane); }
        have = hn; it += NGW;
#pragma unroll
        for (int i = 0; i < 8; ++i) wa[i] = wb[i];
    }
}
__device__ __forceinline__ void ssm_mats(const Frame& F, const Ptrs& P, int l) {
    __syncthreads();
    LAS float* L = (LAS float*)(F.lds + RING_OFF);
    LAS float* apr = L;
    LAS float* api = L + 17 * 64;
    LAS float* bbr = L + 34 * 64;
    LAS float* bbi = bbr + 1024;
    LAS float* ccr = bbi + 1024;
    LAS float* cci = ccr + 1024;
    LAS float* ktab = cci + 1024;
    for (int wi = F.vcu; wi < 256; wi += F.G) {
        const int g = wi >> 3, part = wi & 7; const int tid = F.tid;
        if (tid < 64) { const int p = tid; const float lr = P.lam_re[l * 2048 + g * 64 + p], li = P.lam_im[l * 2048 + g * 64 + p], dt = expf(P.log_step[l * 32 + g]);
            const float mag = expf(lr * dt), are = mag * cosf(li * dt), aim = mag * sinf(li * dt);
            const float den = lr * lr + li * li, nr = are - 1.f, ni = aim, fre = (nr * lr + ni * li) / den, fim = (ni * lr - nr * li) / den;
            float pr = 1.f, pi = 0.f;
            for (int k = 0; k <= 16; ++k) { apr[k * 64 + p] = pr; api[k * 64 + p] = pi; const float t = pr * are - pi * aim; pi = pr * aim + pi * are; pr = t; }
            for (int h = 0; h < 16; ++h) { const float br = P.b_re[(size_t)l * 32768 + (g * 64 + p) * 16 + h], bi = P.b_im[(size_t)l * 32768 + (g * 64 + p) * 16 + h]; bbr[p * 16 + h] = fre * br - fim * bi; bbi[p * 16 + h] = fre * bi + fim * br; } }
        for (int e = tid; e < 1024; e += 512) { ccr[e] = P.c_re[(size_t)l * 32768 + g * 1024 + e]; cci[e] = P.c_im[(size_t)l * 32768 + g * 1024 + e]; }
        __syncthreads();
        for (int e = tid; e < 512; e += 512) { const int tau = e >> 5, i = 2 * part + ((e >> 4) & 1), j = e & 15; float acc = 0.f;
            for (int p = 0; p < 64; ++p) { const float cr = ccr[i * 64 + p], ci = cci[i * 64 + p], ar = apr[tau * 64 + p], ai = api[tau * 64 + p]; const float er = cr * ar - ci * ai, ei = cr * ai + ci * ar; acc += er * bbr[p * 16 + j] - ei * bbi[p * 16 + j]; }
            if (tau == 0 && i == j) acc += P.d_skip[l * 512 + g * 16 + i];
            ktab[tau * 256 + i * 16 + j] = acc; }
        __syncthreads();
        bf16* BM_ = (bf16*)(P.ws + WS_SMAIN) + (size_t)g * 256 * SSM_KM;
        for (int e = tid; e < 32 * SSM_KM / 2; e += 512) {
            const int rr = e / (SSM_KM / 2), k = (e % (SSM_KM / 2)) * 2, s = rr >> 1, i = 2 * part + (rr & 1), n = s * 16 + i; float v[2];
#pragma unroll
            for (int q = 0; q < 2; ++q) { const int kk = k + q;
                if (kk < 256) { const int sp = kk >> 4, j = kk & 15; v[q] = (sp <= s) ? ktab[(s - sp) * 256 + i * 16 + j] : 0.f; }
                else { const int p = (kk - 256) & 63; const float cr = ccr[i * 64 + p], ci = cci[i * 64 + p], ar = apr[(s + 1) * 64 + p], ai = api[(s + 1) * 64 + p]; v[q] = (kk < 320) ? (cr * ar - ci * ai) : -(cr * ai + ci * ar); } }
            *(GAS unsigned*)(BM_ + (size_t)n * SSM_KM + k) = pk2(v[0], v[1]); }
        bf16* BE_ = (bf16*)(P.ws + WS_SEND) + (size_t)g * 256 * SSM_KE;
        for (int e = tid; e < 32 * SSM_KE / 2; e += 512) {
            const int n = part * 32 + e / (SSM_KE / 2), k = (e % (SSM_KE / 2)) * 2; float v[2];
#pragma unroll
            for (int q = 0; q < 2; ++q) { const int kk = k + q, sp = kk >> 4, j = kk & 15, p = n & 63; const float ar = apr[(15 - sp) * 64 + p], ai = api[(15 - sp) * 64 + p], br = bbr[p * 16 + j], bi = bbi[p * 16 + j];
                v[q] = (n < 64) ? (ar * br - ai * bi) : ((n < 128) ? (ar * bi + ai * br) : 0.f); }
            *(GAS unsigned*)(BE_ + (size_t)n * SSM_KE + k) = pk2(v[0], v[1]); }
        __syncthreads();
    }
}
__device__ __forceinline__ void xb_pass(const Frame& F, const Ptrs& P) {
    const int gw = F.vcu * NWAVES + F.wave, NGW = F.G * NWAVES;
    bf16* XB = (bf16*)(P.ws + WS_XN); float* SSQ = (float*)(P.ws + WS_SSQ);
    for (int m = gw; m < T; m += NGW) {
        const GAS f32x4* xr = (const GAS f32x4*)(P.x_in + (size_t)m * DM) + F.lane;
        f32x4 v[4]; float s = 0.f;
#pragma unroll
        for (int j = 0; j < 4; ++j) { v[j] = xr[64 * j]; s += (v[j].x * v[j].x + v[j].y * v[j].y) + (v[j].z * v[j].z + v[j].w * v[j].w); }
        s = wave_sum(s);
        GAS unsigned long long* o8 = (GAS unsigned long long*)(XB + (size_t)m * DM) + F.lane;
#pragma unroll
        for (int j = 0; j < 4; ++j) o8[64 * j] = (unsigned long long)pk2(v[j].x, v[j].y) | ((unsigned long long)pk2(v[j].z, v[j].w) << 32);
        if (F.lane < 16) SSQ[(size_t)m * 16 + F.lane] = (F.lane == 0) ? s : 0.f;
    }
}
__device__ __forceinline__ void final_pass(const Frame& F, const Ptrs& P) {
    const int gw = F.vcu * NWAVES + F.wave, NGW = F.G * NWAVES;
    for (int m = gw; m < T; m += NGW) {
        GAS f32x4* xr = (GAS f32x4*)(P.x + (size_t)m * DM) + F.lane;
        f32x4 v[4]; float s = 0.f;
#pragma unroll
        for (int j = 0; j < 4; ++j) { v[j] = xr[64 * j]; s += (v[j].x * v[j].x + v[j].y * v[j].y) + (v[j].z * v[j].z + v[j].w * v[j].w); }
        const float r = rsqrtf(wave_sum(s) * (1.f / DM) + NORM_EPS);
#pragma unroll
        for (int j = 0; j < 4; ++j) { const f32x4 g = ((const GAS f32x4*)P.norm_final)[F.lane + 64 * j]; xr[64 * j] = v[j] * r * g; }
    }
}
__device__ __forceinline__ void ssm_carry(const Frame& F, const Ptrs& P, int l) {
    if (F.vcu & 15) return;
    const int gt = (F.vcu >> 4) * 512 + F.tid;
    if (gt >= 32 * NB * 64) return;
    const int p = gt & 63, b = (gt >> 6) & 3, g = gt >> 8;
    const float lr = P.lam_re[l * 2048 + g * 64 + p], li = P.lam_im[l * 2048 + g * 64 + p], dt = expf(P.log_step[l * 32 + g]);
    const float mag = expf(lr * dt), are = mag * cosf(li * dt), aim = mag * sinf(li * dt);
    float pr = 1.f, pi = 0.f;
    for (int k = 0; k < 16; ++k) { const float t = pr * are - pi * aim; pi = pr * aim + pi * are; pr = t; }
    const float* he = (const float*)(P.ws + WS_HEND) + ((size_t)g * NCH + b * 256) * 128 + p;
    bf16* hi = (bf16*)(P.ws + WS_HINIT) + ((size_t)g * NCH + b * 256) * 128 + p;
    float sr = 0.f, si = 0.f;
    float er[8], ei[8];
#pragma unroll
    for (int q = 0; q < 8; ++q) { er[q] = he[(size_t)q * 128]; ei[q] = he[(size_t)q * 128 + 64]; }
    for (int c0 = 0; c0 < 256; c0 += 8) {
        float nr_[8], ni_[8];
        const int cn = (c0 + 8 < 256) ? c0 + 8 : c0;
#pragma unroll
        for (int q = 0; q < 8; ++q) { nr_[q] = he[(size_t)(cn + q) * 128]; ni_[q] = he[(size_t)(cn + q) * 128 + 64]; }
#pragma unroll
        for (int q = 0; q < 8; ++q) { hi[(size_t)(c0 + q) * 128] = (bf16)f2bf(sr); hi[(size_t)(c0 + q) * 128 + 64] = (bf16)f2bf(si);
            const float tr = pr * sr - pi * si + er[q], ti = pr * si + pi * sr + ei[q]; sr = tr; si = ti; }
#pragma unroll
        for (int q = 0; q < 8; ++q) { er[q] = nr_[q]; ei[q] = ni_[q]; }
    }
}
namespace att {
__device__ __forceinline__ int crow(int r, int hi) { return (r & 3) + 8 * (r >> 2) + 4 * hi; }
struct St { f32x16 o0, o1; float m, l; };
__device__ __forceinline__ unsigned cvtpk(float lo, float hi) { return cvtpk_s(lo, hi); }

__device__ __forceinline__ void loadk(bf16x8 (&kf)[8], const bf16* kp) {
#pragma unroll
    for (int d0 = 0; d0 < 4; ++d0) { kf[2 * d0] = *(const bf16x8*)(kp + d0 * 16); kf[2 * d0 + 1] = *(const bf16x8*)(kp + 32 * 128 + d0 * 16); }
}
template <int MODE>
__device__ __forceinline__ void tile(St& st, const bf16x8 (&qr)[4], const bf16x8 (&kf)[8], const bf16* vtp  , int kq  , float sl2, bool rowok, int klo  , int hi) {
    f32x16 p0 = {}, p1 = {};
#pragma unroll
    for (int d0 = 0; d0 < 4; ++d0) { p0 = __builtin_amdgcn_mfma_f32_32x32x16_bf16(kf[2 * d0], qr[d0], p0, 0, 0, 0); p1 = __builtin_amdgcn_mfma_f32_32x32x16_bf16(kf[2 * d0 + 1], qr[d0], p1, 0, 0, 0); }
    s16x4 vl[2][4], vh[2][4];
#pragma unroll
    for (int dh = 0; dh < 2; ++dh)
#pragma unroll
        for (int s = 0; s < 4; ++s) { vl[dh][s] = *(const s16x4*)(vtp + (size_t)dh * 32 * S + 16 * s); vh[dh][s] = *(const s16x4*)(vtp + (size_t)dh * 32 * S + 16 * s + 8); }
    const float base = sl2 * (float)(kq + 4 * hi);
    float mx = -INFINITY;
#pragma unroll
    for (int r = 0; r < 16; ++r) { const int c = (r & 3) + 8 * (r >> 2); const int k0 = kq + 4 * hi + c, k1 = k0 + 32;
        float a = fmaf(sl2, (float)c, p0[r]), b = fmaf(sl2, (float)(c + 32), p1[r]);
        if (MODE == 1) { a = (k0 <= 0 && k0 >= klo) ? a : -INFINITY; b = (k1 <= 0 && k1 >= klo) ? b : -INFINITY; }
        else if (MODE == 2) { a = (k0 <= 0) ? a : -INFINITY; b = (k1 <= 0) ? b : -INFINITY; }
        else if (MODE == 3) { a = (rowok && k0 <= 0) ? a : -INFINITY; b = (rowok && k1 <= 0) ? b : -INFINITY; }
        p0[r] = a; p1[r] = b; mx = fmaxf(mx, fmaxf(a, b)); }
    mx += base;
    mx = fmaxf(mx, __shfl_xor(mx, 32));
    const float mn = fmaxf(st.m, mx), alpha = __builtin_amdgcn_exp2f(st.m - mn), off = base - mn;
    float sum = 0.f;
#pragma unroll
    for (int r = 0; r < 16; ++r) { p0[r] = __builtin_amdgcn_exp2f(p0[r] + off); p1[r] = __builtin_amdgcn_exp2f(p1[r] + off); sum += p0[r] + p1[r]; }
    st.m = mn; st.l = st.l * alpha + sum;
#pragma unroll
    for (int r = 0; r < 16; ++r) { st.o0[r] *= alpha; st.o1[r] *= alpha; }
    bf16x8 pf[4];
#pragma unroll
    for (int s = 0; s < 2; ++s) { u32x4 w0, w1;
        w0.x = cvtpk(p0[8 * s + 0], p0[8 * s + 1]); w0.y = cvtpk(p0[8 * s + 2], p0[8 * s + 3]); w0.z = cvtpk(p0[8 * s + 4], p0[8 * s + 5]); w0.w = cvtpk(p0[8 * s + 6], p0[8 * s + 7]);
        w1.x = cvtpk(p1[8 * s + 0], p1[8 * s + 1]); w1.y = cvtpk(p1[8 * s + 2], p1[8 * s + 3]); w1.z = cvtpk(p1[8 * s + 4], p1[8 * s + 5]); w1.w = cvtpk(p1[8 * s + 6], p1[8 * s + 7]);
        pf[s] = __builtin_bit_cast(bf16x8, w0); pf[2 + s] = __builtin_bit_cast(bf16x8, w1); }
#pragma unroll
    for (int s = 0; s < 4; ++s) {
        const bf16x8 v0 = (bf16x8){vl[0][s][0], vl[0][s][1], vl[0][s][2], vl[0][s][3], vh[0][s][0], vh[0][s][1], vh[0][s][2], vh[0][s][3]};
        const bf16x8 v1 = (bf16x8){vl[1][s][0], vl[1][s][1], vl[1][s][2], vl[1][s][3], vh[1][s][0], vh[1][s][1], vh[1][s][2], vh[1][s][3]};
        st.o0 = __builtin_amdgcn_mfma_f32_32x32x16_bf16(v0, pf[s], st.o0, 0, 0, 0);
        st.o1 = __builtin_amdgcn_mfma_f32_32x32x16_bf16(v1, pf[s], st.o1, 0, 0, 0); }
}
__device__ __forceinline__ void finish(const St& st, bf16* op, int hi) {
    const float lt = st.l + __shfl_xor(st.l, 32), rl = __builtin_amdgcn_rcpf(lt);
#pragma unroll
    for (int g = 0; g < 4; ++g) { u32x2 a, b;
        a.x = cvtpk(st.o0[4 * g] * rl, st.o0[4 * g + 1] * rl); a.y = cvtpk(st.o0[4 * g + 2] * rl, st.o0[4 * g + 3] * rl);
        b.x = cvtpk(st.o1[4 * g] * rl, st.o1[4 * g + 1] * rl); b.y = cvtpk(st.o1[4 * g + 2] * rl, st.o1[4 * g + 3] * rl);
        *(u32x2*)(op + 8 * g + 4 * hi) = a; *(u32x2*)(op + 32 + 8 * g + 4 * hi) = b; }
}
__device__ __forceinline__ void loadq(bf16x8 (&qr)[4], const bf16* qp) {
#pragma unroll
    for (int d0 = 0; d0 < 4; ++d0) qr[d0] = *(const bf16x8*)(qp + d0 * 16);
}

constexpr int IMG_K = 0, IMG_V = 32768, IMG_BYTES = 65536;
__device__ __forceinline__ void img_load(const Frame& F, LAS unsigned char* img, const bf16* K, long krow0, int kvh, const bf16* vt0, int key0) {
    const int lane = F.lane, w = F.wave;
#pragma unroll
    for (int i = 0; i < 4; ++i) { const int piece = w * 4 + i, key = piece * 8 + (lane >> 3), c = (lane & 7) ^ ((key >> 1) & 7); long row = krow0 + key; row = row < 0 ? 0 : row;
        __builtin_amdgcn_global_load_lds((const unsigned*)(K + row * 128 + kvh * 64 + c * 8), (LAS unsigned*)(img + IMG_K + piece * 1024), 16, 0, 0); }
#pragma unroll
    for (int i = 0; i < 4; ++i) { const int piece = w * 4 + i, d = piece * 2 + (lane >> 5), c = (lane & 31) ^ (d & 15); int kk = key0 + c * 8; kk = kk < 0 ? 0 : kk;
        __builtin_amdgcn_global_load_lds((const unsigned*)(vt0 + (long)d * S + kk), (LAS unsigned*)(img + IMG_V + piece * 1024), 16, 0, 0); }
}
struct LaneOff { int k[4]; int v[8]; };
__device__ __forceinline__ void lane_off(LaneOff& lo, int r32, int hi) { const int s7 = (r32 >> 1) & 7, x = r32 & 15;
#pragma unroll
    for (int d0 = 0; d0 < 4; ++d0) lo.k[d0] = ((2 * d0 + hi) ^ s7) << 4;
#pragma unroll
    for (int j = 0; j < 8; ++j) lo.v[j] = (j ^ (x & 7)) << 4; }
template <int MODE, bool HALF, bool AL64>
__device__ __forceinline__ void tile_lds(St& st, const bf16x8 (&qr)[4], const LAS unsigned char* img, const LaneOff& lo, int ko, int kq  , float sl2, bool rowok, int klo, int hi, int r32) {
    const LAS unsigned char* kp = img + IMG_K + (ko + r32) * 128;
    const bool fresh = st.m == -INFINITY; const float ref = fresh ? 0.f : st.m;
    const float cin = sl2 * (float)(kq + 4 * hi) - ref;
    f32x16 p0, p1;
#pragma unroll
    for (int r = 0; r < 16; ++r) { p0[r] = cin; p1[r] = cin; }
#pragma unroll
    for (int d0 = 0; d0 < 4; ++d0) {
        p0 = __builtin_amdgcn_mfma_f32_32x32x16_bf16(*(const LAS bf16x8*)(kp + lo.k[d0]), qr[d0], p0, 0, 0, 0);
        if (!HALF) p1 = __builtin_amdgcn_mfma_f32_32x32x16_bf16(*(const LAS bf16x8*)(kp + 32 * 128 + lo.k[d0]), qr[d0], p1, 0, 0, 0); }
    float mx = -INFINITY;
#pragma unroll
    for (int r = 0; r < 16; ++r) { const int c = (r & 3) + 8 * (r >> 2); const int k0 = kq + 4 * hi + c, k1 = k0 + 32;
        float a = fmaf(sl2, (float)c, p0[r]), b = HALF ? -INFINITY : fmaf(sl2, (float)(c + 32), p1[r]);
        if (MODE == 1) { a = (k0 <= 0 && k0 >= klo) ? a : -INFINITY; if (!HALF) b = (k1 <= 0 && k1 >= klo) ? b : -INFINITY; }
        else if (MODE == 2) { a = (k0 <= 0) ? a : -INFINITY; if (!HALF) b = (k1 <= 0) ? b : -INFINITY; }
        else if (MODE == 3) { a = (rowok && k0 <= 0) ? a : -INFINITY; if (!HALF) b = (rowok && k1 <= 0) ? b : -INFINITY; }
        p0[r] = a; if (!HALF) p1[r] = b; mx = fmaxf(mx, HALF ? a : fmaxf(a, b)); }
    mx = fmaxf(mx, __shfl_xor(mx, 32));
    const float delta = fresh ? ((mx == -INFINITY) ? 0.f : mx) : ((mx > 8.f) ? mx : 0.f);
    if (__any(delta != 0.f)) {
        const float alpha = fresh ? 1.f : __builtin_amdgcn_exp2f(-delta);
#pragma unroll
        for (int r = 0; r < 16; ++r) { p0[r] -= delta; if (!HALF) p1[r] -= delta; st.o0[r] *= alpha; st.o1[r] *= alpha; }
        st.l *= alpha;
        st.m = (fresh && mx == -INFINITY) ? -INFINITY : ref + delta;
    }
    float sum = 0.f;
#pragma unroll
    for (int r = 0; r < 16; ++r) { p0[r] = __builtin_amdgcn_exp2f(p0[r]); sum += p0[r]; if (!HALF) { p1[r] = __builtin_amdgcn_exp2f(p1[r]); sum += p1[r]; } }
    st.l += sum;
    const int x = r32 & 15, kc = ko >> 3;
    const LAS unsigned char* vp = img + IMG_V + r32 * 512 + hi * 8 + (AL64 ? ((kc ^ (x & 8)) << 4) : 0);
#pragma unroll
    for (int s = 0; s < (HALF ? 2 : 4); ++s) {
        u32x4 w;
        if (s < 2) { w.x = cvtpk(p0[8 * s + 0], p0[8 * s + 1]); w.y = cvtpk(p0[8 * s + 2], p0[8 * s + 3]); w.z = cvtpk(p0[8 * s + 4], p0[8 * s + 5]); w.w = cvtpk(p0[8 * s + 6], p0[8 * s + 7]); }
        else { w.x = cvtpk(p1[8 * s - 16], p1[8 * s - 15]); w.y = cvtpk(p1[8 * s - 14], p1[8 * s - 13]); w.z = cvtpk(p1[8 * s - 12], p1[8 * s - 11]); w.w = cvtpk(p1[8 * s - 10], p1[8 * s - 9]); }
        const bf16x8 pf = __builtin_bit_cast(bf16x8, w);
        const int o0 = AL64 ? lo.v[2 * s] : (((kc + 2 * s) ^ x) << 4), o1 = AL64 ? lo.v[2 * s + 1] : (((kc + 2 * s + 1) ^ x) << 4);
        const s16x4 a0 = *(const LAS s16x4*)(vp + o0), a1 = *(const LAS s16x4*)(vp + o1), b0 = *(const LAS s16x4*)(vp + 32 * 512 + o0), b1 = *(const LAS s16x4*)(vp + 32 * 512 + o1);
        st.o0 = __builtin_amdgcn_mfma_f32_32x32x16_bf16((bf16x8){a0[0], a0[1], a0[2], a0[3], a1[0], a1[1], a1[2], a1[3]}, pf, st.o0, 0, 0, 0);
        st.o1 = __builtin_amdgcn_mfma_f32_32x32x16_bf16((bf16x8){b0[0], b0[1], b0[2], b0[3], b1[0], b1[1], b1[2], b1[3]}, pf, st.o1, 0, 0, 0); }
}
__device__ __forceinline__ void swa_unit(const Frame& F, const Ptrs& P, int l, int un) {
    bf16* QA = (bf16*)(P.ws + WS_QA); const bf16* KA = (const bf16*)(P.ws + WS_KA); const bf16* VAT = (const bf16*)(P.ws + WS_VAT);
    const int lane = F.lane, r32 = lane & 31, hi = lane >> 5, w = F.wave;
    LAS unsigned char* img = F.lds + RING_OFF;
    LaneOff lo; lane_off(lo, r32, hi);
    {
        const int bk = un >> 5, nb = un & 31, b = bk >> 1, kvh = bk & 1, h = kvh * 4 + (w >> 1);
        __syncthreads();
        img_load(F, img, KA, (long)b * S + nb * 128 - 128, kvh, VAT + (long)((b * 2 + kvh) * 64) * S, nb * 128 - 128);
        const float sl2 = exp2f(-0.5f * (float)(h + 1)) * LOG2E, sink2 = P.sinks[l * 8 + h] * LOG2E;
        asm volatile("s_waitcnt vmcnt(0)" ::: "memory"); __syncthreads();
        for (int qt = 0; qt < 2; ++qt) {
            const int qo = (w & 1) * 64 + qt * 32, t0 = nb * 128 + qo, q = t0 + r32;
            bf16* qrow = QA + (size_t)(b * S + q) * 512 + h * 64;
            bf16x8 qr[4]; loadq(qr, qrow + 8 * hi);
            St st; st.o0 = f32x16{}; st.o1 = f32x16{}; st.m = sink2; st.l = hi ? 0.f : 1.f;
            const int klo = q < 127 ? -q : -127;
#pragma unroll 1
            for (int kt = 0; kt < 2; ++kt) { if (t0 - 128 + 64 * kt + 63 >= 0) tile_lds<1, false, false>(st, qr, img, lo, qo + 64 * kt, t0 - 128 + 64 * kt - q, sl2, true, klo, hi, r32); }
            tile_lds<1, true, false>(st, qr, img, lo, qo + 128, t0 - q, sl2, true, klo, hi, r32);
            finish(st, qrow, hi);
        }
    }
    __syncthreads();
}
__device__ __forceinline__ float moba_sl2(int h) { return exp2f(-0.5f * (float)(8 + h + 1)) * LOG2E; }
__device__ __forceinline__ void select_unit(const Frame& F, const Ptrs& P, int l, int un) {
    const bf16* QM = (const bf16*)(P.ws + WS_QM); const float* KMP = (const float*)(P.ws + WS_KMP);
    unsigned* LIST = (unsigned*)(P.ws + WS_LIST); unsigned* CNT = (unsigned*)(P.ws + WS_CTL) + CW_CNT + l * 128;
    LAS float* km = (LAS float*)(F.lds + RING_OFF);
    const int tid = F.tid, lane = F.lane;
    {
        const int bk = un >> 5, ch = un & 31, b = bk >> 1, kvh = bk & 1, j = ch >> 1;
        __syncthreads();
        for (int e = tid; e < 1024; e += 512) { const int n = e >> 6, d = e & 63; const float* k0 = KMP + (size_t)(b * 16 + n) * 128 + kvh * 64 + d; km[e] = k0[0] + k0[64 * 128]; }
        __syncthreads();
        if (j == 0) return;
        const int hg = tid >> 7, t = ch * 128 + (tid & 127);
        const bf16* qp = QM + (size_t)(b * S + t) * 512 + (kvh * 4 + hg) * 64;
        u32x4 qv[8];
#pragma unroll
        for (int i = 0; i < 8; ++i) qv[i] = *(const u32x4*)(qp + 8 * i);
        int i0 = 0, i1 = 1, i2 = 2;
        if (j > 3) {
            float v0 = -INFINITY, v1 = -INFINITY, v2 = -INFINITY; i0 = 0; i1 = 0; i2 = 0;
#pragma unroll 1
            for (int n = 0; n < j; ++n) { float a = 0.f;
#pragma unroll
                for (int i = 0; i < 8; ++i) { const f32x4 x0 = *(const LAS f32x4*)(km + n * 64 + 8 * i), x1 = *(const LAS f32x4*)(km + n * 64 + 8 * i + 4);
                    a += bf2f(qv[i].x & 0xffffu) * x0[0] + bf2f(qv[i].x >> 16) * x0[1] + bf2f(qv[i].y & 0xffffu) * x0[2] + bf2f(qv[i].y >> 16) * x0[3]
                       + bf2f(qv[i].z & 0xffffu) * x1[0] + bf2f(qv[i].z >> 16) * x1[1] + bf2f(qv[i].w & 0xffffu) * x1[2] + bf2f(qv[i].w >> 16) * x1[3]; }
                if (a > v0) { v2 = v1; i2 = i1; v1 = v0; i1 = i0; v0 = a; i0 = n; } else if (a > v1) { v2 = v1; i2 = i1; v1 = a; i1 = n; } else if (a > v2) { v2 = a; i2 = n; } }
        }
        const int nsel = j < 3 ? j : 3;
        unsigned mycnt = 0u;
#pragma unroll 1
        for (int n = 0; n < j; ++n) { const bool sel = (n == i0 && nsel > 0) || (n == i1 && nsel > 1) || (n == i2 && nsel > 2); const unsigned long long mask = __ballot(sel); if (lane == n) mycnt = (unsigned)__popcll(mask); }
        unsigned mybase = 0u;
        if (lane < j && mycnt) mybase = __hip_atomic_fetch_add(CNT + bk * 16 + lane, mycnt, __ATOMIC_RELAXED, __HIP_MEMORY_SCOPE_AGENT);
#pragma unroll 1
        for (int n = 0; n < j; ++n) {
            const int r = (n == i0) ? 0 : ((n == i1) ? 1 : ((n == i2) ? 2 : 3));
            const bool sel = r < nsel;
            const unsigned long long mask = __ballot(sel);
            if (mask == 0ull) continue;
            const unsigned base = (unsigned)__shfl((int)mybase, n);
            const unsigned pos = base + (unsigned)__popcll(mask & ((1ull << lane) - 1ull));
            if (sel) LIST[(size_t)(bk * 16 + n) * 16384 + pos] = ((unsigned)t << 4) | ((unsigned)hg << 2) | (unsigned)r;
        }
    }
    __syncthreads();
}
__device__ __forceinline__ void swa_select_phase(const Frame& F, const Ptrs& P, int l, int lq) {
    unsigned* qctr = (unsigned*)(P.ws + WS_CTL) + CW_SWAQ + lq;
    volatile LAS unsigned* jobw = (volatile LAS unsigned*)(F.lds + MISC_OFF + 64);
    for (;;) {
        __syncthreads();
        if (F.tid == 0) *jobw = __hip_atomic_fetch_add(qctr, 1u, __ATOMIC_RELAXED, __HIP_MEMORY_SCOPE_AGENT);
        __syncthreads();
        const int job = (int)*jobw;
        if (job >= 512) break;
        if (job < 256) swa_unit(F, P, l, job); else select_unit(F, P, lq, job - 256);
    }
}
__device__ __forceinline__ void store_o(const St& st, bf16* op, float rl, int hi) {
#pragma unroll
    for (int g = 0; g < 4; ++g) { u32x2 a, b;
        a.x = cvtpk(st.o0[4 * g] * rl, st.o0[4 * g + 1] * rl); a.y = cvtpk(st.o0[4 * g + 2] * rl, st.o0[4 * g + 3] * rl);
        b.x = cvtpk(st.o1[4 * g] * rl, st.o1[4 * g + 1] * rl); b.y = cvtpk(st.o1[4 * g + 2] * rl, st.o1[4 * g + 3] * rl);
        *(u32x2*)(op + 8 * g + 4 * hi) = a; *(u32x2*)(op + 32 + 8 * g + 4 * hi) = b; }
}
__device__ __forceinline__ void moba_gather(const Frame& F, const Ptrs& P, int l) {
    const bf16* QM = (const bf16*)(P.ws + WS_QM); const bf16* KM = (const bf16*)(P.ws + WS_KM); const bf16* VMT = (const bf16*)(P.ws + WS_VMT);
    const unsigned* LIST = (const unsigned*)(P.ws + WS_LIST); unsigned* CNT = (unsigned*)(P.ws + WS_CTL) + CW_CNT + l * 128;
    bf16* PART = (bf16*)(P.ws + WS_PART); float* LSE = (float*)(P.ws + WS_LSE);
    const int lane = F.lane, r32 = lane & 31, hi = lane >> 5, w = F.wave;
    const int per = F.G >> 3;
    const int bk = F.vcu / per, loc = F.vcu % per;
    if (bk >= 8 || (F.vcu & 15) == 0) return;
    const int wg = loc - 1 - (loc > 16 ? 1 : 0), nwg = per - 2;
    const int b = bk >> 1, kvh = bk & 1;
    unsigned cnt = 0u;
    if (lane < 16) cnt = __hip_atomic_load(CNT + bk * 16 + lane, __ATOMIC_RELAXED, __HIP_MEMORY_SCOPE_AGENT);
    const int ns_l = (int)((cnt + 255u) >> 8);
    int pre = ns_l;
#pragma unroll
    for (int o = 1; o < 16; o <<= 1) { const int v = __shfl_up(pre, o); if (lane >= o) pre += v; }
    const int total = __shfl(pre, 15);
    const bf16* vt0 = VMT + (long)((b * 2 + kvh) * 64) * S;
    LAS unsigned char* ring = F.lds + RING_OFF;
    LaneOff lo; lane_off(lo, r32, hi);
    __syncthreads();
    int item = wg, n = 0, sub = 0;
    if (item < total) { const unsigned long long le = __ballot(lane < 16 && pre <= item); n = (int)__popcll(le); sub = item - ((n == 0) ? 0 : __shfl(pre, n - 1));
        img_load(F, ring, KM, (long)b * S + n * 256, kvh, vt0, n * 256); }
    int buf = 0;
#pragma unroll 1
    for (; item < total; item += nwg) {
        const int cn = (int)__shfl((int)cnt, n);
        const int ti = sub * 8 + w, idx = ti * 32 + r32; const bool tile_ok = ti * 32 < cn, valid = idx < cn;
        unsigned e = 0u; if (tile_ok) e = LIST[(size_t)(bk * 16 + n) * 16384 + (valid ? idx : ti * 32)];
        const int t = (int)(e >> 4), hg = (int)((e >> 2) & 3u), r = (int)(e & 3u), h = kvh * 4 + hg;
        const size_t row = (size_t)(b * S + t);
        bf16x8 qr[4]; loadq(qr, QM + row * 512 + h * 64 + 8 * hi);
        asm volatile("s_waitcnt vmcnt(0)" ::: "memory"); __syncthreads();
        const int cur_n = n; const LAS unsigned char* img = ring + buf * IMG_BYTES;
        const int nitem = item + nwg;
        if (nitem < total) { const unsigned long long le = __ballot(lane < 16 && pre <= nitem); n = (int)__popcll(le); sub = nitem - ((n == 0) ? 0 : __shfl(pre, n - 1));
            img_load(F, ring + (buf ^ 1) * IMG_BYTES, KM, (long)b * S + n * 256, kvh, vt0, n * 256); }
        buf ^= 1;
        if (tile_ok) {
            const float sl2 = moba_sl2(h);
            St st; st.o0 = f32x16{}; st.o1 = f32x16{}; st.m = -INFINITY; st.l = 0.f;
            const int kq = cur_n * 256 - t;
#pragma unroll 1
            for (int i = 0; i < 4; ++i) tile_lds<0, false, true>(st, qr, img, lo, 64 * i, kq + 64 * i, sl2, true, 0, hi, r32);
            const float lt = st.l + __shfl_xor(st.l, 32);
            if (valid) { const size_t slot = ((size_t)((b * 8 + h) * 3 + r)) * S + t;
                store_o(st, PART + slot * 64, __builtin_amdgcn_rcpf(lt), hi); if (hi == 0) LSE[slot] = st.m + __builtin_amdgcn_logf(lt); }
        }
    }
    asm volatile("s_waitcnt vmcnt(0)" ::: "memory"); __syncthreads();
}
__device__ __forceinline__ void moba_own(const Frame& F, const Ptrs& P, int lq, bool nofull = false, bool nocomb = false) {
    bf16* QM = (bf16*)(P.ws + WS_QM); const bf16* KM = (const bf16*)(P.ws + WS_KM); const bf16* VMT = (const bf16*)(P.ws + WS_VMT);
    const bf16* PART = (const bf16*)(P.ws + WS_PART); const float* LSE = (const float*)(P.ws + WS_LSE);
    unsigned* qctr = (unsigned*)(P.ws + WS_CTL) + CW_OWNQ + lq;
    const int lane = F.lane, r32 = lane & 31, hi = lane >> 5, w = F.wave;
    LAS unsigned char* img = F.lds + RING_OFF;
    volatile LAS unsigned* jobw = (volatile LAS unsigned*)(F.lds + MISC_OFF + 64);
    LaneOff lo; lane_off(lo, r32, hi);
    for (;;) {
        __syncthreads();
        if (F.tid == 0) *jobw = __hip_atomic_fetch_add(qctr, 1u, __ATOMIC_RELAXED, __HIP_MEMORY_SCOPE_AGENT);
        __syncthreads();
        const int sjob = (int)*jobw;
        if (sjob >= 256) break;
        const int bk = sjob >> 5, j = 15 - ((sjob & 31) >> 1), hp = sjob & 1, b = bk >> 1, kvh = bk & 1;
        img_load(F, img, KM, (long)b * S + j * 256, kvh, VMT + (long)((b * 2 + kvh) * 64) * S, j * 256);
        asm volatile("s_waitcnt vmcnt(0)" ::: "memory"); __syncthreads();
        const int nsel = j < 3 ? j : 3;
        bf16x8 qn[4];
        { const int qs0 = w; loadq(qn, QM + (size_t)(b * S + j * 256 + qs0 * 32 + r32) * 512 + (kvh * 4 + 2 * hp) * 64 + 8 * hi); }
#pragma unroll 1
        for (int k = 0; k < 2; ++k) {
            const int hg = 2 * hp + k, qs = (k & 1) ? 7 - w : w, qo = qs * 32, h = kvh * 4 + hg;
            const float sl2 = moba_sl2(h);
            const int t0 = j * 256 + qo, q = t0 + r32;
            const size_t row = (size_t)(b * S + q);
            bf16* qrow = QM + row * 512 + h * 64;
            bf16x8 qr[4];
#pragma unroll
            for (int i = 0; i < 4; ++i) qr[i] = qn[i];
            if (k < 1) { const int qs1 = 7 - w; loadq(qn, QM + (size_t)(b * S + j * 256 + qs1 * 32 + r32) * 512 + (kvh * 4 + 2 * hp + 1) * 64 + 8 * hi); }
            St st; st.o0 = f32x16{}; st.o1 = f32x16{}; st.m = -INFINITY; st.l = 0.f;
            const int nfull = nofull ? 0 : (qo >> 6);
#pragma unroll 1
            for (int i = 0; i < nfull; ++i) tile_lds<0, false, true>(st, qr, img, lo, 64 * i, 64 * i - qo - r32, sl2, true, 0, hi, r32);
            if (qo & 32) tile_lds<2, false, true>(st, qr, img, lo, qo - 32, -32 - r32, sl2, true, 0, hi, r32);
            else tile_lds<2, true, true>(st, qr, img, lo, qo, -r32, sl2, true, 0, hi, r32);
            const float lt = st.l + __shfl_xor(st.l, 32);
            const float lse_own = st.m + __builtin_amdgcn_logf(lt), rl = __builtin_amdgcn_rcpf(lt);
            LAS unsigned char* stg = F.lds + RING_OFF + IMG_BYTES + w * 4736;
#pragma unroll
            for (int g = 0; g < 4; ++g) { u32x2 a2, c2;
                a2.x = cvtpk(st.o0[4 * g] * rl, st.o0[4 * g + 1] * rl); a2.y = cvtpk(st.o0[4 * g + 2] * rl, st.o0[4 * g + 3] * rl);
                c2.x = cvtpk(st.o1[4 * g] * rl, st.o1[4 * g + 1] * rl); c2.y = cvtpk(st.o1[4 * g + 2] * rl, st.o1[4 * g + 3] * rl);
                *(LAS u32x2*)(stg + r32 * 144 + (8 * g + 4 * hi) * 2) = a2; *(LAS u32x2*)(stg + r32 * 144 + (32 + 8 * g + 4 * hi) * 2) = c2; }
            if (hi == 0) *(LAS float*)(stg + 4608 + r32 * 4) = lse_own;
            LDS_WAIT(); asm volatile("" ::: "memory");
            if (nocomb) continue;
#pragma unroll
            for (int i = 0; i < 4; ++i) {
                const int rw = i * 8 + (lane >> 3), ch = lane & 7;
                const size_t grow = (size_t)(b * S + t0 + rw), sl0 = ((size_t)((b * 8 + h) * 3)) * S + t0 + rw;
                const u32x4 own = *(const LAS u32x4*)(stg + rw * 144 + ch * 16); const float lo_ = *(const LAS float*)(stg + 4608 + rw * 4);
                float ls[3]; u32x4 pr[3];
#pragma unroll
                for (int r = 0; r < 3; ++r) { ls[r] = -INFINITY; pr[r] = (u32x4){0u, 0u, 0u, 0u}; if (r < nsel) { ls[r] = LSE[sl0 + (size_t)r * S]; pr[r] = *(const u32x4*)(PART + (sl0 + (size_t)r * S) * 64 + ch * 8); } }
                float M = lo_;
#pragma unroll
                for (int r = 0; r < 3; ++r) M = fmaxf(M, ls[r]);
                const float w0 = __builtin_amdgcn_exp2f(lo_ - M); float W = w0;
                float acc8[8];
                acc8[0] = w0 * bf2f(own.x & 0xffffu); acc8[1] = w0 * bf2f(own.x >> 16); acc8[2] = w0 * bf2f(own.y & 0xffffu); acc8[3] = w0 * bf2f(own.y >> 16);
                acc8[4] = w0 * bf2f(own.z & 0xffffu); acc8[5] = w0 * bf2f(own.z >> 16); acc8[6] = w0 * bf2f(own.w & 0xffffu); acc8[7] = w0 * bf2f(own.w >> 16);
#pragma unroll
                for (int r = 0; r < 3; ++r) { const float wr_ = __builtin_amdgcn_exp2f(ls[r] - M); W += wr_;
                    acc8[0] += wr_ * bf2f(pr[r].x & 0xffffu); acc8[1] += wr_ * bf2f(pr[r].x >> 16); acc8[2] += wr_ * bf2f(pr[r].y & 0xffffu); acc8[3] += wr_ * bf2f(pr[r].y >> 16);
                    acc8[4] += wr_ * bf2f(pr[r].z & 0xffffu); acc8[5] += wr_ * bf2f(pr[r].z >> 16); acc8[6] += wr_ * bf2f(pr[r].w & 0xffffu); acc8[7] += wr_ * bf2f(pr[r].w >> 16); }
                const float rW = __builtin_amdgcn_rcpf(W);
                u32x4 o; o.x = cvtpk(acc8[0] * rW, acc8[1] * rW); o.y = cvtpk(acc8[2] * rW, acc8[3] * rW); o.z = cvtpk(acc8[4] * rW, acc8[5] * rW); o.w = cvtpk(acc8[6] * rW, acc8[7] * rW);
                *(u32x4*)(QM + grow * 512 + h * 64 + ch * 8) = o;
            }
            LDS_WAIT(); asm volatile("" ::: "memory");
        }
    }
}
}
#ifndef BENCH_HOT
#define BENCH_HOT 0
#endif
#ifndef ALIGN_BIG
#define ALIGN_BIG true
#endif
#ifndef BENCH_NOEPI
#define BENCH_NOEPI 0
#endif
#ifndef BENCH_AGLU
#define BENCH_AGLU 0
#endif
#ifndef BENCH_KGLU
#define BENCH_KGLU 0
#endif
#ifndef PH_MASK
#define PH_MASK 0xFFF
#endif
#define PH_ON(k) (((PH_MASK) >> (k)) & 1)
constexpr int NPH = 10, PH_FINAL = DEPTH * NPH, PH_TOTAL = PH_FINAL + 1;
struct Args { Ptrs P; int ph_lo, ph_hi, use_bar, sub; };
__global__ void __launch_bounds__(NWAVES * 64, 2) mk_fwd(Args args) {
    extern __shared__ __attribute__((aligned(16))) unsigned char lds[];
    Frame F;
    F.lds = (LAS unsigned char*)lds;
    F.tid = threadIdx.x; F.lane = F.tid & 63; F.wave = __builtin_amdgcn_readfirstlane(F.tid >> 6);
    F.G = gridDim.x; { const int bx = blockIdx.x; F.vcu = (F.G % 8 == 0) ? (bx % 8) * (F.G / 8) + bx / 8 : bx; }
    const Ptrs& P = args.P;
    unsigned char* ws0 = P.ws;
    volatile LAS unsigned* MISC = (volatile LAS unsigned*)(F.lds + MISC_OFF);
    for (int u = F.tid; u < (LDS_BYTES - LDSCTL_OFF) / 4; u += NWAVES * 64) ((LAS unsigned*)(F.lds + LDSCTL_OFF))[u] = 0u;
    __syncthreads();
    XcdBarrier bar; bar.bar = (unsigned*)(ws0 + WS_CTL) + CW_BAR; bar.x = 0; bar.st = nullptr;
    if (args.use_bar) bar = xcd_barrier_post((unsigned*)(ws0 + WS_CTL) + CW_BAR, MISC + 8);
    LAS unsigned char* ring = F.lds + RING_OFF;
    for (int ph = args.ph_lo; ph < args.ph_hi; ++ph) {
#if defined(BENCH_SET)
        const bool bench = ph >= PH_TOTAL; const int l = bench ? DEPTH - 1 : ph / NPH, k = bench ? (ph - PH_TOTAL) % NPH : ph % NPH;
        if (bench && !(((BENCH_SET) >> k) & 1)) continue;
#if defined(BENCH_EMPTY)
        if (bench) { if (ph + 1 < args.ph_hi) xcd_barrier(bar); continue; }
#endif
        const int lc = bench ? DEPTH + (ph - PH_TOTAL) / NPH : l;
#else
        const bool bench = false; const int l = ph / NPH, k = ph % NPH; const int lc = l;
#endif
        unsigned char* ws = ws0; asm volatile("" : "+s"(ws));
        F.tid = threadIdx.x; asm volatile("" : "+v"(F.tid)); F.lane = F.tid & 63;
        int bx = (int)blockIdx.x; asm volatile("" : "+s"(bx));
        if (ph == PH_FINAL && !bench) { if (PH_ON(10)) final_pass(F, P);
        }
        else if (k == 0 && PH_ON(0)) { conv_layer(F, P, l); ssm_mats(F, P, l); if (l == 0) xb_pass(F, P); __syncthreads(); }
        else if (k == 1 && PH_ON(1)) {
            pg8::SrcStd g{(const char*)(ws + WS_XN), (const char*)(ws + WS_WIN), DM, 0}; pg8::StaticOrder So; So.init(T, DIN, F.G, bx);
            pg8::Unit u0; So.next(0, u0); pg8::rinv_build((LAS float*)(F.lds + RINV_OFF), (const float*)(ws + WS_SSQ), u0.pm);
            pg8::EpiInProj E{ws, pg8::RinvTab{(const LAS float*)(F.lds + RINV_OFF)}, (bench && BENCH_NOEPI) ? 1 : 0};
            pg8::gemm_phase<pg8::EpiInProj, pg8::SrcStd, pg8::StaticOrder, ALIGN_BIG>(ring, g, So, E);
        }
        else if (k == 2 && PH_ON(2)) {
            if (args.sub & 1) { pg8::SrcSsm<false> g{(const char*)(ws + WS_U), nullptr, (const char*)(ws + WS_SEND)}; pg8::SsmOrder So{F.G, bx}; pg8::EpiSsmEnd E{(float*)(ws + WS_HEND)};
                pg8::gemm_phase<pg8::EpiSsmEnd, pg8::SrcSsm<false>, pg8::SsmOrder, true>(ring, g, So, E); }
            if (args.sub & 2) att::swa_select_phase(F, P, l, lc);
        }
        else if (k == 3 && PH_ON(3)) {
#ifndef NO_CARRY
            if (args.sub & 1) ssm_carry(F, P, l);
#endif
#ifndef NO_MOBA
            if (args.sub & 2) att::moba_gather(F, P, lc);
#endif
        }
        else if (k == 4 && PH_ON(4)) {
            pg8::SrcSsm<true> g{(const char*)(ws + WS_U), (const char*)(ws + WS_HINIT), (const char*)(ws + WS_SMAIN)}; pg8::SsmOrder So{F.G, bx}; pg8::EpiSsmMain E{(bf16*)(ws + WS_YS)};
#ifdef BENCH_NO_SSMMAIN
            if (!bench)
#endif
            pg8::gemm_phase<pg8::EpiSsmMain, pg8::SrcSsm<true>, pg8::SsmOrder, true>(ring, g, So, E);
#ifdef BENCH_NO_OWN
            if (!bench)
#endif
#if defined(BENCH_OWN_NOFULL)
            att::moba_own(F, P, lc, bench && (BENCH_OWN_NOFULL & 1), bench && (BENCH_OWN_NOFULL & 2));
#else
            att::moba_own(F, P, lc);
#endif
        }
        else if (k == 5 && PH_ON(5)) {
            pg8::SrcStd g{(const char*)(ws + ((bench && BENCH_AGLU) ? WS_MIXED : WS_YS)), (const char*)(ws + WS_WGLU), (bench && BENCH_KGLU) ? BENCH_KGLU : 512, 0}; pg8::StaticOrder So; So.init(T, 1024, F.G, bx); pg8::EpiGlu E{(bf16*)(ws + WS_A1)};
            pg8::gemm_phase<pg8::EpiGlu, pg8::SrcStd, pg8::StaticOrder, true>(ring, g, So, E);
        }
        else if (k == 6 && PH_ON(6)) {
            pg8::SrcMerge g{(const char*)(ws + WS_QA), (const char*)(ws + WS_A1), (const char*)(ws + WS_QM), (const char*)(ws + WS_WMRG)}; pg8::StaticOrder So; So.init(T, DM, F.G, bx);
            pg8::EpiMerge E{(const bf16*)(ws + WS_GATES), (bf16*)(ws + WS_MIXED)};
            pg8::gemm_phase<pg8::EpiMerge, pg8::SrcMerge, pg8::StaticOrder, true>(ring, g, So, E);
        }
        else if ((k == 7 || k == 9) && PH_ON(7)) {
            const bool f2 = (k == 9);
            pg8::SrcStd g{(const char*)(ws + (f2 ? WS_H1 : WS_MIXED)), (const char*)(ws + (f2 ? WS_WFF2 : WS_WOUT)), f2 ? DFF : DM, 0}; pg8::StaticOrder So; So.init(T, DM, F.G, bx); float* xd = bench ? (float*)(ws + WS_QA) : P.x;
            pg8::EpiResid E{(!bench && l == 0 && !f2) ? P.x_in : (const float*)xd, xd, (bf16*)(ws + (bench ? WS_KM : WS_XN)), (float*)(ws + WS_SSQ)};
            pg8::gemm_phase<pg8::EpiResid, pg8::SrcStd, pg8::StaticOrder, true>(ring, g, So, E);
        }
        else if (k == 8 && PH_ON(8)) {
            pg8::SrcStd g{(const char*)(ws + WS_XN), (const char*)(ws + WS_WFF1), DM, (bench && BENCH_HOT) ? 1 : 0}; pg8::StaticOrder So; So.init(T, DFF, F.G, bx);
            pg8::Unit u0; So.next(0, u0); pg8::rinv_build((LAS float*)(F.lds + RINV_OFF), (const float*)(ws + WS_SSQ), u0.pm);
            pg8::EpiFfn1 E{(bf16*)(ws + WS_H1), pg8::RinvTab{(const LAS float*)(F.lds + RINV_OFF)}, (bench && BENCH_NOEPI) ? 1 : 0};
            pg8::gemm_phase<pg8::EpiFfn1, pg8::SrcStd, pg8::StaticOrder, ALIGN_BIG>(ring, g, So, E);
        }
        if (ph + 1 < args.ph_hi) { if (args.use_bar) xcd_barrier(bar); else __syncthreads(); }
    }
}
extern "C" void kernel_launch(void* const* d_in, const int* in_sizes, int n_in, void* d_out, int out_size, void* d_ws, size_t ws_size, hipStream_t stream) {
    static int grid = 0;
    if (grid == 0) {
        if (n_in != 21 || out_size != T * DM || ws_size < WS_END) { fprintf(stderr, "kernel_launch: unexpected shapes (n_in %d out %d ws %zu)\n", n_in, out_size, ws_size); grid = -1; return; }
        int dev = 0, cus = 0;
        if (hipGetDevice(&dev) != hipSuccess || hipDeviceGetAttribute(&cus, hipDeviceAttributeMultiprocessorCount, dev) != hipSuccess) { grid = -1; return; }
        if (hipFuncSetAttribute((const void*)mk_fwd, hipFuncAttributeMaxDynamicSharedMemorySize, LDS_BYTES) != hipSuccess) { fprintf(stderr, "kernel_launch: hipFuncSetAttribute failed\n"); grid = -1; return; }
        int per_cu = 0;
        if (hipOccupancyMaxActiveBlocksPerMultiprocessor(&per_cu, (const void*)mk_fwd, NWAVES * 64, LDS_BYTES) != hipSuccess || per_cu < 1) { fprintf(stderr, "kernel_launch: occupancy query reports %d workgroups per CU\n", per_cu); (void)hipGetLastError(); }
        grid = cus;
        if (grid != 256) { fprintf(stderr, "kernel_launch: built for a 256-CU device (unit dealing assumes 256 workgroups); found %d CUs; nothing launched\n", cus); grid = -1; return; }
    }
    if (grid < 0) return;
    (void)hipMemsetAsync((char*)d_ws + WS_CTL, 0, CTL_ZERO_BYTES, stream);
    Args a{};
    const float** pp = (const float**)&a.P; for (int i = 0; i < 21; ++i) pp[i] = (const float*)d_in[i];
    a.P.x = (float*)d_out; a.P.ws = (unsigned char*)d_ws;
    #if defined(BENCH_SET)
    a.ph_lo = 0; a.ph_hi = PH_TOTAL + NPH * (BENCH_REPS);
#else
    a.ph_lo = 0; a.ph_hi = PH_TOTAL;
#endif
    a.use_bar = 1; a.sub = 3;
    hipLaunchKernelGGL(mk_fwd, dim3(grid), dim3(NWAVES * 64), LDS_BYTES, stream, a);
}
```

```cpp
#include <hip/hip_runtime.h>
#include <cstdio>
#include <cstdint>

constexpr int NB = 4, S = 4096, T = NB * S, DM = 1024, DEPTH = 4, DIN = 5120, DFF = 4096;
constexpr float LOG2E = 1.4426950408889634f;
constexpr float C2 = 0.125f * LOG2E;
constexpr float NORM_EPS = 1e-6f;
constexpr int SSM_L = 16;
constexpr int SSM_KM = SSM_L * 16 + 128;
constexpr int SSM_KE = SSM_L * 16;
constexpr int NCH = T / SSM_L;

constexpr size_t MiB = 1u << 20;
constexpr size_t WS_CTL = 0, CTL_ZERO_BYTES = 1 * MiB;
constexpr size_t WS_WIN = 1 * MiB, WS_WGLU = 11 * MiB, WS_WMRG = 12 * MiB, WS_WOUT = 15 * MiB, WS_WFF1 = 17 * MiB, WS_WFF2 = 25 * MiB;
constexpr size_t WS_SMAIN = 33 * MiB, WS_SEND = 39 * MiB, WS_KMP = 43 * MiB;
constexpr size_t WS_XN = 44 * MiB;
constexpr size_t WS_QA = 76 * MiB, WS_KA = 92 * MiB, WS_VAT = 96 * MiB, WS_U = 100 * MiB, WS_QM = 116 * MiB, WS_KM = 132 * MiB, WS_VMT = 136 * MiB, WS_GATES = 140 * MiB;
constexpr size_t WS_H1 = 76 * MiB;
constexpr size_t WS_LIST = WS_XN, WS_LSE = WS_XN + 8 * MiB;
constexpr size_t WS_YS = 284 * MiB;
constexpr size_t WS_PART = 236 * MiB;
constexpr size_t WS_A1 = 236 * MiB, WS_MIXED = 252 * MiB, WS_HEND = 284 * MiB, WS_HINIT = 300 * MiB, WS_SSQ = 308 * MiB, WS_END = 309 * MiB;

typedef unsigned short bf16;
typedef short bf16x8 __attribute__((ext_vector_type(8)));
typedef short s16x4 __attribute__((ext_vector_type(4)));
typedef float f32x4 __attribute__((ext_vector_type(4)));
typedef float f32x16 __attribute__((ext_vector_type(16)));
typedef unsigned u32x4 __attribute__((ext_vector_type(4)));
typedef unsigned u32x2 __attribute__((ext_vector_type(2)));

__host__ __device__ __forceinline__ unsigned f2bf(float f) { unsigned u = __builtin_bit_cast(unsigned, f); return (u + 0x7fffu + ((u >> 16) & 1u)) >> 16; }
__host__ __device__ __forceinline__ float bf2f(unsigned b) { return __builtin_bit_cast(float, b << 16); }
typedef float f32x2_t __attribute__((ext_vector_type(2))); typedef __bf16 bf16x2_t __attribute__((ext_vector_type(2)));
__device__ __forceinline__ unsigned cvtpk_s(float lo, float hi) { f32x2_t v = {lo, hi}; bf16x2_t b = __builtin_convertvector(v, bf16x2_t); return __builtin_bit_cast(unsigned, b); }
__device__ __forceinline__ unsigned pk2(float lo, float hi) { return f2bf(lo) | (f2bf(hi) << 16); }
__device__ __forceinline__ float rbf(float f) { return bf2f(f2bf(f)); }
__device__ __forceinline__ float sigmoid_fast(float x) { return __builtin_amdgcn_rcpf(1.f + __builtin_amdgcn_exp2f(-x * LOG2E)); }
__device__ __forceinline__ float gelu_tanh(float x) {
    const float c2 = 2.f * 0.7978845608028654f; const float t = c2 * (x + 0.044715f * x * x * x); return x * sigmoid_fast(t); }
__device__ __forceinline__ float wave_sum(float v) {
#pragma unroll
    for (int o = 1; o < 64; o <<= 1) v += __shfl_xor(v, o);
    return v;
}
__device__ __forceinline__ float wave_max(float v) {
#pragma unroll
    for (int o = 1; o < 64; o <<= 1) v = fmaxf(v, __shfl_xor(v, o));
    return v;
}

struct Ptrs {
    const float *x_in, *norm_mix, *w_in, *sinks, *lam_re, *lam_im, *log_step, *b_re, *b_im, *c_re, *c_im, *d_skip, *w_glu, *w_o_swa, *w_o_ssm, *w_o_moba, *w_out, *norm_ffn, *w_ff1, *w_ff2, *norm_final;
    float* x;
    unsigned char* ws;
};
namespace pg8 {
#define PG8_LAS __attribute__((address_space(3)))
constexpr int BM = 256, BK = 64, HALF = 128, HTB = HALF * BK * 2  , STAGE_BYTES = 8 * HTB, NXCD = 8, WGM = 8;

__host__ __device__ __forceinline__ int lds_byte(int r, int c) { const int st = (r >> 4) * 2 + (c >> 5), rr = r & 15, cc = c & 31, ob = rr * 64 + cc * 2; return st * 1024 + (ob ^ (((ob >> 9) & 1) << 5)); }
__host__ __device__ __forceinline__ void stage_rc(int b, int& R, int& C) { const int st = b / 1024, sb = b % 1024, swz = sb ^ (((sb >> 9) & 1) << 5); R = (st >> 1) * 16 + swz / 64; C = (st & 1) * 32 + (swz % 64) / 2; }
__host__ __device__ __forceinline__ int perm32(int rho) { const int n = rho >> 4, i = rho & 15; return 8 * (i >> 2) + 4 * n + (i & 3); }

struct Unit { int pm, pn; };

struct StaticOrder {
    int nM, nN, nwg, G, c;
    __host__ __device__ void init(int M, int N, int G_, int c_) { nM = M / BM; nN = N / BM; nwg = nM * nN; G = G_; c = c_; }
    __host__ __device__ bool next(int i, Unit& u) const {
        const long L = (long)i * G + c; if (L >= nwg) return false;
        int wgid = (int)L; { const int q = nwg / NXCD, r = nwg % NXCD, xcd = wgid % NXCD, off = wgid / NXCD; wgid = (xcd < r ? xcd * (q + 1) : r * (q + 1) + (xcd - r) * q) + off; }
        const int nig = WGM * nN, gid = wgid / nig, fm = gid * WGM, gsz = (nM - fm) < WGM ? (nM - fm) : WGM;
        u.pm = fm + ((wgid % nig) % gsz); u.pn = (wgid % nig) / gsz; return true;
    }
};
struct SsmOrder {
    int G, c;
    __host__ __device__ bool next(int i, Unit& u) const { const int L = i * G + c; if (L >= 128) return false; u.pn = L >> 2; u.pm = L & 3; return true; }
};

struct SrcStd {
    static constexpr bool TWO_VAR = false;
    const char* A; const char* Bt; int K; int hot;
    __device__ __forceinline__ int nt() const { return K / BK; }
    __device__ __forceinline__ const char* a(const Unit& u, int kt, int h) const { return A + ((size_t)((hot ? 0 : u.pm) * BM + h * HALF) * K + (size_t)kt * BK) * 2; }
    __device__ __forceinline__ const char* b(const Unit& u, int kt, int h) const { return Bt + ((size_t)((hot ? 0 : u.pn) * BM + h * HALF) * K + (size_t)kt * BK) * 2; }
    __device__ __forceinline__ unsigned voffA(int R, int C, int) const { return (unsigned)(R * K + C) * 2u; }
    __device__ __forceinline__ unsigned voffB(int R, int C) const { return (unsigned)(R * K + C) * 2u; }
    __device__ __forceinline__ int avar(int) const { return 0; }
};
struct SrcMerge {
    static constexpr bool TWO_VAR = false;
    const char* A0; const char* A1; const char* A2; const char* Bt;
    __device__ __forceinline__ int nt() const { return 24; }
    __device__ __forceinline__ const char* a(const Unit& u, int kt, int h) const { const int sg = kt >> 3; const char* p = sg == 0 ? A0 : (sg == 1 ? A1 : A2); return p + ((size_t)(u.pm * BM + h * HALF) * 512 + (size_t)(kt & 7) * BK) * 2; }
    __device__ __forceinline__ const char* b(const Unit& u, int kt, int h) const { return Bt + ((size_t)(u.pn * BM + h * HALF) * 1536 + (size_t)kt * BK) * 2; }
    __device__ __forceinline__ unsigned voffA(int R, int C, int) const { return (unsigned)(R * 512 + C) * 2u; }
    __device__ __forceinline__ unsigned voffB(int R, int C) const { return (unsigned)(R * 1536 + C) * 2u; }
    __device__ __forceinline__ int avar(int) const { return 0; }
};
template <bool MAIN> struct SrcSsm {
    static constexpr bool TWO_VAR = MAIN; static constexpr int KTOT = MAIN ? SSM_KM : SSM_KE;
    const char* U; const char* HI; const char* Bt;
    __device__ __forceinline__ int nt() const { return KTOT / BK; }
    __device__ __forceinline__ const char* a(const Unit& u, int kt, int h) const {
        if (!MAIN || kt < 4) return U + ((size_t)(u.pn * NCH + u.pm * BM + h * HALF) * 256 + (size_t)kt * BK) * 2;
        return HI + ((size_t)(u.pn * NCH + u.pm * BM + h * HALF) * 128 + (size_t)(kt - 4) * BK) * 2; }
    __device__ __forceinline__ const char* b(const Unit& u, int kt, int h) const { return Bt + ((size_t)(u.pn * 256 + h * HALF) * KTOT + (size_t)kt * BK) * 2; }
    __device__ __forceinline__ unsigned voffA(int R, int C, int var) const { return var ? (unsigned)(R * 128 + C) * 2u : (unsigned)(R * 256 + C) * 2u; }
    __device__ __forceinline__ unsigned voffB(int R, int C) const { return (unsigned)(R * KTOT + C) * 2u; }
    __device__ __forceinline__ int avar(int kt) const { return (MAIN && kt >= 4) ? 1 : 0; }
};

typedef f32x4 Acc[2][2][4][2];
__device__ __forceinline__ unsigned cvt_pk_bf16(float lo, float hi) { return cvtpk_s(lo, hi); }
__device__ __forceinline__ u32x4 pack8(f32x4 v0, f32x4 v1) { u32x4 w; w.x = cvt_pk_bf16(v0[0], v0[1]); w.y = cvt_pk_bf16(v0[2], v0[3]); w.z = cvt_pk_bf16(v1[0], v1[1]); w.w = cvt_pk_bf16(v1[2], v1[3]); return w; }
__device__ __forceinline__ f32x4 sig4(f32x4 v) { f32x4 o; o[0] = sigmoid_fast(v[0]); o[1] = sigmoid_fast(v[1]); o[2] = sigmoid_fast(v[2]); o[3] = sigmoid_fast(v[3]); return o; }
__device__ __forceinline__ f32x4 unpk_lo(u32x4 w) { f32x4 o; o[0] = bf2f(w.x & 0xffffu); o[1] = bf2f(w.x >> 16); o[2] = bf2f(w.y & 0xffffu); o[3] = bf2f(w.y >> 16); return o; }
__device__ __forceinline__ f32x4 unpk_hi(u32x4 w) { f32x4 o; o[0] = bf2f(w.z & 0xffffu); o[1] = bf2f(w.z >> 16); o[2] = bf2f(w.w & 0xffffu); o[3] = bf2f(w.w >> 16); return o; }
__device__ __forceinline__ f32x4 rcp4(f32x4 v) { f32x4 o; o[0] = __builtin_amdgcn_rcpf(v[0]); o[1] = __builtin_amdgcn_rcpf(v[1]); o[2] = __builtin_amdgcn_rcpf(v[2]); o[3] = __builtin_amdgcn_rcpf(v[3]); return o; }

struct RinvTab { const PG8_LAS float* tab; };
__device__ __forceinline__ void rinv_build(PG8_LAS float* tab, const float* SSQ, int pm0) {
    if (threadIdx.x < 256) { const f32x4* sp = (const f32x4*)(SSQ + (size_t)(pm0 * BM + threadIdx.x) * 16); const f32x4 s = (sp[0] + sp[1]) + (sp[2] + sp[3]); tab[threadIdx.x] = rsqrtf(((s[0] + s[1]) + (s[2] + s[3])) * (1.f / DM) + NORM_EPS); }
    __syncthreads();
}
template <int MODE> __device__ __forceinline__ void st_half_bf16(const Acc& acc, int bj, bf16* base, int ldc, float sc, const PG8_LAS float* ri = nullptr  ) {
    bf16* p = base;
#pragma unroll
    for (int ai = 0; ai < 2; ++ai) {
#pragma unroll
        for (int m = 0; m < 4; ++m) { f32x4 v0 = acc[ai][bj][m][0], v1 = acc[ai][bj][m][1];
            if (ri) { const float rs = ri[ai * HALF + m * 16]; v0 = v0 * rs; v1 = v1 * rs; }
            if (MODE == 0) { v0 = v0 * sc; v1 = v1 * sc; }
            else if (MODE == 1) { v0 = sig4(v0); v1 = sig4(v1); }
            else if (MODE == 2) { v0 = __builtin_elementwise_max(v0, (f32x4){0.f, 0.f, 0.f, 0.f}); v1 = __builtin_elementwise_max(v1, (f32x4){0.f, 0.f, 0.f, 0.f}); v0 = v0 * v0; v1 = v1 * v1; }
            else { v0[0] = gelu_tanh(v0[0]); v0[1] = gelu_tanh(v0[1]); v0[2] = gelu_tanh(v0[2]); v0[3] = gelu_tanh(v0[3]); v1[0] = gelu_tanh(v1[0]); v1[1] = gelu_tanh(v1[1]); v1[2] = gelu_tanh(v1[2]); v1[3] = gelu_tanh(v1[3]); }
            *(u32x4*)p = pack8(v0, v1); asm volatile("" : "+v"(p)); p += (size_t)16 * ldc; }
        p += (size_t)(HALF - 64) * ldc; }
}
__device__ __forceinline__ void st_half_vt(const Acc& acc, int bj, bf16* VT, int b, int s0, int cc, const PG8_LAS float* ri) {
    bf16* p = VT + ((size_t)(b * 2 + (cc >> 6)) * 64 + (cc & 63)) * S + s0;
    float rs[2][4];
#pragma unroll
    for (int ai = 0; ai < 2; ++ai)
#pragma unroll
        for (int m = 0; m < 4; ++m) rs[ai][m] = ri[ai * HALF + m * 16];
#pragma unroll
    for (int n = 0; n < 2; ++n)
#pragma unroll
        for (int e = 0; e < 4; ++e) {
#pragma unroll
            for (int ai = 0; ai < 2; ++ai)
#pragma unroll
                for (int m = 0; m < 4; ++m) p[ai * HALF + m * 16] = (bf16)f2bf(acc[ai][bj][m][n][e] * rs[ai][m]);
            asm volatile("" : "+v"(p)); p += S; }
}

struct EpiInProj {
    static constexpr bool PERM = true, AFTER_DRAIN = false, HAS_MID = false;
    unsigned char* ws; RinvTab RT; int skip;
    __device__ __forceinline__ void operator()(const Acc& acc, const Unit& u, int wr, int wc, int fr, int fq) const {
        if (skip) return;
        bf16 *QA = (bf16*)(ws + WS_QA), *KA = (bf16*)(ws + WS_KA), *VAT = (bf16*)(ws + WS_VAT), *U = (bf16*)(ws + WS_U), *QM = (bf16*)(ws + WS_QM), *KM = (bf16*)(ws + WS_KM), *VMT = (bf16*)(ws + WS_VMT), *GATES = (bf16*)(ws + WS_GATES); float* KMP = (float*)(ws + WS_KMP);
        const int row = u.pm * BM + wr * 64 + fr, cc = wc * 32 + 8 * fq;
        const PG8_LAS float* ri = RT.tab + wr * 64 + fr;
#pragma unroll
        for (int bj = 0; bj < 2; ++bj) {
            const int hc = u.pn * 2 + bj;
            if (hc < 4) st_half_bf16<0>(acc, bj, QA + (size_t)row * 512 + hc * 128 + cc, 512, C2, ri);
            else if (hc == 4) st_half_bf16<0>(acc, bj, KA + (size_t)row * 128 + cc, 128, 1.f, ri);
            else if (hc == 5) st_half_vt(acc, bj, VAT, row / S, row % S, cc, ri);
            else if (hc < 10) { const int ucol = (hc - 6) * 128 + cc;
                st_half_bf16<0>(acc, bj, U + ((size_t)(ucol >> 4) * NCH + ((u.pm * BM + wr * 64) >> 4)) * 256 + fr * 16 + (ucol & 15), 16, 1.f, ri); }
            else if (hc < 14) st_half_bf16<0>(acc, bj, QM + (size_t)row * 512 + (hc - 10) * 128 + cc, 512, C2, ri);
            else if (hc == 14) {
                st_half_bf16<0>(acc, bj, KM + (size_t)row * 128 + cc, 128, 1.f, ri);
                f32x4 c0 = {0.f, 0.f, 0.f, 0.f}, c1 = {0.f, 0.f, 0.f, 0.f};
#pragma unroll
                for (int ai = 0; ai < 2; ++ai)
#pragma unroll
                    for (int m = 0; m < 4; ++m) { const float rs = ri[ai * HALF + m * 16]; c0 += acc[ai][bj][m][0] * rs; c1 += acc[ai][bj][m][1] * rs; }
#pragma unroll
                for (int o = 1; o < 16; o <<= 1)
#pragma unroll
                    for (int e = 0; e < 4; ++e) { c0[e] += __shfl_xor(c0[e], o); c1[e] += __shfl_xor(c1[e], o); }
                if (fr == 0) { float* kp = KMP + (size_t)(wr * 64 + u.pm) * 128 + cc; *(f32x4*)kp = c0; *(f32x4*)(kp + 4) = c1; }
            }
            else if (hc == 15) st_half_vt(acc, bj, VMT, row / S, row % S, cc, ri);
            else st_half_bf16<1>(acc, bj, GATES + (size_t)row * 3072 + (hc - 16) * 128 + cc, 3072, 1.f, ri);
        }
    }
};
struct EpiFfn1 {
    static constexpr bool PERM = true, AFTER_DRAIN = false, HAS_MID = false;
    bf16* H1; RinvTab RT; int skip;
    __device__ __forceinline__ void operator()(const Acc& acc, const Unit& u, int wr, int wc, int fr, int fq) const {
        if (skip) return;
        bf16* base = H1 + (size_t)(u.pm * BM + wr * 64 + fr) * DFF + u.pn * BM + wc * 32 + 8 * fq;
        const PG8_LAS float* ri = RT.tab + wr * 64 + fr;
        st_half_bf16<2>(acc, 0, base, DFF, 1.f, ri); st_half_bf16<2>(acc, 1, base + HALF, DFF, 1.f, ri);
    }
};
struct EpiGlu {
    static constexpr bool PERM = true, AFTER_DRAIN = false, HAS_MID = false;
    bf16* A1;
    __device__ __forceinline__ void operator()(const Acc& acc, const Unit& u, int wr, int wc, int fr, int fq) const {
        bf16* base = A1 + (size_t)(u.pm * BM + wr * 64 + fr) * 512 + u.pn * 128 + wc * 32 + 8 * fq;
#pragma unroll
        for (int ai = 0; ai < 2; ++ai)
#pragma unroll
            for (int m = 0; m < 4; ++m) *(u32x4*)(base + (size_t)(ai * HALF + m * 16) * 512) = pack8(acc[ai][0][m][0] * sig4(acc[ai][1][m][0]), acc[ai][0][m][1] * sig4(acc[ai][1][m][1]));
    }
};
struct EpiMerge {
    static constexpr bool PERM = true, AFTER_DRAIN = false, HAS_MID = true;
    const bf16* GATES; bf16* MIXED;
    __device__ __forceinline__ void mid(Acc& acc, const Unit& u, int t, int wr, int wc, int fr, int fq) const {
        if (t != 8 && t != 16) return;
        const bf16* g = GATES + (size_t)(u.pm * BM + wr * 64 + fr) * 3072 + (t == 8 ? 0 : 1024) + u.pn * BM + wc * 32 + 8 * fq;
#pragma unroll
        for (int ai = 0; ai < 2; ++ai)
#pragma unroll
            for (int m = 0; m < 4; ++m)
#pragma unroll
                for (int bj = 0; bj < 2; ++bj) { const bf16* gp = g + (size_t)(ai * HALF + m * 16) * 3072 + bj * HALF; const u32x4 num = *(const u32x4*)gp, den = *(const u32x4*)(gp + 1024);
                    acc[ai][bj][m][0] = acc[ai][bj][m][0] * (unpk_lo(num) * rcp4(unpk_lo(den))); acc[ai][bj][m][1] = acc[ai][bj][m][1] * (unpk_hi(num) * rcp4(unpk_hi(den))); }
    }
    __device__ __forceinline__ void operator()(const Acc& acc, const Unit& u, int wr, int wc, int fr, int fq) const {
        const size_t ro = (size_t)(u.pm * BM + wr * 64 + fr); const int co = u.pn * BM + wc * 32 + 8 * fq;
#pragma unroll
        for (int ai = 0; ai < 2; ++ai)
#pragma unroll
            for (int m = 0; m < 4; ++m)
#pragma unroll
                for (int bj = 0; bj < 2; ++bj) { const size_t r = ro + ai * HALF + m * 16; const u32x4 g2 = *(const u32x4*)(GATES + r * 3072 + 2048 + co + bj * HALF);
                    *(u32x4*)(MIXED + r * DM + co + bj * HALF) = pack8(acc[ai][bj][m][0] * unpk_lo(g2), acc[ai][bj][m][1] * unpk_hi(g2)); }
    }
};
struct EpiResid {
    static constexpr bool PERM = false, AFTER_DRAIN = false, HAS_MID = false;
    const float* XS; float* X; bf16* XB; float* SSQ;
    __device__ __forceinline__ void operator()(const Acc& acc, const Unit& u, int wr, int wc, int fr, int fq) const {
        const size_t row0 = (size_t)(u.pm * BM + wr * 64 + fr); const int col0 = u.pn * BM + wc * 32 + 4 * fq;
#pragma unroll
        for (int ai = 0; ai < 2; ++ai)
#pragma unroll
            for (int m = 0; m < 4; ++m) { const size_t r = row0 + ai * HALF + m * 16; float ss = 0.f;
#pragma unroll
                for (int bj = 0; bj < 2; ++bj)
#pragma unroll
                    for (int n = 0; n < 2; ++n) { const size_t o_ = r * DM + col0 + bj * HALF + n * 16; const f32x4 v = *(const f32x4*)(XS + o_) + acc[ai][bj][m][n]; *(f32x4*)(X + o_) = v;
                        ss += (v[0] * v[0] + v[1] * v[1]) + (v[2] * v[2] + v[3] * v[3]);
                        u32x2 w; w.x = cvt_pk_bf16(v[0], v[1]); w.y = cvt_pk_bf16(v[2], v[3]); *(u32x2*)(XB + r * DM + col0 + bj * HALF + n * 16) = w; }
                ss += __shfl_xor(ss, 16); ss += __shfl_xor(ss, 32);
                if (fq == 0) SSQ[r * 16 + u.pn * 4 + wc] = ss; }
    }
};
struct EpiSsmEnd {
    static constexpr bool PERM = false, AFTER_DRAIN = false, HAS_MID = false;
    float* HEND;
    __device__ __forceinline__ void operator()(const Acc& acc, const Unit& u, int wr, int wc, int fr, int fq) const {
        float* base = HEND + ((size_t)u.pn * NCH + u.pm * BM + wr * 64 + fr) * 128 + wc * 32 + 4 * fq;
#pragma unroll
        for (int ai = 0; ai < 2; ++ai)
#pragma unroll
            for (int m = 0; m < 4; ++m)
#pragma unroll
                for (int n = 0; n < 2; ++n) *(f32x4*)(base + (size_t)(ai * HALF + m * 16) * 128 + n * 16) = acc[ai][0][m][n];
    }
};
struct EpiSsmMain {
    static constexpr bool PERM = true, AFTER_DRAIN = false, HAS_MID = false;
    bf16* YS;
    __device__ __forceinline__ void operator()(const Acc& acc, const Unit& u, int wr, int wc, int fr, int fq) const {
        const int mrow = u.pm * BM + wr * 64 + fr;
#pragma unroll
        for (int bj = 0; bj < 2; ++bj) { const int s = 8 * bj + 2 * wc + (fq >> 1);
            bf16* base = YS + ((size_t)mrow * 16 + s) * 512 + u.pn * 16 + 8 * (fq & 1);
            st_half_bf16<3>(acc, bj, base, 16 * 512, 1.f); }
    }
};

template <class Epi, class Src, class Sched, bool ALIGN_EPI>
__device__ __forceinline__ void gemm_phase(PG8_LAS unsigned char* lds, const Src g, const Sched& S, const Epi& E) {
    int tid_ = threadIdx.x; asm volatile("" : "+v"(tid_));
    const int tid = tid_, wid = __builtin_amdgcn_readfirstlane(tid >> 6), lane = tid & 63, wr = wid >> 2, wc = wid & 3, fr = lane & 15, fq = lane >> 4;
    const int nt = g.nt();
    unsigned voffA[2], voffA2[2], voffB[2];
#pragma unroll
    for (int i = 0; i < 2; ++i) { int R, C; stage_rc(tid * 16 + i * 8192, R, C); const int Rb = Epi::PERM ? ((R & ~31) + perm32(R & 31)) : R;
        voffA[i] = g.voffA(R, C, 0); voffA2[i] = Src::TWO_VAR ? g.voffA(R, C, 1) : 0u; voffB[i] = g.voffB(Rb, C); }
    const unsigned ldsw = (unsigned)wid * 1024u;
    const int aoff = lds_byte(wr * 64 + fr, fq * 8), boff = lds_byte(wc * 32 + fr, fq * 8);
#define PG8_SA(b, h) (((b) * 2 + (h)) * HTB)
#define PG8_SB(b, h) ((4 + (b) * 2 + (h)) * HTB)
#define PG8_STAGE_B(bufoff, gbase) do { _Pragma("unroll") for (int _i = 0; _i < 2; ++_i) \
        __builtin_amdgcn_global_load_lds((const unsigned*)((const char*)(gbase) + voffB[_i]), (PG8_LAS unsigned*)(lds + (bufoff) + ldsw + _i * 8192), 16, 0, 0); } while (0)
#define PG8_STAGE_A(bufoff, gbase, kt) do { const bool _v = Src::TWO_VAR && g.avar(kt); _Pragma("unroll") for (int _i = 0; _i < 2; ++_i) { const unsigned _o = _v ? voffA2[_i] : voffA[_i]; \
        __builtin_amdgcn_global_load_lds((const unsigned*)((const char*)(gbase) + _o), (PG8_LAS unsigned*)(lds + (bufoff) + ldsw + _i * 8192), 16, 0, 0); } } while (0)
#define PG8_LDA(dst, b, h) do { _Pragma("unroll") for (int m = 0; m < 4; ++m) _Pragma("unroll") for (int k = 0; k < 2; ++k) dst[m][k] = *(const PG8_LAS bf16x8*)(lds + PG8_SA(b, h) + aoff + m * 2048 + k * 1024); } while (0)
#define PG8_LDB(dst, b, h) do { _Pragma("unroll") for (int n = 0; n < 2; ++n) _Pragma("unroll") for (int k = 0; k < 2; ++k) dst[n][k] = *(const PG8_LAS bf16x8*)(lds + PG8_SB(b, h) + boff + n * 2048 + k * 1024); } while (0)
#define PG8_MMA(ai, bj, At, Bt) do { __builtin_amdgcn_s_setprio(1); _Pragma("unroll") for (int m = 0; m < 4; ++m) _Pragma("unroll") for (int n = 0; n < 2; ++n) _Pragma("unroll") for (int k = 0; k < 2; ++k) \
        acc[ai][bj][m][n] = __builtin_amdgcn_mfma_f32_16x16x32_bf16(Bt[n][k], At[m][k], acc[ai][bj][m][n], 0, 0, 0); __builtin_amdgcn_s_setprio(0); } while (0)
#define PG8_WAIT_V(n) asm volatile("s_waitcnt vmcnt(" #n ")" ::: "memory")
#define PG8_WAIT_L(n) asm volatile("s_waitcnt lgkmcnt(" #n ")" ::: "memory")
#define PG8_BAR __builtin_amdgcn_s_barrier()
#define PG8_SCHED __builtin_amdgcn_sched_barrier(0)
    Unit cur, nxt; int ui = 0;
    if (!S.next(0, cur)) return;
    Acc acc;
#pragma unroll
    for (int a = 0; a < 2; ++a)
#pragma unroll
        for (int b = 0; b < 2; ++b)
#pragma unroll
            for (int m = 0; m < 4; ++m)
#pragma unroll
                for (int n = 0; n < 2; ++n) acc[a][b][m][n] = (f32x4){0.f, 0.f, 0.f, 0.f};
    bf16x8 At[4][2], B0[2][2], B1[2][2];
    PG8_STAGE_B(PG8_SB(0, 0), g.b(cur, 0, 0)); PG8_STAGE_B(PG8_SB(0, 1), g.b(cur, 0, 1)); PG8_STAGE_A(PG8_SA(0, 0), g.a(cur, 0, 0), 0); PG8_STAGE_A(PG8_SA(0, 1), g.a(cur, 0, 1), 0);
    if (wr == 1) PG8_BAR;
    PG8_WAIT_V(2); PG8_BAR;
    PG8_STAGE_B(PG8_SB(1, 0), g.b(cur, 1, 0)); PG8_STAGE_A(PG8_SA(1, 0), g.a(cur, 1, 0), 1); PG8_STAGE_B(PG8_SB(1, 1), g.b(cur, 1, 1));
    PG8_WAIT_V(6); PG8_BAR;
    for (;;) {
        const bool has_next = S.next(ui + 1, nxt);
        const Unit nu = has_next ? nxt : cur;
        for (int t = 0; t < nt; t += 2) {
            const bool last = (t == nt - 2);
            if constexpr (Epi::HAS_MID) E.mid(acc, cur, t, wr, wc, fr, fq);
            const Unit u2 = last ? nu : cur; const int k2 = last ? 0 : t + 2, k3 = k2 + 1;
            PG8_LDB(B0, 0, 0); PG8_LDB(B1, 0, 1); PG8_SCHED; PG8_LDA(At, 0, 0); PG8_STAGE_A(PG8_SA(1, 1), g.a(cur, t + 1, 1), t + 1);
            PG8_WAIT_V(8); PG8_WAIT_L(0); PG8_BAR; PG8_MMA(0, 0, At, B0); PG8_MMA(0, 1, At, B1); PG8_BAR; PG8_SCHED;
            PG8_LDA(At, 0, 1); PG8_STAGE_B(PG8_SB(0, 0), g.b(u2, k2, 0)); PG8_STAGE_B(PG8_SB(0, 1), g.b(u2, k2, 1)); PG8_STAGE_A(PG8_SA(0, 0), g.a(u2, k2, 0), k2);
            PG8_WAIT_V(8); PG8_WAIT_L(0); PG8_BAR; PG8_MMA(1, 0, At, B0); PG8_MMA(1, 1, At, B1); PG8_BAR; PG8_SCHED;
            PG8_LDB(B0, 1, 0); PG8_LDB(B1, 1, 1); PG8_SCHED; PG8_LDA(At, 1, 0); PG8_STAGE_A(PG8_SA(0, 1), g.a(u2, k2, 1), k2);
            PG8_WAIT_V(8); PG8_WAIT_L(0); PG8_BAR; PG8_MMA(0, 0, At, B0); PG8_MMA(0, 1, At, B1); PG8_BAR; PG8_SCHED;
            PG8_LDA(At, 1, 1); PG8_STAGE_B(PG8_SB(1, 0), g.b(u2, k3, 0)); PG8_STAGE_B(PG8_SB(1, 1), g.b(u2, k3, 1)); PG8_STAGE_A(PG8_SA(1, 0), g.a(u2, k3, 0), k3);
            PG8_WAIT_V(8); PG8_WAIT_L(0); PG8_BAR; PG8_MMA(1, 0, At, B0); PG8_MMA(1, 1, At, B1); PG8_BAR; PG8_SCHED;
        }
        if constexpr (ALIGN_EPI) { if (wr == 0) PG8_BAR; }
        { int fr_ = fr, fq_ = fq; asm volatile("" : "+v"(fr_), "+v"(fq_));
          E(acc, cur, wr, wc, fr_, fq_); }
        if (!has_next) break;
#pragma unroll
        for (int a = 0; a < 2; ++a)
#pragma unroll
            for (int b = 0; b < 2; ++b)
#pragma unroll
                for (int m = 0; m < 4; ++m)
#pragma unroll
                    for (int n = 0; n < 2; ++n) acc[a][b][m][n] = (f32x4){0.f, 0.f, 0.f, 0.f};
        cur = nxt; ++ui;
        if constexpr (ALIGN_EPI) { if (wr == 1) PG8_BAR; }
    }
    PG8_WAIT_V(0);
    if constexpr (!ALIGN_EPI) { if (wr == 0) PG8_BAR; }
    PG8_BAR;
#undef PG8_SA
#undef PG8_SB
#undef PG8_STAGE_A
#undef PG8_STAGE_B
#undef PG8_LDA
#undef PG8_LDB
#undef PG8_MMA
#undef PG8_WAIT_V
#undef PG8_WAIT_L
#undef PG8_BAR
#undef PG8_SCHED
}
}
constexpr int NWAVES = 8;
constexpr int RING_OFF = 0, RING_BYTES = 131072;
constexpr int LDSCTL_OFF = RING_BYTES, MISC_OFF = LDSCTL_OFF + 320, RINV_OFF = LDSCTL_OFF + 1024;
constexpr int LDS_BYTES = 147456;
constexpr int CW_TMO = 0, CW_CODE = 1, CW_BAR = 4096, CW_CNT = 16384, CW_OWNQ = 20480, CW_SWAQ = 20544;

#define GAS __attribute__((address_space(1)))
#define LAS __attribute__((address_space(3)))
typedef GAS unsigned gu32;
#define RLX_AGENT __ATOMIC_RELAXED, __HIP_MEMORY_SCOPE_AGENT
#define LDS_WAIT() asm volatile("s_waitcnt lgkmcnt(0)" ::: "memory")
#define VM_WAIT() asm volatile("s_waitcnt vmcnt(0)" ::: "memory")

#define XB_TMO      128
#define XB_XCNT(j)  (256  + 64 * (j))
#define XB_XSUB(j)  (1280 + 64 * (j))
#define XB_XGEN(j)  (2304 + 64 * (j))
#define XB_TOP      3328
#define XB_TOPGEN   3392
#define XCD_BAR_WORDS 3456
#define XB_SPIN_CAP (1u << 20)
__device__ __forceinline__ unsigned xb_ld(unsigned* p)              { return __hip_atomic_load(p, __ATOMIC_RELAXED, __HIP_MEMORY_SCOPE_AGENT); }
__device__ __forceinline__ unsigned xb_add(unsigned* p, unsigned v) { return __hip_atomic_fetch_add(p, v, __ATOMIC_RELAXED, __HIP_MEMORY_SCOPE_AGENT); }
__device__ __forceinline__ unsigned xb_xcc_id() { return (unsigned)__builtin_amdgcn_s_getreg((3 << 11) | 20) & 0xFu; }
#define XB_SPIN(cond, bar) do { unsigned _sp = 0; while (cond) { __builtin_amdgcn_s_sleep(1); \
    if ((++_sp & 255u) == 0u) { if (xb_ld(&(bar)[XB_TMO])) break; if (_sp > XB_SPIN_CAP) { atomicAdd(&(bar)[XB_TMO], 1u); break; } } } } while (0)
struct XcdBarrier { unsigned* bar; unsigned x; volatile LAS unsigned* st; };
__device__ __forceinline__ XcdBarrier xcd_barrier_post(unsigned* bar, volatile LAS unsigned* st) {
    XcdBarrier b; b.bar = bar; b.x = xb_xcc_id(); b.st = st;
    if (threadIdx.x == 0) (void)xb_add(&bar[XB_XCNT(b.x)], 1u);
    return b;
}
__device__ __forceinline__ void xcd_barrier_complete(unsigned* bar, unsigned x, unsigned& nloc, unsigned& nx) {
    const unsigned G = gridDim.x * gridDim.y * gridDim.z;
    unsigned sum, cnt, mine, sp = 0u;
    for (;;) {
        sum = 0u; cnt = 0u; mine = 0u;
#pragma unroll
        for (unsigned j = 0; j < 16; ++j) { const unsigned c = xb_ld(&bar[XB_XCNT(j)]); sum += c; cnt += (c > 0u) ? 1u : 0u; mine = (j == x) ? c : mine; }
        if (sum == G) break;
        __builtin_amdgcn_s_sleep(1);
        if ((++sp & 255u) == 0u) { if (xb_ld(&bar[XB_TMO])) break; if (sp > XB_SPIN_CAP) { atomicAdd(&bar[XB_TMO], 1u); break; } }
    }
    nloc = mine > 0u ? mine : 1u; nx = cnt > 0u ? cnt : 1u;
}
__device__ __forceinline__ void xcd_barrier(const XcdBarrier& b) {
    asm volatile("s_waitcnt vmcnt(0)" ::: "memory");
    __syncthreads();
    if (threadIdx.x == 0) {
        unsigned* bar = b.bar;
        __builtin_amdgcn_s_waitcnt(0);
        unsigned nloc = b.st[0], nx = b.st[1];
        if (nloc == 0u) { xcd_barrier_complete(bar, b.x, nloc, nx); b.st[0] = nloc; b.st[1] = nx; }
        const unsigned old = xb_add(&bar[XB_XSUB(b.x)], 1u);
        const unsigned gen = old / nloc;
        if (old + 1u == (gen + 1u) * nloc) {
            __builtin_amdgcn_fence(__ATOMIC_RELEASE, "agent");
            asm volatile("s_waitcnt vmcnt(0)" ::: "memory");
            const unsigned og = xb_add(&bar[XB_TOP], 1u);
            const unsigned tg = og / nx;
            if (og + 1u == (tg + 1u) * nx) xb_add(&bar[XB_TOPGEN], 1u);
            else XB_SPIN(xb_ld(&bar[XB_TOPGEN]) == tg, bar);
            __builtin_amdgcn_fence(__ATOMIC_ACQUIRE, "agent");
            xb_add(&bar[XB_XGEN(b.x)], 1u);
            asm volatile("s_waitcnt vmcnt(0)" ::: "memory");
        } else {
            XB_SPIN(xb_ld(&bar[XB_XGEN(b.x)]) == gen, bar);
            __builtin_amdgcn_fence(__ATOMIC_ACQUIRE, "agent");
            asm volatile("s_waitcnt vmcnt(0)" ::: "memory");
        }
    }
    __syncthreads();
}

struct Frame {
    LAS unsigned char* lds;
    int tid, lane, wave, vcu, G;
};

struct ConvItem { const float* W; const float* gain; bf16* WT; int N, Kdst, k_off, k0, n0, drow0; };
__device__ __forceinline__ bool conv_decode(ConvItem& c, const Ptrs& P, int l, int it) {
    constexpr int I_IN = 16 * 160, I_GLU = 8 * 32, I_MRG = 3 * 8 * 32, I_OUT = 16 * 32, I_F1 = 16 * 128, I_F2 = 64 * 32;
    constexpr int NITEMS = I_IN + I_GLU + I_MRG + I_OUT + I_F1 + I_F2;
    if (it >= NITEMS) return false;
    unsigned char* ws = P.ws; int r = it; c.gain = nullptr; c.k_off = 0;
    if (r < I_IN) { const int kb = r / 160, nb = r % 160; c.W = P.w_in + (size_t)l * DM * DIN; c.N = DIN; c.gain = P.norm_mix + l * DM; c.WT = (bf16*)(ws + WS_WIN); c.Kdst = DM; c.k0 = 64 * kb; c.n0 = 32 * nb; c.drow0 = 32 * nb; return true; } r -= I_IN;
    if (r < I_GLU) { const int kb = r / 32, nb = r % 32; const int n0 = 32 * nb, v = n0 & 511;
        c.W = P.w_glu + (size_t)l * 512 * 1024; c.N = 1024; c.WT = (bf16*)(ws + WS_WGLU); c.Kdst = 512; c.k0 = 64 * kb; c.n0 = n0; c.drow0 = (v >> 7) * 256 + (n0 >= 512 ? 128 : 0) + (v & 127); return true; } r -= I_GLU;
    if (r < I_MRG) { const int sg = r / 256, q = r % 256, kb = q / 32, nb = q % 32; c.W = (sg == 0 ? P.w_o_swa : (sg == 1 ? P.w_o_ssm : P.w_o_moba)) + (size_t)l * 512 * DM;
        c.N = DM; c.WT = (bf16*)(ws + WS_WMRG); c.Kdst = 1536; c.k_off = 512 * sg; c.k0 = 64 * kb; c.n0 = 32 * nb; c.drow0 = 32 * nb; return true; } r -= I_MRG;
    if (r < I_OUT) { const int kb = r / 32, nb = r % 32; c.W = P.w_out + (size_t)l * DM * DM; c.N = DM; c.WT = (bf16*)(ws + WS_WOUT); c.Kdst = DM; c.k0 = 64 * kb; c.n0 = 32 * nb; c.drow0 = 32 * nb; return true; } r -= I_OUT;
    if (r < I_F1) { const int kb = r / 128, nb = r % 128; c.W = P.w_ff1 + (size_t)l * DM * DFF; c.N = DFF; c.gain = P.norm_ffn + l * DM; c.WT = (bf16*)(ws + WS_WFF1); c.Kdst = DM; c.k0 = 64 * kb; c.n0 = 32 * nb; c.drow0 = 32 * nb; return true; } r -= I_F1;
    { const int kb = r / 32, nb = r % 32; c.W = P.w_ff2 + (size_t)l * DFF * DM; c.N = DM; c.WT = (bf16*)(ws + WS_WFF2); c.Kdst = DFF; c.k0 = 64 * kb; c.n0 = 32 * nb; c.drow0 = 32 * nb; return true; }
}
__device__ __forceinline__ void conv_loads(f32x4 (&wv)[8], const ConvItem& c, int lane) {
#pragma unroll
    for (int i = 0; i < 8; ++i) wv[i] = *(const f32x4*)(c.W + (size_t)(c.k0 + 8 * i + (lane >> 3)) * c.N + c.n0 + 4 * (lane & 7));
}
__device__ __forceinline__ void conv_store(const f32x4 (&wv)[8], const ConvItem& c, LAS float* scr, int lane) {
#pragma unroll
    for (int i = 0; i < 8; ++i) { const int kk = 8 * i + (lane >> 3); const float g = c.gain ? c.gain[c.k0 + kk] : 1.f; LAS float* sp = scr + kk * 33 + 4 * (lane & 7);
        sp[0] = wv[i][0] * g; sp[1] = wv[i][1] * g; sp[2] = wv[i][2] * g; sp[3] = wv[i][3] * g; }
    LDS_WAIT(); asm volatile("" ::: "memory");
    const int cc = lane & 7;
#pragma unroll
    for (int j = 0; j < 4; ++j) { const int n = (lane >> 3) + 8 * j; const LAS float* s = scr + (8 * cc) * 33 + n;
        u32x4 o; o.x = pk2(s[0 * 33], s[1 * 33]); o.y = pk2(s[2 * 33], s[3 * 33]); o.z = pk2(s[4 * 33], s[5 * 33]); o.w = pk2(s[6 * 33], s[7 * 33]);
        *(GAS u32x4*)(c.WT + (size_t)(c.drow0 + n) * c.Kdst + c.k_off + c.k0 + 8 * cc) = o; }
    LDS_WAIT(); asm volatile("" ::: "memory");
}
__device__ __forceinline__ void conv_layer(const Frame& F, const Ptrs& P, int l) {
    LAS float* scr = (LAS float*)(F.lds + RING_OFF + F.wave * 16384);
    const int gw = F.vcu * NWAVES + F.wave, NGW = F.G * NWAVES;
    f32x4 wa[8], wb[8];
    int it = gw; bool have;
    { ConvItem c; have = conv_decode(c, P, l, it); if (have) conv_loads(wa, c, F.lane); }
#pragma unroll 1
    while (have) {
        bool hn; { ConvItem n; hn = conv_decode(n, P, l, it + NGW); if (hn) conv_loads(wb, n, F.lane); }
        { ConvItem c; conv_decode(c, P, l, it); asm volatile("" ::: "memory"); conv_store(wa, c, scr, F.lane); }
        have = hn; it += NGW;
#pragma unroll
        for (int i = 0; i < 8; ++i) wa[i] = wb[i];
    }
}
__device__ __forceinline__ void ssm_mats(const Frame& F, const Ptrs& P, int l) {
    __syncthreads();
    LAS float* L = (LAS float*)(F.lds + RING_OFF);
    LAS float* apr = L;
    LAS float* api = L + 17 * 64;
    LAS float* bbr = L + 34 * 64;
    LAS float* bbi = bbr + 1024;
    LAS float* ccr = bbi + 1024;
    LAS float* cci = ccr + 1024;
    LAS float* ktab = cci + 1024;
    for (int wi = F.vcu; wi < 256; wi += F.G) {
        const int g = wi >> 3, part = wi & 7; const int tid = F.tid;
        if (tid < 64) { const int p = tid; const float lr = P.lam_re[l * 2048 + g * 64 + p], li = P.lam_im[l * 2048 + g * 64 + p], dt = expf(P.log_step[l * 32 + g]);
            const float mag = expf(lr * dt), are = mag * cosf(li * dt), aim = mag * sinf(li * dt);
            const float den = lr * lr + li * li, nr = are - 1.f, ni = aim, fre = (nr * lr + ni * li) / den, fim = (ni * lr - nr * li) / den;
            float pr = 1.f, pi = 0.f;
            for (int k = 0; k <= 16; ++k) { apr[k * 64 + p] = pr; api[k * 64 + p] = pi; const float t = pr * are - pi * aim; pi = pr * aim + pi * are; pr = t; }
            for (int h = 0; h < 16; ++h) { const float br = P.b_re[(size_t)l * 32768 + (g * 64 + p) * 16 + h], bi = P.b_im[(size_t)l * 32768 + (g * 64 + p) * 16 + h]; bbr[p * 16 + h] = fre * br - fim * bi; bbi[p * 16 + h] = fre * bi + fim * br; } }
        for (int e = tid; e < 1024; e += 512) { ccr[e] = P.c_re[(size_t)l * 32768 + g * 1024 + e]; cci[e] = P.c_im[(size_t)l * 32768 + g * 1024 + e]; }
        __syncthreads();
        for (int e = tid; e < 512; e += 512) { const int tau = e >> 5, i = 2 * part + ((e >> 4) & 1), j = e & 15; float acc = 0.f;
            for (int p = 0; p < 64; ++p) { const float cr = ccr[i * 64 + p], ci = cci[i * 64 + p], ar = apr[tau * 64 + p], ai = api[tau * 64 + p]; const float er = cr * ar - ci * ai, ei = cr * ai + ci * ar; acc += er * bbr[p * 16 + j] - ei * bbi[p * 16 + j]; }
            if (tau == 0 && i == j) acc += P.d_skip[l * 512 + g * 16 + i];
            ktab[tau * 256 + i * 16 + j] = acc; }
        __syncthreads();
        bf16* BM_ = (bf16*)(P.ws + WS_SMAIN) + (size_t)g * 256 * SSM_KM;
        for (int e = tid; e < 32 * SSM_KM / 2; e += 512) {
            const int rr = e / (SSM_KM / 2), k = (e % (SSM_KM / 2)) * 2, s = rr >> 1, i = 2 * part + (rr & 1), n = s * 16 + i; float v[2];
#pragma unroll
            for (int q = 0; q < 2; ++q) { const int kk = k + q;
                if (kk < 256) { const int sp = kk >> 4, j = kk & 15; v[q] = (sp <= s) ? ktab[(s - sp) * 256 + i * 16 + j] : 0.f; }
                else { const int p = (kk - 256) & 63; const float cr = ccr[i * 64 + p], ci = cci[i * 64 + p], ar = apr[(s + 1) * 64 + p], ai = api[(s + 1) * 64 + p]; v[q] = (kk < 320) ? (cr * ar - ci * ai) : -(cr * ai + ci * ar); } }
            *(GAS unsigned*)(BM_ + (size_t)n * SSM_KM + k) = pk2(v[0], v[1]); }
        bf16* BE_ = (bf16*)(P.ws + WS_SEND) + (size_t)g * 256 * SSM_KE;
        for (int e = tid; e < 32 * SSM_KE / 2; e += 512) {
            const int n = part * 32 + e / (SSM_KE / 2), k = (e % (SSM_KE / 2)) * 2; float v[2];
#pragma unroll
            for (int q = 0; q < 2; ++q) { const int kk = k + q, sp = kk >> 4, j = kk & 15, p = n & 63; const float ar = apr[(15 - sp) * 64 + p], ai = api[(15 - sp) * 64 + p], br = bbr[p * 16 + j], bi = bbi[p * 16 + j];
                v[q] = (n < 64) ? (ar * br - ai * bi) : ((n < 128) ? (ar * bi + ai * br) : 0.f); }
            *(GAS unsigned*)(BE_ + (size_t)n * SSM_KE + k) = pk2(v[0], v[1]); }
        __syncthreads();
    }
}
__device__ __forceinline__ void xb_pass(const Frame& F, const Ptrs& P) {
    const int gw = F.vcu * NWAVES + F.wave, NGW = F.G * NWAVES;
    bf16* XB = (bf16*)(P.ws + WS_XN); float* SSQ = (float*)(P.ws + WS_SSQ);
    for (int m = gw; m < T; m += NGW) {
        const GAS f32x4* xr = (const GAS f32x4*)(P.x_in + (size_t)m * DM) + F.lane;
        f32x4 v[4]; float s = 0.f;
#pragma unroll
        for (int j = 0; j < 4; ++j) { v[j] = xr[64 * j]; s += (v[j].x * v[j].x + v[j].y * v[j].y) + (v[j].z * v[j].z + v[j].w * v[j].w); }
        s = wave_sum(s);
        GAS unsigned long long* o8 = (GAS unsigned long long*)(XB + (size_t)m * DM) + F.lane;
#pragma unroll
        for (int j = 0; j < 4; ++j) o8[64 * j] = (unsigned long long)pk2(v[j].x, v[j].y) | ((unsigned long long)pk2(v[j].z, v[j].w) << 32);
        if (F.lane < 16) SSQ[(size_t)m * 16 + F.lane] = (F.lane == 0) ? s : 0.f;
    }
}
__device__ __forceinline__ void final_pass(const Frame& F, const Ptrs& P) {
    const int gw = F.vcu * NWAVES + F.wave, NGW = F.G * NWAVES;
    for (int m = gw; m < T; m += NGW) {
        GAS f32x4* xr = (GAS f32x4*)(P.x + (size_t)m * DM) + F.lane;
        f32x4 v[4]; float s = 0.f;
#pragma unroll
        for (int j = 0; j < 4; ++j) { v[j] = xr[64 * j]; s += (v[j].x * v[j].x + v[j].y * v[j].y) + (v[j].z * v[j].z + v[j].w * v[j].w); }
        const float r = rsqrtf(wave_sum(s) * (1.f / DM) + NORM_EPS);
#pragma unroll
        for (int j = 0; j < 4; ++j) { const f32x4 g = ((const GAS f32x4*)P.norm_final)[F.lane + 64 * j]; xr[64 * j] = v[j] * r * g; }
    }
}
__device__ __forceinline__ void ssm_carry(const Frame& F, const Ptrs& P, int l) {
    if (F.vcu & 15) return;
    const int gt = (F.vcu >> 4) * 512 + F.tid;
    if (gt >= 32 * NB * 64) return;
    const int p = gt & 63, b = (gt >> 6) & 3, g = gt >> 8;
    const float lr = P.lam_re[l * 2048 + g * 64 + p], li = P.lam_im[l * 2048 + g * 64 + p], dt = expf(P.log_step[l * 32 + g]);
    const float mag = expf(lr * dt), are = mag * cosf(li * dt), aim = mag * sinf(li * dt);
    float pr = 1.f, pi = 0.f;
    for (int k = 0; k < 16; ++k) { const float t = pr * are - pi * aim; pi = pr * aim + pi * are; pr = t; }
    const float* he = (const float*)(P.ws + WS_HEND) + ((size_t)g * NCH + b * 256) * 128 + p;
    bf16* hi = (bf16*)(P.ws + WS_HINIT) + ((size_t)g * NCH + b * 256) * 128 + p;
    float sr = 0.f, si = 0.f;
    float er[8], ei[8];
#pragma unroll
    for (int q = 0; q < 8; ++q) { er[q] = he[(size_t)q * 128]; ei[q] = he[(size_t)q * 128 + 64]; }
    for (int c0 = 0; c0 < 256; c0 += 8) {
        float nr_[8], ni_[8];
        const int cn = (c0 + 8 < 256) ? c0 + 8 : c0;
#pragma unroll
        for (int q = 0; q < 8; ++q) { nr_[q] = he[(size_t)(cn + q) * 128]; ni_[q] = he[(size_t)(cn + q) * 128 + 64]; }
#pragma unroll
        for (int q = 0; q < 8; ++q) { hi[(size_t)(c0 + q) * 128] = (bf16)f2bf(sr); hi[(size_t)(c0 + q) * 128 + 64] = (bf16)f2bf(si);
            const float tr = pr * sr - pi * si + er[q], ti = pr * si + pi * sr + ei[q]; sr = tr; si = ti; }
#pragma unroll
        for (int q = 0; q < 8; ++q) { er[q] = nr_[q]; ei[q] = ni_[q]; }
    }
}
namespace att {
__device__ __forceinline__ int crow(int r, int hi) { return (r & 3) + 8 * (r >> 2) + 4 * hi; }
struct St { f32x16 o0, o1; float m, l; };
__device__ __forceinline__ unsigned cvtpk(float lo, float hi) { return cvtpk_s(lo, hi); }

__device__ __forceinline__ void loadk(bf16x8 (&kf)[8], const bf16* kp) {
#pragma unroll
    for (int d0 = 0; d0 < 4; ++d0) { kf[2 * d0] = *(const bf16x8*)(kp + d0 * 16); kf[2 * d0 + 1] = *(const bf16x8*)(kp + 32 * 128 + d0 * 16); }
}
template <int MODE>
__device__ __forceinline__ void tile(St& st, const bf16x8 (&qr)[4], const bf16x8 (&kf)[8], const bf16* vtp  , int kq  , float sl2, bool rowok, int klo  , int hi) {
    f32x16 p0 = {}, p1 = {};
#pragma unroll
    for (int d0 = 0; d0 < 4; ++d0) { p0 = __builtin_amdgcn_mfma_f32_32x32x16_bf16(kf[2 * d0], qr[d0], p0, 0, 0, 0); p1 = __builtin_amdgcn_mfma_f32_32x32x16_bf16(kf[2 * d0 + 1], qr[d0], p1, 0, 0, 0); }
    s16x4 vl[2][4], vh[2][4];
#pragma unroll
    for (int dh = 0; dh < 2; ++dh)
#pragma unroll
        for (int s = 0; s < 4; ++s) { vl[dh][s] = *(const s16x4*)(vtp + (size_t)dh * 32 * S + 16 * s); vh[dh][s] = *(const s16x4*)(vtp + (size_t)dh * 32 * S + 16 * s + 8); }
    const float base = sl2 * (float)(kq + 4 * hi);
    float mx = -INFINITY;
#pragma unroll
    for (int r = 0; r < 16; ++r) { const int c = (r & 3) + 8 * (r >> 2); const int k0 = kq + 4 * hi + c, k1 = k0 + 32;
        float a = fmaf(sl2, (float)c, p0[r]), b = fmaf(sl2, (float)(c + 32), p1[r]);
        if (MODE == 1) { a = (k0 <= 0 && k0 >= klo) ? a : -INFINITY; b = (k1 <= 0 && k1 >= klo) ? b : -INFINITY; }
        else if (MODE == 2) { a = (k0 <= 0) ? a : -INFINITY; b = (k1 <= 0) ? b : -INFINITY; }
        else if (MODE == 3) { a = (rowok && k0 <= 0) ? a : -INFINITY; b = (rowok && k1 <= 0) ? b : -INFINITY; }
        p0[r] = a; p1[r] = b; mx = fmaxf(mx, fmaxf(a, b)); }
    mx += base;
    mx = fmaxf(mx, __shfl_xor(mx, 32));
    const float mn = fmaxf(st.m, mx), alpha = __builtin_amdgcn_exp2f(st.m - mn), off = base - mn;
    float sum = 0.f;
#pragma unroll
    for (int r = 0; r < 16; ++r) { p0[r] = __builtin_amdgcn_exp2f(p0[r] + off); p1[r] = __builtin_amdgcn_exp2f(p1[r] + off); sum += p0[r] + p1[r]; }
    st.m = mn; st.l = st.l * alpha + sum;
#pragma unroll
    for (int r = 0; r < 16; ++r) { st.o0[r] *= alpha; st.o1[r] *= alpha; }
    bf16x8 pf[4];
#pragma unroll
    for (int s = 0; s < 2; ++s) { u32x4 w0, w1;
        w0.x = cvtpk(p0[8 * s + 0], p0[8 * s + 1]); w0.y = cvtpk(p0[8 * s + 2], p0[8 * s + 3]); w0.z = cvtpk(p0[8 * s + 4], p0[8 * s + 5]); w0.w = cvtpk(p0[8 * s + 6], p0[8 * s + 7]);
        w1.x = cvtpk(p1[8 * s + 0], p1[8 * s + 1]); w1.y = cvtpk(p1[8 * s + 2], p1[8 * s + 3]); w1.z = cvtpk(p1[8 * s + 4], p1[8 * s + 5]); w1.w = cvtpk(p1[8 * s + 6], p1[8 * s + 7]);
        pf[s] = __builtin_bit_cast(bf16x8, w0); pf[2 + s] = __builtin_bit_cast(bf16x8, w1); }
#pragma unroll
    for (int s = 0; s < 4; ++s) {
        const bf16x8 v0 = (bf16x8){vl[0][s][0], vl[0][s][1], vl[0][s][2], vl[0][s][3], vh[0][s][0], vh[0][s][1], vh[0][s][2], vh[0][s][3]};
        const bf16x8 v1 = (bf16x8){vl[1][s][0], vl[1][s][1], vl[1][s][2], vl[1][s][3], vh[1][s][0], vh[1][s][1], vh[1][s][2], vh[1][s][3]};
        st.o0 = __builtin_amdgcn_mfma_f32_32x32x16_bf16(v0, pf[s], st.o0, 0, 0, 0);
        st.o1 = __builtin_amdgcn_mfma_f32_32x32x16_bf16(v1, pf[s], st.o1, 0, 0, 0); }
}
__device__ __forceinline__ void finish(const St& st, bf16* op, int hi) {
    const float lt = st.l + __shfl_xor(st.l, 32), rl = __builtin_amdgcn_rcpf(lt);
#pragma unroll
    for (int g = 0; g < 4; ++g) { u32x2 a, b;
        a.x = cvtpk(st.o0[4 * g] * rl, st.o0[4 * g + 1] * rl); a.y = cvtpk(st.o0[4 * g + 2] * rl, st.o0[4 * g + 3] * rl);
        b.x = cvtpk(st.o1[4 * g] * rl, st.o1[4 * g + 1] * rl); b.y = cvtpk(st.o1[4 * g + 2] * rl, st.o1[4 * g + 3] * rl);
        *(u32x2*)(op + 8 * g + 4 * hi) = a; *(u32x2*)(op + 32 + 8 * g + 4 * hi) = b; }
}
__device__ __forceinline__ void loadq(bf16x8 (&qr)[4], const bf16* qp) {
#pragma unroll
    for (int d0 = 0; d0 < 4; ++d0) qr[d0] = *(const bf16x8*)(qp + d0 * 16);
}

constexpr int IMG_K = 0, IMG_V = 32768, IMG_BYTES = 65536;
__device__ __forceinline__ void img_load(const Frame& F, LAS unsigned char* img, const bf16* K, long krow0, int kvh, const bf16* vt0, int key0) {
    const int lane = F.lane, w = F.wave;
#pragma unroll
    for (int i = 0; i < 4; ++i) { const int piece = w * 4 + i, key = piece * 8 + (lane >> 3), c = (lane & 7) ^ ((key >> 1) & 7); long row = krow0 + key; row = row < 0 ? 0 : row;
        __builtin_amdgcn_global_load_lds((const unsigned*)(K + row * 128 + kvh * 64 + c * 8), (LAS unsigned*)(img + IMG_K + piece * 1024), 16, 0, 0); }
#pragma unroll
    for (int i = 0; i < 4; ++i) { const int piece = w * 4 + i, d = piece * 2 + (lane >> 5), c = (lane & 31) ^ (d & 15); int kk = key0 + c * 8; kk = kk < 0 ? 0 : kk;
        __builtin_amdgcn_global_load_lds((const unsigned*)(vt0 + (long)d * S + kk), (LAS unsigned*)(img + IMG_V + piece * 1024), 16, 0, 0); }
}
struct LaneOff { int k[4]; int v[8]; };
__device__ __forceinline__ void lane_off(LaneOff& lo, int r32, int hi) { const int s7 = (r32 >> 1) & 7, x = r32 & 15;
#pragma unroll
    for (int d0 = 0; d0 < 4; ++d0) lo.k[d0] = ((2 * d0 + hi) ^ s7) << 4;
#pragma unroll
    for (int j = 0; j < 8; ++j) lo.v[j] = (j ^ (x & 7)) << 4; }
template <int MODE, bool HALF, bool AL64>
__device__ __forceinline__ void tile_lds(St& st, const bf16x8 (&qr)[4], const LAS unsigned char* img, const LaneOff& lo, int ko, int kq  , float sl2, bool rowok, int klo, int hi, int r32) {
    const LAS unsigned char* kp = img + IMG_K + (ko + r32) * 128;
    const bool fresh = st.m == -INFINITY; const float ref = fresh ? 0.f : st.m;
    const float cin = sl2 * (float)(kq + 4 * hi) - ref;
    f32x16 p0, p1;
#pragma unroll
    for (int r = 0; r < 16; ++r) { p0[r] = cin; p1[r] = cin; }
    bf16x8 kf[8];
#pragma unroll
    for (int d0 = 0; d0 < 4; ++d0) { kf[2 * d0] = *(const LAS bf16x8*)(kp + lo.k[d0]); if (!HALF) kf[2 * d0 + 1] = *(const LAS bf16x8*)(kp + 32 * 128 + lo.k[d0]); }
    __builtin_amdgcn_sched_barrier(0);
#pragma unroll
    for (int d0 = 0; d0 < 4; ++d0) {
        p0 = __builtin_amdgcn_mfma_f32_32x32x16_bf16(kf[2 * d0], qr[d0], p0, 0, 0, 0);
        if (!HALF) p1 = __builtin_amdgcn_mfma_f32_32x32x16_bf16(kf[2 * d0 + 1], qr[d0], p1, 0, 0, 0); }
    float mx = -INFINITY;
#pragma unroll
    for (int r = 0; r < 16; ++r) { const int c = (r & 3) + 8 * (r >> 2); const int k0 = kq + 4 * hi + c, k1 = k0 + 32;
        float a = fmaf(sl2, (float)c, p0[r]), b = HALF ? -INFINITY : fmaf(sl2, (float)(c + 32), p1[r]);
        if (MODE == 1) { a = (k0 <= 0 && k0 >= klo) ? a : -INFINITY; if (!HALF) b = (k1 <= 0 && k1 >= klo) ? b : -INFINITY; }
        else if (MODE == 2) { a = (k0 <= 0) ? a : -INFINITY; if (!HALF) b = (k1 <= 0) ? b : -INFINITY; }
        else if (MODE == 3) { a = (rowok && k0 <= 0) ? a : -INFINITY; if (!HALF) b = (rowok && k1 <= 0) ? b : -INFINITY; }
        p0[r] = a; if (!HALF) p1[r] = b; mx = fmaxf(mx, HALF ? a : fmaxf(a, b)); }
    mx = fmaxf(mx, __shfl_xor(mx, 32));
    const float delta = fresh ? ((mx == -INFINITY) ? 0.f : mx) : ((mx > 8.f) ? mx : 0.f);
    if (__any(delta != 0.f)) {
        const float alpha = fresh ? 1.f : __builtin_amdgcn_exp2f(-delta);
#pragma unroll
        for (int r = 0; r < 16; ++r) { p0[r] -= delta; if (!HALF) p1[r] -= delta; st.o0[r] *= alpha; st.o1[r] *= alpha; }
        st.l *= alpha;
        st.m = (fresh && mx == -INFINITY) ? -INFINITY : ref + delta;
    }
    float sum = 0.f;
#pragma unroll
    for (int r = 0; r < 16; ++r) { p0[r] = __builtin_amdgcn_exp2f(p0[r]); sum += p0[r]; if (!HALF) { p1[r] = __builtin_amdgcn_exp2f(p1[r]); sum += p1[r]; } }
    st.l += sum;
    const int x = r32 & 15, kc = ko >> 3;
    const LAS unsigned char* vp = img + IMG_V + r32 * 512 + hi * 8 + (AL64 ? ((kc ^ (x & 8)) << 4) : 0);
    constexpr int NS = HALF ? 2 : 4;
    s16x4 va0[NS], va1[NS], vb0[NS], vb1[NS];
#pragma unroll
    for (int s = 0; s < NS; ++s) { const int o0 = AL64 ? lo.v[2 * s] : (((kc + 2 * s) ^ x) << 4), o1 = AL64 ? lo.v[2 * s + 1] : (((kc + 2 * s + 1) ^ x) << 4);
        va0[s] = *(const LAS s16x4*)(vp + o0); va1[s] = *(const LAS s16x4*)(vp + o1); vb0[s] = *(const LAS s16x4*)(vp + 32 * 512 + o0); vb1[s] = *(const LAS s16x4*)(vp + 32 * 512 + o1); }
    __builtin_amdgcn_sched_barrier(0);
#pragma unroll
    for (int s = 0; s < NS; ++s) {
        u32x4 w;
        if (s < 2) { w.x = cvtpk(p0[8 * s + 0], p0[8 * s + 1]); w.y = cvtpk(p0[8 * s + 2], p0[8 * s + 3]); w.z = cvtpk(p0[8 * s + 4], p0[8 * s + 5]); w.w = cvtpk(p0[8 * s + 6], p0[8 * s + 7]); }
        else { w.x = cvtpk(p1[8 * s - 16], p1[8 * s - 15]); w.y = cvtpk(p1[8 * s - 14], p1[8 * s - 13]); w.z = cvtpk(p1[8 * s - 12], p1[8 * s - 11]); w.w = cvtpk(p1[8 * s - 10], p1[8 * s - 9]); }
        const bf16x8 pf = __builtin_bit_cast(bf16x8, w);
        st.o0 = __builtin_amdgcn_mfma_f32_32x32x16_bf16((bf16x8){va0[s][0], va0[s][1], va0[s][2], va0[s][3], va1[s][0], va1[s][1], va1[s][2], va1[s][3]}, pf, st.o0, 0, 0, 0);
        st.o1 = __builtin_amdgcn_mfma_f32_32x32x16_bf16((bf16x8){vb0[s][0], vb0[s][1], vb0[s][2], vb0[s][3], vb1[s][0], vb1[s][1], vb1[s][2], vb1[s][3]}, pf, st.o1, 0, 0, 0); }
}
__device__ __forceinline__ void swa_unit(const Frame& F, const Ptrs& P, int l, int un) {
    bf16* QA = (bf16*)(P.ws + WS_QA); const bf16* KA = (const bf16*)(P.ws + WS_KA); const bf16* VAT = (const bf16*)(P.ws + WS_VAT);
    const int lane = F.lane, r32 = lane & 31, hi = lane >> 5, w = F.wave;
    LAS unsigned char* img = F.lds + RING_OFF;
    LaneOff lo; lane_off(lo, r32, hi);
    {
        const int bk = un >> 5, nb = un & 31, b = bk >> 1, kvh = bk & 1, h = kvh * 4 + (w >> 1);
        __syncthreads();
        img_load(F, img, KA, (long)b * S + nb * 128 - 128, kvh, VAT + (long)((b * 2 + kvh) * 64) * S, nb * 128 - 128);
        const float sl2 = exp2f(-0.5f * (float)(h + 1)) * LOG2E, sink2 = P.sinks[l * 8 + h] * LOG2E;
        asm volatile("s_waitcnt vmcnt(0)" ::: "memory"); __syncthreads();
        for (int qt = 0; qt < 2; ++qt) {
            const int qo = (w & 1) * 64 + qt * 32, t0 = nb * 128 + qo, q = t0 + r32;
            bf16* qrow = QA + (size_t)(b * S + q) * 512 + h * 64;
            bf16x8 qr[4]; loadq(qr, qrow + 8 * hi);
            St st; st.o0 = f32x16{}; st.o1 = f32x16{}; st.m = sink2; st.l = hi ? 0.f : 1.f;
            const int klo = q < 127 ? -q : -127;
#pragma unroll 1
            for (int kt = 0; kt < 2; ++kt) { if (t0 - 128 + 64 * kt + 63 >= 0) tile_lds<1, false, false>(st, qr, img, lo, qo + 64 * kt, t0 - 128 + 64 * kt - q, sl2, true, klo, hi, r32); }
            tile_lds<1, true, false>(st, qr, img, lo, qo + 128, t0 - q, sl2, true, klo, hi, r32);
            finish(st, qrow, hi);
        }
    }
    __syncthreads();
}
__device__ __forceinline__ float moba_sl2(int h) { return exp2f(-0.5f * (float)(8 + h + 1)) * LOG2E; }
__device__ __forceinline__ void select_unit(const Frame& F, const Ptrs& P, int l, int un) {
    const bf16* QM = (const bf16*)(P.ws + WS_QM); const float* KMP = (const float*)(P.ws + WS_KMP);
    unsigned* LIST = (unsigned*)(P.ws + WS_LIST); unsigned* CNT = (unsigned*)(P.ws + WS_CTL) + CW_CNT + l * 128;
    LAS float* km = (LAS float*)(F.lds + RING_OFF);
    const int tid = F.tid, lane = F.lane;
    {
        const int bk = un >> 5, ch = un & 31, b = bk >> 1, kvh = bk & 1, j = ch >> 1;
        __syncthreads();
        for (int e = tid; e < 1024; e += 512) { const int n = e >> 6, d = e & 63; const float* k0 = KMP + (size_t)(b * 16 + n) * 128 + kvh * 64 + d; km[e] = k0[0] + k0[64 * 128]; }
        __syncthreads();
        if (j == 0) return;
        const int hg = tid >> 7, t = ch * 128 + (tid & 127);
        const bf16* qp = QM + (size_t)(b * S + t) * 512 + (kvh * 4 + hg) * 64;
        u32x4 qv[8];
#pragma unroll
        for (int i = 0; i < 8; ++i) qv[i] = *(const u32x4*)(qp + 8 * i);
        int i0 = 0, i1 = 1, i2 = 2;
        if (j > 3) {
            float v0 = -INFINITY, v1 = -INFINITY, v2 = -INFINITY; i0 = 0; i1 = 0; i2 = 0;
#pragma unroll 1
            for (int n = 0; n < j; ++n) { float a = 0.f;
#pragma unroll
                for (int i = 0; i < 8; ++i) { const f32x4 x0 = *(const LAS f32x4*)(km + n * 64 + 8 * i), x1 = *(const LAS f32x4*)(km + n * 64 + 8 * i + 4);
                    a += bf2f(qv[i].x & 0xffffu) * x0[0] + bf2f(qv[i].x >> 16) * x0[1] + bf2f(qv[i].y & 0xffffu) * x0[2] + bf2f(qv[i].y >> 16) * x0[3]
                       + bf2f(qv[i].z & 0xffffu) * x1[0] + bf2f(qv[i].z >> 16) * x1[1] + bf2f(qv[i].w & 0xffffu) * x1[2] + bf2f(qv[i].w >> 16) * x1[3]; }
                if (a > v0) { v2 = v1; i2 = i1; v1 = v0; i1 = i0; v0 = a; i0 = n; } else if (a > v1) { v2 = v1; i2 = i1; v1 = a; i1 = n; } else if (a > v2) { v2 = a; i2 = n; } }
        }
        const int nsel = j < 3 ? j : 3;
        unsigned mycnt = 0u;
#pragma unroll 1
        for (int n = 0; n < j; ++n) { const bool sel = (n == i0 && nsel > 0) || (n == i1 && nsel > 1) || (n == i2 && nsel > 2); const unsigned long long mask = __ballot(sel); if (lane == n) mycnt = (unsigned)__popcll(mask); }
        unsigned mybase = 0u;
        if (lane < j && mycnt) mybase = __hip_atomic_fetch_add(CNT + bk * 16 + lane, mycnt, __ATOMIC_RELAXED, __HIP_MEMORY_SCOPE_AGENT);
#pragma unroll 1
        for (int n = 0; n < j; ++n) {
            const int r = (n == i0) ? 0 : ((n == i1) ? 1 : ((n == i2) ? 2 : 3));
            const bool sel = r < nsel;
            const unsigned long long mask = __ballot(sel);
            if (mask == 0ull) continue;
            const unsigned base = (unsigned)__shfl((int)mybase, n);
            const unsigned pos = base + (unsigned)__popcll(mask & ((1ull << lane) - 1ull));
            if (sel) LIST[(size_t)(bk * 16 + n) * 16384 + pos] = ((unsigned)t << 4) | ((unsigned)hg << 2) | (unsigned)r;
        }
    }
    __syncthreads();
}
__device__ __forceinline__ void swa_select_phase(const Frame& F, const Ptrs& P, int l, int lq) {
    unsigned* qctr = (unsigned*)(P.ws + WS_CTL) + CW_SWAQ + lq;
    volatile LAS unsigned* jobw = (volatile LAS unsigned*)(F.lds + MISC_OFF + 64);
    for (;;) {
        __syncthreads();
        if (F.tid == 0) *jobw = __hip_atomic_fetch_add(qctr, 1u, __ATOMIC_RELAXED, __HIP_MEMORY_SCOPE_AGENT);
        __syncthreads();
        const int job = (int)*jobw;
        if (job >= 512) break;
        if (job < 256) swa_unit(F, P, l, job); else select_unit(F, P, lq, job - 256);
    }
}
__device__ __forceinline__ void store_o(const St& st, bf16* op, float rl, int hi) {
#pragma unroll
    for (int g = 0; g < 4; ++g) { u32x2 a, b;
        a.x = cvtpk(st.o0[4 * g] * rl, st.o0[4 * g + 1] * rl); a.y = cvtpk(st.o0[4 * g + 2] * rl, st.o0[4 * g + 3] * rl);
        b.x = cvtpk(st.o1[4 * g] * rl, st.o1[4 * g + 1] * rl); b.y = cvtpk(st.o1[4 * g + 2] * rl, st.o1[4 * g + 3] * rl);
        *(u32x2*)(op + 8 * g + 4 * hi) = a; *(u32x2*)(op + 32 + 8 * g + 4 * hi) = b; }
}
__device__ __forceinline__ void moba_gather(const Frame& F, const Ptrs& P, int l) {
    const bf16* QM = (const bf16*)(P.ws + WS_QM); const bf16* KM = (const bf16*)(P.ws + WS_KM); const bf16* VMT = (const bf16*)(P.ws + WS_VMT);
    const unsigned* LIST = (const unsigned*)(P.ws + WS_LIST); unsigned* CNT = (unsigned*)(P.ws + WS_CTL) + CW_CNT + l * 128;
    bf16* PART = (bf16*)(P.ws + WS_PART); float* LSE = (float*)(P.ws + WS_LSE);
    const int lane = F.lane, r32 = lane & 31, hi = lane >> 5, w = F.wave;
    const int per = F.G >> 3;
    const int bk = F.vcu / per, loc = F.vcu % per;
    if (bk >= 8 || (F.vcu & 15) == 0) return;
    const int wg = loc - 1 - (loc > 16 ? 1 : 0), nwg = per - 2;
    const int b = bk >> 1, kvh = bk & 1;
    unsigned cnt = 0u;
    if (lane < 16) cnt = __hip_atomic_load(CNT + bk * 16 + lane, __ATOMIC_RELAXED, __HIP_MEMORY_SCOPE_AGENT);
    const int ns_l = (int)((cnt + 255u) >> 8);
    int pre = ns_l;
#pragma unroll
    for (int o = 1; o < 16; o <<= 1) { const int v = __shfl_up(pre, o); if (lane >= o) pre += v; }
    const int total = __shfl(pre, 15);
    const bf16* vt0 = VMT + (long)((b * 2 + kvh) * 64) * S;
    LAS unsigned char* ring = F.lds + RING_OFF;
    LaneOff lo; lane_off(lo, r32, hi);
    __syncthreads();
#define GA_LOCATE(it, n_, s_) do { const unsigned long long le_ = __ballot(lane < 16 && pre <= (it)); n_ = (int)__popcll(le_); s_ = (it) - ((n_ == 0) ? 0 : __shfl(pre, n_ - 1)); } while (0)
#define GA_ENTRY(e_, n_, s_) do { const int cn_ = (int)__shfl((int)cnt, n_), ti_ = (s_) * 8 + w, idx_ = ti_ * 32 + r32; e_ = 0u; if (ti_ * 32 < cn_) e_ = LIST[(size_t)(bk * 16 + n_) * 16384 + (idx_ < cn_ ? idx_ : ti_ * 32)]; } while (0)
#define GA_LOADQ(q_, e_) loadq(q_, QM + ((size_t)(b * S + (int)((e_) >> 4))) * 512 + (kvh * 4 + (int)(((e_) >> 2) & 3u)) * 64 + 8 * hi)
    int item = wg;
    if (item < total) {
        int n0, s0, n1 = 0, s1 = 0, n2 = 0, s2 = 0; unsigned e0, e1 = 0u, e2 = 0u;
        GA_LOCATE(item, n0, s0); GA_ENTRY(e0, n0, s0);
        bool has1 = item + nwg < total; if (has1) { GA_LOCATE(item + nwg, n1, s1); GA_ENTRY(e1, n1, s1); }
        img_load(F, ring, KM, (long)b * S + n0 * 256, kvh, vt0, n0 * 256);
        bf16x8 qn[4]; GA_LOADQ(qn, e0);
        int buf = 0;
#pragma unroll 1
        for (;;) {
            asm volatile("s_waitcnt vmcnt(0)" ::: "memory"); __syncthreads();
            bf16x8 qr[4];
#pragma unroll
            for (int i = 0; i < 4; ++i) qr[i] = qn[i];
            const LAS unsigned char* img = ring + buf * IMG_BYTES;
            if (has1) { img_load(F, ring + (buf ^ 1) * IMG_BYTES, KM, (long)b * S + n1 * 256, kvh, vt0, n1 * 256); GA_LOADQ(qn, e1); }
            const bool has2 = item + 2 * nwg < total; if (has2) { GA_LOCATE(item + 2 * nwg, n2, s2); GA_ENTRY(e2, n2, s2); }
            const int cn = (int)__shfl((int)cnt, n0), ti = s0 * 8 + w; const bool tile_ok = ti * 32 < cn, valid = ti * 32 + r32 < cn;
            if (tile_ok) {
                const int t = (int)(e0 >> 4), hg = (int)((e0 >> 2) & 3u), r = (int)(e0 & 3u), h = kvh * 4 + hg;
                const float sl2 = moba_sl2(h);
                St st; st.o0 = f32x16{}; st.o1 = f32x16{}; st.m = -INFINITY; st.l = 0.f;
                const int kq = n0 * 256 - t;
#pragma unroll 1
                for (int i = 0; i < 4; ++i) tile_lds<0, false, true>(st, qr, img, lo, 64 * i, kq + 64 * i, sl2, true, 0, hi, r32);
                const float lt = st.l + __shfl_xor(st.l, 32);
                if (valid) { const size_t slot = ((size_t)((b * 8 + h) * 3 + r)) * S + t;
                    store_o(st, PART + slot * 64, __builtin_amdgcn_rcpf(lt), hi); if (hi == 0) LSE[slot] = st.m + __builtin_amdgcn_logf(lt); }
            }
            if (!has1) break;
            item += nwg; n0 = n1; s0 = s1; e0 = e1; n1 = n2; s1 = s2; e1 = e2; has1 = has2; buf ^= 1;
        }
    }
#undef GA_LOCATE
#undef GA_ENTRY
#undef GA_LOADQ
    asm volatile("s_waitcnt vmcnt(0)" ::: "memory"); __syncthreads();
}
__device__ __forceinline__ void moba_own(const Frame& F, const Ptrs& P, int lq, bool nofull = false, bool nocomb = false) {
    bf16* QM = (bf16*)(P.ws + WS_QM); const bf16* KM = (const bf16*)(P.ws + WS_KM); const bf16* VMT = (const bf16*)(P.ws + WS_VMT);
    const bf16* PART = (const bf16*)(P.ws + WS_PART); const float* LSE = (const float*)(P.ws + WS_LSE);
    unsigned* qctr = (unsigned*)(P.ws + WS_CTL) + CW_OWNQ + lq;
    const int lane = F.lane, r32 = lane & 31, hi = lane >> 5, w = F.wave;
    LAS unsigned char* img = F.lds + RING_OFF;
    volatile LAS unsigned* jobw = (volatile LAS unsigned*)(F.lds + MISC_OFF + 64);
    LaneOff lo; lane_off(lo, r32, hi);
    for (;;) {
        __syncthreads();
        if (F.tid == 0) *jobw = __hip_atomic_fetch_add(qctr, 1u, __ATOMIC_RELAXED, __HIP_MEMORY_SCOPE_AGENT);
        __syncthreads();
        const int sjob = (int)*jobw;
        if (sjob >= 256) break;
        const int bk = sjob >> 5, j = 15 - ((sjob & 31) >> 1), hp = sjob & 1, b = bk >> 1, kvh = bk & 1;
        img_load(F, img, KM, (long)b * S + j * 256, kvh, VMT + (long)((b * 2 + kvh) * 64) * S, j * 256);
        asm volatile("s_waitcnt vmcnt(0)" ::: "memory"); __syncthreads();
        const int nsel = j < 3 ? j : 3;
#pragma unroll 1
        for (int k = 0; k < 2; ++k) {
            const int hg = 2 * hp + k, qs = (k & 1) ? 7 - w : w, qo = qs * 32, h = kvh * 4 + hg;
            const float sl2 = moba_sl2(h);
            const int t0 = j * 256 + qo, q = t0 + r32;
            const size_t row = (size_t)(b * S + q);
            bf16* qrow = QM + row * 512 + h * 64;
            bf16x8 qr[4]; loadq(qr, qrow + 8 * hi);
            St st; st.o0 = f32x16{}; st.o1 = f32x16{}; st.m = -INFINITY; st.l = 0.f;
            const int nfull = nofull ? 0 : (qo >> 6);
#pragma unroll 1
            for (int i = 0; i < nfull; ++i) tile_lds<0, false, true>(st, qr, img, lo, 64 * i, 64 * i - qo - r32, sl2, true, 0, hi, r32);
            if (qo & 32) tile_lds<2, false, true>(st, qr, img, lo, qo - 32, -32 - r32, sl2, true, 0, hi, r32);
            else tile_lds<2, true, true>(st, qr, img, lo, qo, -r32, sl2, true, 0, hi, r32);
            const float lt = st.l + __shfl_xor(st.l, 32);
            const float lse_own = st.m + __builtin_amdgcn_logf(lt), rl = __builtin_amdgcn_rcpf(lt);
            LAS unsigned char* stg = F.lds + RING_OFF + IMG_BYTES + w * 4736;
#pragma unroll
            for (int g = 0; g < 4; ++g) { u32x2 a2, c2;
                a2.x = cvtpk(st.o0[4 * g] * rl, st.o0[4 * g + 1] * rl); a2.y = cvtpk(st.o0[4 * g + 2] * rl, st.o0[4 * g + 3] * rl);
                c2.x = cvtpk(st.o1[4 * g] * rl, st.o1[4 * g + 1] * rl); c2.y = cvtpk(st.o1[4 * g + 2] * rl, st.o1[4 * g + 3] * rl);
                *(LAS u32x2*)(stg + r32 * 144 + (8 * g + 4 * hi) * 2) = a2; *(LAS u32x2*)(stg + r32 * 144 + (32 + 8 * g + 4 * hi) * 2) = c2; }
            if (hi == 0) *(LAS float*)(stg + 4608 + r32 * 4) = lse_own;
            LDS_WAIT(); asm volatile("" ::: "memory");
            if (nocomb) continue;
#pragma unroll
            for (int i = 0; i < 4; ++i) {
                const int rw = i * 8 + (lane >> 3), ch = lane & 7;
                const size_t grow = (size_t)(b * S + t0 + rw), sl0 = ((size_t)((b * 8 + h) * 3)) * S + t0 + rw;
                const u32x4 own = *(const LAS u32x4*)(stg + rw * 144 + ch * 16); const float lo_ = *(const LAS float*)(stg + 4608 + rw * 4);
                float ls[3]; u32x4 pr[3];
#pragma unroll
                for (int r = 0; r < 3; ++r) { ls[r] = -INFINITY; pr[r] = (u32x4){0u, 0u, 0u, 0u}; if (r < nsel) { ls[r] = LSE[sl0 + (size_t)r * S]; pr[r] = *(const u32x4*)(PART + (sl0 + (size_t)r * S) * 64 + ch * 8); } }
                float M = lo_;
#pragma unroll
                for (int r = 0; r < 3; ++r) M = fmaxf(M, ls[r]);
                const float w0 = __builtin_amdgcn_exp2f(lo_ - M); float W = w0;
                float acc8[8];
                acc8[0] = w0 * bf2f(own.x & 0xffffu); acc8[1] = w0 * bf2f(own.x >> 16); acc8[2] = w0 * bf2f(own.y & 0xffffu); acc8[3] = w0 * bf2f(own.y >> 16);
                acc8[4] = w0 * bf2f(own.z & 0xffffu); acc8[5] = w0 * bf2f(own.z >> 16); acc8[6] = w0 * bf2f(own.w & 0xffffu); acc8[7] = w0 * bf2f(own.w >> 16);
#pragma unroll
                for (int r = 0; r < 3; ++r) { const float wr_ = __builtin_amdgcn_exp2f(ls[r] - M); W += wr_;
                    acc8[0] += wr_ * bf2f(pr[r].x & 0xffffu); acc8[1] += wr_ * bf2f(pr[r].x >> 16); acc8[2] += wr_ * bf2f(pr[r].y & 0xffffu); acc8[3] += wr_ * bf2f(pr[r].y >> 16);
                    acc8[4] += wr_ * bf2f(pr[r].z & 0xffffu); acc8[5] += wr_ * bf2f(pr[r].z >> 16); acc8[6] += wr_ * bf2f(pr[r].w & 0xffffu); acc8[7] += wr_ * bf2f(pr[r].w >> 16); }
                const float rW = __builtin_amdgcn_rcpf(W);
                u32x4 o; o.x = cvtpk(acc8[0] * rW, acc8[1] * rW); o.y = cvtpk(acc8[2] * rW, acc8[3] * rW); o.z = cvtpk(acc8[4] * rW, acc8[5] * rW); o.w = cvtpk(acc8[6] * rW, acc8[7] * rW);
                *(u32x4*)(QM + grow * 512 + h * 64 + ch * 8) = o;
            }
            LDS_WAIT(); asm volatile("" ::: "memory");
        }
    }
}
}
#ifndef BENCH_HOT
#define BENCH_HOT 0
#endif
#ifndef BENCH_SUB
#define BENCH_SUB 3
#endif
#ifndef ALIGN_ONE
#define ALIGN_ONE true
#endif
#ifndef ALIGN_BIG
#define ALIGN_BIG true
#endif
#ifndef BENCH_NOEPI
#define BENCH_NOEPI 0
#endif
#ifndef BENCH_AGLU
#define BENCH_AGLU 0
#endif
#ifndef BENCH_KGLU
#define BENCH_KGLU 0
#endif
#ifndef PH_MASK
#define PH_MASK 0xFFF
#endif
#define PH_ON(k) (((PH_MASK) >> (k)) & 1)
constexpr int NPH = 10, PH_FINAL = DEPTH * NPH, PH_TOTAL = PH_FINAL + 1;
struct Args { Ptrs P; int ph_lo, ph_hi, use_bar, sub; };
__global__ void __launch_bounds__(NWAVES * 64, 2) mk_fwd(Args args) {
    extern __shared__ __attribute__((aligned(16))) unsigned char lds[];
    Frame F;
    F.lds = (LAS unsigned char*)lds;
    F.tid = threadIdx.x; F.lane = F.tid & 63; F.wave = __builtin_amdgcn_readfirstlane(F.tid >> 6);
    F.G = gridDim.x; { const int bx = blockIdx.x; F.vcu = (F.G % 8 == 0) ? (bx % 8) * (F.G / 8) + bx / 8 : bx; }
    const Ptrs& P = args.P;
    unsigned char* ws0 = P.ws;
    volatile LAS unsigned* MISC = (volatile LAS unsigned*)(F.lds + MISC_OFF);
    for (int u = F.tid; u < (LDS_BYTES - LDSCTL_OFF) / 4; u += NWAVES * 64) ((LAS unsigned*)(F.lds + LDSCTL_OFF))[u] = 0u;
    __syncthreads();
    XcdBarrier bar; bar.bar = (unsigned*)(ws0 + WS_CTL) + CW_BAR; bar.x = 0; bar.st = nullptr;
    if (args.use_bar) bar = xcd_barrier_post((unsigned*)(ws0 + WS_CTL) + CW_BAR, MISC + 8);
    LAS unsigned char* ring = F.lds + RING_OFF;
    for (int ph = args.ph_lo; ph < args.ph_hi; ++ph) {
#if defined(BENCH_SET)
        const bool bench = ph >= PH_TOTAL; const int l = bench ? DEPTH - 1 : ph / NPH, k = bench ? (ph - PH_TOTAL) % NPH : ph % NPH;
        if (bench && !(((BENCH_SET) >> k) & 1)) continue;
#if defined(BENCH_EMPTY)
        if (bench) { if (ph + 1 < args.ph_hi) xcd_barrier(bar); continue; }
#endif
        const int lc = bench ? DEPTH + (ph - PH_TOTAL) / NPH : l;
#else
        const bool bench = false; const int l = ph / NPH, k = ph % NPH; const int lc = l;
#endif
        unsigned char* ws = ws0; asm volatile("" : "+s"(ws));
        F.tid = threadIdx.x; asm volatile("" : "+v"(F.tid)); F.lane = F.tid & 63;
        int bx = (int)blockIdx.x; asm volatile("" : "+s"(bx));
        if (ph == PH_FINAL && !bench) { if (PH_ON(10)) final_pass(F, P);
        }
        else if (k == 0 && PH_ON(0)) { conv_layer(F, P, l); ssm_mats(F, P, l); if (l == 0) xb_pass(F, P); __syncthreads(); }
        else if (k == 1 && PH_ON(1)) {
            pg8::SrcStd g{(const char*)(ws + WS_XN), (const char*)(ws + WS_WIN), DM, 0}; pg8::StaticOrder So; So.init(T, DIN, F.G, bx);
            pg8::Unit u0; So.next(0, u0); pg8::rinv_build((LAS float*)(F.lds + RINV_OFF), (const float*)(ws + WS_SSQ), u0.pm);
            pg8::EpiInProj E{ws, pg8::RinvTab{(const LAS float*)(F.lds + RINV_OFF)}, (bench && BENCH_NOEPI) ? 1 : 0};
            pg8::gemm_phase<pg8::EpiInProj, pg8::SrcStd, pg8::StaticOrder, ALIGN_BIG>(ring, g, So, E);
        }
        else if (k == 2 && PH_ON(2)) {
            if (args.sub & 1) { pg8::SrcSsm<false> g{(const char*)(ws + WS_U), nullptr, (const char*)(ws + WS_SEND)}; pg8::SsmOrder So{F.G, bx}; pg8::EpiSsmEnd E{(float*)(ws + WS_HEND)};
                pg8::gemm_phase<pg8::EpiSsmEnd, pg8::SrcSsm<false>, pg8::SsmOrder, ALIGN_ONE>(ring, g, So, E); }
            if (args.sub & 2) att::swa_select_phase(F, P, l, lc);
        }
        else if (k == 3 && PH_ON(3)) {
#ifndef NO_CARRY
            if ((bench ? BENCH_SUB : args.sub) & 1) ssm_carry(F, P, l);
#endif
#ifndef NO_MOBA
            if ((bench ? BENCH_SUB : args.sub) & 2) att::moba_gather(F, P, lc);
#endif
        }
        else if (k == 4 && PH_ON(4)) {
            pg8::SrcSsm<true> g{(const char*)(ws + WS_U), (const char*)(ws + WS_HINIT), (const char*)(ws + WS_SMAIN)}; pg8::SsmOrder So{F.G, bx}; pg8::EpiSsmMain E{(bf16*)(ws + WS_YS)};
#ifdef BENCH_NO_SSMMAIN
            if (!bench)
#endif
            pg8::gemm_phase<pg8::EpiSsmMain, pg8::SrcSsm<true>, pg8::SsmOrder, ALIGN_ONE>(ring, g, So, E);
#ifdef BENCH_NO_OWN
            if (!bench)
#endif
#if defined(BENCH_OWN_NOFULL)
            att::moba_own(F, P, lc, bench && (BENCH_OWN_NOFULL & 1), bench && (BENCH_OWN_NOFULL & 2));
#else
            att::moba_own(F, P, lc);
#endif
        }
        else if (k == 5 && PH_ON(5)) {
            pg8::SrcStd g{(const char*)(ws + ((bench && BENCH_AGLU) ? WS_MIXED : WS_YS)), (const char*)(ws + WS_WGLU), (bench && BENCH_KGLU) ? BENCH_KGLU : 512, 0}; pg8::StaticOrder So; So.init(T, 1024, F.G, bx); pg8::EpiGlu E{(bf16*)(ws + WS_A1)};
            pg8::gemm_phase<pg8::EpiGlu, pg8::SrcStd, pg8::StaticOrder, ALIGN_ONE>(ring, g, So, E);
        }
        else if (k == 6 && PH_ON(6)) {
            pg8::SrcMerge g{(const char*)(ws + WS_QA), (const char*)(ws + WS_A1), (const char*)(ws + WS_QM), (const char*)(ws + WS_WMRG)}; pg8::StaticOrder So; So.init(T, DM, F.G, bx);
            pg8::EpiMerge E{(const bf16*)(ws + WS_GATES), (bf16*)(ws + WS_MIXED)};
            pg8::gemm_phase<pg8::EpiMerge, pg8::SrcMerge, pg8::StaticOrder, ALIGN_ONE>(ring, g, So, E);
        }
        else if ((k == 7 || k == 9) && PH_ON(7)) {
            const bool f2 = (k == 9);
            pg8::SrcStd g{(const char*)(ws + (f2 ? WS_H1 : WS_MIXED)), (const char*)(ws + (f2 ? WS_WFF2 : WS_WOUT)), f2 ? DFF : DM, 0}; pg8::StaticOrder So; So.init(T, DM, F.G, bx); float* xd = bench ? (float*)(ws + WS_QA) : P.x;
            pg8::EpiResid E{(!bench && l == 0 && !f2) ? P.x_in : (const float*)xd, xd, (bf16*)(ws + (bench ? WS_KM : WS_XN)), (float*)(ws + WS_SSQ)};
            pg8::gemm_phase<pg8::EpiResid, pg8::SrcStd, pg8::StaticOrder, ALIGN_ONE>(ring, g, So, E);
        }
        else if (k == 8 && PH_ON(8)) {
            pg8::SrcStd g{(const char*)(ws + WS_XN), (const char*)(ws + WS_WFF1), DM, (bench && BENCH_HOT) ? 1 : 0}; pg8::StaticOrder So; So.init(T, DFF, F.G, bx);
            pg8::Unit u0; So.next(0, u0); pg8::rinv_build((LAS float*)(F.lds + RINV_OFF), (const float*)(ws + WS_SSQ), u0.pm);
            pg8::EpiFfn1 E{(bf16*)(ws + WS_H1), pg8::RinvTab{(const LAS float*)(F.lds + RINV_OFF)}, (bench && BENCH_NOEPI) ? 1 : 0};
            pg8::gemm_phase<pg8::EpiFfn1, pg8::SrcStd, pg8::StaticOrder, ALIGN_BIG>(ring, g, So, E);
        }
        if (ph + 1 < args.ph_hi) { if (args.use_bar) xcd_barrier(bar); else __syncthreads(); }
    }
}
extern "C" void kernel_launch(void* const* d_in, const int* in_sizes, int n_in, void* d_out, int out_size, void* d_ws, size_t ws_size, hipStream_t stream) {
    static int grid = 0;
    if (grid == 0) {
        if (n_in != 21 || out_size != T * DM || ws_size < WS_END) { fprintf(stderr, "kernel_launch: unexpected shapes (n_in %d out %d ws %zu)\n", n_in, out_size, ws_size); grid = -1; return; }
        int dev = 0, cus = 0;
        if (hipGetDevice(&dev) != hipSuccess || hipDeviceGetAttribute(&cus, hipDeviceAttributeMultiprocessorCount, dev) != hipSuccess) { grid = -1; return; }
        if (hipFuncSetAttribute((const void*)mk_fwd, hipFuncAttributeMaxDynamicSharedMemorySize, LDS_BYTES) != hipSuccess) { fprintf(stderr, "kernel_launch: hipFuncSetAttribute failed\n"); grid = -1; return; }
        int per_cu = 0;
        if (hipOccupancyMaxActiveBlocksPerMultiprocessor(&per_cu, (const void*)mk_fwd, NWAVES * 64, LDS_BYTES) != hipSuccess || per_cu < 1) { fprintf(stderr, "kernel_launch: occupancy query reports %d workgroups per CU\n", per_cu); (void)hipGetLastError(); }
        grid = cus;
        if (grid != 256) { fprintf(stderr, "kernel_launch: built for a 256-CU device (unit dealing assumes 256 workgroups); found %d CUs; nothing launched\n", cus); grid = -1; return; }
    }
    if (grid < 0) return;
    (void)hipMemsetAsync((char*)d_ws + WS_CTL, 0, CTL_ZERO_BYTES, stream);
    Args a{};
    const float** pp = (const float**)&a.P; for (int i = 0; i < 21; ++i) pp[i] = (const float*)d_in[i];
    a.P.x = (float*)d_out; a.P.ws = (unsigned char*)d_ws;
    #if defined(BENCH_SET)
    a.ph_lo = 0; a.ph_hi = PH_TOTAL + NPH * (BENCH_REPS);
#else
    a.ph_lo = 0; a.ph_hi = PH_TOTAL;
#endif
    a.use_bar = 1; a.sub = 3;
    hipLaunchKernelGGL(mk_fwd, dim3(grid), dim3(NWAVES * 64), LDS_BYTES, stream, a);
}
```

```cpp
#include <hip/hip_runtime.h>
#include <cstdio>
#include <cstdint>

constexpr int NB = 4, S = 4096, T = NB * S, DM = 1024, DEPTH = 4, DIN = 5120, DFF = 4096;
constexpr float LOG2E = 1.4426950408889634f;
constexpr float C2 = 0.125f * LOG2E;
constexpr float NORM_EPS = 1e-6f;
constexpr int SSM_L = 16;
constexpr int SSM_KM = SSM_L * 16 + 128;
constexpr int SSM_KE = SSM_L * 16;
constexpr int NCH = T / SSM_L;

constexpr size_t MiB = 1u << 20;
constexpr size_t WS_CTL = 0, CTL_ZERO_BYTES = 1 * MiB;
constexpr size_t WS_WIN = 1 * MiB, WS_WGLU = 11 * MiB, WS_WMRG = 12 * MiB, WS_WOUT = 15 * MiB, WS_WFF1 = 17 * MiB, WS_WFF2 = 25 * MiB;
constexpr size_t WS_SMAIN = 33 * MiB, WS_SEND = 39 * MiB, WS_KMP = 43 * MiB;
constexpr size_t WS_XN = 44 * MiB;
constexpr size_t WS_QA = 76 * MiB, WS_KA = 92 * MiB, WS_VAT = 96 * MiB, WS_U = 100 * MiB, WS_QM = 116 * MiB, WS_KM = 132 * MiB, WS_VMT = 136 * MiB, WS_GATES = 140 * MiB;
constexpr size_t WS_H1 = 76 * MiB;
constexpr size_t WS_LIST = WS_XN, WS_LSE = WS_XN + 8 * MiB;
constexpr size_t WS_YS = 284 * MiB;
constexpr size_t WS_PART = 236 * MiB;
constexpr size_t WS_A1 = 236 * MiB, WS_MIXED = 252 * MiB, WS_HEND = 284 * MiB, WS_HINIT = 300 * MiB, WS_SSQ = 308 * MiB, WS_END = 309 * MiB;

typedef unsigned short bf16;
typedef short bf16x8 __attribute__((ext_vector_type(8)));
typedef short s16x4 __attribute__((ext_vector_type(4)));
typedef float f32x4 __attribute__((ext_vector_type(4)));
typedef float f32x16 __attribute__((ext_vector_type(16)));
typedef unsigned u32x4 __attribute__((ext_vector_type(4)));
typedef unsigned u32x2 __attribute__((ext_vector_type(2)));

__host__ __device__ __forceinline__ unsigned f2bf(float f) { unsigned u = __builtin_bit_cast(unsigned, f); return (u + 0x7fffu + ((u >> 16) & 1u)) >> 16; }
__host__ __device__ __forceinline__ float bf2f(unsigned b) { return __builtin_bit_cast(float, b << 16); }
typedef float f32x2_t __attribute__((ext_vector_type(2))); typedef __bf16 bf16x2_t __attribute__((ext_vector_type(2)));
__device__ __forceinline__ unsigned cvtpk_s(float lo, float hi) { f32x2_t v = {lo, hi}; bf16x2_t b = __builtin_convertvector(v, bf16x2_t); return __builtin_bit_cast(unsigned, b); }
__device__ __forceinline__ unsigned pk2(float lo, float hi) { return f2bf(lo) | (f2bf(hi) << 16); }
__device__ __forceinline__ float rbf(float f) { return bf2f(f2bf(f)); }
__device__ __forceinline__ float sigmoid_fast(float x) { return __builtin_amdgcn_rcpf(1.f + __builtin_amdgcn_exp2f(-x * LOG2E)); }
__device__ __forceinline__ float gelu_tanh(float x) {
    const float c2 = 2.f * 0.7978845608028654f; const float t = c2 * (x + 0.044715f * x * x * x); return x * sigmoid_fast(t); }
__device__ __forceinline__ float wave_sum(float v) {
#pragma unroll
    for (int o = 1; o < 64; o <<= 1) v += __shfl_xor(v, o);
    return v;
}
__device__ __forceinline__ float wave_max(float v) {
#pragma unroll
    for (int o = 1; o < 64; o <<= 1) v = fmaxf(v, __shfl_xor(v, o));
    return v;
}

struct Ptrs {
    const float *x_in, *norm_mix, *w_in, *sinks, *lam_re, *lam_im, *log_step, *b_re, *b_im, *c_re, *c_im, *d_skip, *w_glu, *w_o_swa, *w_o_ssm, *w_o_moba, *w_out, *norm_ffn, *w_ff1, *w_ff2, *norm_final;
    float* x;
    unsigned char* ws;
};
typedef const __attribute__((address_space(4))) Ptrs* KP;
namespace pg8 {
#define PG8_LAS __attribute__((address_space(3)))
constexpr int BM = 256, BK = 64, HALF = 128, HTB = HALF * BK * 2  , STAGE_BYTES = 8 * HTB, NXCD = 8, WGM = 8;

__host__ __device__ __forceinline__ int lds_byte(int r, int c) { const int st = (r >> 4) * 2 + (c >> 5), rr = r & 15, cc = c & 31, ob = rr * 64 + cc * 2; return st * 1024 + (ob ^ (((ob >> 9) & 1) << 5)); }
__host__ __device__ __forceinline__ void stage_rc(int b, int& R, int& C) { const int st = b / 1024, sb = b % 1024, swz = sb ^ (((sb >> 9) & 1) << 5); R = (st >> 1) * 16 + swz / 64; C = (st & 1) * 32 + (swz % 64) / 2; }
__host__ __device__ __forceinline__ int perm32(int rho) { const int n = rho >> 4, i = rho & 15; return 8 * (i >> 2) + 4 * n + (i & 3); }

struct Unit { int pm, pn; };

struct StaticOrder {
    int nM, nN, nwg, G, c;
    __host__ __device__ void init(int M, int N, int G_, int c_) { nM = M / BM; nN = N / BM; nwg = nM * nN; G = G_; c = c_; }
    __host__ __device__ bool next(int i, Unit& u) const {
        const long L = (long)i * G + c; if (L >= nwg) return false;
        int wgid = (int)L; { const int q = nwg / NXCD, r = nwg % NXCD, xcd = wgid % NXCD, off = wgid / NXCD; wgid = (xcd < r ? xcd * (q + 1) : r * (q + 1) + (xcd - r) * q) + off; }
        const int nig = WGM * nN, gid = wgid / nig, fm = gid * WGM, gsz = (nM - fm) < WGM ? (nM - fm) : WGM;
        u.pm = fm + ((wgid % nig) % gsz); u.pn = (wgid % nig) / gsz; return true;
    }
};
struct OneUnit { int pm, pn; __host__ __device__ bool next(int i, Unit& u) const { if (i) return false; u.pm = pm; u.pn = pn; return true; } };
struct SsmOrder {
    int G, c;
    __host__ __device__ bool next(int i, Unit& u) const { const int L = i * G + c; if (L >= 128) return false; u.pn = L >> 2; u.pm = L & 3; return true; }
};

struct SrcStd {
    static constexpr bool TWO_VAR = false;
    const char* A; const char* Bt; int K; int hot;
    __device__ __forceinline__ int nt() const { return K / BK; }
    __device__ __forceinline__ const char* a(const Unit& u, int kt, int h) const { return A + ((size_t)((hot ? 0 : u.pm) * BM + h * HALF) * K + (size_t)kt * BK) * 2; }
    __device__ __forceinline__ const char* b(const Unit& u, int kt, int h) const { return Bt + ((size_t)((hot ? 0 : u.pn) * BM + h * HALF) * K + (size_t)kt * BK) * 2; }
    __device__ __forceinline__ unsigned voffA(int R, int C, int) const { return (unsigned)(R * K + C) * 2u; }
    __device__ __forceinline__ unsigned voffB(int R, int C) const { return (unsigned)(R * K + C) * 2u; }
    __device__ __forceinline__ int avar(int) const { return 0; }
};
struct SrcMerge {
    static constexpr bool TWO_VAR = false;
    const char* A0; const char* A1; const char* A2; const char* Bt;
    __device__ __forceinline__ int nt() const { return 24; }
    __device__ __forceinline__ const char* a(const Unit& u, int kt, int h) const { const int sg = kt >> 3; const char* p = sg == 0 ? A0 : (sg == 1 ? A1 : A2); return p + ((size_t)(u.pm * BM + h * HALF) * 512 + (size_t)(kt & 7) * BK) * 2; }
    __device__ __forceinline__ const char* b(const Unit& u, int kt, int h) const { return Bt + ((size_t)(u.pn * BM + h * HALF) * 1536 + (size_t)kt * BK) * 2; }
    __device__ __forceinline__ unsigned voffA(int R, int C, int) const { return (unsigned)(R * 512 + C) * 2u; }
    __device__ __forceinline__ unsigned voffB(int R, int C) const { return (unsigned)(R * 1536 + C) * 2u; }
    __device__ __forceinline__ int avar(int) const { return 0; }
};
template <bool MAIN> struct SrcSsm {
    static constexpr bool TWO_VAR = MAIN; static constexpr int KTOT = MAIN ? SSM_KM : SSM_KE;
    const char* U; const char* HI; const char* Bt;
    __device__ __forceinline__ int nt() const { return KTOT / BK; }
    __device__ __forceinline__ const char* a(const Unit& u, int kt, int h) const {
        if (!MAIN || kt < 4) return U + ((size_t)(u.pn * NCH + u.pm * BM + h * HALF) * 256 + (size_t)kt * BK) * 2;
        return HI + ((size_t)(u.pn * NCH + u.pm * BM + h * HALF) * 128 + (size_t)(kt - 4) * BK) * 2; }
    __device__ __forceinline__ const char* b(const Unit& u, int kt, int h) const { return Bt + ((size_t)(u.pn * 256 + h * HALF) * KTOT + (size_t)kt * BK) * 2; }
    __device__ __forceinline__ unsigned voffA(int R, int C, int var) const { return var ? (unsigned)(R * 128 + C) * 2u : (unsigned)(R * 256 + C) * 2u; }
    __device__ __forceinline__ unsigned voffB(int R, int C) const { return (unsigned)(R * KTOT + C) * 2u; }
    __device__ __forceinline__ int avar(int kt) const { return (MAIN && kt >= 4) ? 1 : 0; }
};

typedef f32x4 Acc[2][2][4][2];
__device__ __forceinline__ unsigned cvt_pk_bf16(float lo, float hi) { return cvtpk_s(lo, hi); }
__device__ __forceinline__ u32x4 pack8(f32x4 v0, f32x4 v1) { u32x4 w; w.x = cvt_pk_bf16(v0[0], v0[1]); w.y = cvt_pk_bf16(v0[2], v0[3]); w.z = cvt_pk_bf16(v1[0], v1[1]); w.w = cvt_pk_bf16(v1[2], v1[3]); return w; }
__device__ __forceinline__ f32x4 sig4(f32x4 v) { f32x4 o; o[0] = sigmoid_fast(v[0]); o[1] = sigmoid_fast(v[1]); o[2] = sigmoid_fast(v[2]); o[3] = sigmoid_fast(v[3]); return o; }
__device__ __forceinline__ f32x4 unpk_lo(u32x4 w) { f32x4 o; o[0] = bf2f(w.x & 0xffffu); o[1] = bf2f(w.x >> 16); o[2] = bf2f(w.y & 0xffffu); o[3] = bf2f(w.y >> 16); return o; }
__device__ __forceinline__ f32x4 unpk_hi(u32x4 w) { f32x4 o; o[0] = bf2f(w.z & 0xffffu); o[1] = bf2f(w.z >> 16); o[2] = bf2f(w.w & 0xffffu); o[3] = bf2f(w.w >> 16); return o; }
__device__ __forceinline__ f32x4 rcp4(f32x4 v) { f32x4 o; o[0] = __builtin_amdgcn_rcpf(v[0]); o[1] = __builtin_amdgcn_rcpf(v[1]); o[2] = __builtin_amdgcn_rcpf(v[2]); o[3] = __builtin_amdgcn_rcpf(v[3]); return o; }

struct RinvTab { const PG8_LAS float* tab; };
__device__ __forceinline__ void rinv_build(PG8_LAS float* tab, const float* SSQ, int pm0) {
    if (threadIdx.x < 256) { const f32x4* sp = (const f32x4*)(SSQ + (size_t)(pm0 * BM + threadIdx.x) * 16); const f32x4 s = (sp[0] + sp[1]) + (sp[2] + sp[3]); tab[threadIdx.x] = rsqrtf(((s[0] + s[1]) + (s[2] + s[3])) * (1.f / DM) + NORM_EPS); }
    __syncthreads();
}
template <int MODE> __device__ __forceinline__ void st_half_bf16(const Acc& acc, int bj, bf16* base, int ldc, float sc, const PG8_LAS float* ri = nullptr  ) {
    bf16* p = base;
#pragma unroll
    for (int ai = 0; ai < 2; ++ai) {
#pragma unroll
        for (int m = 0; m < 4; ++m) { f32x4 v0 = acc[ai][bj][m][0], v1 = acc[ai][bj][m][1];
            if (ri) { const float rs = ri[ai * HALF + m * 16]; v0 = v0 * rs; v1 = v1 * rs; }
            if (MODE == 0) { v0 = v0 * sc; v1 = v1 * sc; }
            else if (MODE == 1) { v0 = sig4(v0); v1 = sig4(v1); }
            else if (MODE == 2) { v0 = __builtin_elementwise_max(v0, (f32x4){0.f, 0.f, 0.f, 0.f}); v1 = __builtin_elementwise_max(v1, (f32x4){0.f, 0.f, 0.f, 0.f}); v0 = v0 * v0; v1 = v1 * v1; }
            else { v0[0] = gelu_tanh(v0[0]); v0[1] = gelu_tanh(v0[1]); v0[2] = gelu_tanh(v0[2]); v0[3] = gelu_tanh(v0[3]); v1[0] = gelu_tanh(v1[0]); v1[1] = gelu_tanh(v1[1]); v1[2] = gelu_tanh(v1[2]); v1[3] = gelu_tanh(v1[3]); }
            *(u32x4*)p = pack8(v0, v1); asm volatile("" : "+v"(p)); p += (size_t)16 * ldc; }
        p += (size_t)(HALF - 64) * ldc; }
}
__device__ __forceinline__ void st_half_vt(const Acc& acc, int bj, bf16* VT, int b, int s0, int cc, const PG8_LAS float* ri) {
    bf16* p = VT + ((size_t)(b * 2 + (cc >> 6)) * 64 + (cc & 63)) * S + s0;
    float rs[2][4];
#pragma unroll
    for (int ai = 0; ai < 2; ++ai)
#pragma unroll
        for (int m = 0; m < 4; ++m) rs[ai][m] = ri[ai * HALF + m * 16];
#pragma unroll
    for (int n = 0; n < 2; ++n)
#pragma unroll
        for (int e = 0; e < 4; ++e) {
#pragma unroll
            for (int ai = 0; ai < 2; ++ai)
#pragma unroll
                for (int m = 0; m < 4; ++m) p[ai * HALF + m * 16] = (bf16)f2bf(acc[ai][bj][m][n][e] * rs[ai][m]);
            asm volatile("" : "+v"(p)); p += S; }
}

struct EpiInProj {
    static constexpr bool PERM = true, AFTER_DRAIN = false, HAS_MID = false;
    unsigned char* ws; RinvTab RT; int skip;
    __device__ __forceinline__ void operator()(const Acc& acc, const Unit& u, int wr, int wc, int fr, int fq) const {
        if (skip) return;
        bf16 *QA = (bf16*)(ws + WS_QA), *KA = (bf16*)(ws + WS_KA), *VAT = (bf16*)(ws + WS_VAT), *U = (bf16*)(ws + WS_U), *QM = (bf16*)(ws + WS_QM), *KM = (bf16*)(ws + WS_KM), *VMT = (bf16*)(ws + WS_VMT), *GATES = (bf16*)(ws + WS_GATES); float* KMP = (float*)(ws + WS_KMP);
        const int row = u.pm * BM + wr * 64 + fr, cc = wc * 32 + 8 * fq;
        const PG8_LAS float* ri = RT.tab + wr * 64 + fr;
#pragma unroll
        for (int bj = 0; bj < 2; ++bj) {
            const int hc = u.pn * 2 + bj;
            if (hc < 4) st_half_bf16<0>(acc, bj, QA + (size_t)row * 512 + hc * 128 + cc, 512, C2, ri);
            else if (hc == 4) st_half_bf16<0>(acc, bj, KA + (size_t)row * 128 + cc, 128, 1.f, ri);
            else if (hc == 5) st_half_vt(acc, bj, VAT, row / S, row % S, cc, ri);
            else if (hc < 10) { const int ucol = (hc - 6) * 128 + cc;
                st_half_bf16<0>(acc, bj, U + ((size_t)(ucol >> 4) * NCH + ((u.pm * BM + wr * 64) >> 4)) * 256 + fr * 16 + (ucol & 15), 16, 1.f, ri); }
            else if (hc < 14) st_half_bf16<0>(acc, bj, QM + (size_t)row * 512 + (hc - 10) * 128 + cc, 512, C2, ri);
            else if (hc == 14) {
                st_half_bf16<0>(acc, bj, KM + (size_t)row * 128 + cc, 128, 1.f, ri);
                f32x4 c0 = {0.f, 0.f, 0.f, 0.f}, c1 = {0.f, 0.f, 0.f, 0.f};
#pragma unroll
                for (int ai = 0; ai < 2; ++ai)
#pragma unroll
                    for (int m = 0; m < 4; ++m) { const float rs = ri[ai * HALF + m * 16]; c0 += acc[ai][bj][m][0] * rs; c1 += acc[ai][bj][m][1] * rs; }
#pragma unroll
                for (int o = 1; o < 16; o <<= 1)
#pragma unroll
                    for (int e = 0; e < 4; ++e) { c0[e] += __shfl_xor(c0[e], o); c1[e] += __shfl_xor(c1[e], o); }
                if (fr == 0) { float* kp = KMP + (size_t)(wr * 64 + u.pm) * 128 + cc; *(f32x4*)kp = c0; *(f32x4*)(kp + 4) = c1; }
            }
            else if (hc == 15) st_half_vt(acc, bj, VMT, row / S, row % S, cc, ri);
            else st_half_bf16<1>(acc, bj, GATES + (size_t)row * 3072 + (hc - 16) * 128 + cc, 3072, 1.f, ri);
        }
    }
};
struct EpiFfn1 {
    static constexpr bool PERM = true, AFTER_DRAIN = false, HAS_MID = false;
    bf16* H1; RinvTab RT; int skip;
    __device__ __forceinline__ void operator()(const Acc& acc, const Unit& u, int wr, int wc, int fr, int fq) const {
        if (skip) return;
        bf16* base = H1 + (size_t)(u.pm * BM + wr * 64 + fr) * DFF + u.pn * BM + wc * 32 + 8 * fq;
        const PG8_LAS float* ri = RT.tab + wr * 64 + fr;
        st_half_bf16<2>(acc, 0, base, DFF, 1.f, ri); st_half_bf16<2>(acc, 1, base + HALF, DFF, 1.f, ri);
    }
};
struct EpiGlu {
    static constexpr bool PERM = true, AFTER_DRAIN = false, HAS_MID = false;
    bf16* A1;
    __device__ __forceinline__ void operator()(const Acc& acc, const Unit& u, int wr, int wc, int fr, int fq) const {
        bf16* base = A1 + (size_t)(u.pm * BM + wr * 64 + fr) * 512 + u.pn * 128 + wc * 32 + 8 * fq;
#pragma unroll
        for (int ai = 0; ai < 2; ++ai)
#pragma unroll
            for (int m = 0; m < 4; ++m) *(u32x4*)(base + (size_t)(ai * HALF + m * 16) * 512) = pack8(acc[ai][0][m][0] * sig4(acc[ai][1][m][0]), acc[ai][0][m][1] * sig4(acc[ai][1][m][1]));
    }
};
struct EpiMerge {
    static constexpr bool PERM = true, AFTER_DRAIN = false, HAS_MID = true;
    const bf16* GATES; bf16* MIXED;
    __device__ __forceinline__ void mid(Acc& acc, const Unit& u, int t, int wr, int wc, int fr, int fq) const {
        if (t != 8 && t != 16) return;
        const bf16* g = GATES + (size_t)(u.pm * BM + wr * 64 + fr) * 3072 + (t == 8 ? 0 : 1024) + u.pn * BM + wc * 32 + 8 * fq;
#pragma unroll
        for (int ai = 0; ai < 2; ++ai)
#pragma unroll
            for (int m = 0; m < 4; ++m)
#pragma unroll
                for (int bj = 0; bj < 2; ++bj) { const bf16* gp = g + (size_t)(ai * HALF + m * 16) * 3072 + bj * HALF; const u32x4 num = *(const u32x4*)gp, den = *(const u32x4*)(gp + 1024);
                    acc[ai][bj][m][0] = acc[ai][bj][m][0] * (unpk_lo(num) * rcp4(unpk_lo(den))); acc[ai][bj][m][1] = acc[ai][bj][m][1] * (unpk_hi(num) * rcp4(unpk_hi(den))); }
    }
    __device__ __forceinline__ void operator()(const Acc& acc, const Unit& u, int wr, int wc, int fr, int fq) const {
        const size_t ro = (size_t)(u.pm * BM + wr * 64 + fr); const int co = u.pn * BM + wc * 32 + 8 * fq;
#pragma unroll
        for (int ai = 0; ai < 2; ++ai)
#pragma unroll
            for (int m = 0; m < 4; ++m)
#pragma unroll
                for (int bj = 0; bj < 2; ++bj) { const size_t r = ro + ai * HALF + m * 16; const u32x4 g2 = *(const u32x4*)(GATES + r * 3072 + 2048 + co + bj * HALF);
                    *(u32x4*)(MIXED + r * DM + co + bj * HALF) = pack8(acc[ai][bj][m][0] * unpk_lo(g2), acc[ai][bj][m][1] * unpk_hi(g2)); }
    }
};
struct EpiResid {
    static constexpr bool PERM = false, AFTER_DRAIN = false, HAS_MID = false;
    const float* XS; float* X; bf16* XB; float* SSQ;
    __device__ __forceinline__ void operator()(const Acc& acc, const Unit& u, int wr, int wc, int fr, int fq) const {
        const size_t row0 = (size_t)(u.pm * BM + wr * 64 + fr); const int col0 = u.pn * BM + wc * 32 + 4 * fq;
#pragma unroll
        for (int ai = 0; ai < 2; ++ai)
#pragma unroll
            for (int m = 0; m < 4; ++m) { const size_t r = row0 + ai * HALF + m * 16; float ss = 0.f;
#pragma unroll
                for (int bj = 0; bj < 2; ++bj)
#pragma unroll
                    for (int n = 0; n < 2; ++n) { const size_t o_ = r * DM + col0 + bj * HALF + n * 16; const f32x4 v = *(const f32x4*)(XS + o_) + acc[ai][bj][m][n]; *(f32x4*)(X + o_) = v;
                        ss += (v[0] * v[0] + v[1] * v[1]) + (v[2] * v[2] + v[3] * v[3]);
                        u32x2 w; w.x = cvt_pk_bf16(v[0], v[1]); w.y = cvt_pk_bf16(v[2], v[3]); *(u32x2*)(XB + r * DM + col0 + bj * HALF + n * 16) = w; }
                ss += __shfl_xor(ss, 16); ss += __shfl_xor(ss, 32);
                if (fq == 0) SSQ[r * 16 + u.pn * 4 + wc] = ss; }
    }
};
struct EpiSsmEnd {
    static constexpr bool PERM = false, AFTER_DRAIN = false, HAS_MID = false;
    float* HEND;
    __device__ __forceinline__ void operator()(const Acc& acc, const Unit& u, int wr, int wc, int fr, int fq) const {
        float* base = HEND + ((size_t)u.pn * NCH + u.pm * BM + wr * 64 + fr) * 128 + wc * 32 + 4 * fq;
#pragma unroll
        for (int ai = 0; ai < 2; ++ai)
#pragma unroll
            for (int m = 0; m < 4; ++m)
#pragma unroll
                for (int n = 0; n < 2; ++n) *(f32x4*)(base + (size_t)(ai * HALF + m * 16) * 128 + n * 16) = acc[ai][0][m][n];
    }
};
struct EpiSsmMain {
    static constexpr bool PERM = true, AFTER_DRAIN = false, HAS_MID = false;
    bf16* YS;
    __device__ __forceinline__ void operator()(const Acc& acc, const Unit& u, int wr, int wc, int fr, int fq) const {
        const int mrow = u.pm * BM + wr * 64 + fr;
#pragma unroll
        for (int bj = 0; bj < 2; ++bj) { const int s = 8 * bj + 2 * wc + (fq >> 1);
            bf16* base = YS + ((size_t)mrow * 16 + s) * 512 + u.pn * 16 + 8 * (fq & 1);
            st_half_bf16<3>(acc, bj, base, 16 * 512, 1.f); }
    }
};

template <class Epi, class Src, class Sched, bool ALIGN_EPI>
__device__ __forceinline__ void gemm_phase(PG8_LAS unsigned char* lds, const Src g, const Sched& S, const Epi& E) {
    int tid_ = threadIdx.x; asm volatile("" : "+v"(tid_));
    const int tid = tid_, wid = __builtin_amdgcn_readfirstlane(tid >> 6), lane = tid & 63, wr = wid >> 2, wc = wid & 3, fr = lane & 15, fq = lane >> 4;
    const int nt = g.nt();
    unsigned voffA[2], voffA2[2], voffB[2];
#pragma unroll
    for (int i = 0; i < 2; ++i) { int R, C; stage_rc(tid * 16 + i * 8192, R, C); const int Rb = Epi::PERM ? ((R & ~31) + perm32(R & 31)) : R;
        voffA[i] = g.voffA(R, C, 0); voffA2[i] = Src::TWO_VAR ? g.voffA(R, C, 1) : 0u; voffB[i] = g.voffB(Rb, C); }
    const unsigned ldsw = (unsigned)wid * 1024u;
    const int aoff = lds_byte(wr * 64 + fr, fq * 8), boff = lds_byte(wc * 32 + fr, fq * 8);
#define PG8_SA(b, h) (((b) * 2 + (h)) * HTB)
#define PG8_SB(b, h) ((4 + (b) * 2 + (h)) * HTB)
#define PG8_STAGE_B(bufoff, gbase) do { _Pragma("unroll") for (int _i = 0; _i < 2; ++_i) \
        __builtin_amdgcn_global_load_lds((const unsigned*)((const char*)(gbase) + voffB[_i]), (PG8_LAS unsigned*)(lds + (bufoff) + ldsw + _i * 8192), 16, 0, 0); } while (0)
#define PG8_STAGE_A(bufoff, gbase, kt) do { const bool _v = Src::TWO_VAR && g.avar(kt); _Pragma("unroll") for (int _i = 0; _i < 2; ++_i) { const unsigned _o = _v ? voffA2[_i] : voffA[_i]; \
        __builtin_amdgcn_global_load_lds((const unsigned*)((const char*)(gbase) + _o), (PG8_LAS unsigned*)(lds + (bufoff) + ldsw + _i * 8192), 16, 0, 0); } } while (0)
#define PG8_LDA(dst, b, h) do { _Pragma("unroll") for (int m = 0; m < 4; ++m) _Pragma("unroll") for (int k = 0; k < 2; ++k) dst[m][k] = *(const PG8_LAS bf16x8*)(lds + PG8_SA(b, h) + aoff + m * 2048 + k * 1024); } while (0)
#define PG8_LDB(dst, b, h) do { _Pragma("unroll") for (int n = 0; n < 2; ++n) _Pragma("unroll") for (int k = 0; k < 2; ++k) dst[n][k] = *(const PG8_LAS bf16x8*)(lds + PG8_SB(b, h) + boff + n * 2048 + k * 1024); } while (0)
#define PG8_MMA(ai, bj, At, Bt) do { __builtin_amdgcn_s_setprio(1); _Pragma("unroll") for (int m = 0; m < 4; ++m) _Pragma("unroll") for (int n = 0; n < 2; ++n) _Pragma("unroll") for (int k = 0; k < 2; ++k) \
        acc[ai][bj][m][n] = __builtin_amdgcn_mfma_f32_16x16x32_bf16(Bt[n][k], At[m][k], acc[ai][bj][m][n], 0, 0, 0); __builtin_amdgcn_s_setprio(0); } while (0)
#define PG8_WAIT_V(n) asm volatile("s_waitcnt vmcnt(" #n ")" ::: "memory")
#define PG8_WAIT_L(n) asm volatile("s_waitcnt lgkmcnt(" #n ")" ::: "memory")
#define PG8_BAR __builtin_amdgcn_s_barrier()
#define PG8_SCHED __builtin_amdgcn_sched_barrier(0)
    Unit cur, nxt; int ui = 0;
    if (!S.next(0, cur)) return;
    Acc acc;
#pragma unroll
    for (int a = 0; a < 2; ++a)
#pragma unroll
        for (int b = 0; b < 2; ++b)
#pragma unroll
            for (int m = 0; m < 4; ++m)
#pragma unroll
                for (int n = 0; n < 2; ++n) acc[a][b][m][n] = (f32x4){0.f, 0.f, 0.f, 0.f};
    bf16x8 At[4][2], B0[2][2], B1[2][2];
    PG8_STAGE_B(PG8_SB(0, 0), g.b(cur, 0, 0)); PG8_STAGE_B(PG8_SB(0, 1), g.b(cur, 0, 1)); PG8_STAGE_A(PG8_SA(0, 0), g.a(cur, 0, 0), 0); PG8_STAGE_A(PG8_SA(0, 1), g.a(cur, 0, 1), 0);
    if (wr == 1) PG8_BAR;
    PG8_WAIT_V(2); PG8_BAR;
    PG8_STAGE_B(PG8_SB(1, 0), g.b(cur, 1, 0)); PG8_STAGE_A(PG8_SA(1, 0), g.a(cur, 1, 0), 1); PG8_STAGE_B(PG8_SB(1, 1), g.b(cur, 1, 1));
    PG8_WAIT_V(6); PG8_BAR;
    for (;;) {
        const bool has_next = S.next(ui + 1, nxt);
        const Unit nu = has_next ? nxt : cur;
        for (int t = 0; t < nt; t += 2) {
            const bool last = (t == nt - 2);
            if constexpr (Epi::HAS_MID) E.mid(acc, cur, t, wr, wc, fr, fq);
            const Unit u2 = last ? nu : cur; const int k2 = last ? 0 : t + 2, k3 = k2 + 1;
            PG8_LDB(B0, 0, 0); PG8_LDB(B1, 0, 1); PG8_SCHED; PG8_LDA(At, 0, 0); PG8_STAGE_A(PG8_SA(1, 1), g.a(cur, t + 1, 1), t + 1);
            PG8_WAIT_V(8); PG8_WAIT_L(0); PG8_BAR; PG8_MMA(0, 0, At, B0); PG8_MMA(0, 1, At, B1); PG8_BAR; PG8_SCHED;
            PG8_LDA(At, 0, 1); PG8_STAGE_B(PG8_SB(0, 0), g.b(u2, k2, 0)); PG8_STAGE_B(PG8_SB(0, 1), g.b(u2, k2, 1)); PG8_STAGE_A(PG8_SA(0, 0), g.a(u2, k2, 0), k2);
            PG8_WAIT_V(8); PG8_WAIT_L(0); PG8_BAR; PG8_MMA(1, 0, At, B0); PG8_MMA(1, 1, At, B1); PG8_BAR; PG8_SCHED;
            PG8_LDB(B0, 1, 0); PG8_LDB(B1, 1, 1); PG8_SCHED; PG8_LDA(At, 1, 0); PG8_STAGE_A(PG8_SA(0, 1), g.a(u2, k2, 1), k2);
            PG8_WAIT_V(8); PG8_WAIT_L(0); PG8_BAR; PG8_MMA(0, 0, At, B0); PG8_MMA(0, 1, At, B1); PG8_BAR; PG8_SCHED;
            PG8_LDA(At, 1, 1); PG8_STAGE_B(PG8_SB(1, 0), g.b(u2, k3, 0)); PG8_STAGE_B(PG8_SB(1, 1), g.b(u2, k3, 1)); PG8_STAGE_A(PG8_SA(1, 0), g.a(u2, k3, 0), k3);
            PG8_WAIT_V(8); PG8_WAIT_L(0); PG8_BAR; PG8_MMA(1, 0, At, B0); PG8_MMA(1, 1, At, B1); PG8_BAR; PG8_SCHED;
        }
        if constexpr (ALIGN_EPI) { if (wr == 0) PG8_BAR; }
        { int fr_ = fr, fq_ = fq; asm volatile("" : "+v"(fr_), "+v"(fq_));
          E(acc, cur, wr, wc, fr_, fq_); }
        if (!has_next) break;
#pragma unroll
        for (int a = 0; a < 2; ++a)
#pragma unroll
            for (int b = 0; b < 2; ++b)
#pragma unroll
                for (int m = 0; m < 4; ++m)
#pragma unroll
                    for (int n = 0; n < 2; ++n) acc[a][b][m][n] = (f32x4){0.f, 0.f, 0.f, 0.f};
        cur = nxt; ++ui;
        if constexpr (ALIGN_EPI) { if (wr == 1) PG8_BAR; }
    }
    PG8_WAIT_V(0);
    if constexpr (!ALIGN_EPI) { if (wr == 0) PG8_BAR; }
    PG8_BAR;
#undef PG8_SA
#undef PG8_SB
#undef PG8_STAGE_A
#undef PG8_STAGE_B
#undef PG8_LDA
#undef PG8_LDB
#undef PG8_MMA
#undef PG8_WAIT_V
#undef PG8_WAIT_L
#undef PG8_BAR
#undef PG8_SCHED
}
}
constexpr int NWAVES = 8;
constexpr int RING_OFF = 0, RING_BYTES = 131072;
constexpr int LDSCTL_OFF = RING_BYTES, MISC_OFF = LDSCTL_OFF + 320, RINV_OFF = LDSCTL_OFF + 1024;
constexpr int LDS_BYTES = 147456;
constexpr int CW_TMO = 0, CW_CODE = 1, CW_BAR = 4096, CW_CNT = 16384, CW_OWNQ = 20480, CW_SWAQ = 20544, CW_DONE = 20608;

#define GAS __attribute__((address_space(1)))
#define LAS __attribute__((address_space(3)))
typedef GAS unsigned gu32;
#define RLX_AGENT __ATOMIC_RELAXED, __HIP_MEMORY_SCOPE_AGENT
#define LDS_WAIT() asm volatile("s_waitcnt lgkmcnt(0)" ::: "memory")
#define VM_WAIT() asm volatile("s_waitcnt vmcnt(0)" ::: "memory")

#define XB_TMO      128
#define XB_XCNT(j)  (256  + 64 * (j))
#define XB_XSUB(j)  (1280 + 64 * (j))
#define XB_XGEN(j)  (2304 + 64 * (j))
#define XB_TOP      3328
#define XB_TOPGEN   3392
#define XCD_BAR_WORDS 3456
#define XB_SPIN_CAP (1u << 20)
__device__ __forceinline__ unsigned xb_ld(unsigned* p)              { return __hip_atomic_load(p, __ATOMIC_RELAXED, __HIP_MEMORY_SCOPE_AGENT); }
__device__ __forceinline__ unsigned xb_add(unsigned* p, unsigned v) { return __hip_atomic_fetch_add(p, v, __ATOMIC_RELAXED, __HIP_MEMORY_SCOPE_AGENT); }
__device__ __forceinline__ unsigned xb_xcc_id() { return (unsigned)__builtin_amdgcn_s_getreg((3 << 11) | 20) & 0xFu; }
#define XB_SPIN(cond, bar) do { unsigned _sp = 0; while (cond) { __builtin_amdgcn_s_sleep(1); \
    if ((++_sp & 255u) == 0u) { if (xb_ld(&(bar)[XB_TMO])) break; if (_sp > XB_SPIN_CAP) { atomicAdd(&(bar)[XB_TMO], 1u); break; } } } } while (0)
struct XcdBarrier { unsigned* bar; unsigned x; volatile LAS unsigned* st; };
__device__ __forceinline__ XcdBarrier xcd_barrier_post(unsigned* bar, volatile LAS unsigned* st) {
    XcdBarrier b; b.bar = bar; b.x = xb_xcc_id(); b.st = st;
    if (threadIdx.x == 0) (void)xb_add(&bar[XB_XCNT(b.x)], 1u);
    return b;
}
__device__ __forceinline__ void xcd_barrier_complete(unsigned* bar, unsigned x, unsigned& nloc, unsigned& nx) {
    const unsigned G = gridDim.x * gridDim.y * gridDim.z;
    unsigned sum, cnt, mine, sp = 0u;
    for (;;) {
        sum = 0u; cnt = 0u; mine = 0u;
#pragma unroll
        for (unsigned j = 0; j < 16; ++j) { const unsigned c = xb_ld(&bar[XB_XCNT(j)]); sum += c; cnt += (c > 0u) ? 1u : 0u; mine = (j == x) ? c : mine; }
        if (sum == G) break;
        __builtin_amdgcn_s_sleep(1);
        if ((++sp & 255u) == 0u) { if (xb_ld(&bar[XB_TMO])) break; if (sp > XB_SPIN_CAP) { atomicAdd(&bar[XB_TMO], 1u); break; } }
    }
    nloc = mine > 0u ? mine : 1u; nx = cnt > 0u ? cnt : 1u;
}
__device__ __forceinline__ void xcd_barrier(const XcdBarrier& b) {
    asm volatile("s_waitcnt vmcnt(0)" ::: "memory");
    __syncthreads();
    if (threadIdx.x == 0) {
        unsigned* bar = b.bar;
        __builtin_amdgcn_s_waitcnt(0);
        unsigned nloc = b.st[0], nx = b.st[1];
        if (nloc == 0u) { xcd_barrier_complete(bar, b.x, nloc, nx); b.st[0] = nloc; b.st[1] = nx; }
        const unsigned old = xb_add(&bar[XB_XSUB(b.x)], 1u);
        const unsigned gen = old / nloc;
        if (old + 1u == (gen + 1u) * nloc) {
            __builtin_amdgcn_fence(__ATOMIC_RELEASE, "agent");
            asm volatile("s_waitcnt vmcnt(0)" ::: "memory");
            const unsigned og = xb_add(&bar[XB_TOP], 1u);
            const unsigned tg = og / nx;
            if (og + 1u == (tg + 1u) * nx) xb_add(&bar[XB_TOPGEN], 1u);
            else XB_SPIN(xb_ld(&bar[XB_TOPGEN]) == tg, bar);
            __builtin_amdgcn_fence(__ATOMIC_ACQUIRE, "agent");
            xb_add(&bar[XB_XGEN(b.x)], 1u);
            asm volatile("s_waitcnt vmcnt(0)" ::: "memory");
        } else {
            XB_SPIN(xb_ld(&bar[XB_XGEN(b.x)]) == gen, bar);
            __builtin_amdgcn_fence(__ATOMIC_ACQUIRE, "agent");
            asm volatile("s_waitcnt vmcnt(0)" ::: "memory");
        }
    }
    __syncthreads();
}

struct Frame {
    LAS unsigned char* lds;
    int tid, lane, wave, vcu, G;
};

struct ConvItem { const float* W; const float* gain; bf16* WT; int N, Kdst, k_off, k0, n0, drow0; };
__device__ __forceinline__ bool conv_decode(ConvItem& c, KP P, int l, int it) {
    constexpr int I_IN = 16 * 160, I_GLU = 8 * 32, I_MRG = 3 * 8 * 32, I_OUT = 16 * 32, I_F1 = 16 * 128, I_F2 = 64 * 32;
    constexpr int NITEMS = I_IN + I_GLU + I_MRG + I_OUT + I_F1 + I_F2;
    if (it >= NITEMS) return false;
    unsigned char* ws = P->ws; int r = it; c.gain = nullptr; c.k_off = 0;
    if (r < I_IN) { const int kb = r / 160, nb = r % 160; c.W = P->w_in + (size_t)l * DM * DIN; c.N = DIN; c.gain = P->norm_mix + l * DM; c.WT = (bf16*)(ws + WS_WIN); c.Kdst = DM; c.k0 = 64 * kb; c.n0 = 32 * nb; c.drow0 = 32 * nb; return true; } r -= I_IN;
    if (r < I_GLU) { const int kb = r / 32, nb = r % 32; const int n0 = 32 * nb, v = n0 & 511;
        c.W = P->w_glu + (size_t)l * 512 * 1024; c.N = 1024; c.WT = (bf16*)(ws + WS_WGLU); c.Kdst = 512; c.k0 = 64 * kb; c.n0 = n0; c.drow0 = (v >> 7) * 256 + (n0 >= 512 ? 128 : 0) + (v & 127); return true; } r -= I_GLU;
    if (r < I_MRG) { const int sg = r / 256, q = r % 256, kb = q / 32, nb = q % 32; c.W = (sg == 0 ? P->w_o_swa : (sg == 1 ? P->w_o_ssm : P->w_o_moba)) + (size_t)l * 512 * DM;
        c.N = DM; c.WT = (bf16*)(ws + WS_WMRG); c.Kdst = 1536; c.k_off = 512 * sg; c.k0 = 64 * kb; c.n0 = 32 * nb; c.drow0 = 32 * nb; return true; } r -= I_MRG;
    if (r < I_OUT) { const int kb = r / 32, nb = r % 32; c.W = P->w_out + (size_t)l * DM * DM; c.N = DM; c.WT = (bf16*)(ws + WS_WOUT); c.Kdst = DM; c.k0 = 64 * kb; c.n0 = 32 * nb; c.drow0 = 32 * nb; return true; } r -= I_OUT;
    if (r < I_F1) { const int kb = r / 128, nb = r % 128; c.W = P->w_ff1 + (size_t)l * DM * DFF; c.N = DFF; c.gain = P->norm_ffn + l * DM; c.WT = (bf16*)(ws + WS_WFF1); c.Kdst = DM; c.k0 = 64 * kb; c.n0 = 32 * nb; c.drow0 = 32 * nb; return true; } r -= I_F1;
    { const int kb = r / 32, nb = r % 32; c.W = P->w_ff2 + (size_t)l * DFF * DM; c.N = DM; c.WT = (bf16*)(ws + WS_WFF2); c.Kdst = DFF; c.k0 = 64 * kb; c.n0 = 32 * nb; c.drow0 = 32 * nb; return true; }
}
__device__ __forceinline__ void conv_loads(f32x4 (&wv)[8], const ConvItem& c, int lane) {
#pragma unroll
    for (int i = 0; i < 8; ++i) wv[i] = *(const f32x4*)(c.W + (size_t)(c.k0 + 8 * i + (lane >> 3)) * c.N + c.n0 + 4 * (lane & 7));
}
__device__ __forceinline__ void conv_store(const f32x4 (&wv)[8], const ConvItem& c, LAS float* scr, int lane) {
#pragma unroll
    for (int i = 0; i < 8; ++i) { const int kk = 8 * i + (lane >> 3); const float g = c.gain ? c.gain[c.k0 + kk] : 1.f; LAS float* sp = scr + kk * 33 + 4 * (lane & 7);
        sp[0] = wv[i][0] * g; sp[1] = wv[i][1] * g; sp[2] = wv[i][2] * g; sp[3] = wv[i][3] * g; }
    LDS_WAIT(); asm volatile("" ::: "memory");
    const int cc = lane & 7;
#pragma unroll
    for (int j = 0; j < 4; ++j) { const int n = (lane >> 3) + 8 * j; const LAS float* s = scr + (8 * cc) * 33 + n;
        u32x4 o; o.x = pk2(s[0 * 33], s[1 * 33]); o.y = pk2(s[2 * 33], s[3 * 33]); o.z = pk2(s[4 * 33], s[5 * 33]); o.w = pk2(s[6 * 33], s[7 * 33]);
        *(GAS u32x4*)(c.WT + (size_t)(c.drow0 + n) * c.Kdst + c.k_off + c.k0 + 8 * cc) = o; }
    LDS_WAIT(); asm volatile("" ::: "memory");
}
__device__ __forceinline__ void conv_layer(const Frame& F, KP P, int l) {
    LAS float* scr = (LAS float*)(F.lds + RING_OFF + F.wave * 16384);
    const int gw = F.vcu * NWAVES + F.wave, NGW = F.G * NWAVES;
    f32x4 wa[8], wb[8];
    int it = gw; bool have;
    { ConvItem c; have = conv_decode(c, P, l, it); if (have) conv_loads(wa, c, F.lane); }
#pragma unroll 1
    while (have) {
        bool hn; { ConvItem n; hn = conv_decode(n, P, l, it + NGW); if (hn) conv_loads(wb, n, F.lane); }
        { ConvItem c; conv_decode(c, P, l, it); asm volatile("" ::: "memory"); conv_store(wa, c, scr, F.lane); }
        have = hn; it += NGW;
#pragma unroll
        for (int i = 0; i < 8; ++i) wa[i] = wb[i];
    }
}
__device__ __forceinline__ void ssm_mats(const Frame& F, KP P, int l) {
    __syncthreads();
    LAS float* L = (LAS float*)(F.lds + RING_OFF);
    LAS float* apr = L;
    LAS float* api = L + 17 * 64;
    LAS float* bbr = L + 34 * 64;
    LAS float* bbi = bbr + 1024;
    LAS float* ccr = bbi + 1024;
    LAS float* cci = ccr + 1024;
    LAS float* ktab = cci + 1024;
    for (int wi = F.vcu; wi < 256; wi += F.G) {
        const int g = wi >> 3, part = wi & 7; const int tid = F.tid;
        if (tid < 64) { const int p = tid; const float lr = P->lam_re[l * 2048 + g * 64 + p], li = P->lam_im[l * 2048 + g * 64 + p], dt = expf(P->log_step[l * 32 + g]);
            const float mag = expf(lr * dt), are = mag * cosf(li * dt), aim = mag * sinf(li * dt);
            const float den = lr * lr + li * li, nr = are - 1.f, ni = aim, fre = (nr * lr + ni * li) / den, fim = (ni * lr - nr * li) / den;
            float pr = 1.f, pi = 0.f;
            for (int k = 0; k <= 16; ++k) { apr[k * 64 + p] = pr; api[k * 64 + p] = pi; const float t = pr * are - pi * aim; pi = pr * aim + pi * are; pr = t; }
            for (int h = 0; h < 16; ++h) { const float br = P->b_re[(size_t)l * 32768 + (g * 64 + p) * 16 + h], bi = P->b_im[(size_t)l * 32768 + (g * 64 + p) * 16 + h]; bbr[p * 16 + h] = fre * br - fim * bi; bbi[p * 16 + h] = fre * bi + fim * br; } }
        for (int e = tid; e < 1024; e += 512) { ccr[e] = P->c_re[(size_t)l * 32768 + g * 1024 + e]; cci[e] = P->c_im[(size_t)l * 32768 + g * 1024 + e]; }
        __syncthreads();
        for (int e = tid; e < 512; e += 512) { const int tau = e >> 5, i = 2 * part + ((e >> 4) & 1), j = e & 15; float acc = 0.f;
            for (int p = 0; p < 64; ++p) { const float cr = ccr[i * 64 + p], ci = cci[i * 64 + p], ar = apr[tau * 64 + p], ai = api[tau * 64 + p]; const float er = cr * ar - ci * ai, ei = cr * ai + ci * ar; acc += er * bbr[p * 16 + j] - ei * bbi[p * 16 + j]; }
            if (tau == 0 && i == j) acc += P->d_skip[l * 512 + g * 16 + i];
            ktab[tau * 256 + i * 16 + j] = acc; }
        __syncthreads();
        bf16* BM_ = (bf16*)(P->ws + WS_SMAIN) + (size_t)g * 256 * SSM_KM;
        for (int e = tid; e < 32 * SSM_KM / 2; e += 512) {
            const int rr = e / (SSM_KM / 2), k = (e % (SSM_KM / 2)) * 2, s = rr >> 1, i = 2 * part + (rr & 1), n = s * 16 + i; float v[2];
#pragma unroll
            for (int q = 0; q < 2; ++q) { const int kk = k + q;
                if (kk < 256) { const int sp = kk >> 4, j = kk & 15; v[q] = (sp <= s) ? ktab[(s - sp) * 256 + i * 16 + j] : 0.f; }
                else { const int p = (kk - 256) & 63; const float cr = ccr[i * 64 + p], ci = cci[i * 64 + p], ar = apr[(s + 1) * 64 + p], ai = api[(s + 1) * 64 + p]; v[q] = (kk < 320) ? (cr * ar - ci * ai) : -(cr * ai + ci * ar); } }
            *(GAS unsigned*)(BM_ + (size_t)n * SSM_KM + k) = pk2(v[0], v[1]); }
        bf16* BE_ = (bf16*)(P->ws + WS_SEND) + (size_t)g * 256 * SSM_KE;
        for (int e = tid; e < 32 * SSM_KE / 2; e += 512) {
            const int n = part * 32 + e / (SSM_KE / 2), k = (e % (SSM_KE / 2)) * 2; float v[2];
#pragma unroll
            for (int q = 0; q < 2; ++q) { const int kk = k + q, sp = kk >> 4, j = kk & 15, p = n & 63; const float ar = apr[(15 - sp) * 64 + p], ai = api[(15 - sp) * 64 + p], br = bbr[p * 16 + j], bi = bbi[p * 16 + j];
                v[q] = (n < 64) ? (ar * br - ai * bi) : ((n < 128) ? (ar * bi + ai * br) : 0.f); }
            *(GAS unsigned*)(BE_ + (size_t)n * SSM_KE + k) = pk2(v[0], v[1]); }
        __syncthreads();
    }
}
__device__ __forceinline__ void xb_pass(const Frame& F, KP P) {
    const int gw = F.vcu * NWAVES + F.wave, NGW = F.G * NWAVES;
    bf16* XB = (bf16*)(P->ws + WS_XN); float* SSQ = (float*)(P->ws + WS_SSQ);
    for (int m = gw; m < T; m += NGW) {
        const GAS f32x4* xr = (const GAS f32x4*)(P->x_in + (size_t)m * DM) + F.lane;
        f32x4 v[4]; float s = 0.f;
#pragma unroll
        for (int j = 0; j < 4; ++j) { v[j] = xr[64 * j]; s += (v[j].x * v[j].x + v[j].y * v[j].y) + (v[j].z * v[j].z + v[j].w * v[j].w); }
        s = wave_sum(s);
        GAS unsigned long long* o8 = (GAS unsigned long long*)(XB + (size_t)m * DM) + F.lane;
#pragma unroll
        for (int j = 0; j < 4; ++j) o8[64 * j] = (unsigned long long)pk2(v[j].x, v[j].y) | ((unsigned long long)pk2(v[j].z, v[j].w) << 32);
        if (F.lane < 16) SSQ[(size_t)m * 16 + F.lane] = (F.lane == 0) ? s : 0.f;
    }
}
__device__ __forceinline__ void final_pass(const Frame& F, KP P) {
    const int gw = F.vcu * NWAVES + F.wave, NGW = F.G * NWAVES;
    for (int m = gw; m < T; m += NGW) {
        GAS f32x4* xr = (GAS f32x4*)(P->x + (size_t)m * DM) + F.lane;
        f32x4 v[4]; float s = 0.f;
#pragma unroll
        for (int j = 0; j < 4; ++j) { v[j] = xr[64 * j]; s += (v[j].x * v[j].x + v[j].y * v[j].y) + (v[j].z * v[j].z + v[j].w * v[j].w); }
        const float r = rsqrtf(wave_sum(s) * (1.f / DM) + NORM_EPS);
#pragma unroll
        for (int j = 0; j < 4; ++j) { const f32x4 g = ((const GAS f32x4*)P->norm_final)[F.lane + 64 * j]; xr[64 * j] = v[j] * r * g; }
    }
}
__device__ __forceinline__ void ssm_carry(const Frame& F, KP P, int l) {
    if (F.vcu & 15) return;
    const int gt = (F.vcu >> 4) * 512 + F.tid;
    if (gt >= 32 * NB * 64) return;
    const int p = gt & 63, b = (gt >> 6) & 3, g = gt >> 8;
    const float lr = P->lam_re[l * 2048 + g * 64 + p], li = P->lam_im[l * 2048 + g * 64 + p], dt = expf(P->log_step[l * 32 + g]);
    const float mag = expf(lr * dt), are = mag * cosf(li * dt), aim = mag * sinf(li * dt);
    float pr = 1.f, pi = 0.f;
    for (int k = 0; k < 16; ++k) { const float t = pr * are - pi * aim; pi = pr * aim + pi * are; pr = t; }
    const float* he = (const float*)(P->ws + WS_HEND) + ((size_t)g * NCH + b * 256) * 128 + p;
    bf16* hi = (bf16*)(P->ws + WS_HINIT) + ((size_t)g * NCH + b * 256) * 128 + p;
    float sr = 0.f, si = 0.f;
    float er[8], ei[8];
#pragma unroll
    for (int q = 0; q < 8; ++q) { er[q] = he[(size_t)q * 128]; ei[q] = he[(size_t)q * 128 + 64]; }
    for (int c0 = 0; c0 < 256; c0 += 8) {
        float nr_[8], ni_[8];
        const int cn = (c0 + 8 < 256) ? c0 + 8 : c0;
#pragma unroll
        for (int q = 0; q < 8; ++q) { nr_[q] = he[(size_t)(cn + q) * 128]; ni_[q] = he[(size_t)(cn + q) * 128 + 64]; }
#pragma unroll
        for (int q = 0; q < 8; ++q) { hi[(size_t)(c0 + q) * 128] = (bf16)f2bf(sr); hi[(size_t)(c0 + q) * 128 + 64] = (bf16)f2bf(si);
            const float tr = pr * sr - pi * si + er[q], ti = pr * si + pi * sr + ei[q]; sr = tr; si = ti; }
#pragma unroll
        for (int q = 0; q < 8; ++q) { er[q] = nr_[q]; ei[q] = ni_[q]; }
    }
}
namespace att {
__device__ __forceinline__ int crow(int r, int hi) { return (r & 3) + 8 * (r >> 2) + 4 * hi; }
struct St { f32x16 o0, o1; float m, l; };
__device__ __forceinline__ unsigned cvtpk(float lo, float hi) { return cvtpk_s(lo, hi); }

__device__ __forceinline__ void loadk(bf16x8 (&kf)[8], const bf16* kp) {
#pragma unroll
    for (int d0 = 0; d0 < 4; ++d0) { kf[2 * d0] = *(const bf16x8*)(kp + d0 * 16); kf[2 * d0 + 1] = *(const bf16x8*)(kp + 32 * 128 + d0 * 16); }
}
template <int MODE>
__device__ __forceinline__ void tile(St& st, const bf16x8 (&qr)[4], const bf16x8 (&kf)[8], const bf16* vtp  , int kq  , float sl2, bool rowok, int klo  , int hi) {
    f32x16 p0 = {}, p1 = {};
#pragma unroll
    for (int d0 = 0; d0 < 4; ++d0) { p0 = __builtin_amdgcn_mfma_f32_32x32x16_bf16(kf[2 * d0], qr[d0], p0, 0, 0, 0); p1 = __builtin_amdgcn_mfma_f32_32x32x16_bf16(kf[2 * d0 + 1], qr[d0], p1, 0, 0, 0); }
    s16x4 vl[2][4], vh[2][4];
#pragma unroll
    for (int dh = 0; dh < 2; ++dh)
#pragma unroll
        for (int s = 0; s < 4; ++s) { vl[dh][s] = *(const s16x4*)(vtp + (size_t)dh * 32 * S + 16 * s); vh[dh][s] = *(const s16x4*)(vtp + (size_t)dh * 32 * S + 16 * s + 8); }
    const float base = sl2 * (float)(kq + 4 * hi);
    float mx = -INFINITY;
#pragma unroll
    for (int r = 0; r < 16; ++r) { const int c = (r & 3) + 8 * (r >> 2); const int k0 = kq + 4 * hi + c, k1 = k0 + 32;
        float a = fmaf(sl2, (float)c, p0[r]), b = fmaf(sl2, (float)(c + 32), p1[r]);
        if (MODE == 1) { a = (k0 <= 0 && k0 >= klo) ? a : -INFINITY; b = (k1 <= 0 && k1 >= klo) ? b : -INFINITY; }
        else if (MODE == 2) { a = (k0 <= 0) ? a : -INFINITY; b = (k1 <= 0) ? b : -INFINITY; }
        else if (MODE == 3) { a = (rowok && k0 <= 0) ? a : -INFINITY; b = (rowok && k1 <= 0) ? b : -INFINITY; }
        p0[r] = a; p1[r] = b; mx = fmaxf(mx, fmaxf(a, b)); }
    mx += base;
    mx = fmaxf(mx, __shfl_xor(mx, 32));
    const float mn = fmaxf(st.m, mx), alpha = __builtin_amdgcn_exp2f(st.m - mn), off = base - mn;
    float sum = 0.f;
#pragma unroll
    for (int r = 0; r < 16; ++r) { p0[r] = __builtin_amdgcn_exp2f(p0[r] + off); p1[r] = __builtin_amdgcn_exp2f(p1[r] + off); sum += p0[r] + p1[r]; }
    st.m = mn; st.l = st.l * alpha + sum;
#pragma unroll
    for (int r = 0; r < 16; ++r) { st.o0[r] *= alpha; st.o1[r] *= alpha; }
    bf16x8 pf[4];
#pragma unroll
    for (int s = 0; s < 2; ++s) { u32x4 w0, w1;
        w0.x = cvtpk(p0[8 * s + 0], p0[8 * s + 1]); w0.y = cvtpk(p0[8 * s + 2], p0[8 * s + 3]); w0.z = cvtpk(p0[8 * s + 4], p0[8 * s + 5]); w0.w = cvtpk(p0[8 * s + 6], p0[8 * s + 7]);
        w1.x = cvtpk(p1[8 * s + 0], p1[8 * s + 1]); w1.y = cvtpk(p1[8 * s + 2], p1[8 * s + 3]); w1.z = cvtpk(p1[8 * s + 4], p1[8 * s + 5]); w1.w = cvtpk(p1[8 * s + 6], p1[8 * s + 7]);
        pf[s] = __builtin_bit_cast(bf16x8, w0); pf[2 + s] = __builtin_bit_cast(bf16x8, w1); }
#pragma unroll
    for (int s = 0; s < 4; ++s) {
        const bf16x8 v0 = (bf16x8){vl[0][s][0], vl[0][s][1], vl[0][s][2], vl[0][s][3], vh[0][s][0], vh[0][s][1], vh[0][s][2], vh[0][s][3]};
        const bf16x8 v1 = (bf16x8){vl[1][s][0], vl[1][s][1], vl[1][s][2], vl[1][s][3], vh[1][s][0], vh[1][s][1], vh[1][s][2], vh[1][s][3]};
        st.o0 = __builtin_amdgcn_mfma_f32_32x32x16_bf16(v0, pf[s], st.o0, 0, 0, 0);
        st.o1 = __builtin_amdgcn_mfma_f32_32x32x16_bf16(v1, pf[s], st.o1, 0, 0, 0); }
}
__device__ __forceinline__ void finish(const St& st, bf16* op, int hi) {
    const float lt = st.l + __shfl_xor(st.l, 32), rl = __builtin_amdgcn_rcpf(lt);
#pragma unroll
    for (int g = 0; g < 4; ++g) { u32x2 a, b;
        a.x = cvtpk(st.o0[4 * g] * rl, st.o0[4 * g + 1] * rl); a.y = cvtpk(st.o0[4 * g + 2] * rl, st.o0[4 * g + 3] * rl);
        b.x = cvtpk(st.o1[4 * g] * rl, st.o1[4 * g + 1] * rl); b.y = cvtpk(st.o1[4 * g + 2] * rl, st.o1[4 * g + 3] * rl);
        *(u32x2*)(op + 8 * g + 4 * hi) = a; *(u32x2*)(op + 32 + 8 * g + 4 * hi) = b; }
}
__device__ __forceinline__ void loadq(bf16x8 (&qr)[4], const bf16* qp) {
#pragma unroll
    for (int d0 = 0; d0 < 4; ++d0) qr[d0] = *(const bf16x8*)(qp + d0 * 16);
}

constexpr int IMG_K = 0, IMG_V = 32768, IMG_BYTES = 65536;
__device__ __forceinline__ void img_load(const Frame& F, LAS unsigned char* img, const bf16* K, long krow0, int kvh, const bf16* vt0, int key0) {
    const int lane = F.lane, w = F.wave;
#pragma unroll
    for (int i = 0; i < 4; ++i) { const int piece = w * 4 + i, key = piece * 8 + (lane >> 3), c = (lane & 7) ^ ((key >> 1) & 7); long row = krow0 + key; row = row < 0 ? 0 : row;
        __builtin_amdgcn_global_load_lds((const unsigned*)(K + row * 128 + kvh * 64 + c * 8), (LAS unsigned*)(img + IMG_K + piece * 1024), 16, 0, 0); }
#pragma unroll
    for (int i = 0; i < 4; ++i) { const int piece = w * 4 + i, d = piece * 2 + (lane >> 5), c = (lane & 31) ^ (d & 15); int kk = key0 + c * 8; kk = kk < 0 ? 0 : kk;
        __builtin_amdgcn_global_load_lds((const unsigned*)(vt0 + (long)d * S + kk), (LAS unsigned*)(img + IMG_V + piece * 1024), 16, 0, 0); }
}
struct LaneOff { int k[4]; int v[8]; };
__device__ __forceinline__ void lane_off(LaneOff& lo, int r32, int hi) { const int s7 = (r32 >> 1) & 7, x = r32 & 15;
#pragma unroll
    for (int d0 = 0; d0 < 4; ++d0) lo.k[d0] = ((2 * d0 + hi) ^ s7) << 4;
#pragma unroll
    for (int j = 0; j < 8; ++j) lo.v[j] = (j ^ (x & 7)) << 4; }
template <int MODE, bool HALF, bool AL64>
__device__ __forceinline__ void tile_lds(St& st, const bf16x8 (&qr)[4], const LAS unsigned char* img, const LaneOff& lo, int ko, int kq  , float sl2, bool rowok, int klo, int hi, int r32) {
    const LAS unsigned char* kp = img + IMG_K + (ko + r32) * 128;
    const bool fresh = st.m == -INFINITY; const float ref = fresh ? 0.f : st.m;
    const float cin = sl2 * (float)(kq + 4 * hi) - ref;
    f32x16 p0, p1;
#pragma unroll
    for (int r = 0; r < 16; ++r) { p0[r] = cin; p1[r] = cin; }
    bf16x8 kf[8];
#pragma unroll
    for (int d0 = 0; d0 < 4; ++d0) { kf[2 * d0] = *(const LAS bf16x8*)(kp + lo.k[d0]); if (!HALF) kf[2 * d0 + 1] = *(const LAS bf16x8*)(kp + 32 * 128 + lo.k[d0]); }
    __builtin_amdgcn_sched_barrier(0);
#pragma unroll
    for (int d0 = 0; d0 < 4; ++d0) {
        p0 = __builtin_amdgcn_mfma_f32_32x32x16_bf16(kf[2 * d0], qr[d0], p0, 0, 0, 0);
        if (!HALF) p1 = __builtin_amdgcn_mfma_f32_32x32x16_bf16(kf[2 * d0 + 1], qr[d0], p1, 0, 0, 0); }
    float mx = -INFINITY;
#pragma unroll
    for (int r = 0; r < 16; ++r) { const int c = (r & 3) + 8 * (r >> 2); const int k0 = kq + 4 * hi + c, k1 = k0 + 32;
        float a = fmaf(sl2, (float)c, p0[r]), b = HALF ? -INFINITY : fmaf(sl2, (float)(c + 32), p1[r]);
        if (MODE == 1) { a = (k0 <= 0 && k0 >= klo) ? a : -INFINITY; if (!HALF) b = (k1 <= 0 && k1 >= klo) ? b : -INFINITY; }
        else if (MODE == 2) { a = (k0 <= 0) ? a : -INFINITY; if (!HALF) b = (k1 <= 0) ? b : -INFINITY; }
        else if (MODE == 3) { a = (rowok && k0 <= 0) ? a : -INFINITY; if (!HALF) b = (rowok && k1 <= 0) ? b : -INFINITY; }
        p0[r] = a; if (!HALF) p1[r] = b; mx = fmaxf(mx, HALF ? a : fmaxf(a, b)); }
    mx = fmaxf(mx, __shfl_xor(mx, 32));
    const float delta = fresh ? ((mx == -INFINITY) ? 0.f : mx) : ((mx > 8.f) ? mx : 0.f);
    if (__any(delta != 0.f)) {
        const float alpha = fresh ? 1.f : __builtin_amdgcn_exp2f(-delta);
#pragma unroll
        for (int r = 0; r < 16; ++r) { p0[r] -= delta; if (!HALF) p1[r] -= delta; st.o0[r] *= alpha; st.o1[r] *= alpha; }
        st.l *= alpha;
        st.m = (fresh && mx == -INFINITY) ? -INFINITY : ref + delta;
    }
    float sum = 0.f;
#pragma unroll
    for (int r = 0; r < 16; ++r) { p0[r] = __builtin_amdgcn_exp2f(p0[r]); sum += p0[r]; if (!HALF) { p1[r] = __builtin_amdgcn_exp2f(p1[r]); sum += p1[r]; } }
    st.l += sum;
    const int x = r32 & 15, kc = ko >> 3;
    const LAS unsigned char* vp = img + IMG_V + r32 * 512 + hi * 8 + (AL64 ? ((kc ^ (x & 8)) << 4) : 0);
    constexpr int NS = HALF ? 2 : 4;
    s16x4 va0[NS], va1[NS], vb0[NS], vb1[NS];
#pragma unroll
    for (int s = 0; s < NS; ++s) { const int o0 = AL64 ? lo.v[2 * s] : (((kc + 2 * s) ^ x) << 4), o1 = AL64 ? lo.v[2 * s + 1] : (((kc + 2 * s + 1) ^ x) << 4);
        va0[s] = *(const LAS s16x4*)(vp + o0); va1[s] = *(const LAS s16x4*)(vp + o1); vb0[s] = *(const LAS s16x4*)(vp + 32 * 512 + o0); vb1[s] = *(const LAS s16x4*)(vp + 32 * 512 + o1); }
    __builtin_amdgcn_sched_barrier(0);
#pragma unroll
    for (int s = 0; s < NS; ++s) {
        u32x4 w;
        if (s < 2) { w.x = cvtpk(p0[8 * s + 0], p0[8 * s + 1]); w.y = cvtpk(p0[8 * s + 2], p0[8 * s + 3]); w.z = cvtpk(p0[8 * s + 4], p0[8 * s + 5]); w.w = cvtpk(p0[8 * s + 6], p0[8 * s + 7]); }
        else { w.x = cvtpk(p1[8 * s - 16], p1[8 * s - 15]); w.y = cvtpk(p1[8 * s - 14], p1[8 * s - 13]); w.z = cvtpk(p1[8 * s - 12], p1[8 * s - 11]); w.w = cvtpk(p1[8 * s - 10], p1[8 * s - 9]); }
        const bf16x8 pf = __builtin_bit_cast(bf16x8, w);
        st.o0 = __builtin_amdgcn_mfma_f32_32x32x16_bf16((bf16x8){va0[s][0], va0[s][1], va0[s][2], va0[s][3], va1[s][0], va1[s][1], va1[s][2], va1[s][3]}, pf, st.o0, 0, 0, 0);
        st.o1 = __builtin_amdgcn_mfma_f32_32x32x16_bf16((bf16x8){vb0[s][0], vb0[s][1], vb0[s][2], vb0[s][3], vb1[s][0], vb1[s][1], vb1[s][2], vb1[s][3]}, pf, st.o1, 0, 0, 0); }
}
__device__ __forceinline__ void swa_unit(const Frame& F, KP P, int l, int un) {
    bf16* QA = (bf16*)(P->ws + WS_QA); const bf16* KA = (const bf16*)(P->ws + WS_KA); const bf16* VAT = (const bf16*)(P->ws + WS_VAT);
    const int lane = F.lane, r32 = lane & 31, hi = lane >> 5, w = F.wave;
    LAS unsigned char* img = F.lds + RING_OFF;
    LaneOff lo; lane_off(lo, r32, hi);
    {
        const int bk = un >> 5, nb = un & 31, b = bk >> 1, kvh = bk & 1, h = kvh * 4 + (w >> 1);
        __syncthreads();
        img_load(F, img, KA, (long)b * S + nb * 128 - 128, kvh, VAT + (long)((b * 2 + kvh) * 64) * S, nb * 128 - 128);
        const float sl2 = exp2f(-0.5f * (float)(h + 1)) * LOG2E, sink2 = P->sinks[l * 8 + h] * LOG2E;
        asm volatile("s_waitcnt vmcnt(0)" ::: "memory"); __syncthreads();
        for (int qt = 0; qt < 2; ++qt) {
            const int qo = (w & 1) * 64 + qt * 32, t0 = nb * 128 + qo, q = t0 + r32;
            bf16* qrow = QA + (size_t)(b * S + q) * 512 + h * 64;
            bf16x8 qr[4]; loadq(qr, qrow + 8 * hi);
            St st; st.o0 = f32x16{}; st.o1 = f32x16{}; st.m = sink2; st.l = hi ? 0.f : 1.f;
            const int klo = q < 127 ? -q : -127;
#pragma unroll 1
            for (int kt = 0; kt < 2; ++kt) { if (t0 - 128 + 64 * kt + 63 >= 0) tile_lds<1, false, false>(st, qr, img, lo, qo + 64 * kt, t0 - 128 + 64 * kt - q, sl2, true, klo, hi, r32); }
            tile_lds<1, true, false>(st, qr, img, lo, qo + 128, t0 - q, sl2, true, klo, hi, r32);
            finish(st, qrow, hi);
        }
    }
    __syncthreads();
}
__device__ __forceinline__ float moba_sl2(int h) { return exp2f(-0.5f * (float)(8 + h + 1)) * LOG2E; }
__device__ __forceinline__ void select_unit(const Frame& F, KP P, int l, int un) {
    const bf16* QM = (const bf16*)(P->ws + WS_QM); const float* KMP = (const float*)(P->ws + WS_KMP);
    unsigned* LIST = (unsigned*)(P->ws + WS_LIST); unsigned* CNT = (unsigned*)(P->ws + WS_CTL) + CW_CNT + l * 128;
    LAS float* km = (LAS float*)(F.lds + RING_OFF);
    const int tid = F.tid, lane = F.lane;
    {
        const int bk = un >> 5, ch = un & 31, b = bk >> 1, kvh = bk & 1, j = ch >> 1;
        __syncthreads();
        for (int e = tid; e < 1024; e += 512) { const int n = e >> 6, d = e & 63; const float* k0 = KMP + (size_t)(b * 16 + n) * 128 + kvh * 64 + d; km[e] = k0[0] + k0[64 * 128]; }
        __syncthreads();
        if (j == 0) return;
        const int hg = tid >> 7, t = ch * 128 + (tid & 127);
        const bf16* qp = QM + (size_t)(b * S + t) * 512 + (kvh * 4 + hg) * 64;
        u32x4 qv[8];
#pragma unroll
        for (int i = 0; i < 8; ++i) qv[i] = *(const u32x4*)(qp + 8 * i);
        int i0 = 0, i1 = 1, i2 = 2;
        if (j > 3) {
            float v0 = -INFINITY, v1 = -INFINITY, v2 = -INFINITY; i0 = 0; i1 = 0; i2 = 0;
#pragma unroll 1
            for (int n = 0; n < j; ++n) { float a = 0.f;
#pragma unroll
                for (int i = 0; i < 8; ++i) { const f32x4 x0 = *(const LAS f32x4*)(km + n * 64 + 8 * i), x1 = *(const LAS f32x4*)(km + n * 64 + 8 * i + 4);
                    a += bf2f(qv[i].x & 0xffffu) * x0[0] + bf2f(qv[i].x >> 16) * x0[1] + bf2f(qv[i].y & 0xffffu) * x0[2] + bf2f(qv[i].y >> 16) * x0[3]
                       + bf2f(qv[i].z & 0xffffu) * x1[0] + bf2f(qv[i].z >> 16) * x1[1] + bf2f(qv[i].w & 0xffffu) * x1[2] + bf2f(qv[i].w >> 16) * x1[3]; }
                if (a > v0) { v2 = v1; i2 = i1; v1 = v0; i1 = i0; v0 = a; i0 = n; } else if (a > v1) { v2 = v1; i2 = i1; v1 = a; i1 = n; } else if (a > v2) { v2 = a; i2 = n; } }
        }
        const int nsel = j < 3 ? j : 3;
        unsigned mycnt = 0u;
#pragma unroll 1
        for (int n = 0; n < j; ++n) { const bool sel = (n == i0 && nsel > 0) || (n == i1 && nsel > 1) || (n == i2 && nsel > 2); const unsigned long long mask = __ballot(sel); if (lane == n) mycnt = (unsigned)__popcll(mask); }
        unsigned mybase = 0u;
        if (lane < j && mycnt) mybase = __hip_atomic_fetch_add(CNT + bk * 16 + lane, mycnt, __ATOMIC_RELAXED, __HIP_MEMORY_SCOPE_AGENT);
#pragma unroll 1
        for (int n = 0; n < j; ++n) {
            const int r = (n == i0) ? 0 : ((n == i1) ? 1 : ((n == i2) ? 2 : 3));
            const bool sel = r < nsel;
            const unsigned long long mask = __ballot(sel);
            if (mask == 0ull) continue;
            const unsigned base = (unsigned)__shfl((int)mybase, n);
            const unsigned pos = base + (unsigned)__popcll(mask & ((1ull << lane) - 1ull));
            if (sel) LIST[(size_t)(bk * 16 + n) * 16384 + pos] = ((unsigned)t << 4) | ((unsigned)hg << 2) | (unsigned)r;
        }
    }
    __syncthreads();
}
__device__ __forceinline__ void swa_select_phase(const Frame& F, KP P, int l, int lq) {
    unsigned* qctr = (unsigned*)(P->ws + WS_CTL) + CW_SWAQ + lq;
    volatile LAS unsigned* jobw = (volatile LAS unsigned*)(F.lds + MISC_OFF + 64);
    for (;;) {
        __syncthreads();
        if (F.tid == 0) *jobw = __hip_atomic_fetch_add(qctr, 1u, __ATOMIC_RELAXED, __HIP_MEMORY_SCOPE_AGENT);
        __syncthreads();
        const int job = (int)*jobw;
        if (job >= 512) break;
        if (job < 256) swa_unit(F, P, l, job); else select_unit(F, P, lq, job - 256);
    }
}
__device__ __forceinline__ void store_o(const St& st, bf16* op, float rl, int hi) {
#pragma unroll
    for (int g = 0; g < 4; ++g) { u32x2 a, b;
        a.x = cvtpk(st.o0[4 * g] * rl, st.o0[4 * g + 1] * rl); a.y = cvtpk(st.o0[4 * g + 2] * rl, st.o0[4 * g + 3] * rl);
        b.x = cvtpk(st.o1[4 * g] * rl, st.o1[4 * g + 1] * rl); b.y = cvtpk(st.o1[4 * g + 2] * rl, st.o1[4 * g + 3] * rl);
        *(u32x2*)(op + 8 * g + 4 * hi) = a; *(u32x2*)(op + 32 + 8 * g + 4 * hi) = b; }
}
__device__ __forceinline__ void moba_gather(const Frame& F, KP P, int l, bool nostore = false) {
    const bf16* QM = (const bf16*)(P->ws + WS_QM); const bf16* KM = (const bf16*)(P->ws + WS_KM); const bf16* VMT = (const bf16*)(P->ws + WS_VMT);
    const unsigned* LIST = (const unsigned*)(P->ws + WS_LIST); unsigned* CNT = (unsigned*)(P->ws + WS_CTL) + CW_CNT + l * 128;
    bf16* PART = (bf16*)(P->ws + WS_PART); float* LSE = (float*)(P->ws + WS_LSE);
    const int lane = F.lane, r32 = lane & 31, hi = lane >> 5, w = F.wave;
    const int per = F.G >> 3;
    const int bk = F.vcu / per, loc = F.vcu % per;
    if (bk >= 8 || (F.vcu & 15) == 0) return;
    const int wg = loc - 1 - (loc > 16 ? 1 : 0), nwg = per - 2;
    const int b = bk >> 1, kvh = bk & 1;
    unsigned cnt = 0u;
    if (lane < 16) cnt = __hip_atomic_load(CNT + bk * 16 + lane, __ATOMIC_RELAXED, __HIP_MEMORY_SCOPE_AGENT);
    const int ns_l = (int)((cnt + 255u) >> 8);
    int pre = ns_l;
#pragma unroll
    for (int o = 1; o < 16; o <<= 1) { const int v = __shfl_up(pre, o); if (lane >= o) pre += v; }
    const int total = __shfl(pre, 15);
    const bf16* vt0 = VMT + (long)((b * 2 + kvh) * 64) * S;
    LAS unsigned char* ring = F.lds + RING_OFF;
    LaneOff lo; lane_off(lo, r32, hi);
    __syncthreads();
#define GA_LOCATE(it, n_, s_) do { const unsigned long long le_ = __ballot(lane < 16 && pre <= (it)); n_ = (int)__popcll(le_); s_ = (it) - ((n_ == 0) ? 0 : __shfl(pre, n_ - 1)); } while (0)
#define GA_ENTRY(e_, n_, s_) do { const int cn_ = (int)__shfl((int)cnt, n_), ti_ = (s_) * 8 + w, idx_ = ti_ * 32 + r32; e_ = 0u; if (ti_ * 32 < cn_) e_ = LIST[(size_t)(bk * 16 + n_) * 16384 + (idx_ < cn_ ? idx_ : ti_ * 32)]; } while (0)
#define GA_LOADQ(q_, e_) loadq(q_, QM + ((size_t)(b * S + (int)((e_) >> 4))) * 512 + (kvh * 4 + (int)(((e_) >> 2) & 3u)) * 64 + 8 * hi)
    int item = wg;
    if (item < total) {
        int n0, s0, n1 = 0, s1 = 0, n2 = 0, s2 = 0; unsigned e0, e1 = 0u, e2 = 0u;
        GA_LOCATE(item, n0, s0); GA_ENTRY(e0, n0, s0);
        bool has1 = item + nwg < total; if (has1) { GA_LOCATE(item + nwg, n1, s1); GA_ENTRY(e1, n1, s1); }
        img_load(F, ring, KM, (long)b * S + n0 * 256, kvh, vt0, n0 * 256);
        bf16x8 qn[4]; GA_LOADQ(qn, e0);
        int buf = 0;
#pragma unroll 1
        for (;;) {
            asm volatile("s_waitcnt vmcnt(0)" ::: "memory"); __syncthreads();
            bf16x8 qr[4];
#pragma unroll
            for (int i = 0; i < 4; ++i) qr[i] = qn[i];
            const LAS unsigned char* img = ring + buf * IMG_BYTES;
            if (has1) { img_load(F, ring + (buf ^ 1) * IMG_BYTES, KM, (long)b * S + n1 * 256, kvh, vt0, n1 * 256); GA_LOADQ(qn, e1); }
            const bool has2 = item + 2 * nwg < total; if (has2) { GA_LOCATE(item + 2 * nwg, n2, s2); GA_ENTRY(e2, n2, s2); }
            const int cn = (int)__shfl((int)cnt, n0), ti = s0 * 8 + w; const bool tile_ok = ti * 32 < cn, valid = ti * 32 + r32 < cn;
            if (tile_ok) {
                const int t = (int)(e0 >> 4), hg = (int)((e0 >> 2) & 3u), r = (int)(e0 & 3u), h = kvh * 4 + hg;
                const float sl2 = moba_sl2(h);
                St st; st.o0 = f32x16{}; st.o1 = f32x16{}; st.m = -INFINITY; st.l = 0.f;
                const int kq = n0 * 256 - t;
#pragma unroll 1
                for (int i = 0; i < (nostore ? 1 : 4); ++i) tile_lds<0, false, true>(st, qr, img, lo, 64 * i, kq + 64 * i, sl2, true, 0, hi, r32);
                const float lt = st.l + __shfl_xor(st.l, 32);
                if (valid && !nostore) { const size_t slot = ((size_t)((b * 8 + h) * 3 + r)) * S + t;
                    store_o(st, PART + slot * 64, __builtin_amdgcn_rcpf(lt), hi); if (hi == 0) LSE[slot] = st.m + __builtin_amdgcn_logf(lt); }
            }
            if (!has1) break;
            item += nwg; n0 = n1; s0 = s1; e0 = e1; n1 = n2; s1 = s2; e1 = e2; has1 = has2; buf ^= 1;
        }
    }
#undef GA_LOCATE
#undef GA_ENTRY
#undef GA_LOADQ
    asm volatile("s_waitcnt vmcnt(0)" ::: "memory"); __syncthreads();
}
__device__ __forceinline__ void own_subjob(const Frame& F, KP P, int sjob, bool nofull = false, bool nocomb = false) {
    bf16* QM = (bf16*)(P->ws + WS_QM); const bf16* KM = (const bf16*)(P->ws + WS_KM); const bf16* VMT = (const bf16*)(P->ws + WS_VMT);
    const bf16* PART = (const bf16*)(P->ws + WS_PART); const float* LSE = (const float*)(P->ws + WS_LSE);
    int lane_ = F.lane; asm volatile("" : "+v"(lane_));
    const int lane = lane_, r32 = lane & 31, hi = lane >> 5, w = F.wave;
    LAS unsigned char* img = F.lds + RING_OFF;
    LaneOff lo; lane_off(lo, r32, hi);
    {
        const int bk = sjob >> 5, j = 15 - ((sjob & 31) >> 1), hp = sjob & 1, b = bk >> 1, kvh = bk & 1;
        img_load(F, img, KM, (long)b * S + j * 256, kvh, VMT + (long)((b * 2 + kvh) * 64) * S, j * 256);
        asm volatile("s_waitcnt vmcnt(0)" ::: "memory"); __syncthreads();
        const int nsel = j < 3 ? j : 3;
#pragma unroll 1
        for (int k = 0; k < 2; ++k) {
            const int hg = 2 * hp + k, qs = (k & 1) ? 7 - w : w, qo = qs * 32, h = kvh * 4 + hg;
            const float sl2 = moba_sl2(h);
            const int t0 = j * 256 + qo, q = t0 + r32;
            const size_t row = (size_t)(b * S + q);
            bf16* qrow = QM + row * 512 + h * 64;
            bf16x8 qr[4]; loadq(qr, qrow + 8 * hi);
            St st; st.o0 = f32x16{}; st.o1 = f32x16{}; st.m = -INFINITY; st.l = 0.f;
            const int nfull = nofull ? 0 : (qo >> 6);
#pragma unroll 1
            for (int i = 0; i < nfull; ++i) tile_lds<0, false, true>(st, qr, img, lo, 64 * i, 64 * i - qo - r32, sl2, true, 0, hi, r32);
            if (qo & 32) tile_lds<2, false, true>(st, qr, img, lo, qo - 32, -32 - r32, sl2, true, 0, hi, r32);
            else tile_lds<2, true, true>(st, qr, img, lo, qo, -r32, sl2, true, 0, hi, r32);
            const float lt = st.l + __shfl_xor(st.l, 32);
            const float lse_own = st.m + __builtin_amdgcn_logf(lt), rl = __builtin_amdgcn_rcpf(lt);
            LAS unsigned char* stg = F.lds + RING_OFF + IMG_BYTES + w * 4736;
#pragma unroll
            for (int g = 0; g < 4; ++g) { u32x2 a2, c2;
                a2.x = cvtpk(st.o0[4 * g] * rl, st.o0[4 * g + 1] * rl); a2.y = cvtpk(st.o0[4 * g + 2] * rl, st.o0[4 * g + 3] * rl);
                c2.x = cvtpk(st.o1[4 * g] * rl, st.o1[4 * g + 1] * rl); c2.y = cvtpk(st.o1[4 * g + 2] * rl, st.o1[4 * g + 3] * rl);
                *(LAS u32x2*)(stg + r32 * 144 + (8 * g + 4 * hi) * 2) = a2; *(LAS u32x2*)(stg + r32 * 144 + (32 + 8 * g + 4 * hi) * 2) = c2; }
            if (hi == 0) *(LAS float*)(stg + 4608 + r32 * 4) = lse_own;
            LDS_WAIT(); asm volatile("" ::: "memory");
            if (nocomb) continue;
#pragma unroll 2
            for (int i = 0; i < 4; ++i) {
                const int rw = i * 8 + (lane >> 3), ch = lane & 7;
                const size_t grow = (size_t)(b * S + t0 + rw), sl0 = ((size_t)((b * 8 + h) * 3)) * S + t0 + rw;
                const u32x4 own = *(const LAS u32x4*)(stg + rw * 144 + ch * 16); const float lo_ = *(const LAS float*)(stg + 4608 + rw * 4);
                float ls[3]; u32x4 pr[3];
#pragma unroll
                for (int r = 0; r < 3; ++r) { ls[r] = -INFINITY; pr[r] = (u32x4){0u, 0u, 0u, 0u}; if (r < nsel) { ls[r] = LSE[sl0 + (size_t)r * S]; pr[r] = *(const u32x4*)(PART + (sl0 + (size_t)r * S) * 64 + ch * 8); } }
                float M = lo_;
#pragma unroll
                for (int r = 0; r < 3; ++r) M = fmaxf(M, ls[r]);
                const float w0 = __builtin_amdgcn_exp2f(lo_ - M); float W = w0;
                float acc8[8];
                acc8[0] = w0 * bf2f(own.x & 0xffffu); acc8[1] = w0 * bf2f(own.x >> 16); acc8[2] = w0 * bf2f(own.y & 0xffffu); acc8[3] = w0 * bf2f(own.y >> 16);
                acc8[4] = w0 * bf2f(own.z & 0xffffu); acc8[5] = w0 * bf2f(own.z >> 16); acc8[6] = w0 * bf2f(own.w & 0xffffu); acc8[7] = w0 * bf2f(own.w >> 16);
#pragma unroll
                for (int r = 0; r < 3; ++r) { const float wr_ = __builtin_amdgcn_exp2f(ls[r] - M); W += wr_;
                    acc8[0] += wr_ * bf2f(pr[r].x & 0xffffu); acc8[1] += wr_ * bf2f(pr[r].x >> 16); acc8[2] += wr_ * bf2f(pr[r].y & 0xffffu); acc8[3] += wr_ * bf2f(pr[r].y >> 16);
                    acc8[4] += wr_ * bf2f(pr[r].z & 0xffffu); acc8[5] += wr_ * bf2f(pr[r].z >> 16); acc8[6] += wr_ * bf2f(pr[r].w & 0xffffu); acc8[7] += wr_ * bf2f(pr[r].w >> 16); }
                const float rW = __builtin_amdgcn_rcpf(W);
                u32x4 o; o.x = cvtpk(acc8[0] * rW, acc8[1] * rW); o.y = cvtpk(acc8[2] * rW, acc8[3] * rW); o.z = cvtpk(acc8[4] * rW, acc8[5] * rW); o.w = cvtpk(acc8[6] * rW, acc8[7] * rW);
                *(u32x4*)(QM + grow * 512 + h * 64 + ch * 8) = o;
            }
            LDS_WAIT(); asm volatile("" ::: "memory");
        }
    }
}
}
#ifndef BENCH_HOT
#define BENCH_HOT 0
#endif
#ifndef BENCH_NOSTORE
#define BENCH_NOSTORE 0
#endif
#ifndef BENCH_SUB
#define BENCH_SUB 3
#endif
#ifndef ALIGN_ONE
#define ALIGN_ONE true
#endif
#ifndef ALIGN_BIG
#define ALIGN_BIG true
#endif
#ifndef BENCH_NOEPI
#define BENCH_NOEPI 0
#endif
#ifndef BENCH_AGLU
#define BENCH_AGLU 0
#endif
#ifndef BENCH_KGLU
#define BENCH_KGLU 0
#endif
#ifndef PH_MASK
#define PH_MASK 0xFFF
#endif
#define PH_ON(k) (((PH_MASK) >> (k)) & 1)
constexpr int NPH = 10, PH_FINAL = DEPTH * NPH, PH_TOTAL = PH_FINAL + 1;
struct Args { Ptrs P; int ph_lo, ph_hi, use_bar, sub; };
__global__ void __launch_bounds__(NWAVES * 64, 2) mk_fwd(Args args) {
    extern __shared__ __attribute__((aligned(16))) unsigned char lds[];
    Frame F;
    F.lds = (LAS unsigned char*)lds;
    F.tid = threadIdx.x; F.lane = F.tid & 63; F.wave = __builtin_amdgcn_readfirstlane(F.tid >> 6);
    F.G = gridDim.x; { const int bx = blockIdx.x; F.vcu = (F.G % 8 == 0) ? (bx % 8) * (F.G / 8) + bx / 8 : bx; }
    typedef const __attribute__((address_space(4))) Args* KArgs;
    const KArgs ka = (KArgs)__builtin_amdgcn_kernarg_segment_ptr();
    volatile LAS unsigned* MISC = (volatile LAS unsigned*)(F.lds + MISC_OFF);
    for (int u = F.tid; u < (LDS_BYTES - LDSCTL_OFF) / 4; u += NWAVES * 64) ((LAS unsigned*)(F.lds + LDSCTL_OFF))[u] = 0u;
    __syncthreads();
    XcdBarrier bar; bar.bar = (unsigned*)(ka->P.ws + WS_CTL) + CW_BAR; bar.x = 0; bar.st = nullptr;
    const int use_bar = ka->use_bar;
    if (use_bar) bar = xcd_barrier_post((unsigned*)(ka->P.ws + WS_CTL) + CW_BAR, MISC + 8);
    LAS unsigned char* ring = F.lds + RING_OFF;
    for (int ph = ka->ph_lo; ; ++ph) {
        { KArgs ka3 = ka; asm volatile("" : "+s"(ka3)); if (ph >= ka3->ph_hi) break; }
#if defined(BENCH_SET)
        const bool bench = ph >= PH_TOTAL; const int l = bench ? DEPTH - 1 : ph / NPH, k = bench ? (ph - PH_TOTAL) % NPH : ph % NPH;
        if (bench && !(((BENCH_SET) >> k) & 1)) continue;
#if defined(BENCH_EMPTY)
        if (bench) { if (ph + 1 < ka->ph_hi) xcd_barrier(bar); continue; }
#endif
        const int lc = bench ? DEPTH + (ph - PH_TOTAL) / NPH : l;
#else
        const bool bench = false; const int l = ph / NPH, k = ph % NPH; const int lc = l;
#endif
        KArgs ka2 = ka; asm volatile("" : "+s"(ka2)); KP P = &ka2->P;
        unsigned char* ws = ka2->P.ws;
        F.tid = threadIdx.x; asm volatile("" : "+v"(F.tid)); F.lane = F.tid & 63;
        int bx = (int)blockIdx.x; asm volatile("" : "+s"(bx));
        { int g_ = (int)gridDim.x, w_ = F.tid >> 6; asm volatile("" : "+s"(g_)); F.G = g_; F.vcu = (g_ % 8 == 0) ? (bx % 8) * (g_ / 8) + bx / 8 : bx; F.wave = __builtin_amdgcn_readfirstlane(w_); }
        if (ph == PH_FINAL && !bench) { if (PH_ON(10)) final_pass(F, P);
        }
        else if (k == 0 && PH_ON(0)) { conv_layer(F, P, l); ssm_mats(F, P, l); if (l == 0) xb_pass(F, P); __syncthreads(); }
        else if (k == 1 && PH_ON(1)) {
            pg8::SrcStd g{(const char*)(ws + WS_XN), (const char*)(ws + WS_WIN), DM, 0}; pg8::StaticOrder So; So.init(T, DIN, F.G, bx);
            pg8::Unit u0; So.next(0, u0); pg8::rinv_build((LAS float*)(F.lds + RINV_OFF), (const float*)(ws + WS_SSQ), u0.pm);
            pg8::EpiInProj E{ws, pg8::RinvTab{(const LAS float*)(F.lds + RINV_OFF)}, (bench && BENCH_NOEPI) ? 1 : 0};
            pg8::gemm_phase<pg8::EpiInProj, pg8::SrcStd, pg8::StaticOrder, ALIGN_BIG>(ring, g, So, E);
        }
        else if (k == 2 && PH_ON(2)) {
            if (ka2->sub & 1) { pg8::SrcSsm<false> g{(const char*)(ws + WS_U), nullptr, (const char*)(ws + WS_SEND)}; pg8::SsmOrder So{F.G, bx}; pg8::EpiSsmEnd E{(float*)(ws + WS_HEND)};
                pg8::gemm_phase<pg8::EpiSsmEnd, pg8::SrcSsm<false>, pg8::SsmOrder, ALIGN_ONE>(ring, g, So, E); }
            if (ka2->sub & 2) att::swa_select_phase(F, P, l, lc);
        }
        else if (k == 3 && PH_ON(3)) {
#ifndef NO_CARRY
            if ((bench ? BENCH_SUB : ka2->sub) & 1) ssm_carry(F, P, l);
#endif
#ifndef NO_MOBA
            if ((bench ? BENCH_SUB : ka2->sub) & 2) att::moba_gather(F, P, lc, bench && BENCH_NOSTORE);
#endif
        }
        else if (k == 4 && PH_ON(4)) {
            unsigned* done = (unsigned*)(ws + WS_CTL) + CW_DONE + lc;
            { pg8::SrcSsm<true> g{(const char*)(ws + WS_U), (const char*)(ws + WS_HINIT), (const char*)(ws + WS_SMAIN)}; pg8::SsmOrder So{F.G, bx}; pg8::EpiSsmMain E{(bf16*)(ws + WS_YS)};
              pg8::Unit u0; const bool mine = So.next(0, u0);
              pg8::gemm_phase<pg8::EpiSsmMain, pg8::SrcSsm<true>, pg8::SsmOrder, true>(ring, g, So, E);
              if (mine && F.tid == 0) {
                  __builtin_amdgcn_fence(__ATOMIC_RELEASE, "agent"); asm volatile("s_waitcnt vmcnt(0)" ::: "memory");
                  __hip_atomic_fetch_add(done, 1u, __ATOMIC_RELAXED, __HIP_MEMORY_SCOPE_AGENT); } }
            unsigned* qctr = (unsigned*)(ws + WS_CTL) + CW_OWNQ + lc;
            volatile LAS unsigned* jobw = (volatile LAS unsigned*)(F.lds + MISC_OFF + 64);
            int job;
            for (;;) {
                __syncthreads();
                if (F.tid == 0) *jobw = __hip_atomic_fetch_add(qctr, 1u, __ATOMIC_RELAXED, __HIP_MEMORY_SCOPE_AGENT);
                __syncthreads();
                job = (int)*jobw;
                if (job >= 256) break;
                att::own_subjob(F, P, job);
            }
            if (job < 512) {
                if (F.tid == 0) { unsigned sp = 0u; while (__hip_atomic_load(done, __ATOMIC_RELAXED, __HIP_MEMORY_SCOPE_AGENT) < 128u) { __builtin_amdgcn_s_sleep(2); if (++sp > (1u << 22)) break; }
                    __builtin_amdgcn_fence(__ATOMIC_ACQUIRE, "agent"); asm volatile("s_waitcnt vmcnt(0)" ::: "memory"); }
                __syncthreads();
            }
            while (job < 512) {
                { const int gj = job - 256;
                  pg8::SrcStd g{(const char*)(ws + WS_YS), (const char*)(ws + WS_WGLU), 512, 0}; pg8::OneUnit So{gj >> 2, gj & 3}; pg8::EpiGlu E{(bf16*)(ws + WS_A1)};
                  pg8::gemm_phase<pg8::EpiGlu, pg8::SrcStd, pg8::OneUnit, true>(ring, g, So, E); }
                __syncthreads();
                if (F.tid == 0) *jobw = __hip_atomic_fetch_add(qctr, 1u, __ATOMIC_RELAXED, __HIP_MEMORY_SCOPE_AGENT);
                __syncthreads();
                job = (int)*jobw;
            }
        }
        else if (k == 5 && PH_ON(5)) { }
        else if (k == 6 && PH_ON(6)) {
            pg8::SrcMerge g{(const char*)(ws + WS_QA), (const char*)(ws + WS_A1), (const char*)(ws + WS_QM), (const char*)(ws + WS_WMRG)}; pg8::StaticOrder So; So.init(T, DM, F.G, bx);
            pg8::EpiMerge E{(const bf16*)(ws + WS_GATES), (bf16*)(ws + WS_MIXED)};
            pg8::gemm_phase<pg8::EpiMerge, pg8::SrcMerge, pg8::StaticOrder, ALIGN_ONE>(ring, g, So, E);
        }
        else if ((k == 7 || k == 9) && PH_ON(7)) {
            const bool f2 = (k == 9);
            pg8::SrcStd g{(const char*)(ws + (f2 ? WS_H1 : WS_MIXED)), (const char*)(ws + (f2 ? WS_WFF2 : WS_WOUT)), f2 ? DFF : DM, 0}; pg8::StaticOrder So; So.init(T, DM, F.G, bx); float* xd = bench ? (float*)(ws + WS_QA) : P->x;
            pg8::EpiResid E{(!bench && l == 0 && !f2) ? P->x_in : (const float*)xd, xd, (bf16*)(ws + (bench ? WS_KM : WS_XN)), (float*)(ws + WS_SSQ)};
            pg8::gemm_phase<pg8::EpiResid, pg8::SrcStd, pg8::StaticOrder, ALIGN_ONE>(ring, g, So, E);
        }
        else if (k == 8 && PH_ON(8)) {
            pg8::SrcStd g{(const char*)(ws + WS_XN), (const char*)(ws + WS_WFF1), DM, (bench && BENCH_HOT) ? 1 : 0}; pg8::StaticOrder So; So.init(T, DFF, F.G, bx);
            pg8::Unit u0; So.next(0, u0); pg8::rinv_build((LAS float*)(F.lds + RINV_OFF), (const float*)(ws + WS_SSQ), u0.pm);
            pg8::EpiFfn1 E{(bf16*)(ws + WS_H1), pg8::RinvTab{(const LAS float*)(F.lds + RINV_OFF)}, (bench && BENCH_NOEPI) ? 1 : 0};
            pg8::gemm_phase<pg8::EpiFfn1, pg8::SrcStd, pg8::StaticOrder, ALIGN_BIG>(ring, g, So, E);
        }
        if (k == 5 && !bench) continue;
        { KArgs ka3 = ka; asm volatile("" : "+s"(ka3)); if (ph + 1 < ka3->ph_hi) { if (ka3->use_bar) xcd_barrier(bar); else __syncthreads(); } }
    }
}
extern "C" void kernel_launch(void* const* d_in, const int* in_sizes, int n_in, void* d_out, int out_size, void* d_ws, size_t ws_size, hipStream_t stream) {
    static int grid = 0;
    if (grid == 0) {
        if (n_in != 21 || out_size != T * DM || ws_size < WS_END) { fprintf(stderr, "kernel_launch: unexpected shapes (n_in %d out %d ws %zu)\n", n_in, out_size, ws_size); grid = -1; return; }
        int dev = 0, cus = 0;
        if (hipGetDevice(&dev) != hipSuccess || hipDeviceGetAttribute(&cus, hipDeviceAttributeMultiprocessorCount, dev) != hipSuccess) { grid = -1; return; }
        if (hipFuncSetAttribute((const void*)mk_fwd, hipFuncAttributeMaxDynamicSharedMemorySize, LDS_BYTES) != hipSuccess) { fprintf(stderr, "kernel_launch: hipFuncSetAttribute failed\n"); grid = -1; return; }
        int per_cu = 0;
        if (hipOccupancyMaxActiveBlocksPerMultiprocessor(&per_cu, (const void*)mk_fwd, NWAVES * 64, LDS_BYTES) != hipSuccess || per_cu < 1) { fprintf(stderr, "kernel_launch: occupancy query reports %d workgroups per CU\n", per_cu); (void)hipGetLastError(); }
        grid = cus;
        if (grid != 256) { fprintf(stderr, "kernel_launch: built for a 256-CU device (unit dealing assumes 256 workgroups); found %d CUs; nothing launched\n", cus); grid = -1; return; }
    }
    if (grid < 0) return;
    (void)hipMemsetAsync((char*)d_ws + WS_CTL, 0, CTL_ZERO_BYTES, stream);
    Args a{};
    const float** pp = (const float**)&a.P; for (int i = 0; i < 21; ++i) pp[i] = (const float*)d_in[i];
    a.P.x = (float*)d_out; a.P.ws = (unsigned char*)d_ws;
    #if defined(BENCH_SET)
    a.ph_lo = 0; a.ph_hi = PH_TOTAL + NPH * (BENCH_REPS);
#else
    a.ph_lo = 0; a.ph_hi = PH_TOTAL;
#endif
    a.use_bar = 1; a.sub = 3;
    hipLaunchKernelGGL(mk_fwd, dim3(grid), dim3(NWAVES * 64), LDS_BYTES, stream, a);
}
```

```cpp
#include <hip/hip_runtime.h>
#include <cstdio>
#include <cstdint>

constexpr int NB = 4, S = 4096, T = NB * S, DM = 1024, DEPTH = 4, DIN = 5120, DFF = 4096;
constexpr float LOG2E = 1.4426950408889634f;
constexpr float C2 = 0.125f * LOG2E;
constexpr float NORM_EPS = 1e-6f;
constexpr int SSM_L = 16;
constexpr int SSM_KM = SSM_L * 16 + 128;
constexpr int SSM_KE = SSM_L * 16;
constexpr int NCH = T / SSM_L;

constexpr size_t MiB = 1u << 20;
constexpr size_t WS_CTL = 0, CTL_ZERO_BYTES = 1 * MiB;
constexpr size_t WS_WIN = 1 * MiB, WS_WGLU = 11 * MiB, WS_WMRG = 12 * MiB, WS_WOUT = 15 * MiB, WS_WFF1 = 17 * MiB, WS_WFF2 = 25 * MiB;
constexpr size_t WS_SMAIN = 33 * MiB, WS_SEND = 39 * MiB, WS_KMP = 43 * MiB;
constexpr size_t WS_XN = 44 * MiB;
constexpr size_t WS_QA = 76 * MiB, WS_KA = 92 * MiB, WS_VAT = 96 * MiB, WS_U = 100 * MiB, WS_QM = 116 * MiB, WS_KM = 132 * MiB, WS_VMT = 136 * MiB, WS_GATES = 140 * MiB;
constexpr size_t WS_H1 = 76 * MiB;
constexpr size_t WS_LIST = WS_XN, WS_LSE = WS_XN + 8 * MiB;
constexpr size_t WS_YS = 284 * MiB;
constexpr size_t WS_PART = 236 * MiB;
constexpr size_t WS_A1 = 236 * MiB, WS_MIXED = 252 * MiB, WS_HEND = 284 * MiB, WS_HINIT = 300 * MiB, WS_SSQ = 308 * MiB, WS_END = 309 * MiB;

typedef unsigned short bf16;
typedef short bf16x8 __attribute__((ext_vector_type(8)));
typedef short s16x4 __attribute__((ext_vector_type(4)));
typedef float f32x4 __attribute__((ext_vector_type(4)));
typedef float f32x16 __attribute__((ext_vector_type(16)));
typedef unsigned u32x4 __attribute__((ext_vector_type(4)));
typedef unsigned u32x2 __attribute__((ext_vector_type(2)));

__host__ __device__ __forceinline__ unsigned f2bf(float f) { unsigned u = __builtin_bit_cast(unsigned, f); return (u + 0x7fffu + ((u >> 16) & 1u)) >> 16; }
__host__ __device__ __forceinline__ float bf2f(unsigned b) { return __builtin_bit_cast(float, b << 16); }
typedef float f32x2_t __attribute__((ext_vector_type(2))); typedef __bf16 bf16x2_t __attribute__((ext_vector_type(2)));
__device__ __forceinline__ unsigned cvtpk_s(float lo, float hi) { f32x2_t v = {lo, hi}; bf16x2_t b = __builtin_convertvector(v, bf16x2_t); return __builtin_bit_cast(unsigned, b); }
__device__ __forceinline__ unsigned pk2(float lo, float hi) { return f2bf(lo) | (f2bf(hi) << 16); }
__device__ __forceinline__ float rbf(float f) { return bf2f(f2bf(f)); }
__device__ __forceinline__ float sigmoid_fast(float x) { return __builtin_amdgcn_rcpf(1.f + __builtin_amdgcn_exp2f(-x * LOG2E)); }
__device__ __forceinline__ float gelu_tanh(float x) {
    const float c2 = 2.f * 0.7978845608028654f; const float t = c2 * (x + 0.044715f * x * x * x); return x * sigmoid_fast(t); }
__device__ __forceinline__ float wave_sum(float v) {
#pragma unroll
    for (int o = 1; o < 64; o <<= 1) v += __shfl_xor(v, o);
    return v;
}
__device__ __forceinline__ float wave_max(float v) {
#pragma unroll
    for (int o = 1; o < 64; o <<= 1) v = fmaxf(v, __shfl_xor(v, o));
    return v;
}

struct Ptrs {
    const float *x_in, *norm_mix, *w_in, *sinks, *lam_re, *lam_im, *log_step, *b_re, *b_im, *c_re, *c_im, *d_skip, *w_glu, *w_o_swa, *w_o_ssm, *w_o_moba, *w_out, *norm_ffn, *w_ff1, *w_ff2, *norm_final;
    float* x;
    unsigned char* ws;
};
typedef const __attribute__((address_space(4))) Ptrs* KP;
namespace pg8 {
#define PG8_LAS __attribute__((address_space(3)))
constexpr int BM = 256, BK = 64, HALF = 128, HTB = HALF * BK * 2  , STAGE_BYTES = 8 * HTB, NXCD = 8, WGM = 8;

__host__ __device__ __forceinline__ int lds_byte(int r, int c) { const int st = (r >> 4) * 2 + (c >> 5), rr = r & 15, cc = c & 31, ob = rr * 64 + cc * 2; return st * 1024 + (ob ^ (((ob >> 9) & 1) << 5)); }
__host__ __device__ __forceinline__ void stage_rc(int b, int& R, int& C) { const int st = b / 1024, sb = b % 1024, swz = sb ^ (((sb >> 9) & 1) << 5); R = (st >> 1) * 16 + swz / 64; C = (st & 1) * 32 + (swz % 64) / 2; }
__host__ __device__ __forceinline__ int perm32(int rho) { const int n = rho >> 4, i = rho & 15; return 8 * (i >> 2) + 4 * n + (i & 3); }

struct Unit { int pm, pn; };

struct StaticOrder {
    int nM, nN, nwg, G, c;
    __host__ __device__ void init(int M, int N, int G_, int c_) { nM = M / BM; nN = N / BM; nwg = nM * nN; G = G_; c = c_; }
    __host__ __device__ bool next(int i, Unit& u) const {
        const long L = (long)i * G + c; if (L >= nwg) return false;
        int wgid = (int)L; { const int q = nwg / NXCD, r = nwg % NXCD, xcd = wgid % NXCD, off = wgid / NXCD; wgid = (xcd < r ? xcd * (q + 1) : r * (q + 1) + (xcd - r) * q) + off; }
        const int nig = WGM * nN, gid = wgid / nig, fm = gid * WGM, gsz = (nM - fm) < WGM ? (nM - fm) : WGM;
        u.pm = fm + ((wgid % nig) % gsz); u.pn = (wgid % nig) / gsz; return true;
    }
};
struct OneUnit { int pm, pn; __host__ __device__ bool next(int i, Unit& u) const { if (i) return false; u.pm = pm; u.pn = pn; return true; } };
struct SsmOrder {
    int G, c;
    __host__ __device__ bool next(int i, Unit& u) const { const int L = i * G + c; if (L >= 128) return false; u.pn = L >> 2; u.pm = L & 3; return true; }
};

struct SrcStd {
    static constexpr bool TWO_VAR = false;
    const char* A; const char* Bt; int K; int hot;
    __device__ __forceinline__ int nt() const { return K / BK; }
    __device__ __forceinline__ const char* a(const Unit& u, int kt, int h) const { return A + ((size_t)((hot ? 0 : u.pm) * BM + h * HALF) * K + (size_t)kt * BK) * 2; }
    __device__ __forceinline__ const char* b(const Unit& u, int kt, int h) const { return Bt + ((size_t)((hot ? 0 : u.pn) * BM + h * HALF) * K + (size_t)kt * BK) * 2; }
    __device__ __forceinline__ unsigned voffA(int R, int C, int) const { return (unsigned)(R * K + C) * 2u; }
    __device__ __forceinline__ unsigned voffB(int R, int C) const { return (unsigned)(R * K + C) * 2u; }
    __device__ __forceinline__ int avar(int) const { return 0; }
};
struct SrcMerge {
    static constexpr bool TWO_VAR = false;
    const char* A0; const char* A1; const char* A2; const char* Bt;
    __device__ __forceinline__ int nt() const { return 24; }
    __device__ __forceinline__ const char* a(const Unit& u, int kt, int h) const { const int sg = kt >> 3; const char* p = sg == 0 ? A0 : (sg == 1 ? A1 : A2); return p + ((size_t)(u.pm * BM + h * HALF) * 512 + (size_t)(kt & 7) * BK) * 2; }
    __device__ __forceinline__ const char* b(const Unit& u, int kt, int h) const { return Bt + ((size_t)(u.pn * BM + h * HALF) * 1536 + (size_t)kt * BK) * 2; }
    __device__ __forceinline__ unsigned voffA(int R, int C, int) const { return (unsigned)(R * 512 + C) * 2u; }
    __device__ __forceinline__ unsigned voffB(int R, int C) const { return (unsigned)(R * 1536 + C) * 2u; }
    __device__ __forceinline__ int avar(int) const { return 0; }
};
template <bool MAIN> struct SrcSsm {
    static constexpr bool TWO_VAR = MAIN; static constexpr int KTOT = MAIN ? SSM_KM : SSM_KE;
    const char* U; const char* HI; const char* Bt;
    __device__ __forceinline__ int nt() const { return KTOT / BK; }
    __device__ __forceinline__ const char* a(const Unit& u, int kt, int h) const {
        if (!MAIN || kt < 4) return U + ((size_t)(u.pn * NCH + u.pm * BM + h * HALF) * 256 + (size_t)kt * BK) * 2;
        return HI + ((size_t)(u.pn * NCH + u.pm * BM + h * HALF) * 128 + (size_t)(kt - 4) * BK) * 2; }
    __device__ __forceinline__ const char* b(const Unit& u, int kt, int h) const { return Bt + ((size_t)(u.pn * 256 + h * HALF) * KTOT + (size_t)kt * BK) * 2; }
    __device__ __forceinline__ unsigned voffA(int R, int C, int var) const { return var ? (unsigned)(R * 128 + C) * 2u : (unsigned)(R * 256 + C) * 2u; }
    __device__ __forceinline__ unsigned voffB(int R, int C) const { return (unsigned)(R * KTOT + C) * 2u; }
    __device__ __forceinline__ int avar(int kt) const { return (MAIN && kt >= 4) ? 1 : 0; }
};

typedef f32x4 Acc[2][2][4][2];
struct WsRes { __amdgpu_buffer_rsrc_t r; const unsigned char* base; };
#ifndef WT_MASK
#define WT_MASK 3
#endif
__device__ __forceinline__ WsRes ws_res(unsigned char* ws) { WsRes w; w.r = __builtin_amdgcn_make_buffer_rsrc(ws, 0, (int)0x7fffffff, 0x00020000); w.base = ws; return w; }
__device__ __forceinline__ unsigned ws_off(const WsRes& w, const void* p) { return (unsigned)((const unsigned char*)p - w.base); }
template <bool WT> __device__ __forceinline__ void wt16(const WsRes& w, unsigned off, u32x4 v) { if (WT) __builtin_amdgcn_raw_buffer_store_b128(v, w.r, off, 0, 16); else __builtin_amdgcn_raw_buffer_store_b128(v, w.r, off, 0, 0); }
template <bool WT> __device__ __forceinline__ void wt16f(__amdgpu_buffer_rsrc_t r, unsigned off, f32x4 v) { if (WT) __builtin_amdgcn_raw_buffer_store_b128(__builtin_bit_cast(u32x4, v), r, off, 0, 16); else __builtin_amdgcn_raw_buffer_store_b128(__builtin_bit_cast(u32x4, v), r, off, 0, 0); }
template <bool WT> __device__ __forceinline__ void wt8(const WsRes& w, unsigned off, u32x2 v) { if (WT) __builtin_amdgcn_raw_buffer_store_b64(v, w.r, off, 0, 16); else __builtin_amdgcn_raw_buffer_store_b64(v, w.r, off, 0, 0); }
__device__ __forceinline__ unsigned cvt_pk_bf16(float lo, float hi) { return cvtpk_s(lo, hi); }
__device__ __forceinline__ u32x4 pack8(f32x4 v0, f32x4 v1) { u32x4 w; w.x = cvt_pk_bf16(v0[0], v0[1]); w.y = cvt_pk_bf16(v0[2], v0[3]); w.z = cvt_pk_bf16(v1[0], v1[1]); w.w = cvt_pk_bf16(v1[2], v1[3]); return w; }
__device__ __forceinline__ f32x4 sig4(f32x4 v) { f32x4 o; o[0] = sigmoid_fast(v[0]); o[1] = sigmoid_fast(v[1]); o[2] = sigmoid_fast(v[2]); o[3] = sigmoid_fast(v[3]); return o; }
__device__ __forceinline__ f32x4 unpk_lo(u32x4 w) { f32x4 o; o[0] = bf2f(w.x & 0xffffu); o[1] = bf2f(w.x >> 16); o[2] = bf2f(w.y & 0xffffu); o[3] = bf2f(w.y >> 16); return o; }
__device__ __forceinline__ f32x4 unpk_hi(u32x4 w) { f32x4 o; o[0] = bf2f(w.z & 0xffffu); o[1] = bf2f(w.z >> 16); o[2] = bf2f(w.w & 0xffffu); o[3] = bf2f(w.w >> 16); return o; }
__device__ __forceinline__ f32x4 rcp4(f32x4 v) { f32x4 o; o[0] = __builtin_amdgcn_rcpf(v[0]); o[1] = __builtin_amdgcn_rcpf(v[1]); o[2] = __builtin_amdgcn_rcpf(v[2]); o[3] = __builtin_amdgcn_rcpf(v[3]); return o; }

struct RinvTab { const PG8_LAS float* tab; };
__device__ __forceinline__ void rinv_build(PG8_LAS float* tab, const float* SSQ, int pm0) {
    int t_ = threadIdx.x; asm volatile("" : "+v"(t_));
    if (t_ < 256) { const f32x4* sp = (const f32x4*)(SSQ + (size_t)(pm0 * BM + t_) * 16); const f32x4 s = (sp[0] + sp[1]) + (sp[2] + sp[3]); tab[t_] = rsqrtf(((s[0] + s[1]) + (s[2] + s[3])) * (1.f / DM) + NORM_EPS); }
    __syncthreads();
}
template <int MODE, bool WT = ((WT_MASK & 4) != 0)> __device__ __forceinline__ void st_half_bf16(const WsRes& W, const Acc& acc, int bj, bf16* base, int ldc, float sc, const PG8_LAS float* ri = nullptr  ) {
    unsigned p = ws_off(W, base);
#pragma unroll
    for (int ai = 0; ai < 2; ++ai) {
#pragma unroll
        for (int m = 0; m < 4; ++m) { f32x4 v0 = acc[ai][bj][m][0], v1 = acc[ai][bj][m][1];
            if (ri) { const float rs = ri[ai * HALF + m * 16]; v0 = v0 * rs; v1 = v1 * rs; }
            if (MODE == 0) { v0 = v0 * sc; v1 = v1 * sc; }
            else if (MODE == 1) { v0 = sig4(v0); v1 = sig4(v1); }
            else if (MODE == 2) { v0 = __builtin_elementwise_max(v0, (f32x4){0.f, 0.f, 0.f, 0.f}); v1 = __builtin_elementwise_max(v1, (f32x4){0.f, 0.f, 0.f, 0.f}); v0 = v0 * v0; v1 = v1 * v1; }
            else { v0[0] = gelu_tanh(v0[0]); v0[1] = gelu_tanh(v0[1]); v0[2] = gelu_tanh(v0[2]); v0[3] = gelu_tanh(v0[3]); v1[0] = gelu_tanh(v1[0]); v1[1] = gelu_tanh(v1[1]); v1[2] = gelu_tanh(v1[2]); v1[3] = gelu_tanh(v1[3]); }
            wt16<WT>(W, p, pack8(v0, v1)); asm volatile("" : "+v"(p)); p += 32u * (unsigned)ldc; }
        p += 2u * (unsigned)(HALF - 64) * (unsigned)ldc; }
}
__device__ __forceinline__ void st_half_vt(const Acc& acc, int bj, bf16* VT, int b, int s0, int cc, const PG8_LAS float* ri) {
    bf16* p = VT + ((size_t)(b * 2 + (cc >> 6)) * 64 + (cc & 63)) * S + (s0 & ~15) + ((((s0 >> 2) & 3) == 1 ? 2 : (((s0 >> 2) & 3) == 2 ? 1 : ((s0 >> 2) & 3))) << 2) + (s0 & 3);
    float rs[2][4];
#pragma unroll
    for (int ai = 0; ai < 2; ++ai)
#pragma unroll
        for (int m = 0; m < 4; ++m) rs[ai][m] = ri[ai * HALF + m * 16];
#pragma unroll
    for (int n = 0; n < 2; ++n)
#pragma unroll
        for (int e = 0; e < 4; ++e) {
#pragma unroll
            for (int ai = 0; ai < 2; ++ai)
#pragma unroll
                for (int m = 0; m < 4; ++m) p[ai * HALF + m * 16] = (bf16)f2bf(acc[ai][bj][m][n][e] * rs[ai][m]);
            asm volatile("" : "+v"(p)); p += S; }
}

struct EpiInProj {
    static constexpr bool PERM = true, AFTER_DRAIN = false, HAS_MID = false, CAN_RELAX = true;
    __device__ __forceinline__ bool st16(const Unit& u) const { return !skip && u.pn != 2 && u.pn != 7; }
    unsigned char* ws; RinvTab RT; int skip;
    __device__ __forceinline__ void operator()(const Acc& acc, const Unit& u, int wr, int wc, int fr, int fq) const {
        if (skip) return;
        const WsRes W = ws_res(ws);
        bf16 *QA = (bf16*)(ws + WS_QA), *KA = (bf16*)(ws + WS_KA), *VAT = (bf16*)(ws + WS_VAT), *U = (bf16*)(ws + WS_U), *QM = (bf16*)(ws + WS_QM), *KM = (bf16*)(ws + WS_KM), *VMT = (bf16*)(ws + WS_VMT), *GATES = (bf16*)(ws + WS_GATES); float* KMP = (float*)(ws + WS_KMP);
        const int row = u.pm * BM + wr * 64 + fr, cc = wc * 32 + 8 * fq;
        const PG8_LAS float* ri = RT.tab + wr * 64 + fr;
#pragma unroll
        for (int bj = 0; bj < 2; ++bj) {
            const int hc = u.pn * 2 + bj;
            if (hc < 4) st_half_bf16<0, ((WT_MASK & 32) != 0)>(W, acc, bj, QA + (size_t)row * 512 + hc * 128 + cc, 512, C2, ri);
            else if (hc == 4) st_half_bf16<0, ((WT_MASK & 32) != 0)>(W, acc, bj, KA + (size_t)row * 128 + cc, 128, 1.f, ri);
            else if (hc == 5) st_half_vt(acc, bj, VAT, row / S, row % S, cc, ri);
            else if (hc < 10) { const int ucol = (hc - 6) * 128 + cc;
                st_half_bf16<0, ((WT_MASK & 32) != 0)>(W, acc, bj, U + ((size_t)(ucol >> 4) * NCH + ((u.pm * BM + wr * 64) >> 4)) * 256 + fr * 16 + (ucol & 15), 16, 1.f, ri); }
            else if (hc < 14) st_half_bf16<0, ((WT_MASK & 32) != 0)>(W, acc, bj, QM + (size_t)row * 512 + (hc - 10) * 128 + cc, 512, C2, ri);
            else if (hc == 14) {
                st_half_bf16<0, ((WT_MASK & 32) != 0)>(W, acc, bj, KM + (size_t)row * 128 + cc, 128, 1.f, ri);
                f32x4 c0 = {0.f, 0.f, 0.f, 0.f}, c1 = {0.f, 0.f, 0.f, 0.f};
#pragma unroll
                for (int ai = 0; ai < 2; ++ai)
#pragma unroll
                    for (int m = 0; m < 4; ++m) { const float rs = ri[ai * HALF + m * 16]; c0 += acc[ai][bj][m][0] * rs; c1 += acc[ai][bj][m][1] * rs; }
#pragma unroll
                for (int o = 1; o < 16; o <<= 1)
#pragma unroll
                    for (int e = 0; e < 4; ++e) { c0[e] += __shfl_xor(c0[e], o); c1[e] += __shfl_xor(c1[e], o); }
                if (fr == 0) { float* kp = KMP + (size_t)(wr * 64 + u.pm) * 128 + cc; *(f32x4*)kp = c0; *(f32x4*)(kp + 4) = c1; }
            }
            else if (hc == 15) st_half_vt(acc, bj, VMT, row / S, row % S, cc, ri);
            else st_half_bf16<1, ((WT_MASK & 2) != 0)>(W, acc, bj, GATES + (size_t)row * 3072 + (hc - 16) * 128 + cc, 3072, 1.f, ri);
        }
    }
};
struct EpiFfn1 {
    static constexpr bool PERM = true, AFTER_DRAIN = false, HAS_MID = false, CAN_RELAX = true;
    __device__ __forceinline__ bool st16(const Unit& u) const { return !skip; }
    bf16* H1; RinvTab RT; int skip; unsigned char* ws;
    __device__ __forceinline__ void operator()(const Acc& acc, const Unit& u, int wr, int wc, int fr, int fq) const {
        if (skip) return;
        const WsRes W = ws_res(ws);
        bf16* base = H1 + (size_t)(u.pm * BM + wr * 64 + fr) * DFF + u.pn * BM + wc * 32 + 8 * fq;
        const PG8_LAS float* ri = RT.tab + wr * 64 + fr;
        st_half_bf16<2, ((WT_MASK & 1) != 0)>(W, acc, 0, base, DFF, 1.f, ri); st_half_bf16<2, ((WT_MASK & 1) != 0)>(W, acc, 1, base + HALF, DFF, 1.f, ri);
    }
};
struct EpiGlu {
    static constexpr bool PERM = true, AFTER_DRAIN = false, HAS_MID = false, CAN_RELAX = false;
    __device__ __forceinline__ bool st16(const Unit& u) const { return false; }
    bf16* A1; unsigned char* ws;
    __device__ __forceinline__ void operator()(const Acc& acc, const Unit& u, int wr, int wc, int fr, int fq) const {
        const WsRes W = ws_res(ws);
        bf16* base = A1 + (size_t)(u.pm * BM + wr * 64 + fr) * 512 + u.pn * 128 + wc * 32 + 8 * fq;
#pragma unroll
        for (int ai = 0; ai < 2; ++ai)
#pragma unroll
            for (int m = 0; m < 4; ++m) wt16<((WT_MASK & 4) != 0)>(W, ws_off(W, base + (size_t)(ai * HALF + m * 16) * 512), pack8(acc[ai][0][m][0] * sig4(acc[ai][1][m][0]), acc[ai][0][m][1] * sig4(acc[ai][1][m][1])));
    }
};
struct EpiMerge {
    static constexpr bool PERM = true, AFTER_DRAIN = false, HAS_MID = true, CAN_RELAX = false;
    __device__ __forceinline__ bool st16(const Unit& u) const { return false; }
    const bf16* GATES; bf16* MIXED; unsigned char* ws;
    __device__ __forceinline__ void mid(Acc& acc, const Unit& u, int t, int wr, int wc, int fr, int fq) const {
        if (t != 8 && t != 16) return;
        const bf16* g = GATES + (size_t)(u.pm * BM + wr * 64 + fr) * 3072 + (t == 8 ? 0 : 1024) + u.pn * BM + wc * 32 + 8 * fq;
#pragma unroll
        for (int ai = 0; ai < 2; ++ai)
#pragma unroll
            for (int m = 0; m < 4; ++m)
#pragma unroll
                for (int bj = 0; bj < 2; ++bj) { const bf16* gp = g + (size_t)(ai * HALF + m * 16) * 3072 + bj * HALF; const u32x4 num = *(const u32x4*)gp, den = *(const u32x4*)(gp + 1024);
                    acc[ai][bj][m][0] = acc[ai][bj][m][0] * (unpk_lo(num) * rcp4(unpk_lo(den))); acc[ai][bj][m][1] = acc[ai][bj][m][1] * (unpk_hi(num) * rcp4(unpk_hi(den))); }
    }
    __device__ __forceinline__ void operator()(const Acc& acc, const Unit& u, int wr, int wc, int fr, int fq) const {
        const WsRes W = ws_res(ws);
        const size_t ro = (size_t)(u.pm * BM + wr * 64 + fr); const int co = u.pn * BM + wc * 32 + 8 * fq;
#pragma unroll
        for (int ai = 0; ai < 2; ++ai)
#pragma unroll
            for (int m = 0; m < 4; ++m)
#pragma unroll
                for (int bj = 0; bj < 2; ++bj) { const size_t r = ro + ai * HALF + m * 16; const u32x4 g2 = *(const u32x4*)(GATES + r * 3072 + 2048 + co + bj * HALF);
                    wt16<((WT_MASK & 4) != 0)>(W, ws_off(W, MIXED + r * DM + co + bj * HALF), pack8(acc[ai][bj][m][0] * unpk_lo(g2), acc[ai][bj][m][1] * unpk_hi(g2))); }
    }
};
struct EpiResid {
    static constexpr bool PERM = false, AFTER_DRAIN = false, HAS_MID = false, CAN_RELAX = false;
    __device__ __forceinline__ bool st16(const Unit& u) const { return false; }
    const float* XS; float* X; bf16* XB; float* SSQ; unsigned char* ws;
    __device__ __forceinline__ void operator()(const Acc& acc, const Unit& u, int wr, int wc, int fr, int fq) const {
        const WsRes W = ws_res(ws);
        const __amdgpu_buffer_rsrc_t xr_ = __builtin_amdgcn_make_buffer_rsrc(X, 0, T * DM * 4, 0x00020000);
        const size_t row0 = (size_t)(u.pm * BM + wr * 64 + fr); const int col0 = u.pn * BM + wc * 32 + 4 * fq;
#pragma unroll
        for (int ai = 0; ai < 2; ++ai)
#pragma unroll
            for (int m = 0; m < 4; ++m) { const size_t r = row0 + ai * HALF + m * 16; float ss = 0.f;
#pragma unroll
                for (int bj = 0; bj < 2; ++bj)
#pragma unroll
                    for (int n = 0; n < 2; ++n) { const size_t o_ = r * DM + col0 + bj * HALF + n * 16; const f32x4 v = *(const f32x4*)(XS + o_) + acc[ai][bj][m][n]; if ((WT_MASK & 16) != 0) wt16f<true>(xr_, (unsigned)(o_ * 4), v); else *(f32x4*)(X + o_) = v;
                        ss += (v[0] * v[0] + v[1] * v[1]) + (v[2] * v[2] + v[3] * v[3]);
                        u32x2 w; w.x = cvt_pk_bf16(v[0], v[1]); w.y = cvt_pk_bf16(v[2], v[3]); wt8<((WT_MASK & 4) != 0)>(W, ws_off(W, XB + r * DM + col0 + bj * HALF + n * 16), w); }
                ss += __shfl_xor(ss, 16); ss += __shfl_xor(ss, 32);
                if (fq == 0) SSQ[r * 16 + u.pn * 4 + wc] = ss; }
    }
};
struct EpiSsmEnd {
    static constexpr bool PERM = false, AFTER_DRAIN = false, HAS_MID = false, CAN_RELAX = false;
    __device__ __forceinline__ bool st16(const Unit& u) const { return false; }
    float* HEND;
    __device__ __forceinline__ void operator()(const Acc& acc, const Unit& u, int wr, int wc, int fr, int fq) const {
        float* base = HEND + ((size_t)u.pn * NCH + u.pm * BM + wr * 64 + fr) * 128 + wc * 32 + 4 * fq;
#pragma unroll
        for (int ai = 0; ai < 2; ++ai)
#pragma unroll
            for (int m = 0; m < 4; ++m)
#pragma unroll
                for (int n = 0; n < 2; ++n) *(f32x4*)(base + (size_t)(ai * HALF + m * 16) * 128 + n * 16) = acc[ai][0][m][n];
    }
};
struct EpiSsmMain {
    static constexpr bool PERM = true, AFTER_DRAIN = false, HAS_MID = false, CAN_RELAX = false;
    __device__ __forceinline__ bool st16(const Unit& u) const { return false; }
    bf16* YS; unsigned char* ws;
    __device__ __forceinline__ void operator()(const Acc& acc, const Unit& u, int wr, int wc, int fr, int fq) const {
        const WsRes W = ws_res(ws);
        const int mrow = u.pm * BM + wr * 64 + fr;
#pragma unroll
        for (int bj = 0; bj < 2; ++bj) { const int s = 8 * bj + 2 * wc + (fq >> 1);
            bf16* base = YS + ((size_t)mrow * 16 + s) * 512 + u.pn * 16 + 8 * (fq & 1);
            st_half_bf16<3>(W, acc, bj, base, 16 * 512, 1.f); }
    }
};

template <class Epi, class Src, class Sched, bool ALIGN_EPI>
__device__ __forceinline__ void gemm_phase(PG8_LAS unsigned char* lds, const Src g, const Sched& S, const Epi& E) {
    int tid_ = threadIdx.x; asm volatile("" : "+v"(tid_));
    const int tid = tid_, wid = __builtin_amdgcn_readfirstlane(tid >> 6), lane = tid & 63, wr = wid >> 2, wc = wid & 3, fr = lane & 15, fq = lane >> 4;
    const int nt = g.nt();
    unsigned voffA[2], voffA2[2], voffB[2];
#pragma unroll
    for (int i = 0; i < 2; ++i) { int R, C; stage_rc(tid * 16 + i * 8192, R, C); const int Rb = Epi::PERM ? ((R & ~31) + perm32(R & 31)) : R;
        voffA[i] = g.voffA(R, C, 0); voffA2[i] = Src::TWO_VAR ? g.voffA(R, C, 1) : 0u; voffB[i] = g.voffB(Rb, C); }
    const unsigned ldsw = (unsigned)wid * 1024u;
    const int aoff = lds_byte(wr * 64 + fr, fq * 8), boff = lds_byte(wc * 32 + fr, fq * 8);
#define PG8_SA(b, h) (((b) * 2 + (h)) * HTB)
#define PG8_SB(b, h) ((4 + (b) * 2 + (h)) * HTB)
#define PG8_STAGE_B(bufoff, gbase) do { _Pragma("unroll") for (int _i = 0; _i < 2; ++_i) \
        __builtin_amdgcn_global_load_lds((const unsigned*)((const char*)(gbase) + voffB[_i]), (PG8_LAS unsigned*)(lds + (bufoff) + ldsw + _i * 8192), 16, 0, 0); } while (0)
#define PG8_STAGE_A(bufoff, gbase, kt) do { const bool _v = Src::TWO_VAR && g.avar(kt); _Pragma("unroll") for (int _i = 0; _i < 2; ++_i) { const unsigned _o = _v ? voffA2[_i] : voffA[_i]; \
        __builtin_amdgcn_global_load_lds((const unsigned*)((const char*)(gbase) + _o), (PG8_LAS unsigned*)(lds + (bufoff) + ldsw + _i * 8192), 16, 0, 0); } } while (0)
#define PG8_LDA(dst, b, h) do { _Pragma("unroll") for (int m = 0; m < 4; ++m) _Pragma("unroll") for (int k = 0; k < 2; ++k) dst[m][k] = *(const PG8_LAS bf16x8*)(lds + PG8_SA(b, h) + aoff + m * 2048 + k * 1024); } while (0)
#define PG8_LDB(dst, b, h) do { _Pragma("unroll") for (int n = 0; n < 2; ++n) _Pragma("unroll") for (int k = 0; k < 2; ++k) dst[n][k] = *(const PG8_LAS bf16x8*)(lds + PG8_SB(b, h) + boff + n * 2048 + k * 1024); } while (0)
#define PG8_MMA(ai, bj, At, Bt) do { __builtin_amdgcn_s_setprio(1); _Pragma("unroll") for (int m = 0; m < 4; ++m) _Pragma("unroll") for (int n = 0; n < 2; ++n) _Pragma("unroll") for (int k = 0; k < 2; ++k) \
        acc[ai][bj][m][n] = __builtin_amdgcn_mfma_f32_16x16x32_bf16(Bt[n][k], At[m][k], acc[ai][bj][m][n], 0, 0, 0); __builtin_amdgcn_s_setprio(0); } while (0)
#define PG8_WAIT_V(n) asm volatile("s_waitcnt vmcnt(" #n ")" ::: "memory")
#define PG8_WAIT_L(n) asm volatile("s_waitcnt lgkmcnt(" #n ")" ::: "memory")
#define PG8_WAIT_VR(rl) asm volatile("s_cmp_eq_u32 %0, 0\n\ts_cbranch_scc1 1f\n\ts_waitcnt vmcnt(24)\n\ts_branch 2f\n1:\ts_waitcnt vmcnt(8)\n2:" :: "s"(__builtin_amdgcn_readfirstlane((int)(rl))) : "scc", "memory")
#define PG8_BAR __builtin_amdgcn_s_barrier()
#define PG8_SCHED __builtin_amdgcn_sched_barrier(0)
    Unit cur, nxt; int ui = 0; bool relax = false;
    if (!S.next(0, cur)) return;
    Acc acc;
#pragma unroll
    for (int a = 0; a < 2; ++a)
#pragma unroll
        for (int b = 0; b < 2; ++b)
#pragma unroll
            for (int m = 0; m < 4; ++m)
#pragma unroll
                for (int n = 0; n < 2; ++n) acc[a][b][m][n] = (f32x4){0.f, 0.f, 0.f, 0.f};
    bf16x8 At[4][2], B0[2][2], B1[2][2];
    PG8_STAGE_B(PG8_SB(0, 0), g.b(cur, 0, 0)); PG8_STAGE_B(PG8_SB(0, 1), g.b(cur, 0, 1)); PG8_STAGE_A(PG8_SA(0, 0), g.a(cur, 0, 0), 0); PG8_STAGE_A(PG8_SA(0, 1), g.a(cur, 0, 1), 0);
    if (wr == 1) PG8_BAR;
    PG8_WAIT_V(2); PG8_BAR;
    PG8_STAGE_B(PG8_SB(1, 0), g.b(cur, 1, 0)); PG8_STAGE_A(PG8_SA(1, 0), g.a(cur, 1, 0), 1); PG8_STAGE_B(PG8_SB(1, 1), g.b(cur, 1, 1));
    PG8_WAIT_V(6); PG8_BAR;
    for (;;) {
        const bool has_next = S.next(ui + 1, nxt);
        const Unit nu = has_next ? nxt : cur;
        for (int t = 0; t < nt; t += 2) {
            const bool last = (t == nt - 2);
            const bool rl = relax && t == 0;
            if constexpr (Epi::HAS_MID) E.mid(acc, cur, t, wr, wc, fr, fq);
            const Unit u2 = last ? nu : cur; const int k2 = last ? 0 : t + 2, k3 = k2 + 1;
            PG8_LDB(B0, 0, 0); PG8_LDB(B1, 0, 1); PG8_SCHED; PG8_LDA(At, 0, 0); PG8_STAGE_A(PG8_SA(1, 1), g.a(cur, t + 1, 1), t + 1);
            if constexpr (Epi::CAN_RELAX) PG8_WAIT_VR(rl); else PG8_WAIT_V(8);
            PG8_WAIT_L(0); PG8_BAR; PG8_MMA(0, 0, At, B0); PG8_MMA(0, 1, At, B1); PG8_BAR; PG8_SCHED;
            PG8_LDA(At, 0, 1); PG8_STAGE_B(PG8_SB(0, 0), g.b(u2, k2, 0)); PG8_STAGE_B(PG8_SB(0, 1), g.b(u2, k2, 1)); PG8_STAGE_A(PG8_SA(0, 0), g.a(u2, k2, 0), k2);
            if constexpr (Epi::CAN_RELAX) PG8_WAIT_VR(rl); else PG8_WAIT_V(8);
            PG8_WAIT_L(0); PG8_BAR; PG8_MMA(1, 0, At, B0); PG8_MMA(1, 1, At, B1); PG8_BAR; PG8_SCHED;
            PG8_LDB(B0, 1, 0); PG8_LDB(B1, 1, 1); PG8_SCHED; PG8_LDA(At, 1, 0); PG8_STAGE_A(PG8_SA(0, 1), g.a(u2, k2, 1), k2);
            PG8_WAIT_V(8); PG8_WAIT_L(0); PG8_BAR; PG8_MMA(0, 0, At, B0); PG8_MMA(0, 1, At, B1); PG8_BAR; PG8_SCHED;
            PG8_LDA(At, 1, 1); PG8_STAGE_B(PG8_SB(1, 0), g.b(u2, k3, 0)); PG8_STAGE_B(PG8_SB(1, 1), g.b(u2, k3, 1)); PG8_STAGE_A(PG8_SA(1, 0), g.a(u2, k3, 0), k3);
            PG8_WAIT_V(8); PG8_WAIT_L(0); PG8_BAR; PG8_MMA(1, 0, At, B0); PG8_MMA(1, 1, At, B1); PG8_BAR; PG8_SCHED;
        }
        if constexpr (ALIGN_EPI) { if (wr == 0) PG8_BAR; }
        { int fr_ = fr, fq_ = fq; asm volatile("" : "+v"(fr_), "+v"(fq_));
          E(acc, cur, wr, wc, fr_, fq_); }
        relax = E.st16(cur);
        if (!has_next) break;
#pragma unroll
        for (int a = 0; a < 2; ++a)
#pragma unroll
            for (int b = 0; b < 2; ++b)
#pragma unroll
                for (int m = 0; m < 4; ++m)
#pragma unroll
                    for (int n = 0; n < 2; ++n) acc[a][b][m][n] = (f32x4){0.f, 0.f, 0.f, 0.f};
        cur = nxt; ++ui;
        if constexpr (ALIGN_EPI) { if (wr == 1) PG8_BAR; }
    }
    PG8_WAIT_V(0);
    if constexpr (!ALIGN_EPI) { if (wr == 0) PG8_BAR; }
    PG8_BAR;
#undef PG8_SA
#undef PG8_SB
#undef PG8_STAGE_A
#undef PG8_STAGE_B
#undef PG8_LDA
#undef PG8_LDB
#undef PG8_MMA
#undef PG8_WAIT_V
#undef PG8_WAIT_L
#undef PG8_WAIT_VR
#undef PG8_BAR
#undef PG8_SCHED
}
}
constexpr int NWAVES = 8;
constexpr int RING_OFF = 0, RING_BYTES = 131072;
constexpr int LDSCTL_OFF = RING_BYTES, MISC_OFF = LDSCTL_OFF + 320, RINV_OFF = LDSCTL_OFF + 1024;
constexpr int LDS_BYTES = 147456;
constexpr int CW_TMO = 0, CW_CODE = 1, CW_BAR = 4096, CW_CNT = 16384, CW_OWNQ = 20480, CW_SWAQ = 20544, CW_DONE = 20608;

#define GAS __attribute__((address_space(1)))
#define LAS __attribute__((address_space(3)))
typedef GAS unsigned gu32;
#define RLX_AGENT __ATOMIC_RELAXED, __HIP_MEMORY_SCOPE_AGENT
#define LDS_WAIT() asm volatile("s_waitcnt lgkmcnt(0)" ::: "memory")
#define VM_WAIT() asm volatile("s_waitcnt vmcnt(0)" ::: "memory")

#define XB_TMO      128
#define XB_XCNT(j)  (256  + 64 * (j))
#define XB_XSUB(j)  (1280 + 64 * (j))
#define XB_XGEN(j)  (2304 + 64 * (j))
#define XB_TOP      3328
#define XB_TOPGEN   3392
#define XCD_BAR_WORDS 3456
#define XB_SPIN_CAP (1u << 20)
__device__ __forceinline__ unsigned xb_ld(unsigned* p)              { return __hip_atomic_load(p, __ATOMIC_RELAXED, __HIP_MEMORY_SCOPE_AGENT); }
__device__ __forceinline__ unsigned xb_add(unsigned* p, unsigned v) { return __hip_atomic_fetch_add(p, v, __ATOMIC_RELAXED, __HIP_MEMORY_SCOPE_AGENT); }
__device__ __forceinline__ unsigned xb_xcc_id() { return (unsigned)__builtin_amdgcn_s_getreg((3 << 11) | 20) & 0xFu; }
#ifndef XB_SLEEP
#define XB_SLEEP 1
#endif
#define XB_SPIN(cond, bar) do { unsigned _sp = 0; while (cond) { if (XB_SLEEP) __builtin_amdgcn_s_sleep(XB_SLEEP); \
    if ((++_sp & 255u) == 0u) { if (xb_ld(&(bar)[XB_TMO])) break; if (_sp > XB_SPIN_CAP) { atomicAdd(&(bar)[XB_TMO], 1u); break; } } } } while (0)
struct XcdBarrier { unsigned* bar; unsigned x; volatile LAS unsigned* st; };
__device__ __forceinline__ XcdBarrier xcd_barrier_post(unsigned* bar, volatile LAS unsigned* st) {
    XcdBarrier b; b.bar = bar; b.x = xb_xcc_id(); b.st = st;
    if (threadIdx.x == 0) (void)xb_add(&bar[XB_XCNT(b.x)], 1u);
    return b;
}
__device__ __forceinline__ void xcd_barrier_complete(unsigned* bar, unsigned x, unsigned& nloc, unsigned& nx) {
    const unsigned G = gridDim.x * gridDim.y * gridDim.z;
    unsigned sum, cnt, mine, sp = 0u;
    for (;;) {
        sum = 0u; cnt = 0u; mine = 0u;
#pragma unroll
        for (unsigned j = 0; j < 16; ++j) { const unsigned c = xb_ld(&bar[XB_XCNT(j)]); sum += c; cnt += (c > 0u) ? 1u : 0u; mine = (j == x) ? c : mine; }
        if (sum == G) break;
        __builtin_amdgcn_s_sleep(1);
        if ((++sp & 255u) == 0u) { if (xb_ld(&bar[XB_TMO])) break; if (sp > XB_SPIN_CAP) { atomicAdd(&bar[XB_TMO], 1u); break; } }
    }
    nloc = mine > 0u ? mine : 1u; nx = cnt > 0u ? cnt : 1u;
}
__device__ __forceinline__ void xcd_barrier(const XcdBarrier& b) {
    asm volatile("s_waitcnt vmcnt(0)" ::: "memory");
    __syncthreads();
    if (threadIdx.x == 0) {
        unsigned* bar = b.bar;
        __builtin_amdgcn_s_waitcnt(0);
        unsigned nloc = b.st[0], nx = b.st[1];
        if (nloc == 0u) { xcd_barrier_complete(bar, b.x, nloc, nx); b.st[0] = nloc; b.st[1] = nx; }
        const unsigned old = xb_add(&bar[XB_XSUB(b.x)], 1u);
        const unsigned gen = old / nloc;
        if (old + 1u == (gen + 1u) * nloc) {
            __builtin_amdgcn_fence(__ATOMIC_RELEASE, "agent");
            asm volatile("s_waitcnt vmcnt(0)" ::: "memory");
            const unsigned og = xb_add(&bar[XB_TOP], 1u);
            const unsigned tg = og / nx;
            if (og + 1u == (tg + 1u) * nx) xb_add(&bar[XB_TOPGEN], 1u);
            else XB_SPIN(xb_ld(&bar[XB_TOPGEN]) == tg, bar);
            __builtin_amdgcn_fence(__ATOMIC_ACQUIRE, "agent");
            xb_add(&bar[XB_XGEN(b.x)], 1u);
            asm volatile("s_waitcnt vmcnt(0)" ::: "memory");
        } else {
            XB_SPIN(xb_ld(&bar[XB_XGEN(b.x)]) == gen, bar);
            __builtin_amdgcn_fence(__ATOMIC_ACQUIRE, "agent");
            asm volatile("s_waitcnt vmcnt(0)" ::: "memory");
        }
    }
    __syncthreads();
}

struct Frame {
    LAS unsigned char* lds;
    int tid, lane, wave, vcu, G;
};

struct ConvItem { const float* W; const float* gain; bf16* WT; int N, Kdst, k_off, k0, n0, drow0; };
__device__ __forceinline__ bool conv_decode(ConvItem& c, KP P, int l, int it) {
    constexpr int I_IN = 16 * 160, I_GLU = 8 * 32, I_MRG = 3 * 8 * 32, I_OUT = 16 * 32, I_F1 = 16 * 128, I_F2 = 64 * 32;
    constexpr int NITEMS = I_IN + I_GLU + I_MRG + I_OUT + I_F1 + I_F2;
    if (it >= NITEMS) return false;
    unsigned char* ws = P->ws; int r = it; c.gain = nullptr; c.k_off = 0;
    if (r < I_IN) { const int kb = r / 160, nb = r % 160; c.W = P->w_in + (size_t)l * DM * DIN; c.N = DIN; c.gain = P->norm_mix + l * DM; c.WT = (bf16*)(ws + WS_WIN); c.Kdst = DM; c.k0 = 64 * kb; c.n0 = 32 * nb; c.drow0 = 32 * nb; return true; } r -= I_IN;
    if (r < I_GLU) { const int kb = r / 32, nb = r % 32; const int n0 = 32 * nb, v = n0 & 511;
        c.W = P->w_glu + (size_t)l * 512 * 1024; c.N = 1024; c.WT = (bf16*)(ws + WS_WGLU); c.Kdst = 512; c.k0 = 64 * kb; c.n0 = n0; c.drow0 = (v >> 7) * 256 + (n0 >= 512 ? 128 : 0) + (v & 127); return true; } r -= I_GLU;
    if (r < I_MRG) { const int sg = r / 256, q = r % 256, kb = q / 32, nb = q % 32; c.W = (sg == 0 ? P->w_o_swa : (sg == 1 ? P->w_o_ssm : P->w_o_moba)) + (size_t)l * 512 * DM;
        c.N = DM; c.WT = (bf16*)(ws + WS_WMRG); c.Kdst = 1536; c.k_off = 512 * sg; c.k0 = 64 * kb; c.n0 = 32 * nb; c.drow0 = 32 * nb; return true; } r -= I_MRG;
    if (r < I_OUT) { const int kb = r / 32, nb = r % 32; c.W = P->w_out + (size_t)l * DM * DM; c.N = DM; c.WT = (bf16*)(ws + WS_WOUT); c.Kdst = DM; c.k0 = 64 * kb; c.n0 = 32 * nb; c.drow0 = 32 * nb; return true; } r -= I_OUT;
    if (r < I_F1) { const int kb = r / 128, nb = r % 128; c.W = P->w_ff1 + (size_t)l * DM * DFF; c.N = DFF; c.gain = P->norm_ffn + l * DM; c.WT = (bf16*)(ws + WS_WFF1); c.Kdst = DM; c.k0 = 64 * kb; c.n0 = 32 * nb; c.drow0 = 32 * nb; return true; } r -= I_F1;
    { const int kb = r / 32, nb = r % 32; c.W = P->w_ff2 + (size_t)l * DFF * DM; c.N = DM; c.WT = (bf16*)(ws + WS_WFF2); c.Kdst = DFF; c.k0 = 64 * kb; c.n0 = 32 * nb; c.drow0 = 32 * nb; return true; }
}
__device__ __forceinline__ void conv_loads(f32x4 (&wv)[8], const ConvItem& c, int lane) {
#pragma unroll
    for (int i = 0; i < 8; ++i) wv[i] = *(const f32x4*)(c.W + (size_t)(c.k0 + 8 * i + (lane >> 3)) * c.N + c.n0 + 4 * (lane & 7));
}
__device__ __forceinline__ void conv_store(const f32x4 (&wv)[8], const ConvItem& c, LAS float* scr, int lane) {
#pragma unroll
    for (int i = 0; i < 8; ++i) { const int kk = 8 * i + (lane >> 3); const float g = c.gain ? c.gain[c.k0 + kk] : 1.f; LAS float* sp = scr + kk * 33 + 4 * (lane & 7);
        sp[0] = wv[i][0] * g; sp[1] = wv[i][1] * g; sp[2] = wv[i][2] * g; sp[3] = wv[i][3] * g; }
    LDS_WAIT(); asm volatile("" ::: "memory");
    const int cc = lane & 7;
#pragma unroll
    for (int j = 0; j < 4; ++j) { const int n = (lane >> 3) + 8 * j; const LAS float* s = scr + (8 * cc) * 33 + n;
        u32x4 o; o.x = pk2(s[0 * 33], s[1 * 33]); o.y = pk2(s[2 * 33], s[3 * 33]); o.z = pk2(s[4 * 33], s[5 * 33]); o.w = pk2(s[6 * 33], s[7 * 33]);
        if ((WT_MASK & 8) != 0) { const __amdgpu_buffer_rsrc_t wr_ = __builtin_amdgcn_make_buffer_rsrc(c.WT, 0, 16 << 20, 0x00020000); __builtin_amdgcn_raw_buffer_store_b128(o, wr_, (unsigned)(((size_t)(c.drow0 + n) * c.Kdst + c.k_off + c.k0 + 8 * cc) * 2), 0, 16); }
        else *(GAS u32x4*)(c.WT + (size_t)(c.drow0 + n) * c.Kdst + c.k_off + c.k0 + 8 * cc) = o; }
    LDS_WAIT(); asm volatile("" ::: "memory");
}
__device__ __forceinline__ void conv_layer(const Frame& F, KP P, int l) {
    LAS float* scr = (LAS float*)(F.lds + RING_OFF + F.wave * 16384);
    const int gw = F.vcu * NWAVES + F.wave, NGW = F.G * NWAVES;
    f32x4 wa[8], wb[8];
    int it = gw; bool have;
    { ConvItem c; have = conv_decode(c, P, l, it); if (have) conv_loads(wa, c, F.lane); }
#pragma unroll 1
    while (have) {
        bool hn; { ConvItem n; hn = conv_decode(n, P, l, it + NGW); if (hn) conv_loads(wb, n, F.lane); }
        { ConvItem c; conv_decode(c, P, l, it); asm volatile("" ::: "memory"); conv_store(wa, c, scr, F.lane); }
        have = hn; it += NGW;
#pragma unroll
        for (int i = 0; i < 8; ++i) wa[i] = wb[i];
    }
}
__device__ __forceinline__ void ssm_mats(const Frame& F, KP P, int l) {
    __syncthreads();
    LAS float* L = (LAS float*)(F.lds + RING_OFF);
    LAS float* apr = L;
    LAS float* api = L + 17 * 64;
    LAS float* bbr = L + 34 * 64;
    LAS float* bbi = bbr + 1024;
    LAS float* ccr = bbi + 1024;
    LAS float* cci = ccr + 1024;
    LAS float* ktab = cci + 1024;
    for (int wi = F.vcu; wi < 256; wi += F.G) {
        const int g = wi >> 3, part = wi & 7; const int tid = F.tid;
        if (tid < 64) { const int p = tid; const float lr = P->lam_re[l * 2048 + g * 64 + p], li = P->lam_im[l * 2048 + g * 64 + p], dt = expf(P->log_step[l * 32 + g]);
            const float mag = expf(lr * dt), are = mag * cosf(li * dt), aim = mag * sinf(li * dt);
            const float den = lr * lr + li * li, nr = are - 1.f, ni = aim, fre = (nr * lr + ni * li) / den, fim = (ni * lr - nr * li) / den;
            float pr = 1.f, pi = 0.f;
            for (int k = 0; k <= 16; ++k) { apr[k * 64 + p] = pr; api[k * 64 + p] = pi; const float t = pr * are - pi * aim; pi = pr * aim + pi * are; pr = t; }
            for (int h = 0; h < 16; ++h) { const float br = P->b_re[(size_t)l * 32768 + (g * 64 + p) * 16 + h], bi = P->b_im[(size_t)l * 32768 + (g * 64 + p) * 16 + h]; bbr[p * 16 + h] = fre * br - fim * bi; bbi[p * 16 + h] = fre * bi + fim * br; } }
        for (int e = tid; e < 1024; e += 512) { ccr[e] = P->c_re[(size_t)l * 32768 + g * 1024 + e]; cci[e] = P->c_im[(size_t)l * 32768 + g * 1024 + e]; }
        __syncthreads();
        for (int e = tid; e < 512; e += 512) { const int tau = e >> 5, i = 2 * part + ((e >> 4) & 1), j = e & 15; float acc = 0.f;
            for (int p = 0; p < 64; ++p) { const float cr = ccr[i * 64 + p], ci = cci[i * 64 + p], ar = apr[tau * 64 + p], ai = api[tau * 64 + p]; const float er = cr * ar - ci * ai, ei = cr * ai + ci * ar; acc += er * bbr[p * 16 + j] - ei * bbi[p * 16 + j]; }
            if (tau == 0 && i == j) acc += P->d_skip[l * 512 + g * 16 + i];
            ktab[tau * 256 + i * 16 + j] = acc; }
        __syncthreads();
        bf16* BM_ = (bf16*)(P->ws + WS_SMAIN) + (size_t)g * 256 * SSM_KM;
        for (int e = tid; e < 32 * SSM_KM / 2; e += 512) {
            const int rr = e / (SSM_KM / 2), k = (e % (SSM_KM / 2)) * 2, s = rr >> 1, i = 2 * part + (rr & 1), n = s * 16 + i; float v[2];
#pragma unroll
            for (int q = 0; q < 2; ++q) { const int kk = k + q;
                if (kk < 256) { const int sp = kk >> 4, j = kk & 15; v[q] = (sp <= s) ? ktab[(s - sp) * 256 + i * 16 + j] : 0.f; }
                else { const int p = (kk - 256) & 63; const float cr = ccr[i * 64 + p], ci = cci[i * 64 + p], ar = apr[(s + 1) * 64 + p], ai = api[(s + 1) * 64 + p]; v[q] = (kk < 320) ? (cr * ar - ci * ai) : -(cr * ai + ci * ar); } }
            *(GAS unsigned*)(BM_ + (size_t)n * SSM_KM + k) = pk2(v[0], v[1]); }
        bf16* BE_ = (bf16*)(P->ws + WS_SEND) + (size_t)g * 256 * SSM_KE;
        for (int e = tid; e < 32 * SSM_KE / 2; e += 512) {
            const int n = part * 32 + e / (SSM_KE / 2), k = (e % (SSM_KE / 2)) * 2; float v[2];
#pragma unroll
            for (int q = 0; q < 2; ++q) { const int kk = k + q, sp = kk >> 4, j = kk & 15, p = n & 63; const float ar = apr[(15 - sp) * 64 + p], ai = api[(15 - sp) * 64 + p], br = bbr[p * 16 + j], bi = bbi[p * 16 + j];
                v[q] = (n < 64) ? (ar * br - ai * bi) : ((n < 128) ? (ar * bi + ai * br) : 0.f); }
            *(GAS unsigned*)(BE_ + (size_t)n * SSM_KE + k) = pk2(v[0], v[1]); }
        __syncthreads();
    }
}
__device__ __forceinline__ void xb_pass(const Frame& F, KP P) {
    const int gw = F.vcu * NWAVES + F.wave, NGW = F.G * NWAVES;
    bf16* XB = (bf16*)(P->ws + WS_XN); float* SSQ = (float*)(P->ws + WS_SSQ);
    for (int m = gw; m < T; m += NGW) {
        const GAS f32x4* xr = (const GAS f32x4*)(P->x_in + (size_t)m * DM) + F.lane;
        f32x4 v[4]; float s = 0.f;
#pragma unroll
        for (int j = 0; j < 4; ++j) { v[j] = xr[64 * j]; s += (v[j].x * v[j].x + v[j].y * v[j].y) + (v[j].z * v[j].z + v[j].w * v[j].w); }
        s = wave_sum(s);
        GAS unsigned long long* o8 = (GAS unsigned long long*)(XB + (size_t)m * DM) + F.lane;
#pragma unroll
        for (int j = 0; j < 4; ++j) o8[64 * j] = (unsigned long long)pk2(v[j].x, v[j].y) | ((unsigned long long)pk2(v[j].z, v[j].w) << 32);
        if (F.lane < 16) SSQ[(size_t)m * 16 + F.lane] = (F.lane == 0) ? s : 0.f;
    }
}
__device__ __forceinline__ void final_pass(const Frame& F, KP P) {
    const int gw = F.vcu * NWAVES + F.wave, NGW = F.G * NWAVES;
    for (int m = gw; m < T; m += NGW) {
        GAS f32x4* xr = (GAS f32x4*)(P->x + (size_t)m * DM) + F.lane;
        f32x4 v[4]; float s = 0.f;
#pragma unroll
        for (int j = 0; j < 4; ++j) { v[j] = xr[64 * j]; s += (v[j].x * v[j].x + v[j].y * v[j].y) + (v[j].z * v[j].z + v[j].w * v[j].w); }
        const float r = rsqrtf(wave_sum(s) * (1.f / DM) + NORM_EPS);
#pragma unroll
        for (int j = 0; j < 4; ++j) { const f32x4 g = ((const GAS f32x4*)P->norm_final)[F.lane + 64 * j]; xr[64 * j] = v[j] * r * g; }
    }
}
__device__ __forceinline__ void ssm_carry(const Frame& F, KP P, int l) {
    if (F.vcu & 15) return;
    const int gt = (F.vcu >> 4) * 512 + F.tid;
    if (gt >= 32 * NB * 64) return;
    const int p = gt & 63, b = (gt >> 6) & 3, g = gt >> 8;
    const float lr = P->lam_re[l * 2048 + g * 64 + p], li = P->lam_im[l * 2048 + g * 64 + p], dt = expf(P->log_step[l * 32 + g]);
    const float mag = expf(lr * dt), are = mag * cosf(li * dt), aim = mag * sinf(li * dt);
    float pr = 1.f, pi = 0.f;
    for (int k = 0; k < 16; ++k) { const float t = pr * are - pi * aim; pi = pr * aim + pi * are; pr = t; }
    const float* he = (const float*)(P->ws + WS_HEND) + ((size_t)g * NCH + b * 256) * 128 + p;
    bf16* hi = (bf16*)(P->ws + WS_HINIT) + ((size_t)g * NCH + b * 256) * 128 + p;
    float sr = 0.f, si = 0.f;
    float er[8], ei[8];
#pragma unroll
    for (int q = 0; q < 8; ++q) { er[q] = he[(size_t)q * 128]; ei[q] = he[(size_t)q * 128 + 64]; }
    for (int c0 = 0; c0 < 256; c0 += 8) {
        float nr_[8], ni_[8];
        const int cn = (c0 + 8 < 256) ? c0 + 8 : c0;
#pragma unroll
        for (int q = 0; q < 8; ++q) { nr_[q] = he[(size_t)(cn + q) * 128]; ni_[q] = he[(size_t)(cn + q) * 128 + 64]; }
#pragma unroll
        for (int q = 0; q < 8; ++q) { hi[(size_t)(c0 + q) * 128] = (bf16)f2bf(sr); hi[(size_t)(c0 + q) * 128 + 64] = (bf16)f2bf(si);
            const float tr = pr * sr - pi * si + er[q], ti = pr * si + pi * sr + ei[q]; sr = tr; si = ti; }
#pragma unroll
        for (int q = 0; q < 8; ++q) { er[q] = nr_[q]; ei[q] = ni_[q]; }
    }
}
namespace att {
__device__ __forceinline__ int crow(int r, int hi) { return (r & 3) + 8 * (r >> 2) + 4 * hi; }
struct St { f32x16 o0, o1; float m, l; };
__device__ __forceinline__ unsigned cvtpk(float lo, float hi) { return cvtpk_s(lo, hi); }

__device__ __forceinline__ void loadk(bf16x8 (&kf)[8], const bf16* kp) {
#pragma unroll
    for (int d0 = 0; d0 < 4; ++d0) { kf[2 * d0] = *(const bf16x8*)(kp + d0 * 16); kf[2 * d0 + 1] = *(const bf16x8*)(kp + 32 * 128 + d0 * 16); }
}
template <int MODE>
__device__ __forceinline__ void tile(St& st, const bf16x8 (&qr)[4], const bf16x8 (&kf)[8], const bf16* vtp  , int kq  , float sl2, bool rowok, int klo  , int hi) {
    f32x16 p0 = {}, p1 = {};
#pragma unroll
    for (int d0 = 0; d0 < 4; ++d0) { p0 = __builtin_amdgcn_mfma_f32_32x32x16_bf16(kf[2 * d0], qr[d0], p0, 0, 0, 0); p1 = __builtin_amdgcn_mfma_f32_32x32x16_bf16(kf[2 * d0 + 1], qr[d0], p1, 0, 0, 0); }
    s16x4 vl[2][4], vh[2][4];
#pragma unroll
    for (int dh = 0; dh < 2; ++dh)
#pragma unroll
        for (int s = 0; s < 4; ++s) { vl[dh][s] = *(const s16x4*)(vtp + (size_t)dh * 32 * S + 16 * s); vh[dh][s] = *(const s16x4*)(vtp + (size_t)dh * 32 * S + 16 * s + 8); }
    const float base = sl2 * (float)(kq + 4 * hi);
    float mx = -INFINITY;
#pragma unroll
    for (int r = 0; r < 16; ++r) { const int c = (r & 3) + 8 * (r >> 2); const int k0 = kq + 4 * hi + c, k1 = k0 + 32;
        float a = fmaf(sl2, (float)c, p0[r]), b = fmaf(sl2, (float)(c + 32), p1[r]);
        if (MODE == 1) { a = (k0 <= 0 && k0 >= klo) ? a : -INFINITY; b = (k1 <= 0 && k1 >= klo) ? b : -INFINITY; }
        else if (MODE == 2) { a = (k0 <= 0) ? a : -INFINITY; b = (k1 <= 0) ? b : -INFINITY; }
        else if (MODE == 3) { a = (rowok && k0 <= 0) ? a : -INFINITY; b = (rowok && k1 <= 0) ? b : -INFINITY; }
        p0[r] = a; p1[r] = b; mx = fmaxf(mx, fmaxf(a, b)); }
    mx += base;
    mx = fmaxf(mx, __shfl_xor(mx, 32));
    const float mn = fmaxf(st.m, mx), alpha = __builtin_amdgcn_exp2f(st.m - mn), off = base - mn;
    float sum = 0.f;
#pragma unroll
    for (int r = 0; r < 16; ++r) { p0[r] = __builtin_amdgcn_exp2f(p0[r] + off); p1[r] = __builtin_amdgcn_exp2f(p1[r] + off); sum += p0[r] + p1[r]; }
    st.m = mn; st.l = st.l * alpha + sum;
#pragma unroll
    for (int r = 0; r < 16; ++r) { st.o0[r] *= alpha; st.o1[r] *= alpha; }
    bf16x8 pf[4];
#pragma unroll
    for (int s = 0; s < 2; ++s) { u32x4 w0, w1;
        w0.x = cvtpk(p0[8 * s + 0], p0[8 * s + 1]); w0.y = cvtpk(p0[8 * s + 2], p0[8 * s + 3]); w0.z = cvtpk(p0[8 * s + 4], p0[8 * s + 5]); w0.w = cvtpk(p0[8 * s + 6], p0[8 * s + 7]);
        w1.x = cvtpk(p1[8 * s + 0], p1[8 * s + 1]); w1.y = cvtpk(p1[8 * s + 2], p1[8 * s + 3]); w1.z = cvtpk(p1[8 * s + 4], p1[8 * s + 5]); w1.w = cvtpk(p1[8 * s + 6], p1[8 * s + 7]);
        pf[s] = __builtin_bit_cast(bf16x8, w0); pf[2 + s] = __builtin_bit_cast(bf16x8, w1); }
#pragma unroll
    for (int s = 0; s < 4; ++s) {
        const bf16x8 v0 = (bf16x8){vl[0][s][0], vl[0][s][1], vl[0][s][2], vl[0][s][3], vh[0][s][0], vh[0][s][1], vh[0][s][2], vh[0][s][3]};
        const bf16x8 v1 = (bf16x8){vl[1][s][0], vl[1][s][1], vl[1][s][2], vl[1][s][3], vh[1][s][0], vh[1][s][1], vh[1][s][2], vh[1][s][3]};
        st.o0 = __builtin_amdgcn_mfma_f32_32x32x16_bf16(v0, pf[s], st.o0, 0, 0, 0);
        st.o1 = __builtin_amdgcn_mfma_f32_32x32x16_bf16(v1, pf[s], st.o1, 0, 0, 0); }
}
__device__ __forceinline__ void finish(const St& st, bf16* op, int hi) {
    const float lt = st.l + __shfl_xor(st.l, 32), rl = __builtin_amdgcn_rcpf(lt);
#pragma unroll
    for (int g = 0; g < 4; ++g) { u32x2 a, b;
        a.x = cvtpk(st.o0[4 * g] * rl, st.o0[4 * g + 1] * rl); a.y = cvtpk(st.o0[4 * g + 2] * rl, st.o0[4 * g + 3] * rl);
        b.x = cvtpk(st.o1[4 * g] * rl, st.o1[4 * g + 1] * rl); b.y = cvtpk(st.o1[4 * g + 2] * rl, st.o1[4 * g + 3] * rl);
        *(u32x2*)(op + 8 * g + 4 * hi) = a; *(u32x2*)(op + 32 + 8 * g + 4 * hi) = b; }
}
__device__ __forceinline__ void loadq(bf16x8 (&qr)[4], const bf16* qp) {
#pragma unroll
    for (int d0 = 0; d0 < 4; ++d0) qr[d0] = *(const bf16x8*)(qp + d0 * 16);
}

constexpr int IMG_K = 0, IMG_V = 32768, IMG_BYTES = 65536;
__device__ __forceinline__ void img_load(const Frame& F, LAS unsigned char* img, const bf16* K, long krow0, int kvh, const bf16* vt0, int key0) {
    const int lane = F.lane, w = F.wave;
#pragma unroll
    for (int i = 0; i < 4; ++i) { const int piece = w * 4 + i, key = piece * 8 + (lane >> 3), c = (lane & 7) ^ ((key >> 1) & 7); long row = krow0 + key; row = row < 0 ? 0 : row;
        __builtin_amdgcn_global_load_lds((const unsigned*)(K + row * 128 + kvh * 64 + c * 8), (LAS unsigned*)(img + IMG_K + piece * 1024), 16, 0, 0); }
#pragma unroll
    for (int i = 0; i < 4; ++i) { const int piece = w * 4 + i, d = piece * 2 + (lane >> 5), c = (lane & 31) ^ (d & 15); int kk = key0 + c * 8; kk = kk < 0 ? 0 : kk;
        __builtin_amdgcn_global_load_lds((const unsigned*)(vt0 + (long)d * S + kk), (LAS unsigned*)(img + IMG_V + piece * 1024), 16, 0, 0); }
}
struct LaneOff { int k[4]; int v[4]; };
__device__ __forceinline__ void lane_off(LaneOff& lo, int r32, int hi) { const int s7 = (r32 >> 1) & 7, x = r32 & 15;
#pragma unroll
    for (int d0 = 0; d0 < 4; ++d0) lo.k[d0] = ((2 * d0 + hi) ^ s7) << 4;
#pragma unroll
    for (int s = 0; s < 4; ++s) lo.v[s] = ((2 * s + hi) ^ (x & 7)) << 4; }
__device__ __forceinline__ float vmax3(float a, float b, float c) { float r; asm("v_max3_f32 %0, %1, %2, %3" : "=v"(r) : "v"(a), "v"(b), "v"(c)); return r; }
__device__ __forceinline__ float xhalf_max(float v) { float a = v, b = v; asm("s_nop 1\n\tv_permlane32_swap_b32 %0, %1" : "+v"(a), "+v"(b)); return fmaxf(a, b); }
template <bool HALF>
__device__ __forceinline__ void read_k(bf16x8 (&kf)[8], const LAS unsigned char* img, const LaneOff& lo, int ko, int r32) {
    const LAS unsigned char* kp = img + IMG_K + (ko + r32) * 128;
#pragma unroll
    for (int d0 = 0; d0 < 4; ++d0) { kf[2 * d0] = *(const LAS bf16x8*)(kp + lo.k[d0]); if (!HALF) kf[2 * d0 + 1] = *(const LAS bf16x8*)(kp + 32 * 128 + lo.k[d0]); }
}
template <int MODE, bool HALF, bool AL64, bool NEXTK>
__device__ __forceinline__ void tile_run(St& st, const bf16x8 (&qr)[4], bf16x8 (&kf)[8], const LAS unsigned char* img, const LaneOff& lo, int ko, int kq  , float sl2, bool rowok, int klo, int hi, int r32, int ko_next) {
    const bool fresh = st.m == -INFINITY; const float ref = fresh ? 0.f : st.m;
    const float cin = sl2 * (float)(kq + 4 * hi) - ref, cin1 = cin + 32.f * sl2;
    f32x16 p0, p1;
#pragma unroll
    for (int r = 0; r < 16; ++r) { const float c = (float)((r & 3) + 8 * (r >> 2)); p0[r] = fmaf(sl2, c, cin); p1[r] = fmaf(sl2, c, cin1); }
#pragma unroll
    for (int d0 = 0; d0 < 4; ++d0) {
        p0 = __builtin_amdgcn_mfma_f32_32x32x16_bf16(kf[2 * d0], qr[d0], p0, 0, 0, 0);
        if (!HALF) p1 = __builtin_amdgcn_mfma_f32_32x32x16_bf16(kf[2 * d0 + 1], qr[d0], p1, 0, 0, 0); }
    __builtin_amdgcn_sched_barrier(0);
    const int x = r32 & 15, kc = ko >> 3;
    const LAS unsigned char* vp = img + IMG_V + r32 * 512 + (AL64 ? ((kc ^ (x & 8)) << 4) : 0);
    constexpr int NS = HALF ? 2 : 4;
    bf16x8 va[NS], vb[NS];
#pragma unroll
    for (int s = 0; s < NS; ++s) { const int o = AL64 ? lo.v[s] : (((kc + 2 * s + hi) ^ x) << 4);
        va[s] = *(const LAS bf16x8*)(vp + o); vb[s] = *(const LAS bf16x8*)(vp + 32 * 512 + o); }
    if (NEXTK) read_k<false>(kf, img, lo, ko_next, r32);
    __builtin_amdgcn_sched_barrier(0);
    if (MODE != 0) {
#pragma unroll
        for (int r = 0; r < 16; ++r) { const int c = (r & 3) + 8 * (r >> 2); const int k0 = kq + 4 * hi + c, k1 = k0 + 32;
            float a = p0[r], b = HALF ? -INFINITY : p1[r];
            if (MODE == 1) { a = (k0 <= 0 && k0 >= klo) ? a : -INFINITY; if (!HALF) b = (k1 <= 0 && k1 >= klo) ? b : -INFINITY; }
            else if (MODE == 2) { a = (k0 <= 0) ? a : -INFINITY; if (!HALF) b = (k1 <= 0) ? b : -INFINITY; }
            else if (MODE == 3) { a = (rowok && k0 <= 0) ? a : -INFINITY; if (!HALF) b = (rowok && k1 <= 0) ? b : -INFINITY; }
            p0[r] = a; if (!HALF) p1[r] = b; }
    }
    float ma = fmaxf(p0[0], HALF ? p0[1] : p1[0]), mb = ma;
    if (HALF) {
#pragma unroll
        for (int r = 2; r < 14; r += 4) { ma = vmax3(ma, p0[r], p0[r + 1]); mb = vmax3(mb, p0[r + 2], p0[r + 3]); }
        ma = vmax3(ma, p0[14], p0[15]);
    } else {
#pragma unroll
        for (int r = 1; r < 15; r += 2) { ma = vmax3(ma, p0[r], p0[r + 1]); mb = vmax3(mb, p1[r], p1[r + 1]); }
        ma = vmax3(ma, p0[15], p1[15]);
    }
    const float mxh = fmaxf(ma, mb);
    if (__builtin_expect(__any(fresh || mxh > 8.f), 0)) {
        asm volatile("" ::: "memory");
        const float mx = xhalf_max(mxh);
        const float delta = fresh ? ((mx == -INFINITY) ? 0.f : mx) : ((mx > 8.f) ? mx : 0.f);
        const float alpha = fresh ? 1.f : __builtin_amdgcn_exp2f(-delta);
#pragma unroll
        for (int r = 0; r < 16; ++r) { p0[r] -= delta; if (!HALF) p1[r] -= delta; st.o0[r] *= alpha; st.o1[r] *= alpha; }
        st.l *= alpha;
        st.m = (fresh && mx == -INFINITY) ? -INFINITY : ref + delta;
    }
#pragma unroll
    for (int r = 0; r < 16; ++r) { p0[r] = __builtin_amdgcn_exp2f(p0[r]); if (!HALF) p1[r] = __builtin_amdgcn_exp2f(p1[r]); }
    { f32x2_t s2 = {0.f, 0.f};
#pragma unroll
      for (int r = 0; r < 16; r += 2) { s2 += (f32x2_t){p0[r], p0[r + 1]}; if (!HALF) s2 += (f32x2_t){p1[r], p1[r + 1]}; }
      st.l += s2[0] + s2[1]; }
#pragma unroll
    for (int s = 0; s < NS; ++s) {
        u32x4 w;
        if (s < 2) { w.x = cvtpk(p0[8 * s + 0], p0[8 * s + 1]); w.y = cvtpk(p0[8 * s + 2], p0[8 * s + 3]); w.z = cvtpk(p0[8 * s + 4], p0[8 * s + 5]); w.w = cvtpk(p0[8 * s + 6], p0[8 * s + 7]); }
        else { w.x = cvtpk(p1[8 * s - 16], p1[8 * s - 15]); w.y = cvtpk(p1[8 * s - 14], p1[8 * s - 13]); w.z = cvtpk(p1[8 * s - 12], p1[8 * s - 11]); w.w = cvtpk(p1[8 * s - 10], p1[8 * s - 9]); }
        const bf16x8 pf = __builtin_bit_cast(bf16x8, w);
        st.o0 = __builtin_amdgcn_mfma_f32_32x32x16_bf16(va[s], pf, st.o0, 0, 0, 0);
        st.o1 = __builtin_amdgcn_mfma_f32_32x32x16_bf16(vb[s], pf, st.o1, 0, 0, 0); }
}
template <int MODE, bool HALF, bool AL64>
__device__ __forceinline__ void tile_lds(St& st, const bf16x8 (&qr)[4], const LAS unsigned char* img, const LaneOff& lo, int ko, int kq  , float sl2, bool rowok, int klo, int hi, int r32) {
    bf16x8 kf[8];
    read_k<HALF>(kf, img, lo, ko, r32);
    __builtin_amdgcn_sched_barrier(0);
    tile_run<MODE, HALF, AL64, false>(st, qr, kf, img, lo, ko, kq, sl2, rowok, klo, hi, r32, 0);
}
__device__ __forceinline__ void swa_unit(const Frame& F, KP P, int l, int un) {
    bf16* QA = (bf16*)(P->ws + WS_QA); const bf16* KA = (const bf16*)(P->ws + WS_KA); const bf16* VAT = (const bf16*)(P->ws + WS_VAT);
    Frame F2 = F; asm volatile("" : "+v"(F2.lane));
    const int lane = F2.lane, r32 = lane & 31, hi = lane >> 5, w = F.wave;
    LAS unsigned char* img = F.lds + RING_OFF;
    LaneOff lo; lane_off(lo, r32, hi);
    {
        const int bk = un >> 5, nb = un & 31, b = bk >> 1, kvh = bk & 1, h = kvh * 4 + (w >> 1);
        __syncthreads();
        img_load(F2, img, KA, (long)b * S + nb * 128 - 128, kvh, VAT + (long)((b * 2 + kvh) * 64) * S, nb * 128 - 128);
        const float sl2 = exp2f(-0.5f * (float)(h + 1)) * LOG2E, sink2 = P->sinks[l * 8 + h] * LOG2E;
        bf16x8 qn[4]; loadq(qn, QA + (size_t)(b * S + nb * 128 + (w & 1) * 64 + r32) * 512 + h * 64 + 8 * hi);
        asm volatile("s_waitcnt vmcnt(0)" ::: "memory"); __syncthreads();
#pragma unroll 1
        for (int qt = 0; qt < 2; ++qt) {
            const int qo = (w & 1) * 64 + qt * 32, t0 = nb * 128 + qo, q = t0 + r32;
            bf16* qrow = QA + (size_t)(b * S + q) * 512 + h * 64;
            bf16x8 qr[4];
            if (qt == 0) {
#pragma unroll
                for (int i = 0; i < 4; ++i) qr[i] = qn[i];
            } else loadq(qr, qrow + 8 * hi);
            St st; st.o0 = f32x16{}; st.o1 = f32x16{}; st.m = sink2; st.l = hi ? 0.f : 1.f;
            const int klo = q < 127 ? -q : -127;
            bf16x8 kf[8]; read_k<false>(kf, img, lo, qo, r32);
#pragma unroll 1
            for (int kt = 0; kt < 2; ++kt) tile_run<1, false, false, true>(st, qr, kf, img, lo, qo + 64 * kt, t0 - 128 + 64 * kt - q, sl2, true, klo, hi, r32, qo + 64 * kt + 64);
            tile_run<1, true, false, false>(st, qr, kf, img, lo, qo + 128, t0 - q, sl2, true, klo, hi, r32, 0);
            finish(st, qrow, hi);
        }
    }
    __syncthreads();
}
__device__ __forceinline__ float moba_sl2(int h) { return exp2f(-0.5f * (float)(8 + h + 1)) * LOG2E; }
__device__ __forceinline__ void select_unit(const Frame& F, KP P, int l, int un) {
    const bf16* QM = (const bf16*)(P->ws + WS_QM); const float* KMP = (const float*)(P->ws + WS_KMP);
    unsigned* LIST = (unsigned*)(P->ws + WS_LIST); unsigned* CNT = (unsigned*)(P->ws + WS_CTL) + CW_CNT + l * 128;
    LAS float* km = (LAS float*)(F.lds + RING_OFF);
    int tid_ = F.tid; asm volatile("" : "+v"(tid_));
    const int tid = tid_, lane = tid & 63;
    {
        const int bk = un >> 5, ch = un & 31, b = bk >> 1, kvh = bk & 1, j = ch >> 1;
        __syncthreads();
        for (int e = tid; e < 1024; e += 512) { const int n = e >> 6, d = e & 63; const float* k0 = KMP + (size_t)(b * 16 + n) * 128 + kvh * 64 + d; km[e] = k0[0] + k0[64 * 128]; }
        __syncthreads();
        if (j == 0) return;
        const int hg = tid >> 7, t = ch * 128 + (tid & 127);
        const bf16* qp = QM + (size_t)(b * S + t) * 512 + (kvh * 4 + hg) * 64;
        u32x4 qv[8];
#pragma unroll
        for (int i = 0; i < 8; ++i) qv[i] = *(const u32x4*)(qp + 8 * i);
        int i0 = 0, i1 = 1, i2 = 2;
        if (j > 3) {
            float v0 = -INFINITY, v1 = -INFINITY, v2 = -INFINITY; i0 = 0; i1 = 0; i2 = 0;
#pragma unroll 1
            for (int n = 0; n < j; ++n) { float a = 0.f;
#pragma unroll
                for (int i = 0; i < 8; ++i) { const f32x4 x0 = *(const LAS f32x4*)(km + n * 64 + 8 * i), x1 = *(const LAS f32x4*)(km + n * 64 + 8 * i + 4);
                    a += bf2f(qv[i].x & 0xffffu) * x0[0] + bf2f(qv[i].x >> 16) * x0[1] + bf2f(qv[i].y & 0xffffu) * x0[2] + bf2f(qv[i].y >> 16) * x0[3]
                       + bf2f(qv[i].z & 0xffffu) * x1[0] + bf2f(qv[i].z >> 16) * x1[1] + bf2f(qv[i].w & 0xffffu) * x1[2] + bf2f(qv[i].w >> 16) * x1[3]; }
                if (a > v0) { v2 = v1; i2 = i1; v1 = v0; i1 = i0; v0 = a; i0 = n; } else if (a > v1) { v2 = v1; i2 = i1; v1 = a; i1 = n; } else if (a > v2) { v2 = a; i2 = n; } }
        }
        const int nsel = j < 3 ? j : 3;
        unsigned mycnt = 0u;
#pragma unroll 1
        for (int n = 0; n < j; ++n) { const bool sel = (n == i0 && nsel > 0) || (n == i1 && nsel > 1) || (n == i2 && nsel > 2); const unsigned long long mask = __ballot(sel); if (lane == n) mycnt = (unsigned)__popcll(mask); }
        unsigned mybase = 0u;
        if (lane < j && mycnt) mybase = __hip_atomic_fetch_add(CNT + bk * 16 + lane, mycnt, __ATOMIC_RELAXED, __HIP_MEMORY_SCOPE_AGENT);
#pragma unroll 1
        for (int n = 0; n < j; ++n) {
            const int r = (n == i0) ? 0 : ((n == i1) ? 1 : ((n == i2) ? 2 : 3));
            const bool sel = r < nsel;
            const unsigned long long mask = __ballot(sel);
            if (mask == 0ull) continue;
            const unsigned base = (unsigned)__shfl((int)mybase, n);
            const unsigned pos = base + (unsigned)__popcll(mask & ((1ull << lane) - 1ull));
            if (sel) LIST[(size_t)(bk * 16 + n) * 16384 + pos] = ((unsigned)t << 4) | ((unsigned)hg << 2) | (unsigned)r;
        }
    }
    __syncthreads();
}
__device__ __forceinline__ void swa_select_phase(const Frame& F, KP P, int l, int lq) {
    unsigned* qctr = (unsigned*)(P->ws + WS_CTL) + CW_SWAQ + lq;
    volatile LAS unsigned* jobw = (volatile LAS unsigned*)(F.lds + MISC_OFF + 64);
    for (;;) {
        __syncthreads();
        if (F.tid == 0) *jobw = __hip_atomic_fetch_add(qctr, 1u, __ATOMIC_RELAXED, __HIP_MEMORY_SCOPE_AGENT);
        __syncthreads();
        const int job = (int)*jobw;
        if (job >= 512) break;
        if (job < 256) swa_unit(F, P, l, job); else select_unit(F, P, lq, job - 256);
    }
}
__device__ __forceinline__ void store_o(const St& st, bf16* op, float rl, int hi) {
#pragma unroll
    for (int g = 0; g < 4; ++g) { u32x2 a, b;
        a.x = cvtpk(st.o0[4 * g] * rl, st.o0[4 * g + 1] * rl); a.y = cvtpk(st.o0[4 * g + 2] * rl, st.o0[4 * g + 3] * rl);
        b.x = cvtpk(st.o1[4 * g] * rl, st.o1[4 * g + 1] * rl); b.y = cvtpk(st.o1[4 * g + 2] * rl, st.o1[4 * g + 3] * rl);
        *(u32x2*)(op + 8 * g + 4 * hi) = a; *(u32x2*)(op + 32 + 8 * g + 4 * hi) = b; }
}
__device__ __forceinline__ void moba_gather(const Frame& F, KP P, int l, bool nostore = false) {
    const bf16* QM = (const bf16*)(P->ws + WS_QM); const bf16* KM = (const bf16*)(P->ws + WS_KM); const bf16* VMT = (const bf16*)(P->ws + WS_VMT);
    const unsigned* LIST = (const unsigned*)(P->ws + WS_LIST); unsigned* CNT = (unsigned*)(P->ws + WS_CTL) + CW_CNT + l * 128;
    bf16* PART = (bf16*)(P->ws + WS_PART); float* LSE = (float*)(P->ws + WS_LSE);
    const int lane = F.lane, r32 = lane & 31, hi = lane >> 5, w = F.wave;
    const int per = F.G >> 3;
    const int bk = F.vcu / per, loc = F.vcu % per;
    if (bk >= 8 || (F.vcu & 15) == 0) return;
    const int wg = loc - 1 - (loc > 16 ? 1 : 0), nwg = per - 2;
    const int b = bk >> 1, kvh = bk & 1;
    unsigned cnt = 0u;
    if (lane < 16) cnt = __hip_atomic_load(CNT + bk * 16 + lane, __ATOMIC_RELAXED, __HIP_MEMORY_SCOPE_AGENT);
    const int ns_l = (int)((cnt + 255u) >> 8);
    int pre = ns_l;
#pragma unroll
    for (int o = 1; o < 16; o <<= 1) { const int v = __shfl_up(pre, o); if (lane >= o) pre += v; }
    const int total = __shfl(pre, 15);
    const bf16* vt0 = VMT + (long)((b * 2 + kvh) * 64) * S;
    LAS unsigned char* ring = F.lds + RING_OFF;
    LaneOff lo; lane_off(lo, r32, hi);
    __syncthreads();
#define GA_LOCATE(it, n_, s_) do { const unsigned long long le_ = __ballot(lane < 16 && pre <= (it)); n_ = (int)__popcll(le_); s_ = (it) - ((n_ == 0) ? 0 : __shfl(pre, n_ - 1)); } while (0)
#define GA_ENTRY(e_, n_, s_) do { const int cn_ = (int)__shfl((int)cnt, n_), ti_ = (s_) * 8 + w, idx_ = ti_ * 32 + r32; e_ = 0u; if (ti_ * 32 < cn_) e_ = LIST[(size_t)(bk * 16 + n_) * 16384 + (idx_ < cn_ ? idx_ : ti_ * 32)]; } while (0)
#define GA_LOADQ(q_, e_) loadq(q_, QM + ((size_t)(b * S + (int)((e_) >> 4))) * 512 + (kvh * 4 + (int)(((e_) >> 2) & 3u)) * 64 + 8 * hi)
    int item = wg;
    if (item < total) {
        int n0, s0, n1 = 0, s1 = 0, n2 = 0, s2 = 0; unsigned e0, e1 = 0u, e2 = 0u;
        GA_LOCATE(item, n0, s0); GA_ENTRY(e0, n0, s0);
        bool has1 = item + nwg < total; if (has1) { GA_LOCATE(item + nwg, n1, s1); GA_ENTRY(e1, n1, s1); }
        img_load(F, ring, KM, (long)b * S + n0 * 256, kvh, vt0, n0 * 256);
        bf16x8 qn[4]; GA_LOADQ(qn, e0);
        int buf = 0;
#pragma unroll 1
        for (;;) {
            asm volatile("s_waitcnt vmcnt(0)" ::: "memory"); __syncthreads();
            bf16x8 qr[4];
#pragma unroll
            for (int i = 0; i < 4; ++i) qr[i] = qn[i];
            const LAS unsigned char* img = ring + buf * IMG_BYTES;
            if (has1) { Frame F2 = F; asm volatile("" : "+v"(F2.lane));
                img_load(F2, ring + (buf ^ 1) * IMG_BYTES, KM, (long)b * S + n1 * 256, kvh, vt0, n1 * 256); GA_LOADQ(qn, e1); }
            const bool has2 = item + 2 * nwg < total; if (has2) { GA_LOCATE(item + 2 * nwg, n2, s2); GA_ENTRY(e2, n2, s2); }
            const int cn = (int)__shfl((int)cnt, n0), ti = s0 * 8 + w; const bool tile_ok = ti * 32 < cn, valid = ti * 32 + r32 < cn;
            if (tile_ok) {
                const int t = (int)(e0 >> 4), hg = (int)((e0 >> 2) & 3u), r = (int)(e0 & 3u), h = kvh * 4 + hg;
                const float sl2 = moba_sl2(h);
                St st; st.o0 = f32x16{}; st.o1 = f32x16{}; st.m = -INFINITY; st.l = 0.f;
                const int kq = n0 * 256 - t;
                bf16x8 kf[8]; read_k<false>(kf, img, lo, 0, r32);
#pragma unroll 1
                for (int i = 0; i < 3; ++i) tile_run<0, false, true, true>(st, qr, kf, img, lo, 64 * i, kq + 64 * i, sl2, true, 0, hi, r32, 64 * i + 64);
                tile_run<0, false, true, false>(st, qr, kf, img, lo, 192, kq + 192, sl2, true, 0, hi, r32, 0);
                const float lt = st.l + __shfl_xor(st.l, 32);
                if (valid && !nostore) { const size_t slot = ((size_t)((b * 8 + h) * 3 + r)) * S + t;
                    store_o(st, PART + slot * 64, __builtin_amdgcn_rcpf(lt), hi); if (hi == 0) LSE[slot] = st.m + __builtin_amdgcn_logf(lt); }
            }
            if (!has1) break;
            item += nwg; n0 = n1; s0 = s1; e0 = e1; n1 = n2; s1 = s2; e1 = e2; has1 = has2; buf ^= 1;
        }
    }
#undef GA_LOCATE
#undef GA_ENTRY
#undef GA_LOADQ
    asm volatile("s_waitcnt vmcnt(0)" ::: "memory"); __syncthreads();
}
__device__ __forceinline__ void own_subjob(const Frame& F, KP P, int sjob, bool nofull = false, bool nocomb = false) {
    bf16* QM = (bf16*)(P->ws + WS_QM); const bf16* KM = (const bf16*)(P->ws + WS_KM); const bf16* VMT = (const bf16*)(P->ws + WS_VMT);
    const bf16* PART = (const bf16*)(P->ws + WS_PART); const float* LSE = (const float*)(P->ws + WS_LSE);
    int lane_ = F.lane; asm volatile("" : "+v"(lane_));
    const int lane = lane_, r32 = lane & 31, hi = lane >> 5, w = F.wave;
    LAS unsigned char* img = F.lds + RING_OFF;
    LaneOff lo; lane_off(lo, r32, hi);
    {
        const int bk = sjob >> 5, j = 15 - ((sjob & 31) >> 1), hp = sjob & 1, b = bk >> 1, kvh = bk & 1;
        img_load(F, img, KM, (long)b * S + j * 256, kvh, VMT + (long)((b * 2 + kvh) * 64) * S, j * 256);
        asm volatile("s_waitcnt vmcnt(0)" ::: "memory"); __syncthreads();
        const int nsel = j < 3 ? j : 3;
#pragma unroll 1
        for (int k = 0; k < 2; ++k) {
            const int hg = 2 * hp + k, qs = (k & 1) ? 7 - w : w, qo = qs * 32, h = kvh * 4 + hg;
            const float sl2 = moba_sl2(h);
            const int t0 = j * 256 + qo, q = t0 + r32;
            const size_t row = (size_t)(b * S + q);
            bf16* qrow = QM + row * 512 + h * 64;
            bf16x8 qr[4]; loadq(qr, qrow + 8 * hi);
            St st; st.o0 = f32x16{}; st.o1 = f32x16{}; st.m = -INFINITY; st.l = 0.f;
            const int nfull = nofull ? 0 : (qo >> 6), kod = (qo & 32) ? qo - 32 : qo;
            bf16x8 kf[8]; read_k<false>(kf, img, lo, nfull ? 0 : kod, r32);
#pragma unroll 1
            for (int i = 0; i < nfull; ++i) tile_run<0, false, true, true>(st, qr, kf, img, lo, 64 * i, 64 * i - qo - r32, sl2, true, 0, hi, r32, (i + 1 < nfull) ? 64 * i + 64 : kod);
            if (qo & 32) tile_run<2, false, true, false>(st, qr, kf, img, lo, qo - 32, -32 - r32, sl2, true, 0, hi, r32, 0);
            else tile_run<2, true, true, false>(st, qr, kf, img, lo, qo, -r32, sl2, true, 0, hi, r32, 0);
            const float lt = st.l + __shfl_xor(st.l, 32);
            const float lse_own = st.m + __builtin_amdgcn_logf(lt), rl = __builtin_amdgcn_rcpf(lt);
            LAS unsigned char* stg = F.lds + RING_OFF + IMG_BYTES + w * 4736;
#pragma unroll
            for (int g = 0; g < 4; ++g) { u32x2 a2, c2;
                a2.x = cvtpk(st.o0[4 * g] * rl, st.o0[4 * g + 1] * rl); a2.y = cvtpk(st.o0[4 * g + 2] * rl, st.o0[4 * g + 3] * rl);
                c2.x = cvtpk(st.o1[4 * g] * rl, st.o1[4 * g + 1] * rl); c2.y = cvtpk(st.o1[4 * g + 2] * rl, st.o1[4 * g + 3] * rl);
                *(LAS u32x2*)(stg + r32 * 144 + (8 * g + 4 * hi) * 2) = a2; *(LAS u32x2*)(stg + r32 * 144 + (32 + 8 * g + 4 * hi) * 2) = c2; }
            if (hi == 0) *(LAS float*)(stg + 4608 + r32 * 4) = lse_own;
            LDS_WAIT(); asm volatile("" ::: "memory");
            if (nocomb) continue;
#pragma unroll 2
            for (int i = 0; i < 4; ++i) {
                const int rw = i * 8 + (lane >> 3), ch = lane & 7;
                const size_t grow = (size_t)(b * S + t0 + rw), sl0 = ((size_t)((b * 8 + h) * 3)) * S + t0 + rw;
                const u32x4 own = *(const LAS u32x4*)(stg + rw * 144 + ch * 16); const float lo_ = *(const LAS float*)(stg + 4608 + rw * 4);
                float ls[3]; u32x4 pr[3];
#pragma unroll
                for (int r = 0; r < 3; ++r) { ls[r] = -INFINITY; pr[r] = (u32x4){0u, 0u, 0u, 0u}; if (r < nsel) { ls[r] = LSE[sl0 + (size_t)r * S]; pr[r] = *(const u32x4*)(PART + (sl0 + (size_t)r * S) * 64 + ch * 8); } }
                float M = lo_;
#pragma unroll
                for (int r = 0; r < 3; ++r) M = fmaxf(M, ls[r]);
                const float w0 = __builtin_amdgcn_exp2f(lo_ - M); float W = w0;
                float acc8[8];
                acc8[0] = w0 * bf2f(own.x & 0xffffu); acc8[1] = w0 * bf2f(own.x >> 16); acc8[2] = w0 * bf2f(own.y & 0xffffu); acc8[3] = w0 * bf2f(own.y >> 16);
                acc8[4] = w0 * bf2f(own.z & 0xffffu); acc8[5] = w0 * bf2f(own.z >> 16); acc8[6] = w0 * bf2f(own.w & 0xffffu); acc8[7] = w0 * bf2f(own.w >> 16);
#pragma unroll
                for (int r = 0; r < 3; ++r) { const float wr_ = __builtin_amdgcn_exp2f(ls[r] - M); W += wr_;
                    acc8[0] += wr_ * bf2f(pr[r].x & 0xffffu); acc8[1] += wr_ * bf2f(pr[r].x >> 16); acc8[2] += wr_ * bf2f(pr[r].y & 0xffffu); acc8[3] += wr_ * bf2f(pr[r].y >> 16);
                    acc8[4] += wr_ * bf2f(pr[r].z & 0xffffu); acc8[5] += wr_ * bf2f(pr[r].z >> 16); acc8[6] += wr_ * bf2f(pr[r].w & 0xffffu); acc8[7] += wr_ * bf2f(pr[r].w >> 16); }
                const float rW = __builtin_amdgcn_rcpf(W);
                u32x4 o; o.x = cvtpk(acc8[0] * rW, acc8[1] * rW); o.y = cvtpk(acc8[2] * rW, acc8[3] * rW); o.z = cvtpk(acc8[4] * rW, acc8[5] * rW); o.w = cvtpk(acc8[6] * rW, acc8[7] * rW);
                *(u32x4*)(QM + grow * 512 + h * 64 + ch * 8) = o;
            }
            LDS_WAIT(); asm volatile("" ::: "memory");
        }
    }
}
}
#ifndef BENCH_HOT
#define BENCH_HOT 0
#endif
#ifndef BENCH_NOSTORE
#define BENCH_NOSTORE 0
#endif
#ifndef BENCH_SUB
#define BENCH_SUB 3
#endif
#ifndef ALIGN_ONE
#define ALIGN_ONE true
#endif
#ifndef ALIGN_BIG
#define ALIGN_BIG true
#endif
#ifndef BENCH_NOEPI
#define BENCH_NOEPI 0
#endif
#ifndef BENCH_AGLU
#define BENCH_AGLU 0
#endif
#ifndef BENCH_KGLU
#define BENCH_KGLU 0
#endif
#ifndef PH_MASK
#define PH_MASK 0xFFF
#endif
#define PH_ON(k) (((PH_MASK) >> (k)) & 1)
constexpr int NPH = 10, PH_FINAL = DEPTH * NPH, PH_TOTAL = PH_FINAL + 1;
struct Args { Ptrs P; int ph_lo, ph_hi, use_bar, sub; };
__global__ void __launch_bounds__(NWAVES * 64, 2) mk_fwd(Args args) {
    extern __shared__ __attribute__((aligned(16))) unsigned char lds[];
    Frame F;
    F.lds = (LAS unsigned char*)lds;
    F.tid = threadIdx.x; F.lane = F.tid & 63; F.wave = __builtin_amdgcn_readfirstlane(F.tid >> 6);
    F.G = gridDim.x; { const int bx = blockIdx.x; F.vcu = (F.G % 8 == 0) ? (bx % 8) * (F.G / 8) + bx / 8 : bx; }
    typedef const __attribute__((address_space(4))) Args* KArgs;
    const KArgs ka = (KArgs)__builtin_amdgcn_kernarg_segment_ptr();
    volatile LAS unsigned* MISC = (volatile LAS unsigned*)(F.lds + MISC_OFF);
    for (int u = F.tid; u < (LDS_BYTES - LDSCTL_OFF) / 4; u += NWAVES * 64) ((LAS unsigned*)(F.lds + LDSCTL_OFF))[u] = 0u;
    __syncthreads();
    XcdBarrier bar; bar.bar = (unsigned*)(ka->P.ws + WS_CTL) + CW_BAR; bar.x = 0; bar.st = nullptr;
    const int use_bar = ka->use_bar;
    if (use_bar) bar = xcd_barrier_post((unsigned*)(ka->P.ws + WS_CTL) + CW_BAR, MISC + 8);
    LAS unsigned char* ring = F.lds + RING_OFF;
    for (int ph = ka->ph_lo; ; ++ph) {
        { KArgs ka3 = ka; asm volatile("" : "+s"(ka3)); if (ph >= ka3->ph_hi) break; }
#if defined(BENCH_SET)
        const bool bench = ph >= PH_TOTAL; const int l = bench ? DEPTH - 1 : ph / NPH, k = bench ? (ph - PH_TOTAL) % NPH : ph % NPH;
        if (bench && !(((BENCH_SET) >> k) & 1)) continue;
#if defined(BENCH_EMPTY)
        if (bench) { if (ph + 1 < ka->ph_hi) xcd_barrier(bar); continue; }
#endif
        const int lc = bench ? DEPTH + (ph - PH_TOTAL) / NPH : l;
#else
        const bool bench = false; const int l = ph / NPH, k = ph % NPH; const int lc = l;
#endif
        KArgs ka2 = ka; asm volatile("" : "+s"(ka2)); KP P = &ka2->P;
        unsigned char* ws = ka2->P.ws;
        F.tid = threadIdx.x; asm volatile("" : "+v"(F.tid)); F.lane = F.tid & 63;
        int bx = (int)blockIdx.x; asm volatile("" : "+s"(bx));
        { int g_ = (int)gridDim.x, w_ = F.tid >> 6; asm volatile("" : "+s"(g_)); F.G = g_; F.vcu = (g_ % 8 == 0) ? (bx % 8) * (g_ / 8) + bx / 8 : bx; F.wave = __builtin_amdgcn_readfirstlane(w_); }
        if (ph == PH_FINAL && !bench) { if (PH_ON(10)) final_pass(F, P);
        }
        else if (k == 0 && PH_ON(0)) { conv_layer(F, P, l); ssm_mats(F, P, l); if (l == 0) xb_pass(F, P); __syncthreads(); }
        else if (k == 1 && PH_ON(1)) {
            pg8::SrcStd g{(const char*)(ws + WS_XN), (const char*)(ws + WS_WIN), DM, 0}; pg8::StaticOrder So; So.init(T, DIN, F.G, bx);
            pg8::Unit u0; So.next(0, u0); pg8::rinv_build((LAS float*)(F.lds + RINV_OFF), (const float*)(ws + WS_SSQ), u0.pm);
            pg8::EpiInProj E{ws, pg8::RinvTab{(const LAS float*)(F.lds + RINV_OFF)}, (bench && BENCH_NOEPI) ? 1 : 0};
            pg8::gemm_phase<pg8::EpiInProj, pg8::SrcStd, pg8::StaticOrder, ALIGN_BIG>(ring, g, So, E);
        }
        else if (k == 2 && PH_ON(2)) {
            if (ka2->sub & 1) { pg8::SrcSsm<false> g{(const char*)(ws + WS_U), nullptr, (const char*)(ws + WS_SEND)}; pg8::SsmOrder So{F.G, bx}; pg8::EpiSsmEnd E{(float*)(ws + WS_HEND)};
                pg8::gemm_phase<pg8::EpiSsmEnd, pg8::SrcSsm<false>, pg8::SsmOrder, ALIGN_ONE>(ring, g, So, E); }
            if (ka2->sub & 2) att::swa_select_phase(F, P, l, lc);
        }
        else if (k == 3 && PH_ON(3)) {
#ifndef NO_CARRY
            if ((bench ? BENCH_SUB : ka2->sub) & 1) ssm_carry(F, P, l);
#endif
#ifndef NO_MOBA
            if ((bench ? BENCH_SUB : ka2->sub) & 2) att::moba_gather(F, P, lc, bench && BENCH_NOSTORE);
#endif
        }
        else if (k == 4 && PH_ON(4)) {
            unsigned* done = (unsigned*)(ws + WS_CTL) + CW_DONE + lc;
            { pg8::SrcSsm<true> g{(const char*)(ws + WS_U), (const char*)(ws + WS_HINIT), (const char*)(ws + WS_SMAIN)}; pg8::SsmOrder So{F.G, bx}; pg8::EpiSsmMain E{(bf16*)(ws + WS_YS), ws};
              pg8::Unit u0; const bool mine = So.next(0, u0);
              pg8::gemm_phase<pg8::EpiSsmMain, pg8::SrcSsm<true>, pg8::SsmOrder, true>(ring, g, So, E);
              if (mine && F.tid == 0) {
                  __builtin_amdgcn_fence(__ATOMIC_RELEASE, "agent"); asm volatile("s_waitcnt vmcnt(0)" ::: "memory");
                  __hip_atomic_fetch_add(done, 1u, __ATOMIC_RELAXED, __HIP_MEMORY_SCOPE_AGENT); } }
            unsigned* qctr = (unsigned*)(ws + WS_CTL) + CW_OWNQ + lc;
            volatile LAS unsigned* jobw = (volatile LAS unsigned*)(F.lds + MISC_OFF + 64);
            int job;
            for (;;) {
                __syncthreads();
                if (F.tid == 0) *jobw = __hip_atomic_fetch_add(qctr, 1u, __ATOMIC_RELAXED, __HIP_MEMORY_SCOPE_AGENT);
                __syncthreads();
                job = (int)*jobw;
                if (job >= 256) break;
                att::own_subjob(F, P, job);
            }
            if (job < 512) {
                if (F.tid == 0) { unsigned sp = 0u; while (__hip_atomic_load(done, __ATOMIC_RELAXED, __HIP_MEMORY_SCOPE_AGENT) < 128u) { __builtin_amdgcn_s_sleep(2); if (++sp > (1u << 22)) break; }
                    __builtin_amdgcn_fence(__ATOMIC_ACQUIRE, "agent"); asm volatile("s_waitcnt vmcnt(0)" ::: "memory"); }
                __syncthreads();
            }
            while (job < 512) {
                { const int gj = job - 256;
                  pg8::SrcStd g{(const char*)(ws + WS_YS), (const char*)(ws + WS_WGLU), 512, 0}; pg8::OneUnit So{gj >> 2, gj & 3}; pg8::EpiGlu E{(bf16*)(ws + WS_A1), ws};
                  pg8::gemm_phase<pg8::EpiGlu, pg8::SrcStd, pg8::OneUnit, true>(ring, g, So, E); }
                __syncthreads();
                if (F.tid == 0) *jobw = __hip_atomic_fetch_add(qctr, 1u, __ATOMIC_RELAXED, __HIP_MEMORY_SCOPE_AGENT);
                __syncthreads();
                job = (int)*jobw;
            }
        }
        else if (k == 5 && PH_ON(5)) { }
        else if (k == 6 && PH_ON(6)) {
            pg8::SrcMerge g{(const char*)(ws + WS_QA), (const char*)(ws + WS_A1), (const char*)(ws + WS_QM), (const char*)(ws + WS_WMRG)}; pg8::StaticOrder So; So.init(T, DM, F.G, bx);
            pg8::EpiMerge E{(const bf16*)(ws + WS_GATES), (bf16*)(ws + WS_MIXED), ws};
            pg8::gemm_phase<pg8::EpiMerge, pg8::SrcMerge, pg8::StaticOrder, ALIGN_ONE>(ring, g, So, E);
        }
        else if ((k == 7 || k == 9) && PH_ON(7)) {
            const bool f2 = (k == 9);
            pg8::SrcStd g{(const char*)(ws + (f2 ? WS_H1 : WS_MIXED)), (const char*)(ws + (f2 ? WS_WFF2 : WS_WOUT)), f2 ? DFF : DM, (bench && BENCH_HOT) ? 1 : 0}; pg8::StaticOrder So; So.init(T, DM, F.G, bx); float* xd = bench ? (float*)(ws + WS_QA) : P->x;
            pg8::EpiResid E{(!bench && l == 0 && !f2) ? P->x_in : (const float*)xd, xd, (bf16*)(ws + (bench ? WS_KM : WS_XN)), (float*)(ws + WS_SSQ), ws};
            pg8::gemm_phase<pg8::EpiResid, pg8::SrcStd, pg8::StaticOrder, ALIGN_ONE>(ring, g, So, E);
        }
        else if (k == 8 && PH_ON(8)) {
            pg8::SrcStd g{(const char*)(ws + WS_XN), (const char*)(ws + WS_WFF1), DM, (bench && BENCH_HOT) ? 1 : 0}; pg8::StaticOrder So; So.init(T, DFF, F.G, bx);
            pg8::Unit u0; So.next(0, u0); pg8::rinv_build((LAS float*)(F.lds + RINV_OFF), (const float*)(ws + WS_SSQ), u0.pm);
            pg8::EpiFfn1 E{(bf16*)(ws + WS_H1), pg8::RinvTab{(const LAS float*)(F.lds + RINV_OFF)}, (bench && BENCH_NOEPI) ? 1 : 0, ws};
            pg8::gemm_phase<pg8::EpiFfn1, pg8::SrcStd, pg8::StaticOrder, ALIGN_BIG>(ring, g, So, E);
        }
        if (k == 5 && !bench) continue;
        { KArgs ka3 = ka; asm volatile("" : "+s"(ka3)); if (ph + 1 < ka3->ph_hi) { if (ka3->use_bar) xcd_barrier(bar); else __syncthreads(); } }
    }
}
extern "C" void kernel_launch(void* const* d_in, const int* in_sizes, int n_in, void* d_out, int out_size, void* d_ws, size_t ws_size, hipStream_t stream) {
    static int grid = 0;
    if (grid == 0) {
        if (n_in != 21 || out_size != T * DM || ws_size < WS_END) { fprintf(stderr, "kernel_launch: unexpected shapes (n_in %d out %d ws %zu)\n", n_in, out_size, ws_size); grid = -1; return; }
        int dev = 0, cus = 0;
        if (hipGetDevice(&dev) != hipSuccess || hipDeviceGetAttribute(&cus, hipDeviceAttributeMultiprocessorCount, dev) != hipSuccess) { grid = -1; return; }
        if (hipFuncSetAttribute((const void*)mk_fwd, hipFuncAttributeMaxDynamicSharedMemorySize, LDS_BYTES) != hipSuccess) { fprintf(stderr, "kernel_launch: hipFuncSetAttribute failed\n"); grid = -1; return; }
        int per_cu = 0;
        if (hipOccupancyMaxActiveBlocksPerMultiprocessor(&per_cu, (const void*)mk_fwd, NWAVES * 64, LDS_BYTES) != hipSuccess || per_cu < 1) { fprintf(stderr, "kernel_launch: occupancy query reports %d workgroups per CU\n", per_cu); (void)hipGetLastError(); }
        grid = cus;
        if (grid != 256) { fprintf(stderr, "kernel_launch: built for a 256-CU device (unit dealing assumes 256 workgroups); found %d CUs; nothing launched\n", cus); grid = -1; return; }
    }
    if (grid < 0) return;
    (void)hipMemsetAsync((char*)d_ws + WS_CTL, 0, CTL_ZERO_BYTES, stream);
    Args a{};
    const float** pp = (const float**)&a.P; for (int i = 0; i < 21; ++i) pp[i] = (const float*)d_in[i];
    a.P.x = (float*)d_out; a.P.ws = (unsigned char*)d_ws;
    #if defined(BENCH_SET)
    a.ph_lo = 0; a.ph_hi = PH_TOTAL + NPH * (BENCH_REPS);
#else
    a.ph_lo = 0; a.ph_hi = PH_TOTAL;
#endif
    a.use_bar = 1; a.sub = 3;
    hipLaunchKernelGGL(mk_fwd, dim3(grid), dim3(NWAVES * 64), LDS_BYTES, stream, a);
}
```

```cpp
#include <hip/hip_runtime.h>
#include <cstdio>
#include <cstdint>

constexpr int NB = 4, S = 4096, T = NB * S, DM = 1024, DEPTH = 4, DIN = 5120, DFF = 4096;
constexpr float LOG2E = 1.4426950408889634f;
constexpr float C2 = 0.125f * LOG2E;
constexpr float NORM_EPS = 1e-6f;
constexpr int SSM_L = 16;
constexpr int SSM_KM = SSM_L * 16 + 128;
constexpr int SSM_KE = SSM_L * 16;
constexpr int NCH = T / SSM_L;

constexpr size_t MiB = 1u << 20;
constexpr size_t WS_CTL = 0, CTL_ZERO_BYTES = 1 * MiB;
constexpr size_t WS_WIN = 1 * MiB, WS_WGLU = 11 * MiB, WS_WMRG = 12 * MiB, WS_WOUT = 15 * MiB, WS_WFF1 = 17 * MiB, WS_WFF2 = 25 * MiB;
constexpr size_t WS_SMAIN = 33 * MiB, WS_SEND = 39 * MiB, WS_KMP = 43 * MiB;
constexpr size_t WS_XN = 44 * MiB;
constexpr size_t WS_QA = 76 * MiB, WS_KA = 92 * MiB, WS_VAT = 96 * MiB, WS_U = 100 * MiB, WS_QM = 116 * MiB, WS_KM = 132 * MiB, WS_VMT = 136 * MiB, WS_GATES = 140 * MiB;
constexpr size_t WS_H1 = 76 * MiB;
constexpr size_t WS_LIST = WS_XN, WS_LSE = WS_XN + 8 * MiB;
constexpr size_t WS_YS = 284 * MiB;
constexpr size_t WS_PART = 236 * MiB;
constexpr size_t WS_A1 = 236 * MiB, WS_MIXED = 252 * MiB, WS_HEND = 284 * MiB, WS_HINIT = 300 * MiB, WS_SSQ = 308 * MiB, WS_END = 309 * MiB;

typedef unsigned short bf16;
typedef short bf16x8 __attribute__((ext_vector_type(8)));
typedef short s16x4 __attribute__((ext_vector_type(4)));
typedef float f32x4 __attribute__((ext_vector_type(4)));
typedef float f32x16 __attribute__((ext_vector_type(16)));
typedef unsigned u32x4 __attribute__((ext_vector_type(4)));
typedef unsigned u32x2 __attribute__((ext_vector_type(2)));

__host__ __device__ __forceinline__ unsigned f2bf(float f) { unsigned u = __builtin_bit_cast(unsigned, f); return (u + 0x7fffu + ((u >> 16) & 1u)) >> 16; }
__host__ __device__ __forceinline__ float bf2f(unsigned b) { return __builtin_bit_cast(float, b << 16); }
typedef float f32x2_t __attribute__((ext_vector_type(2))); typedef __bf16 bf16x2_t __attribute__((ext_vector_type(2)));
__device__ __forceinline__ unsigned cvtpk_s(float lo, float hi) { f32x2_t v = {lo, hi}; bf16x2_t b = __builtin_convertvector(v, bf16x2_t); return __builtin_bit_cast(unsigned, b); }
__device__ __forceinline__ unsigned pk2(float lo, float hi) { return f2bf(lo) | (f2bf(hi) << 16); }
__device__ __forceinline__ float rbf(float f) { return bf2f(f2bf(f)); }
__device__ __forceinline__ float sigmoid_fast(float x) { return __builtin_amdgcn_rcpf(1.f + __builtin_amdgcn_exp2f(-x * LOG2E)); }
__device__ __forceinline__ float gelu_tanh(float x) {
    const float c2 = 2.f * 0.7978845608028654f; const float t = c2 * (x + 0.044715f * x * x * x); return x * sigmoid_fast(t); }
__device__ __forceinline__ float wave_sum(float v) {
#pragma unroll
    for (int o = 1; o < 64; o <<= 1) v += __shfl_xor(v, o);
    return v;
}
__device__ __forceinline__ float wave_max(float v) {
#pragma unroll
    for (int o = 1; o < 64; o <<= 1) v = fmaxf(v, __shfl_xor(v, o));
    return v;
}

struct Ptrs {
    const float *x_in, *norm_mix, *w_in, *sinks, *lam_re, *lam_im, *log_step, *b_re, *b_im, *c_re, *c_im, *d_skip, *w_glu, *w_o_swa, *w_o_ssm, *w_o_moba, *w_out, *norm_ffn, *w_ff1, *w_ff2, *norm_final;
    float* x;
    unsigned char* ws;
};
typedef const __attribute__((address_space(4))) Ptrs* KP;
namespace pg8 {
#define PG8_LAS __attribute__((address_space(3)))
constexpr int BM = 256, BK = 64, HALF = 128, HTB = HALF * BK * 2  , STAGE_BYTES = 8 * HTB, NXCD = 8, WGM = 8;

__host__ __device__ __forceinline__ int lds_byte(int r, int c) { const int st = (r >> 4) * 2 + (c >> 5), rr = r & 15, cc = c & 31, ob = rr * 64 + cc * 2; return st * 1024 + (ob ^ (((ob >> 9) & 1) << 5)); }
__host__ __device__ __forceinline__ void stage_rc(int b, int& R, int& C) { const int st = b / 1024, sb = b % 1024, swz = sb ^ (((sb >> 9) & 1) << 5); R = (st >> 1) * 16 + swz / 64; C = (st & 1) * 32 + (swz % 64) / 2; }
__host__ __device__ __forceinline__ int perm32(int rho) { const int n = rho >> 4, i = rho & 15; return 8 * (i >> 2) + 4 * n + (i & 3); }

struct Unit { int pm, pn; };

struct StaticOrder {
    int nM, nN, nwg, G, c;
    __host__ __device__ void init(int M, int N, int G_, int c_) { nM = M / BM; nN = N / BM; nwg = nM * nN; G = G_; c = c_; }
    __host__ __device__ bool next(int i, Unit& u) const {
        const long L = (long)i * G + c; if (L >= nwg) return false;
        int wgid = (int)L; { const int q = nwg / NXCD, r = nwg % NXCD, xcd = wgid % NXCD, off = wgid / NXCD; wgid = (xcd < r ? xcd * (q + 1) : r * (q + 1) + (xcd - r) * q) + off; }
        const int nig = WGM * nN, gid = wgid / nig, fm = gid * WGM, gsz = (nM - fm) < WGM ? (nM - fm) : WGM;
        u.pm = fm + ((wgid % nig) % gsz); u.pn = (wgid % nig) / gsz; return true;
    }
};
struct OneUnit { int pm, pn; __host__ __device__ bool next(int i, Unit& u) const { if (i) return false; u.pm = pm; u.pn = pn; return true; } };
struct SsmOrder {
    int G, c;
    __host__ __device__ bool next(int i, Unit& u) const { const int L = i * G + c; if (L >= 128) return false; u.pn = L >> 2; u.pm = L & 3; return true; }
};

struct SrcStd {
    static constexpr bool TWO_VAR = false;
    const char* A; const char* Bt; int K; int hot;
    __device__ __forceinline__ int nt() const { return K / BK; }
    __device__ __forceinline__ const char* a(const Unit& u, int kt, int h) const { return A + ((size_t)((hot ? 0 : u.pm) * BM + h * HALF) * K + (size_t)kt * BK) * 2; }
    __device__ __forceinline__ const char* b(const Unit& u, int kt, int h) const { return Bt + ((size_t)((hot ? 0 : u.pn) * BM + h * HALF) * K + (size_t)kt * BK) * 2; }
    __device__ __forceinline__ unsigned voffA(int R, int C, int) const { return (unsigned)(R * K + C) * 2u; }
    __device__ __forceinline__ unsigned voffB(int R, int C) const { return (unsigned)(R * K + C) * 2u; }
    __device__ __forceinline__ int avar(int) const { return 0; }
};
struct SrcMerge {
    static constexpr bool TWO_VAR = false;
    const char* A0; const char* A1; const char* A2; const char* Bt;
    __device__ __forceinline__ int nt() const { return 24; }
    __device__ __forceinline__ const char* a(const Unit& u, int kt, int h) const { const int sg = kt >> 3; const char* p = sg == 0 ? A0 : (sg == 1 ? A1 : A2); return p + ((size_t)(u.pm * BM + h * HALF) * 512 + (size_t)(kt & 7) * BK) * 2; }
    __device__ __forceinline__ const char* b(const Unit& u, int kt, int h) const { return Bt + ((size_t)(u.pn * BM + h * HALF) * 1536 + (size_t)kt * BK) * 2; }
    __device__ __forceinline__ unsigned voffA(int R, int C, int) const { return (unsigned)(R * 512 + C) * 2u; }
    __device__ __forceinline__ unsigned voffB(int R, int C) const { return (unsigned)(R * 1536 + C) * 2u; }
    __device__ __forceinline__ int avar(int) const { return 0; }
};
template <bool MAIN> struct SrcSsm {
    static constexpr bool TWO_VAR = MAIN; static constexpr int KTOT = MAIN ? SSM_KM : SSM_KE;
    const char* U; const char* HI; const char* Bt;
    __device__ __forceinline__ int nt() const { return KTOT / BK; }
    __device__ __forceinline__ const char* a(const Unit& u, int kt, int h) const {
        if (!MAIN || kt < 4) return U + ((size_t)(u.pn * NCH + u.pm * BM + h * HALF) * 256 + (size_t)kt * BK) * 2;
        return HI + ((size_t)(u.pn * NCH + u.pm * BM + h * HALF) * 128 + (size_t)(kt - 4) * BK) * 2; }
    __device__ __forceinline__ const char* b(const Unit& u, int kt, int h) const { return Bt + ((size_t)(u.pn * 256 + h * HALF) * KTOT + (size_t)kt * BK) * 2; }
    __device__ __forceinline__ unsigned voffA(int R, int C, int var) const { return var ? (unsigned)(R * 128 + C) * 2u : (unsigned)(R * 256 + C) * 2u; }
    __device__ __forceinline__ unsigned voffB(int R, int C) const { return (unsigned)(R * KTOT + C) * 2u; }
    __device__ __forceinline__ int avar(int kt) const { return (MAIN && kt >= 4) ? 1 : 0; }
};

typedef f32x4 Acc[2][2][4][2];
struct WsRes { __amdgpu_buffer_rsrc_t r; const unsigned char* base; };
#ifndef WT_MASK
#define WT_MASK 3
#endif
__device__ __forceinline__ WsRes ws_res(unsigned char* ws) { WsRes w; w.r = __builtin_amdgcn_make_buffer_rsrc(ws, 0, (int)0x7fffffff, 0x00020000); w.base = ws; return w; }
__device__ __forceinline__ unsigned ws_off(const WsRes& w, const void* p) { return (unsigned)((const unsigned char*)p - w.base); }
template <bool WT> __device__ __forceinline__ void wt16(const WsRes& w, unsigned off, u32x4 v) { if (WT) __builtin_amdgcn_raw_buffer_store_b128(v, w.r, off, 0, 16); else __builtin_amdgcn_raw_buffer_store_b128(v, w.r, off, 0, 0); }
template <bool WT> __device__ __forceinline__ void wt16f(__amdgpu_buffer_rsrc_t r, unsigned off, f32x4 v) { if (WT) __builtin_amdgcn_raw_buffer_store_b128(__builtin_bit_cast(u32x4, v), r, off, 0, 16); else __builtin_amdgcn_raw_buffer_store_b128(__builtin_bit_cast(u32x4, v), r, off, 0, 0); }
template <bool WT> __device__ __forceinline__ void wt8(const WsRes& w, unsigned off, u32x2 v) { if (WT) __builtin_amdgcn_raw_buffer_store_b64(v, w.r, off, 0, 16); else __builtin_amdgcn_raw_buffer_store_b64(v, w.r, off, 0, 0); }
__device__ __forceinline__ unsigned cvt_pk_bf16(float lo, float hi) { return cvtpk_s(lo, hi); }
__device__ __forceinline__ u32x4 pack8(f32x4 v0, f32x4 v1) { u32x4 w; w.x = cvt_pk_bf16(v0[0], v0[1]); w.y = cvt_pk_bf16(v0[2], v0[3]); w.z = cvt_pk_bf16(v1[0], v1[1]); w.w = cvt_pk_bf16(v1[2], v1[3]); return w; }
__device__ __forceinline__ f32x4 sig4(f32x4 v) { f32x4 o; o[0] = sigmoid_fast(v[0]); o[1] = sigmoid_fast(v[1]); o[2] = sigmoid_fast(v[2]); o[3] = sigmoid_fast(v[3]); return o; }
__device__ __forceinline__ f32x4 unpk_lo(u32x4 w) { f32x4 o; o[0] = bf2f(w.x & 0xffffu); o[1] = bf2f(w.x >> 16); o[2] = bf2f(w.y & 0xffffu); o[3] = bf2f(w.y >> 16); return o; }
__device__ __forceinline__ f32x4 unpk_hi(u32x4 w) { f32x4 o; o[0] = bf2f(w.z & 0xffffu); o[1] = bf2f(w.z >> 16); o[2] = bf2f(w.w & 0xffffu); o[3] = bf2f(w.w >> 16); return o; }
__device__ __forceinline__ f32x4 rcp4(f32x4 v) { f32x4 o; o[0] = __builtin_amdgcn_rcpf(v[0]); o[1] = __builtin_amdgcn_rcpf(v[1]); o[2] = __builtin_amdgcn_rcpf(v[2]); o[3] = __builtin_amdgcn_rcpf(v[3]); return o; }

struct RinvTab { const PG8_LAS float* tab; };
__device__ __forceinline__ void rinv_build(PG8_LAS float* tab, const float* SSQ, int pm0) {
    int t_ = threadIdx.x; asm volatile("" : "+v"(t_));
    if (t_ < 256) { const f32x4* sp = (const f32x4*)(SSQ + (size_t)(pm0 * BM + t_) * 16); const f32x4 s = (sp[0] + sp[1]) + (sp[2] + sp[3]); tab[t_] = rsqrtf(((s[0] + s[1]) + (s[2] + s[3])) * (1.f / DM) + NORM_EPS); }
    __syncthreads();
}
template <int MODE, bool WT = ((WT_MASK & 4) != 0)> __device__ __forceinline__ void st_half_bf16(const WsRes& W, const Acc& acc, int bj, bf16* base, int ldc, float sc, const PG8_LAS float* ri = nullptr  ) {
    unsigned p = ws_off(W, base);
#pragma unroll
    for (int ai = 0; ai < 2; ++ai) {
#pragma unroll
        for (int m = 0; m < 4; ++m) { f32x4 v0 = acc[ai][bj][m][0], v1 = acc[ai][bj][m][1];
            if (ri) { const float rs = ri[ai * HALF + m * 16]; v0 = v0 * rs; v1 = v1 * rs; }
            if (MODE == 0) { v0 = v0 * sc; v1 = v1 * sc; }
            else if (MODE == 1) { v0 = sig4(v0); v1 = sig4(v1); }
            else if (MODE == 2) { v0 = __builtin_elementwise_max(v0, (f32x4){0.f, 0.f, 0.f, 0.f}); v1 = __builtin_elementwise_max(v1, (f32x4){0.f, 0.f, 0.f, 0.f}); v0 = v0 * v0; v1 = v1 * v1; }
            else { v0[0] = gelu_tanh(v0[0]); v0[1] = gelu_tanh(v0[1]); v0[2] = gelu_tanh(v0[2]); v0[3] = gelu_tanh(v0[3]); v1[0] = gelu_tanh(v1[0]); v1[1] = gelu_tanh(v1[1]); v1[2] = gelu_tanh(v1[2]); v1[3] = gelu_tanh(v1[3]); }
            wt16<WT>(W, p, pack8(v0, v1)); asm volatile("" : "+v"(p)); p += 32u * (unsigned)ldc; }
        p += 2u * (unsigned)(HALF - 64) * (unsigned)ldc; }
}
__device__ __forceinline__ void st_half_vt(const Acc& acc, int bj, bf16* VT, int b, int s0, int cc, const PG8_LAS float* ri) {
    bf16* p = VT + ((size_t)(b * 2 + (cc >> 6)) * 64 + (cc & 63)) * S + (s0 & ~15) + ((((s0 >> 2) & 3) == 1 ? 2 : (((s0 >> 2) & 3) == 2 ? 1 : ((s0 >> 2) & 3))) << 2) + (s0 & 3);
    float rs[2][4];
#pragma unroll
    for (int ai = 0; ai < 2; ++ai)
#pragma unroll
        for (int m = 0; m < 4; ++m) rs[ai][m] = ri[ai * HALF + m * 16];
#pragma unroll
    for (int n = 0; n < 2; ++n)
#pragma unroll
        for (int e = 0; e < 4; ++e) {
#pragma unroll
            for (int ai = 0; ai < 2; ++ai)
#pragma unroll
                for (int m = 0; m < 4; ++m) p[ai * HALF + m * 16] = (bf16)f2bf(acc[ai][bj][m][n][e] * rs[ai][m]);
            asm volatile("" : "+v"(p)); p += S; }
}

struct EpiInProj {
    static constexpr bool PERM = true, AFTER_DRAIN = false, HAS_MID = false;
    unsigned char* ws; RinvTab RT; int skip;
    __device__ __forceinline__ void operator()(const Acc& acc, const Unit& u, int wr, int wc, int fr, int fq) const {
        if (skip) return;
        const WsRes W = ws_res(ws);
        bf16 *QA = (bf16*)(ws + WS_QA), *KA = (bf16*)(ws + WS_KA), *VAT = (bf16*)(ws + WS_VAT), *U = (bf16*)(ws + WS_U), *QM = (bf16*)(ws + WS_QM), *KM = (bf16*)(ws + WS_KM), *VMT = (bf16*)(ws + WS_VMT), *GATES = (bf16*)(ws + WS_GATES); float* KMP = (float*)(ws + WS_KMP);
        const int row = u.pm * BM + wr * 64 + fr, cc = wc * 32 + 8 * fq;
        const PG8_LAS float* ri = RT.tab + wr * 64 + fr;
#pragma unroll
        for (int bj = 0; bj < 2; ++bj) {
            const int hc = u.pn * 2 + bj;
            if (hc < 4) st_half_bf16<0, ((WT_MASK & 32) != 0)>(W, acc, bj, QA + (size_t)row * 512 + hc * 128 + cc, 512, C2, ri);
            else if (hc == 4) st_half_bf16<0, ((WT_MASK & 32) != 0)>(W, acc, bj, KA + (size_t)row * 128 + cc, 128, 1.f, ri);
            else if (hc == 5) st_half_vt(acc, bj, VAT, row / S, row % S, cc, ri);
            else if (hc < 10) { const int ucol = (hc - 6) * 128 + cc;
                st_half_bf16<0, ((WT_MASK & 32) != 0)>(W, acc, bj, U + ((size_t)(ucol >> 4) * NCH + ((u.pm * BM + wr * 64) >> 4)) * 256 + fr * 16 + (ucol & 15), 16, 1.f, ri); }
            else if (hc < 14) st_half_bf16<0, ((WT_MASK & 32) != 0)>(W, acc, bj, QM + (size_t)row * 512 + (hc - 10) * 128 + cc, 512, C2, ri);
            else if (hc == 14) {
                st_half_bf16<0, ((WT_MASK & 32) != 0)>(W, acc, bj, KM + (size_t)row * 128 + cc, 128, 1.f, ri);
                f32x4 c0 = {0.f, 0.f, 0.f, 0.f}, c1 = {0.f, 0.f, 0.f, 0.f};
#pragma unroll
                for (int ai = 0; ai < 2; ++ai)
#pragma unroll
                    for (int m = 0; m < 4; ++m) { const float rs = ri[ai * HALF + m * 16]; c0 += acc[ai][bj][m][0] * rs; c1 += acc[ai][bj][m][1] * rs; }
#pragma unroll
                for (int o = 1; o < 16; o <<= 1)
#pragma unroll
                    for (int e = 0; e < 4; ++e) { c0[e] += __shfl_xor(c0[e], o); c1[e] += __shfl_xor(c1[e], o); }
                if (fr == 0) { float* kp = KMP + (size_t)(wr * 64 + u.pm) * 128 + cc; *(f32x4*)kp = c0; *(f32x4*)(kp + 4) = c1; }
            }
            else if (hc == 15) st_half_vt(acc, bj, VMT, row / S, row % S, cc, ri);
            else st_half_bf16<1, ((WT_MASK & 2) != 0)>(W, acc, bj, GATES + (size_t)row * 3072 + (hc - 16) * 128 + cc, 3072, 1.f, ri);
        }
    }
};
struct EpiFfn1 {
    static constexpr bool PERM = true, AFTER_DRAIN = false, HAS_MID = false;
    bf16* H1; RinvTab RT; int skip; unsigned char* ws;
    __device__ __forceinline__ void operator()(const Acc& acc, const Unit& u, int wr, int wc, int fr, int fq) const {
        if (skip) return;
        const WsRes W = ws_res(ws);
        bf16* base = H1 + (size_t)(u.pm * BM + wr * 64 + fr) * DFF + u.pn * BM + wc * 32 + 8 * fq;
        const PG8_LAS float* ri = RT.tab + wr * 64 + fr;
        st_half_bf16<2, ((WT_MASK & 1) != 0)>(W, acc, 0, base, DFF, 1.f, ri); st_half_bf16<2, ((WT_MASK & 1) != 0)>(W, acc, 1, base + HALF, DFF, 1.f, ri);
    }
};
struct EpiGlu {
    static constexpr bool PERM = true, AFTER_DRAIN = false, HAS_MID = false;
    bf16* A1; unsigned char* ws;
    __device__ __forceinline__ void operator()(const Acc& acc, const Unit& u, int wr, int wc, int fr, int fq) const {
        const WsRes W = ws_res(ws);
        bf16* base = A1 + (size_t)(u.pm * BM + wr * 64 + fr) * 512 + u.pn * 128 + wc * 32 + 8 * fq;
#pragma unroll
        for (int ai = 0; ai < 2; ++ai)
#pragma unroll
            for (int m = 0; m < 4; ++m) wt16<((WT_MASK & 4) != 0)>(W, ws_off(W, base + (size_t)(ai * HALF + m * 16) * 512), pack8(acc[ai][0][m][0] * sig4(acc[ai][1][m][0]), acc[ai][0][m][1] * sig4(acc[ai][1][m][1])));
    }
};
struct EpiMerge {
    static constexpr bool PERM = true, AFTER_DRAIN = false, HAS_MID = true;
    const bf16* GATES; bf16* MIXED; unsigned char* ws;
    __device__ __forceinline__ void mid(Acc& acc, const Unit& u, int t, int wr, int wc, int fr, int fq) const {
        if (t != 8 && t != 16) return;
        const bf16* g = GATES + (size_t)(u.pm * BM + wr * 64 + fr) * 3072 + (t == 8 ? 0 : 1024) + u.pn * BM + wc * 32 + 8 * fq;
#pragma unroll
        for (int ai = 0; ai < 2; ++ai)
#pragma unroll
            for (int m = 0; m < 4; ++m)
#pragma unroll
                for (int bj = 0; bj < 2; ++bj) { const bf16* gp = g + (size_t)(ai * HALF + m * 16) * 3072 + bj * HALF; const u32x4 num = *(const u32x4*)gp, den = *(const u32x4*)(gp + 1024);
                    acc[ai][bj][m][0] = acc[ai][bj][m][0] * (unpk_lo(num) * rcp4(unpk_lo(den))); acc[ai][bj][m][1] = acc[ai][bj][m][1] * (unpk_hi(num) * rcp4(unpk_hi(den))); }
    }
    __device__ __forceinline__ void operator()(const Acc& acc, const Unit& u, int wr, int wc, int fr, int fq) const {
        const WsRes W = ws_res(ws);
        const size_t ro = (size_t)(u.pm * BM + wr * 64 + fr); const int co = u.pn * BM + wc * 32 + 8 * fq;
#pragma unroll
        for (int ai = 0; ai < 2; ++ai)
#pragma unroll
            for (int m = 0; m < 4; ++m)
#pragma unroll
                for (int bj = 0; bj < 2; ++bj) { const size_t r = ro + ai * HALF + m * 16; const u32x4 g2 = *(const u32x4*)(GATES + r * 3072 + 2048 + co + bj * HALF);
                    wt16<((WT_MASK & 4) != 0)>(W, ws_off(W, MIXED + r * DM + co + bj * HALF), pack8(acc[ai][bj][m][0] * unpk_lo(g2), acc[ai][bj][m][1] * unpk_hi(g2))); }
    }
};
struct EpiResid {
    static constexpr bool PERM = false, AFTER_DRAIN = false, HAS_MID = false;
    const float* XS; float* X; bf16* XB; float* SSQ; unsigned char* ws;
    __device__ __forceinline__ void operator()(const Acc& acc, const Unit& u, int wr, int wc, int fr, int fq) const {
        const WsRes W = ws_res(ws);
        const __amdgpu_buffer_rsrc_t xr_ = __builtin_amdgcn_make_buffer_rsrc(X, 0, T * DM * 4, 0x00020000);
        const size_t row0 = (size_t)(u.pm * BM + wr * 64 + fr); const int col0 = u.pn * BM + wc * 32 + 4 * fq;
#pragma unroll
        for (int ai = 0; ai < 2; ++ai)
#pragma unroll
            for (int m = 0; m < 4; ++m) { const size_t r = row0 + ai * HALF + m * 16; float ss = 0.f;
#pragma unroll
                for (int bj = 0; bj < 2; ++bj)
#pragma unroll
                    for (int n = 0; n < 2; ++n) { const size_t o_ = r * DM + col0 + bj * HALF + n * 16; const f32x4 v = *(const f32x4*)(XS + o_) + acc[ai][bj][m][n]; if ((WT_MASK & 16) != 0) wt16f<true>(xr_, (unsigned)(o_ * 4), v); else *(f32x4*)(X + o_) = v;
                        ss += (v[0] * v[0] + v[1] * v[1]) + (v[2] * v[2] + v[3] * v[3]);
                        u32x2 w; w.x = cvt_pk_bf16(v[0], v[1]); w.y = cvt_pk_bf16(v[2], v[3]); wt8<((WT_MASK & 4) != 0)>(W, ws_off(W, XB + r * DM + col0 + bj * HALF + n * 16), w); }
                ss += __shfl_xor(ss, 16); ss += __shfl_xor(ss, 32);
                if (fq == 0) SSQ[r * 16 + u.pn * 4 + wc] = ss; }
    }
};
struct EpiSsmEnd {
    static constexpr bool PERM = false, AFTER_DRAIN = false, HAS_MID = false;
    float* HEND;
    __device__ __forceinline__ void operator()(const Acc& acc, const Unit& u, int wr, int wc, int fr, int fq) const {
        float* base = HEND + ((size_t)u.pn * NCH + u.pm * BM + wr * 64 + fr) * 128 + wc * 32 + 4 * fq;
#pragma unroll
        for (int ai = 0; ai < 2; ++ai)
#pragma unroll
            for (int m = 0; m < 4; ++m)
#pragma unroll
                for (int n = 0; n < 2; ++n) *(f32x4*)(base + (size_t)(ai * HALF + m * 16) * 128 + n * 16) = acc[ai][0][m][n];
    }
};
struct EpiSsmMain {
    static constexpr bool PERM = true, AFTER_DRAIN = false, HAS_MID = false;
    bf16* YS; unsigned char* ws;
    __device__ __forceinline__ void operator()(const Acc& acc, const Unit& u, int wr, int wc, int fr, int fq) const {
        const WsRes W = ws_res(ws);
        const int mrow = u.pm * BM + wr * 64 + fr;
#pragma unroll
        for (int bj = 0; bj < 2; ++bj) { const int s = 8 * bj + 2 * wc + (fq >> 1);
            bf16* base = YS + ((size_t)mrow * 16 + s) * 512 + u.pn * 16 + 8 * (fq & 1);
            st_half_bf16<3>(W, acc, bj, base, 16 * 512, 1.f); }
    }
};

template <class Epi, class Src, class Sched, bool ALIGN_EPI>
__device__ __forceinline__ void gemm_phase(PG8_LAS unsigned char* lds, const Src g, const Sched& S, const Epi& E) {
    int tid_ = threadIdx.x; asm volatile("" : "+v"(tid_));
    const int tid = tid_, wid = __builtin_amdgcn_readfirstlane(tid >> 6), lane = tid & 63, wr = wid >> 2, wc = wid & 3, fr = lane & 15, fq = lane >> 4;
    const int nt = g.nt();
    unsigned voffA[2], voffA2[2], voffB[2];
#pragma unroll
    for (int i = 0; i < 2; ++i) { int R, C; stage_rc(tid * 16 + i * 8192, R, C); const int Rb = Epi::PERM ? ((R & ~31) + perm32(R & 31)) : R;
        voffA[i] = g.voffA(R, C, 0); voffA2[i] = Src::TWO_VAR ? g.voffA(R, C, 1) : 0u; voffB[i] = g.voffB(Rb, C); }
    const unsigned ldsw = (unsigned)wid * 1024u;
    const int aoff = lds_byte(wr * 64 + fr, fq * 8), boff = lds_byte(wc * 32 + fr, fq * 8);
#define PG8_SA(b, h) (((b) * 2 + (h)) * HTB)
#define PG8_SB(b, h) ((4 + (b) * 2 + (h)) * HTB)
#define PG8_STAGE_B(bufoff, gbase) do { _Pragma("unroll") for (int _i = 0; _i < 2; ++_i) \
        __builtin_amdgcn_global_load_lds((const unsigned*)((const char*)(gbase) + voffB[_i]), (PG8_LAS unsigned*)(lds + (bufoff) + ldsw + _i * 8192), 16, 0, 0); } while (0)
#define PG8_STAGE_A(bufoff, gbase, kt) do { const bool _v = Src::TWO_VAR && g.avar(kt); _Pragma("unroll") for (int _i = 0; _i < 2; ++_i) { const unsigned _o = _v ? voffA2[_i] : voffA[_i]; \
        __builtin_amdgcn_global_load_lds((const unsigned*)((const char*)(gbase) + _o), (PG8_LAS unsigned*)(lds + (bufoff) + ldsw + _i * 8192), 16, 0, 0); } } while (0)
#define PG8_LDA(dst, b, h) do { _Pragma("unroll") for (int m = 0; m < 4; ++m) _Pragma("unroll") for (int k = 0; k < 2; ++k) dst[m][k] = *(const PG8_LAS bf16x8*)(lds + PG8_SA(b, h) + aoff + m * 2048 + k * 1024); } while (0)
#define PG8_LDB(dst, b, h) do { _Pragma("unroll") for (int n = 0; n < 2; ++n) _Pragma("unroll") for (int k = 0; k < 2; ++k) dst[n][k] = *(const PG8_LAS bf16x8*)(lds + PG8_SB(b, h) + boff + n * 2048 + k * 1024); } while (0)
#define PG8_MMA(ai, bj, At, Bt) do { __builtin_amdgcn_s_setprio(1); _Pragma("unroll") for (int m = 0; m < 4; ++m) _Pragma("unroll") for (int n = 0; n < 2; ++n) _Pragma("unroll") for (int k = 0; k < 2; ++k) \
        acc[ai][bj][m][n] = __builtin_amdgcn_mfma_f32_16x16x32_bf16(Bt[n][k], At[m][k], acc[ai][bj][m][n], 0, 0, 0); __builtin_amdgcn_s_setprio(0); } while (0)
#define PG8_WAIT_V(n) asm volatile("s_waitcnt vmcnt(" #n ")" ::: "memory")
#define PG8_WAIT_L(n) asm volatile("s_waitcnt lgkmcnt(" #n ")" ::: "memory")
#define PG8_BAR __builtin_amdgcn_s_barrier()
#define PG8_SCHED __builtin_amdgcn_sched_barrier(0)
    Unit cur, nxt; int ui = 0;
    if (!S.next(0, cur)) return;
    Acc acc;
#pragma unroll
    for (int a = 0; a < 2; ++a)
#pragma unroll
        for (int b = 0; b < 2; ++b)
#pragma unroll
            for (int m = 0; m < 4; ++m)
#pragma unroll
                for (int n = 0; n < 2; ++n) acc[a][b][m][n] = (f32x4){0.f, 0.f, 0.f, 0.f};
    bf16x8 At[4][2], B0[2][2], B1[2][2];
    PG8_STAGE_B(PG8_SB(0, 0), g.b(cur, 0, 0)); PG8_STAGE_B(PG8_SB(0, 1), g.b(cur, 0, 1)); PG8_STAGE_A(PG8_SA(0, 0), g.a(cur, 0, 0), 0); PG8_STAGE_A(PG8_SA(0, 1), g.a(cur, 0, 1), 0);
    if (wr == 1) PG8_BAR;
    PG8_WAIT_V(2); PG8_BAR;
    PG8_STAGE_B(PG8_SB(1, 0), g.b(cur, 1, 0)); PG8_STAGE_A(PG8_SA(1, 0), g.a(cur, 1, 0), 1); PG8_STAGE_B(PG8_SB(1, 1), g.b(cur, 1, 1));
    PG8_WAIT_V(6); PG8_BAR;
    for (;;) {
        const bool has_next = S.next(ui + 1, nxt);
        const Unit nu = has_next ? nxt : cur;
        for (int t = 0; t < nt; t += 2) {
            const bool last = (t == nt - 2);
            if constexpr (Epi::HAS_MID) E.mid(acc, cur, t, wr, wc, fr, fq);
            const Unit u2 = last ? nu : cur; const int k2 = last ? 0 : t + 2, k3 = k2 + 1;
            PG8_LDB(B0, 0, 0); PG8_LDB(B1, 0, 1); PG8_SCHED; PG8_LDA(At, 0, 0); PG8_STAGE_A(PG8_SA(1, 1), g.a(cur, t + 1, 1), t + 1);
            PG8_WAIT_V(8); PG8_WAIT_L(0); PG8_BAR; PG8_MMA(0, 0, At, B0); PG8_MMA(0, 1, At, B1); PG8_BAR; PG8_SCHED;
            PG8_LDA(At, 0, 1); PG8_STAGE_B(PG8_SB(0, 0), g.b(u2, k2, 0)); PG8_STAGE_B(PG8_SB(0, 1), g.b(u2, k2, 1)); PG8_STAGE_A(PG8_SA(0, 0), g.a(u2, k2, 0), k2);
            PG8_WAIT_V(8); PG8_WAIT_L(0); PG8_BAR; PG8_MMA(1, 0, At, B0); PG8_MMA(1, 1, At, B1); PG8_BAR; PG8_SCHED;
            PG8_LDB(B0, 1, 0); PG8_LDB(B1, 1, 1); PG8_SCHED; PG8_LDA(At, 1, 0); PG8_STAGE_A(PG8_SA(0, 1), g.a(u2, k2, 1), k2);
            PG8_WAIT_V(8); PG8_WAIT_L(0); PG8_BAR; PG8_MMA(0, 0, At, B0); PG8_MMA(0, 1, At, B1); PG8_BAR; PG8_SCHED;
            PG8_LDA(At, 1, 1); PG8_STAGE_B(PG8_SB(1, 0), g.b(u2, k3, 0)); PG8_STAGE_B(PG8_SB(1, 1), g.b(u2, k3, 1)); PG8_STAGE_A(PG8_SA(1, 0), g.a(u2, k3, 0), k3);
            PG8_WAIT_V(8); PG8_WAIT_L(0); PG8_BAR; PG8_MMA(1, 0, At, B0); PG8_MMA(1, 1, At, B1); PG8_BAR; PG8_SCHED;
        }
        if constexpr (ALIGN_EPI) { if (wr == 0) PG8_BAR; }
        { int fr_ = fr, fq_ = fq; asm volatile("" : "+v"(fr_), "+v"(fq_));
          E(acc, cur, wr, wc, fr_, fq_); }
        if (!has_next) break;
#pragma unroll
        for (int a = 0; a < 2; ++a)
#pragma unroll
            for (int b = 0; b < 2; ++b)
#pragma unroll
                for (int m = 0; m < 4; ++m)
#pragma unroll
                    for (int n = 0; n < 2; ++n) acc[a][b][m][n] = (f32x4){0.f, 0.f, 0.f, 0.f};
        cur = nxt; ++ui;
        if constexpr (ALIGN_EPI) { if (wr == 1) PG8_BAR; }
    }
    PG8_WAIT_V(0);
    if constexpr (!ALIGN_EPI) { if (wr == 0) PG8_BAR; }
    PG8_BAR;
#undef PG8_SA
#undef PG8_SB
#undef PG8_STAGE_A
#undef PG8_STAGE_B
#undef PG8_LDA
#undef PG8_LDB
#undef PG8_MMA
#undef PG8_WAIT_V
#undef PG8_WAIT_L
#undef PG8_BAR
#undef PG8_SCHED
}
}
constexpr int NWAVES = 8;
constexpr int RING_OFF = 0, RING_BYTES = 131072;
constexpr int LDSCTL_OFF = RING_BYTES, MISC_OFF = LDSCTL_OFF + 320, RINV_OFF = LDSCTL_OFF + 1024;
constexpr int GSTG_OFF = LDSCTL_OFF + 1024;
constexpr int LDS_BYTES = 153600;
constexpr int CW_TMO = 0, CW_CODE = 1, CW_BAR = 4096, CW_CNT = 16384, CW_OWNQ = 20480, CW_SWAQ = 20544, CW_DONE = 20608;

#define GAS __attribute__((address_space(1)))
#define LAS __attribute__((address_space(3)))
typedef GAS unsigned gu32;
#define RLX_AGENT __ATOMIC_RELAXED, __HIP_MEMORY_SCOPE_AGENT
#define LDS_WAIT() asm volatile("s_waitcnt lgkmcnt(0)" ::: "memory")
#define VM_WAIT() asm volatile("s_waitcnt vmcnt(0)" ::: "memory")

#define XB_TMO      128
#define XB_XCNT(j)  (256  + 64 * (j))
#define XB_XSUB(j)  (1280 + 64 * (j))
#define XB_XGEN(j)  (2304 + 64 * (j))
#define XB_TOP      3328
#define XB_TOPGEN   3392
#define XCD_BAR_WORDS 3456
#define XB_SPIN_CAP (1u << 20)
__device__ __forceinline__ unsigned xb_ld(unsigned* p)              { return __hip_atomic_load(p, __ATOMIC_RELAXED, __HIP_MEMORY_SCOPE_AGENT); }
__device__ __forceinline__ unsigned xb_add(unsigned* p, unsigned v) { return __hip_atomic_fetch_add(p, v, __ATOMIC_RELAXED, __HIP_MEMORY_SCOPE_AGENT); }
__device__ __forceinline__ unsigned xb_xcc_id() { return (unsigned)__builtin_amdgcn_s_getreg((3 << 11) | 20) & 0xFu; }
#ifndef XB_SLEEP
#define XB_SLEEP 1
#endif
#define XB_SPIN(cond, bar) do { unsigned _sp = 0; while (cond) { if (XB_SLEEP) __builtin_amdgcn_s_sleep(XB_SLEEP); \
    if ((++_sp & 255u) == 0u) { if (xb_ld(&(bar)[XB_TMO])) break; if (_sp > XB_SPIN_CAP) { atomicAdd(&(bar)[XB_TMO], 1u); break; } } } } while (0)
struct XcdBarrier { unsigned* bar; unsigned x; volatile LAS unsigned* st; };
__device__ __forceinline__ XcdBarrier xcd_barrier_post(unsigned* bar, volatile LAS unsigned* st) {
    XcdBarrier b; b.bar = bar; b.x = xb_xcc_id(); b.st = st;
    if (threadIdx.x == 0) (void)xb_add(&bar[XB_XCNT(b.x)], 1u);
    return b;
}
__device__ __forceinline__ void xcd_barrier_complete(unsigned* bar, unsigned x, unsigned& nloc, unsigned& nx) {
    const unsigned G = gridDim.x * gridDim.y * gridDim.z;
    unsigned sum, cnt, mine, sp = 0u;
    for (;;) {
        sum = 0u; cnt = 0u; mine = 0u;
#pragma unroll
        for (unsigned j = 0; j < 16; ++j) { const unsigned c = xb_ld(&bar[XB_XCNT(j)]); sum += c; cnt += (c > 0u) ? 1u : 0u; mine = (j == x) ? c : mine; }
        if (sum == G) break;
        __builtin_amdgcn_s_sleep(1);
        if ((++sp & 255u) == 0u) { if (xb_ld(&bar[XB_TMO])) break; if (sp > XB_SPIN_CAP) { atomicAdd(&bar[XB_TMO], 1u); break; } }
    }
    nloc = mine > 0u ? mine : 1u; nx = cnt > 0u ? cnt : 1u;
}
__device__ __forceinline__ void xcd_barrier(const XcdBarrier& b) {
    asm volatile("s_waitcnt vmcnt(0)" ::: "memory");
    __syncthreads();
    if (threadIdx.x == 0) {
        unsigned* bar = b.bar;
        __builtin_amdgcn_s_waitcnt(0);
        unsigned nloc = b.st[0], nx = b.st[1];
        if (nloc == 0u) { xcd_barrier_complete(bar, b.x, nloc, nx); b.st[0] = nloc; b.st[1] = nx; }
        const unsigned old = xb_add(&bar[XB_XSUB(b.x)], 1u);
        const unsigned gen = old / nloc;
        if (old + 1u == (gen + 1u) * nloc) {
            __builtin_amdgcn_fence(__ATOMIC_RELEASE, "agent");
            asm volatile("s_waitcnt vmcnt(0)" ::: "memory");
            const unsigned og = xb_add(&bar[XB_TOP], 1u);
            const unsigned tg = og / nx;
            if (og + 1u == (tg + 1u) * nx) xb_add(&bar[XB_TOPGEN], 1u);
            else XB_SPIN(xb_ld(&bar[XB_TOPGEN]) == tg, bar);
            __builtin_amdgcn_fence(__ATOMIC_ACQUIRE, "agent");
            xb_add(&bar[XB_XGEN(b.x)], 1u);
            asm volatile("s_waitcnt vmcnt(0)" ::: "memory");
        } else {
            XB_SPIN(xb_ld(&bar[XB_XGEN(b.x)]) == gen, bar);
            __builtin_amdgcn_fence(__ATOMIC_ACQUIRE, "agent");
            asm volatile("s_waitcnt vmcnt(0)" ::: "memory");
        }
    }
    __syncthreads();
}

struct Frame {
    LAS unsigned char* lds;
    int tid, lane, wave, vcu, G;
};

struct ConvItem { const float* W; const float* gain; bf16* WT; int N, Kdst, k_off, k0, n0, drow0; };
__device__ __forceinline__ bool conv_decode(ConvItem& c, KP P, int l, int it) {
    constexpr int I_IN = 16 * 160, I_GLU = 8 * 32, I_MRG = 3 * 8 * 32, I_OUT = 16 * 32, I_F1 = 16 * 128, I_F2 = 64 * 32;
    constexpr int NITEMS = I_IN + I_GLU + I_MRG + I_OUT + I_F1 + I_F2;
    if (it >= NITEMS) return false;
    unsigned char* ws = P->ws; int r = it; c.gain = nullptr; c.k_off = 0;
    if (r < I_IN) { const int kb = r / 160, nb = r % 160; c.W = P->w_in + (size_t)l * DM * DIN; c.N = DIN; c.gain = P->norm_mix + l * DM; c.WT = (bf16*)(ws + WS_WIN); c.Kdst = DM; c.k0 = 64 * kb; c.n0 = 32 * nb; c.drow0 = 32 * nb; return true; } r -= I_IN;
    if (r < I_GLU) { const int kb = r / 32, nb = r % 32; const int n0 = 32 * nb, v = n0 & 511;
        c.W = P->w_glu + (size_t)l * 512 * 1024; c.N = 1024; c.WT = (bf16*)(ws + WS_WGLU); c.Kdst = 512; c.k0 = 64 * kb; c.n0 = n0; c.drow0 = (v >> 7) * 256 + (n0 >= 512 ? 128 : 0) + (v & 127); return true; } r -= I_GLU;
    if (r < I_MRG) { const int sg = r / 256, q = r % 256, kb = q / 32, nb = q % 32; c.W = (sg == 0 ? P->w_o_swa : (sg == 1 ? P->w_o_ssm : P->w_o_moba)) + (size_t)l * 512 * DM;
        c.N = DM; c.WT = (bf16*)(ws + WS_WMRG); c.Kdst = 1536; c.k_off = 512 * sg; c.k0 = 64 * kb; c.n0 = 32 * nb; c.drow0 = 32 * nb; return true; } r -= I_MRG;
    if (r < I_OUT) { const int kb = r / 32, nb = r % 32; c.W = P->w_out + (size_t)l * DM * DM; c.N = DM; c.WT = (bf16*)(ws + WS_WOUT); c.Kdst = DM; c.k0 = 64 * kb; c.n0 = 32 * nb; c.drow0 = 32 * nb; return true; } r -= I_OUT;
    if (r < I_F1) { const int kb = r / 128, nb = r % 128; c.W = P->w_ff1 + (size_t)l * DM * DFF; c.N = DFF; c.gain = P->norm_ffn + l * DM; c.WT = (bf16*)(ws + WS_WFF1); c.Kdst = DM; c.k0 = 64 * kb; c.n0 = 32 * nb; c.drow0 = 32 * nb; return true; } r -= I_F1;
    { const int kb = r / 32, nb = r % 32; c.W = P->w_ff2 + (size_t)l * DFF * DM; c.N = DM; c.WT = (bf16*)(ws + WS_WFF2); c.Kdst = DFF; c.k0 = 64 * kb; c.n0 = 32 * nb; c.drow0 = 32 * nb; return true; }
}
__device__ __forceinline__ void conv_loads(f32x4 (&wv)[8], const ConvItem& c, int lane) {
#pragma unroll
    for (int i = 0; i < 8; ++i) wv[i] = *(const f32x4*)(c.W + (size_t)(c.k0 + 8 * i + (lane >> 3)) * c.N + c.n0 + 4 * (lane & 7));
}
__device__ __forceinline__ void conv_store(const f32x4 (&wv)[8], const ConvItem& c, LAS float* scr, int lane) {
#pragma unroll
    for (int i = 0; i < 8; ++i) { const int kk = 8 * i + (lane >> 3); const float g = c.gain ? c.gain[c.k0 + kk] : 1.f; LAS float* sp = scr + kk * 33 + 4 * (lane & 7);
        sp[0] = wv[i][0] * g; sp[1] = wv[i][1] * g; sp[2] = wv[i][2] * g; sp[3] = wv[i][3] * g; }
    LDS_WAIT(); asm volatile("" ::: "memory");
    const int cc = lane & 7;
#pragma unroll
    for (int j = 0; j < 4; ++j) { const int n = (lane >> 3) + 8 * j; const LAS float* s = scr + (8 * cc) * 33 + n;
        u32x4 o; o.x = pk2(s[0 * 33], s[1 * 33]); o.y = pk2(s[2 * 33], s[3 * 33]); o.z = pk2(s[4 * 33], s[5 * 33]); o.w = pk2(s[6 * 33], s[7 * 33]);
        if ((WT_MASK & 8) != 0) { const __amdgpu_buffer_rsrc_t wr_ = __builtin_amdgcn_make_buffer_rsrc(c.WT, 0, 16 << 20, 0x00020000); __builtin_amdgcn_raw_buffer_store_b128(o, wr_, (unsigned)(((size_t)(c.drow0 + n) * c.Kdst + c.k_off + c.k0 + 8 * cc) * 2), 0, 16); }
        else *(GAS u32x4*)(c.WT + (size_t)(c.drow0 + n) * c.Kdst + c.k_off + c.k0 + 8 * cc) = o; }
    LDS_WAIT(); asm volatile("" ::: "memory");
}
__device__ __forceinline__ void conv_layer(const Frame& F, KP P, int l) {
    LAS float* scr = (LAS float*)(F.lds + RING_OFF + F.wave * 16384);
    const int gw = F.vcu * NWAVES + F.wave, NGW = F.G * NWAVES;
    f32x4 wa[8], wb[8];
    int it = gw; bool have;
    { ConvItem c; have = conv_decode(c, P, l, it); if (have) conv_loads(wa, c, F.lane); }
#pragma unroll 1
    while (have) {
        bool hn; { ConvItem n; hn = conv_decode(n, P, l, it + NGW); if (hn) conv_loads(wb, n, F.lane); }
        { ConvItem c; conv_decode(c, P, l, it); asm volatile("" ::: "memory"); conv_store(wa, c, scr, F.lane); }
        have = hn; it += NGW;
#pragma unroll
        for (int i = 0; i < 8; ++i) wa[i] = wb[i];
    }
}
__device__ __forceinline__ void ssm_mats(const Frame& F, KP P, int l) {
    __syncthreads();
    LAS float* L = (LAS float*)(F.lds + RING_OFF);
    LAS float* apr = L;
    LAS float* api = L + 17 * 64;
    LAS float* bbr = L + 34 * 64;
    LAS float* bbi = bbr + 1024;
    LAS float* ccr = bbi + 1024;
    LAS float* cci = ccr + 1024;
    LAS float* ktab = cci + 1024;
    for (int wi = F.vcu; wi < 256; wi += F.G) {
        const int g = wi >> 3, part = wi & 7; const int tid = F.tid;
        if (tid < 64) { const int p = tid; const float lr = P->lam_re[l * 2048 + g * 64 + p], li = P->lam_im[l * 2048 + g * 64 + p], dt = expf(P->log_step[l * 32 + g]);
            const float mag = expf(lr * dt), are = mag * cosf(li * dt), aim = mag * sinf(li * dt);
            const float den = lr * lr + li * li, nr = are - 1.f, ni = aim, fre = (nr * lr + ni * li) / den, fim = (ni * lr - nr * li) / den;
            float pr = 1.f, pi = 0.f;
            for (int k = 0; k <= 16; ++k) { apr[k * 64 + p] = pr; api[k * 64 + p] = pi; const float t = pr * are - pi * aim; pi = pr * aim + pi * are; pr = t; }
            for (int h = 0; h < 16; ++h) { const float br = P->b_re[(size_t)l * 32768 + (g * 64 + p) * 16 + h], bi = P->b_im[(size_t)l * 32768 + (g * 64 + p) * 16 + h]; bbr[p * 16 + h] = fre * br - fim * bi; bbi[p * 16 + h] = fre * bi + fim * br; } }
        for (int e = tid; e < 1024; e += 512) { ccr[e] = P->c_re[(size_t)l * 32768 + g * 1024 + e]; cci[e] = P->c_im[(size_t)l * 32768 + g * 1024 + e]; }
        __syncthreads();
        for (int e = tid; e < 512; e += 512) { const int tau = e >> 5, i = 2 * part + ((e >> 4) & 1), j = e & 15; float acc = 0.f;
            for (int p = 0; p < 64; ++p) { const float cr = ccr[i * 64 + p], ci = cci[i * 64 + p], ar = apr[tau * 64 + p], ai = api[tau * 64 + p]; const float er = cr * ar - ci * ai, ei = cr * ai + ci * ar; acc += er * bbr[p * 16 + j] - ei * bbi[p * 16 + j]; }
            if (tau == 0 && i == j) acc += P->d_skip[l * 512 + g * 16 + i];
            ktab[tau * 256 + i * 16 + j] = acc; }
        __syncthreads();
        bf16* BM_ = (bf16*)(P->ws + WS_SMAIN) + (size_t)g * 256 * SSM_KM;
        for (int e = tid; e < 32 * SSM_KM / 2; e += 512) {
            const int rr = e / (SSM_KM / 2), k = (e % (SSM_KM / 2)) * 2, s = rr >> 1, i = 2 * part + (rr & 1), n = s * 16 + i; float v[2];
#pragma unroll
            for (int q = 0; q < 2; ++q) { const int kk = k + q;
                if (kk < 256) { const int sp = kk >> 4, j = kk & 15; v[q] = (sp <= s) ? ktab[(s - sp) * 256 + i * 16 + j] : 0.f; }
                else { const int p = (kk - 256) & 63; const float cr = ccr[i * 64 + p], ci = cci[i * 64 + p], ar = apr[(s + 1) * 64 + p], ai = api[(s + 1) * 64 + p]; v[q] = (kk < 320) ? (cr * ar - ci * ai) : -(cr * ai + ci * ar); } }
            *(GAS unsigned*)(BM_ + (size_t)n * SSM_KM + k) = pk2(v[0], v[1]); }
        bf16* BE_ = (bf16*)(P->ws + WS_SEND) + (size_t)g * 256 * SSM_KE;
        for (int e = tid; e < 32 * SSM_KE / 2; e += 512) {
            const int n = part * 32 + e / (SSM_KE / 2), k = (e % (SSM_KE / 2)) * 2; float v[2];
#pragma unroll
            for (int q = 0; q < 2; ++q) { const int kk = k + q, sp = kk >> 4, j = kk & 15, p = n & 63; const float ar = apr[(15 - sp) * 64 + p], ai = api[(15 - sp) * 64 + p], br = bbr[p * 16 + j], bi = bbi[p * 16 + j];
                v[q] = (n < 64) ? (ar * br - ai * bi) : ((n < 128) ? (ar * bi + ai * br) : 0.f); }
            *(GAS unsigned*)(BE_ + (size_t)n * SSM_KE + k) = pk2(v[0], v[1]); }
        __syncthreads();
    }
}
__device__ __forceinline__ void xb_pass(const Frame& F, KP P) {
    const int gw = F.vcu * NWAVES + F.wave, NGW = F.G * NWAVES;
    bf16* XB = (bf16*)(P->ws + WS_XN); float* SSQ = (float*)(P->ws + WS_SSQ);
    for (int m = gw; m < T; m += NGW) {
        const GAS f32x4* xr = (const GAS f32x4*)(P->x_in + (size_t)m * DM) + F.lane;
        f32x4 v[4]; float s = 0.f;
#pragma unroll
        for (int j = 0; j < 4; ++j) { v[j] = xr[64 * j]; s += (v[j].x * v[j].x + v[j].y * v[j].y) + (v[j].z * v[j].z + v[j].w * v[j].w); }
        s = wave_sum(s);
        GAS unsigned long long* o8 = (GAS unsigned long long*)(XB + (size_t)m * DM) + F.lane;
#pragma unroll
        for (int j = 0; j < 4; ++j) o8[64 * j] = (unsigned long long)pk2(v[j].x, v[j].y) | ((unsigned long long)pk2(v[j].z, v[j].w) << 32);
        if (F.lane < 16) SSQ[(size_t)m * 16 + F.lane] = (F.lane == 0) ? s : 0.f;
    }
}
__device__ __forceinline__ void final_pass(const Frame& F, KP P) {
    const int gw = F.vcu * NWAVES + F.wave, NGW = F.G * NWAVES;
    for (int m = gw; m < T; m += NGW) {
        GAS f32x4* xr = (GAS f32x4*)(P->x + (size_t)m * DM) + F.lane;
        f32x4 v[4]; float s = 0.f;
#pragma unroll
        for (int j = 0; j < 4; ++j) { v[j] = xr[64 * j]; s += (v[j].x * v[j].x + v[j].y * v[j].y) + (v[j].z * v[j].z + v[j].w * v[j].w); }
        const float r = rsqrtf(wave_sum(s) * (1.f / DM) + NORM_EPS);
#pragma unroll
        for (int j = 0; j < 4; ++j) { const f32x4 g = ((const GAS f32x4*)P->norm_final)[F.lane + 64 * j]; xr[64 * j] = v[j] * r * g; }
    }
}
__device__ __forceinline__ void ssm_carry(const Frame& F, KP P, int l) {
    if (F.vcu & 15) return;
    const int gt = (F.vcu >> 4) * 512 + F.tid;
    if (gt >= 32 * NB * 64) return;
    const int p = gt & 63, b = (gt >> 6) & 3, g = gt >> 8;
    const float lr = P->lam_re[l * 2048 + g * 64 + p], li = P->lam_im[l * 2048 + g * 64 + p], dt = expf(P->log_step[l * 32 + g]);
    const float mag = expf(lr * dt), are = mag * cosf(li * dt), aim = mag * sinf(li * dt);
    float pr = 1.f, pi = 0.f;
    for (int k = 0; k < 16; ++k) { const float t = pr * are - pi * aim; pi = pr * aim + pi * are; pr = t; }
    const float* he = (const float*)(P->ws + WS_HEND) + ((size_t)g * NCH + b * 256) * 128 + p;
    bf16* hi = (bf16*)(P->ws + WS_HINIT) + ((size_t)g * NCH + b * 256) * 128 + p;
    float sr = 0.f, si = 0.f;
    float er[8], ei[8];
#pragma unroll
    for (int q = 0; q < 8; ++q) { er[q] = he[(size_t)q * 128]; ei[q] = he[(size_t)q * 128 + 64]; }
    for (int c0 = 0; c0 < 256; c0 += 8) {
        float nr_[8], ni_[8];
        const int cn = (c0 + 8 < 256) ? c0 + 8 : c0;
#pragma unroll
        for (int q = 0; q < 8; ++q) { nr_[q] = he[(size_t)(cn + q) * 128]; ni_[q] = he[(size_t)(cn + q) * 128 + 64]; }
#pragma unroll
        for (int q = 0; q < 8; ++q) { hi[(size_t)(c0 + q) * 128] = (bf16)f2bf(sr); hi[(size_t)(c0 + q) * 128 + 64] = (bf16)f2bf(si);
            const float tr = pr * sr - pi * si + er[q], ti = pr * si + pi * sr + ei[q]; sr = tr; si = ti; }
#pragma unroll
        for (int q = 0; q < 8; ++q) { er[q] = nr_[q]; ei[q] = ni_[q]; }
    }
}
namespace att {
__device__ __forceinline__ int crow(int r, int hi) { return (r & 3) + 8 * (r >> 2) + 4 * hi; }
struct St { f32x16 o0, o1; float m, l; };
__device__ __forceinline__ unsigned cvtpk(float lo, float hi) { return cvtpk_s(lo, hi); }

__device__ __forceinline__ void loadk(bf16x8 (&kf)[8], const bf16* kp) {
#pragma unroll
    for (int d0 = 0; d0 < 4; ++d0) { kf[2 * d0] = *(const bf16x8*)(kp + d0 * 16); kf[2 * d0 + 1] = *(const bf16x8*)(kp + 32 * 128 + d0 * 16); }
}
template <int MODE>
__device__ __forceinline__ void tile(St& st, const bf16x8 (&qr)[4], const bf16x8 (&kf)[8], const bf16* vtp  , int kq  , float sl2, bool rowok, int klo  , int hi) {
    f32x16 p0 = {}, p1 = {};
#pragma unroll
    for (int d0 = 0; d0 < 4; ++d0) { p0 = __builtin_amdgcn_mfma_f32_32x32x16_bf16(kf[2 * d0], qr[d0], p0, 0, 0, 0); p1 = __builtin_amdgcn_mfma_f32_32x32x16_bf16(kf[2 * d0 + 1], qr[d0], p1, 0, 0, 0); }
    s16x4 vl[2][4], vh[2][4];
#pragma unroll
    for (int dh = 0; dh < 2; ++dh)
#pragma unroll
        for (int s = 0; s < 4; ++s) { vl[dh][s] = *(const s16x4*)(vtp + (size_t)dh * 32 * S + 16 * s); vh[dh][s] = *(const s16x4*)(vtp + (size_t)dh * 32 * S + 16 * s + 8); }
    const float base = sl2 * (float)(kq + 4 * hi);
    float mx = -INFINITY;
#pragma unroll
    for (int r = 0; r < 16; ++r) { const int c = (r & 3) + 8 * (r >> 2); const int k0 = kq + 4 * hi + c, k1 = k0 + 32;
        float a = fmaf(sl2, (float)c, p0[r]), b = fmaf(sl2, (float)(c + 32), p1[r]);
        if (MODE == 1) { a = (k0 <= 0 && k0 >= klo) ? a : -INFINITY; b = (k1 <= 0 && k1 >= klo) ? b : -INFINITY; }
        else if (MODE == 2) { a = (k0 <= 0) ? a : -INFINITY; b = (k1 <= 0) ? b : -INFINITY; }
        else if (MODE == 3) { a = (rowok && k0 <= 0) ? a : -INFINITY; b = (rowok && k1 <= 0) ? b : -INFINITY; }
        p0[r] = a; p1[r] = b; mx = fmaxf(mx, fmaxf(a, b)); }
    mx += base;
    mx = fmaxf(mx, __shfl_xor(mx, 32));
    const float mn = fmaxf(st.m, mx), alpha = __builtin_amdgcn_exp2f(st.m - mn), off = base - mn;
    float sum = 0.f;
#pragma unroll
    for (int r = 0; r < 16; ++r) { p0[r] = __builtin_amdgcn_exp2f(p0[r] + off); p1[r] = __builtin_amdgcn_exp2f(p1[r] + off); sum += p0[r] + p1[r]; }
    st.m = mn; st.l = st.l * alpha + sum;
#pragma unroll
    for (int r = 0; r < 16; ++r) { st.o0[r] *= alpha; st.o1[r] *= alpha; }
    bf16x8 pf[4];
#pragma unroll
    for (int s = 0; s < 2; ++s) { u32x4 w0, w1;
        w0.x = cvtpk(p0[8 * s + 0], p0[8 * s + 1]); w0.y = cvtpk(p0[8 * s + 2], p0[8 * s + 3]); w0.z = cvtpk(p0[8 * s + 4], p0[8 * s + 5]); w0.w = cvtpk(p0[8 * s + 6], p0[8 * s + 7]);
        w1.x = cvtpk(p1[8 * s + 0], p1[8 * s + 1]); w1.y = cvtpk(p1[8 * s + 2], p1[8 * s + 3]); w1.z = cvtpk(p1[8 * s + 4], p1[8 * s + 5]); w1.w = cvtpk(p1[8 * s + 6], p1[8 * s + 7]);
        pf[s] = __builtin_bit_cast(bf16x8, w0); pf[2 + s] = __builtin_bit_cast(bf16x8, w1); }
#pragma unroll
    for (int s = 0; s < 4; ++s) {
        const bf16x8 v0 = (bf16x8){vl[0][s][0], vl[0][s][1], vl[0][s][2], vl[0][s][3], vh[0][s][0], vh[0][s][1], vh[0][s][2], vh[0][s][3]};
        const bf16x8 v1 = (bf16x8){vl[1][s][0], vl[1][s][1], vl[1][s][2], vl[1][s][3], vh[1][s][0], vh[1][s][1], vh[1][s][2], vh[1][s][3]};
        st.o0 = __builtin_amdgcn_mfma_f32_32x32x16_bf16(v0, pf[s], st.o0, 0, 0, 0);
        st.o1 = __builtin_amdgcn_mfma_f32_32x32x16_bf16(v1, pf[s], st.o1, 0, 0, 0); }
}
__device__ __forceinline__ void finish(const St& st, bf16* op, int hi) {
    const float lt = st.l + __shfl_xor(st.l, 32), rl = __builtin_amdgcn_rcpf(lt);
#pragma unroll
    for (int g = 0; g < 4; ++g) { u32x2 a, b;
        a.x = cvtpk(st.o0[4 * g] * rl, st.o0[4 * g + 1] * rl); a.y = cvtpk(st.o0[4 * g + 2] * rl, st.o0[4 * g + 3] * rl);
        b.x = cvtpk(st.o1[4 * g] * rl, st.o1[4 * g + 1] * rl); b.y = cvtpk(st.o1[4 * g + 2] * rl, st.o1[4 * g + 3] * rl);
        *(u32x2*)(op + 8 * g + 4 * hi) = a; *(u32x2*)(op + 32 + 8 * g + 4 * hi) = b; }
}
__device__ __forceinline__ void loadq(bf16x8 (&qr)[4], const bf16* qp) {
#pragma unroll
    for (int d0 = 0; d0 < 4; ++d0) qr[d0] = *(const bf16x8*)(qp + d0 * 16);
}

constexpr int IMG_K = 0, IMG_V = 32768, IMG_BYTES = 65536;
__device__ __forceinline__ void img_load(const Frame& F, LAS unsigned char* img, const bf16* K, long krow0, int kvh, const bf16* vt0, int key0) {
    const int lane = F.lane, w = F.wave;
#pragma unroll
    for (int i = 0; i < 4; ++i) { const int piece = w * 4 + i, key = piece * 8 + (lane >> 3), c = (lane & 7) ^ ((key >> 1) & 7); long row = krow0 + key; row = row < 0 ? 0 : row;
        __builtin_amdgcn_global_load_lds((const unsigned*)(K + row * 128 + kvh * 64 + c * 8), (LAS unsigned*)(img + IMG_K + piece * 1024), 16, 0, 0); }
#pragma unroll
    for (int i = 0; i < 4; ++i) { const int piece = w * 4 + i, d = piece * 2 + (lane >> 5), c = (lane & 31) ^ (d & 15); int kk = key0 + c * 8; kk = kk < 0 ? 0 : kk;
        __builtin_amdgcn_global_load_lds((const unsigned*)(vt0 + (long)d * S + kk), (LAS unsigned*)(img + IMG_V + piece * 1024), 16, 0, 0); }
}
struct LaneOff { int k[4]; int v[4]; };
__device__ __forceinline__ void lane_off(LaneOff& lo, int r32, int hi) { const int s7 = (r32 >> 1) & 7, x = r32 & 15;
#pragma unroll
    for (int d0 = 0; d0 < 4; ++d0) lo.k[d0] = ((2 * d0 + hi) ^ s7) << 4;
#pragma unroll
    for (int s = 0; s < 4; ++s) lo.v[s] = ((2 * s + hi) ^ (x & 7)) << 4; }
__device__ __forceinline__ float vmax3(float a, float b, float c) { float r; asm("v_max3_f32 %0, %1, %2, %3" : "=v"(r) : "v"(a), "v"(b), "v"(c)); return r; }
__device__ __forceinline__ float xhalf_max(float v) { float a = v, b = v; asm("s_nop 1\n\tv_permlane32_swap_b32 %0, %1" : "+v"(a), "+v"(b)); return fmaxf(a, b); }
__device__ __forceinline__ float xhalf_sum(float v) { float a = v, b = v; asm("s_nop 1\n\tv_permlane32_swap_b32 %0, %1" : "+v"(a), "+v"(b)); return a + b; }
__device__ __forceinline__ void stage_o(const St& st, float rl, LAS unsigned char* stg, int r32, int hi) {
#pragma unroll
    for (int g = 0; g < 4; ++g) { u32x2 a2, c2;
        a2.x = cvtpk(st.o0[4 * g] * rl, st.o0[4 * g + 1] * rl); a2.y = cvtpk(st.o0[4 * g + 2] * rl, st.o0[4 * g + 3] * rl);
        c2.x = cvtpk(st.o1[4 * g] * rl, st.o1[4 * g + 1] * rl); c2.y = cvtpk(st.o1[4 * g + 2] * rl, st.o1[4 * g + 3] * rl);
        *(LAS u32x2*)(stg + r32 * 144 + (8 * g + 4 * hi) * 2) = a2; *(LAS u32x2*)(stg + r32 * 144 + (32 + 8 * g + 4 * hi) * 2) = c2; }
}
template <bool HALF>
__device__ __forceinline__ void read_k(bf16x8 (&kf)[8], const LAS unsigned char* img, const LaneOff& lo, int ko, int r32) {
    const LAS unsigned char* kp = img + IMG_K + (ko + r32) * 128;
#pragma unroll
    for (int d0 = 0; d0 < 4; ++d0) { kf[2 * d0] = *(const LAS bf16x8*)(kp + lo.k[d0]); if (!HALF) kf[2 * d0 + 1] = *(const LAS bf16x8*)(kp + 32 * 128 + lo.k[d0]); }
}
template <int MODE, bool HALF, bool AL64, bool NEXTK>
__device__ __forceinline__ void tile_run(St& st, const bf16x8 (&qr)[4], bf16x8 (&kf)[8], const LAS unsigned char* img, const LaneOff& lo, int ko, int kq  , float sl2, bool rowok, int klo, int hi, int r32, int ko_next) {
    const bool fresh = st.m == -INFINITY; const float ref = fresh ? 0.f : st.m;
    const float cin = sl2 * (float)(kq + 4 * hi) - ref, cin1 = cin + 32.f * sl2;
    f32x16 p0, p1;
#pragma unroll
    for (int r = 0; r < 16; ++r) { const float c = (float)((r & 3) + 8 * (r >> 2)); p0[r] = fmaf(sl2, c, cin); p1[r] = fmaf(sl2, c, cin1); }
#pragma unroll
    for (int d0 = 0; d0 < 4; ++d0) {
        p0 = __builtin_amdgcn_mfma_f32_32x32x16_bf16(kf[2 * d0], qr[d0], p0, 0, 0, 0);
        if (!HALF) p1 = __builtin_amdgcn_mfma_f32_32x32x16_bf16(kf[2 * d0 + 1], qr[d0], p1, 0, 0, 0); }
    __builtin_amdgcn_sched_barrier(0);
    const int x = r32 & 15, kc = ko >> 3;
    const LAS unsigned char* vp = img + IMG_V + r32 * 512 + (AL64 ? ((kc ^ (x & 8)) << 4) : 0);
    constexpr int NS = HALF ? 2 : 4;
    bf16x8 va[NS], vb[NS];
#pragma unroll
    for (int s = 0; s < NS; ++s) { const int o = AL64 ? lo.v[s] : (((kc + 2 * s + hi) ^ x) << 4);
        va[s] = *(const LAS bf16x8*)(vp + o); vb[s] = *(const LAS bf16x8*)(vp + 32 * 512 + o); }
    if (NEXTK) read_k<false>(kf, img, lo, ko_next, r32);
    __builtin_amdgcn_sched_barrier(0);
    if (MODE != 0) {
#pragma unroll
        for (int r = 0; r < 16; ++r) { const int c = (r & 3) + 8 * (r >> 2); const int k0 = kq + 4 * hi + c, k1 = k0 + 32;
            float a = p0[r], b = HALF ? -INFINITY : p1[r];
            if (MODE == 1) { a = (k0 <= 0 && k0 >= klo) ? a : -INFINITY; if (!HALF) b = (k1 <= 0 && k1 >= klo) ? b : -INFINITY; }
            else if (MODE == 2) { a = (k0 <= 0) ? a : -INFINITY; if (!HALF) b = (k1 <= 0) ? b : -INFINITY; }
            else if (MODE == 3) { a = (rowok && k0 <= 0) ? a : -INFINITY; if (!HALF) b = (rowok && k1 <= 0) ? b : -INFINITY; }
            p0[r] = a; if (!HALF) p1[r] = b; }
    }
    float ma = fmaxf(p0[0], HALF ? p0[1] : p1[0]), mb = ma;
    if (HALF) {
#pragma unroll
        for (int r = 2; r < 14; r += 4) { ma = vmax3(ma, p0[r], p0[r + 1]); mb = vmax3(mb, p0[r + 2], p0[r + 3]); }
        ma = vmax3(ma, p0[14], p0[15]);
    } else {
#pragma unroll
        for (int r = 1; r < 15; r += 2) { ma = vmax3(ma, p0[r], p0[r + 1]); mb = vmax3(mb, p1[r], p1[r + 1]); }
        ma = vmax3(ma, p0[15], p1[15]);
    }
    const float mxh = fmaxf(ma, mb);
    if (__builtin_expect(__any(fresh || mxh > 8.f), 0)) {
        asm volatile("" ::: "memory");
        const float mx = xhalf_max(mxh);
        const float delta = fresh ? ((mx == -INFINITY) ? 0.f : mx) : ((mx > 8.f) ? mx : 0.f);
        const float alpha = fresh ? 1.f : __builtin_amdgcn_exp2f(-delta);
#pragma unroll
        for (int r = 0; r < 16; ++r) { p0[r] -= delta; if (!HALF) p1[r] -= delta; st.o0[r] *= alpha; st.o1[r] *= alpha; }
        st.l *= alpha;
        st.m = (fresh && mx == -INFINITY) ? -INFINITY : ref + delta;
    }
#pragma unroll
    for (int r = 0; r < 16; ++r) { p0[r] = __builtin_amdgcn_exp2f(p0[r]); if (!HALF) p1[r] = __builtin_amdgcn_exp2f(p1[r]); }
    { f32x2_t s2 = {0.f, 0.f};
#pragma unroll
      for (int r = 0; r < 16; r += 2) { s2 += (f32x2_t){p0[r], p0[r + 1]}; if (!HALF) s2 += (f32x2_t){p1[r], p1[r + 1]}; }
      st.l += s2[0] + s2[1]; }
#pragma unroll
    for (int s = 0; s < NS; ++s) {
        u32x4 w;
        if (s < 2) { w.x = cvtpk(p0[8 * s + 0], p0[8 * s + 1]); w.y = cvtpk(p0[8 * s + 2], p0[8 * s + 3]); w.z = cvtpk(p0[8 * s + 4], p0[8 * s + 5]); w.w = cvtpk(p0[8 * s + 6], p0[8 * s + 7]); }
        else { w.x = cvtpk(p1[8 * s - 16], p1[8 * s - 15]); w.y = cvtpk(p1[8 * s - 14], p1[8 * s - 13]); w.z = cvtpk(p1[8 * s - 12], p1[8 * s - 11]); w.w = cvtpk(p1[8 * s - 10], p1[8 * s - 9]); }
        const bf16x8 pf = __builtin_bit_cast(bf16x8, w);
        st.o0 = __builtin_amdgcn_mfma_f32_32x32x16_bf16(va[s], pf, st.o0, 0, 0, 0);
        st.o1 = __builtin_amdgcn_mfma_f32_32x32x16_bf16(vb[s], pf, st.o1, 0, 0, 0); }
}
template <int MODE, bool HALF, bool AL64>
__device__ __forceinline__ void tile_lds(St& st, const bf16x8 (&qr)[4], const LAS unsigned char* img, const LaneOff& lo, int ko, int kq  , float sl2, bool rowok, int klo, int hi, int r32) {
    bf16x8 kf[8];
    read_k<HALF>(kf, img, lo, ko, r32);
    __builtin_amdgcn_sched_barrier(0);
    tile_run<MODE, HALF, AL64, false>(st, qr, kf, img, lo, ko, kq, sl2, rowok, klo, hi, r32, 0);
}
__device__ __forceinline__ void swa_unit(const Frame& F, KP P, int l, int un) {
    bf16* QA = (bf16*)(P->ws + WS_QA); const bf16* KA = (const bf16*)(P->ws + WS_KA); const bf16* VAT = (const bf16*)(P->ws + WS_VAT);
    Frame F2 = F; asm volatile("" : "+v"(F2.lane));
    const int lane = F2.lane, r32 = lane & 31, hi = lane >> 5, w = F.wave;
    LAS unsigned char* img = F.lds + RING_OFF;
    LaneOff lo; lane_off(lo, r32, hi);
    {
        const int bk = un >> 5, nb = un & 31, b = bk >> 1, kvh = bk & 1, h = kvh * 4 + (w >> 1);
        __syncthreads();
        img_load(F2, img, KA, (long)b * S + nb * 128 - 128, kvh, VAT + (long)((b * 2 + kvh) * 64) * S, nb * 128 - 128);
        const float sl2 = exp2f(-0.5f * (float)(h + 1)) * LOG2E, sink2 = P->sinks[l * 8 + h] * LOG2E;
        bf16x8 qn[4]; loadq(qn, QA + (size_t)(b * S + nb * 128 + (w & 1) * 64 + r32) * 512 + h * 64 + 8 * hi);
        asm volatile("s_waitcnt vmcnt(0)" ::: "memory"); __syncthreads();
#pragma unroll 1
        for (int qt = 0; qt < 2; ++qt) {
            const int qo = (w & 1) * 64 + qt * 32, t0 = nb * 128 + qo, q = t0 + r32;
            bf16* qrow = QA + (size_t)(b * S + q) * 512 + h * 64;
            bf16x8 qr[4];
            if (qt == 0) {
#pragma unroll
                for (int i = 0; i < 4; ++i) qr[i] = qn[i];
            } else loadq(qr, qrow + 8 * hi);
            St st; st.o0 = f32x16{}; st.o1 = f32x16{}; st.m = sink2; st.l = hi ? 0.f : 1.f;
            const int klo = q < 127 ? -q : -127;
            bf16x8 kf[8]; read_k<false>(kf, img, lo, qo, r32);
#pragma unroll 1
            for (int kt = 0; kt < 2; ++kt) tile_run<1, false, false, true>(st, qr, kf, img, lo, qo + 64 * kt, t0 - 128 + 64 * kt - q, sl2, true, klo, hi, r32, qo + 64 * kt + 64);
            tile_run<1, true, false, false>(st, qr, kf, img, lo, qo + 128, t0 - q, sl2, true, klo, hi, r32, 0);
            { const float rl = __builtin_amdgcn_rcpf(xhalf_sum(st.l));
              LAS unsigned char* stg = F.lds + RING_OFF + IMG_BYTES + w * 4736;
              stage_o(st, rl, stg, r32, hi);
              LDS_WAIT(); asm volatile("" ::: "memory");
#pragma unroll
              for (int i = 0; i < 4; ++i) { const int rw = i * 8 + (lane >> 3), ch = lane & 7;
                  *(u32x4*)(QA + (size_t)(b * S + t0 + rw) * 512 + h * 64 + ch * 8) = *(const LAS u32x4*)(stg + rw * 144 + ch * 16); }
              LDS_WAIT(); asm volatile("" ::: "memory"); }
        }
    }
    __syncthreads();
}
__device__ __forceinline__ float moba_sl2(int h) { return exp2f(-0.5f * (float)(8 + h + 1)) * LOG2E; }
__device__ __forceinline__ void select_unit(const Frame& F, KP P, int l, int un) {
    const bf16* QM = (const bf16*)(P->ws + WS_QM); const float* KMP = (const float*)(P->ws + WS_KMP);
    unsigned* LIST = (unsigned*)(P->ws + WS_LIST); unsigned* CNT = (unsigned*)(P->ws + WS_CTL) + CW_CNT + l * 128;
    LAS float* km = (LAS float*)(F.lds + RING_OFF);
    int tid_ = F.tid; asm volatile("" : "+v"(tid_));
    const int tid = tid_, lane = tid & 63;
    {
        const int bk = un >> 5, ch = un & 31, b = bk >> 1, kvh = bk & 1, j = ch >> 1;
        __syncthreads();
        for (int e = tid; e < 1024; e += 512) { const int n = e >> 6, d = e & 63; const float* k0 = KMP + (size_t)(b * 16 + n) * 128 + kvh * 64 + d; km[e] = k0[0] + k0[64 * 128]; }
        __syncthreads();
        if (j == 0) return;
        const int hg = tid >> 7, t = ch * 128 + (tid & 127);
        const bf16* qp = QM + (size_t)(b * S + t) * 512 + (kvh * 4 + hg) * 64;
        u32x4 qv[8];
#pragma unroll
        for (int i = 0; i < 8; ++i) qv[i] = *(const u32x4*)(qp + 8 * i);
        int i0 = 0, i1 = 1, i2 = 2;
        if (j > 3) {
            float v0 = -INFINITY, v1 = -INFINITY, v2 = -INFINITY; i0 = 0; i1 = 0; i2 = 0;
#pragma unroll 1
            for (int n = 0; n < j; ++n) { float a = 0.f;
#pragma unroll
                for (int i = 0; i < 8; ++i) { const f32x4 x0 = *(const LAS f32x4*)(km + n * 64 + 8 * i), x1 = *(const LAS f32x4*)(km + n * 64 + 8 * i + 4);
                    a += bf2f(qv[i].x & 0xffffu) * x0[0] + bf2f(qv[i].x >> 16) * x0[1] + bf2f(qv[i].y & 0xffffu) * x0[2] + bf2f(qv[i].y >> 16) * x0[3]
                       + bf2f(qv[i].z & 0xffffu) * x1[0] + bf2f(qv[i].z >> 16) * x1[1] + bf2f(qv[i].w & 0xffffu) * x1[2] + bf2f(qv[i].w >> 16) * x1[3]; }
                if (a > v0) { v2 = v1; i2 = i1; v1 = v0; i1 = i0; v0 = a; i0 = n; } else if (a > v1) { v2 = v1; i2 = i1; v1 = a; i1 = n; } else if (a > v2) { v2 = a; i2 = n; } }
        }
        const int nsel = j < 3 ? j : 3;
        unsigned mycnt = 0u;
#pragma unroll 1
        for (int n = 0; n < j; ++n) { const bool sel = (n == i0 && nsel > 0) || (n == i1 && nsel > 1) || (n == i2 && nsel > 2); const unsigned long long mask = __ballot(sel); if (lane == n) mycnt = (unsigned)__popcll(mask); }
        unsigned mybase = 0u;
        if (lane < j && mycnt) mybase = __hip_atomic_fetch_add(CNT + bk * 16 + lane, mycnt, __ATOMIC_RELAXED, __HIP_MEMORY_SCOPE_AGENT);
#pragma unroll 1
        for (int n = 0; n < j; ++n) {
            const int r = (n == i0) ? 0 : ((n == i1) ? 1 : ((n == i2) ? 2 : 3));
            const bool sel = r < nsel;
            const unsigned long long mask = __ballot(sel);
            if (mask == 0ull) continue;
            const unsigned base = (unsigned)__shfl((int)mybase, n);
            const unsigned pos = base + (unsigned)__popcll(mask & ((1ull << lane) - 1ull));
            if (sel) LIST[(size_t)(bk * 16 + n) * 16384 + pos] = ((unsigned)t << 4) | ((unsigned)hg << 2) | (unsigned)r;
        }
    }
    __syncthreads();
}
__device__ __forceinline__ void swa_select_phase(const Frame& F, KP P, int l, int lq) {
    unsigned* qctr = (unsigned*)(P->ws + WS_CTL) + CW_SWAQ + lq;
    volatile LAS unsigned* jobw = (volatile LAS unsigned*)(F.lds + MISC_OFF + 64);
    for (;;) {
        __syncthreads();
        if (F.tid == 0) *jobw = __hip_atomic_fetch_add(qctr, 1u, __ATOMIC_RELAXED, __HIP_MEMORY_SCOPE_AGENT);
        __syncthreads();
        const int job = (int)*jobw;
        if (job >= 512) break;
        if (job < 256) swa_unit(F, P, l, job); else select_unit(F, P, lq, job - 256);
    }
}
__device__ __forceinline__ void store_o(const St& st, bf16* op, float rl, int hi) {
#pragma unroll
    for (int g = 0; g < 4; ++g) { u32x2 a, b;
        a.x = cvtpk(st.o0[4 * g] * rl, st.o0[4 * g + 1] * rl); a.y = cvtpk(st.o0[4 * g + 2] * rl, st.o0[4 * g + 3] * rl);
        b.x = cvtpk(st.o1[4 * g] * rl, st.o1[4 * g + 1] * rl); b.y = cvtpk(st.o1[4 * g + 2] * rl, st.o1[4 * g + 3] * rl);
        *(u32x2*)(op + 8 * g + 4 * hi) = a; *(u32x2*)(op + 32 + 8 * g + 4 * hi) = b; }
}
__device__ __forceinline__ void moba_gather(const Frame& F, KP P, int l, bool nostore = false) {
    const bf16* QM = (const bf16*)(P->ws + WS_QM); const bf16* KM = (const bf16*)(P->ws + WS_KM); const bf16* VMT = (const bf16*)(P->ws + WS_VMT);
    const unsigned* LIST = (const unsigned*)(P->ws + WS_LIST); unsigned* CNT = (unsigned*)(P->ws + WS_CTL) + CW_CNT + l * 128;
    bf16* PART = (bf16*)(P->ws + WS_PART); float* LSE = (float*)(P->ws + WS_LSE);
    const int lane = F.lane, r32 = lane & 31, hi = lane >> 5, w = F.wave;
    const int per = F.G >> 3;
    const int bk = F.vcu / per, loc = F.vcu % per;
    if (bk >= 8 || (F.vcu & 15) == 0) return;
    const int wg = loc - 1 - (loc > 16 ? 1 : 0), nwg = per - 2;
    const int b = bk >> 1, kvh = bk & 1;
    unsigned cnt = 0u;
    if (lane < 16) cnt = __hip_atomic_load(CNT + bk * 16 + lane, __ATOMIC_RELAXED, __HIP_MEMORY_SCOPE_AGENT);
    const int ns_l = (int)((cnt + 255u) >> 8);
    int pre = ns_l;
#pragma unroll
    for (int o = 1; o < 16; o <<= 1) { const int v = __shfl_up(pre, o); if (lane >= o) pre += v; }
    const int total = __shfl(pre, 15);
    const bf16* vt0 = VMT + (long)((b * 2 + kvh) * 64) * S;
    LAS unsigned char* ring = F.lds + RING_OFF;
    LaneOff lo; lane_off(lo, r32, hi);
    __syncthreads();
#define GA_LOCATE(it, n_, s_) do { const unsigned long long le_ = __ballot(lane < 16 && pre <= (it)); n_ = (int)__popcll(le_); s_ = (it) - ((n_ == 0) ? 0 : __shfl(pre, n_ - 1)); } while (0)
#define GA_ENTRY(e_, n_, s_) do { const int cn_ = (int)__shfl((int)cnt, n_), ti_ = (s_) * 8 + w, idx_ = ti_ * 32 + r32; e_ = 0u; if (ti_ * 32 < cn_) e_ = LIST[(size_t)(bk * 16 + n_) * 16384 + (idx_ < cn_ ? idx_ : ti_ * 32)]; } while (0)
#define GA_LOADQ(q_, e_) loadq(q_, QM + ((size_t)(b * S + (int)((e_) >> 4))) * 512 + (kvh * 4 + (int)(((e_) >> 2) & 3u)) * 64 + 8 * hi)
    int item = wg;
    if (item < total) {
        int n0, s0, n1 = 0, s1 = 0, n2 = 0, s2 = 0; unsigned e0, e1 = 0u, e2 = 0u;
        GA_LOCATE(item, n0, s0); GA_ENTRY(e0, n0, s0);
        bool has1 = item + nwg < total; if (has1) { GA_LOCATE(item + nwg, n1, s1); GA_ENTRY(e1, n1, s1); }
        img_load(F, ring, KM, (long)b * S + n0 * 256, kvh, vt0, n0 * 256);
        bf16x8 qn[4]; GA_LOADQ(qn, e0);
        int buf = 0;
#pragma unroll 1
        for (;;) {
            asm volatile("s_waitcnt vmcnt(0)" ::: "memory"); __syncthreads();
            bf16x8 qr[4];
#pragma unroll
            for (int i = 0; i < 4; ++i) qr[i] = qn[i];
            const LAS unsigned char* img = ring + buf * IMG_BYTES;
            if (has1) { Frame F2 = F; asm volatile("" : "+v"(F2.lane));
                img_load(F2, ring + (buf ^ 1) * IMG_BYTES, KM, (long)b * S + n1 * 256, kvh, vt0, n1 * 256); GA_LOADQ(qn, e1); }
            const bool has2 = item + 2 * nwg < total; if (has2) { GA_LOCATE(item + 2 * nwg, n2, s2); GA_ENTRY(e2, n2, s2); }
            const int cn = (int)__shfl((int)cnt, n0), ti = s0 * 8 + w; const bool tile_ok = ti * 32 < cn, valid = ti * 32 + r32 < cn;
            if (tile_ok) {
                const int t = (int)(e0 >> 4), hg = (int)((e0 >> 2) & 3u), r = (int)(e0 & 3u), h = kvh * 4 + hg;
                const float sl2 = moba_sl2(h);
                St st; st.o0 = f32x16{}; st.o1 = f32x16{}; st.m = -INFINITY; st.l = 0.f;
                const int kq = n0 * 256 - t;
                bf16x8 kf[8]; read_k<false>(kf, img, lo, 0, r32);
#pragma unroll 1
                for (int i = 0; i < 3; ++i) tile_run<0, false, true, true>(st, qr, kf, img, lo, 64 * i, kq + 64 * i, sl2, true, 0, hi, r32, 64 * i + 64);
                tile_run<0, false, true, false>(st, qr, kf, img, lo, 192, kq + 192, sl2, true, 0, hi, r32, 0);
                const float lt = xhalf_sum(st.l), rl = __builtin_amdgcn_rcpf(lt);
                const unsigned slot = (unsigned)(((b * 8 + h) * 3 + r) * S + t);
                if (!nostore) {
                    if (valid && hi == 0) LSE[slot] = st.m + __builtin_amdgcn_logf(lt);
                    LAS unsigned char* stg = F.lds + GSTG_OFF + w * 2560;
                    const unsigned sl_ = valid ? slot : 0xffffffffu;
                    const unsigned sr0 = (unsigned)__shfl((int)sl_, lane >> 2), sr1 = (unsigned)__shfl((int)sl_, 16 + (lane >> 2));
#pragma unroll
                    for (int half = 0; half < 2; ++half) {
#pragma unroll
                        for (int g = 0; g < 4; ++g) { u32x2 a2;
                            if (half == 0) { a2.x = cvtpk(st.o0[4 * g] * rl, st.o0[4 * g + 1] * rl); a2.y = cvtpk(st.o0[4 * g + 2] * rl, st.o0[4 * g + 3] * rl); }
                            else { a2.x = cvtpk(st.o1[4 * g] * rl, st.o1[4 * g + 1] * rl); a2.y = cvtpk(st.o1[4 * g + 2] * rl, st.o1[4 * g + 3] * rl); }
                            *(LAS u32x2*)(stg + r32 * 80 + 16 * g + 8 * hi) = a2; }
                        LDS_WAIT(); asm volatile("" ::: "memory");
                        const u32x4 v0 = *(const LAS u32x4*)(stg + (lane >> 2) * 80 + (lane & 3) * 16), v1 = *(const LAS u32x4*)(stg + (16 + (lane >> 2)) * 80 + (lane & 3) * 16);
                        if (sr0 != 0xffffffffu) *(u32x4*)(PART + (size_t)sr0 * 64 + half * 32 + (lane & 3) * 8) = v0;
                        if (sr1 != 0xffffffffu) *(u32x4*)(PART + (size_t)sr1 * 64 + half * 32 + (lane & 3) * 8) = v1;
                        LDS_WAIT(); asm volatile("" ::: "memory"); }
                }
            }
            if (!has1) break;
            item += nwg; n0 = n1; s0 = s1; e0 = e1; n1 = n2; s1 = s2; e1 = e2; has1 = has2; buf ^= 1;
        }
    }
#undef GA_LOCATE
#undef GA_ENTRY
#undef GA_LOADQ
    asm volatile("s_waitcnt vmcnt(0)" ::: "memory"); __syncthreads();
}
__device__ __forceinline__ void own_subjob(const Frame& F, KP P, int sjob, bool nofull = false, bool nocomb = false) {
    bf16* QM = (bf16*)(P->ws + WS_QM); const bf16* KM = (const bf16*)(P->ws + WS_KM); const bf16* VMT = (const bf16*)(P->ws + WS_VMT);
    const bf16* PART = (const bf16*)(P->ws + WS_PART); const float* LSE = (const float*)(P->ws + WS_LSE);
    int lane_ = F.lane; asm volatile("" : "+v"(lane_));
    const int lane = lane_, r32 = lane & 31, hi = lane >> 5, w = F.wave;
    LAS unsigned char* img = F.lds + RING_OFF;
    LaneOff lo; lane_off(lo, r32, hi);
    {
        const int bk = sjob >> 5, j = 15 - ((sjob & 31) >> 1), hp = sjob & 1, b = bk >> 1, kvh = bk & 1;
        img_load(F, img, KM, (long)b * S + j * 256, kvh, VMT + (long)((b * 2 + kvh) * 64) * S, j * 256);
        asm volatile("s_waitcnt vmcnt(0)" ::: "memory"); __syncthreads();
        const int nsel = j < 3 ? j : 3;
#pragma unroll 1
        for (int k = 0; k < 2; ++k) {
            const int hg = 2 * hp + k, qs = (k & 1) ? 7 - w : w, qo = qs * 32, h = kvh * 4 + hg;
            const float sl2 = moba_sl2(h);
            const int t0 = j * 256 + qo, q = t0 + r32;
            const size_t row = (size_t)(b * S + q);
            bf16* qrow = QM + row * 512 + h * 64;
            bf16x8 qr[4]; loadq(qr, qrow + 8 * hi);
            St st; st.o0 = f32x16{}; st.o1 = f32x16{}; st.m = -INFINITY; st.l = 0.f;
            const int nfull = nofull ? 0 : (qo >> 6), kod = (qo & 32) ? qo - 32 : qo;
            bf16x8 kf[8]; read_k<false>(kf, img, lo, nfull ? 0 : kod, r32);
#pragma unroll 1
            for (int i = 0; i < nfull; ++i) tile_run<0, false, true, true>(st, qr, kf, img, lo, 64 * i, 64 * i - qo - r32, sl2, true, 0, hi, r32, (i + 1 < nfull) ? 64 * i + 64 : kod);
            if (qo & 32) tile_run<2, false, true, false>(st, qr, kf, img, lo, qo - 32, -32 - r32, sl2, true, 0, hi, r32, 0);
            else tile_run<2, true, true, false>(st, qr, kf, img, lo, qo, -r32, sl2, true, 0, hi, r32, 0);
            const float lt = st.l + __shfl_xor(st.l, 32);
            const float lse_own = st.m + __builtin_amdgcn_logf(lt), rl = __builtin_amdgcn_rcpf(lt);
            LAS unsigned char* stg = F.lds + RING_OFF + IMG_BYTES + w * 4736;
#pragma unroll
            for (int g = 0; g < 4; ++g) { u32x2 a2, c2;
                a2.x = cvtpk(st.o0[4 * g] * rl, st.o0[4 * g + 1] * rl); a2.y = cvtpk(st.o0[4 * g + 2] * rl, st.o0[4 * g + 3] * rl);
                c2.x = cvtpk(st.o1[4 * g] * rl, st.o1[4 * g + 1] * rl); c2.y = cvtpk(st.o1[4 * g + 2] * rl, st.o1[4 * g + 3] * rl);
                *(LAS u32x2*)(stg + r32 * 144 + (8 * g + 4 * hi) * 2) = a2; *(LAS u32x2*)(stg + r32 * 144 + (32 + 8 * g + 4 * hi) * 2) = c2; }
            if (hi == 0) *(LAS float*)(stg + 4608 + r32 * 4) = lse_own;
            LDS_WAIT(); asm volatile("" ::: "memory");
            if (nocomb) continue;
#pragma unroll 2
            for (int i = 0; i < 4; ++i) {
                const int rw = i * 8 + (lane >> 3), ch = lane & 7;
                const size_t grow = (size_t)(b * S + t0 + rw), sl0 = ((size_t)((b * 8 + h) * 3)) * S + t0 + rw;
                const u32x4 own = *(const LAS u32x4*)(stg + rw * 144 + ch * 16); const float lo_ = *(const LAS float*)(stg + 4608 + rw * 4);
                float ls[3]; u32x4 pr[3];
#pragma unroll
                for (int r = 0; r < 3; ++r) { ls[r] = -INFINITY; pr[r] = (u32x4){0u, 0u, 0u, 0u}; if (r < nsel) { ls[r] = LSE[sl0 + (size_t)r * S]; pr[r] = *(const u32x4*)(PART + (sl0 + (size_t)r * S) * 64 + ch * 8); } }
                float M = lo_;
#pragma unroll
                for (int r = 0; r < 3; ++r) M = fmaxf(M, ls[r]);
                const float w0 = __builtin_amdgcn_exp2f(lo_ - M); float W = w0;
                float acc8[8];
                acc8[0] = w0 * bf2f(own.x & 0xffffu); acc8[1] = w0 * bf2f(own.x >> 16); acc8[2] = w0 * bf2f(own.y & 0xffffu); acc8[3] = w0 * bf2f(own.y >> 16);
                acc8[4] = w0 * bf2f(own.z & 0xffffu); acc8[5] = w0 * bf2f(own.z >> 16); acc8[6] = w0 * bf2f(own.w & 0xffffu); acc8[7] = w0 * bf2f(own.w >> 16);
#pragma unroll
                for (int r = 0; r < 3; ++r) { const float wr_ = __builtin_amdgcn_exp2f(ls[r] - M); W += wr_;
                    acc8[0] += wr_ * bf2f(pr[r].x & 0xffffu); acc8[1] += wr_ * bf2f(pr[r].x >> 16); acc8[2] += wr_ * bf2f(pr[r].y & 0xffffu); acc8[3] += wr_ * bf2f(pr[r].y >> 16);
                    acc8[4] += wr_ * bf2f(pr[r].z & 0xffffu); acc8[5] += wr_ * bf2f(pr[r].z >> 16); acc8[6] += wr_ * bf2f(pr[r].w & 0xffffu); acc8[7] += wr_ * bf2f(pr[r].w >> 16); }
                const float rW = __builtin_amdgcn_rcpf(W);
                u32x4 o; o.x = cvtpk(acc8[0] * rW, acc8[1] * rW); o.y = cvtpk(acc8[2] * rW, acc8[3] * rW); o.z = cvtpk(acc8[4] * rW, acc8[5] * rW); o.w = cvtpk(acc8[6] * rW, acc8[7] * rW);
                *(u32x4*)(QM + grow * 512 + h * 64 + ch * 8) = o;
            }
            LDS_WAIT(); asm volatile("" ::: "memory");
        }
    }
}
}
#ifndef BENCH_HOT
#define BENCH_HOT 0
#endif
#ifndef BENCH_NOSTORE
#define BENCH_NOSTORE 0
#endif
#ifndef BENCH_SUB
#define BENCH_SUB 3
#endif
#ifndef ALIGN_ONE
#define ALIGN_ONE true
#endif
#ifndef ALIGN_BIG
#define ALIGN_BIG true
#endif
#ifndef BENCH_NOEPI
#define BENCH_NOEPI 0
#endif
#ifndef BENCH_AGLU
#define BENCH_AGLU 0
#endif
#ifndef BENCH_KGLU
#define BENCH_KGLU 0
#endif
#ifndef PH_MASK
#define PH_MASK 0xFFF
#endif
#define PH_ON(k) (((PH_MASK) >> (k)) & 1)
constexpr int NPH = 10, PH_FINAL = DEPTH * NPH, PH_TOTAL = PH_FINAL + 1;
struct Args { Ptrs P; int ph_lo, ph_hi, use_bar, sub; };
__global__ void __launch_bounds__(NWAVES * 64, 2) mk_fwd(Args args) {
    extern __shared__ __attribute__((aligned(16))) unsigned char lds[];
    Frame F;
    F.lds = (LAS unsigned char*)lds;
    F.tid = threadIdx.x; F.lane = F.tid & 63; F.wave = __builtin_amdgcn_readfirstlane(F.tid >> 6);
    F.G = gridDim.x; { const int bx = blockIdx.x; F.vcu = (F.G % 8 == 0) ? (bx % 8) * (F.G / 8) + bx / 8 : bx; }
    typedef const __attribute__((address_space(4))) Args* KArgs;
    const KArgs ka = (KArgs)__builtin_amdgcn_kernarg_segment_ptr();
    volatile LAS unsigned* MISC = (volatile LAS unsigned*)(F.lds + MISC_OFF);
    for (int u = F.tid; u < (LDS_BYTES - LDSCTL_OFF) / 4; u += NWAVES * 64) ((LAS unsigned*)(F.lds + LDSCTL_OFF))[u] = 0u;
    __syncthreads();
    XcdBarrier bar; bar.bar = (unsigned*)(ka->P.ws + WS_CTL) + CW_BAR; bar.x = 0; bar.st = nullptr;
    const int use_bar = ka->use_bar;
    if (use_bar) bar = xcd_barrier_post((unsigned*)(ka->P.ws + WS_CTL) + CW_BAR, MISC + 8);
    LAS unsigned char* ring = F.lds + RING_OFF;
    for (int ph = ka->ph_lo; ; ++ph) {
        { KArgs ka3 = ka; asm volatile("" : "+s"(ka3)); if (ph >= ka3->ph_hi) break; }
#if defined(BENCH_SET)
        const bool bench = ph >= PH_TOTAL; const int l = bench ? DEPTH - 1 : ph / NPH, k = bench ? (ph - PH_TOTAL) % NPH : ph % NPH;
        if (bench && !(((BENCH_SET) >> k) & 1)) continue;
#if defined(BENCH_EMPTY)
        if (bench) { if (ph + 1 < ka->ph_hi) xcd_barrier(bar); continue; }
#endif
        const int lc = bench ? DEPTH + (ph - PH_TOTAL) / NPH : l;
#else
        const bool bench = false; const int l = ph / NPH, k = ph % NPH; const int lc = l;
#endif
        KArgs ka2 = ka; asm volatile("" : "+s"(ka2)); KP P = &ka2->P;
        unsigned char* ws = ka2->P.ws;
        F.tid = threadIdx.x; asm volatile("" : "+v"(F.tid)); F.lane = F.tid & 63;
        int bx = (int)blockIdx.x; asm volatile("" : "+s"(bx));
        { int g_ = (int)gridDim.x, w_ = F.tid >> 6; asm volatile("" : "+s"(g_)); F.G = g_; F.vcu = (g_ % 8 == 0) ? (bx % 8) * (g_ / 8) + bx / 8 : bx; F.wave = __builtin_amdgcn_readfirstlane(w_); }
        if (ph == PH_FINAL && !bench) { if (PH_ON(10)) final_pass(F, P);
        }
        else if (k == 0 && PH_ON(0)) { conv_layer(F, P, l); ssm_mats(F, P, l); if (l == 0) xb_pass(F, P); __syncthreads(); }
        else if (k == 1 && PH_ON(1)) {
            pg8::SrcStd g{(const char*)(ws + WS_XN), (const char*)(ws + WS_WIN), DM, 0}; pg8::StaticOrder So; So.init(T, DIN, F.G, bx);
            pg8::Unit u0; So.next(0, u0); pg8::rinv_build((LAS float*)(F.lds + RINV_OFF), (const float*)(ws + WS_SSQ), u0.pm);
            pg8::EpiInProj E{ws, pg8::RinvTab{(const LAS float*)(F.lds + RINV_OFF)}, (bench && BENCH_NOEPI) ? 1 : 0};
            pg8::gemm_phase<pg8::EpiInProj, pg8::SrcStd, pg8::StaticOrder, ALIGN_BIG>(ring, g, So, E);
        }
        else if (k == 2 && PH_ON(2)) {
            if (ka2->sub & 1) { pg8::SrcSsm<false> g{(const char*)(ws + WS_U), nullptr, (const char*)(ws + WS_SEND)}; pg8::SsmOrder So{F.G, bx}; pg8::EpiSsmEnd E{(float*)(ws + WS_HEND)};
                pg8::gemm_phase<pg8::EpiSsmEnd, pg8::SrcSsm<false>, pg8::SsmOrder, ALIGN_ONE>(ring, g, So, E); }
            if (ka2->sub & 2) att::swa_select_phase(F, P, l, lc);
        }
        else if (k == 3 && PH_ON(3)) {
#ifndef NO_CARRY
            if ((bench ? BENCH_SUB : ka2->sub) & 1) ssm_carry(F, P, l);
#endif
#ifndef NO_MOBA
            if ((bench ? BENCH_SUB : ka2->sub) & 2) att::moba_gather(F, P, lc, bench && BENCH_NOSTORE);
#endif
        }
        else if (k == 4 && PH_ON(4)) {
            unsigned* done = (unsigned*)(ws + WS_CTL) + CW_DONE + lc;
            { pg8::SrcSsm<true> g{(const char*)(ws + WS_U), (const char*)(ws + WS_HINIT), (const char*)(ws + WS_SMAIN)}; pg8::SsmOrder So{F.G, bx}; pg8::EpiSsmMain E{(bf16*)(ws + WS_YS), ws};
              pg8::Unit u0; const bool mine = So.next(0, u0);
              pg8::gemm_phase<pg8::EpiSsmMain, pg8::SrcSsm<true>, pg8::SsmOrder, true>(ring, g, So, E);
              if (mine && F.tid == 0) {
                  __builtin_amdgcn_fence(__ATOMIC_RELEASE, "agent"); asm volatile("s_waitcnt vmcnt(0)" ::: "memory");
                  __hip_atomic_fetch_add(done, 1u, __ATOMIC_RELAXED, __HIP_MEMORY_SCOPE_AGENT); } }
            unsigned* qctr = (unsigned*)(ws + WS_CTL) + CW_OWNQ + lc;
            volatile LAS unsigned* jobw = (volatile LAS unsigned*)(F.lds + MISC_OFF + 64);
            int job;
            for (;;) {
                __syncthreads();
                if (F.tid == 0) *jobw = __hip_atomic_fetch_add(qctr, 1u, __ATOMIC_RELAXED, __HIP_MEMORY_SCOPE_AGENT);
                __syncthreads();
                job = (int)*jobw;
                if (job >= 256) break;
                att::own_subjob(F, P, job);
            }
            if (job < 512) {
                if (F.tid == 0) { unsigned sp = 0u; while (__hip_atomic_load(done, __ATOMIC_RELAXED, __HIP_MEMORY_SCOPE_AGENT) < 128u) { __builtin_amdgcn_s_sleep(2); if (++sp > (1u << 22)) break; }
                    __builtin_amdgcn_fence(__ATOMIC_ACQUIRE, "agent"); asm volatile("s_waitcnt vmcnt(0)" ::: "memory"); }
                __syncthreads();
            }
            while (job < 512) {
                { const int gj = job - 256;
                  pg8::SrcStd g{(const char*)(ws + WS_YS), (const char*)(ws + WS_WGLU), 512, 0}; pg8::OneUnit So{gj >> 2, gj & 3}; pg8::EpiGlu E{(bf16*)(ws + WS_A1), ws};
                  pg8::gemm_phase<pg8::EpiGlu, pg8::SrcStd, pg8::OneUnit, true>(ring, g, So, E); }
                __syncthreads();
                if (F.tid == 0) *jobw = __hip_atomic_fetch_add(qctr, 1u, __ATOMIC_RELAXED, __HIP_MEMORY_SCOPE_AGENT);
                __syncthreads();
                job = (int)*jobw;
            }
        }
        else if (k == 5 && PH_ON(5)) { }
        else if (k == 6 && PH_ON(6)) {
            pg8::SrcMerge g{(const char*)(ws + WS_QA), (const char*)(ws + WS_A1), (const char*)(ws + WS_QM), (const char*)(ws + WS_WMRG)}; pg8::StaticOrder So; So.init(T, DM, F.G, bx);
            pg8::EpiMerge E{(const bf16*)(ws + WS_GATES), (bf16*)(ws + WS_MIXED), ws};
            pg8::gemm_phase<pg8::EpiMerge, pg8::SrcMerge, pg8::StaticOrder, ALIGN_ONE>(ring, g, So, E);
        }
        else if ((k == 7 || k == 9) && PH_ON(7)) {
            const bool f2 = (k == 9);
            pg8::SrcStd g{(const char*)(ws + (f2 ? WS_H1 : WS_MIXED)), (const char*)(ws + (f2 ? WS_WFF2 : WS_WOUT)), f2 ? DFF : DM, (bench && BENCH_HOT) ? 1 : 0}; pg8::StaticOrder So; So.init(T, DM, F.G, bx); float* xd = bench ? (float*)(ws + WS_QA) : P->x;
            pg8::EpiResid E{(!bench && l == 0 && !f2) ? P->x_in : (const float*)xd, xd, (bf16*)(ws + (bench ? WS_KM : WS_XN)), (float*)(ws + WS_SSQ), ws};
            pg8::gemm_phase<pg8::EpiResid, pg8::SrcStd, pg8::StaticOrder, ALIGN_ONE>(ring, g, So, E);
        }
        else if (k == 8 && PH_ON(8)) {
            pg8::SrcStd g{(const char*)(ws + WS_XN), (const char*)(ws + WS_WFF1), DM, (bench && BENCH_HOT) ? 1 : 0}; pg8::StaticOrder So; So.init(T, DFF, F.G, bx);
            pg8::Unit u0; So.next(0, u0); pg8::rinv_build((LAS float*)(F.lds + RINV_OFF), (const float*)(ws + WS_SSQ), u0.pm);
            pg8::EpiFfn1 E{(bf16*)(ws + WS_H1), pg8::RinvTab{(const LAS float*)(F.lds + RINV_OFF)}, (bench && BENCH_NOEPI) ? 1 : 0, ws};
            pg8::gemm_phase<pg8::EpiFfn1, pg8::SrcStd, pg8::StaticOrder, ALIGN_BIG>(ring, g, So, E);
        }
        if (k == 5 && !bench) continue;
        { KArgs ka3 = ka; asm volatile("" : "+s"(ka3)); if (ph + 1 < ka3->ph_hi) { if (ka3->use_bar) xcd_barrier(bar); else __syncthreads(); } }
    }
}
extern "C" void kernel_launch(void* const* d_in, const int* in_sizes, int n_in, void* d_out, int out_size, void* d_ws, size_t ws_size, hipStream_t stream) {
    static int grid = 0;
    if (grid == 0) {
        if (n_in != 21 || out_size != T * DM || ws_size < WS_END) { fprintf(stderr, "kernel_launch: unexpected shapes (n_in %d out %d ws %zu)\n", n_in, out_size, ws_size); grid = -1; return; }
        int dev = 0, cus = 0;
        if (hipGetDevice(&dev) != hipSuccess || hipDeviceGetAttribute(&cus, hipDeviceAttributeMultiprocessorCount, dev) != hipSuccess) { grid = -1; return; }
        if (hipFuncSetAttribute((const void*)mk_fwd, hipFuncAttributeMaxDynamicSharedMemorySize, LDS_BYTES) != hipSuccess) { fprintf(stderr, "kernel_launch: hipFuncSetAttribute failed\n"); grid = -1; return; }
        int per_cu = 0;
        if (hipOccupancyMaxActiveBlocksPerMultiprocessor(&per_cu, (const void*)mk_fwd, NWAVES * 64, LDS_BYTES) != hipSuccess || per_cu < 1) { fprintf(stderr, "kernel_launch: occupancy query reports %d workgroups per CU\n", per_cu); (void)hipGetLastError(); }
        grid = cus;
        if (grid != 256) { fprintf(stderr, "kernel_launch: built for a 256-CU device (unit dealing assumes 256 workgroups); found %d CUs; nothing launched\n", cus); grid = -1; return; }
    }
    if (grid < 0) return;
    (void)hipMemsetAsync((char*)d_ws + WS_CTL, 0, CTL_ZERO_BYTES, stream);
    Args a{};
    const float** pp = (const float**)&a.P; for (int i = 0; i < 21; ++i) pp[i] = (const float*)d_in[i];
    a.P.x = (float*)d_out; a.P.ws = (unsigned char*)d_ws;
    #if defined(BENCH_SET)
    a.ph_lo = 0; a.ph_hi = PH_TOTAL + NPH * (BENCH_REPS);
#else
    a.ph_lo = 0; a.ph_hi = PH_TOTAL;
#endif
    a.use_bar = 1; a.sub = 3;
    hipLaunchKernelGGL(mk_fwd, dim3(grid), dim3(NWAVES * 64), LDS_BYTES, stream, a);
}
```

```cpp
#include <hip/hip_runtime.h>
#include <cstdio>
#include <cstdint>

constexpr int NB = 4, S = 4096, T = NB * S, DM = 1024, DEPTH = 4, DIN = 5120, DFF = 4096;
constexpr float LOG2E = 1.4426950408889634f;
constexpr float C2 = 0.125f * LOG2E;
constexpr float NORM_EPS = 1e-6f;
constexpr int SSM_L = 16;
constexpr int SSM_KM = SSM_L * 16 + 128;
constexpr int SSM_KE = SSM_L * 16;
constexpr int NCH = T / SSM_L;

constexpr size_t MiB = 1u << 20;
constexpr size_t WS_CTL = 0, CTL_ZERO_BYTES = 1 * MiB;
constexpr size_t WS_WIN = 1 * MiB, WS_WGLU = 11 * MiB, WS_WMRG = 12 * MiB, WS_WOUT = 15 * MiB, WS_WFF1 = 17 * MiB, WS_WFF2 = 25 * MiB;
constexpr size_t WS_SMAIN = 33 * MiB, WS_SEND = 39 * MiB, WS_KMP = 43 * MiB;
constexpr size_t WS_XN = 44 * MiB;
constexpr size_t WS_QA = 76 * MiB, WS_KA = 92 * MiB, WS_VAT = 96 * MiB, WS_U = 100 * MiB, WS_QM = 116 * MiB, WS_KM = 132 * MiB, WS_VMT = 136 * MiB, WS_GATES = 140 * MiB;
constexpr size_t WS_H1 = 76 * MiB;
constexpr size_t WS_LIST = 309 * MiB, WS_LSE = 317 * MiB;
constexpr size_t WS_YS = 284 * MiB;
constexpr size_t DO_PART = 16 * MiB;
constexpr size_t WS_A1 = 236 * MiB, WS_MIXED = 252 * MiB, WS_HEND = 284 * MiB, WS_HINIT = 300 * MiB, WS_SSQ = 308 * MiB, WS_END = 319 * MiB;

typedef unsigned short bf16;
typedef short bf16x8 __attribute__((ext_vector_type(8)));
typedef short s16x4 __attribute__((ext_vector_type(4)));
typedef float f32x4 __attribute__((ext_vector_type(4)));
typedef float f32x16 __attribute__((ext_vector_type(16)));
typedef unsigned u32x4 __attribute__((ext_vector_type(4)));
typedef unsigned u32x2 __attribute__((ext_vector_type(2)));

__host__ __device__ __forceinline__ unsigned f2bf(float f) { unsigned u = __builtin_bit_cast(unsigned, f); return (u + 0x7fffu + ((u >> 16) & 1u)) >> 16; }
__host__ __device__ __forceinline__ float bf2f(unsigned b) { return __builtin_bit_cast(float, b << 16); }
typedef float f32x2_t __attribute__((ext_vector_type(2))); typedef __bf16 bf16x2_t __attribute__((ext_vector_type(2)));
__device__ __forceinline__ unsigned cvtpk_s(float lo, float hi) { f32x2_t v = {lo, hi}; bf16x2_t b = __builtin_convertvector(v, bf16x2_t); return __builtin_bit_cast(unsigned, b); }
__device__ __forceinline__ unsigned pk2(float lo, float hi) { return f2bf(lo) | (f2bf(hi) << 16); }
__device__ __forceinline__ float rbf(float f) { return bf2f(f2bf(f)); }
__device__ __forceinline__ float sigmoid_fast(float x) { return __builtin_amdgcn_rcpf(1.f + __builtin_amdgcn_exp2f(-x * LOG2E)); }
__device__ __forceinline__ float gelu_tanh(float x) {
    const float c2 = 2.f * 0.7978845608028654f; const float t = c2 * (x + 0.044715f * x * x * x); return x * sigmoid_fast(t); }
__device__ __forceinline__ float wave_sum(float v) {
#pragma unroll
    for (int o = 1; o < 64; o <<= 1) v += __shfl_xor(v, o);
    return v;
}
__device__ __forceinline__ float wave_max(float v) {
#pragma unroll
    for (int o = 1; o < 64; o <<= 1) v = fmaxf(v, __shfl_xor(v, o));
    return v;
}

struct Ptrs {
    const float *x_in, *norm_mix, *w_in, *sinks, *lam_re, *lam_im, *log_step, *b_re, *b_im, *c_re, *c_im, *d_skip, *w_glu, *w_o_swa, *w_o_ssm, *w_o_moba, *w_out, *norm_ffn, *w_ff1, *w_ff2, *norm_final;
    float* x;
    unsigned char* ws;
};
typedef const __attribute__((address_space(4))) Ptrs* KP;
__device__ __forceinline__ void team_barrier(unsigned* tc, unsigned target);
namespace pg8 {
#define PG8_LAS __attribute__((address_space(3)))
constexpr int BM = 256, BK = 64, HALF = 128, HTB = HALF * BK * 2  , STAGE_BYTES = 8 * HTB, NXCD = 8, WGM = 8;

__host__ __device__ __forceinline__ int lds_byte(int r, int c) { const int st = (r >> 4) * 2 + (c >> 5), rr = r & 15, cc = c & 31, ob = rr * 64 + cc * 2; return st * 1024 + (ob ^ (((ob >> 9) & 1) << 5)); }
__host__ __device__ __forceinline__ void stage_rc(int b, int& R, int& C) { const int st = b / 1024, sb = b % 1024, swz = sb ^ (((sb >> 9) & 1) << 5); R = (st >> 1) * 16 + swz / 64; C = (st & 1) * 32 + (swz % 64) / 2; }
__host__ __device__ __forceinline__ int perm32(int rho) { const int n = rho >> 4, i = rho & 15; return 8 * (i >> 2) + 4 * n + (i & 3); }

struct Unit { int pm, pn; };

struct StaticOrder {
    int nM, nN, nwg, G, c;
    __host__ __device__ __forceinline__ void init(int M, int N, int G_, int c_) { nM = M / BM; nN = N / BM; nwg = nM * nN; G = G_; c = c_; }
    __host__ __device__ __forceinline__ bool next(int i, Unit& u) const {
        const long L = (long)i * G + c; if (L >= nwg) return false;
        int wgid = (int)L; { const int q = nwg / NXCD, r = nwg % NXCD, xcd = wgid % NXCD, off = wgid / NXCD; wgid = (xcd < r ? xcd * (q + 1) : r * (q + 1) + (xcd - r) * q) + off; }
        const int nig = WGM * nN, gid = wgid / nig, fm = gid * WGM, gsz = (nM - fm) < WGM ? (nM - fm) : WGM;
        u.pm = fm + ((wgid % nig) % gsz); u.pn = (wgid % nig) / gsz; return true;
    }
};
struct OneUnit { int pm, pn; __host__ __device__ __forceinline__ bool next(int i, Unit& u) const { if (i) return false; u.pm = pm; u.pn = pn; return true; } };
struct SsmOrder {
    int g, b; bool has;
    __host__ __device__ __forceinline__ bool next(int i, Unit& u) const { if (i || !has) return false; u.pn = g; u.pm = b; return true; }
};

struct SrcStd {
    static constexpr bool TWO_VAR = false;
    const char* A; const char* Bt; int K; int hot;
    __device__ __forceinline__ int nt() const { return K / BK; }
    __device__ __forceinline__ const char* a(const Unit& u, int kt, int h) const { return A + ((size_t)((hot ? 0 : u.pm) * BM + h * HALF) * K + (size_t)kt * BK) * 2; }
    __device__ __forceinline__ const char* b(const Unit& u, int kt, int h) const { return Bt + ((size_t)((hot ? 0 : u.pn) * BM + h * HALF) * K + (size_t)kt * BK) * 2; }
    __device__ __forceinline__ unsigned voffA(int R, int C, int) const { return (unsigned)(R * K + C) * 2u; }
    __device__ __forceinline__ unsigned voffB(int R, int C) const { return (unsigned)(R * K + C) * 2u; }
    __device__ __forceinline__ int avar(int) const { return 0; }
};
struct SrcMerge {
    static constexpr bool TWO_VAR = false;
    const char* A0; const char* A1; const char* A2; const char* Bt;
    __device__ __forceinline__ int nt() const { return 24; }
    __device__ __forceinline__ const char* a(const Unit& u, int kt, int h) const { const int sg = kt >> 3; const char* p = sg == 0 ? A0 : (sg == 1 ? A1 : A2); return p + ((size_t)(u.pm * BM + h * HALF) * 512 + (size_t)(kt & 7) * BK) * 2; }
    __device__ __forceinline__ const char* b(const Unit& u, int kt, int h) const { return Bt + ((size_t)(u.pn * BM + h * HALF) * 1536 + (size_t)kt * BK) * 2; }
    __device__ __forceinline__ unsigned voffA(int R, int C, int) const { return (unsigned)(R * 512 + C) * 2u; }
    __device__ __forceinline__ unsigned voffB(int R, int C) const { return (unsigned)(R * 1536 + C) * 2u; }
    __device__ __forceinline__ int avar(int) const { return 0; }
};
template <bool MAIN> struct SrcSsm {
    static constexpr bool TWO_VAR = MAIN; static constexpr int KTOT = MAIN ? SSM_KM : SSM_KE;
    const char* U; const char* HI; const char* Bt;
    __device__ __forceinline__ int nt() const { return KTOT / BK; }
    __device__ __forceinline__ const char* a(const Unit& u, int kt, int h) const {
        if (!MAIN || kt < 4) return U + ((size_t)(u.pn * NCH + u.pm * BM + h * HALF) * 256 + (size_t)kt * BK) * 2;
        return HI + ((size_t)(u.pn * NCH + u.pm * BM + h * HALF) * 128 + (size_t)(kt - 4) * BK) * 2; }
    __device__ __forceinline__ const char* b(const Unit& u, int kt, int h) const { return Bt + ((size_t)(u.pn * 256 + h * HALF) * KTOT + (size_t)kt * BK) * 2; }
    __device__ __forceinline__ unsigned voffA(int R, int C, int var) const { return var ? (unsigned)(R * 128 + C) * 2u : (unsigned)(R * 256 + C) * 2u; }
    __device__ __forceinline__ unsigned voffB(int R, int C) const { return (unsigned)(R * KTOT + C) * 2u; }
    __device__ __forceinline__ int avar(int kt) const { return (MAIN && kt >= 4) ? 1 : 0; }
};

typedef f32x4 Acc[2][2][4][2];
struct WsRes { __amdgpu_buffer_rsrc_t r; const unsigned char* base; };
#ifndef WT_MASK
#define WT_MASK 7
#endif
__device__ __forceinline__ WsRes ws_res(unsigned char* ws) { WsRes w; w.r = __builtin_amdgcn_make_buffer_rsrc(ws, 0, (int)0x7fffffff, 0x00020000); w.base = ws; return w; }
__device__ __forceinline__ unsigned ws_off(const WsRes& w, const void* p) { return (unsigned)((const unsigned char*)p - w.base); }
template <bool WT> __device__ __forceinline__ void wt16(const WsRes& w, unsigned off, u32x4 v) { if (WT) __builtin_amdgcn_raw_buffer_store_b128(v, w.r, off, 0, 16); else __builtin_amdgcn_raw_buffer_store_b128(v, w.r, off, 0, 0); }
template <bool WT> __device__ __forceinline__ void wt16f(__amdgpu_buffer_rsrc_t r, unsigned off, f32x4 v) { if (WT) __builtin_amdgcn_raw_buffer_store_b128(__builtin_bit_cast(u32x4, v), r, off, 0, 16); else __builtin_amdgcn_raw_buffer_store_b128(__builtin_bit_cast(u32x4, v), r, off, 0, 0); }
template <bool WT> __device__ __forceinline__ void wt8(const WsRes& w, unsigned off, u32x2 v) { if (WT) __builtin_amdgcn_raw_buffer_store_b64(v, w.r, off, 0, 16); else __builtin_amdgcn_raw_buffer_store_b64(v, w.r, off, 0, 0); }
__device__ __forceinline__ unsigned cvt_pk_bf16(float lo, float hi) { return cvtpk_s(lo, hi); }
__device__ __forceinline__ u32x4 pack8(f32x4 v0, f32x4 v1) { u32x4 w; w.x = cvt_pk_bf16(v0[0], v0[1]); w.y = cvt_pk_bf16(v0[2], v0[3]); w.z = cvt_pk_bf16(v1[0], v1[1]); w.w = cvt_pk_bf16(v1[2], v1[3]); return w; }
__device__ __forceinline__ f32x4 sig4(f32x4 v) { f32x4 o; o[0] = sigmoid_fast(v[0]); o[1] = sigmoid_fast(v[1]); o[2] = sigmoid_fast(v[2]); o[3] = sigmoid_fast(v[3]); return o; }
__device__ __forceinline__ f32x4 unpk_lo(u32x4 w) { f32x4 o; o[0] = bf2f(w.x & 0xffffu); o[1] = bf2f(w.x >> 16); o[2] = bf2f(w.y & 0xffffu); o[3] = bf2f(w.y >> 16); return o; }
__device__ __forceinline__ f32x4 unpk_hi(u32x4 w) { f32x4 o; o[0] = bf2f(w.z & 0xffffu); o[1] = bf2f(w.z >> 16); o[2] = bf2f(w.w & 0xffffu); o[3] = bf2f(w.w >> 16); return o; }
__device__ __forceinline__ f32x4 rcp4(f32x4 v) { f32x4 o; o[0] = __builtin_amdgcn_rcpf(v[0]); o[1] = __builtin_amdgcn_rcpf(v[1]); o[2] = __builtin_amdgcn_rcpf(v[2]); o[3] = __builtin_amdgcn_rcpf(v[3]); return o; }

struct RinvTab { const PG8_LAS float* tab; };
__device__ __forceinline__ void rinv_build(PG8_LAS float* tab, const float* SSQ, int pm0) {
    int t_ = threadIdx.x; asm volatile("" : "+v"(t_));
    if (t_ < 256) { const f32x4* sp = (const f32x4*)(SSQ + (size_t)(pm0 * BM + t_) * 16); const f32x4 s = (sp[0] + sp[1]) + (sp[2] + sp[3]); tab[t_] = rsqrtf(((s[0] + s[1]) + (s[2] + s[3])) * (1.f / DM) + NORM_EPS); }
    __syncthreads();
}
template <int MODE, bool WT = ((WT_MASK & 4) != 0)> __device__ __forceinline__ void st_half_bf16(const WsRes& W, const Acc& acc, int bj, bf16* base, int ldc, float sc, const PG8_LAS float* ri = nullptr  ) {
    unsigned p = ws_off(W, base);
#pragma unroll
    for (int ai = 0; ai < 2; ++ai) {
#pragma unroll
        for (int m = 0; m < 4; ++m) { f32x4 v0 = acc[ai][bj][m][0], v1 = acc[ai][bj][m][1];
            const float rs = ri ? ri[ai * HALF + m * 16] : 1.f;
            if (MODE == 0) { const float f = rs * sc; v0 = v0 * f; v1 = v1 * f; }
            else if (MODE == 1) { const float f = -LOG2E * rs;
#pragma unroll
                for (int e = 0; e < 4; ++e) { v0[e] = __builtin_amdgcn_rcpf(1.f + __builtin_amdgcn_exp2f(v0[e] * f)); v1[e] = __builtin_amdgcn_rcpf(1.f + __builtin_amdgcn_exp2f(v1[e] * f)); } }
            else if (ri) { v0 = v0 * rs; v1 = v1 * rs; }
            if (MODE == 0 || MODE == 1) { }
            else if (MODE == 2) { v0 = __builtin_elementwise_max(v0, (f32x4){0.f, 0.f, 0.f, 0.f}); v1 = __builtin_elementwise_max(v1, (f32x4){0.f, 0.f, 0.f, 0.f}); v0 = v0 * v0; v1 = v1 * v1; }
            else { v0[0] = gelu_tanh(v0[0]); v0[1] = gelu_tanh(v0[1]); v0[2] = gelu_tanh(v0[2]); v0[3] = gelu_tanh(v0[3]); v1[0] = gelu_tanh(v1[0]); v1[1] = gelu_tanh(v1[1]); v1[2] = gelu_tanh(v1[2]); v1[3] = gelu_tanh(v1[3]); }
            wt16<WT>(W, p, pack8(v0, v1)); asm volatile("" : "+v"(p)); p += 32u * (unsigned)ldc; }
        p += 2u * (unsigned)(HALF - 64) * (unsigned)ldc; }
}
__device__ __forceinline__ void st_half_vt(const Acc& acc, int bj, bf16* VT, int b, int sbase  , int wr, int wc, int fr, int fq, const PG8_LAS float* ri, PG8_LAS unsigned char* stg  ) {
    const int g4 = (fr >> 2) & 3, pf = ((g4 == 1 ? 2 : (g4 == 2 ? 1 : g4)) << 2) + (fr & 3);
    float rs[2][4];
#pragma unroll
    for (int ai = 0; ai < 2; ++ai)
#pragma unroll
        for (int m = 0; m < 4; ++m) rs[ai][m] = ri[ai * HALF + m * 16];
    const int lane = fr + 16 * fq;
    bf16* vbase = VT + ((size_t)(b * 2 + (wc >> 1)) * 64 + 32 * (wc & 1)) * S + sbase + 64 * wr;
#pragma unroll
    for (int n = 0; n < 2; ++n)
#pragma unroll
        for (int eh = 0; eh < 2; ++eh) {
#pragma unroll
            for (int ai = 0; ai < 2; ++ai)
#pragma unroll
                for (int m = 0; m < 4; ++m) { const unsigned w = cvt_pk_bf16(acc[ai][bj][m][n][2 * eh] * rs[ai][m], acc[ai][bj][m][n][2 * eh + 1] * rs[ai][m]);
                    PG8_LAS unsigned short* q = (PG8_LAS unsigned short*)(stg + (2 * fq) * 272 + (64 * ai + 16 * m + pf) * 2);
                    q[0] = (unsigned short)(w & 0xffffu); q[136] = (unsigned short)(w >> 16); }
            asm volatile("s_waitcnt lgkmcnt(0)" ::: "memory");
#pragma unroll
            for (int j = 0; j < 2; ++j) { const int c = lane + 64 * j, lr = c >> 4, k = c & 15;
                const u32x4 v = *(const PG8_LAS u32x4*)(stg + lr * 272 + k * 16);
                const int d = 8 * (lr >> 1) + 4 * n + 2 * eh + (lr & 1);
                *(u32x4*)(vbase + (size_t)d * S + 128 * (k >> 3) + 8 * (k & 7)) = v; }
            asm volatile("s_waitcnt lgkmcnt(0)" ::: "memory");
        }
}

struct EpiInProj {
    static constexpr bool PERM = true, AFTER_DRAIN = false, HAS_MID = false;
    __device__ __forceinline__ void pre(const Unit& u) const { rinv_build((PG8_LAS float*)RT.tab, (const float*)(ws + WS_SSQ), u.pm); }
    unsigned char* ws; RinvTab RT; int skip;
    __device__ __forceinline__ void operator()(const Acc& acc, const Unit& u, int wr, int wc, int fr, int fq) const {
        if (skip) return;
        const WsRes W = ws_res(ws);
        bf16 *QA = (bf16*)(ws + WS_QA), *KA = (bf16*)(ws + WS_KA), *VAT = (bf16*)(ws + WS_VAT), *U = (bf16*)(ws + WS_U), *QM = (bf16*)(ws + WS_QM), *KM = (bf16*)(ws + WS_KM), *VMT = (bf16*)(ws + WS_VMT), *GATES = (bf16*)(ws + WS_GATES); float* KMP = (float*)(ws + WS_KMP);
        const int row = u.pm * BM + wr * 64 + fr, cc = wc * 32 + 8 * fq;
        const PG8_LAS float* ri = RT.tab + wr * 64 + fr;
#pragma unroll
        for (int bj = 0; bj < 2; ++bj) {
            const int hc = u.pn * 2 + bj;
            if (hc < 4) st_half_bf16<0, ((WT_MASK & 32) != 0)>(W, acc, bj, QA + (size_t)row * 512 + hc * 128 + cc, 512, C2, ri);
            else if (hc == 4) st_half_bf16<0, ((WT_MASK & 32) != 0)>(W, acc, bj, KA + (size_t)row * 128 + cc, 128, 1.f, ri);
            else if (hc == 5) st_half_vt(acc, bj, VAT, (u.pm * BM) / S, (u.pm * BM) % S, wr, wc, fr, fq, ri, (PG8_LAS unsigned char*)RT.tab + 1024 + (wr * 4 + wc) * 2176);
            else if (hc < 10) { const int ucol = (hc - 6) * 128 + cc;
                st_half_bf16<0, ((WT_MASK & 32) != 0)>(W, acc, bj, U + ((size_t)(ucol >> 4) * NCH + ((u.pm * BM + wr * 64) >> 4)) * 256 + fr * 16 + (ucol & 15), 16, 1.f, ri); }
            else if (hc < 14) st_half_bf16<0, ((WT_MASK & 32) != 0)>(W, acc, bj, QM + (size_t)row * 512 + (hc - 10) * 128 + cc, 512, C2, ri);
            else if (hc == 14) {
                st_half_bf16<0, ((WT_MASK & 32) != 0)>(W, acc, bj, KM + (size_t)row * 128 + cc, 128, 1.f, ri);
                f32x4 c0 = {0.f, 0.f, 0.f, 0.f}, c1 = {0.f, 0.f, 0.f, 0.f};
#pragma unroll
                for (int ai = 0; ai < 2; ++ai)
#pragma unroll
                    for (int m = 0; m < 4; ++m) { const float rs = ri[ai * HALF + m * 16]; c0 += acc[ai][bj][m][0] * rs; c1 += acc[ai][bj][m][1] * rs; }
#pragma unroll
                for (int o = 1; o < 16; o <<= 1)
#pragma unroll
                    for (int e = 0; e < 4; ++e) { c0[e] += __shfl_xor(c0[e], o); c1[e] += __shfl_xor(c1[e], o); }
                if (fr == 0) { float* kp = KMP + (size_t)(wr * 64 + u.pm) * 128 + cc; *(f32x4*)kp = c0; *(f32x4*)(kp + 4) = c1; }
            }
            else if (hc == 15) st_half_vt(acc, bj, VMT, (u.pm * BM) / S, (u.pm * BM) % S, wr, wc, fr, fq, ri, (PG8_LAS unsigned char*)RT.tab + 1024 + (wr * 4 + wc) * 2176);
            else st_half_bf16<1, ((WT_MASK & 2) != 0)>(W, acc, bj, GATES + (size_t)row * 3072 + (hc - 16) * 128 + cc, 3072, 1.f, ri);
        }
    }
};
struct EpiFfn1 {
    static constexpr bool PERM = true, AFTER_DRAIN = false, HAS_MID = false;
    __device__ __forceinline__ void pre(const Unit& u) const { rinv_build((PG8_LAS float*)RT.tab, (const float*)(ws + WS_SSQ), u.pm); }
    bf16* H1; RinvTab RT; int skip; unsigned char* ws;
    __device__ __forceinline__ void operator()(const Acc& acc, const Unit& u, int wr, int wc, int fr, int fq) const {
        if (skip) return;
        const WsRes W = ws_res(ws);
        bf16* base = H1 + (size_t)(u.pm * BM + wr * 64 + fr) * DFF + u.pn * BM + wc * 32 + 8 * fq;
        const PG8_LAS float* ri = RT.tab + wr * 64 + fr;
        st_half_bf16<2, ((WT_MASK & 1) != 0)>(W, acc, 0, base, DFF, 1.f, ri); st_half_bf16<2, ((WT_MASK & 1) != 0)>(W, acc, 1, base + HALF, DFF, 1.f, ri);
    }
};
struct EpiGlu {
    static constexpr bool PERM = true, AFTER_DRAIN = false, HAS_MID = false;
    __device__ __forceinline__ void pre(const Unit& u) const { }
    bf16* A1; unsigned char* ws;
    __device__ __forceinline__ void operator()(const Acc& acc, const Unit& u, int wr, int wc, int fr, int fq) const {
        const WsRes W = ws_res(ws);
        bf16* base = A1 + (size_t)(u.pm * BM + wr * 64 + fr) * 512 + u.pn * 128 + wc * 32 + 8 * fq;
#pragma unroll
        for (int ai = 0; ai < 2; ++ai)
#pragma unroll
            for (int m = 0; m < 4; ++m) wt16<((WT_MASK & 4) != 0)>(W, ws_off(W, base + (size_t)(ai * HALF + m * 16) * 512), pack8(acc[ai][0][m][0] * sig4(acc[ai][1][m][0]), acc[ai][0][m][1] * sig4(acc[ai][1][m][1])));
    }
};
__device__ __forceinline__ void ld16_gate_pairs(u32x4 (&A)[16], unsigned voff, const void* base) {
    asm volatile(
            "s_nop 4\n\t"
            "global_load_dwordx4 %[a0], %[vo], %[sb] offset:0\n\t"
            "global_load_dwordx4 %[a1], %[vo], %[sb] offset:2048\n\t"
            "global_load_dwordx4 %[a2], %[vo], %[sb] offset:256\n\t"
            "global_load_dwordx4 %[a3], %[vo], %[sb] offset:2304\n\t"
            "v_add_u32 %[vo], 0x18000, %[vo]\n\t"
            "global_load_dwordx4 %[a4], %[vo], %[sb] offset:0\n\t"
            "global_load_dwordx4 %[a5], %[vo], %[sb] offset:2048\n\t"
            "global_load_dwordx4 %[a6], %[vo], %[sb] offset:256\n\t"
            "global_load_dwordx4 %[a7], %[vo], %[sb] offset:2304\n\t"
            "v_add_u32 %[vo], 0x18000, %[vo]\n\t"
            "global_load_dwordx4 %[a8], %[vo], %[sb] offset:0\n\t"
            "global_load_dwordx4 %[a9], %[vo], %[sb] offset:2048\n\t"
            "global_load_dwordx4 %[a10], %[vo], %[sb] offset:256\n\t"
            "global_load_dwordx4 %[a11], %[vo], %[sb] offset:2304\n\t"
            "v_add_u32 %[vo], 0x18000, %[vo]\n\t"
            "global_load_dwordx4 %[a12], %[vo], %[sb] offset:0\n\t"
            "global_load_dwordx4 %[a13], %[vo], %[sb] offset:2048\n\t"
            "global_load_dwordx4 %[a14], %[vo], %[sb] offset:256\n\t"
            "global_load_dwordx4 %[a15], %[vo], %[sb] offset:2304\n\t"
            "s_waitcnt vmcnt(0)"
            : [a0]"=&v"(A[0]), [a1]"=&v"(A[1]), [a2]"=&v"(A[2]), [a3]"=&v"(A[3]), [a4]"=&v"(A[4]), [a5]"=&v"(A[5]), [a6]"=&v"(A[6]), [a7]"=&v"(A[7]), [a8]"=&v"(A[8]), [a9]"=&v"(A[9]), [a10]"=&v"(A[10]), [a11]"=&v"(A[11]), [a12]"=&v"(A[12]), [a13]"=&v"(A[13]), [a14]"=&v"(A[14]), [a15]"=&v"(A[15]), [vo]"+v"(voff) : [sb]"s"(base) : "memory");
}
__device__ __forceinline__ void ld16_gate_tile(u32x4 (&A)[16], unsigned voff, const void* base) {
    asm volatile(
            "s_nop 4\n\t"
            "global_load_dwordx4 %[a0], %[vo], %[sb] offset:0\n\t"
            "global_load_dwordx4 %[a1], %[vo], %[sb] offset:256\n\t"
            "v_add_u32 %[vo], 0x18000, %[vo]\n\t"
            "global_load_dwordx4 %[a2], %[vo], %[sb] offset:0\n\t"
            "global_load_dwordx4 %[a3], %[vo], %[sb] offset:256\n\t"
            "v_add_u32 %[vo], 0x18000, %[vo]\n\t"
            "global_load_dwordx4 %[a4], %[vo], %[sb] offset:0\n\t"
            "global_load_dwordx4 %[a5], %[vo], %[sb] offset:256\n\t"
            "v_add_u32 %[vo], 0x18000, %[vo]\n\t"
            "global_load_dwordx4 %[a6], %[vo], %[sb] offset:0\n\t"
            "global_load_dwordx4 %[a7], %[vo], %[sb] offset:256\n\t"
            "v_add_u32 %[vo], 0x78000, %[vo]\n\t"
            "global_load_dwordx4 %[a8], %[vo], %[sb] offset:0\n\t"
            "global_load_dwordx4 %[a9], %[vo], %[sb] offset:256\n\t"
            "v_add_u32 %[vo], 0x18000, %[vo]\n\t"
            "global_load_dwordx4 %[a10], %[vo], %[sb] offset:0\n\t"
            "global_load_dwordx4 %[a11], %[vo], %[sb] offset:256\n\t"
            "v_add_u32 %[vo], 0x18000, %[vo]\n\t"
            "global_load_dwordx4 %[a12], %[vo], %[sb] offset:0\n\t"
            "global_load_dwordx4 %[a13], %[vo], %[sb] offset:256\n\t"
            "v_add_u32 %[vo], 0x18000, %[vo]\n\t"
            "global_load_dwordx4 %[a14], %[vo], %[sb] offset:0\n\t"
            "global_load_dwordx4 %[a15], %[vo], %[sb] offset:256\n\t"
            "s_waitcnt vmcnt(0)"
            : [a0]"=&v"(A[0]), [a1]"=&v"(A[1]), [a2]"=&v"(A[2]), [a3]"=&v"(A[3]), [a4]"=&v"(A[4]), [a5]"=&v"(A[5]), [a6]"=&v"(A[6]), [a7]"=&v"(A[7]), [a8]"=&v"(A[8]), [a9]"=&v"(A[9]), [a10]"=&v"(A[10]), [a11]"=&v"(A[11]), [a12]"=&v"(A[12]), [a13]"=&v"(A[13]), [a14]"=&v"(A[14]), [a15]"=&v"(A[15]), [vo]"+v"(voff) : [sb]"s"(base) : "memory");
}
__device__ __forceinline__ void ld8_xb(u32x4 (&A)[8], unsigned voff, const void* base) {
    asm volatile(
            "s_nop 4\n\t"
            "global_load_dwordx4 %[a0], %[vo], %[sb] offset:0\n\t"
            "global_load_dwordx4 %[a1], %[vo], %[sb] offset:256\n\t"
            "v_add_u32 %[vo], 0x8000, %[vo]\n\t"
            "global_load_dwordx4 %[a2], %[vo], %[sb] offset:0\n\t"
            "global_load_dwordx4 %[a3], %[vo], %[sb] offset:256\n\t"
            "v_add_u32 %[vo], 0x8000, %[vo]\n\t"
            "global_load_dwordx4 %[a4], %[vo], %[sb] offset:0\n\t"
            "global_load_dwordx4 %[a5], %[vo], %[sb] offset:256\n\t"
            "v_add_u32 %[vo], 0x8000, %[vo]\n\t"
            "global_load_dwordx4 %[a6], %[vo], %[sb] offset:0\n\t"
            "global_load_dwordx4 %[a7], %[vo], %[sb] offset:256\n\t"
            "s_waitcnt vmcnt(0)"
            : [a0]"=&v"(A[0]), [a1]"=&v"(A[1]), [a2]"=&v"(A[2]), [a3]"=&v"(A[3]), [a4]"=&v"(A[4]), [a5]"=&v"(A[5]), [a6]"=&v"(A[6]), [a7]"=&v"(A[7]), [vo]"+v"(voff) : [sb]"s"(base) : "memory");
}
__device__ __forceinline__ void ld16_xs(u32x4 (&A)[16], unsigned voff, const void* base) {
    asm volatile(
            "s_nop 4\n\t"
            "global_load_dwordx4 %[a0], %[vo], %[sb] offset:0\n\t"
            "global_load_dwordx4 %[a1], %[vo], %[sb] offset:16\n\t"
            "global_load_dwordx4 %[a2], %[vo], %[sb] offset:512\n\t"
            "global_load_dwordx4 %[a3], %[vo], %[sb] offset:528\n\t"
            "v_add_u32 %[vo], 0x10000, %[vo]\n\t"
            "global_load_dwordx4 %[a4], %[vo], %[sb] offset:0\n\t"
            "global_load_dwordx4 %[a5], %[vo], %[sb] offset:16\n\t"
            "global_load_dwordx4 %[a6], %[vo], %[sb] offset:512\n\t"
            "global_load_dwordx4 %[a7], %[vo], %[sb] offset:528\n\t"
            "v_add_u32 %[vo], 0x10000, %[vo]\n\t"
            "global_load_dwordx4 %[a8], %[vo], %[sb] offset:0\n\t"
            "global_load_dwordx4 %[a9], %[vo], %[sb] offset:16\n\t"
            "global_load_dwordx4 %[a10], %[vo], %[sb] offset:512\n\t"
            "global_load_dwordx4 %[a11], %[vo], %[sb] offset:528\n\t"
            "v_add_u32 %[vo], 0x10000, %[vo]\n\t"
            "global_load_dwordx4 %[a12], %[vo], %[sb] offset:0\n\t"
            "global_load_dwordx4 %[a13], %[vo], %[sb] offset:16\n\t"
            "global_load_dwordx4 %[a14], %[vo], %[sb] offset:512\n\t"
            "global_load_dwordx4 %[a15], %[vo], %[sb] offset:528\n\t"
            "s_waitcnt vmcnt(0)"
            : [a0]"=&v"(A[0]), [a1]"=&v"(A[1]), [a2]"=&v"(A[2]), [a3]"=&v"(A[3]), [a4]"=&v"(A[4]), [a5]"=&v"(A[5]), [a6]"=&v"(A[6]), [a7]"=&v"(A[7]), [a8]"=&v"(A[8]), [a9]"=&v"(A[9]), [a10]"=&v"(A[10]), [a11]"=&v"(A[11]), [a12]"=&v"(A[12]), [a13]"=&v"(A[13]), [a14]"=&v"(A[14]), [a15]"=&v"(A[15]), [vo]"+v"(voff) : [sb]"s"(base) : "memory");
}
struct EpiMerge {
    static constexpr bool PERM = true, AFTER_DRAIN = false, HAS_MID = true;
    __device__ __forceinline__ void pre(const Unit& u) const { }
    const bf16* GATES; bf16* MIXED; unsigned char* ws;
    __device__ __forceinline__ void mid(Acc& acc, const Unit& u, int t, int wr, int wc, int fr, int fq) const {
        if (t != 8 && t != 16) return;
        const unsigned vo = (unsigned)(((u.pm * BM + wr * 64 + fr) * 3072 + (t == 8 ? 0 : 1024) + u.pn * BM + wc * 32 + 8 * fq) * 2);
#pragma unroll
        for (int ai = 0; ai < 2; ++ai) { u32x4 G[16]; ld16_gate_pairs(G, vo + (unsigned)(ai * HALF * 3072 * 2), GATES);
#pragma unroll
            for (int m = 0; m < 4; ++m)
#pragma unroll
                for (int bj = 0; bj < 2; ++bj) { const u32x4 num = G[4 * m + 2 * bj], den = G[4 * m + 2 * bj + 1];
                    acc[ai][bj][m][0] = acc[ai][bj][m][0] * (unpk_lo(num) * rcp4(unpk_lo(den))); acc[ai][bj][m][1] = acc[ai][bj][m][1] * (unpk_hi(num) * rcp4(unpk_hi(den))); } }
    }
    __device__ __forceinline__ void operator()(const Acc& acc, const Unit& u, int wr, int wc, int fr, int fq) const {
        const WsRes W = ws_res(ws);
        const size_t ro = (size_t)(u.pm * BM + wr * 64 + fr); const int co = u.pn * BM + wc * 32 + 8 * fq;
        u32x4 G[16]; ld16_gate_tile(G, (unsigned)((ro * 3072 + 2048 + co) * 2), GATES);
#pragma unroll
        for (int ai = 0; ai < 2; ++ai)
#pragma unroll
            for (int m = 0; m < 4; ++m)
#pragma unroll
                for (int bj = 0; bj < 2; ++bj) { const size_t r = ro + ai * HALF + m * 16; const u32x4 g2 = G[8 * ai + 2 * m + bj];
                    wt16<((WT_MASK & 4) != 0)>(W, ws_off(W, MIXED + r * DM + co + bj * HALF), pack8(acc[ai][bj][m][0] * unpk_lo(g2), acc[ai][bj][m][1] * unpk_hi(g2))); }
    }
};
struct EpiResid {
    static constexpr bool PERM = true, AFTER_DRAIN = false, HAS_MID = false;
    __device__ __forceinline__ void pre(const Unit& u) const { }
    const float* XS; bf16* XB; float* SSQ; unsigned char* ws; float* OUT; const float* GAIN; unsigned* tc; PG8_LAS float* tab;
    __device__ __forceinline__ void operator()(const Acc& acc, const Unit& u, int wr, int wc, int fr, int fq) const {
        const WsRes W = ws_res(ws);
        const size_t row0 = (size_t)(u.pm * BM + wr * 64 + fr); const int col0 = u.pn * BM + wc * 32 + 8 * fq;
        if (OUT) {
#pragma unroll
            for (int ai = 0; ai < 2; ++ai) { u32x4 R8[8]; ld8_xb(R8, (unsigned)(((row0 + ai * HALF) * DM + col0) * 2), XB);
#pragma unroll
                for (int m = 0; m < 4; ++m) { const size_t r = row0 + ai * HALF + m * 16; float ss = 0.f;
#pragma unroll
                    for (int bj = 0; bj < 2; ++bj) { const u32x4 old = R8[2 * m + bj]; const f32x4 v0 = unpk_lo(old) + acc[ai][bj][m][0], v1 = unpk_hi(old) + acc[ai][bj][m][1];
                        ss += ((v0[0] * v0[0] + v0[1] * v0[1]) + (v0[2] * v0[2] + v0[3] * v0[3])) + ((v1[0] * v1[0] + v1[1] * v1[1]) + (v1[2] * v1[2] + v1[3] * v1[3])); }
                    ss += __shfl_xor(ss, 16); ss += __shfl_xor(ss, 32);
                    if (fq == 0) __builtin_amdgcn_raw_buffer_store_b32(__builtin_bit_cast(unsigned, ss), W.r, ws_off(W, SSQ + r * 16 + u.pn * 4 + wc), 0, 16); } }
            team_barrier(tc, 4u);
            rinv_build(tab, SSQ, u.pm);
            f32x4 g[2][2];
#pragma unroll
            for (int bj = 0; bj < 2; ++bj) { g[bj][0] = *(const f32x4*)(GAIN + col0 + bj * HALF); g[bj][1] = *(const f32x4*)(GAIN + col0 + bj * HALF + 4); }
#pragma unroll
            for (int ai = 0; ai < 2; ++ai) { u32x4 R8[8]; ld8_xb(R8, (unsigned)(((row0 + ai * HALF) * DM + col0) * 2), XB);
#pragma unroll
                for (int m = 0; m < 4; ++m) { const size_t r = row0 + ai * HALF + m * 16; const float ri = tab[wr * 64 + fr + ai * HALF + m * 16];
#pragma unroll
                    for (int bj = 0; bj < 2; ++bj) { const u32x4 old = R8[2 * m + bj]; float* op = OUT + r * DM + col0 + bj * HALF;
                        *(f32x4*)op = (unpk_lo(old) + acc[ai][bj][m][0]) * ri * g[bj][0]; *(f32x4*)(op + 4) = (unpk_hi(old) + acc[ai][bj][m][1]) * ri * g[bj][1]; } } }
            return;
        }
#pragma unroll
        for (int ai = 0; ai < 2; ++ai) {
            u32x4 R[16];
            const unsigned eo = (unsigned)((row0 + ai * HALF) * DM + col0);
            if (XS) ld16_xs(R, eo * 4u, XS);
            else { u32x4 R8[8]; ld8_xb(R8, eo * 2u, XB);
#pragma unroll
                for (int i = 0; i < 8; ++i) R[i] = R8[i]; }
#pragma unroll
            for (int m = 0; m < 4; ++m) { const size_t r = row0 + ai * HALF + m * 16; float ss = 0.f;
#pragma unroll
                for (int bj = 0; bj < 2; ++bj) { const size_t o_ = r * DM + col0 + bj * HALF;
                    f32x4 v0, v1;
                    if (XS) { v0 = __builtin_bit_cast(f32x4, R[4 * m + 2 * bj]); v1 = __builtin_bit_cast(f32x4, R[4 * m + 2 * bj + 1]); }
                    else { const u32x4 old = R[2 * m + bj]; v0 = unpk_lo(old); v1 = unpk_hi(old); }
                    v0 = v0 + acc[ai][bj][m][0]; v1 = v1 + acc[ai][bj][m][1];
                    ss += ((v0[0] * v0[0] + v0[1] * v0[1]) + (v0[2] * v0[2] + v0[3] * v0[3])) + ((v1[0] * v1[0] + v1[1] * v1[1]) + (v1[2] * v1[2] + v1[3] * v1[3]));
                    wt16<((WT_MASK & 4) != 0)>(W, ws_off(W, XB + o_), pack8(v0, v1)); }
                ss += __shfl_xor(ss, 16); ss += __shfl_xor(ss, 32);
                if (fq == 0) __builtin_amdgcn_raw_buffer_store_b32(__builtin_bit_cast(unsigned, ss), W.r, ws_off(W, SSQ + r * 16 + u.pn * 4 + wc), 0, 16); }
        }
    }
};
struct EpiSsmEnd {
    static constexpr bool PERM = false, AFTER_DRAIN = false, HAS_MID = false;
    __device__ __forceinline__ void pre(const Unit& u) const { }
    float* HEND; unsigned char* ws;
    __device__ __forceinline__ void operator()(const Acc& acc, const Unit& u, int wr, int wc, int fr, int fq) const {
        const WsRes W = ws_res(ws);
        float* base = HEND + ((size_t)u.pn * NCH + u.pm * BM + wr * 64 + fr) * 128 + wc * 32 + 4 * fq;
#pragma unroll
        for (int ai = 0; ai < 2; ++ai)
#pragma unroll
            for (int m = 0; m < 4; ++m)
#pragma unroll
                for (int n = 0; n < 2; ++n) wt16f<true>(W.r, ws_off(W, base + (size_t)(ai * HALF + m * 16) * 128 + n * 16), acc[ai][0][m][n]);
    }
};
struct EpiSsmMain {
    static constexpr bool PERM = true, AFTER_DRAIN = false, HAS_MID = false;
    __device__ __forceinline__ void pre(const Unit& u) const { }
    bf16* YS; unsigned char* ws;
    __device__ __forceinline__ void operator()(const Acc& acc, const Unit& u, int wr, int wc, int fr, int fq) const {
        const WsRes W = ws_res(ws);
        const int mrow = u.pm * BM + wr * 64 + fr;
#pragma unroll
        for (int bj = 0; bj < 2; ++bj) { const int s = 8 * bj + 2 * wc + (fq >> 1);
            bf16* base = YS + ((size_t)mrow * 16 + s) * 512 + u.pn * 16 + 8 * (fq & 1);
            st_half_bf16<3>(W, acc, bj, base, 16 * 512, 1.f); }
    }
};

template <class Epi, class Src, class Sched, bool ALIGN_EPI>
__device__ __forceinline__ void gemm_phase(PG8_LAS unsigned char* lds, const Src g, const Sched& S, const Epi& E) {
    int tid_ = threadIdx.x; asm volatile("" : "+v"(tid_));
    const int tid = tid_, wid = __builtin_amdgcn_readfirstlane(tid >> 6), lane = tid & 63, wr = wid >> 2, wc = wid & 3, fr = lane & 15, fq = lane >> 4;
    const int nt = g.nt();
    unsigned voffA[2], voffA2[2], voffB[2];
#pragma unroll
    for (int i = 0; i < 2; ++i) { int R, C; stage_rc(tid * 16 + i * 8192, R, C); const int Rb = Epi::PERM ? ((R & ~31) + perm32(R & 31)) : R;
        voffA[i] = g.voffA(R, C, 0); voffA2[i] = Src::TWO_VAR ? g.voffA(R, C, 1) : 0u; voffB[i] = g.voffB(Rb, C); }
    const unsigned ldsw = (unsigned)wid * 1024u;
    const int aoff = lds_byte(wr * 64 + fr, fq * 8), boff = lds_byte(wc * 32 + fr, fq * 8);
#define PG8_SA(b, h) (((b) * 2 + (h)) * HTB)
#define PG8_SB(b, h) ((4 + (b) * 2 + (h)) * HTB)
#define PG8_STAGE_B(bufoff, gbase) do { _Pragma("unroll") for (int _i = 0; _i < 2; ++_i) \
        __builtin_amdgcn_global_load_lds((const unsigned*)((const char*)(gbase) + voffB[_i]), (PG8_LAS unsigned*)(lds + (bufoff) + ldsw + _i * 8192), 16, 0, 0); } while (0)
#define PG8_STAGE_A(bufoff, gbase, kt) do { const bool _v = Src::TWO_VAR && g.avar(kt); _Pragma("unroll") for (int _i = 0; _i < 2; ++_i) { const unsigned _o = _v ? voffA2[_i] : voffA[_i]; \
        __builtin_amdgcn_global_load_lds((const unsigned*)((const char*)(gbase) + _o), (PG8_LAS unsigned*)(lds + (bufoff) + ldsw + _i * 8192), 16, 0, 0); } } while (0)
#define PG8_LDA(dst, b, h) do { _Pragma("unroll") for (int m = 0; m < 4; ++m) _Pragma("unroll") for (int k = 0; k < 2; ++k) dst[m][k] = *(const PG8_LAS bf16x8*)(lds + PG8_SA(b, h) + aoff + m * 2048 + k * 1024); } while (0)
#define PG8_LDB(dst, b, h) do { _Pragma("unroll") for (int n = 0; n < 2; ++n) _Pragma("unroll") for (int k = 0; k < 2; ++k) dst[n][k] = *(const PG8_LAS bf16x8*)(lds + PG8_SB(b, h) + boff + n * 2048 + k * 1024); } while (0)
#define PG8_MMA(ai, bj, At, Bt) do { __builtin_amdgcn_s_setprio(1); _Pragma("unroll") for (int m = 0; m < 4; ++m) _Pragma("unroll") for (int n = 0; n < 2; ++n) _Pragma("unroll") for (int k = 0; k < 2; ++k) \
        acc[ai][bj][m][n] = __builtin_amdgcn_mfma_f32_16x16x32_bf16(Bt[n][k], At[m][k], acc[ai][bj][m][n], 0, 0, 0); __builtin_amdgcn_s_setprio(0); } while (0)
#define PG8_WAIT_V(n) asm volatile("s_waitcnt vmcnt(" #n ")" ::: "memory")
#define PG8_WAIT_L(n) asm volatile("s_waitcnt lgkmcnt(" #n ")" ::: "memory")
#define PG8_BAR __builtin_amdgcn_s_barrier()
#define PG8_SCHED __builtin_amdgcn_sched_barrier(0)
    Unit cur, nxt; int ui = 0;
    if (!S.next(0, cur)) return;
    Acc acc;
#pragma unroll
    for (int a = 0; a < 2; ++a)
#pragma unroll
        for (int b = 0; b < 2; ++b)
#pragma unroll
            for (int m = 0; m < 4; ++m)
#pragma unroll
                for (int n = 0; n < 2; ++n) acc[a][b][m][n] = (f32x4){0.f, 0.f, 0.f, 0.f};
    bf16x8 At[4][2], B0[2][2], B1[2][2];
    PG8_STAGE_B(PG8_SB(0, 0), g.b(cur, 0, 0)); PG8_STAGE_B(PG8_SB(0, 1), g.b(cur, 0, 1)); PG8_STAGE_A(PG8_SA(0, 0), g.a(cur, 0, 0), 0); PG8_STAGE_A(PG8_SA(0, 1), g.a(cur, 0, 1), 0);
    E.pre(cur);
    if (wr == 1) PG8_BAR;
    PG8_WAIT_V(2); PG8_BAR;
    PG8_STAGE_B(PG8_SB(1, 0), g.b(cur, 1, 0)); PG8_STAGE_A(PG8_SA(1, 0), g.a(cur, 1, 0), 1); PG8_STAGE_B(PG8_SB(1, 1), g.b(cur, 1, 1));
    PG8_WAIT_V(6); PG8_BAR;
    for (;;) {
        const bool has_next = S.next(ui + 1, nxt);
        const Unit nu = has_next ? nxt : cur;
        for (int t = 0; t < nt; t += 2) {
            const bool last = (t == nt - 2);
            if constexpr (Epi::HAS_MID) E.mid(acc, cur, t, wr, wc, fr, fq);
            const Unit u2 = last ? nu : cur; const int k2 = last ? 0 : t + 2, k3 = k2 + 1;
            PG8_LDB(B0, 0, 0); PG8_LDB(B1, 0, 1); PG8_SCHED; PG8_LDA(At, 0, 0); PG8_STAGE_A(PG8_SA(1, 1), g.a(cur, t + 1, 1), t + 1);
            PG8_WAIT_V(8); PG8_WAIT_L(0); PG8_BAR; PG8_MMA(0, 0, At, B0); PG8_MMA(0, 1, At, B1); PG8_BAR; PG8_SCHED;
            PG8_LDA(At, 0, 1); PG8_STAGE_B(PG8_SB(0, 0), g.b(u2, k2, 0)); PG8_STAGE_B(PG8_SB(0, 1), g.b(u2, k2, 1)); PG8_STAGE_A(PG8_SA(0, 0), g.a(u2, k2, 0), k2);
            PG8_WAIT_V(8); PG8_WAIT_L(0); PG8_BAR; PG8_MMA(1, 0, At, B0); PG8_MMA(1, 1, At, B1); PG8_BAR; PG8_SCHED;
            PG8_LDB(B0, 1, 0); PG8_LDB(B1, 1, 1); PG8_SCHED; PG8_LDA(At, 1, 0); PG8_STAGE_A(PG8_SA(0, 1), g.a(u2, k2, 1), k2);
            PG8_WAIT_V(8); PG8_WAIT_L(0); PG8_BAR; PG8_MMA(0, 0, At, B0); PG8_MMA(0, 1, At, B1); PG8_BAR; PG8_SCHED;
            PG8_LDA(At, 1, 1); PG8_STAGE_B(PG8_SB(1, 0), g.b(u2, k3, 0)); PG8_STAGE_B(PG8_SB(1, 1), g.b(u2, k3, 1)); PG8_STAGE_A(PG8_SA(1, 0), g.a(u2, k3, 0), k3);
            PG8_WAIT_V(8); PG8_WAIT_L(0); PG8_BAR; PG8_MMA(1, 0, At, B0); PG8_MMA(1, 1, At, B1); PG8_BAR; PG8_SCHED;
        }
        if constexpr (ALIGN_EPI) { if (wr == 0) PG8_BAR; }
        { int fr_ = fr, fq_ = fq; asm volatile("" : "+v"(fr_), "+v"(fq_));
          E(acc, cur, wr, wc, fr_, fq_); }
        if (!has_next) break;
#pragma unroll
        for (int a = 0; a < 2; ++a)
#pragma unroll
            for (int b = 0; b < 2; ++b)
#pragma unroll
                for (int m = 0; m < 4; ++m)
#pragma unroll
                    for (int n = 0; n < 2; ++n) acc[a][b][m][n] = (f32x4){0.f, 0.f, 0.f, 0.f};
        cur = nxt; ++ui;
        if constexpr (ALIGN_EPI) { if (wr == 1) PG8_BAR; }
    }
    PG8_WAIT_V(0);
    if constexpr (!ALIGN_EPI) { if (wr == 0) PG8_BAR; }
    PG8_BAR;
#undef PG8_SA
#undef PG8_SB
#undef PG8_STAGE_A
#undef PG8_STAGE_B
#undef PG8_LDA
#undef PG8_LDB
#undef PG8_MMA
#undef PG8_WAIT_V
#undef PG8_WAIT_L
#undef PG8_BAR
#undef PG8_SCHED
}
}
constexpr int NWAVES = 8;
constexpr int RING_OFF = 0, RING_BYTES = 131072;
constexpr int LDSCTL_OFF = RING_BYTES, MISC_OFF = LDSCTL_OFF + 320, RINV_OFF = LDSCTL_OFF + 1024;
constexpr int GSTG_OFF = LDSCTL_OFF + 1024;
constexpr int LDS_BYTES = 153600;
constexpr int CW_TMO = 0, CW_CODE = 1, CW_BAR = 4096, CW_CNT = 16384, CW_OWNQ = 20480, CW_SWAQ = 20544, CW_DONE = 20608, CW_TEAM = 21504, CW_MDONE = 20800, CW_WDONE = 20816, CW_BBAR = 32768, CW_CDONE = 20832, CW_EDONE = 20848, CW_SDONE = 20864;

#define GAS __attribute__((address_space(1)))
#define LAS __attribute__((address_space(3)))
typedef GAS unsigned gu32;
#define RLX_AGENT __ATOMIC_RELAXED, __HIP_MEMORY_SCOPE_AGENT
#define LDS_WAIT() asm volatile("s_waitcnt lgkmcnt(0)" ::: "memory")
#define VM_WAIT() asm volatile("s_waitcnt vmcnt(0)" ::: "memory")

#define XB_TMO      128
#define XB_XCNT(j)  (256  + 64 * (j))
#define XB_XSUB(j)  (1280 + 64 * (j))
#define XB_XGEN(j)  (2304 + 64 * (j))
#define XB_TOP      3328
#define XB_TOPGEN   3392
#define XCD_BAR_WORDS 3456
#define XB_SPIN_CAP (1u << 20)
__device__ __forceinline__ unsigned xb_ld(unsigned* p)              { return __hip_atomic_load(p, __ATOMIC_RELAXED, __HIP_MEMORY_SCOPE_AGENT); }
__device__ __forceinline__ unsigned xb_add(unsigned* p, unsigned v) { return __hip_atomic_fetch_add(p, v, __ATOMIC_RELAXED, __HIP_MEMORY_SCOPE_AGENT); }
__device__ __forceinline__ unsigned xb_xcc_id() { return (unsigned)__builtin_amdgcn_s_getreg((3 << 11) | 20) & 0xFu; }
#ifndef XB_SLEEP
#define XB_SLEEP 0
#endif
#define XB_SPIN(cond, bar) do { unsigned _sp = 0; while (cond) { if (XB_SLEEP) __builtin_amdgcn_s_sleep(XB_SLEEP); \
    if ((++_sp & 255u) == 0u) { if (xb_ld(&(bar)[XB_TMO])) break; if (_sp > XB_SPIN_CAP) { atomicAdd(&(bar)[XB_TMO], 1u); break; } } } } while (0)
struct XcdBarrier { unsigned* bar; unsigned x; volatile LAS unsigned* st; unsigned total; };
__device__ __forceinline__ XcdBarrier xcd_barrier_post(unsigned* bar, volatile LAS unsigned* st, unsigned total) {
    XcdBarrier b; b.bar = bar; b.x = xb_xcc_id(); b.st = st; b.total = total;
    if (threadIdx.x == 0) (void)xb_add(&bar[XB_XCNT(b.x)], 1u);
    return b;
}
__device__ __forceinline__ void xcd_barrier_complete(unsigned* bar, unsigned x, unsigned& nloc, unsigned& nx, unsigned G) {
    unsigned sum, cnt, mine, sp = 0u;
    for (;;) {
        sum = 0u; cnt = 0u; mine = 0u;
        unsigned cv[16];
        { unsigned vo = (unsigned)(XB_XCNT(0) * 4);
          asm volatile(
            "s_nop 4\n\t"
            "global_load_dword %[a0], %[vo], %[sb] offset:0 sc1\n\tglobal_load_dword %[a1], %[vo], %[sb] offset:256 sc1\n\tglobal_load_dword %[a2], %[vo], %[sb] offset:512 sc1\n\tglobal_load_dword %[a3], %[vo], %[sb] offset:768 sc1\n\t"
            "global_load_dword %[a4], %[vo], %[sb] offset:1024 sc1\n\tglobal_load_dword %[a5], %[vo], %[sb] offset:1280 sc1\n\tglobal_load_dword %[a6], %[vo], %[sb] offset:1536 sc1\n\tglobal_load_dword %[a7], %[vo], %[sb] offset:1792 sc1\n\t"
            "global_load_dword %[a8], %[vo], %[sb] offset:2048 sc1\n\tglobal_load_dword %[a9], %[vo], %[sb] offset:2304 sc1\n\tglobal_load_dword %[a10], %[vo], %[sb] offset:2560 sc1\n\tglobal_load_dword %[a11], %[vo], %[sb] offset:2816 sc1\n\t"
            "global_load_dword %[a12], %[vo], %[sb] offset:3072 sc1\n\tglobal_load_dword %[a13], %[vo], %[sb] offset:3328 sc1\n\tglobal_load_dword %[a14], %[vo], %[sb] offset:3584 sc1\n\tglobal_load_dword %[a15], %[vo], %[sb] offset:3840 sc1\n\t"
            "s_waitcnt vmcnt(0)"
            : [a0]"=&v"(cv[0]), [a1]"=&v"(cv[1]), [a2]"=&v"(cv[2]), [a3]"=&v"(cv[3]), [a4]"=&v"(cv[4]), [a5]"=&v"(cv[5]), [a6]"=&v"(cv[6]), [a7]"=&v"(cv[7]), [a8]"=&v"(cv[8]), [a9]"=&v"(cv[9]), [a10]"=&v"(cv[10]), [a11]"=&v"(cv[11]),
              [a12]"=&v"(cv[12]), [a13]"=&v"(cv[13]), [a14]"=&v"(cv[14]), [a15]"=&v"(cv[15]) : [vo]"v"(vo), [sb]"s"(bar) : "memory"); }
#pragma unroll
        for (unsigned j = 0; j < 16; ++j) { const unsigned c = cv[j]; sum += c; cnt += (c > 0u) ? 1u : 0u; mine = (j == x) ? c : mine; }
        if (sum == G) break;
        __builtin_amdgcn_s_sleep(1);
        if ((++sp & 255u) == 0u) { if (xb_ld(&bar[XB_TMO])) break; if (sp > XB_SPIN_CAP) { atomicAdd(&bar[XB_TMO], 1u); break; } }
    }
    nloc = mine > 0u ? mine : 1u; nx = cnt > 0u ? cnt : 1u;
}
__device__ __forceinline__ void xcd_barrier(const XcdBarrier& b) {
    asm volatile("s_waitcnt vmcnt(0)" ::: "memory");
    __syncthreads();
    if (threadIdx.x == 0) {
        unsigned* bar = b.bar;
        __builtin_amdgcn_s_waitcnt(0);
        unsigned nloc = b.st[0], nx = b.st[1];
        if (nloc == 0u) { xcd_barrier_complete(bar, b.x, nloc, nx, b.total); b.st[0] = nloc; b.st[1] = nx; }
        const unsigned old = xb_add(&bar[XB_XSUB(b.x)], 1u);
        const unsigned gen = old / nloc;
        if (old + 1u == (gen + 1u) * nloc) {
            __builtin_amdgcn_fence(__ATOMIC_RELEASE, "agent");
            asm volatile("s_waitcnt vmcnt(0)" ::: "memory");
            const unsigned og = xb_add(&bar[XB_TOP], 1u);
            const unsigned tg = og / nx;
            if (og + 1u == (tg + 1u) * nx) xb_add(&bar[XB_TOPGEN], 1u);
            else XB_SPIN(xb_ld(&bar[XB_TOPGEN]) == tg, bar);
            xb_add(&bar[XB_XGEN(b.x)], 1u);
            __builtin_amdgcn_fence(__ATOMIC_ACQUIRE, "agent");
            asm volatile("s_waitcnt vmcnt(0)" ::: "memory");
        } else {
            XB_SPIN(xb_ld(&bar[XB_XGEN(b.x)]) == gen, bar);
            __builtin_amdgcn_fence(__ATOMIC_ACQUIRE, "agent");
            asm volatile("s_waitcnt vmcnt(0)" ::: "memory");
        }
    }
    __syncthreads();
}

__device__ __forceinline__ f32x4 unpk4_lo(u32x4 w) { f32x4 o; o[0] = bf2f(w.x & 0xffffu); o[1] = bf2f(w.x >> 16); o[2] = bf2f(w.y & 0xffffu); o[3] = bf2f(w.y >> 16); return o; }
__device__ __forceinline__ f32x4 unpk4_hi(u32x4 w) { f32x4 o; o[0] = bf2f(w.z & 0xffffu); o[1] = bf2f(w.z >> 16); o[2] = bf2f(w.w & 0xffffu); o[3] = bf2f(w.w >> 16); return o; }
__device__ __forceinline__ void team_barrier(unsigned* tc, unsigned target) {
    asm volatile("s_waitcnt vmcnt(0)" ::: "memory");
    __syncthreads();
    if (threadIdx.x == 0) {
        __builtin_amdgcn_s_waitcnt(0);
        (void)__hip_atomic_fetch_add(tc, 1u, __ATOMIC_RELAXED, __HIP_MEMORY_SCOPE_AGENT);
        unsigned sp = 0u;
        while (__hip_atomic_load(tc, __ATOMIC_RELAXED, __HIP_MEMORY_SCOPE_AGENT) < target) { if (++sp > (1u << 26)) break; }
        __builtin_amdgcn_fence(__ATOMIC_ACQUIRE, "agent");
        asm volatile("s_waitcnt vmcnt(0)" ::: "memory");
    }
    __syncthreads();
}
struct Frame {
    LAS unsigned char* lds;
    int tid, lane, wave, vcu, G;
};

struct ConvItem { const float* W; const float* gain; bf16* WT; int N, Kdst, k_off, k0, n0, drow0; };
__device__ __forceinline__ bool conv_decode(ConvItem& c, KP P, int l, int it) {
    constexpr int I_IN = 16 * 160, I_GLU = 8 * 32, I_MRG = 3 * 8 * 32, I_OUT = 16 * 32, I_F1 = 16 * 128, I_F2 = 64 * 32;
    constexpr int NITEMS = I_IN + I_GLU + I_MRG + I_OUT + I_F1 + I_F2;
    if (it >= NITEMS) return false;
    unsigned char* ws = P->ws; int r = it; c.gain = nullptr; c.k_off = 0;
    if (r < I_IN) { const int kb = r / 160, nb = r % 160; c.W = P->w_in + (size_t)l * DM * DIN; c.N = DIN; c.gain = P->norm_mix + l * DM; c.WT = (bf16*)(ws + WS_WIN); c.Kdst = DM; c.k0 = 64 * kb; c.n0 = 32 * nb; c.drow0 = 32 * nb; return true; } r -= I_IN;
    if (r < I_GLU) { const int kb = r / 32, nb = r % 32; const int n0 = 32 * nb, v = n0 & 511;
        c.W = P->w_glu + (size_t)l * 512 * 1024; c.N = 1024; c.WT = (bf16*)(ws + WS_WGLU); c.Kdst = 512; c.k0 = 64 * kb; c.n0 = n0; c.drow0 = (v >> 7) * 256 + (n0 >= 512 ? 128 : 0) + (v & 127); return true; } r -= I_GLU;
    if (r < I_MRG) { const int sg = r / 256, q = r % 256, kb = q / 32, nb = q % 32; c.W = (sg == 0 ? P->w_o_swa : (sg == 1 ? P->w_o_ssm : P->w_o_moba)) + (size_t)l * 512 * DM;
        c.N = DM; c.WT = (bf16*)(ws + WS_WMRG); c.Kdst = 1536; c.k_off = 512 * sg; c.k0 = 64 * kb; c.n0 = 32 * nb; c.drow0 = 32 * nb; return true; } r -= I_MRG;
    if (r < I_OUT) { const int kb = r / 32, nb = r % 32; c.W = P->w_out + (size_t)l * DM * DM; c.N = DM; c.WT = (bf16*)(ws + WS_WOUT); c.Kdst = DM; c.k0 = 64 * kb; c.n0 = 32 * nb; c.drow0 = 32 * nb; return true; } r -= I_OUT;
    if (r < I_F1) { const int kb = r / 128, nb = r % 128; c.W = P->w_ff1 + (size_t)l * DM * DFF; c.N = DFF; c.gain = P->norm_ffn + l * DM; c.WT = (l & 1) ? (bf16*)(ws + WS_WFF1) : (bf16*)((unsigned char*)P->x + 8 * MiB); c.Kdst = DM; c.k0 = 64 * kb; c.n0 = 32 * nb; c.drow0 = 32 * nb; return true; } r -= I_F1;
    { const int kb = r / 32, nb = r % 32; c.W = P->w_ff2 + (size_t)l * DFF * DM; c.N = DM; c.WT = (l & 1) ? (bf16*)(ws + WS_WFF2) : (bf16*)P->x; c.Kdst = DFF; c.k0 = 64 * kb; c.n0 = 32 * nb; c.drow0 = 32 * nb; return true; }
}
__device__ __forceinline__ void conv_loads(f32x4 (&wv)[8], float (&gv)[8], const ConvItem& c, int lane) {
#pragma unroll
    for (int i = 0; i < 8; ++i) wv[i] = *(const f32x4*)(c.W + (size_t)(c.k0 + 8 * i + (lane >> 3)) * c.N + c.n0 + 4 * (lane & 7));
#pragma unroll
    for (int i = 0; i < 8; ++i) gv[i] = c.gain ? c.gain[c.k0 + 8 * i + (lane >> 3)] : 1.f;
}
__device__ __forceinline__ void conv_store(const f32x4 (&wv)[8], const float (&gv)[8], const ConvItem& c, LAS float* scr, int lane) {
#pragma unroll
    for (int i = 0; i < 8; ++i) { const int kk = 8 * i + (lane >> 3); const float g = gv[i]; LAS float* sp = scr + kk * 33 + 4 * (lane & 7);
        sp[0] = wv[i][0] * g; sp[1] = wv[i][1] * g; sp[2] = wv[i][2] * g; sp[3] = wv[i][3] * g; }
    LDS_WAIT(); asm volatile("" ::: "memory");
    const int cc = lane & 7;
#pragma unroll
    for (int j = 0; j < 4; ++j) { const int n = (lane >> 3) + 8 * j; const LAS float* s = scr + (8 * cc) * 33 + n;
        u32x4 o; o.x = pk2(s[0 * 33], s[1 * 33]); o.y = pk2(s[2 * 33], s[3 * 33]); o.z = pk2(s[4 * 33], s[5 * 33]); o.w = pk2(s[6 * 33], s[7 * 33]);
        if ((WT_MASK & 8) != 0) { const __amdgpu_buffer_rsrc_t wr_ = __builtin_amdgcn_make_buffer_rsrc(c.WT, 0, 16 << 20, 0x00020000); __builtin_amdgcn_raw_buffer_store_b128(o, wr_, (unsigned)(((size_t)(c.drow0 + n) * c.Kdst + c.k_off + c.k0 + 8 * cc) * 2), 0, 16); }
        else *(GAS u32x4*)(c.WT + (size_t)(c.drow0 + n) * c.Kdst + c.k_off + c.k0 + 8 * cc) = o; }
    LDS_WAIT(); asm volatile("" ::: "memory");
}
__device__ __forceinline__ void conv_layer(const Frame& F, KP P, int l) {
    LAS float* scr = (LAS float*)(F.lds + RING_OFF + F.wave * 16384);
    const int gw = F.vcu * NWAVES + F.wave, NGW = F.G * NWAVES;
#pragma unroll 1
    for (int it = gw; ; it += 4 * NGW) {
        f32x4 w0[8], w1[8], w2[8], w3[8]; float g0[8], g1[8], g2[8], g3[8];
        bool h0, h1, h2, h3;
        { ConvItem c; h0 = conv_decode(c, P, l, it); if (h0) conv_loads(w0, g0, c, F.lane); }
        if (!h0) break;
        { ConvItem c; h1 = conv_decode(c, P, l, it + NGW); if (h1) conv_loads(w1, g1, c, F.lane); }
        { ConvItem c; h2 = conv_decode(c, P, l, it + 2 * NGW); if (h2) conv_loads(w2, g2, c, F.lane); }
        { ConvItem c; h3 = conv_decode(c, P, l, it + 3 * NGW); if (h3) conv_loads(w3, g3, c, F.lane); }
        { ConvItem c; conv_decode(c, P, l, it); asm volatile("" ::: "memory"); conv_store(w0, g0, c, scr, F.lane); }
        if (h1) { ConvItem c; conv_decode(c, P, l, it + NGW); asm volatile("" ::: "memory"); conv_store(w1, g1, c, scr, F.lane); }
        if (h2) { ConvItem c; conv_decode(c, P, l, it + 2 * NGW); asm volatile("" ::: "memory"); conv_store(w2, g2, c, scr, F.lane); }
        if (h3) { ConvItem c; conv_decode(c, P, l, it + 3 * NGW); asm volatile("" ::: "memory"); conv_store(w3, g3, c, scr, F.lane); }
    }
}
__device__ __forceinline__ void ssm_mats(const Frame& F, KP P, int l) {
    __syncthreads();
    LAS float* L = (LAS float*)(F.lds + RING_OFF);
    LAS float* apr = L;
    LAS float* api = L + 17 * 64;
    LAS float* bbr = L + 34 * 64;
    LAS float* bbi = bbr + 1024;
    LAS float* ccr = bbi + 1024;
    LAS float* cci = ccr + 1024;
    LAS float* ktab = cci + 1024;
    for (int wi = F.vcu; wi < 256; wi += F.G) {
        const int g = wi >> 3, part = wi & 7; const int tid = F.tid;
        if (tid < 64) { const int p = tid; const float lr = P->lam_re[l * 2048 + g * 64 + p], li = P->lam_im[l * 2048 + g * 64 + p], dt = expf(P->log_step[l * 32 + g]);
            const float mag = expf(lr * dt), are = mag * cosf(li * dt), aim = mag * sinf(li * dt);
            const float den = lr * lr + li * li, nr = are - 1.f, ni = aim, fre = (nr * lr + ni * li) / den, fim = (ni * lr - nr * li) / den;
            float pr = 1.f, pi = 0.f;
            for (int k = 0; k <= 16; ++k) { apr[k * 64 + p] = pr; api[k * 64 + p] = pi; const float t = pr * are - pi * aim; pi = pr * aim + pi * are; pr = t; }
            for (int h = 0; h < 16; ++h) { const float br = P->b_re[(size_t)l * 32768 + (g * 64 + p) * 16 + h], bi = P->b_im[(size_t)l * 32768 + (g * 64 + p) * 16 + h]; bbr[p * 16 + h] = fre * br - fim * bi; bbi[p * 16 + h] = fre * bi + fim * br; } }
        for (int e = tid; e < 1024; e += 512) { ccr[e] = P->c_re[(size_t)l * 32768 + g * 1024 + e]; cci[e] = P->c_im[(size_t)l * 32768 + g * 1024 + e]; }
        __syncthreads();
        for (int e = tid; e < 512; e += 512) { const int tau = e >> 5, i = 2 * part + ((e >> 4) & 1), j = e & 15; float acc = 0.f;
            for (int p = 0; p < 64; ++p) { const float cr = ccr[i * 64 + p], ci = cci[i * 64 + p], ar = apr[tau * 64 + p], ai = api[tau * 64 + p]; const float er = cr * ar - ci * ai, ei = cr * ai + ci * ar; acc += er * bbr[p * 16 + j] - ei * bbi[p * 16 + j]; }
            if (tau == 0 && i == j) acc += P->d_skip[l * 512 + g * 16 + i];
            ktab[tau * 256 + i * 16 + j] = acc; }
        __syncthreads();
        bf16* BM_ = (bf16*)(P->ws + WS_SMAIN) + (size_t)g * 256 * SSM_KM;
        for (int e = tid; e < 32 * SSM_KM / 2; e += 512) {
            const int rr = e / (SSM_KM / 2), k = (e % (SSM_KM / 2)) * 2, s = rr >> 1, i = 2 * part + (rr & 1), n = s * 16 + i; float v[2];
#pragma unroll
            for (int q = 0; q < 2; ++q) { const int kk = k + q;
                if (kk < 256) { const int sp = kk >> 4, j = kk & 15; v[q] = (sp <= s) ? ktab[(s - sp) * 256 + i * 16 + j] : 0.f; }
                else { const int p = (kk - 256) & 63; const float cr = ccr[i * 64 + p], ci = cci[i * 64 + p], ar = apr[(s + 1) * 64 + p], ai = api[(s + 1) * 64 + p]; v[q] = (kk < 320) ? (cr * ar - ci * ai) : -(cr * ai + ci * ar); } }
            *(GAS unsigned*)(BM_ + (size_t)n * SSM_KM + k) = pk2(v[0], v[1]); }
        bf16* BE_ = (bf16*)(P->ws + WS_SEND) + (size_t)g * 256 * SSM_KE;
        for (int e = tid; e < 32 * SSM_KE / 2; e += 512) {
            const int n = part * 32 + e / (SSM_KE / 2), k = (e % (SSM_KE / 2)) * 2; float v[2];
#pragma unroll
            for (int q = 0; q < 2; ++q) { const int kk = k + q, sp = kk >> 4, j = kk & 15, p = n & 63; const float ar = apr[(15 - sp) * 64 + p], ai = api[(15 - sp) * 64 + p], br = bbr[p * 16 + j], bi = bbi[p * 16 + j];
                v[q] = (n < 64) ? (ar * br - ai * bi) : ((n < 128) ? (ar * bi + ai * br) : 0.f); }
            *(GAS unsigned*)(BE_ + (size_t)n * SSM_KE + k) = pk2(v[0], v[1]); }
        __syncthreads();
    }
}
__device__ __forceinline__ void xb_pass(const Frame& F, KP P) {
    const int gw = F.vcu * NWAVES + F.wave, NGW = F.G * NWAVES;
    bf16* XB = (bf16*)(P->ws + WS_XN); float* SSQ = (float*)(P->ws + WS_SSQ);
    for (int m = gw; m < T; m += NGW) {
        const GAS f32x4* xr = (const GAS f32x4*)(P->x_in + (size_t)m * DM) + F.lane;
        f32x4 v[4]; float s = 0.f;
#pragma unroll
        for (int j = 0; j < 4; ++j) { v[j] = xr[64 * j]; s += (v[j].x * v[j].x + v[j].y * v[j].y) + (v[j].z * v[j].z + v[j].w * v[j].w); }
        s = wave_sum(s);
        GAS unsigned long long* o8 = (GAS unsigned long long*)(XB + (size_t)m * DM) + F.lane;
#pragma unroll
        for (int j = 0; j < 4; ++j) o8[64 * j] = (unsigned long long)pk2(v[j].x, v[j].y) | ((unsigned long long)pk2(v[j].z, v[j].w) << 32);
        if (F.lane < 16) SSQ[(size_t)m * 16 + F.lane] = (F.lane == 0) ? s : 0.f;
    }
}
__device__ __forceinline__ void final_pass(const Frame& F, KP P) {
    const int gw = F.vcu * NWAVES + F.wave, NGW = F.G * NWAVES;
    const bf16* XB = (const bf16*)(P->ws + WS_XN); const float* SSQ = (const float*)(P->ws + WS_SSQ);
    f32x4 g[4];
#pragma unroll
    for (int j = 0; j < 4; ++j) g[j] = ((const GAS f32x4*)P->norm_final)[2 * F.lane + (j & 1) + 128 * (j >> 1)];
    for (int m = gw; m < T; m += NGW) {
        const GAS u32x4* xr = (const GAS u32x4*)(XB + (size_t)m * DM) + F.lane;
        const u32x4 a = xr[0], c = xr[64];
        float s = (F.lane < 16) ? SSQ[(size_t)m * 16 + F.lane] : 0.f;
        const float r = rsqrtf(wave_sum(s) * (1.f / DM) + NORM_EPS);
        GAS f32x4* o = (GAS f32x4*)(P->x + (size_t)m * DM) + 2 * F.lane;
        o[0] = unpk4_lo(a) * r * g[0]; o[1] = unpk4_hi(a) * r * g[1]; o[128] = unpk4_lo(c) * r * g[2]; o[129] = unpk4_hi(c) * r * g[3];
    }
}
__device__ __forceinline__ void ssm_carry(const Frame& F, KP P, int l) {
    if (F.vcu & 15) return;
    const int per = F.G >> 3, bk = F.vcu / per, ci = (bk & 1) * 2 + ((F.vcu % per) >> 4);
    if (bk >= 8 || ci >= 4) return;
    const int p = F.tid & 63, b = bk >> 1, g = ci * 8 + (F.tid >> 6);
    const float lr = P->lam_re[l * 2048 + g * 64 + p], li = P->lam_im[l * 2048 + g * 64 + p], dt = expf(P->log_step[l * 32 + g]);
    const float mag = expf(lr * dt), are = mag * cosf(li * dt), aim = mag * sinf(li * dt);
    float pr = 1.f, pi = 0.f;
    for (int k = 0; k < 16; ++k) { const float t = pr * are - pi * aim; pi = pr * aim + pi * are; pr = t; }
    const float* he = (const float*)(P->ws + WS_HEND) + ((size_t)g * NCH + b * 256) * 128 + p;
    bf16* hi = (bf16*)(P->ws + WS_HINIT) + ((size_t)g * NCH + b * 256) * 128 + p;
    float sr = 0.f, si = 0.f;
    constexpr int CB = 32;
    float er[CB], ei[CB];
#pragma unroll
    for (int q = 0; q < CB; ++q) { er[q] = he[(size_t)q * 128]; ei[q] = he[(size_t)q * 128 + 64]; }
    for (int c0 = 0; c0 < 256; c0 += CB) {
        float nr_[CB], ni_[CB];
        const int cn = (c0 + CB < 256) ? c0 + CB : c0;
#pragma unroll
        for (int q = 0; q < CB; ++q) { nr_[q] = he[(size_t)(cn + q) * 128]; ni_[q] = he[(size_t)(cn + q) * 128 + 64]; }
#pragma unroll
        for (int q = 0; q < CB; ++q) { hi[(size_t)(c0 + q) * 128] = (bf16)f2bf(sr); hi[(size_t)(c0 + q) * 128 + 64] = (bf16)f2bf(si);
            const float tr = pr * sr - pi * si + er[q], ti = pr * si + pi * sr + ei[q]; sr = tr; si = ti; }
#pragma unroll
        for (int q = 0; q < CB; ++q) { er[q] = nr_[q]; ei[q] = ni_[q]; }
    }
}
namespace att {
__device__ __forceinline__ int crow(int r, int hi) { return (r & 3) + 8 * (r >> 2) + 4 * hi; }
struct St { f32x16 o0, o1; float m, l; };
__device__ __forceinline__ unsigned cvtpk(float lo, float hi) { return cvtpk_s(lo, hi); }

__device__ __forceinline__ void loadk(bf16x8 (&kf)[8], const bf16* kp) {
#pragma unroll
    for (int d0 = 0; d0 < 4; ++d0) { kf[2 * d0] = *(const bf16x8*)(kp + d0 * 16); kf[2 * d0 + 1] = *(const bf16x8*)(kp + 32 * 128 + d0 * 16); }
}
template <int MODE>
__device__ __forceinline__ void tile(St& st, const bf16x8 (&qr)[4], const bf16x8 (&kf)[8], const bf16* vtp  , int kq  , float sl2, bool rowok, int klo  , int hi) {
    f32x16 p0 = {}, p1 = {};
#pragma unroll
    for (int d0 = 0; d0 < 4; ++d0) { p0 = __builtin_amdgcn_mfma_f32_32x32x16_bf16(kf[2 * d0], qr[d0], p0, 0, 0, 0); p1 = __builtin_amdgcn_mfma_f32_32x32x16_bf16(kf[2 * d0 + 1], qr[d0], p1, 0, 0, 0); }
    s16x4 vl[2][4], vh[2][4];
#pragma unroll
    for (int dh = 0; dh < 2; ++dh)
#pragma unroll
        for (int s = 0; s < 4; ++s) { vl[dh][s] = *(const s16x4*)(vtp + (size_t)dh * 32 * S + 16 * s); vh[dh][s] = *(const s16x4*)(vtp + (size_t)dh * 32 * S + 16 * s + 8); }
    const float base = sl2 * (float)(kq + 4 * hi);
    float mx = -INFINITY;
#pragma unroll
    for (int r = 0; r < 16; ++r) { const int c = (r & 3) + 8 * (r >> 2); const int k0 = kq + 4 * hi + c, k1 = k0 + 32;
        float a = fmaf(sl2, (float)c, p0[r]), b = fmaf(sl2, (float)(c + 32), p1[r]);
        if (MODE == 1) { a = (k0 <= 0 && k0 >= klo) ? a : -INFINITY; b = (k1 <= 0 && k1 >= klo) ? b : -INFINITY; }
        else if (MODE == 2) { a = (k0 <= 0) ? a : -INFINITY; b = (k1 <= 0) ? b : -INFINITY; }
        else if (MODE == 3) { a = (rowok && k0 <= 0) ? a : -INFINITY; b = (rowok && k1 <= 0) ? b : -INFINITY; }
        p0[r] = a; p1[r] = b; mx = fmaxf(mx, fmaxf(a, b)); }
    mx += base;
    mx = fmaxf(mx, __shfl_xor(mx, 32));
    const float mn = fmaxf(st.m, mx), alpha = __builtin_amdgcn_exp2f(st.m - mn), off = base - mn;
    float sum = 0.f;
#pragma unroll
    for (int r = 0; r < 16; ++r) { p0[r] = __builtin_amdgcn_exp2f(p0[r] + off); p1[r] = __builtin_amdgcn_exp2f(p1[r] + off); sum += p0[r] + p1[r]; }
    st.m = mn; st.l = st.l * alpha + sum;
#pragma unroll
    for (int r = 0; r < 16; ++r) { st.o0[r] *= alpha; st.o1[r] *= alpha; }
    bf16x8 pf[4];
#pragma unroll
    for (int s = 0; s < 2; ++s) { u32x4 w0, w1;
        w0.x = cvtpk(p0[8 * s + 0], p0[8 * s + 1]); w0.y = cvtpk(p0[8 * s + 2], p0[8 * s + 3]); w0.z = cvtpk(p0[8 * s + 4], p0[8 * s + 5]); w0.w = cvtpk(p0[8 * s + 6], p0[8 * s + 7]);
        w1.x = cvtpk(p1[8 * s + 0], p1[8 * s + 1]); w1.y = cvtpk(p1[8 * s + 2], p1[8 * s + 3]); w1.z = cvtpk(p1[8 * s + 4], p1[8 * s + 5]); w1.w = cvtpk(p1[8 * s + 6], p1[8 * s + 7]);
        pf[s] = __builtin_bit_cast(bf16x8, w0); pf[2 + s] = __builtin_bit_cast(bf16x8, w1); }
#pragma unroll
    for (int s = 0; s < 4; ++s) {
        const bf16x8 v0 = (bf16x8){vl[0][s][0], vl[0][s][1], vl[0][s][2], vl[0][s][3], vh[0][s][0], vh[0][s][1], vh[0][s][2], vh[0][s][3]};
        const bf16x8 v1 = (bf16x8){vl[1][s][0], vl[1][s][1], vl[1][s][2], vl[1][s][3], vh[1][s][0], vh[1][s][1], vh[1][s][2], vh[1][s][3]};
        st.o0 = __builtin_amdgcn_mfma_f32_32x32x16_bf16(v0, pf[s], st.o0, 0, 0, 0);
        st.o1 = __builtin_amdgcn_mfma_f32_32x32x16_bf16(v1, pf[s], st.o1, 0, 0, 0); }
}
__device__ __forceinline__ void finish(const St& st, bf16* op, int hi) {
    const float lt = st.l + __shfl_xor(st.l, 32), rl = __builtin_amdgcn_rcpf(lt);
#pragma unroll
    for (int g = 0; g < 4; ++g) { u32x2 a, b;
        a.x = cvtpk(st.o0[4 * g] * rl, st.o0[4 * g + 1] * rl); a.y = cvtpk(st.o0[4 * g + 2] * rl, st.o0[4 * g + 3] * rl);
        b.x = cvtpk(st.o1[4 * g] * rl, st.o1[4 * g + 1] * rl); b.y = cvtpk(st.o1[4 * g + 2] * rl, st.o1[4 * g + 3] * rl);
        *(u32x2*)(op + 8 * g + 4 * hi) = a; *(u32x2*)(op + 32 + 8 * g + 4 * hi) = b; }
}
__device__ __forceinline__ void loadq(bf16x8 (&qr)[4], const bf16* qp) {
#pragma unroll
    for (int d0 = 0; d0 < 4; ++d0) qr[d0] = *(const bf16x8*)(qp + d0 * 16);
}

constexpr int IMG_K = 0, IMG_V = 32768, IMG_BYTES = 65536;
__device__ __forceinline__ void img_load(const Frame& F, LAS unsigned char* img, const bf16* K, long krow0, int kvh, const bf16* vt0, int key0) {
    const int lane = F.lane, w = F.wave;
#pragma unroll
    for (int i = 0; i < 4; ++i) { const int piece = w * 4 + i, key = piece * 8 + (lane >> 3), c = (lane & 7) ^ ((key >> 1) & 7); long row = krow0 + key; row = row < 0 ? 0 : row;
        __builtin_amdgcn_global_load_lds((const unsigned*)(K + row * 128 + kvh * 64 + c * 8), (LAS unsigned*)(img + IMG_K + piece * 1024), 16, 0, 0); }
#pragma unroll
    for (int i = 0; i < 4; ++i) { const int piece = w * 4 + i, d = piece * 2 + (lane >> 5), c = (lane & 31) ^ (d & 15); int kk = key0 + c * 8; kk = kk < 0 ? 0 : kk;
        __builtin_amdgcn_global_load_lds((const unsigned*)(vt0 + (long)d * S + kk), (LAS unsigned*)(img + IMG_V + piece * 1024), 16, 0, 0); }
}
struct LaneOff { int k[4]; int v[4]; };
__device__ __forceinline__ void lane_off(LaneOff& lo, int r32, int hi) { const int s7 = (r32 >> 1) & 7, x = r32 & 15;
#pragma unroll
    for (int d0 = 0; d0 < 4; ++d0) lo.k[d0] = ((2 * d0 + hi) ^ s7) << 4;
#pragma unroll
    for (int s = 0; s < 4; ++s) lo.v[s] = ((2 * s + hi) ^ (x & 7)) << 4; }
__device__ __forceinline__ float vmax3(float a, float b, float c) { float r; asm("v_max3_f32 %0, %1, %2, %3" : "=v"(r) : "v"(a), "v"(b), "v"(c)); return r; }
__device__ __forceinline__ float xhalf_max(float v) { float a = v, b = v; asm("s_nop 1\n\tv_permlane32_swap_b32 %0, %1" : "+v"(a), "+v"(b)); return fmaxf(a, b); }
__device__ __forceinline__ float xhalf_sum(float v) { float a = v, b = v; asm("s_nop 1\n\tv_permlane32_swap_b32 %0, %1" : "+v"(a), "+v"(b)); return a + b; }
__device__ __forceinline__ void stage_o(const St& st, float rl, LAS unsigned char* stg, int r32, int hi) {
#pragma unroll
    for (int g = 0; g < 4; ++g) { u32x2 a2, c2;
        a2.x = cvtpk(st.o0[4 * g] * rl, st.o0[4 * g + 1] * rl); a2.y = cvtpk(st.o0[4 * g + 2] * rl, st.o0[4 * g + 3] * rl);
        c2.x = cvtpk(st.o1[4 * g] * rl, st.o1[4 * g + 1] * rl); c2.y = cvtpk(st.o1[4 * g + 2] * rl, st.o1[4 * g + 3] * rl);
        *(LAS u32x2*)(stg + r32 * 144 + (8 * g + 4 * hi) * 2) = a2; *(LAS u32x2*)(stg + r32 * 144 + (32 + 8 * g + 4 * hi) * 2) = c2; }
}
template <bool HALF>
__device__ __forceinline__ void read_k(bf16x8 (&kf)[8], const LAS unsigned char* img, const LaneOff& lo, int ko, int r32) {
    const LAS unsigned char* kp = img + IMG_K + (ko + r32) * 128;
#pragma unroll
    for (int d0 = 0; d0 < 4; ++d0) { kf[2 * d0] = *(const LAS bf16x8*)(kp + lo.k[d0]); if (!HALF) kf[2 * d0 + 1] = *(const LAS bf16x8*)(kp + 32 * 128 + lo.k[d0]); }
}
template <int MODE, bool HALF, bool AL64, bool NEXTK>
__device__ __forceinline__ void tile_run(St& st, const bf16x8 (&qr)[4], bf16x8 (&kf)[8], const LAS unsigned char* img, const LaneOff& lo, int ko, int kq  , float sl2, bool rowok, int klo, int hi, int r32, int ko_next) {
    const bool fresh = st.m == -INFINITY; const float ref = fresh ? 0.f : st.m;
    const float cin = sl2 * (float)(kq + 4 * hi) - ref, cin1 = cin + 32.f * sl2;
    f32x16 p0, p1;
#pragma unroll
    for (int r = 0; r < 16; ++r) { const float c = (float)((r & 3) + 8 * (r >> 2)); p0[r] = fmaf(sl2, c, cin); p1[r] = fmaf(sl2, c, cin1); }
#pragma unroll
    for (int d0 = 0; d0 < 4; ++d0) {
        p0 = __builtin_amdgcn_mfma_f32_32x32x16_bf16(kf[2 * d0], qr[d0], p0, 0, 0, 0);
        if (!HALF) p1 = __builtin_amdgcn_mfma_f32_32x32x16_bf16(kf[2 * d0 + 1], qr[d0], p1, 0, 0, 0); }
    __builtin_amdgcn_sched_barrier(0);
    const int x = r32 & 15, kc = ko >> 3;
    const LAS unsigned char* vp = img + IMG_V + r32 * 512 + (AL64 ? ((kc ^ (x & 8)) << 4) : 0);
    constexpr int NS = HALF ? 2 : 4;
    bf16x8 va[NS], vb[NS];
#pragma unroll
    for (int s = 0; s < NS; ++s) { const int o = AL64 ? lo.v[s] : (((kc + 2 * s + hi) ^ x) << 4);
        va[s] = *(const LAS bf16x8*)(vp + o); vb[s] = *(const LAS bf16x8*)(vp + 32 * 512 + o); }
    if (NEXTK) read_k<false>(kf, img, lo, ko_next, r32);
    __builtin_amdgcn_sched_barrier(0);
    if (MODE != 0) {
#pragma unroll
        for (int r = 0; r < 16; ++r) { const int c = (r & 3) + 8 * (r >> 2); const int k0 = kq + 4 * hi + c, k1 = k0 + 32;
            float a = p0[r], b = HALF ? -INFINITY : p1[r];
            if (MODE == 1) { a = (k0 <= 0 && k0 >= klo) ? a : -INFINITY; if (!HALF) b = (k1 <= 0 && k1 >= klo) ? b : -INFINITY; }
            else if (MODE == 2) { a = (k0 <= 0) ? a : -INFINITY; if (!HALF) b = (k1 <= 0) ? b : -INFINITY; }
            else if (MODE == 3) { a = (rowok && k0 <= 0) ? a : -INFINITY; if (!HALF) b = (rowok && k1 <= 0) ? b : -INFINITY; }
            p0[r] = a; if (!HALF) p1[r] = b; }
    }
    float ma = fmaxf(p0[0], HALF ? p0[1] : p1[0]), mb = ma;
    if (HALF) {
#pragma unroll
        for (int r = 2; r < 14; r += 4) { ma = vmax3(ma, p0[r], p0[r + 1]); mb = vmax3(mb, p0[r + 2], p0[r + 3]); }
        ma = vmax3(ma, p0[14], p0[15]);
    } else {
#pragma unroll
        for (int r = 1; r < 15; r += 2) { ma = vmax3(ma, p0[r], p0[r + 1]); mb = vmax3(mb, p1[r], p1[r + 1]); }
        ma = vmax3(ma, p0[15], p1[15]);
    }
    const float mxh = fmaxf(ma, mb);
    if (__builtin_expect(__any(fresh || mxh > 8.f), 0)) {
        asm volatile("" ::: "memory");
        const float mx = xhalf_max(mxh);
        const float delta = fresh ? ((mx == -INFINITY) ? 0.f : mx) : ((mx > 8.f) ? mx : 0.f);
        const float alpha = fresh ? 1.f : __builtin_amdgcn_exp2f(-delta);
#pragma unroll
        for (int r = 0; r < 16; ++r) { p0[r] -= delta; if (!HALF) p1[r] -= delta; st.o0[r] *= alpha; st.o1[r] *= alpha; }
        st.l *= alpha;
        st.m = (fresh && mx == -INFINITY) ? -INFINITY : ref + delta;
    }
#pragma unroll
    for (int r = 0; r < 16; ++r) { p0[r] = __builtin_amdgcn_exp2f(p0[r]); if (!HALF) p1[r] = __builtin_amdgcn_exp2f(p1[r]); }
    { f32x2_t s2 = {0.f, 0.f};
#pragma unroll
      for (int r = 0; r < 16; r += 2) { s2 += (f32x2_t){p0[r], p0[r + 1]}; if (!HALF) s2 += (f32x2_t){p1[r], p1[r + 1]}; }
      st.l += s2[0] + s2[1]; }
#pragma unroll
    for (int s = 0; s < NS; ++s) {
        u32x4 w;
        if (s < 2) { w.x = cvtpk(p0[8 * s + 0], p0[8 * s + 1]); w.y = cvtpk(p0[8 * s + 2], p0[8 * s + 3]); w.z = cvtpk(p0[8 * s + 4], p0[8 * s + 5]); w.w = cvtpk(p0[8 * s + 6], p0[8 * s + 7]); }
        else { w.x = cvtpk(p1[8 * s - 16], p1[8 * s - 15]); w.y = cvtpk(p1[8 * s - 14], p1[8 * s - 13]); w.z = cvtpk(p1[8 * s - 12], p1[8 * s - 11]); w.w = cvtpk(p1[8 * s - 10], p1[8 * s - 9]); }
        const bf16x8 pf = __builtin_bit_cast(bf16x8, w);
        st.o0 = __builtin_amdgcn_mfma_f32_32x32x16_bf16(va[s], pf, st.o0, 0, 0, 0);
        st.o1 = __builtin_amdgcn_mfma_f32_32x32x16_bf16(vb[s], pf, st.o1, 0, 0, 0); }
}
template <int MODE, bool HALF, bool AL64>
__device__ __forceinline__ void tile_lds(St& st, const bf16x8 (&qr)[4], const LAS unsigned char* img, const LaneOff& lo, int ko, int kq  , float sl2, bool rowok, int klo, int hi, int r32) {
    bf16x8 kf[8];
    read_k<HALF>(kf, img, lo, ko, r32);
    __builtin_amdgcn_sched_barrier(0);
    tile_run<MODE, HALF, AL64, false>(st, qr, kf, img, lo, ko, kq, sl2, rowok, klo, hi, r32, 0);
}
__device__ __forceinline__ void swa_unit(const Frame& F, KP P, int l, int un) {
    bf16* QA = (bf16*)(P->ws + WS_QA); const bf16* KA = (const bf16*)(P->ws + WS_KA); const bf16* VAT = (const bf16*)(P->ws + WS_VAT);
    Frame F2 = F; asm volatile("" : "+v"(F2.lane));
    const int lane = F2.lane, r32 = lane & 31, hi = lane >> 5, w = F.wave;
    LAS unsigned char* img = F.lds + RING_OFF;
    LaneOff lo; lane_off(lo, r32, hi);
    {
        const int bk = un >> 5, nb = un & 31, b = bk >> 1, kvh = bk & 1, h = kvh * 4 + (w >> 1);
        __syncthreads();
        img_load(F2, img, KA, (long)b * S + nb * 128 - 128, kvh, VAT + (long)((b * 2 + kvh) * 64) * S, nb * 128 - 128);
        const float sl2 = exp2f(-0.5f * (float)(h + 1)) * LOG2E, sink2 = P->sinks[l * 8 + h] * LOG2E;
        bf16x8 qn[4]; loadq(qn, QA + (size_t)(b * S + nb * 128 + (w & 1) * 64 + r32) * 512 + h * 64 + 8 * hi);
        asm volatile("s_waitcnt vmcnt(0)" ::: "memory"); __syncthreads();
#pragma unroll 1
        for (int qt = 0; qt < 2; ++qt) {
            const int qo = (w & 1) * 64 + qt * 32, t0 = nb * 128 + qo, q = t0 + r32;
            bf16* qrow = QA + (size_t)(b * S + q) * 512 + h * 64;
            bf16x8 qr[4];
            if (qt == 0) {
#pragma unroll
                for (int i = 0; i < 4; ++i) qr[i] = qn[i];
            } else loadq(qr, qrow + 8 * hi);
            St st; st.o0 = f32x16{}; st.o1 = f32x16{}; st.m = sink2; st.l = hi ? 0.f : 1.f;
            const int klo = q < 127 ? -q : -127;
            bf16x8 kf[8]; read_k<false>(kf, img, lo, qo, r32);
#pragma unroll 1
            for (int kt = 0; kt < 2; ++kt) tile_run<1, false, false, true>(st, qr, kf, img, lo, qo + 64 * kt, t0 - 128 + 64 * kt - q, sl2, true, klo, hi, r32, qo + 64 * kt + 64);
            tile_run<1, true, false, false>(st, qr, kf, img, lo, qo + 128, t0 - q, sl2, true, klo, hi, r32, 0);
            { const float rl = __builtin_amdgcn_rcpf(xhalf_sum(st.l));
              LAS unsigned char* stg = F.lds + RING_OFF + IMG_BYTES + w * 4736;
              stage_o(st, rl, stg, r32, hi);
              LDS_WAIT(); asm volatile("" ::: "memory");
#pragma unroll
              for (int i = 0; i < 4; ++i) { const int rw = i * 8 + (lane >> 3), ch = lane & 7;
                  *(u32x4*)(QA + (size_t)(b * S + t0 + rw) * 512 + h * 64 + ch * 8) = *(const LAS u32x4*)(stg + rw * 144 + ch * 16); }
              LDS_WAIT(); asm volatile("" ::: "memory"); }
        }
    }
    __syncthreads();
}
__device__ __forceinline__ float moba_sl2(int h) { return exp2f(-0.5f * (float)(8 + h + 1)) * LOG2E; }
__device__ __forceinline__ void select_unit(const Frame& F, KP P, int l, int un) {
    const bf16* QM = (const bf16*)(P->ws + WS_QM); const float* KMP = (const float*)(P->ws + WS_KMP);
    const __amdgpu_buffer_rsrc_t lrs = __builtin_amdgcn_make_buffer_rsrc(P->ws, 0, (int)0x7fffffff, 0x00020000); unsigned* CNT = (unsigned*)(P->ws + WS_CTL) + CW_CNT + l * 128;
    LAS float* km = (LAS float*)(F.lds + RING_OFF);
    int tid_ = F.tid; asm volatile("" : "+v"(tid_));
    const int tid = tid_, lane = tid & 63;
    {
        const int bk = un & 7, ch = 31 - (un >> 3), b = bk >> 1, kvh = bk & 1, j = ch >> 1;
        if (j == 0) return;
        const int hg = tid >> 7, t = ch * 128 + (tid & 127);
        const bf16* qp = QM + (size_t)(b * S + t) * 512 + (kvh * 4 + hg) * 64;
        u32x4 qv[8];
#pragma unroll
        for (int i = 0; i < 8; ++i) qv[i] = *(const u32x4*)(qp + 8 * i);
        __syncthreads();
        for (int e = tid; e < 1024; e += 512) { const int n = e >> 6, d = e & 63; const float* k0 = KMP + (size_t)(b * 16 + n) * 128 + kvh * 64 + d; km[e] = k0[0] + k0[64 * 128]; }
        __syncthreads();
        int i0 = 0, i1 = 1, i2 = 2;
        if (j > 3) {
            float v0 = -INFINITY, v1 = -INFINITY, v2 = -INFINITY; i0 = 0; i1 = 0; i2 = 0;
#pragma unroll 1
            for (int n = 0; n < j; ++n) { float a = 0.f;
#pragma unroll
                for (int i = 0; i < 8; ++i) { const f32x4 x0 = *(const LAS f32x4*)(km + n * 64 + 8 * i), x1 = *(const LAS f32x4*)(km + n * 64 + 8 * i + 4);
                    a += bf2f(qv[i].x & 0xffffu) * x0[0] + bf2f(qv[i].x >> 16) * x0[1] + bf2f(qv[i].y & 0xffffu) * x0[2] + bf2f(qv[i].y >> 16) * x0[3]
                       + bf2f(qv[i].z & 0xffffu) * x1[0] + bf2f(qv[i].z >> 16) * x1[1] + bf2f(qv[i].w & 0xffffu) * x1[2] + bf2f(qv[i].w >> 16) * x1[3]; }
                if (a > v0) { v2 = v1; i2 = i1; v1 = v0; i1 = i0; v0 = a; i0 = n; } else if (a > v1) { v2 = v1; i2 = i1; v1 = a; i1 = n; } else if (a > v2) { v2 = a; i2 = n; } }
        }
        const int nsel = j < 3 ? j : 3;
        unsigned mycnt = 0u;
#pragma unroll 1
        for (int n = 0; n < j; ++n) { const bool sel = (n == i0 && nsel > 0) || (n == i1 && nsel > 1) || (n == i2 && nsel > 2); const unsigned long long mask = __ballot(sel); if (lane == n) mycnt = (unsigned)__popcll(mask); }
        unsigned mybase = 0u;
        if (lane < j && mycnt) mybase = __hip_atomic_fetch_add(CNT + bk * 16 + lane, mycnt, __ATOMIC_RELAXED, __HIP_MEMORY_SCOPE_AGENT);
#pragma unroll 1
        for (int n = 0; n < j; ++n) {
            const int r = (n == i0) ? 0 : ((n == i1) ? 1 : ((n == i2) ? 2 : 3));
            const bool sel = r < nsel;
            const unsigned long long mask = __ballot(sel);
            if (mask == 0ull) continue;
            const unsigned base = (unsigned)__shfl((int)mybase, n);
            const unsigned pos = base + (unsigned)__popcll(mask & ((1ull << lane) - 1ull));
            if (sel) __builtin_amdgcn_raw_buffer_store_b32(((unsigned)t << 4) | ((unsigned)hg << 2) | (unsigned)r, lrs, (unsigned)(WS_LIST + ((size_t)(bk * 16 + n) * 16384 + pos) * 4), 0, 16);
        }
    }
    __syncthreads();
}
__device__ __forceinline__ void swa_select_phase(const Frame& F, KP P, int l, int lq, int bb) {
    unsigned* qctr = (unsigned*)(P->ws + WS_CTL) + CW_SWAQ + lq * 4 + bb;
    volatile LAS unsigned* jobw = (volatile LAS unsigned*)(F.lds + MISC_OFF + 64);
    for (;;) {
        __syncthreads();
        if (F.tid == 0) *jobw = __hip_atomic_fetch_add(qctr, 1u, __ATOMIC_RELAXED, __HIP_MEMORY_SCOPE_AGENT);
        __syncthreads();
        const int job = (int)*jobw;
        if (job >= 128) break;
        if (job >= 64) swa_unit(F, P, l, 64 * bb + job - 64);
        else { select_unit(F, P, lq, (job >> 1) * 8 + 2 * bb + (job & 1));
            asm volatile("s_waitcnt vmcnt(0)" ::: "memory"); __syncthreads();
            if (F.tid == 0) __hip_atomic_fetch_add((unsigned*)(P->ws + WS_CTL) + CW_SDONE + lq * 8 + 2 * bb + (job & 1), 1u, __ATOMIC_RELAXED, __HIP_MEMORY_SCOPE_AGENT); }
    }
}
__device__ __forceinline__ void store_o(const St& st, bf16* op, float rl, int hi) {
#pragma unroll
    for (int g = 0; g < 4; ++g) { u32x2 a, b;
        a.x = cvtpk(st.o0[4 * g] * rl, st.o0[4 * g + 1] * rl); a.y = cvtpk(st.o0[4 * g + 2] * rl, st.o0[4 * g + 3] * rl);
        b.x = cvtpk(st.o1[4 * g] * rl, st.o1[4 * g + 1] * rl); b.y = cvtpk(st.o1[4 * g + 2] * rl, st.o1[4 * g + 3] * rl);
        *(u32x2*)(op + 8 * g + 4 * hi) = a; *(u32x2*)(op + 32 + 8 * g + 4 * hi) = b; }
}
__device__ __forceinline__ void moba_gather(const Frame& F, KP P, int l, bool nostore = false) {
    const bf16* QM = (const bf16*)(P->ws + WS_QM); const bf16* KM = (const bf16*)(P->ws + WS_KM); const bf16* VMT = (const bf16*)(P->ws + WS_VMT);
    const unsigned* LIST = (const unsigned*)(P->ws + WS_LIST); unsigned* CNT = (unsigned*)(P->ws + WS_CTL) + CW_CNT + l * 128;
    bf16* PART = (bf16*)((unsigned char*)P->x + DO_PART); float* LSE = (float*)(P->ws + WS_LSE);
    const int lane = F.lane, r32 = lane & 31, hi = lane >> 5, w = F.wave;
    const int per = F.G >> 3;
    const int bk = F.vcu / per, loc = F.vcu % per;
    if (bk >= 8 || (F.vcu & 15) == 0) return;
    const int wg = loc - 1 - (loc > 16 ? 1 : 0), nwg = per - 2;
    const int b = bk >> 1, kvh = bk & 1;
    unsigned cnt = 0u;
    if (lane < 16) cnt = __hip_atomic_load(CNT + bk * 16 + lane, __ATOMIC_RELAXED, __HIP_MEMORY_SCOPE_AGENT);
    const int ns_l = (int)((cnt + 255u) >> 8);
    int pre = ns_l;
#pragma unroll
    for (int o = 1; o < 16; o <<= 1) { const int v = __shfl_up(pre, o); if (lane >= o) pre += v; }
    const int total = __shfl(pre, 15);
    const bf16* vt0 = VMT + (long)((b * 2 + kvh) * 64) * S;
    LAS unsigned char* ring = F.lds + RING_OFF;
    LaneOff lo; lane_off(lo, r32, hi);
    __syncthreads();
#define GA_LOCATE(it, n_, s_) do { const unsigned long long le_ = __ballot(lane < 16 && pre <= (it)); n_ = (int)__popcll(le_); s_ = (it) - ((n_ == 0) ? 0 : __shfl(pre, n_ - 1)); } while (0)
#define GA_ENTRY(e_, n_, s_) do { const int cn_ = (int)__shfl((int)cnt, n_), ti_ = (s_) * 8 + w, idx_ = ti_ * 32 + r32; e_ = 0u; if (ti_ * 32 < cn_) e_ = LIST[(size_t)(bk * 16 + n_) * 16384 + (idx_ < cn_ ? idx_ : ti_ * 32)]; } while (0)
#define GA_LOADQ(q_, e_) loadq(q_, QM + ((size_t)(b * S + (int)((e_) >> 4))) * 512 + (kvh * 4 + (int)(((e_) >> 2) & 3u)) * 64 + 8 * hi)
    int item = (total * wg) / nwg; const int item_end = (total * (wg + 1)) / nwg;
    if (item < item_end) {
        int n0, s0, n1 = 0, s1 = 0, n2 = 0, s2 = 0; unsigned e0, e1 = 0u, e2 = 0u;
        GA_LOCATE(item, n0, s0); GA_ENTRY(e0, n0, s0);
        bool has1 = item + 1 < item_end; if (has1) { GA_LOCATE(item + 1, n1, s1); GA_ENTRY(e1, n1, s1); }
        bool newimg = true;
        img_load(F, ring, KM, (long)b * S + n0 * 256, kvh, vt0, n0 * 256);
        bf16x8 qn[4]; GA_LOADQ(qn, e0);
        int buf = 0;
        asm volatile("s_waitcnt vmcnt(0)" ::: "memory");
        bf16x8 qr[4];
#pragma unroll
        for (int i = 0; i < 4; ++i) qr[i] = qn[i];
#pragma unroll 1
        for (;;) {
            if (newimg) { LDS_WAIT(); __builtin_amdgcn_s_barrier(); }
            asm volatile("" ::: "memory");
            const LAS unsigned char* img = ring + buf * IMG_BYTES;
            const bool has2 = item + 2 < item_end, newimg1 = has1 && n1 != n0;
            auto issue_next = [&]() {
                if (has1) { Frame F2 = F; asm volatile("" : "+v"(F2.lane));
                    if (newimg1) img_load(F2, ring + (buf ^ 1) * IMG_BYTES, KM, (long)b * S + n1 * 256, kvh, vt0, n1 * 256);
                    GA_LOADQ(qn, e1); }
                if (has2) { GA_LOCATE(item + 2, n2, s2); GA_ENTRY(e2, n2, s2); } };
            const int cn = (int)__shfl((int)cnt, n0), ti = s0 * 8 + w; const bool tile_ok = ti * 32 < cn, valid = ti * 32 + r32 < cn;
            const int t = (int)(e0 >> 4), hg = (int)((e0 >> 2) & 3u), r = (int)(e0 & 3u), h = kvh * 4 + hg;
            St st; st.o0 = f32x16{}; st.o1 = f32x16{}; st.m = -INFINITY; st.l = 0.f;
            if (tile_ok) {
                const float sl2 = moba_sl2(h);
                const int kq = n0 * 256 - t, istage = w >> 2;
                bf16x8 kf[8]; read_k<false>(kf, img, lo, 0, r32);
#pragma unroll 1
                for (int i = 0; i < 3; ++i) { if (i == istage) issue_next();
                    tile_run<0, false, true, true>(st, qr, kf, img, lo, 64 * i, kq + 64 * i, sl2, true, 0, hi, r32, 64 * i + 64); }
                tile_run<0, false, true, false>(st, qr, kf, img, lo, 192, kq + 192, sl2, true, 0, hi, r32, 0);
            } else issue_next();
            asm volatile("s_waitcnt vmcnt(0)" ::: "memory");
#pragma unroll
            for (int i = 0; i < 4; ++i) { qr[i] = qn[i]; asm volatile("" : "+v"(qr[i])); }
            asm volatile("" : "+v"(e2));
            if (tile_ok && !nostore) {
                const float lt = xhalf_sum(st.l), rl = __builtin_amdgcn_rcpf(lt);
                const unsigned slot = (unsigned)(((b * 8 + h) * 3 + r) * S + t);
                if (valid && hi == 0) LSE[slot] = st.m + __builtin_amdgcn_logf(lt);
                LAS unsigned char* stg = F.lds + GSTG_OFF + w * 2560;
                const unsigned sl_ = valid ? slot : 0xffffffffu;
                const unsigned sr0 = (unsigned)__shfl((int)sl_, lane >> 2), sr1 = (unsigned)__shfl((int)sl_, 16 + (lane >> 2));
#pragma unroll
                for (int half = 0; half < 2; ++half) {
#pragma unroll
                    for (int g = 0; g < 4; ++g) { u32x2 a2;
                        if (half == 0) { a2.x = cvtpk(st.o0[4 * g] * rl, st.o0[4 * g + 1] * rl); a2.y = cvtpk(st.o0[4 * g + 2] * rl, st.o0[4 * g + 3] * rl); }
                        else { a2.x = cvtpk(st.o1[4 * g] * rl, st.o1[4 * g + 1] * rl); a2.y = cvtpk(st.o1[4 * g + 2] * rl, st.o1[4 * g + 3] * rl); }
                        *(LAS u32x2*)(stg + r32 * 80 + 16 * g + 8 * hi) = a2; }
                    LDS_WAIT(); asm volatile("" ::: "memory");
                    const u32x4 v0 = *(const LAS u32x4*)(stg + (lane >> 2) * 80 + (lane & 3) * 16), v1 = *(const LAS u32x4*)(stg + (16 + (lane >> 2)) * 80 + (lane & 3) * 16);
                    if (sr0 != 0xffffffffu) *(u32x4*)(PART + (size_t)sr0 * 64 + half * 32 + (lane & 3) * 8) = v0;
                    if (sr1 != 0xffffffffu) *(u32x4*)(PART + (size_t)sr1 * 64 + half * 32 + (lane & 3) * 8) = v1;
                    LDS_WAIT(); asm volatile("" ::: "memory"); }
            }
            if (!has1) break;
            item += 1; n0 = n1; s0 = s1; e0 = e1; n1 = n2; s1 = s2; e1 = e2; has1 = has2; newimg = newimg1; if (newimg1) buf ^= 1;
        }
    }
#undef GA_LOCATE
#undef GA_ENTRY
#undef GA_LOADQ
    asm volatile("s_waitcnt vmcnt(0)" ::: "memory"); __syncthreads();
}
__device__ __forceinline__ void own_subjob(const Frame& F, KP P, int sjob, bool nofull = false, bool nocomb = false) {
    bf16* QM = (bf16*)(P->ws + WS_QM); const bf16* KM = (const bf16*)(P->ws + WS_KM); const bf16* VMT = (const bf16*)(P->ws + WS_VMT);
    const bf16* PART = (const bf16*)((const unsigned char*)P->x + DO_PART); const float* LSE = (const float*)(P->ws + WS_LSE);
    int lane_ = F.lane; asm volatile("" : "+v"(lane_));
    const int lane = lane_, r32 = lane & 31, hi = lane >> 5, w = F.wave;
    LAS unsigned char* img = F.lds + RING_OFF;
    LaneOff lo; lane_off(lo, r32, hi);
    {
        const int bk = sjob >> 5, j = 15 - ((sjob & 31) >> 1), hp = sjob & 1, b = bk >> 1, kvh = bk & 1;
        img_load(F, img, KM, (long)b * S + j * 256, kvh, VMT + (long)((b * 2 + kvh) * 64) * S, j * 256);
        asm volatile("s_waitcnt vmcnt(0)" ::: "memory"); __syncthreads();
        const int nsel = j < 3 ? j : 3;
#pragma unroll 1
        for (int k = 0; k < 2; ++k) {
            const int hg = 2 * hp + k, qs = (k & 1) ? 7 - w : w, qo = qs * 32, h = kvh * 4 + hg;
            const float sl2 = moba_sl2(h);
            const int t0 = j * 256 + qo, q = t0 + r32;
            const size_t row = (size_t)(b * S + q);
            bf16* qrow = QM + row * 512 + h * 64;
            bf16x8 qr[4]; loadq(qr, qrow + 8 * hi);
            St st; st.o0 = f32x16{}; st.o1 = f32x16{}; st.m = -INFINITY; st.l = 0.f;
            const int nfull = nofull ? 0 : (qo >> 6), kod = (qo & 32) ? qo - 32 : qo;
            bf16x8 kf[8]; read_k<false>(kf, img, lo, nfull ? 0 : kod, r32);
#pragma unroll 1
            for (int i = 0; i < nfull; ++i) tile_run<0, false, true, true>(st, qr, kf, img, lo, 64 * i, 64 * i - qo - r32, sl2, true, 0, hi, r32, (i + 1 < nfull) ? 64 * i + 64 : kod);
            if (qo & 32) tile_run<2, false, true, false>(st, qr, kf, img, lo, qo - 32, -32 - r32, sl2, true, 0, hi, r32, 0);
            else tile_run<2, true, true, false>(st, qr, kf, img, lo, qo, -r32, sl2, true, 0, hi, r32, 0);
            const float lt = st.l + __shfl_xor(st.l, 32);
            const float lse_own = st.m + __builtin_amdgcn_logf(lt), rl = __builtin_amdgcn_rcpf(lt);
            LAS unsigned char* stg = F.lds + RING_OFF + IMG_BYTES + w * 4736;
#pragma unroll
            for (int g = 0; g < 4; ++g) { u32x2 a2, c2;
                a2.x = cvtpk(st.o0[4 * g] * rl, st.o0[4 * g + 1] * rl); a2.y = cvtpk(st.o0[4 * g + 2] * rl, st.o0[4 * g + 3] * rl);
                c2.x = cvtpk(st.o1[4 * g] * rl, st.o1[4 * g + 1] * rl); c2.y = cvtpk(st.o1[4 * g + 2] * rl, st.o1[4 * g + 3] * rl);
                *(LAS u32x2*)(stg + r32 * 144 + (8 * g + 4 * hi) * 2) = a2; *(LAS u32x2*)(stg + r32 * 144 + (32 + 8 * g + 4 * hi) * 2) = c2; }
            if (hi == 0) *(LAS float*)(stg + 4608 + r32 * 4) = lse_own;
            LDS_WAIT(); asm volatile("" ::: "memory");
            if (nocomb) continue;
#pragma unroll
            for (int i = 0; i < 4; ++i) {
                const int rw = i * 8 + (lane >> 3), ch = lane & 7;
                const size_t grow = (size_t)(b * S + t0 + rw), sl0 = ((size_t)((b * 8 + h) * 3)) * S + t0 + rw;
                const u32x4 own = *(const LAS u32x4*)(stg + rw * 144 + ch * 16); const float lo_ = *(const LAS float*)(stg + 4608 + rw * 4);
                float ls[3]; u32x4 pr[3];
#pragma unroll
                for (int r = 0; r < 3; ++r) { ls[r] = -INFINITY; pr[r] = (u32x4){0u, 0u, 0u, 0u}; if (r < nsel) { ls[r] = LSE[sl0 + (size_t)r * S]; pr[r] = *(const u32x4*)(PART + (sl0 + (size_t)r * S) * 64 + ch * 8); } }
                float M = lo_;
#pragma unroll
                for (int r = 0; r < 3; ++r) M = fmaxf(M, ls[r]);
                const float w0 = __builtin_amdgcn_exp2f(lo_ - M); float W = w0;
                float acc8[8];
                acc8[0] = w0 * bf2f(own.x & 0xffffu); acc8[1] = w0 * bf2f(own.x >> 16); acc8[2] = w0 * bf2f(own.y & 0xffffu); acc8[3] = w0 * bf2f(own.y >> 16);
                acc8[4] = w0 * bf2f(own.z & 0xffffu); acc8[5] = w0 * bf2f(own.z >> 16); acc8[6] = w0 * bf2f(own.w & 0xffffu); acc8[7] = w0 * bf2f(own.w >> 16);
#pragma unroll
                for (int r = 0; r < 3; ++r) { const float wr_ = __builtin_amdgcn_exp2f(ls[r] - M); W += wr_;
                    acc8[0] += wr_ * bf2f(pr[r].x & 0xffffu); acc8[1] += wr_ * bf2f(pr[r].x >> 16); acc8[2] += wr_ * bf2f(pr[r].y & 0xffffu); acc8[3] += wr_ * bf2f(pr[r].y >> 16);
                    acc8[4] += wr_ * bf2f(pr[r].z & 0xffffu); acc8[5] += wr_ * bf2f(pr[r].z >> 16); acc8[6] += wr_ * bf2f(pr[r].w & 0xffffu); acc8[7] += wr_ * bf2f(pr[r].w >> 16); }
                const float rW = __builtin_amdgcn_rcpf(W);
                u32x4 o; o.x = cvtpk(acc8[0] * rW, acc8[1] * rW); o.y = cvtpk(acc8[2] * rW, acc8[3] * rW); o.z = cvtpk(acc8[4] * rW, acc8[5] * rW); o.w = cvtpk(acc8[6] * rW, acc8[7] * rW);
                *(u32x4*)(QM + grow * 512 + h * 64 + ch * 8) = o;
            }
            LDS_WAIT(); asm volatile("" ::: "memory");
        }
    }
}
}
#ifndef BENCH_HOT
#define BENCH_HOT 0
#endif
#ifndef BENCH_NOSTORE
#define BENCH_NOSTORE 0
#endif
#ifndef BENCH_SUB
#define BENCH_SUB 3
#endif
#ifndef ALIGN_ONE
#define ALIGN_ONE true
#endif
#ifndef ALIGN_BIG
#define ALIGN_BIG true
#endif
#ifndef BENCH_NOEPI
#define BENCH_NOEPI 0
#endif
#ifndef BENCH_AGLU
#define BENCH_AGLU 0
#endif
#ifndef BENCH_KGLU
#define BENCH_KGLU 0
#endif
#ifndef PH_MASK
#define PH_MASK 0xFFF
#endif
#define PH_ON(k) (((PH_MASK) >> (k)) & 1)
constexpr int NPH = 10, PH_FINAL = DEPTH * NPH, PH_TOTAL = PH_FINAL + 1;
struct Args { Ptrs P; int ph_lo, ph_hi, use_bar, sub; };
__global__ void __launch_bounds__(NWAVES * 64, 2) mk_fwd(Args args) {
    extern __shared__ __attribute__((aligned(16))) unsigned char lds[];
    Frame F;
    F.lds = (LAS unsigned char*)lds;
    F.tid = threadIdx.x; F.lane = F.tid & 63; F.wave = __builtin_amdgcn_readfirstlane(F.tid >> 6);
    F.G = gridDim.x; { const int bx = blockIdx.x; F.vcu = (F.G % 8 == 0) ? (bx % 8) * (F.G / 8) + bx / 8 : bx; }
    typedef const __attribute__((address_space(4))) Args* KArgs;
    const KArgs ka = (KArgs)__builtin_amdgcn_kernarg_segment_ptr();
    volatile LAS unsigned* MISC = (volatile LAS unsigned*)(F.lds + MISC_OFF);
    for (int u = F.tid; u < (LDS_BYTES - LDSCTL_OFF) / 4; u += NWAVES * 64) ((LAS unsigned*)(F.lds + LDSCTL_OFF))[u] = 0u;
    __syncthreads();
    XcdBarrier bar; bar.bar = (unsigned*)(ka->P.ws + WS_CTL) + CW_BAR; bar.x = 0; bar.st = nullptr; bar.total = gridDim.x;
    const int use_bar = ka->use_bar;
    XcdBarrier bbar; bbar.bar = nullptr; bbar.x = 0; bbar.st = nullptr; bbar.total = 64u;
    if (use_bar) { bar = xcd_barrier_post((unsigned*)(ka->P.ws + WS_CTL) + CW_BAR, MISC + 8, gridDim.x);
        bbar = xcd_barrier_post((unsigned*)(ka->P.ws + WS_CTL) + CW_BBAR + (((int)blockIdx.x & 7) >> 1) * 4096, MISC + 12, 64u); }
    LAS unsigned char* ring = F.lds + RING_OFF;
    for (int ph = ka->ph_lo; ; ++ph) {
        { KArgs ka3 = ka; asm volatile("" : "+s"(ka3)); if (ph >= ka3->ph_hi) break; }
#if defined(BENCH_SET)
        const bool bench = ph >= PH_TOTAL; const int l = bench ? DEPTH - 1 : ph / NPH, k = bench ? (ph - PH_TOTAL) % NPH : ph % NPH;
        if (bench && !(((BENCH_SET) >> k) & 1)) continue;
#if defined(BENCH_EMPTY)
        if (bench) { if (ph + 1 < ka->ph_hi) xcd_barrier(bar); continue; }
#endif
        const int lc = bench ? DEPTH + (ph - PH_TOTAL) / NPH : l;
#else
        const bool bench = false; const int l = ph / NPH, k = ph % NPH; const int lc = l;
#endif
        KArgs ka2 = ka; asm volatile("" : "+s"(ka2)); KP P = &ka2->P;
        unsigned char* ws = ka2->P.ws;
        F.tid = threadIdx.x; asm volatile("" : "+v"(F.tid)); F.lane = F.tid & 63;
        int bx = (int)blockIdx.x; asm volatile("" : "+s"(bx));
        const int bb = (bx & 7) >> 1, lb = (bx & 1) * 32 + (bx >> 3);
        { int g_ = (int)gridDim.x, w_ = F.tid >> 6; asm volatile("" : "+s"(g_)); F.G = g_; F.vcu = (g_ % 8 == 0) ? (bx % 8) * (g_ / 8) + bx / 8 : bx; F.wave = __builtin_amdgcn_readfirstlane(w_); }
        if (ph == PH_FINAL && !bench) { if (PH_ON(10)) final_pass(F, P);
        }
        else if (k == 0 && PH_ON(0)) { if (l == 0) { conv_layer(F, P, l); ssm_mats(F, P, l); xb_pass(F, P); __syncthreads(); } }
        else if (k == 1 && PH_ON(1)) {
            pg8::SrcStd g{(const char*)(ws + WS_XN), (const char*)(ws + WS_WIN), DM, 0}; pg8::StaticOrder So; So.init(T, DIN, F.G, bx);
            pg8::EpiInProj E{ws, pg8::RinvTab{(const LAS float*)(F.lds + RINV_OFF)}, (bench && BENCH_NOEPI) ? 1 : 0};
            pg8::gemm_phase<pg8::EpiInProj, pg8::SrcStd, pg8::StaticOrder, ALIGN_BIG>(ring, g, So, E);
        }
        else if (k == 2 && PH_ON(2)) {
            unsigned* edone = (unsigned*)(ws + WS_CTL) + CW_EDONE + lc * 4 + bb;
            if (ka2->sub & 1) { pg8::SrcSsm<false> g{(const char*)(ws + WS_U), nullptr, (const char*)(ws + WS_SEND)}; pg8::SsmOrder So{lb, bb, lb < 32}; pg8::EpiSsmEnd E{(float*)(ws + WS_HEND), ws};
                pg8::gemm_phase<pg8::EpiSsmEnd, pg8::SrcSsm<false>, pg8::SsmOrder, ALIGN_ONE>(ring, g, So, E);
                if (lb < 32 && F.tid == 0) __hip_atomic_fetch_add(edone, 1u, __ATOMIC_RELAXED, __HIP_MEMORY_SCOPE_AGENT); }
            if (ka2->sub & 2) att::swa_select_phase(F, P, l, lc, bb);
            if ((F.vcu & 15) == 0) {
                if (F.tid == 0) { unsigned sp = 0u; while (__hip_atomic_load(edone, __ATOMIC_RELAXED, __HIP_MEMORY_SCOPE_AGENT) < 32u) { if (++sp > (1u << 26)) break; }
                    __builtin_amdgcn_fence(__ATOMIC_ACQUIRE, "agent"); asm volatile("s_waitcnt vmcnt(0)" ::: "memory"); }
                __syncthreads();
                ssm_carry(F, P, l);
                asm volatile("s_waitcnt vmcnt(0)" ::: "memory"); __syncthreads(); if (F.tid == 0) __hip_atomic_fetch_add((unsigned*)(ws + WS_CTL) + CW_CDONE + l, 1u, __ATOMIC_RELAXED, __HIP_MEMORY_SCOPE_AGENT);
            } else {
                if (F.tid == 0) { unsigned* sd = (unsigned*)(ws + WS_CTL) + CW_SDONE + lc * 8 + (bx & 7); unsigned sp = 0u;
                    while (__hip_atomic_load(sd, __ATOMIC_RELAXED, __HIP_MEMORY_SCOPE_AGENT) < 32u) { if (++sp > (1u << 26)) break; }
                    __builtin_amdgcn_fence(__ATOMIC_ACQUIRE, "agent"); asm volatile("s_waitcnt vmcnt(0)" ::: "memory"); }
                __syncthreads();
                att::moba_gather(F, P, lc, false);
            }
        }
        else if (k == 3 && PH_ON(3)) { }
        else if (k == 4 && PH_ON(4)) {
            unsigned* done = (unsigned*)(ws + WS_CTL) + CW_DONE + lc * 4 + bb;
            if (!bench && use_bar && lb < 32) {
                if (F.tid == 0) { unsigned* cd = (unsigned*)(ws + WS_CTL) + CW_CDONE + l; unsigned sp = 0u;
                    while (__hip_atomic_load(cd, __ATOMIC_RELAXED, __HIP_MEMORY_SCOPE_AGENT) < 16u) { if (++sp > (1u << 26)) break; } }
                __syncthreads(); }
            { pg8::SrcSsm<true> g{(const char*)(ws + WS_U), (const char*)(ws + WS_HINIT), (const char*)(ws + WS_SMAIN)}; pg8::SsmOrder So{lb, bb, lb < 32}; pg8::EpiSsmMain E{(bf16*)(ws + WS_YS), ws};
              pg8::Unit u0; const bool mine = So.next(0, u0);
              pg8::gemm_phase<pg8::EpiSsmMain, pg8::SrcSsm<true>, pg8::SsmOrder, true>(ring, g, So, E);
              if (mine && F.tid == 0) {
                  __builtin_amdgcn_fence(__ATOMIC_RELEASE, "agent"); asm volatile("s_waitcnt vmcnt(0)" ::: "memory");
                  __hip_atomic_fetch_add(done, 1u, __ATOMIC_RELAXED, __HIP_MEMORY_SCOPE_AGENT); } }
            unsigned* qctr = (unsigned*)(ws + WS_CTL) + CW_OWNQ + lc * 4 + bb;
            volatile LAS unsigned* jobw = (volatile LAS unsigned*)(F.lds + MISC_OFF + 64);
            int job;
            for (;;) {
                __syncthreads();
                if (F.tid == 0) *jobw = __hip_atomic_fetch_add(qctr, 1u, __ATOMIC_RELAXED, __HIP_MEMORY_SCOPE_AGENT);
                __syncthreads();
                job = (int)*jobw;
                if (job >= 64) break;
                att::own_subjob(F, P, 64 * bb + job);
            }
            if (job < 128) {
                if (F.tid == 0) { unsigned sp = 0u; while (__hip_atomic_load(done, __ATOMIC_RELAXED, __HIP_MEMORY_SCOPE_AGENT) < 32u) { __builtin_amdgcn_s_sleep(2); if (++sp > (1u << 22)) break; }
                    __builtin_amdgcn_fence(__ATOMIC_ACQUIRE, "agent"); asm volatile("s_waitcnt vmcnt(0)" ::: "memory"); }
                __syncthreads();
            }
            while (job < 128) {
                { const int gj = 64 * bb + job - 64;
                  pg8::SrcStd g{(const char*)(ws + WS_YS), (const char*)(ws + WS_WGLU), 512, 0}; pg8::OneUnit So{gj >> 2, gj & 3}; pg8::EpiGlu E{(bf16*)(ws + WS_A1), ws};
                  pg8::gemm_phase<pg8::EpiGlu, pg8::SrcStd, pg8::OneUnit, true>(ring, g, So, E); }
                __syncthreads();
                if (F.tid == 0) *jobw = __hip_atomic_fetch_add(qctr, 1u, __ATOMIC_RELAXED, __HIP_MEMORY_SCOPE_AGENT);
                __syncthreads();
                job = (int)*jobw;
            }
        }
        else if (k == 5 && PH_ON(5)) { }
        else if (k == 6 && PH_ON(6)) {
            pg8::SrcMerge g{(const char*)(ws + WS_QA), (const char*)(ws + WS_A1), (const char*)(ws + WS_QM), (const char*)(ws + WS_WMRG)}; pg8::StaticOrder So; So.init(T, DM, F.G, bx);
            pg8::EpiMerge E{(const bf16*)(ws + WS_GATES), (bf16*)(ws + WS_MIXED), ws};
            pg8::gemm_phase<pg8::EpiMerge, pg8::SrcMerge, pg8::StaticOrder, ALIGN_ONE>(ring, g, So, E);
        }
        else if ((k == 7 || k == 9) && PH_ON(7)) {
            const bool f2 = (k == 9);
            pg8::SrcStd g{(const char*)(ws + (f2 ? WS_H1 : WS_MIXED)), (f2 ? ((l & 1) ? (const char*)(ws + WS_WFF2) : (const char*)P->x) : (const char*)(ws + WS_WOUT)), f2 ? DFF : DM, (bench && BENCH_HOT) ? 1 : 0}; pg8::StaticOrder So; So.init(T, DM, F.G, bx);
            const bool fin = !bench && f2 && l == DEPTH - 1 && use_bar;
            pg8::Unit uf; So.next(0, uf);
            pg8::EpiResid E{(!bench && l == 0 && !f2) ? P->x_in : (const float*)nullptr, (bf16*)(ws + (bench ? WS_KM : WS_XN)), (float*)(ws + WS_SSQ), ws,
                            fin ? P->x : (float*)nullptr, P->norm_final, (unsigned*)(ws + WS_CTL) + CW_TEAM + uf.pm * 16 + 1, (LAS float*)(F.lds + RINV_OFF)};
            pg8::gemm_phase<pg8::EpiResid, pg8::SrcStd, pg8::StaticOrder, ALIGN_ONE>(ring, g, So, E);
            if (f2 && !bench && l + 1 < DEPTH) {
                if (use_bar) { if (F.tid == 0) { unsigned* wd = (unsigned*)(ws + WS_CTL) + CW_WDONE + l; unsigned sp = 0u;
                        while (__hip_atomic_load(wd, __ATOMIC_RELAXED, __HIP_MEMORY_SCOPE_AGENT) < (unsigned)F.G) { __builtin_amdgcn_s_sleep(1); if (++sp > (1u << 24)) break; } }
                    __syncthreads(); }
                conv_layer(F, P, l + 1); ssm_mats(F, P, l + 1); __syncthreads(); }
        }
        else if (k == 8 && PH_ON(8)) {
            if (!bench && use_bar) {
                if (F.tid == 0) { unsigned* md = (unsigned*)(ws + WS_CTL) + CW_MDONE + l; unsigned sp = 0u;
                    while (__hip_atomic_load(md, __ATOMIC_RELAXED, __HIP_MEMORY_SCOPE_AGENT) < (unsigned)F.G) { __builtin_amdgcn_s_sleep(1); if (++sp > (1u << 24)) break; } }
                __syncthreads(); }
            pg8::SrcStd g{(const char*)(ws + WS_XN), ((l & 1) ? (const char*)(ws + WS_WFF1) : (const char*)P->x + 8 * MiB), DM, (bench && BENCH_HOT) ? 1 : 0}; pg8::StaticOrder So; So.init(T, DFF, F.G, bx);
            pg8::EpiFfn1 E{(bf16*)(ws + WS_H1), pg8::RinvTab{(const LAS float*)(F.lds + RINV_OFF)}, (bench && BENCH_NOEPI) ? 1 : 0, ws};
            pg8::gemm_phase<pg8::EpiFfn1, pg8::SrcStd, pg8::StaticOrder, ALIGN_BIG>(ring, g, So, E);
        }
        if (k == 9 && l == DEPTH - 1 && !bench && use_bar) break;
        if ((k == 5 || k == 3 || (k == 0 && l > 0)) && !bench) continue;
        if ((k == 6 || k == 7 || k == 8) && !bench && use_bar) {
            static_assert((WT_MASK & 5) == 5, "the team hand-over relies on write-through stores of MIXED, XB / SSQ and H1");
            if (k == 6 && F.tid == 0) __hip_atomic_fetch_add((unsigned*)(ws + WS_CTL) + CW_MDONE + l, 1u, __ATOMIC_RELAXED, __HIP_MEMORY_SCOPE_AGENT);
            if (k == 7 && F.tid == 0) __hip_atomic_fetch_add((unsigned*)(ws + WS_CTL) + CW_WDONE + l, 1u, __ATOMIC_RELAXED, __HIP_MEMORY_SCOPE_AGENT);
            pg8::StaticOrder So; So.init(T, DM, F.G, bx); pg8::Unit u0; So.next(0, u0);
            team_barrier((unsigned*)(ws + WS_CTL) + CW_TEAM + u0.pm * 16, 4u * (unsigned)(l * 3 + (k - 6) + 1));
            continue;
        }
        { KArgs ka3 = ka; asm volatile("" : "+s"(ka3)); if (ph + 1 < ka3->ph_hi) { if (ka3->use_bar) { if (k >= 1 && k <= 4 && !bench) xcd_barrier(bbar); else xcd_barrier(bar); } else __syncthreads(); } }
    }
}
extern "C" void kernel_launch(void* const* d_in, const int* in_sizes, int n_in, void* d_out, int out_size, void* d_ws, size_t ws_size, hipStream_t stream) {
    static int grid = 0;
    if (grid == 0) {
        if (n_in != 21 || out_size != T * DM || ws_size < WS_END) { fprintf(stderr, "kernel_launch: unexpected shapes (n_in %d out %d ws %zu)\n", n_in, out_size, ws_size); grid = -1; return; }
        int dev = 0, cus = 0;
        if (hipGetDevice(&dev) != hipSuccess || hipDeviceGetAttribute(&cus, hipDeviceAttributeMultiprocessorCount, dev) != hipSuccess) { grid = -1; return; }
        if (hipFuncSetAttribute((const void*)mk_fwd, hipFuncAttributeMaxDynamicSharedMemorySize, LDS_BYTES) != hipSuccess) { fprintf(stderr, "kernel_launch: hipFuncSetAttribute failed\n"); grid = -1; return; }
        int per_cu = 0;
        if (hipOccupancyMaxActiveBlocksPerMultiprocessor(&per_cu, (const void*)mk_fwd, NWAVES * 64, LDS_BYTES) != hipSuccess || per_cu < 1) { fprintf(stderr, "kernel_launch: occupancy query reports %d workgroups per CU\n", per_cu); (void)hipGetLastError(); }
        grid = cus;
        if (grid != 256) { fprintf(stderr, "kernel_launch: built for a 256-CU device (unit dealing assumes 256 workgroups); found %d CUs; nothing launched\n", cus); grid = -1; return; }
    }
    if (grid < 0) return;
    (void)hipMemsetAsync((char*)d_ws + WS_CTL, 0, CTL_ZERO_BYTES, stream);
    Args a{};
    const float** pp = (const float**)&a.P; for (int i = 0; i < 21; ++i) pp[i] = (const float*)d_in[i];
    a.P.x = (float*)d_out; a.P.ws = (unsigned char*)d_ws;
    #if defined(BENCH_SET)
    a.ph_lo = 0; a.ph_hi = PH_TOTAL + NPH * (BENCH_REPS);
#else
    a.ph_lo = 0; a.ph_hi = PH_TOTAL;
#endif
    a.use_bar = 1; a.sub = 3;
    hipLaunchKernelGGL(mk_fwd, dim3(grid), dim3(NWAVES * 64), LDS_BYTES, stream, a);
}
```
